# Optimizing an MI355X kernel written in HIP

```python
import jax, jax.numpy as jnp
from jax import lax
import numpy as np

D_MODEL = 1024
BATCH = 16
SEQ = 256
DEPTH = 2
DEC_BATCH = 2
DEC_SEQ = 2048
PAST_LEN = 512

GRID_W = 64
N_EVEN = (DEPTH + 1) // 2
N_ODD = DEPTH // 2
N_DIR = 2
CONV_W = D_MODEL
CONV_TAPS = 3
WKV_W = D_MODEL
WKV_HEAD_DIM = 64
WKV_HEADS = WKV_W // WKV_HEAD_DIM
DECAY_RANK = 64
ICLR_RANK = 64
GN_EPS = 64e-5
GLA_HEADS = 4
GLA_DK_TOTAL = D_MODEL // 2
GLA_DV_TOTAL = D_MODEL
GLA_DK = GLA_DK_TOTAL // GLA_HEADS
GLA_DV = GLA_DV_TOTAL // GLA_HEADS
GLA_GATE_RANK = 16
GLA_GATE_NORM = 16.0
GLA_CHUNK = 64
EVEN_IN = 4 * CONV_W + 4 * WKV_W
ODD_IN = 2 * GLA_DK_TOTAL + 2 * GLA_DV_TOTAL
EVEN_SPLITS = [CONV_W, 2 * CONV_W, 3 * CONV_W, 4 * CONV_W, 4 * CONV_W + WKV_W, 4 * CONV_W + 2 * WKV_W, 4 * CONV_W + 3 * WKV_W]
ODD_SPLITS = [GLA_DK_TOTAL, 2 * GLA_DK_TOTAL, 2 * GLA_DK_TOTAL + GLA_DV_TOTAL]
NORM_EPS = 1e-6

kernel_name = 'bidir_conv_rwkv7_gla_diffusion_step'


def _rmsnorm(x, g):
    xf = x.astype(jnp.float32)
    y = xf * lax.rsqrt(jnp.mean(xf * xf, axis=-1, keepdims=True) + NORM_EPS)
    return (y * g.astype(jnp.float32)).astype(x.dtype)


def _short_conv(u, w, row_len):
    b, t, ch = u.shape
    ug = u.reshape(b, t // row_len, row_len, ch)
    up = jnp.pad(ug, ((0, 0), (0, 0), (1, 1), (0, 0)))
    y = w[0] * up[:, :, :-2] + w[1] * up[:, :, 1:-1] + w[2] * up[:, :, 2:]
    return y.reshape(b, t, ch)


def _orient(xf, xb):
    return jnp.stack([xf, jnp.flip(xb, axis=1)], axis=0)


def _unorient(o):
    return o[0] + jnp.flip(o[1], axis=1)


def _wkv7_scan(r, w, k, kk, a, v, s0):
    def step(s, inp):
        r_t, w_t, k_t, kk_t, a_t, v_t = inp
        s_kk = jnp.einsum('zbhvk,zbhk->zbhv', s, kk_t)
        s = (s * w_t[..., None, :] - s_kk[..., :, None] * (kk_t * a_t)[..., None, :]
             + v_t[..., :, None] * k_t[..., None, :])
        return s, jnp.einsum('zbhvk,zbhk->zbhv', s, r_t)
    xs = tuple(jnp.moveaxis(z, 2, 0) for z in (r, w, k, kk, a, v))
    s_fin, o = lax.scan(step, s0, xs)
    return jnp.moveaxis(o, 0, 2), s_fin


def _gla_chunk_scan(q, k, v, g, s0):
    z, b, t, h, _ = q.shape
    n = t // GLA_CHUNK

    def chunks(x):
        return x.reshape(z, b, n, GLA_CHUNK, h, x.shape[-1]).transpose(2, 0, 1, 4, 3, 5)

    mask = jnp.tril(jnp.ones((GLA_CHUNK, GLA_CHUNK), dtype=bool))

    def step(s, inp):
        q_c, k_c, v_c, g_c = inp
        bc = jnp.cumsum(g_c, axis=-2)
        b_last = bc[..., -1:, :]
        qe = q_c * jnp.exp(bc)
        ke = k_c * jnp.exp(-bc)
        att = jnp.where(mask, jnp.einsum('zbhid,zbhjd->zbhij', qe, ke), 0.0)
        o = jnp.einsum('zbhij,zbhje->zbhie', att, v_c) + jnp.einsum('zbhid,zbhde->zbhie', qe, s)
        s = (jnp.exp(b_last)[..., 0, :, None] * s
             + jnp.einsum('zbhjd,zbhje->zbhde', k_c * jnp.exp(b_last - bc), v_c))
        return s, o

    s_fin, o = lax.scan(step, s0, (chunks(q), chunks(k), chunks(v), chunks(g)))
    o = o.transpose(1, 2, 0, 4, 3, 5).reshape(z, b, t, h, v.shape[-1])
    return o, s_fin


def _mixer_conv_wkv(h, s0, row_len, w_in, w_out, conv_w, w0, w1, w2, a0, a1, a2,
                    k_k, k_a, r_k, ln_w, ln_b):
    f32 = jnp.float32
    b, t, _ = h.shape
    heads = lambda z: z.reshape(z.shape[:-1] + (WKV_HEADS, WKV_HEAD_DIM))
    u, gb, gc, zc, r, k, v, zw = jnp.split(h @ w_in, EVEN_SPLITS, axis=-1)
    o_conv = jax.nn.silu(zc) * gb * _short_conv(gc * u, conv_w, row_len)
    hf = h.astype(f32)
    w_raw = w0[:, None, None, :] + jnp.einsum('zbtr,zrc->zbtc', jnp.tanh(jnp.einsum('btd,zdr->zbtr', hf, w1)), w2)
    decay = jnp.exp(-jnp.exp(-jax.nn.softplus(-w_raw) - 0.5))
    iclr = jax.nn.sigmoid(a0[:, None, None, :] + jnp.einsum('zbtr,zrc->zbtc', jnp.einsum('btd,zdr->zbtr', hf, a1), a2))
    rf, kf, vf = r.astype(f32), k.astype(f32), v.astype(f32)
    kk = heads(kf * k_k)
    kk = kk / jnp.maximum(jnp.sqrt(jnp.sum(kk * kk, axis=-1, keepdims=True)), 1e-12)
    k_mod = heads(kf[None] * (1.0 + (iclr - 1.0) * k_a))
    decay_h, iclr_h = heads(decay), heads(iclr)
    rh, vh = heads(rf), heads(vf)
    o, s_fin = _wkv7_scan(_orient(rh, rh), _orient(decay_h[0], decay_h[1]), _orient(k_mod[0], k_mod[1]),
                          _orient(kk, kk), _orient(iclr_h[0], iclr_h[1]), _orient(vh, vh), s0.astype(f32))
    o = _unorient(o)
    mu = jnp.mean(o, axis=-1, keepdims=True)
    var = jnp.mean(jnp.square(o - mu), axis=-1, keepdims=True)
    gn = ((o - mu) * lax.rsqrt(var + GN_EPS)).reshape(b, t, WKV_W) * ln_w + ln_b
    bonus = jnp.sum(rh[None] * k_mod * r_k, axis=(0, -1))[..., None] * vh
    o_wkv = (gn + bonus.reshape(b, t, WKV_W)) * jax.nn.silu(zw.astype(f32))
    y = jnp.concatenate([o_conv, o_wkv.astype(h.dtype)], axis=-1) @ w_out
    return y, s_fin


def _mixer_gla(h, s0, w_in, w_out, gk1, gk2, gk_b, g_norm):
    f32 = jnp.float32
    b, t, _ = h.shape
    kh = lambda z: z.reshape(z.shape[:-1] + (GLA_HEADS, GLA_DK))
    vhd = lambda z: z.reshape(z.shape[:-1] + (GLA_HEADS, GLA_DV))
    q, k, v, zg = jnp.split(h @ w_in, ODD_SPLITS, axis=-1)
    hf = h.astype(f32)
    g = jax.nn.log_sigmoid(jnp.einsum('zbtr,zrc->zbtc', jnp.einsum('btd,zdr->zbtr', hf, gk1), gk2)
                           + gk_b[:, None, None, :]) / GLA_GATE_NORM
    g = kh(g)
    qh = kh(q.astype(f32) * GLA_DK ** -0.5)
    khh = kh(k.astype(f32))
    vh = vhd(v.astype(f32))
    o, s_fin = _gla_chunk_scan(_orient(qh, qh), _orient(khh, khh), _orient(vh, vh),
                               _orient(g[0], g[1]), s0.astype(f32))
    o = _unorient(o)
    o = o * lax.rsqrt(jnp.mean(o * o, axis=-1, keepdims=True) + NORM_EPS) * g_norm
    o = o.reshape(b, t, GLA_DV_TOTAL) * jax.nn.silu(zg.astype(f32))
    return o.astype(h.dtype) @ w_out, s_fin


def _trunk(x, cvec, s_wkv, s_gla, row_len, norm_g, ada_w, ada_b, final_g, even, odd):
    f32 = jnp.float32
    new_wkv, new_gla = [], []
    cf = jax.nn.silu(cvec.astype(f32))
    for l in range(DEPTH):
        mod = cf @ ada_w[l].astype(f32) + ada_b[l].astype(f32)
        shift, scale, gate = jnp.split(mod[:, None, :], 3, axis=-1)
        h = (_rmsnorm(x, norm_g[l]).astype(f32) * (1.0 + scale) + shift).astype(x.dtype)
        i = l // 2
        if l % 2 == 0:
            y, s = _mixer_conv_wkv(h, jnp.swapaxes(s_wkv[:, i], 0, 1), row_len, *[p[i] for p in even])
            new_wkv.append(jnp.swapaxes(s, 0, 1))
        else:
            y, s = _mixer_gla(h, jnp.swapaxes(s_gla[:, i], 0, 1), *[p[i] for p in odd])
            new_gla.append(jnp.swapaxes(s, 0, 1))
        x = (x.astype(f32) + gate * y.astype(f32)).astype(x.dtype)
    return _rmsnorm(x, final_g), jnp.stack(new_wkv, axis=1), jnp.stack(new_gla, axis=1)


def setup_inputs(seed: int = 0) -> dict:
    key = jax.random.key(seed)
    ks = iter(jax.random.split(key, 40))
    f32 = jnp.float32
    nrm = lambda shape, s: jax.random.normal(next(ks), shape, f32) * s
    D = D_MODEL
    return {
        'x_prompt': nrm((BATCH, SEQ, D), 1.0),
        'x_sample': nrm((DEC_BATCH, DEC_SEQ, D), 1.0),
        'state_wkv': nrm((DEC_BATCH, N_EVEN, N_DIR, WKV_HEADS, WKV_HEAD_DIM, WKV_HEAD_DIM), 0.3),
        'state_gla': nrm((DEC_BATCH, N_ODD, N_DIR, GLA_HEADS, GLA_DK, GLA_DV), 0.3),
        'c': nrm((DEC_BATCH, D), 1.0),
        'c_ctx': nrm((D,), 1.0),
        'norm_g': 1.0 + nrm((DEPTH, D), 0.02),
        'ada_w': nrm((DEPTH, D, 3 * D), 0.5 * D ** -0.5),
        'ada_b': nrm((DEPTH, 3 * D), 0.01),
        'final_g': 1.0 + nrm((D,), 0.02),
        'e_w_in': nrm((N_EVEN, D, EVEN_IN), D ** -0.5),
        'e_w_out': nrm((N_EVEN, CONV_W + WKV_W, D), (CONV_W + WKV_W) ** -0.5),
        'conv_w': nrm((N_EVEN, CONV_TAPS, CONV_W), 0.5),
        'wkv_w0': jax.random.uniform(next(ks), (N_EVEN, N_DIR, WKV_W), f32, -6.0, 1.0),
        'wkv_w1': nrm((N_EVEN, N_DIR, D, DECAY_RANK), D ** -0.5),
        'wkv_w2': nrm((N_EVEN, N_DIR, DECAY_RANK, WKV_W), 0.1 * DECAY_RANK ** -0.5),
        'wkv_a0': nrm((N_EVEN, N_DIR, WKV_W), 0.5),
        'wkv_a1': nrm((N_EVEN, N_DIR, D, ICLR_RANK), D ** -0.5),
        'wkv_a2': nrm((N_EVEN, N_DIR, ICLR_RANK, WKV_W), 0.1 * ICLR_RANK ** -0.5),
        'wkv_k_k': 0.85 + nrm((N_EVEN, WKV_W), 0.1),
        'wkv_k_a': 1.0 + nrm((N_EVEN, WKV_W), 0.1),
        'wkv_r_k': nrm((N_EVEN, WKV_HEADS, WKV_HEAD_DIM), 0.1),
        'wkv_ln_w': 1.0 + nrm((N_EVEN, WKV_W), 0.02),
        'wkv_ln_b': nrm((N_EVEN, WKV_W), 0.01),
        'o_w_in': nrm((N_ODD, D, ODD_IN), D ** -0.5),
        'o_w_out': nrm((N_ODD, GLA_DV_TOTAL, D), GLA_DV_TOTAL ** -0.5),
        'gla_gk1': nrm((N_ODD, N_DIR, D, GLA_GATE_RANK), D ** -0.5),
        'gla_gk2': nrm((N_ODD, N_DIR, GLA_GATE_RANK, GLA_DK_TOTAL), GLA_GATE_RANK ** -0.5),
        'gla_gk_b': nrm((N_ODD, N_DIR, GLA_DK_TOTAL), 0.5),
        'gla_g_norm': 1.0 + nrm((N_ODD, GLA_DV), 0.02),
    }


def reference(x_prompt, x_sample, state_wkv, state_gla, c, c_ctx, norm_g, ada_w, ada_b, final_g,
              e_w_in, e_w_out, conv_w, wkv_w0, wkv_w1, wkv_w2, wkv_a0, wkv_a1, wkv_a2,
              wkv_k_k, wkv_k_a, wkv_r_k, wkv_ln_w, wkv_ln_b,
              o_w_in, o_w_out, gla_gk1, gla_gk2, gla_gk_b, gla_g_norm):
    even = (e_w_in, e_w_out, conv_w, wkv_w0, wkv_w1, wkv_w2, wkv_a0, wkv_a1, wkv_a2,
            wkv_k_k, wkv_k_a, wkv_r_k, wkv_ln_w, wkv_ln_b)
    odd = (o_w_in, o_w_out, gla_gk1, gla_gk2, gla_gk_b, gla_g_norm)
    n_ctx_req, ctx_len = x_prompt.shape[0], x_prompt.shape[1]
    zero_wkv = jnp.zeros((n_ctx_req,) + state_wkv.shape[1:], jnp.float32)
    zero_gla = jnp.zeros((n_ctx_req,) + state_gla.shape[1:], jnp.float32)
    y_prompt, new_state_wkv, new_state_gla = _trunk(x_prompt, c_ctx[None, :], zero_wkv, zero_gla, ctx_len,
                                                    norm_g, ada_w, ada_b, final_g, even, odd)
    y_sample, _, _ = _trunk(x_sample, c, state_wkv, state_gla, GRID_W,
                            norm_g, ada_w, ada_b, final_g, even, odd)
    return (y_prompt, y_sample, new_state_wkv, new_state_gla)
```

```cpp
#include <hip/hip_runtime.h>
#include <hip/hip_cooperative_groups.h>
#include <cstdio>
namespace cg = cooperative_groups;

#define LAS __attribute__((address_space(3)))
typedef unsigned short bf16_t;
typedef short bf16x8 __attribute__((ext_vector_type(8)));
typedef float f32x4 __attribute__((ext_vector_type(4)));
typedef unsigned u32x4 __attribute__((ext_vector_type(4)));
typedef unsigned u32x2 __attribute__((ext_vector_type(2)));

#ifndef MULTI_LAUNCH
#define MULTI_LAUNCH 0
#endif

constexpr int D = 1024, NTOK = 8192, NPTOK = 4096;
constexpr int N0 = 8448;
constexpr int N1 = 3328;
constexpr int NTHR = 512;
constexpr int LDS_BYTES = 131072 + 256;

constexpr size_t MB = 1024 * 1024;
constexpr size_t WS_CTL = 0;
constexpr size_t WS_MOD = 4096;
constexpr size_t WS_BON = WS_MOD + 2 * 3 * 3072 * 4;
constexpr size_t WS_BT0 = 2 * MB;
constexpr size_t WS_WT0O = WS_BT0 + (size_t)N0 * 1024 * 2;
constexpr size_t WS_BT1 = WS_WT0O + (size_t)1024 * 2048 * 2;
constexpr size_t WS_WT1O = WS_BT1 + (size_t)N1 * 1024 * 2;
constexpr size_t WS_H = WS_WT1O + (size_t)1024 * 1024 * 2;
constexpr size_t WS_OC = WS_H + (size_t)NTOK * 1024 * 2;
constexpr size_t WS_X1 = WS_OC + (size_t)NTOK * 2048 * 2;
constexpr size_t WS_P = WS_X1 + (size_t)NTOK * 1024 * 4;
constexpr size_t WS_P2 = WS_P + 64 * MB;
constexpr size_t WS_END = WS_P + (size_t)NTOK * N0 * 2;

struct Params {
    const float* in[30];
    float* out;
    unsigned char* ws;
    int ph_lo, ph_hi;
};

__device__ __forceinline__ float bf2f(bf16_t h) { return __uint_as_float(((unsigned)h) << 16); }
__device__ __forceinline__ bf16_t f2bf(float f) { unsigned u = __float_as_uint(f); u += 0x7FFFu + ((u >> 16) & 1u); return (bf16_t)(u >> 16); }
__device__ __forceinline__ unsigned pack2(float lo, float hi) { return (unsigned)f2bf(lo) | ((unsigned)f2bf(hi) << 16); }
__device__ __forceinline__ float bflo(unsigned w) { return __uint_as_float(w << 16); }
__device__ __forceinline__ float bfhi(unsigned w) { return __uint_as_float(w & 0xFFFF0000u); }
__device__ __forceinline__ float silu(float x) { return x / (1.f + __expf(-x)); }
__device__ __forceinline__ float wave_sum(float v) {
#pragma unroll
    for (int m = 32; m >= 1; m >>= 1) v += __shfl_xor(v, m, 64);
    return v;
}

namespace pg8 {
constexpr int BM = 256, BK = 64, HALF = 128, HTB = HALF * BK * 2, NXCD = 8, WGM = 8;
__device__ __forceinline__ int lds_byte(int r, int c) { const int st = (r >> 4) * 2 + (c >> 5), rr = r & 15, cc = c & 31, ob = rr * 64 + cc * 2; return st * 1024 + (ob ^ (((ob >> 9) & 1) << 5)); }
__device__ __forceinline__ void stage_rc(int b, int& R, int& C) { const int st = b / 1024, sb = b % 1024, swz = sb ^ (((sb >> 9) & 1) << 5); R = (st >> 1) * 16 + swz / 64; C = (st & 1) * 32 + (swz % 64) / 2; }
__device__ __forceinline__ int perm32(int rho) { const int n = rho >> 4, i = rho & 15; return 8 * (i >> 2) + 4 * n + (i & 3); }

struct Unit { int pm, pn, ks; };
struct Gemm { const bf16_t* A; const bf16_t* Bt; int M, N, K, ld, KS; };

struct Order {
    int nM, nN, nNr, nwg, G, c;
    __device__ void init(int M, int N, int KS, int G_, int c_) { nM = M / BM; nNr = N / BM; nN = nNr * KS; nwg = nM * nN; G = G_; c = c_; }
    __device__ bool next(int i, Unit& u) const {
        const long L = (long)i * G + c; if (L >= nwg) return false;
        int wgid = (int)L; { const int q = nwg / NXCD, r = nwg % NXCD, xcd = wgid % NXCD, off = wgid / NXCD; wgid = (xcd < r ? xcd * (q + 1) : r * (q + 1) + (xcd - r) * q) + off; }
        const int nig = WGM * nN, gid = wgid / nig, fm = gid * WGM, gsz = (nM - fm) < WGM ? (nM - fm) : WGM;
        u.pm = fm + ((wgid % nig) % gsz); const int pn = (wgid % nig) / gsz; u.pn = pn % nNr; u.ks = pn / nNr; return true;
    }
};

__device__ __forceinline__ unsigned cvt_pk_bf16(float lo, float hi) { unsigned r; asm volatile("v_cvt_pk_bf16_f32 %0, %1, %2" : "=v"(r) : "v"(lo), "v"(hi)); return r; }

struct EpiF32 {
    static constexpr bool PERM = false;
    float* C; int ldc; size_t ks_stride;
    __device__ __forceinline__ void operator()(const f32x4 (&acc)[2][2][4][2], const Unit& u, int wr, int wc, int fr, int fq) const {
        const int row0 = u.pm * BM + wr * 64 + fr, col0 = u.pn * BM + wc * 32 + 4 * fq;
        float* Cb = C + (size_t)u.ks * ks_stride;
#pragma unroll
        for (int ai = 0; ai < 2; ++ai)
#pragma unroll
            for (int m = 0; m < 4; ++m) { float* rowp = Cb + (size_t)(row0 + ai * HALF + m * 16) * ldc + col0;
#pragma unroll
                for (int bj = 0; bj < 2; ++bj)
#pragma unroll
                    for (int n = 0; n < 2; ++n) *(f32x4*)(rowp + bj * HALF + n * 16) = acc[ai][bj][m][n]; }
    }
};
struct EpiBf16 {
    static constexpr bool PERM = true;
    bf16_t* O; int ldc;
    __device__ __forceinline__ void operator()(const f32x4 (&acc)[2][2][4][2], const Unit& u, int wr, int wc, int fr, int fq) const {
        const int row0 = u.pm * BM + wr * 64 + fr; const int col0 = u.pn * BM + wc * 32 + 8 * fq;
#pragma unroll
        for (int ai = 0; ai < 2; ++ai)
#pragma unroll
            for (int m = 0; m < 4; ++m) { bf16_t* rowp = O + (size_t)(row0 + ai * HALF + m * 16) * ldc + col0;
#pragma unroll
                for (int bj = 0; bj < 2; ++bj) { const f32x4 v0 = acc[ai][bj][m][0], v1 = acc[ai][bj][m][1];
                    u32x4 w; w.x = cvt_pk_bf16(v0[0], v0[1]); w.y = cvt_pk_bf16(v0[2], v0[3]); w.z = cvt_pk_bf16(v1[0], v1[1]); w.w = cvt_pk_bf16(v1[2], v1[3]);
                    *(u32x4*)(rowp + bj * HALF) = w; } }
    }
};

template <class Epi>
__device__ __forceinline__ void gemm_phase(LAS unsigned char* lds, const Gemm g, const Order& S, const Epi& E) {
    const int tid = threadIdx.x, wid = __builtin_amdgcn_readfirstlane(tid >> 6), lane = tid & 63, wr = wid >> 2, wc = wid & 3, fr = lane & 15, fq = lane >> 4;
    const int K = g.K, nt = K / BK, ld = g.ld;
    unsigned voffA[2], voffB[2];
#pragma unroll
    for (int i = 0; i < 2; ++i) { int R, C; stage_rc(tid * 16 + i * 8192, R, C); const int Rb = Epi::PERM ? ((R & ~31) + perm32(R & 31)) : R;
        voffA[i] = (unsigned)(R * ld + C) * 2u; voffB[i] = (unsigned)(Rb * ld + C) * 2u; }
    const size_t kstep = (size_t)(BK * 2);
    const size_t hstep = (size_t)HALF * ld * 2;
    const size_t tstep = 2 * hstep;
    const size_t ksb = (size_t)K * 2;
    const unsigned ldsw = (unsigned)wid * 1024u;
    const int aoff = lds_byte(wr * 64 + fr, fq * 8), boff = lds_byte(wc * 32 + fr, fq * 8);
#define PG8_SA(b, h) (((b) * 2 + (h)) * HTB)
#define PG8_SB(b, h) ((4 + (b) * 2 + (h)) * HTB)
#define PG8_STAGE(bufoff, gbase, voff) do { _Pragma("unroll") for (int _i = 0; _i < 2; ++_i) \
        __builtin_amdgcn_global_load_lds((const unsigned*)((const char*)(gbase) + (voff)[_i]), (LAS unsigned*)(lds + (bufoff) + ldsw + _i * 8192), 16, 0, 0); } while (0)
#define PG8_LDA(dst, b, h) do { _Pragma("unroll") for (int m = 0; m < 4; ++m) _Pragma("unroll") for (int k = 0; k < 2; ++k) dst[m][k] = *(const LAS bf16x8*)(lds + PG8_SA(b, h) + aoff + m * 2048 + k * 1024); } while (0)
#define PG8_LDB(dst, b, h) do { _Pragma("unroll") for (int n = 0; n < 2; ++n) _Pragma("unroll") for (int k = 0; k < 2; ++k) dst[n][k] = *(const LAS bf16x8*)(lds + PG8_SB(b, h) + boff + n * 2048 + k * 1024); } while (0)
#define PG8_MMA(ai, bj, At, Bt) do { __builtin_amdgcn_s_setprio(1); _Pragma("unroll") for (int m = 0; m < 4; ++m) _Pragma("unroll") for (int n = 0; n < 2; ++n) _Pragma("unroll") for (int k = 0; k < 2; ++k) \
        acc[ai][bj][m][n] = __builtin_amdgcn_mfma_f32_16x16x32_bf16(Bt[n][k], At[m][k], acc[ai][bj][m][n], 0, 0, 0); __builtin_amdgcn_s_setprio(0); } while (0)
#define PG8_WAIT_V(n) asm volatile("s_waitcnt vmcnt(" #n ")" ::: "memory")
#define PG8_WAIT_L(n) asm volatile("s_waitcnt lgkmcnt(" #n ")" ::: "memory")
#define PG8_BAR __builtin_amdgcn_s_barrier()
#define PG8_SCHED __builtin_amdgcn_sched_barrier(0)
    Unit cur, nxt; int ui = 0;
    if (!S.next(0, cur)) return;
    f32x4 acc[2][2][4][2];
#pragma unroll
    for (int a = 0; a < 2; ++a)
#pragma unroll
        for (int b = 0; b < 2; ++b)
#pragma unroll
            for (int m = 0; m < 4; ++m)
#pragma unroll
                for (int n = 0; n < 2; ++n) acc[a][b][m][n] = (f32x4){0.f, 0.f, 0.f, 0.f};
    bf16x8 At[4][2], B0[2][2], B1[2][2];
    const char* cA = (const char*)g.A + (size_t)cur.pm * tstep + (size_t)cur.ks * ksb; const char* cB = (const char*)g.Bt + (size_t)cur.pn * tstep + (size_t)cur.ks * ksb;
    PG8_STAGE(PG8_SB(0, 0), cB, voffB); PG8_STAGE(PG8_SA(0, 0), cA, voffA); PG8_STAGE(PG8_SB(0, 1), cB + hstep, voffB); PG8_STAGE(PG8_SA(0, 1), cA + hstep, voffA);
    if (wr == 1) PG8_BAR;
    PG8_WAIT_V(4); PG8_BAR;
    PG8_STAGE(PG8_SB(1, 0), cB + kstep, voffB); PG8_STAGE(PG8_SA(1, 0), cA + kstep, voffA); PG8_STAGE(PG8_SB(1, 1), cB + hstep + kstep, voffB);
    PG8_WAIT_V(6); PG8_BAR;
    for (;;) {
        const bool has_next = S.next(ui + 1, nxt);
        const char* nA = has_next ? (const char*)g.A + (size_t)nxt.pm * tstep + (size_t)nxt.ks * ksb : cA; const char* nB = has_next ? (const char*)g.Bt + (size_t)nxt.pn * tstep + (size_t)nxt.ks * ksb : cB;
        for (int t = 0; t < nt; t += 2) {
            const bool last = (t == nt - 2);
            const char* a1 = cA + (size_t)(t + 1) * kstep;
            const char* a2 = last ? nA : cA + (size_t)(t + 2) * kstep; const char* b2 = last ? nB : cB + (size_t)(t + 2) * kstep;
            const char* a3 = a2 + kstep; const char* b3 = b2 + kstep;
            PG8_LDB(B0, 0, 0); PG8_SCHED; PG8_LDA(At, 0, 0); PG8_STAGE(PG8_SA(1, 1), a1 + hstep, voffA);
            PG8_WAIT_L(8); PG8_BAR; PG8_WAIT_L(0); PG8_MMA(0, 0, At, B0); PG8_BAR; PG8_SCHED;
            PG8_LDB(B1, 0, 1); PG8_STAGE(PG8_SB(0, 0), b2, voffB);
            PG8_BAR; PG8_WAIT_L(0); PG8_MMA(0, 1, At, B1); PG8_BAR;
            PG8_LDA(At, 0, 1); PG8_STAGE(PG8_SA(0, 0), a2, voffA);
            PG8_BAR; PG8_WAIT_L(0); PG8_MMA(1, 0, At, B0); PG8_BAR; PG8_SCHED;
            PG8_STAGE(PG8_SB(0, 1), b2 + hstep, voffB);
            PG8_WAIT_V(6); PG8_BAR; PG8_MMA(1, 1, At, B1); PG8_BAR;
            PG8_LDB(B0, 1, 0); PG8_SCHED; PG8_LDA(At, 1, 0); PG8_STAGE(PG8_SA(0, 1), a2 + hstep, voffA);
            PG8_WAIT_L(8); PG8_BAR; PG8_WAIT_L(0); PG8_MMA(0, 0, At, B0); PG8_BAR; PG8_SCHED;
            PG8_LDB(B1, 1, 1); PG8_STAGE(PG8_SB(1, 0), b3, voffB);
            PG8_BAR; PG8_WAIT_L(0); PG8_MMA(0, 1, At, B1); PG8_BAR;
            PG8_LDA(At, 1, 1); PG8_STAGE(PG8_SA(1, 0), a3, voffA);
            PG8_BAR; PG8_WAIT_L(0); PG8_MMA(1, 0, At, B0); PG8_BAR; PG8_SCHED;
            PG8_STAGE(PG8_SB(1, 1), b3 + hstep, voffB);
            PG8_WAIT_V(6); PG8_BAR; PG8_MMA(1, 1, At, B1); PG8_BAR;
        }
        E(acc, cur, wr, wc, fr, fq);
        if (!has_next) break;
#pragma unroll
        for (int a = 0; a < 2; ++a)
#pragma unroll
            for (int b = 0; b < 2; ++b)
#pragma unroll
                for (int m = 0; m < 4; ++m)
#pragma unroll
                    for (int n = 0; n < 2; ++n) acc[a][b][m][n] = (f32x4){0.f, 0.f, 0.f, 0.f};
        cur = nxt; cA = nA; cB = nB; ++ui;
    }
    PG8_WAIT_V(0);
    if (wr == 0) PG8_BAR;
    PG8_BAR;
#undef PG8_SA
#undef PG8_SB
#undef PG8_STAGE
#undef PG8_LDA
#undef PG8_LDB
#undef PG8_MMA
#undef PG8_WAIT_V
#undef PG8_WAIT_L
#undef PG8_BAR
#undef PG8_SCHED
}
}

__device__ void transpose_tile(const float* __restrict__ src, int ldsrc, int N, int k0, int n0, bf16_t* __restrict__ dst, int lddst, int dstrow0, float* tile) {
    const int tid = threadIdx.x;
    for (int i = tid; i < 4096; i += NTHR) { const int kk = i >> 6, nn = i & 63; float v = 0.f; if (n0 + nn < N) v = src[(size_t)(k0 + kk) * ldsrc + n0 + nn]; tile[kk * 65 + nn] = v; }
    __syncthreads();
    for (int i = tid; i < 2048; i += NTHR) { const int nn = i >> 5, kp = (i & 31) * 2;
        if (n0 + nn < N) *(unsigned*)(dst + (size_t)(dstrow0 + n0 + nn) * lddst + k0 + kp) = pack2(tile[kp * 65 + nn], tile[(kp + 1) * 65 + nn]); }
    __syncthreads();
}

__device__ void phase_prologue(const Params& p, float* lds) {
    const int tid = threadIdx.x;
    unsigned char* ws = p.ws;
    bf16_t* BT0 = (bf16_t*)(ws + WS_BT0); bf16_t* WT0O = (bf16_t*)(ws + WS_WT0O); bf16_t* BT1 = (bf16_t*)(ws + WS_BT1); bf16_t* WT1O = (bf16_t*)(ws + WS_WT1O);
    float* MOD = (float*)(ws + WS_MOD);
    constexpr int NGEMV = 192, NT = 3680;
    for (int it = blockIdx.x; it < NGEMV + NT; it += gridDim.x) {
        if (it < NGEMV) {
            const int l = it / 96, j0 = (it % 96) * 32;
            float* sc = lds;
            float* red = lds + 3072;
            for (int i = tid; i < 3072; i += NTHR) { const int cnd = i >> 10, k = i & 1023; const float v = cnd == 0 ? p.in[5][k] : p.in[4][(cnd - 1) * 1024 + k]; sc[i] = silu(v); }
            __syncthreads();
            const int col = tid & 31, ksp = tid >> 5;
            float a0 = 0.f, a1 = 0.f, a2 = 0.f;
            const float* w = p.in[7] + (size_t)l * 1024 * 3072 + j0 + col;
            for (int k = ksp * 64; k < ksp * 64 + 64; ++k) { const float wv = w[(size_t)k * 3072]; a0 += sc[k] * wv; a1 += sc[1024 + k] * wv; a2 += sc[2048 + k] * wv; }
            red[(ksp * 3 + 0) * 32 + col] = a0; red[(ksp * 3 + 1) * 32 + col] = a1; red[(ksp * 3 + 2) * 32 + col] = a2;
            __syncthreads();
            if (tid < 96) { const int cnd = tid >> 5, cc = tid & 31; float s = 0.f; for (int q = 0; q < 16; ++q) s += red[(q * 3 + cnd) * 32 + cc];
                MOD[(l * 3 + cnd) * 3072 + j0 + cc] = s + p.in[8][l * 3072 + j0 + cc]; }
            __syncthreads();
        } else {
            int t = it - NGEMV;
            const float* src; int ldsrc, N; bf16_t* dst; int lddst, drow0, nnt;
            if (t < 2048) { src = p.in[10]; ldsrc = 8192; N = 8192; dst = BT0; lddst = 1024; drow0 = 0; nnt = 128; }
            else if (t < 2048 + 32) { t -= 2048; const int z = t >> 4; t &= 15; src = p.in[14] + (size_t)z * 1024 * 64; ldsrc = 64; N = 64; dst = BT0; lddst = 1024; drow0 = 8192 + z * 64; nnt = 1; }
            else if (t < 2048 + 64) { t -= 2048 + 32; const int z = t >> 4; t &= 15; src = p.in[17] + (size_t)z * 1024 * 64; ldsrc = 64; N = 64; dst = BT0; lddst = 1024; drow0 = 8320 + z * 64; nnt = 1; }
            else if (t < 2112 + 512) { t -= 2112; src = p.in[11]; ldsrc = 1024; N = 1024; dst = WT0O; lddst = 2048; drow0 = 0; nnt = 16; }
            else if (t < 2624 + 768) { t -= 2624; src = p.in[24]; ldsrc = 3072; N = 3072; dst = BT1; lddst = 1024; drow0 = 0; nnt = 48; }
            else if (t < 3392 + 32) { t -= 3392; const int z = t >> 4; t &= 15; src = p.in[26] + (size_t)z * 1024 * 16; ldsrc = 16; N = 16; dst = BT1; lddst = 1024; drow0 = 3072 + z * 16; nnt = 1; }
            else { t -= 3424; src = p.in[25]; ldsrc = 1024; N = 1024; dst = WT1O; lddst = 1024; drow0 = 0; nnt = 16; }
            const int kt = t / nnt, ntile = t % nnt;
            transpose_tile(src, ldsrc, N, kt * 64, ntile * 64, dst, lddst, drow0, lds);
        }
    }
    { u32x4* z = (u32x4*)(BT1 + (size_t)3104 * 1024); const int n = 224 * 1024 * 2 / 16;
      for (int i = blockIdx.x * NTHR + tid; i < n; i += gridDim.x * NTHR) z[i] = (u32x4){0u, 0u, 0u, 0u}; }
}

__device__ void phase_h(const Params& p, int layer) {
    const int tid = threadIdx.x, wave = tid >> 6, lane = tid & 63;
    unsigned char* ws = p.ws;
    const float* MOD = (const float*)(ws + WS_MOD);
    bf16_t* H = (bf16_t*)(ws + WS_H);
    float* X1 = (float*)(ws + WS_X1);
    const float* Y = (const float*)(ws + WS_P);
    for (int tok = blockIdx.x * 8 + wave; tok < NTOK; tok += gridDim.x * 8) {
        const float* xr = tok < NPTOK ? p.in[0] + (size_t)tok * D : p.in[1] + (size_t)(tok - NPTOK) * D;
        const int cond = tok < NPTOK ? 0 : 1 + ((tok - NPTOK) >> 11);
        f32x4 xv[4]; float ss = 0.f;
#pragma unroll
        for (int i = 0; i < 4; ++i) { const int idx = i * 256 + lane * 4; xv[i] = *(const f32x4*)(xr + idx);
            if (layer == 1) { const f32x4 ya = *(const f32x4*)(Y + (size_t)tok * D + idx), yb = *(const f32x4*)(Y + (size_t)NTOK * D + (size_t)tok * D + idx);
                const f32x4 gt = *(const f32x4*)(MOD + (0 * 3 + cond) * 3072 + 2048 + idx);
                xv[i] = xv[i] + gt * (ya + yb); *(f32x4*)(X1 + (size_t)tok * D + idx) = xv[i]; }
            ss += xv[i][0] * xv[i][0] + xv[i][1] * xv[i][1] + xv[i][2] * xv[i][2] + xv[i][3] * xv[i][3]; }
        ss = wave_sum(ss);
        const float rstd = rsqrtf(ss * (1.f / 1024.f) + 1e-6f);
#pragma unroll
        for (int i = 0; i < 4; ++i) { const int idx = i * 256 + lane * 4;
            const f32x4 g = *(const f32x4*)(p.in[6] + layer * D + idx);
            const f32x4 sh = *(const f32x4*)(MOD + (layer * 3 + cond) * 3072 + idx), sc = *(const f32x4*)(MOD + (layer * 3 + cond) * 3072 + 1024 + idx);
            f32x4 h;
#pragma unroll
            for (int j = 0; j < 4; ++j) h[j] = xv[i][j] * rstd * g[j] * (1.f + sc[j]) + sh[j];
            u32x2 w; w.x = pack2(h[0], h[1]); w.y = pack2(h[2], h[3]);
            *(u32x2*)(H + (size_t)tok * D + idx) = w; }
    }
}

__device__ void wkv_unit(const Params& p, int u, float* lds) {
    const int tid = threadIdx.x, lane = tid & 63, wave = tid >> 6;
    unsigned char* ws = p.ws;
    const bf16_t* P = (const bf16_t*)(ws + WS_P);
    bf16_t* OD = (bf16_t*)(ws + WS_X1);
    float* BON = (float*)(ws + WS_BON);
    int z, b, hd, T, tok0; bool sample;
    if (u < 64) { sample = true; z = u >> 5; b = (u >> 4) & 1; hd = u & 15; T = 2048; tok0 = NPTOK + b * 2048; }
    else { const int q = u - 64; sample = false; z = q >> 8; b = (q >> 4) & 15; hd = q & 15; T = 256; tok0 = b * 256; }
    float* w2h = lds; float* a2h = lds + 4096; float* tl = lds + 8192;
    float* opR = lds + 12288; float* opW = opR + 2048; float* opK = opW + 2048; float* opKK = opK + 2048; float* opB = opKK + 2048; float* opV = opB + 2048; float* obuf = opV + 2048;
    for (int i = tid; i < 4096; i += NTHR) { const int r = i >> 6, c = i & 63;
        w2h[i] = p.in[15][(size_t)(z * 64 + r) * 1024 + hd * 64 + c]; a2h[i] = p.in[18][(size_t)(z * 64 + r) * 1024 + hd * 64 + c]; }
    const int v = tid >> 3, kg = tid & 7;
    float S[8];
    if (sample) { const float* s0 = p.in[2] + ((size_t)((b * 2 + z) * 16 + hd)) * 4096 + v * 64 + kg * 8;
#pragma unroll
        for (int i = 0; i < 8; ++i) S[i] = s0[i]; }
    else {
#pragma unroll
        for (int i = 0; i < 8; ++i) S[i] = 0.f; }
    const int c = lane, ch = hd * 64 + c;
    const float w0c = p.in[13][z * 1024 + ch], a0c = p.in[16][z * 1024 + ch], kkc = p.in[19][ch], kac = p.in[20][ch], rkc = p.in[21][ch];
    __syncthreads();
    for (int tb = 0; tb < T; tb += 32) {
        for (int i = tid; i < 4096; i += NTHR) { const int tau = i >> 7, j = i & 127; const int t = z ? (T - 1 - (tb + tau)) : (tb + tau);
            const size_t row = (size_t)(tok0 + t) * N0;
            float val = bf2f(P[row + 8192 + (j < 64 ? z * 64 + j : 128 + z * 64 + (j - 64))]);
            if (j < 64) val = tanhf(val);
            tl[i] = val; }
        __syncthreads();
#pragma unroll 1
        for (int i = 0; i < 4; ++i) { const int tau = wave + 8 * i; const int t = z ? (T - 1 - (tb + tau)) : (tb + tau); const int tokg = tok0 + t;
            float wr_ = w0c, ap = a0c;
            const float* tlr = tl + tau * 128;
#pragma unroll 8
            for (int r = 0; r < 64; ++r) { wr_ += tlr[r] * w2h[r * 64 + c]; ap += tlr[64 + r] * a2h[r * 64 + c]; }
            const float nx = -wr_; const float sp = fmaxf(nx, 0.f) + log1pf(__expf(-fabsf(nx)));
            const float decay = __expf(-__expf(-sp - 0.5f));
            const float iclr = 1.f / (1.f + __expf(-ap));
            const size_t row = (size_t)tokg * N0;
            const float rr = bf2f(P[row + 4096 + ch]), kx = bf2f(P[row + 5120 + ch]), vv = bf2f(P[row + 6144 + ch]);
            const float kkraw = kx * kkc;
            const float ssq = wave_sum(kkraw * kkraw);
            const float kk = kkraw / fmaxf(sqrtf(ssq), 1e-12f);
            const float kmod = kx * (1.f + (iclr - 1.f) * kac);
            const float bon = wave_sum(rr * kmod * rkc);
            if (lane == 0) BON[((size_t)z * NTOK + tokg) * 16 + hd] = bon;
            opR[tau * 64 + c] = rr; opW[tau * 64 + c] = decay; opK[tau * 64 + c] = kmod; opKK[tau * 64 + c] = kk; opB[tau * 64 + c] = kk * iclr; opV[tau * 64 + c] = vv; }
        __syncthreads();
#pragma unroll 1
        for (int tau = 0; tau < 32; ++tau) {
            const f32x4* rp = (const f32x4*)(opR + tau * 64 + kg * 8); const f32x4* wp = (const f32x4*)(opW + tau * 64 + kg * 8); const f32x4* kp = (const f32x4*)(opK + tau * 64 + kg * 8);
            const f32x4* kkp = (const f32x4*)(opKK + tau * 64 + kg * 8); const f32x4* bp = (const f32x4*)(opB + tau * 64 + kg * 8);
            const float vv = opV[tau * 64 + v];
            float kkv[8], wv[8], kv[8], bv[8], rv[8];
#pragma unroll
            for (int h2 = 0; h2 < 2; ++h2) { const f32x4 a = kkp[h2], bq = wp[h2], cq = kp[h2], dq = bp[h2], eq = rp[h2];
#pragma unroll
                for (int j = 0; j < 4; ++j) { kkv[h2 * 4 + j] = a[j]; wv[h2 * 4 + j] = bq[j]; kv[h2 * 4 + j] = cq[j]; bv[h2 * 4 + j] = dq[j]; rv[h2 * 4 + j] = eq[j]; } }
            float pk = 0.f;
#pragma unroll
            for (int i = 0; i < 8; ++i) pk += S[i] * kkv[i];
            pk += __shfl_xor(pk, 1, 64); pk += __shfl_xor(pk, 2, 64); pk += __shfl_xor(pk, 4, 64);
            float q = 0.f;
#pragma unroll
            for (int i = 0; i < 8; ++i) { S[i] = S[i] * wv[i] - pk * bv[i] + vv * kv[i]; q += S[i] * rv[i]; }
            q += __shfl_xor(q, 1, 64); q += __shfl_xor(q, 2, 64); q += __shfl_xor(q, 4, 64);
            if (kg == 0) obuf[tau * 64 + v] = q;
        }
        __syncthreads();
        for (int i = tid; i < 2048; i += NTHR) { const int tau = i >> 6, cc = i & 63; const int t = z ? (T - 1 - (tb + tau)) : (tb + tau);
            OD[((size_t)z * NTOK + tok0 + t) * 1024 + hd * 64 + cc] = f2bf(obuf[i]); }
        __syncthreads();
    }
    if (!sample) { float* so = p.out + (size_t)2 * NPTOK * D + ((size_t)((b * 2 + z) * 16 + hd)) * 4096 + v * 64 + kg * 8;
#pragma unroll
        for (int i = 0; i < 8; ++i) so[i] = S[i]; }
    __syncthreads();
}

__device__ void conv_tile(const Params& p, int tile) {
    const int tid = threadIdx.x;
    unsigned char* ws = p.ws;
    const bf16_t* P = (const bf16_t*)(ws + WS_P);
    bf16_t* OC = (bf16_t*)(ws + WS_OC);
    const int cgp = tid & 127, c0 = cgp * 8, sub = tid >> 7;
    float cw0[8], cw1[8], cw2[8];
#pragma unroll
    for (int j = 0; j < 8; ++j) { cw0[j] = p.in[12][c0 + j]; cw1[j] = p.in[12][1024 + c0 + j]; cw2[j] = p.in[12][2048 + c0 + j]; }
    for (int jj = 0; jj < 4; ++jj) {
        const int t = tile * 16 + sub + 4 * jj;
        const int rl = t < NPTOK ? 256 : 64; const int pos = t & (rl - 1);
        const bf16_t* row = P + (size_t)t * N0;
        const u32x4 z4 = (u32x4){0u, 0u, 0u, 0u};
        const u32x4 u1 = *(const u32x4*)(row + c0), g1 = *(const u32x4*)(row + 2048 + c0);
        const u32x4 u0 = pos > 0 ? *(const u32x4*)(row - N0 + c0) : z4, g0 = pos > 0 ? *(const u32x4*)(row - N0 + 2048 + c0) : z4;
        const u32x4 u2 = pos < rl - 1 ? *(const u32x4*)(row + N0 + c0) : z4, g2 = pos < rl - 1 ? *(const u32x4*)(row + N0 + 2048 + c0) : z4;
        const u32x4 gb = *(const u32x4*)(row + 1024 + c0), zc = *(const u32x4*)(row + 3072 + c0);
        u32x4 o;
#pragma unroll
        for (int q = 0; q < 4; ++q) {
            const float y0 = cw0[2 * q] * (bflo(g0[q]) * bflo(u0[q])) + cw1[2 * q] * (bflo(g1[q]) * bflo(u1[q])) + cw2[2 * q] * (bflo(g2[q]) * bflo(u2[q]));
            const float y1 = cw0[2 * q + 1] * (bfhi(g0[q]) * bfhi(u0[q])) + cw1[2 * q + 1] * (bfhi(g1[q]) * bfhi(u1[q])) + cw2[2 * q + 1] * (bfhi(g2[q]) * bfhi(u2[q]));
            o[q] = pack2(silu(bflo(zc[q])) * bflo(gb[q]) * y0, silu(bfhi(zc[q])) * bfhi(gb[q]) * y1);
        }
        *(u32x4*)(OC + (size_t)t * 2048 + c0) = o;
    }
}

__device__ void phase_mix0(const Params& p, float* lds) {
    unsigned* ctr = (unsigned*)(p.ws + WS_CTL);
    int* slot = (int*)(lds + 32768);
    constexpr int NSCAN = 576, NCONV = 512;
    for (;;) {
        if (threadIdx.x == 0) *slot = (int)atomicAdd(ctr, 1u);
        __syncthreads();
        const int it = *slot;
        __syncthreads();
        if (it >= NSCAN + NCONV) break;
        if (it < NSCAN) wkv_unit(p, it, lds); else conv_tile(p, it - NSCAN);
    }
}

__device__ void phase_wkv_post(const Params& p) {
    const int tid = threadIdx.x, wave = tid >> 6, lane = tid & 63;
    unsigned char* ws = p.ws;
    const bf16_t* P = (const bf16_t*)(ws + WS_P);
    const bf16_t* OD = (const bf16_t*)(ws + WS_X1);
    const float* BON = (const float*)(ws + WS_BON);
    bf16_t* OC = (bf16_t*)(ws + WS_OC);
    for (int tok = blockIdx.x * 8 + wave; tok < NTOK; tok += gridDim.x * 8) {
        const bf16_t* row = P + (size_t)tok * N0;
        for (int hd = 0; hd < 16; ++hd) { const int ch = hd * 64 + lane;
            const float o = bf2f(OD[(size_t)tok * 1024 + ch]) + bf2f(OD[((size_t)NTOK + tok) * 1024 + ch]);
            const float mu = wave_sum(o) * (1.f / 64.f);
            const float dv = o - mu;
            const float var = wave_sum(dv * dv) * (1.f / 64.f);
            const float gn = dv * rsqrtf(var + 64e-5f) * p.in[22][ch] + p.in[23][ch];
            const float bon = BON[(size_t)tok * 16 + hd] + BON[((size_t)NTOK + tok) * 16 + hd];
            const float vv = bf2f(row[6144 + ch]), zw = bf2f(row[7168 + ch]);
            OC[(size_t)tok * 2048 + 1024 + ch] = f2bf((gn + bon * vv) * silu(zw)); }
    }
}

__device__ void gla_unit(const Params& p, int u, float* lds) {
    const int tid = threadIdx.x;
    unsigned char* ws = p.ws;
    const bf16_t* P1 = (const bf16_t*)(ws + WS_P);
    float* OD = (float*)(ws + WS_P2);
    int z, b, hd, eh, T, tok0; bool sample;
    if (u < 32) { sample = true; z = u >> 4; b = (u >> 3) & 1; hd = (u >> 1) & 3; eh = u & 1; T = 2048; tok0 = NPTOK + b * 2048; }
    else { const int q = u - 32; sample = false; z = q >> 7; b = (q >> 3) & 15; hd = (q >> 1) & 3; eh = q & 1; T = 256; tok0 = b * 256; }
    float* opQ = lds; float* opK = lds + 2048; float* opE = lds + 4096; float* opV = lds + 6144; float* l1g = lds + 8192; float* gk2h = lds + 8448; float* red = lds + 10496;
    for (int i = tid; i < 2048; i += NTHR) { const int r = i >> 7, d = i & 127; gk2h[i] = p.in[27][(size_t)(z * 16 + r) * 512 + hd * 128 + d]; }
    const int e = tid & 127, dq = tid >> 7;
    float S[32];
    if (sample) { const float* s0 = p.in[3] + ((size_t)((b * 2 + z) * 4 + hd)) * 32768 + (size_t)(dq * 32) * 256 + eh * 128 + e;
#pragma unroll
        for (int i = 0; i < 32; ++i) S[i] = s0[(size_t)i * 256]; }
    else {
#pragma unroll
        for (int i = 0; i < 32; ++i) S[i] = 0.f; }
    const int d = tid & 127, tq = tid >> 7;
    const float gbias = p.in[28][z * 512 + hd * 128 + d];
    __syncthreads();
    for (int tb = 0; tb < T; tb += 16) {
        if (tid < 256) { const int tau = tid >> 4, r = tid & 15; const int t = z ? (T - 1 - (tb + tau)) : (tb + tau);
            l1g[tid] = bf2f(P1[(size_t)(tok0 + t) * N1 + 3072 + z * 16 + r]); }
        __syncthreads();
#pragma unroll
        for (int i = 0; i < 4; ++i) { const int tau = tq + 4 * i; const int t = z ? (T - 1 - (tb + tau)) : (tb + tau); const size_t row = (size_t)(tok0 + t) * N1;
            float x = gbias;
#pragma unroll
            for (int r = 0; r < 16; ++r) x += l1g[tau * 16 + r] * gk2h[r * 128 + d];
            const float ls = fminf(x, 0.f) - log1pf(__expf(-fabsf(x)));
            opE[tau * 128 + d] = __expf(ls * (1.f / 16.f));
            opQ[tau * 128 + d] = bf2f(P1[row + hd * 128 + d]) * 0.08838834764831845f;
            opK[tau * 128 + d] = bf2f(P1[row + 512 + hd * 128 + d]);
            opV[tau * 128 + d] = bf2f(P1[row + 1024 + hd * 256 + eh * 128 + d]); }
        __syncthreads();
#pragma unroll 1
        for (int tau = 0; tau < 16; ++tau) {
            const float vv = opV[tau * 128 + e];
            const f32x4* qp = (const f32x4*)(opQ + tau * 128 + dq * 32); const f32x4* kp = (const f32x4*)(opK + tau * 128 + dq * 32); const f32x4* ep = (const f32x4*)(opE + tau * 128 + dq * 32);
            float acc = 0.f;
#pragma unroll
            for (int i4 = 0; i4 < 8; ++i4) { const f32x4 q4 = qp[i4], k4 = kp[i4], e4 = ep[i4];
#pragma unroll
                for (int j = 0; j < 4; ++j) { S[i4 * 4 + j] = S[i4 * 4 + j] * e4[j] + k4[j] * vv; acc += q4[j] * S[i4 * 4 + j]; } }
            red[(dq * 16 + tau) * 128 + e] = acc;
        }
        __syncthreads();
        for (int i = tid; i < 2048; i += NTHR) { const int tau = i >> 7, ee = i & 127; const int t = z ? (T - 1 - (tb + tau)) : (tb + tau);
            OD[((size_t)z * NTOK + tok0 + t) * 1024 + hd * 256 + eh * 128 + ee] = red[i] + red[2048 + i] + red[4096 + i] + red[6144 + i]; }
        __syncthreads();
    }
    if (!sample) { float* so = p.out + (size_t)2 * NPTOK * D + 2097152 + ((size_t)((b * 2 + z) * 4 + hd)) * 32768 + (size_t)(dq * 32) * 256 + eh * 128 + e;
#pragma unroll
        for (int i = 0; i < 32; ++i) so[(size_t)i * 256] = S[i]; }
    __syncthreads();
}

__device__ void phase_gla(const Params& p, float* lds) {
    unsigned* ctr = (unsigned*)(p.ws + WS_CTL) + 16;
    int* slot = (int*)(lds + 32768);
    for (;;) {
        if (threadIdx.x == 0) *slot = (int)atomicAdd(ctr, 1u);
        __syncthreads();
        const int it = *slot;
        __syncthreads();
        if (it >= 288) break;
        gla_unit(p, it, lds);
    }
}

__device__ void phase_gla_post(const Params& p) {
    const int tid = threadIdx.x, wave = tid >> 6, lane = tid & 63;
    unsigned char* ws = p.ws;
    const bf16_t* P1 = (const bf16_t*)(ws + WS_P);
    const float* OD = (const float*)(ws + WS_P2);
    bf16_t* OG = (bf16_t*)(ws + WS_OC);
    for (int tok = blockIdx.x * 8 + wave; tok < NTOK; tok += gridDim.x * 8) {
        for (int hd = 0; hd < 4; ++hd) { const int idx = hd * 256 + lane * 4;
            const f32x4 a = *(const f32x4*)(OD + (size_t)tok * 1024 + idx), b2 = *(const f32x4*)(OD + ((size_t)NTOK + tok) * 1024 + idx);
            const f32x4 o = a + b2;
            const float ss = wave_sum(o[0] * o[0] + o[1] * o[1] + o[2] * o[2] + o[3] * o[3]);
            const float rs = rsqrtf(ss * (1.f / 256.f) + 1e-6f);
            const f32x4 gn = *(const f32x4*)(p.in[29] + lane * 4);
            const u32x2 zz = *(const u32x2*)(P1 + (size_t)tok * N1 + 2048 + idx);
            const float z0 = bflo(zz.x), z1 = bfhi(zz.x), z2 = bflo(zz.y), z3 = bfhi(zz.y);
            u32x2 w; w.x = pack2(o[0] * rs * gn[0] * silu(z0), o[1] * rs * gn[1] * silu(z1)); w.y = pack2(o[2] * rs * gn[2] * silu(z2), o[3] * rs * gn[3] * silu(z3));
            *(u32x2*)(OG + (size_t)tok * 1024 + idx) = w; }
    }
}

__device__ void phase_final(const Params& p) {
    const int tid = threadIdx.x, wave = tid >> 6, lane = tid & 63;
    unsigned char* ws = p.ws;
    const float* MOD = (const float*)(ws + WS_MOD);
    const float* X1 = (const float*)(ws + WS_X1);
    const float* Y = (const float*)(ws + WS_P2);
    for (int tok = blockIdx.x * 8 + wave; tok < NTOK; tok += gridDim.x * 8) {
        const int cond = tok < NPTOK ? 0 : 1 + ((tok - NPTOK) >> 11);
        f32x4 xv[4]; float ss = 0.f;
#pragma unroll
        for (int i = 0; i < 4; ++i) { const int idx = i * 256 + lane * 4;
            const f32x4 x1 = *(const f32x4*)(X1 + (size_t)tok * D + idx);
            const f32x4 ya = *(const f32x4*)(Y + (size_t)tok * D + idx), yb = *(const f32x4*)(Y + (size_t)NTOK * D + (size_t)tok * D + idx);
            const f32x4 gt = *(const f32x4*)(MOD + (1 * 3 + cond) * 3072 + 2048 + idx);
            xv[i] = x1 + gt * (ya + yb);
            ss += xv[i][0] * xv[i][0] + xv[i][1] * xv[i][1] + xv[i][2] * xv[i][2] + xv[i][3] * xv[i][3]; }
        ss = wave_sum(ss);
        const float rstd = rsqrtf(ss * (1.f / 1024.f) + 1e-6f);
#pragma unroll
        for (int i = 0; i < 4; ++i) { const int idx = i * 256 + lane * 4;
            const f32x4 g = *(const f32x4*)(p.in[9] + idx);
            f32x4 o;
#pragma unroll
            for (int j = 0; j < 4; ++j) o[j] = xv[i][j] * rstd * g[j];
            *(f32x4*)(p.out + (size_t)tok * D + idx) = o; }
    }
}

constexpr int NPHASE = 12;
__global__ void __launch_bounds__(NTHR, 2) fwd_megakernel(Params p) {
    extern __shared__ __attribute__((aligned(16))) unsigned char smem[];
    float* ldsf = (float*)smem;
    LAS unsigned char* ldsl = (LAS unsigned char*)smem;
    unsigned char* ws = p.ws;
#define PHASE(n) if (p.ph_lo <= (n) && (n) < p.ph_hi && ((n) == p.ph_lo || (cg::this_grid().sync(), true)))
    PHASE(0) phase_prologue(p, ldsf);
    PHASE(1) phase_h(p, 0);
    PHASE(2) { pg8::Gemm g{(const bf16_t*)(ws + WS_H), (const bf16_t*)(ws + WS_BT0), NTOK, N0, 1024, 1024, 1}; pg8::Order S; S.init(NTOK, N0, 1, gridDim.x, blockIdx.x);
               pg8::EpiBf16 E{(bf16_t*)(ws + WS_P), N0}; pg8::gemm_phase(ldsl, g, S, E); }
    PHASE(3) phase_mix0(p, ldsf);
    PHASE(4) phase_wkv_post(p);
    PHASE(5) { pg8::Gemm g{(const bf16_t*)(ws + WS_OC), (const bf16_t*)(ws + WS_WT0O), NTOK, 1024, 1024, 2048, 2}; pg8::Order S; S.init(NTOK, 1024, 2, gridDim.x, blockIdx.x);
               pg8::EpiF32 E{(float*)(ws + WS_P), 1024, (size_t)NTOK * 1024}; pg8::gemm_phase(ldsl, g, S, E); }
    PHASE(6) phase_h(p, 1);
    PHASE(7) { pg8::Gemm g{(const bf16_t*)(ws + WS_H), (const bf16_t*)(ws + WS_BT1), NTOK, N1, 1024, 1024, 1}; pg8::Order S; S.init(NTOK, N1, 1, gridDim.x, blockIdx.x);
               pg8::EpiBf16 E{(bf16_t*)(ws + WS_P), N1}; pg8::gemm_phase(ldsl, g, S, E); }
    PHASE(8) phase_gla(p, ldsf);
    PHASE(9) phase_gla_post(p);
    PHASE(10) { pg8::Gemm g{(const bf16_t*)(ws + WS_OC), (const bf16_t*)(ws + WS_WT1O), NTOK, 1024, 512, 1024, 2}; pg8::Order S; S.init(NTOK, 1024, 2, gridDim.x, blockIdx.x);
                pg8::EpiF32 E{(float*)(ws + WS_P2), 1024, (size_t)NTOK * 1024}; pg8::gemm_phase(ldsl, g, S, E); }
    PHASE(11) phase_final(p);
}

extern "C" void kernel_launch(void* const* d_in, const int* in_sizes, int n_in, void* d_out, int out_size, void* d_ws, size_t ws_size, hipStream_t stream) {
    static int grid = 0;
    if (grid == 0) {
        if (n_in != 30 || ws_size < WS_END) { fprintf(stderr, "kernel_launch: unexpected n_in %d / ws_size %zu (need %zu)\n", n_in, ws_size, (size_t)WS_END); grid = -1; return; }
        int dev = 0, cus = 0, per_cu = 0;
        hipGetDevice(&dev);
        hipDeviceGetAttribute(&cus, hipDeviceAttributeMultiprocessorCount, dev);
        hipFuncSetAttribute((const void*)fwd_megakernel, hipFuncAttributeMaxDynamicSharedMemorySize, LDS_BYTES);
        hipOccupancyMaxActiveBlocksPerMultiprocessor(&per_cu, (const void*)fwd_megakernel, NTHR, LDS_BYTES);
        if (per_cu < 1) { fprintf(stderr, "kernel_launch: occupancy query returned %d\n", per_cu); per_cu = 1; }
        grid = cus * per_cu;
        (void)hipGetLastError();
    }
    if (grid < 0) return;
    hipMemsetAsync((char*)d_ws + WS_CTL, 0, 256, stream);
    Params p{};
    for (int i = 0; i < 30; ++i) p.in[i] = (const float*)d_in[i];
    p.out = (float*)d_out; p.ws = (unsigned char*)d_ws;
#if MULTI_LAUNCH
    for (int ph = 0; ph < NPHASE; ++ph) { p.ph_lo = ph; p.ph_hi = ph + 1; hipLaunchKernelGGL(fwd_megakernel, dim3(grid), dim3(NTHR), LDS_BYTES, stream, p); }
#else
    p.ph_lo = 0; p.ph_hi = NPHASE;
    void* args[] = {&p};
    hipError_t e = hipLaunchCooperativeKernel((const void*)fwd_megakernel, dim3(grid), dim3(NTHR), args, LDS_BYTES, stream);
    if (e != hipSuccess) fprintf(stderr, "cooperative launch failed: %s (grid %d)\n", hipGetErrorString(e), grid);
#endif
}
```

```cpp
#include <hip/hip_runtime.h>
#include <hip/hip_cooperative_groups.h>
#include <cstdio>
namespace cg = cooperative_groups;

#define LAS __attribute__((address_space(3)))
typedef unsigned short bf16_t;
typedef short bf16x8 __attribute__((ext_vector_type(8)));
typedef float f32x4 __attribute__((ext_vector_type(4)));
typedef unsigned u32x4 __attribute__((ext_vector_type(4)));
typedef unsigned u32x2 __attribute__((ext_vector_type(2)));

#ifndef MULTI_LAUNCH
#define MULTI_LAUNCH 0
#endif

constexpr int D = 1024, NTOK = 8192, NPTOK = 4096;
constexpr int N0 = 8448;
constexpr int N1 = 3328;
constexpr int NTHR = 512;
constexpr int LDS_BYTES = 131072 + 256;

constexpr size_t MB = 1024 * 1024;
constexpr size_t WS_CTL = 0;
constexpr size_t WS_MOD = 4096;
constexpr size_t WS_BON = WS_MOD + 2 * 3 * 3072 * 4;
constexpr size_t WS_BT0 = 2 * MB;
constexpr size_t WS_WT0O = WS_BT0 + (size_t)N0 * 1024 * 2;
constexpr size_t WS_BT1 = WS_WT0O + (size_t)1024 * 2048 * 2;
constexpr size_t WS_WT1O = WS_BT1 + (size_t)N1 * 1024 * 2;
constexpr size_t WS_H = WS_WT1O + (size_t)1024 * 1024 * 2;
constexpr size_t WS_OC = WS_H + (size_t)NTOK * 1024 * 2;
constexpr size_t WS_X1 = WS_OC + (size_t)NTOK * 2048 * 2;
constexpr size_t WS_P = WS_X1 + (size_t)NTOK * 1024 * 4;
constexpr size_t WS_P2 = WS_P + 64 * MB;
constexpr size_t WS_END = WS_P + (size_t)NTOK * N0 * 2;

struct Params {
    const float* in[30];
    float* out;
    unsigned char* ws;
    int ph_lo, ph_hi;
};

__device__ __forceinline__ float bf2f(bf16_t h) { return __uint_as_float(((unsigned)h) << 16); }
__device__ __forceinline__ bf16_t f2bf(float f) { unsigned u = __float_as_uint(f); u += 0x7FFFu + ((u >> 16) & 1u); return (bf16_t)(u >> 16); }
__device__ __forceinline__ unsigned pack2(float lo, float hi) { return (unsigned)f2bf(lo) | ((unsigned)f2bf(hi) << 16); }
__device__ __forceinline__ float bflo(unsigned w) { return __uint_as_float(w << 16); }
__device__ __forceinline__ float bfhi(unsigned w) { return __uint_as_float(w & 0xFFFF0000u); }
__device__ __forceinline__ float silu(float x) { return x / (1.f + __expf(-x)); }
__device__ __forceinline__ float wave_sum(float v) {
#pragma unroll
    for (int m = 32; m >= 1; m >>= 1) v += __shfl_xor(v, m, 64);
    return v;
}

namespace pg8 {
constexpr int BM = 256, BK = 64, HALF = 128, HTB = HALF * BK * 2, NXCD = 8, WGM = 8;
__device__ __forceinline__ int lds_byte(int r, int c) { const int st = (r >> 4) * 2 + (c >> 5), rr = r & 15, cc = c & 31, ob = rr * 64 + cc * 2; return st * 1024 + (ob ^ (((ob >> 9) & 1) << 5)); }
__device__ __forceinline__ void stage_rc(int b, int& R, int& C) { const int st = b / 1024, sb = b % 1024, swz = sb ^ (((sb >> 9) & 1) << 5); R = (st >> 1) * 16 + swz / 64; C = (st & 1) * 32 + (swz % 64) / 2; }
__device__ __forceinline__ int perm32(int rho) { const int n = rho >> 4, i = rho & 15; return 8 * (i >> 2) + 4 * n + (i & 3); }

struct Unit { int pm, pn, ks; };
struct Gemm { const bf16_t* A; const bf16_t* Bt; int M, N, K, ld, KS; };

struct Order {
    int nM, nN, nNr, nwg, G, c;
    __device__ void init(int M, int N, int KS, int G_, int c_) { nM = M / BM; nNr = N / BM; nN = nNr * KS; nwg = nM * nN; G = G_; c = c_; }
    __device__ bool next(int i, Unit& u) const {
        const long L = (long)i * G + c; if (L >= nwg) return false;
        int wgid = (int)L; { const int q = nwg / NXCD, r = nwg % NXCD, xcd = wgid % NXCD, off = wgid / NXCD; wgid = (xcd < r ? xcd * (q + 1) : r * (q + 1) + (xcd - r) * q) + off; }
        const int nig = WGM * nN, gid = wgid / nig, fm = gid * WGM, gsz = (nM - fm) < WGM ? (nM - fm) : WGM;
        u.pm = fm + ((wgid % nig) % gsz); const int pn = (wgid % nig) / gsz; u.pn = pn % nNr; u.ks = pn / nNr; return true;
    }
};

__device__ __forceinline__ unsigned cvt_pk_bf16(float lo, float hi) { unsigned r; asm volatile("v_cvt_pk_bf16_f32 %0, %1, %2" : "=v"(r) : "v"(lo), "v"(hi)); return r; }

struct EpiF32 {
    static constexpr bool PERM = false;
    float* C; int ldc; size_t ks_stride;
    __device__ __forceinline__ void operator()(const f32x4 (&acc)[2][2][4][2], const Unit& u, int wr, int wc, int fr, int fq) const {
        const int row0 = u.pm * BM + wr * 64 + fr, col0 = u.pn * BM + wc * 32 + 4 * fq;
        float* Cb = C + (size_t)u.ks * ks_stride;
#pragma unroll
        for (int ai = 0; ai < 2; ++ai)
#pragma unroll
            for (int m = 0; m < 4; ++m) { float* rowp = Cb + (size_t)(row0 + ai * HALF + m * 16) * ldc + col0;
#pragma unroll
                for (int bj = 0; bj < 2; ++bj)
#pragma unroll
                    for (int n = 0; n < 2; ++n) *(f32x4*)(rowp + bj * HALF + n * 16) = acc[ai][bj][m][n]; }
    }
};
struct EpiBf16 {
    static constexpr bool PERM = true;
    bf16_t* O; int ldc;
    __device__ __forceinline__ void operator()(const f32x4 (&acc)[2][2][4][2], const Unit& u, int wr, int wc, int fr, int fq) const {
        const int row0 = u.pm * BM + wr * 64 + fr; const int col0 = u.pn * BM + wc * 32 + 8 * fq;
#pragma unroll
        for (int ai = 0; ai < 2; ++ai)
#pragma unroll
            for (int m = 0; m < 4; ++m) { bf16_t* rowp = O + (size_t)(row0 + ai * HALF + m * 16) * ldc + col0;
#pragma unroll
                for (int bj = 0; bj < 2; ++bj) { const f32x4 v0 = acc[ai][bj][m][0], v1 = acc[ai][bj][m][1];
                    u32x4 w; w.x = cvt_pk_bf16(v0[0], v0[1]); w.y = cvt_pk_bf16(v0[2], v0[3]); w.z = cvt_pk_bf16(v1[0], v1[1]); w.w = cvt_pk_bf16(v1[2], v1[3]);
                    *(u32x4*)(rowp + bj * HALF) = w; } }
    }
};

template <class Epi>
__device__ __forceinline__ void gemm_phase(LAS unsigned char* lds, const Gemm g, const Order& S, const Epi& E) {
    const int tid = threadIdx.x, wid = __builtin_amdgcn_readfirstlane(tid >> 6), lane = tid & 63, wr = wid >> 2, wc = wid & 3, fr = lane & 15, fq = lane >> 4;
    const int K = g.K, nt = K / BK, ld = g.ld;
    unsigned voffA[2], voffB[2];
#pragma unroll
    for (int i = 0; i < 2; ++i) { int R, C; stage_rc(tid * 16 + i * 8192, R, C); const int Rb = Epi::PERM ? ((R & ~31) + perm32(R & 31)) : R;
        voffA[i] = (unsigned)(R * ld + C) * 2u; voffB[i] = (unsigned)(Rb * ld + C) * 2u; }
    const size_t kstep = (size_t)(BK * 2);
    const size_t hstep = (size_t)HALF * ld * 2;
    const size_t tstep = 2 * hstep;
    const size_t ksb = (size_t)K * 2;
    const unsigned ldsw = (unsigned)wid * 1024u;
    const int aoff = lds_byte(wr * 64 + fr, fq * 8), boff = lds_byte(wc * 32 + fr, fq * 8);
#define PG8_SA(b, h) (((b) * 2 + (h)) * HTB)
#define PG8_SB(b, h) ((4 + (b) * 2 + (h)) * HTB)
#define PG8_STAGE(bufoff, gbase, voff) do { _Pragma("unroll") for (int _i = 0; _i < 2; ++_i) \
        __builtin_amdgcn_global_load_lds((const unsigned*)((const char*)(gbase) + (voff)[_i]), (LAS unsigned*)(lds + (bufoff) + ldsw + _i * 8192), 16, 0, 0); } while (0)
#define PG8_LDA(dst, b, h) do { _Pragma("unroll") for (int m = 0; m < 4; ++m) _Pragma("unroll") for (int k = 0; k < 2; ++k) dst[m][k] = *(const LAS bf16x8*)(lds + PG8_SA(b, h) + aoff + m * 2048 + k * 1024); } while (0)
#define PG8_LDB(dst, b, h) do { _Pragma("unroll") for (int n = 0; n < 2; ++n) _Pragma("unroll") for (int k = 0; k < 2; ++k) dst[n][k] = *(const LAS bf16x8*)(lds + PG8_SB(b, h) + boff + n * 2048 + k * 1024); } while (0)
#define PG8_MMA(ai, bj, At, Bt) do { __builtin_amdgcn_s_setprio(1); _Pragma("unroll") for (int m = 0; m < 4; ++m) _Pragma("unroll") for (int n = 0; n < 2; ++n) _Pragma("unroll") for (int k = 0; k < 2; ++k) \
        acc[ai][bj][m][n] = __builtin_amdgcn_mfma_f32_16x16x32_bf16(Bt[n][k], At[m][k], acc[ai][bj][m][n], 0, 0, 0); __builtin_amdgcn_s_setprio(0); } while (0)
#define PG8_WAIT_V(n) asm volatile("s_waitcnt vmcnt(" #n ")" ::: "memory")
#define PG8_WAIT_L(n) asm volatile("s_waitcnt lgkmcnt(" #n ")" ::: "memory")
#define PG8_BAR __builtin_amdgcn_s_barrier()
#define PG8_SCHED __builtin_amdgcn_sched_barrier(0)
    Unit cur, nxt; int ui = 0;
    if (!S.next(0, cur)) return;
    f32x4 acc[2][2][4][2];
#pragma unroll
    for (int a = 0; a < 2; ++a)
#pragma unroll
        for (int b = 0; b < 2; ++b)
#pragma unroll
            for (int m = 0; m < 4; ++m)
#pragma unroll
                for (int n = 0; n < 2; ++n) acc[a][b][m][n] = (f32x4){0.f, 0.f, 0.f, 0.f};
    bf16x8 At[4][2], B0[2][2], B1[2][2];
    const char* cA = (const char*)g.A + (size_t)cur.pm * tstep + (size_t)cur.ks * ksb; const char* cB = (const char*)g.Bt + (size_t)cur.pn * tstep + (size_t)cur.ks * ksb;
    PG8_STAGE(PG8_SB(0, 0), cB, voffB); PG8_STAGE(PG8_SA(0, 0), cA, voffA); PG8_STAGE(PG8_SB(0, 1), cB + hstep, voffB); PG8_STAGE(PG8_SA(0, 1), cA + hstep, voffA);
    if (wr == 1) PG8_BAR;
    PG8_WAIT_V(4); PG8_BAR;
    PG8_STAGE(PG8_SB(1, 0), cB + kstep, voffB); PG8_STAGE(PG8_SA(1, 0), cA + kstep, voffA); PG8_STAGE(PG8_SB(1, 1), cB + hstep + kstep, voffB);
    PG8_WAIT_V(6); PG8_BAR;
    for (;;) {
        const bool has_next = S.next(ui + 1, nxt);
        const char* nA = has_next ? (const char*)g.A + (size_t)nxt.pm * tstep + (size_t)nxt.ks * ksb : cA; const char* nB = has_next ? (const char*)g.Bt + (size_t)nxt.pn * tstep + (size_t)nxt.ks * ksb : cB;
        for (int t = 0; t < nt; t += 2) {
            const bool last = (t == nt - 2);
            const char* a1 = cA + (size_t)(t + 1) * kstep;
            const char* a2 = last ? nA : cA + (size_t)(t + 2) * kstep; const char* b2 = last ? nB : cB + (size_t)(t + 2) * kstep;
            const char* a3 = a2 + kstep; const char* b3 = b2 + kstep;
            PG8_LDB(B0, 0, 0); PG8_SCHED; PG8_LDA(At, 0, 0); PG8_STAGE(PG8_SA(1, 1), a1 + hstep, voffA);
            PG8_WAIT_L(8); PG8_BAR; PG8_WAIT_L(0); PG8_MMA(0, 0, At, B0); PG8_BAR; PG8_SCHED;
            PG8_LDB(B1, 0, 1); PG8_STAGE(PG8_SB(0, 0), b2, voffB);
            PG8_BAR; PG8_WAIT_L(0); PG8_MMA(0, 1, At, B1); PG8_BAR;
            PG8_LDA(At, 0, 1); PG8_STAGE(PG8_SA(0, 0), a2, voffA);
            PG8_BAR; PG8_WAIT_L(0); PG8_MMA(1, 0, At, B0); PG8_BAR; PG8_SCHED;
            PG8_STAGE(PG8_SB(0, 1), b2 + hstep, voffB);
            PG8_WAIT_V(6); PG8_BAR; PG8_MMA(1, 1, At, B1); PG8_BAR;
            PG8_LDB(B0, 1, 0); PG8_SCHED; PG8_LDA(At, 1, 0); PG8_STAGE(PG8_SA(0, 1), a2 + hstep, voffA);
            PG8_WAIT_L(8); PG8_BAR; PG8_WAIT_L(0); PG8_MMA(0, 0, At, B0); PG8_BAR; PG8_SCHED;
            PG8_LDB(B1, 1, 1); PG8_STAGE(PG8_SB(1, 0), b3, voffB);
            PG8_BAR; PG8_WAIT_L(0); PG8_MMA(0, 1, At, B1); PG8_BAR;
            PG8_LDA(At, 1, 1); PG8_STAGE(PG8_SA(1, 0), a3, voffA);
            PG8_BAR; PG8_WAIT_L(0); PG8_MMA(1, 0, At, B0); PG8_BAR; PG8_SCHED;
            PG8_STAGE(PG8_SB(1, 1), b3 + hstep, voffB);
            PG8_WAIT_V(6); PG8_BAR; PG8_MMA(1, 1, At, B1); PG8_BAR;
        }
        E(acc, cur, wr, wc, fr, fq);
        if (!has_next) break;
#pragma unroll
        for (int a = 0; a < 2; ++a)
#pragma unroll
            for (int b = 0; b < 2; ++b)
#pragma unroll
                for (int m = 0; m < 4; ++m)
#pragma unroll
                    for (int n = 0; n < 2; ++n) acc[a][b][m][n] = (f32x4){0.f, 0.f, 0.f, 0.f};
        cur = nxt; cA = nA; cB = nB; ++ui;
    }
    PG8_WAIT_V(0);
    if (wr == 0) PG8_BAR;
    PG8_BAR;
#undef PG8_SA
#undef PG8_SB
#undef PG8_STAGE
#undef PG8_LDA
#undef PG8_LDB
#undef PG8_MMA
#undef PG8_WAIT_V
#undef PG8_WAIT_L
#undef PG8_BAR
#undef PG8_SCHED
}
}

__device__ void transpose_tile(const float* __restrict__ src, int ldsrc, int N, int k0, int n0, bf16_t* __restrict__ dst, int lddst, int dstrow0, float* tile) {
    const int tid = threadIdx.x;
    for (int i = tid; i < 4096; i += NTHR) { const int kk = i >> 6, nn = i & 63; float v = 0.f; if (n0 + nn < N) v = src[(size_t)(k0 + kk) * ldsrc + n0 + nn]; tile[kk * 65 + nn] = v; }
    __syncthreads();
    for (int i = tid; i < 2048; i += NTHR) { const int nn = i >> 5, kp = (i & 31) * 2;
        if (n0 + nn < N) *(unsigned*)(dst + (size_t)(dstrow0 + n0 + nn) * lddst + k0 + kp) = pack2(tile[kp * 65 + nn], tile[(kp + 1) * 65 + nn]); }
    __syncthreads();
}

__device__ void phase_prologue(const Params& p, float* lds) {
    const int tid = threadIdx.x;
    unsigned char* ws = p.ws;
    bf16_t* BT0 = (bf16_t*)(ws + WS_BT0); bf16_t* WT0O = (bf16_t*)(ws + WS_WT0O); bf16_t* BT1 = (bf16_t*)(ws + WS_BT1); bf16_t* WT1O = (bf16_t*)(ws + WS_WT1O);
    float* MOD = (float*)(ws + WS_MOD);
    constexpr int NGEMV = 192, NT = 3680;
    for (int it = blockIdx.x; it < NGEMV + NT; it += gridDim.x) {
        if (it < NGEMV) {
            const int l = it / 96, j0 = (it % 96) * 32;
            float* sc = lds;
            float* red = lds + 3072;
            for (int i = tid; i < 3072; i += NTHR) { const int cnd = i >> 10, k = i & 1023; const float v = cnd == 0 ? p.in[5][k] : p.in[4][(cnd - 1) * 1024 + k]; sc[i] = silu(v); }
            __syncthreads();
            const int col = tid & 31, ksp = tid >> 5;
            float a0 = 0.f, a1 = 0.f, a2 = 0.f;
            const float* w = p.in[7] + (size_t)l * 1024 * 3072 + j0 + col;
            for (int k = ksp * 64; k < ksp * 64 + 64; ++k) { const float wv = w[(size_t)k * 3072]; a0 += sc[k] * wv; a1 += sc[1024 + k] * wv; a2 += sc[2048 + k] * wv; }
            red[(ksp * 3 + 0) * 32 + col] = a0; red[(ksp * 3 + 1) * 32 + col] = a1; red[(ksp * 3 + 2) * 32 + col] = a2;
            __syncthreads();
            if (tid < 96) { const int cnd = tid >> 5, cc = tid & 31; float s = 0.f; for (int q = 0; q < 16; ++q) s += red[(q * 3 + cnd) * 32 + cc];
                MOD[(l * 3 + cnd) * 3072 + j0 + cc] = s + p.in[8][l * 3072 + j0 + cc]; }
            __syncthreads();
        } else {
            int t = it - NGEMV;
            const float* src; int ldsrc, N; bf16_t* dst; int lddst, drow0, nnt;
            if (t < 2048) { src = p.in[10]; ldsrc = 8192; N = 8192; dst = BT0; lddst = 1024; drow0 = 0; nnt = 128; }
            else if (t < 2048 + 32) { t -= 2048; const int z = t >> 4; t &= 15; src = p.in[14] + (size_t)z * 1024 * 64; ldsrc = 64; N = 64; dst = BT0; lddst = 1024; drow0 = 8192 + z * 64; nnt = 1; }
            else if (t < 2048 + 64) { t -= 2048 + 32; const int z = t >> 4; t &= 15; src = p.in[17] + (size_t)z * 1024 * 64; ldsrc = 64; N = 64; dst = BT0; lddst = 1024; drow0 = 8320 + z * 64; nnt = 1; }
            else if (t < 2112 + 512) { t -= 2112; src = p.in[11]; ldsrc = 1024; N = 1024; dst = WT0O; lddst = 2048; drow0 = 0; nnt = 16; }
            else if (t < 2624 + 768) { t -= 2624; src = p.in[24]; ldsrc = 3072; N = 3072; dst = BT1; lddst = 1024; drow0 = 0; nnt = 48; }
            else if (t < 3392 + 32) { t -= 3392; const int z = t >> 4; t &= 15; src = p.in[26] + (size_t)z * 1024 * 16; ldsrc = 16; N = 16; dst = BT1; lddst = 1024; drow0 = 3072 + z * 16; nnt = 1; }
            else { t -= 3424; src = p.in[25]; ldsrc = 1024; N = 1024; dst = WT1O; lddst = 1024; drow0 = 0; nnt = 16; }
            const int kt = t / nnt, ntile = t % nnt;
            transpose_tile(src, ldsrc, N, kt * 64, ntile * 64, dst, lddst, drow0, lds);
        }
    }
    { u32x4* z = (u32x4*)(BT1 + (size_t)3104 * 1024); const int n = 224 * 1024 * 2 / 16;
      for (int i = blockIdx.x * NTHR + tid; i < n; i += gridDim.x * NTHR) z[i] = (u32x4){0u, 0u, 0u, 0u}; }
}

__device__ void phase_h(const Params& p, int layer) {
    const int tid = threadIdx.x, wave = tid >> 6, lane = tid & 63;
    unsigned char* ws = p.ws;
    const float* MOD = (const float*)(ws + WS_MOD);
    bf16_t* H = (bf16_t*)(ws + WS_H);
    float* X1 = (float*)(ws + WS_X1);
    const float* Y = (const float*)(ws + WS_P);
    for (int tok = blockIdx.x * 8 + wave; tok < NTOK; tok += gridDim.x * 8) {
        const float* xr = tok < NPTOK ? p.in[0] + (size_t)tok * D : p.in[1] + (size_t)(tok - NPTOK) * D;
        const int cond = tok < NPTOK ? 0 : 1 + ((tok - NPTOK) >> 11);
        f32x4 xv[4]; float ss = 0.f;
#pragma unroll
        for (int i = 0; i < 4; ++i) { const int idx = i * 256 + lane * 4; xv[i] = *(const f32x4*)(xr + idx);
            if (layer == 1) { const f32x4 ya = *(const f32x4*)(Y + (size_t)tok * D + idx), yb = *(const f32x4*)(Y + (size_t)NTOK * D + (size_t)tok * D + idx);
                const f32x4 gt = *(const f32x4*)(MOD + (0 * 3 + cond) * 3072 + 2048 + idx);
                xv[i] = xv[i] + gt * (ya + yb); *(f32x4*)(X1 + (size_t)tok * D + idx) = xv[i]; }
            ss += xv[i][0] * xv[i][0] + xv[i][1] * xv[i][1] + xv[i][2] * xv[i][2] + xv[i][3] * xv[i][3]; }
        ss = wave_sum(ss);
        const float rstd = rsqrtf(ss * (1.f / 1024.f) + 1e-6f);
#pragma unroll
        for (int i = 0; i < 4; ++i) { const int idx = i * 256 + lane * 4;
            const f32x4 g = *(const f32x4*)(p.in[6] + layer * D + idx);
            const f32x4 sh = *(const f32x4*)(MOD + (layer * 3 + cond) * 3072 + idx), sc = *(const f32x4*)(MOD + (layer * 3 + cond) * 3072 + 1024 + idx);
            f32x4 h;
#pragma unroll
            for (int j = 0; j < 4; ++j) h[j] = xv[i][j] * rstd * g[j] * (1.f + sc[j]) + sh[j];
            u32x2 w; w.x = pack2(h[0], h[1]); w.y = pack2(h[2], h[3]);
            *(u32x2*)(H + (size_t)tok * D + idx) = w; }
    }
}

__device__ void wkv_unit(const Params& p, int u, float* lds) {
    const int tid = threadIdx.x, lane = tid & 63, wave = tid >> 6;
    unsigned char* ws = p.ws;
    const bf16_t* P = (const bf16_t*)(ws + WS_P);
    bf16_t* OD = (bf16_t*)(ws + WS_X1);
    float* BON = (float*)(ws + WS_BON);
    int z, b, hd, T, tok0; bool sample;
    if (u < 64) { sample = true; z = u >> 5; b = (u >> 4) & 1; hd = u & 15; T = 2048; tok0 = NPTOK + b * 2048; }
    else { const int q = u - 64; sample = false; z = q >> 8; b = (q >> 4) & 15; hd = q & 15; T = 256; tok0 = b * 256; }
    float* w2h = lds; float* a2h = lds + 4096; float* tl = lds + 8192;
    float* opR = lds + 12288; float* opW = opR + 2048; float* opK = opW + 2048; float* opKK = opK + 2048; float* opB = opKK + 2048; float* opV = opB + 2048; float* obuf = opV + 2048;
    for (int i = tid; i < 4096; i += NTHR) { const int r = i >> 6, c = i & 63;
        w2h[i] = p.in[15][(size_t)(z * 64 + r) * 1024 + hd * 64 + c]; a2h[i] = p.in[18][(size_t)(z * 64 + r) * 1024 + hd * 64 + c]; }
    const int v = tid >> 3, kg = tid & 7;
    float S[8];
    if (sample) { const float* s0 = p.in[2] + ((size_t)((b * 2 + z) * 16 + hd)) * 4096 + v * 64 + kg * 8;
#pragma unroll
        for (int i = 0; i < 8; ++i) S[i] = s0[i]; }
    else {
#pragma unroll
        for (int i = 0; i < 8; ++i) S[i] = 0.f; }
    const int c = lane, ch = hd * 64 + c;
    const float w0c = p.in[13][z * 1024 + ch], a0c = p.in[16][z * 1024 + ch], kkc = p.in[19][ch], kac = p.in[20][ch], rkc = p.in[21][ch];
    __syncthreads();
    for (int tb = 0; tb < T; tb += 32) {
        for (int i = tid; i < 4096; i += NTHR) { const int tau = i >> 7, j = i & 127; const int t = z ? (T - 1 - (tb + tau)) : (tb + tau);
            const size_t row = (size_t)(tok0 + t) * N0;
            float val = bf2f(P[row + 8192 + (j < 64 ? z * 64 + j : 128 + z * 64 + (j - 64))]);
            if (j < 64) val = tanhf(val);
            tl[i] = val; }
        __syncthreads();
#pragma unroll 1
        for (int i = 0; i < 4; ++i) { const int tau = wave + 8 * i; const int t = z ? (T - 1 - (tb + tau)) : (tb + tau); const int tokg = tok0 + t;
            float wr_ = w0c, ap = a0c;
            const float* tlr = tl + tau * 128;
#pragma unroll 8
            for (int r = 0; r < 64; ++r) { wr_ += tlr[r] * w2h[r * 64 + c]; ap += tlr[64 + r] * a2h[r * 64 + c]; }
            const float nx = -wr_; const float sp = fmaxf(nx, 0.f) + log1pf(__expf(-fabsf(nx)));
            const float decay = __expf(-__expf(-sp - 0.5f));
            const float iclr = 1.f / (1.f + __expf(-ap));
            const size_t row = (size_t)tokg * N0;
            const float rr = bf2f(P[row + 4096 + ch]), kx = bf2f(P[row + 5120 + ch]), vv = bf2f(P[row + 6144 + ch]);
            const float kkraw = kx * kkc;
            const float ssq = wave_sum(kkraw * kkraw);
            const float kk = kkraw / fmaxf(sqrtf(ssq), 1e-12f);
            const float kmod = kx * (1.f + (iclr - 1.f) * kac);
            const float bon = wave_sum(rr * kmod * rkc);
            if (lane == 0) BON[((size_t)z * NTOK + tokg) * 16 + hd] = bon;
            opR[tau * 64 + c] = rr; opW[tau * 64 + c] = decay; opK[tau * 64 + c] = kmod; opKK[tau * 64 + c] = kk; opB[tau * 64 + c] = kk * iclr; opV[tau * 64 + c] = vv; }
        __syncthreads();
#pragma unroll 1
        for (int tau = 0; tau < 32; ++tau) {
            const f32x4* rp = (const f32x4*)(opR + tau * 64 + kg * 8); const f32x4* wp = (const f32x4*)(opW + tau * 64 + kg * 8); const f32x4* kp = (const f32x4*)(opK + tau * 64 + kg * 8);
            const f32x4* kkp = (const f32x4*)(opKK + tau * 64 + kg * 8); const f32x4* bp = (const f32x4*)(opB + tau * 64 + kg * 8);
            const float vv = opV[tau * 64 + v];
            float kkv[8], wv[8], kv[8], bv[8], rv[8];
#pragma unroll
            for (int h2 = 0; h2 < 2; ++h2) { const f32x4 a = kkp[h2], bq = wp[h2], cq = kp[h2], dq = bp[h2], eq = rp[h2];
#pragma unroll
                for (int j = 0; j < 4; ++j) { kkv[h2 * 4 + j] = a[j]; wv[h2 * 4 + j] = bq[j]; kv[h2 * 4 + j] = cq[j]; bv[h2 * 4 + j] = dq[j]; rv[h2 * 4 + j] = eq[j]; } }
            float pk = 0.f;
#pragma unroll
            for (int i = 0; i < 8; ++i) pk += S[i] * kkv[i];
            pk += __shfl_xor(pk, 1, 64); pk += __shfl_xor(pk, 2, 64); pk += __shfl_xor(pk, 4, 64);
            float q = 0.f;
#pragma unroll
            for (int i = 0; i < 8; ++i) { S[i] = S[i] * wv[i] - pk * bv[i] + vv * kv[i]; q += S[i] * rv[i]; }
            q += __shfl_xor(q, 1, 64); q += __shfl_xor(q, 2, 64); q += __shfl_xor(q, 4, 64);
            if (kg == 0) obuf[tau * 64 + v] = q;
        }
        __syncthreads();
        for (int i = tid; i < 2048; i += NTHR) { const int tau = i >> 6, cc = i & 63; const int t = z ? (T - 1 - (tb + tau)) : (tb + tau);
            OD[((size_t)z * NTOK + tok0 + t) * 1024 + hd * 64 + cc] = f2bf(obuf[i]); }
        __syncthreads();
    }
    if (!sample) { float* so = p.out + (size_t)2 * NPTOK * D + ((size_t)((b * 2 + z) * 16 + hd)) * 4096 + v * 64 + kg * 8;
#pragma unroll
        for (int i = 0; i < 8; ++i) so[i] = S[i]; }
    __syncthreads();
}

__device__ void conv_tile(const Params& p, int tile) {
    const int tid = threadIdx.x;
    unsigned char* ws = p.ws;
    const bf16_t* P = (const bf16_t*)(ws + WS_P);
    bf16_t* OC = (bf16_t*)(ws + WS_OC);
    const int cgp = tid & 127, c0 = cgp * 8, sub = tid >> 7;
    float cw0[8], cw1[8], cw2[8];
#pragma unroll
    for (int j = 0; j < 8; ++j) { cw0[j] = p.in[12][c0 + j]; cw1[j] = p.in[12][1024 + c0 + j]; cw2[j] = p.in[12][2048 + c0 + j]; }
    for (int jj = 0; jj < 4; ++jj) {
        const int t = tile * 16 + sub + 4 * jj;
        const int rl = t < NPTOK ? 256 : 64; const int pos = t & (rl - 1);
        const bf16_t* row = P + (size_t)t * N0;
        const u32x4 z4 = (u32x4){0u, 0u, 0u, 0u};
        const u32x4 u1 = *(const u32x4*)(row + c0), g1 = *(const u32x4*)(row + 2048 + c0);
        const u32x4 u0 = pos > 0 ? *(const u32x4*)(row - N0 + c0) : z4, g0 = pos > 0 ? *(const u32x4*)(row - N0 + 2048 + c0) : z4;
        const u32x4 u2 = pos < rl - 1 ? *(const u32x4*)(row + N0 + c0) : z4, g2 = pos < rl - 1 ? *(const u32x4*)(row + N0 + 2048 + c0) : z4;
        const u32x4 gb = *(const u32x4*)(row + 1024 + c0), zc = *(const u32x4*)(row + 3072 + c0);
        u32x4 o;
#pragma unroll
        for (int q = 0; q < 4; ++q) {
            const float y0 = cw0[2 * q] * (bflo(g0[q]) * bflo(u0[q])) + cw1[2 * q] * (bflo(g1[q]) * bflo(u1[q])) + cw2[2 * q] * (bflo(g2[q]) * bflo(u2[q]));
            const float y1 = cw0[2 * q + 1] * (bfhi(g0[q]) * bfhi(u0[q])) + cw1[2 * q + 1] * (bfhi(g1[q]) * bfhi(u1[q])) + cw2[2 * q + 1] * (bfhi(g2[q]) * bfhi(u2[q]));
            o[q] = pack2(silu(bflo(zc[q])) * bflo(gb[q]) * y0, silu(bfhi(zc[q])) * bfhi(gb[q]) * y1);
        }
        *(u32x4*)(OC + (size_t)t * 2048 + c0) = o;
    }
}

__device__ void phase_mix0(const Params& p, float* lds) {
    unsigned* ctr = (unsigned*)(p.ws + WS_CTL);
    int* slot = (int*)(lds + 32768);
    constexpr int NSCAN = 576, NCONV = 512;
    for (;;) {
        if (threadIdx.x == 0) *slot = (int)atomicAdd(ctr, 1u);
        __syncthreads();
        const int it = *slot;
        __syncthreads();
        if (it >= NSCAN + NCONV) break;
        if (it < NSCAN) wkv_unit(p, it, lds); else conv_tile(p, it - NSCAN);
    }
}

__device__ void phase_wkv_post(const Params& p) {
    const int tid = threadIdx.x, wave = tid >> 6, lane = tid & 63;
    unsigned char* ws = p.ws;
    const bf16_t* P = (const bf16_t*)(ws + WS_P);
    const bf16_t* OD = (const bf16_t*)(ws + WS_X1);
    const float* BON = (const float*)(ws + WS_BON);
    bf16_t* OC = (bf16_t*)(ws + WS_OC);
    for (int tok = blockIdx.x * 8 + wave; tok < NTOK; tok += gridDim.x * 8) {
        const bf16_t* row = P + (size_t)tok * N0;
        for (int hd = 0; hd < 16; ++hd) { const int ch = hd * 64 + lane;
            const float o = bf2f(OD[(size_t)tok * 1024 + ch]) + bf2f(OD[((size_t)NTOK + tok) * 1024 + ch]);
            const float mu = wave_sum(o) * (1.f / 64.f);
            const float dv = o - mu;
            const float var = wave_sum(dv * dv) * (1.f / 64.f);
            const float gn = dv * rsqrtf(var + 64e-5f) * p.in[22][ch] + p.in[23][ch];
            const float bon = BON[(size_t)tok * 16 + hd] + BON[((size_t)NTOK + tok) * 16 + hd];
            const float vv = bf2f(row[6144 + ch]), zw = bf2f(row[7168 + ch]);
            OC[(size_t)tok * 2048 + 1024 + ch] = f2bf((gn + bon * vv) * silu(zw)); }
    }
}

__device__ __forceinline__ f32x4 mma_nt(const bf16_t* A, int lda, const bf16_t* B, int ldb, int K, f32x4 acc, int fr, int fq) {
    for (int k0 = 0; k0 < K; k0 += 32) {
        const bf16x8 a = *(const bf16x8*)(A + fr * lda + k0 + fq * 8);
        const bf16x8 b = *(const bf16x8*)(B + fr * ldb + k0 + fq * 8);
        acc = __builtin_amdgcn_mfma_f32_16x16x32_bf16(a, b, acc, 0, 0, 0);
    }
    return acc;
}

__device__ void gla_unit(const Params& p, int u, float* ldsf) {
    const int tid = threadIdx.x, lane = tid & 63, w = __builtin_amdgcn_readfirstlane(tid >> 6), fr = lane & 15, fq = lane >> 4;
    unsigned char* ws = p.ws;
    const bf16_t* P1 = (const bf16_t*)(ws + WS_P);
    float* OD = (float*)(ws + WS_P2);
    int z, b, hd, eh, T, tok0; bool sample;
    if (u < 32) { sample = true; z = u >> 4; b = (u >> 3) & 1; hd = (u >> 1) & 3; eh = u & 1; T = 2048; tok0 = NPTOK + b * 2048; }
    else { const int q = u - 32; sample = false; z = q >> 7; b = (q >> 3) & 15; hd = (q >> 1) & 3; eh = q & 1; T = 256; tok0 = b * 256; }
    bf16_t* QE = (bf16_t*)ldsf;
    bf16_t* KE = QE + 64 * 136;
    bf16_t* KDT = KE + 64 * 136;
    bf16_t* VT = KDT + 128 * 72;
    bf16_t* ATT = VT + 128 * 72;
    bf16_t* ST = ATT + 64 * 72;
    float* G = (float*)ST;
    float* L1G = (float*)(ST + 128 * 136);
    float* GK2 = L1G + 1024;
    float* EBL = GK2 + 2048;
    for (int i = tid; i < 2048; i += NTHR) { const int r = i >> 7, d = i & 127; GK2[i] = p.in[27][(size_t)(z * 16 + r) * 512 + hd * 128 + d]; }
    f32x4 Sacc[8];
    if (sample) { const float* s0 = p.in[3] + ((size_t)((b * 2 + z) * 4 + hd)) * 32768 + eh * 128 + fr;
#pragma unroll
        for (int et = 0; et < 8; ++et)
#pragma unroll
            for (int jj = 0; jj < 4; ++jj) Sacc[et][jj] = s0[(size_t)(w * 16 + fq * 4 + jj) * 256 + et * 16]; }
    else {
#pragma unroll
        for (int et = 0; et < 8; ++et) Sacc[et] = (f32x4){0.f, 0.f, 0.f, 0.f}; }
    const int d = tid & 127, tq = tid >> 7;
    const float gbias = p.in[28][z * 512 + hd * 128 + d];
    const int it = w & 3, eg = w >> 2;
    __syncthreads();
#pragma unroll 1
    for (int cb = 0; cb < T; cb += 64) {
        for (int i = tid; i < 1024; i += NTHR) { const int tau = i >> 4, r = i & 15; const int t = z ? (T - 1 - (cb + tau)) : (cb + tau);
            L1G[i] = bf2f(P1[(size_t)(tok0 + t) * N1 + 3072 + z * 16 + r]); }
        __syncthreads();
        { float run = 0.f;
#pragma unroll 4
          for (int i = 0; i < 16; ++i) { const int tau = tq * 16 + i;
            float x = gbias;
#pragma unroll
            for (int r = 0; r < 16; ++r) x += L1G[tau * 16 + r] * GK2[r * 128 + d];
            const float ls = fminf(x, 0.f) - log1pf(__expf(-fabsf(x)));
            run += ls * (1.f / 16.f);
            G[tau * 132 + d] = run; } }
        __syncthreads();
        { const float t0 = G[15 * 132 + d], t1 = G[31 * 132 + d], t2 = G[47 * 132 + d], t3 = G[63 * 132 + d];
          const float blast = t0 + t1 + t2 + t3;
          const float off = tq == 0 ? 0.f : (tq == 1 ? t0 : (tq == 2 ? t0 + t1 : t0 + t1 + t2));
          if (tq == 0) EBL[d] = __expf(blast);
#pragma unroll 4
          for (int i = 0; i < 16; ++i) { const int tau = tq * 16 + i; const int t = z ? (T - 1 - (cb + tau)) : (cb + tau); const size_t row = (size_t)(tok0 + t) * N1;
            const float bc = G[tau * 132 + d] + off;
            const float q = bf2f(P1[row + hd * 128 + d]) * 0.08838834764831845f, k = bf2f(P1[row + 512 + hd * 128 + d]);
            QE[tau * 136 + d] = f2bf(q * __expf(bc)); KE[tau * 136 + d] = f2bf(k * __expf(-bc)); KDT[d * 72 + tau] = f2bf(k * __expf(blast - bc));
            VT[d * 72 + tau] = P1[row + 1024 + hd * 256 + eh * 128 + d]; } }
        __syncthreads();
#pragma unroll
        for (int et = 0; et < 8; ++et) { u32x2 v2; v2.x = pack2(Sacc[et][0], Sacc[et][1]); v2.y = pack2(Sacc[et][2], Sacc[et][3]);
            *(u32x2*)(ST + (et * 16 + fr) * 136 + w * 16 + fq * 4) = v2; }
        __syncthreads();
#pragma unroll
        for (int q2 = 0; q2 < 2; ++q2) { const int tA = 2 * w + q2, ia = tA >> 2, ja = tA & 3;
            f32x4 a4 = (f32x4){0.f, 0.f, 0.f, 0.f};
            if (ja <= ia) a4 = mma_nt(QE + ia * 16 * 136, 136, KE + ja * 16 * 136, 136, 128, a4, fr, fq);
#pragma unroll
            for (int jj = 0; jj < 4; ++jj) { const int i = ia * 16 + fq * 4 + jj, j = ja * 16 + fr; ATT[i * 72 + j] = f2bf(j <= i ? a4[jj] : 0.f); } }
        f32x4 oacc[4];
#pragma unroll
        for (int e4 = 0; e4 < 4; ++e4) oacc[e4] = mma_nt(QE + it * 16 * 136, 136, ST + (eg * 4 + e4) * 16 * 136, 136, 128, (f32x4){0.f, 0.f, 0.f, 0.f}, fr, fq);
        __syncthreads();
#pragma unroll
        for (int e4 = 0; e4 < 4; ++e4) { oacc[e4] = mma_nt(ATT + it * 16 * 72, 72, VT + (eg * 4 + e4) * 16 * 72, 72, 64, oacc[e4], fr, fq);
#pragma unroll
            for (int jj = 0; jj < 4; ++jj) { const int tau = it * 16 + fq * 4 + jj; const int t = z ? (T - 1 - (cb + tau)) : (cb + tau);
                OD[((size_t)z * NTOK + tok0 + t) * 1024 + hd * 256 + eh * 128 + (eg * 4 + e4) * 16 + fr] = oacc[e4][jj]; } }
        { float eb[4];
#pragma unroll
          for (int jj = 0; jj < 4; ++jj) eb[jj] = EBL[w * 16 + fq * 4 + jj];
#pragma unroll
          for (int et = 0; et < 8; ++et) {
#pragma unroll
            for (int jj = 0; jj < 4; ++jj) Sacc[et][jj] *= eb[jj];
            Sacc[et] = mma_nt(KDT + w * 16 * 72, 72, VT + et * 16 * 72, 72, 64, Sacc[et], fr, fq); } }
        __syncthreads();
    }
    if (!sample) { float* so = p.out + (size_t)2 * NPTOK * D + 2097152 + ((size_t)((b * 2 + z) * 4 + hd)) * 32768 + eh * 128 + fr;
#pragma unroll
        for (int et = 0; et < 8; ++et)
#pragma unroll
            for (int jj = 0; jj < 4; ++jj) so[(size_t)(w * 16 + fq * 4 + jj) * 256 + et * 16] = Sacc[et][jj]; }
    __syncthreads();
}

__device__ void phase_gla(const Params& p, float* lds) {
    unsigned* ctr = (unsigned*)(p.ws + WS_CTL) + 16;
    int* slot = (int*)(lds + 32768);
    for (;;) {
        if (threadIdx.x == 0) *slot = (int)atomicAdd(ctr, 1u);
        __syncthreads();
        const int it = *slot;
        __syncthreads();
        if (it >= 288) break;
        gla_unit(p, it, lds);
    }
}

__device__ void phase_gla_post(const Params& p) {
    const int tid = threadIdx.x, wave = tid >> 6, lane = tid & 63;
    unsigned char* ws = p.ws;
    const bf16_t* P1 = (const bf16_t*)(ws + WS_P);
    const float* OD = (const float*)(ws + WS_P2);
    bf16_t* OG = (bf16_t*)(ws + WS_OC);
    for (int tok = blockIdx.x * 8 + wave; tok < NTOK; tok += gridDim.x * 8) {
        for (int hd = 0; hd < 4; ++hd) { const int idx = hd * 256 + lane * 4;
            const f32x4 a = *(const f32x4*)(OD + (size_t)tok * 1024 + idx), b2 = *(const f32x4*)(OD + ((size_t)NTOK + tok) * 1024 + idx);
            const f32x4 o = a + b2;
            const float ss = wave_sum(o[0] * o[0] + o[1] * o[1] + o[2] * o[2] + o[3] * o[3]);
            const float rs = rsqrtf(ss * (1.f / 256.f) + 1e-6f);
            const f32x4 gn = *(const f32x4*)(p.in[29] + lane * 4);
            const u32x2 zz = *(const u32x2*)(P1 + (size_t)tok * N1 + 2048 + idx);
            const float z0 = bflo(zz.x), z1 = bfhi(zz.x), z2 = bflo(zz.y), z3 = bfhi(zz.y);
            u32x2 w; w.x = pack2(o[0] * rs * gn[0] * silu(z0), o[1] * rs * gn[1] * silu(z1)); w.y = pack2(o[2] * rs * gn[2] * silu(z2), o[3] * rs * gn[3] * silu(z3));
            *(u32x2*)(OG + (size_t)tok * 1024 + idx) = w; }
    }
}

__device__ void phase_final(const Params& p) {
    const int tid = threadIdx.x, wave = tid >> 6, lane = tid & 63;
    unsigned char* ws = p.ws;
    const float* MOD = (const float*)(ws + WS_MOD);
    const float* X1 = (const float*)(ws + WS_X1);
    const float* Y = (const float*)(ws + WS_P2);
    for (int tok = blockIdx.x * 8 + wave; tok < NTOK; tok += gridDim.x * 8) {
        const int cond = tok < NPTOK ? 0 : 1 + ((tok - NPTOK) >> 11);
        f32x4 xv[4]; float ss = 0.f;
#pragma unroll
        for (int i = 0; i < 4; ++i) { const int idx = i * 256 + lane * 4;
            const f32x4 x1 = *(const f32x4*)(X1 + (size_t)tok * D + idx);
            const f32x4 ya = *(const f32x4*)(Y + (size_t)tok * D + idx), yb = *(const f32x4*)(Y + (size_t)NTOK * D + (size_t)tok * D + idx);
            const f32x4 gt = *(const f32x4*)(MOD + (1 * 3 + cond) * 3072 + 2048 + idx);
            xv[i] = x1 + gt * (ya + yb);
            ss += xv[i][0] * xv[i][0] + xv[i][1] * xv[i][1] + xv[i][2] * xv[i][2] + xv[i][3] * xv[i][3]; }
        ss = wave_sum(ss);
        const float rstd = rsqrtf(ss * (1.f / 1024.f) + 1e-6f);
#pragma unroll
        for (int i = 0; i < 4; ++i) { const int idx = i * 256 + lane * 4;
            const f32x4 g = *(const f32x4*)(p.in[9] + idx);
            f32x4 o;
#pragma unroll
            for (int j = 0; j < 4; ++j) o[j] = xv[i][j] * rstd * g[j];
            *(f32x4*)(p.out + (size_t)tok * D + idx) = o; }
    }
}

constexpr int NPHASE = 12;
__global__ void __launch_bounds__(NTHR, 2) fwd_megakernel(Params p) {
    extern __shared__ __attribute__((aligned(16))) unsigned char smem[];
    float* ldsf = (float*)smem;
    LAS unsigned char* ldsl = (LAS unsigned char*)smem;
    unsigned char* ws = p.ws;
#define PHASE(n) if (p.ph_lo <= (n) && (n) < p.ph_hi && ((n) == p.ph_lo || (cg::this_grid().sync(), true)))
    PHASE(0) phase_prologue(p, ldsf);
    PHASE(1) phase_h(p, 0);
    PHASE(2) { pg8::Gemm g{(const bf16_t*)(ws + WS_H), (const bf16_t*)(ws + WS_BT0), NTOK, N0, 1024, 1024, 1}; pg8::Order S; S.init(NTOK, N0, 1, gridDim.x, blockIdx.x);
               pg8::EpiBf16 E{(bf16_t*)(ws + WS_P), N0}; pg8::gemm_phase(ldsl, g, S, E); }
    PHASE(3) phase_mix0(p, ldsf);
    PHASE(4) phase_wkv_post(p);
    PHASE(5) { pg8::Gemm g{(const bf16_t*)(ws + WS_OC), (const bf16_t*)(ws + WS_WT0O), NTOK, 1024, 1024, 2048, 2}; pg8::Order S; S.init(NTOK, 1024, 2, gridDim.x, blockIdx.x);
               pg8::EpiF32 E{(float*)(ws + WS_P), 1024, (size_t)NTOK * 1024}; pg8::gemm_phase(ldsl, g, S, E); }
    PHASE(6) phase_h(p, 1);
    PHASE(7) { pg8::Gemm g{(const bf16_t*)(ws + WS_H), (const bf16_t*)(ws + WS_BT1), NTOK, N1, 1024, 1024, 1}; pg8::Order S; S.init(NTOK, N1, 1, gridDim.x, blockIdx.x);
               pg8::EpiBf16 E{(bf16_t*)(ws + WS_P), N1}; pg8::gemm_phase(ldsl, g, S, E); }
    PHASE(8) phase_gla(p, ldsf);
    PHASE(9) phase_gla_post(p);
    PHASE(10) { pg8::Gemm g{(const bf16_t*)(ws + WS_OC), (const bf16_t*)(ws + WS_WT1O), NTOK, 1024, 512, 1024, 2}; pg8::Order S; S.init(NTOK, 1024, 2, gridDim.x, blockIdx.x);
                pg8::EpiF32 E{(float*)(ws + WS_P2), 1024, (size_t)NTOK * 1024}; pg8::gemm_phase(ldsl, g, S, E); }
    PHASE(11) phase_final(p);
}

extern "C" void kernel_launch(void* const* d_in, const int* in_sizes, int n_in, void* d_out, int out_size, void* d_ws, size_t ws_size, hipStream_t stream) {
    static int grid = 0;
    if (grid == 0) {
        if (n_in != 30 || ws_size < WS_END) { fprintf(stderr, "kernel_launch: unexpected n_in %d / ws_size %zu (need %zu)\n", n_in, ws_size, (size_t)WS_END); grid = -1; return; }
        int dev = 0, cus = 0, per_cu = 0;
        hipGetDevice(&dev);
        hipDeviceGetAttribute(&cus, hipDeviceAttributeMultiprocessorCount, dev);
        hipFuncSetAttribute((const void*)fwd_megakernel, hipFuncAttributeMaxDynamicSharedMemorySize, LDS_BYTES);
        hipOccupancyMaxActiveBlocksPerMultiprocessor(&per_cu, (const void*)fwd_megakernel, NTHR, LDS_BYTES);
        if (per_cu < 1) { fprintf(stderr, "kernel_launch: occupancy query returned %d\n", per_cu); per_cu = 1; }
        grid = cus * per_cu;
        (void)hipGetLastError();
    }
    if (grid < 0) return;
    hipMemsetAsync((char*)d_ws + WS_CTL, 0, 256, stream);
    Params p{};
    for (int i = 0; i < 30; ++i) p.in[i] = (const float*)d_in[i];
    p.out = (float*)d_out; p.ws = (unsigned char*)d_ws;
#if MULTI_LAUNCH
    for (int ph = 0; ph < NPHASE; ++ph) { p.ph_lo = ph; p.ph_hi = ph + 1; hipLaunchKernelGGL(fwd_megakernel, dim3(grid), dim3(NTHR), LDS_BYTES, stream, p); }
#else
    p.ph_lo = 0; p.ph_hi = NPHASE;
    void* args[] = {&p};
    hipError_t e = hipLaunchCooperativeKernel((const void*)fwd_megakernel, dim3(grid), dim3(NTHR), args, LDS_BYTES, stream);
    if (e != hipSuccess) fprintf(stderr, "cooperative launch failed: %s (grid %d)\n", hipGetErrorString(e), grid);
#endif
}
```

```cpp
#include <hip/hip_runtime.h>
#include <hip/hip_cooperative_groups.h>
#include <cstdio>
namespace cg = cooperative_groups;

#define LAS __attribute__((address_space(3)))
typedef unsigned short bf16_t;
typedef short bf16x8 __attribute__((ext_vector_type(8)));
typedef float f32x4 __attribute__((ext_vector_type(4)));
typedef unsigned u32x4 __attribute__((ext_vector_type(4)));
typedef unsigned u32x2 __attribute__((ext_vector_type(2)));

#ifndef MULTI_LAUNCH
#define MULTI_LAUNCH 0
#endif

constexpr int D = 1024, NTOK = 8192, NPTOK = 4096;
constexpr int N0 = 8448;
constexpr int N1 = 3328;
constexpr int NTHR = 512;
constexpr int LDS_BYTES = 131072 + 256;

constexpr size_t MB = 1024 * 1024;
constexpr size_t WS_CTL = 0;
constexpr size_t WS_MOD = 4096;
constexpr size_t WS_BON = WS_MOD + 2 * 3 * 3072 * 4;
constexpr size_t WS_BT0 = 2 * MB;
constexpr size_t WS_WT0O = WS_BT0 + (size_t)N0 * 1024 * 2;
constexpr size_t WS_BT1 = WS_WT0O + (size_t)1024 * 2048 * 2;
constexpr size_t WS_WT1O = WS_BT1 + (size_t)N1 * 1024 * 2;
constexpr size_t WS_H = WS_WT1O + (size_t)1024 * 1024 * 2;
constexpr size_t WS_OC = WS_H + (size_t)NTOK * 1024 * 2;
constexpr size_t WS_X1 = WS_OC + (size_t)NTOK * 2048 * 2;
constexpr size_t WS_P = WS_X1 + (size_t)NTOK * 1024 * 4;
constexpr size_t WS_P2 = WS_P + 64 * MB;
constexpr size_t WS_END = WS_P + (size_t)NTOK * N0 * 2;

struct Params {
    const float* in[30];
    float* out;
    unsigned char* ws;
    int ph_lo, ph_hi;
};

__device__ __forceinline__ float bf2f(bf16_t h) { return __uint_as_float(((unsigned)h) << 16); }
__device__ __forceinline__ bf16_t f2bf(float f) { unsigned u = __float_as_uint(f); u += 0x7FFFu + ((u >> 16) & 1u); return (bf16_t)(u >> 16); }
__device__ __forceinline__ unsigned pack2(float lo, float hi) { return (unsigned)f2bf(lo) | ((unsigned)f2bf(hi) << 16); }
__device__ __forceinline__ float bflo(unsigned w) { return __uint_as_float(w << 16); }
__device__ __forceinline__ float bfhi(unsigned w) { return __uint_as_float(w & 0xFFFF0000u); }
__device__ __forceinline__ float silu(float x) { return x / (1.f + __expf(-x)); }
__device__ __forceinline__ float wave_sum(float v) {
#pragma unroll
    for (int m = 32; m >= 1; m >>= 1) v += __shfl_xor(v, m, 64);
    return v;
}

namespace pg8 {
constexpr int BM = 256, BK = 64, HALF = 128, HTB = HALF * BK * 2, NXCD = 8, WGM = 8;
__device__ __forceinline__ int lds_byte(int r, int c) { const int st = (r >> 4) * 2 + (c >> 5), rr = r & 15, cc = c & 31, ob = rr * 64 + cc * 2; return st * 1024 + (ob ^ (((ob >> 9) & 1) << 5)); }
__device__ __forceinline__ void stage_rc(int b, int& R, int& C) { const int st = b / 1024, sb = b % 1024, swz = sb ^ (((sb >> 9) & 1) << 5); R = (st >> 1) * 16 + swz / 64; C = (st & 1) * 32 + (swz % 64) / 2; }
__device__ __forceinline__ int perm32(int rho) { const int n = rho >> 4, i = rho & 15; return 8 * (i >> 2) + 4 * n + (i & 3); }

struct Unit { int pm, pn, ks; };
struct Gemm { const bf16_t* A; const bf16_t* Bt; int M, N, K, ld, KS; };

struct Order {
    int nM, nN, nNr, nwg, G, c;
    __device__ void init(int M, int N, int KS, int G_, int c_) { nM = M / BM; nNr = N / BM; nN = nNr * KS; nwg = nM * nN; G = G_; c = c_; }
    __device__ bool next(int i, Unit& u) const {
        const long L = (long)i * G + c; if (L >= nwg) return false;
        int wgid = (int)L; { const int q = nwg / NXCD, r = nwg % NXCD, xcd = wgid % NXCD, off = wgid / NXCD; wgid = (xcd < r ? xcd * (q + 1) : r * (q + 1) + (xcd - r) * q) + off; }
        const int nig = WGM * nN, gid = wgid / nig, fm = gid * WGM, gsz = (nM - fm) < WGM ? (nM - fm) : WGM;
        u.pm = fm + ((wgid % nig) % gsz); const int pn = (wgid % nig) / gsz; u.pn = pn % nNr; u.ks = pn / nNr; return true;
    }
};

__device__ __forceinline__ unsigned cvt_pk_bf16(float lo, float hi) { unsigned r; asm volatile("v_cvt_pk_bf16_f32 %0, %1, %2" : "=v"(r) : "v"(lo), "v"(hi)); return r; }

struct EpiF32 {
    static constexpr bool PERM = false;
    float* C; int ldc; size_t ks_stride;
    __device__ __forceinline__ void operator()(const f32x4 (&acc)[2][2][4][2], const Unit& u, int wr, int wc, int fr, int fq) const {
        const int row0 = u.pm * BM + wr * 64 + fr, col0 = u.pn * BM + wc * 32 + 4 * fq;
        float* Cb = C + (size_t)u.ks * ks_stride;
#pragma unroll
        for (int ai = 0; ai < 2; ++ai)
#pragma unroll
            for (int m = 0; m < 4; ++m) { float* rowp = Cb + (size_t)(row0 + ai * HALF + m * 16) * ldc + col0;
#pragma unroll
                for (int bj = 0; bj < 2; ++bj)
#pragma unroll
                    for (int n = 0; n < 2; ++n) *(f32x4*)(rowp + bj * HALF + n * 16) = acc[ai][bj][m][n]; }
    }
};
struct EpiBf16 {
    static constexpr bool PERM = true;
    bf16_t* O; int ldc;
    __device__ __forceinline__ void operator()(const f32x4 (&acc)[2][2][4][2], const Unit& u, int wr, int wc, int fr, int fq) const {
        const int row0 = u.pm * BM + wr * 64 + fr; const int col0 = u.pn * BM + wc * 32 + 8 * fq;
#pragma unroll
        for (int ai = 0; ai < 2; ++ai)
#pragma unroll
            for (int m = 0; m < 4; ++m) { bf16_t* rowp = O + (size_t)(row0 + ai * HALF + m * 16) * ldc + col0;
#pragma unroll
                for (int bj = 0; bj < 2; ++bj) { const f32x4 v0 = acc[ai][bj][m][0], v1 = acc[ai][bj][m][1];
                    u32x4 w; w.x = cvt_pk_bf16(v0[0], v0[1]); w.y = cvt_pk_bf16(v0[2], v0[3]); w.z = cvt_pk_bf16(v1[0], v1[1]); w.w = cvt_pk_bf16(v1[2], v1[3]);
                    *(u32x4*)(rowp + bj * HALF) = w; } }
    }
};

template <class Epi>
__device__ __forceinline__ void gemm_phase(LAS unsigned char* lds, const Gemm g, const Order& S, const Epi& E) {
    const int tid = threadIdx.x, wid = __builtin_amdgcn_readfirstlane(tid >> 6), lane = tid & 63, wr = wid >> 2, wc = wid & 3, fr = lane & 15, fq = lane >> 4;
    const int K = g.K, nt = K / BK, ld = g.ld;
    unsigned voffA[2], voffB[2];
#pragma unroll
    for (int i = 0; i < 2; ++i) { int R, C; stage_rc(tid * 16 + i * 8192, R, C); const int Rb = Epi::PERM ? ((R & ~31) + perm32(R & 31)) : R;
        voffA[i] = (unsigned)(R * ld + C) * 2u; voffB[i] = (unsigned)(Rb * ld + C) * 2u; }
    const size_t kstep = (size_t)(BK * 2);
    const size_t hstep = (size_t)HALF * ld * 2;
    const size_t tstep = 2 * hstep;
    const size_t ksb = (size_t)K * 2;
    const unsigned ldsw = (unsigned)wid * 1024u;
    const int aoff = lds_byte(wr * 64 + fr, fq * 8), boff = lds_byte(wc * 32 + fr, fq * 8);
#define PG8_SA(b, h) (((b) * 2 + (h)) * HTB)
#define PG8_SB(b, h) ((4 + (b) * 2 + (h)) * HTB)
#define PG8_STAGE(bufoff, gbase, voff) do { _Pragma("unroll") for (int _i = 0; _i < 2; ++_i) \
        __builtin_amdgcn_global_load_lds((const unsigned*)((const char*)(gbase) + (voff)[_i]), (LAS unsigned*)(lds + (bufoff) + ldsw + _i * 8192), 16, 0, 0); } while (0)
#define PG8_LDA(dst, b, h) do { _Pragma("unroll") for (int m = 0; m < 4; ++m) _Pragma("unroll") for (int k = 0; k < 2; ++k) dst[m][k] = *(const LAS bf16x8*)(lds + PG8_SA(b, h) + aoff + m * 2048 + k * 1024); } while (0)
#define PG8_LDB(dst, b, h) do { _Pragma("unroll") for (int n = 0; n < 2; ++n) _Pragma("unroll") for (int k = 0; k < 2; ++k) dst[n][k] = *(const LAS bf16x8*)(lds + PG8_SB(b, h) + boff + n * 2048 + k * 1024); } while (0)
#define PG8_MMA(ai, bj, At, Bt) do { __builtin_amdgcn_s_setprio(1); _Pragma("unroll") for (int m = 0; m < 4; ++m) _Pragma("unroll") for (int n = 0; n < 2; ++n) _Pragma("unroll") for (int k = 0; k < 2; ++k) \
        acc[ai][bj][m][n] = __builtin_amdgcn_mfma_f32_16x16x32_bf16(Bt[n][k], At[m][k], acc[ai][bj][m][n], 0, 0, 0); __builtin_amdgcn_s_setprio(0); } while (0)
#define PG8_WAIT_V(n) asm volatile("s_waitcnt vmcnt(" #n ")" ::: "memory")
#define PG8_WAIT_L(n) asm volatile("s_waitcnt lgkmcnt(" #n ")" ::: "memory")
#define PG8_BAR __builtin_amdgcn_s_barrier()
#define PG8_SCHED __builtin_amdgcn_sched_barrier(0)
    Unit cur, nxt; int ui = 0;
    if (!S.next(0, cur)) return;
    f32x4 acc[2][2][4][2];
#pragma unroll
    for (int a = 0; a < 2; ++a)
#pragma unroll
        for (int b = 0; b < 2; ++b)
#pragma unroll
            for (int m = 0; m < 4; ++m)
#pragma unroll
                for (int n = 0; n < 2; ++n) acc[a][b][m][n] = (f32x4){0.f, 0.f, 0.f, 0.f};
    bf16x8 At[4][2], B0[2][2], B1[2][2];
    const char* cA = (const char*)g.A + (size_t)cur.pm * tstep + (size_t)cur.ks * ksb; const char* cB = (const char*)g.Bt + (size_t)cur.pn * tstep + (size_t)cur.ks * ksb;
    PG8_STAGE(PG8_SB(0, 0), cB, voffB); PG8_STAGE(PG8_SA(0, 0), cA, voffA); PG8_STAGE(PG8_SB(0, 1), cB + hstep, voffB); PG8_STAGE(PG8_SA(0, 1), cA + hstep, voffA);
    if (wr == 1) PG8_BAR;
    PG8_WAIT_V(4); PG8_BAR;
    PG8_STAGE(PG8_SB(1, 0), cB + kstep, voffB); PG8_STAGE(PG8_SA(1, 0), cA + kstep, voffA); PG8_STAGE(PG8_SB(1, 1), cB + hstep + kstep, voffB);
    PG8_WAIT_V(6); PG8_BAR;
    for (;;) {
        const bool has_next = S.next(ui + 1, nxt);
        const char* nA = has_next ? (const char*)g.A + (size_t)nxt.pm * tstep + (size_t)nxt.ks * ksb : cA; const char* nB = has_next ? (const char*)g.Bt + (size_t)nxt.pn * tstep + (size_t)nxt.ks * ksb : cB;
        for (int t = 0; t < nt; t += 2) {
            const bool last = (t == nt - 2);
            const char* a1 = cA + (size_t)(t + 1) * kstep;
            const char* a2 = last ? nA : cA + (size_t)(t + 2) * kstep; const char* b2 = last ? nB : cB + (size_t)(t + 2) * kstep;
            const char* a3 = a2 + kstep; const char* b3 = b2 + kstep;
            PG8_LDB(B0, 0, 0); PG8_SCHED; PG8_LDA(At, 0, 0); PG8_STAGE(PG8_SA(1, 1), a1 + hstep, voffA);
            PG8_WAIT_L(8); PG8_BAR; PG8_WAIT_L(0); PG8_MMA(0, 0, At, B0); PG8_BAR; PG8_SCHED;
            PG8_LDB(B1, 0, 1); PG8_STAGE(PG8_SB(0, 0), b2, voffB);
            PG8_BAR; PG8_WAIT_L(0); PG8_MMA(0, 1, At, B1); PG8_BAR;
            PG8_LDA(At, 0, 1); PG8_STAGE(PG8_SA(0, 0), a2, voffA);
            PG8_BAR; PG8_WAIT_L(0); PG8_MMA(1, 0, At, B0); PG8_BAR; PG8_SCHED;
            PG8_STAGE(PG8_SB(0, 1), b2 + hstep, voffB);
            PG8_WAIT_V(6); PG8_BAR; PG8_MMA(1, 1, At, B1); PG8_BAR;
            PG8_LDB(B0, 1, 0); PG8_SCHED; PG8_LDA(At, 1, 0); PG8_STAGE(PG8_SA(0, 1), a2 + hstep, voffA);
            PG8_WAIT_L(8); PG8_BAR; PG8_WAIT_L(0); PG8_MMA(0, 0, At, B0); PG8_BAR; PG8_SCHED;
            PG8_LDB(B1, 1, 1); PG8_STAGE(PG8_SB(1, 0), b3, voffB);
            PG8_BAR; PG8_WAIT_L(0); PG8_MMA(0, 1, At, B1); PG8_BAR;
            PG8_LDA(At, 1, 1); PG8_STAGE(PG8_SA(1, 0), a3, voffA);
            PG8_BAR; PG8_WAIT_L(0); PG8_MMA(1, 0, At, B0); PG8_BAR; PG8_SCHED;
            PG8_STAGE(PG8_SB(1, 1), b3 + hstep, voffB);
            PG8_WAIT_V(6); PG8_BAR; PG8_MMA(1, 1, At, B1); PG8_BAR;
        }
        E(acc, cur, wr, wc, fr, fq);
        if (!has_next) break;
#pragma unroll
        for (int a = 0; a < 2; ++a)
#pragma unroll
            for (int b = 0; b < 2; ++b)
#pragma unroll
                for (int m = 0; m < 4; ++m)
#pragma unroll
                    for (int n = 0; n < 2; ++n) acc[a][b][m][n] = (f32x4){0.f, 0.f, 0.f, 0.f};
        cur = nxt; cA = nA; cB = nB; ++ui;
    }
    PG8_WAIT_V(0);
    if (wr == 0) PG8_BAR;
    PG8_BAR;
#undef PG8_SA
#undef PG8_SB
#undef PG8_STAGE
#undef PG8_LDA
#undef PG8_LDB
#undef PG8_MMA
#undef PG8_WAIT_V
#undef PG8_WAIT_L
#undef PG8_BAR
#undef PG8_SCHED
}
}

__device__ void transpose_tile(const float* __restrict__ src, int ldsrc, int N, int k0, int n0, bf16_t* __restrict__ dst, int lddst, int dstrow0, float* tile) {
    const int tid = threadIdx.x;
    for (int i = tid; i < 4096; i += NTHR) { const int kk = i >> 6, nn = i & 63; float v = 0.f; if (n0 + nn < N) v = src[(size_t)(k0 + kk) * ldsrc + n0 + nn]; tile[kk * 65 + nn] = v; }
    __syncthreads();
    for (int i = tid; i < 2048; i += NTHR) { const int nn = i >> 5, kp = (i & 31) * 2;
        if (n0 + nn < N) *(unsigned*)(dst + (size_t)(dstrow0 + n0 + nn) * lddst + k0 + kp) = pack2(tile[kp * 65 + nn], tile[(kp + 1) * 65 + nn]); }
    __syncthreads();
}

__device__ void phase_prologue(const Params& p, float* lds) {
    const int tid = threadIdx.x;
    unsigned char* ws = p.ws;
    bf16_t* BT0 = (bf16_t*)(ws + WS_BT0); bf16_t* WT0O = (bf16_t*)(ws + WS_WT0O); bf16_t* BT1 = (bf16_t*)(ws + WS_BT1); bf16_t* WT1O = (bf16_t*)(ws + WS_WT1O);
    float* MOD = (float*)(ws + WS_MOD);
    constexpr int NGEMV = 192, NT = 3680;
    for (int it = blockIdx.x; it < NGEMV + NT; it += gridDim.x) {
        if (it < NGEMV) {
            const int l = it / 96, j0 = (it % 96) * 32;
            float* sc = lds;
            float* red = lds + 3072;
            for (int i = tid; i < 3072; i += NTHR) { const int cnd = i >> 10, k = i & 1023; const float v = cnd == 0 ? p.in[5][k] : p.in[4][(cnd - 1) * 1024 + k]; sc[i] = silu(v); }
            __syncthreads();
            const int col = tid & 31, ksp = tid >> 5;
            float a0 = 0.f, a1 = 0.f, a2 = 0.f;
            const float* w = p.in[7] + (size_t)l * 1024 * 3072 + j0 + col;
            for (int k = ksp * 64; k < ksp * 64 + 64; ++k) { const float wv = w[(size_t)k * 3072]; a0 += sc[k] * wv; a1 += sc[1024 + k] * wv; a2 += sc[2048 + k] * wv; }
            red[(ksp * 3 + 0) * 32 + col] = a0; red[(ksp * 3 + 1) * 32 + col] = a1; red[(ksp * 3 + 2) * 32 + col] = a2;
            __syncthreads();
            if (tid < 96) { const int cnd = tid >> 5, cc = tid & 31; float s = 0.f; for (int q = 0; q < 16; ++q) s += red[(q * 3 + cnd) * 32 + cc];
                MOD[(l * 3 + cnd) * 3072 + j0 + cc] = s + p.in[8][l * 3072 + j0 + cc]; }
            __syncthreads();
        } else {
            int t = it - NGEMV;
            const float* src; int ldsrc, N; bf16_t* dst; int lddst, drow0, nnt;
            if (t < 2048) { src = p.in[10]; ldsrc = 8192; N = 8192; dst = BT0; lddst = 1024; drow0 = 0; nnt = 128; }
            else if (t < 2048 + 32) { t -= 2048; const int z = t >> 4; t &= 15; src = p.in[14] + (size_t)z * 1024 * 64; ldsrc = 64; N = 64; dst = BT0; lddst = 1024; drow0 = 8192 + z * 64; nnt = 1; }
            else if (t < 2048 + 64) { t -= 2048 + 32; const int z = t >> 4; t &= 15; src = p.in[17] + (size_t)z * 1024 * 64; ldsrc = 64; N = 64; dst = BT0; lddst = 1024; drow0 = 8320 + z * 64; nnt = 1; }
            else if (t < 2112 + 512) { t -= 2112; src = p.in[11]; ldsrc = 1024; N = 1024; dst = WT0O; lddst = 2048; drow0 = 0; nnt = 16; }
            else if (t < 2624 + 768) { t -= 2624; src = p.in[24]; ldsrc = 3072; N = 3072; dst = BT1; lddst = 1024; drow0 = 0; nnt = 48; }
            else if (t < 3392 + 32) { t -= 3392; const int z = t >> 4; t &= 15; src = p.in[26] + (size_t)z * 1024 * 16; ldsrc = 16; N = 16; dst = BT1; lddst = 1024; drow0 = 3072 + z * 16; nnt = 1; }
            else { t -= 3424; src = p.in[25]; ldsrc = 1024; N = 1024; dst = WT1O; lddst = 1024; drow0 = 0; nnt = 16; }
            const int kt = t / nnt, ntile = t % nnt;
            transpose_tile(src, ldsrc, N, kt * 64, ntile * 64, dst, lddst, drow0, lds);
        }
    }
    { u32x4* z = (u32x4*)(BT1 + (size_t)3104 * 1024); const int n = 224 * 1024 * 2 / 16;
      for (int i = blockIdx.x * NTHR + tid; i < n; i += gridDim.x * NTHR) z[i] = (u32x4){0u, 0u, 0u, 0u}; }
}

__device__ void phase_h(const Params& p, int layer) {
    const int tid = threadIdx.x, wave = tid >> 6, lane = tid & 63;
    unsigned char* ws = p.ws;
    const float* MOD = (const float*)(ws + WS_MOD);
    bf16_t* H = (bf16_t*)(ws + WS_H);
    float* X1 = (float*)(ws + WS_X1);
    const float* Y = (const float*)(ws + WS_P);
    for (int tok = blockIdx.x * 8 + wave; tok < NTOK; tok += gridDim.x * 8) {
        const float* xr = tok < NPTOK ? p.in[0] + (size_t)tok * D : p.in[1] + (size_t)(tok - NPTOK) * D;
        const int cond = tok < NPTOK ? 0 : 1 + ((tok - NPTOK) >> 11);
        f32x4 xv[4]; float ss = 0.f;
#pragma unroll
        for (int i = 0; i < 4; ++i) { const int idx = i * 256 + lane * 4; xv[i] = *(const f32x4*)(xr + idx);
            if (layer == 1) { const f32x4 ya = *(const f32x4*)(Y + (size_t)tok * D + idx), yb = *(const f32x4*)(Y + (size_t)NTOK * D + (size_t)tok * D + idx);
                const f32x4 gt = *(const f32x4*)(MOD + (0 * 3 + cond) * 3072 + 2048 + idx);
                xv[i] = xv[i] + gt * (ya + yb); *(f32x4*)(X1 + (size_t)tok * D + idx) = xv[i]; }
            ss += xv[i][0] * xv[i][0] + xv[i][1] * xv[i][1] + xv[i][2] * xv[i][2] + xv[i][3] * xv[i][3]; }
        ss = wave_sum(ss);
        const float rstd = rsqrtf(ss * (1.f / 1024.f) + 1e-6f);
#pragma unroll
        for (int i = 0; i < 4; ++i) { const int idx = i * 256 + lane * 4;
            const f32x4 g = *(const f32x4*)(p.in[6] + layer * D + idx);
            const f32x4 sh = *(const f32x4*)(MOD + (layer * 3 + cond) * 3072 + idx), sc = *(const f32x4*)(MOD + (layer * 3 + cond) * 3072 + 1024 + idx);
            f32x4 h;
#pragma unroll
            for (int j = 0; j < 4; ++j) h[j] = xv[i][j] * rstd * g[j] * (1.f + sc[j]) + sh[j];
            u32x2 w; w.x = pack2(h[0], h[1]); w.y = pack2(h[2], h[3]);
            *(u32x2*)(H + (size_t)tok * D + idx) = w; }
    }
}

__device__ __forceinline__ f32x4 mma_nt(const bf16_t* A, int lda, const bf16_t* B, int ldb, int K, f32x4 acc, int fr, int fq) {
    for (int k0 = 0; k0 < K; k0 += 32) {
        const bf16x8 a = *(const bf16x8*)(A + fr * lda + k0 + fq * 8);
        const bf16x8 b = *(const bf16x8*)(B + fr * ldb + k0 + fq * 8);
        acc = __builtin_amdgcn_mfma_f32_16x16x32_bf16(a, b, acc, 0, 0, 0);
    }
    return acc;
}
__device__ __forceinline__ bf16x8 pack8(float a0, float a1, float a2, float a3, float a4, float a5, float a6, float a7) {
    u32x4 w; w.x = pack2(a0, a1); w.y = pack2(a2, a3); w.z = pack2(a4, a5); w.w = pack2(a6, a7);
    return __builtin_bit_cast(bf16x8, w);
}
__device__ void wkv_unit(const Params& p, int u, float* ldsf) {
    const int tid = threadIdx.x, lane = tid & 63, w = __builtin_amdgcn_readfirstlane(tid >> 6), fr = lane & 15, fq = lane >> 4;
    unsigned char* ws = p.ws;
    unsigned char* lds = (unsigned char*)ldsf;
    const bf16_t* P = (const bf16_t*)(ws + WS_P);
    bf16_t* OD = (bf16_t*)(ws + WS_X1);
    float* BON = (float*)(ws + WS_BON);
    int z, b, hd, T, tok0; bool sample;
    if (u < 64) { sample = true; z = u >> 5; b = (u >> 4) & 1; hd = u & 15; T = 2048; tok0 = NPTOK + b * 2048; }
    else { const int q = u - 64; sample = false; z = q >> 8; b = (q >> 4) & 15; hd = q & 15; T = 256; tok0 = b * 256; }
    bf16_t* TLW = (bf16_t*)(lds + 0);
    bf16_t* TLA = (bf16_t*)(lds + 4608);
    float* WA = (float*)(lds + 9216);
    float* LW = (float*)(lds + 26624);
    bf16_t* KTr = (bf16_t*)(lds + 34816);
    bf16_t* BTr = (bf16_t*)(lds + 39424);
    bf16_t* KKH = (bf16_t*)(lds + 44032);
    bf16_t* RH = (bf16_t*)(lds + 48640);
    bf16_t* KBm = (bf16_t*)(lds + 53248);
    bf16_t* VS = (bf16_t*)(lds + 63488);
    float* MM = (float*)(lds + 67584);
    bf16_t* TA = (bf16_t*)(lds + 75776);
    bf16_t* NA = (bf16_t*)(lds + 78336);
    float* PC = (float*)(lds + 80896);
    bf16x8 bw[2];
    { const float* W2 = (w >> 2) ? p.in[18] : p.in[15];
#pragma unroll
      for (int ks = 0; ks < 2; ++ks) { float t8[8];
#pragma unroll
        for (int e = 0; e < 8; ++e) t8[e] = W2[(size_t)(z * 64 + ks * 32 + fq * 8 + e) * 1024 + hd * 64 + (w & 3) * 16 + fr];
        bw[ks] = pack8(t8[0], t8[1], t8[2], t8[3], t8[4], t8[5], t8[6], t8[7]); } }
    f32x4 Sacc[4];
#pragma unroll
    for (int kt = 0; kt < 4; ++kt) Sacc[kt] = (f32x4){0.f, 0.f, 0.f, 0.f};
    if (sample && w < 4) { const float* s0 = p.in[2] + ((size_t)((b * 2 + z) * 16 + hd)) * 4096 + (size_t)(w * 16 + fr) * 64;
#pragma unroll
        for (int kt = 0; kt < 4; ++kt)
#pragma unroll
            for (int jj = 0; jj < 4; ++jj) Sacc[kt][jj] = s0[kt * 16 + fq * 4 + jj]; }
    const int c = lane, ch = hd * 64 + c;
    const int pcol = ((c >> 5) * 32) + (((c >> 2) & 3) * 8) + (((c >> 4) & 1) * 4) + (c & 3);
    const float w0c = p.in[13][z * 1024 + ch], a0c = p.in[16][z * 1024 + ch], kkc = p.in[19][ch], kac = p.in[20][ch], rkc = p.in[21][ch];
    const int stau = tid >> 4, sseg = tid & 15;
    const int scol = 8192 + (sseg < 8 ? z * 64 + sseg * 8 : 128 + z * 64 + (sseg - 8) * 8);
    u32x4 tlraw; bf16_t rraw[4], kraw[4], vraw[4];
#define WKV_LOAD_RAW(tb_) do { \
        { const int t_ = z ? (T - 1 - ((tb_) + stau)) : ((tb_) + stau); tlraw = *(const u32x4*)(P + (size_t)(tok0 + t_) * N0 + scol); } \
        _Pragma("unroll") for (int i_ = 0; i_ < 4; ++i_) { const int tau_ = w + 8 * i_; const int t_ = z ? (T - 1 - ((tb_) + tau_)) : ((tb_) + tau_); const size_t row_ = (size_t)(tok0 + t_) * N0; \
            rraw[i_] = P[row_ + 4096 + ch]; kraw[i_] = P[row_ + 5120 + ch]; vraw[i_] = P[row_ + 6144 + ch]; } } while (0)
    WKV_LOAD_RAW(0);
    __syncthreads();
#pragma unroll 1
    for (int tb = 0; tb < T; tb += 32) {
        { u32x4 o = tlraw;
          if (sseg < 8) { o.x = pack2(tanhf(bflo(tlraw.x)), tanhf(bfhi(tlraw.x))); o.y = pack2(tanhf(bflo(tlraw.y)), tanhf(bfhi(tlraw.y)));
                          o.z = pack2(tanhf(bflo(tlraw.z)), tanhf(bfhi(tlraw.z))); o.w = pack2(tanhf(bflo(tlraw.w)), tanhf(bfhi(tlraw.w))); }
          *(u32x4*)((sseg < 8 ? TLW : TLA) + stau * 72 + (sseg & 7) * 8) = o; }
        float rr[4], kx[4], vv[4];
#pragma unroll
        for (int i = 0; i < 4; ++i) { rr[i] = bf2f(rraw[i]); kx[i] = bf2f(kraw[i]); vv[i] = bf2f(vraw[i]); }
        __syncthreads();
        if (tb + 32 < T) WKV_LOAD_RAW(tb + 32);
        { const bf16_t* TL = (w >> 2) ? TLA : TLW; float* WAo = WA + (w >> 2) * 32 * 68;
#pragma unroll
          for (int mt = 0; mt < 2; ++mt) { f32x4 acc = (f32x4){0.f, 0.f, 0.f, 0.f};
#pragma unroll
            for (int ks = 0; ks < 2; ++ks) { const bf16x8 a = *(const bf16x8*)(TL + (mt * 16 + fr) * 72 + ks * 32 + fq * 8);
                acc = __builtin_amdgcn_mfma_f32_16x16x32_bf16(a, bw[ks], acc, 0, 0, 0); }
#pragma unroll
            for (int jj = 0; jj < 4; ++jj) WAo[(mt * 16 + fq * 4 + jj) * 68 + (w & 3) * 16 + fr] = acc[jj]; } }
        __syncthreads();
        float kkv[4], kmv[4], bv[4], lwv[4];
#pragma unroll
        for (int i = 0; i < 4; ++i) { const int tau = w + 8 * i; const int t = z ? (T - 1 - (tb + tau)) : (tb + tau); const int tokg = tok0 + t;
            const float wr_ = w0c + WA[tau * 68 + c], ap = a0c + WA[32 * 68 + tau * 68 + c];
            const float nx = -wr_; const float sp = fmaxf(nx, 0.f) + log1pf(__expf(-fabsf(nx)));
            const float lw = -__expf(-sp - 0.5f);
            const float iclr = 1.f / (1.f + __expf(-ap));
            const float kkraw = kx[i] * kkc;
            const float ssq = wave_sum(kkraw * kkraw);
            const float kk = kkraw / fmaxf(sqrtf(ssq), 1e-12f);
            const float kmod = kx[i] * (1.f + (iclr - 1.f) * kac);
            const float bon = wave_sum(rr[i] * kmod * rkc);
            if (lane == 0) BON[((size_t)z * NTOK + tokg) * 16 + hd] = bon;
            kkv[i] = kk; kmv[i] = kmod; bv[i] = kk * iclr; lwv[i] = lw;
            LW[tau * 64 + c] = lw; }
        __syncthreads();
#pragma unroll
        for (int i = 0; i < 4; ++i) { const int tau = w + 8 * i; const int j = tau & 15, cn = tau >> 4;
            float cum = 0.f;
            for (int q = 0; q <= j; ++q) cum += LW[(cn * 16 + q) * 64 + c];
            const float Pj = __expf(cum), ipj = __expf(-cum), pm1 = __expf(cum - lwv[i]);
            const bf16_t ktv = f2bf(kmv[i] * ipj), btv = f2bf(bv[i] * ipj);
            KTr[tau * 72 + pcol] = ktv; BTr[tau * 72 + pcol] = btv; KKH[tau * 72 + pcol] = f2bf(kkv[i] * pm1); RH[tau * 72 + pcol] = f2bf(rr[i] * Pj);
            const int sU = (j >> 2) * 8 + (j & 3);
            KBm[(cn * 64 + c) * 40 + sU] = f2bf(-bv[i] * ipj); KBm[(cn * 64 + c) * 40 + sU + 4] = ktv;
            VS[tau * 64 + c] = f2bf(vv[i]);
            if (j == 15) PC[cn * 64 + c] = Pj; }
        __syncthreads();
        { const int cn = w >> 2, which = w & 3;
          const bf16_t* Am = ((which & 1) ? KTr : BTr) + cn * 16 * 72; const bf16_t* Bm = ((which & 2) ? RH : KKH) + cn * 16 * 72;
          const f32x4 acc = mma_nt(Am, 72, Bm, 72, 64, (f32x4){0.f, 0.f, 0.f, 0.f}, fr, fq);
#pragma unroll
          for (int jj = 0; jj < 4; ++jj) { const int i = fq * 4 + jj, j = fr; const bool keep = (which & 2) ? (i <= j) : (i < j);
              MM[((cn * 4 + which) * 16 + i) * 16 + j] = keep ? acc[jj] : 0.f; } }
        __syncthreads();
        if (w == 0 && lane < 32) { const int cn = lane >> 4, col = lane & 15;
            const float* Mb = MM + (cn * 4 + 0) * 256; const float* Mk = MM + (cn * 4 + 1) * 256;
            float Tc[16];
#pragma unroll
            for (int i = 15; i >= 0; --i) { float sacc = (i == col) ? 1.f : 0.f;
#pragma unroll
                for (int l = i + 1; l < 16; ++l) sacc -= Mb[i * 16 + l] * Tc[l];
                Tc[i] = sacc; asm volatile("" ::: "memory"); }
#pragma unroll
            for (int i = 0; i < 16; ++i) { float a1 = 0.f;
#pragma unroll
                for (int l = i + 1; l < 16; ++l) a1 += Mk[i * 16 + l] * Tc[l];
                const int sU = (i >> 2) * 8 + (i & 3);
                TA[(cn * 16 + col) * 40 + sU] = f2bf(Tc[i]); TA[(cn * 16 + col) * 40 + sU + 4] = f2bf(a1); asm volatile("" ::: "memory"); } }
        if (w == 1) {
#pragma unroll
            for (int q = 0; q < 8; ++q) { const int idx = q * 64 + lane; const int cn = idx >> 8, i = (idx >> 4) & 15, j = idx & 15; const int sU = (i >> 2) * 8 + (i & 3);
                NA[(cn * 16 + j) * 40 + sU] = f2bf(-MM[((cn * 4 + 2) * 16 + i) * 16 + j]); NA[(cn * 16 + j) * 40 + sU + 4] = f2bf(MM[((cn * 4 + 3) * 16 + i) * 16 + j]); } }
        __syncthreads();
        if (w < 4) {
#pragma unroll
            for (int cn = 0; cn < 2; ++cn) {
                bf16x8 sb[2];
#pragma unroll
                for (int ks = 0; ks < 2; ++ks) sb[ks] = pack8(Sacc[2 * ks][0], Sacc[2 * ks][1], Sacc[2 * ks][2], Sacc[2 * ks][3], Sacc[2 * ks + 1][0], Sacc[2 * ks + 1][1], Sacc[2 * ks + 1][2], Sacc[2 * ks + 1][3]);
                f32x4 U0 = (f32x4){0.f, 0.f, 0.f, 0.f}, O = (f32x4){0.f, 0.f, 0.f, 0.f};
#pragma unroll
                for (int ks = 0; ks < 2; ++ks) { const bf16x8 a = *(const bf16x8*)(KKH + (cn * 16 + fr) * 72 + ks * 32 + fq * 8);
                    U0 = __builtin_amdgcn_mfma_f32_16x16x32_bf16(a, sb[ks], U0, 0, 0, 0);
                    const bf16x8 ar = *(const bf16x8*)(RH + (cn * 16 + fr) * 72 + ks * 32 + fq * 8);
                    O = __builtin_amdgcn_mfma_f32_16x16x32_bf16(ar, sb[ks], O, 0, 0, 0); }
                float vf[4];
#pragma unroll
                for (int e = 0; e < 4; ++e) vf[e] = bf2f(VS[(cn * 16 + fq * 4 + e) * 64 + w * 16 + fr]);
                const bf16x8 bU0 = pack8(U0[0], U0[1], U0[2], U0[3], vf[0], vf[1], vf[2], vf[3]);
                const bf16x8 ta = *(const bf16x8*)(TA + (cn * 16 + fr) * 40 + fq * 8);
                const f32x4 U = __builtin_amdgcn_mfma_f32_16x16x32_bf16(ta, bU0, (f32x4){0.f, 0.f, 0.f, 0.f}, 0, 0, 0);
                const bf16x8 bUV = pack8(U[0], U[1], U[2], U[3], vf[0], vf[1], vf[2], vf[3]);
                const bf16x8 na = *(const bf16x8*)(NA + (cn * 16 + fr) * 40 + fq * 8);
                O = __builtin_amdgcn_mfma_f32_16x16x32_bf16(na, bUV, O, 0, 0, 0);
#pragma unroll
                for (int jj = 0; jj < 4; ++jj) { const int tau = cn * 16 + fq * 4 + jj; const int t = z ? (T - 1 - (tb + tau)) : (tb + tau);
                    OD[((size_t)z * NTOK + tok0 + t) * 1024 + hd * 64 + w * 16 + fr] = f2bf(O[jj]); }
#pragma unroll
                for (int kt = 0; kt < 4; ++kt) { const bf16x8 kb = *(const bf16x8*)(KBm + (cn * 64 + kt * 16 + fr) * 40 + fq * 8);
                    Sacc[kt] = __builtin_amdgcn_mfma_f32_16x16x32_bf16(kb, bUV, Sacc[kt], 0, 0, 0);
                    const f32x4 pc = *(const f32x4*)(PC + cn * 64 + kt * 16 + fq * 4);
                    Sacc[kt] = Sacc[kt] * pc; }
            }
        }
        __syncthreads();
    }
#undef WKV_LOAD_RAW
    if (!sample && w < 4) { float* so = p.out + (size_t)2 * NPTOK * D + ((size_t)((b * 2 + z) * 16 + hd)) * 4096 + (size_t)(w * 16 + fr) * 64;
#pragma unroll
        for (int kt = 0; kt < 4; ++kt)
#pragma unroll
            for (int jj = 0; jj < 4; ++jj) so[kt * 16 + fq * 4 + jj] = Sacc[kt][jj]; }
    __syncthreads();
}

__device__ void conv_tile(const Params& p, int tile) {
    const int tid = threadIdx.x;
    unsigned char* ws = p.ws;
    const bf16_t* P = (const bf16_t*)(ws + WS_P);
    bf16_t* OC = (bf16_t*)(ws + WS_OC);
    const int cgp = tid & 127, c0 = cgp * 8, sub = tid >> 7;
    float cw0[8], cw1[8], cw2[8];
#pragma unroll
    for (int j = 0; j < 8; ++j) { cw0[j] = p.in[12][c0 + j]; cw1[j] = p.in[12][1024 + c0 + j]; cw2[j] = p.in[12][2048 + c0 + j]; }
    for (int jj = 0; jj < 4; ++jj) {
        const int t = tile * 16 + sub + 4 * jj;
        const int rl = t < NPTOK ? 256 : 64; const int pos = t & (rl - 1);
        const bf16_t* row = P + (size_t)t * N0;
        const u32x4 z4 = (u32x4){0u, 0u, 0u, 0u};
        const u32x4 u1 = *(const u32x4*)(row + c0), g1 = *(const u32x4*)(row + 2048 + c0);
        const u32x4 u0 = pos > 0 ? *(const u32x4*)(row - N0 + c0) : z4, g0 = pos > 0 ? *(const u32x4*)(row - N0 + 2048 + c0) : z4;
        const u32x4 u2 = pos < rl - 1 ? *(const u32x4*)(row + N0 + c0) : z4, g2 = pos < rl - 1 ? *(const u32x4*)(row + N0 + 2048 + c0) : z4;
        const u32x4 gb = *(const u32x4*)(row + 1024 + c0), zc = *(const u32x4*)(row + 3072 + c0);
        u32x4 o;
#pragma unroll
        for (int q = 0; q < 4; ++q) {
            const float y0 = cw0[2 * q] * (bflo(g0[q]) * bflo(u0[q])) + cw1[2 * q] * (bflo(g1[q]) * bflo(u1[q])) + cw2[2 * q] * (bflo(g2[q]) * bflo(u2[q]));
            const float y1 = cw0[2 * q + 1] * (bfhi(g0[q]) * bfhi(u0[q])) + cw1[2 * q + 1] * (bfhi(g1[q]) * bfhi(u1[q])) + cw2[2 * q + 1] * (bfhi(g2[q]) * bfhi(u2[q]));
            o[q] = pack2(silu(bflo(zc[q])) * bflo(gb[q]) * y0, silu(bfhi(zc[q])) * bfhi(gb[q]) * y1);
        }
        *(u32x4*)(OC + (size_t)t * 2048 + c0) = o;
    }
}

__device__ void phase_mix0(const Params& p, float* lds) {
    unsigned* ctr = (unsigned*)(p.ws + WS_CTL);
    int* slot = (int*)(lds + 32768);
    constexpr int NSCAN = 576, NCONV = 512;
    for (;;) {
        if (threadIdx.x == 0) *slot = (int)atomicAdd(ctr, 1u);
        __syncthreads();
        const int it = *slot;
        __syncthreads();
        if (it >= NSCAN + NCONV) break;
        if (it < NSCAN) wkv_unit(p, it, lds); else conv_tile(p, it - NSCAN);
    }
}

__device__ void phase_wkv_post(const Params& p) {
    const int tid = threadIdx.x, wave = tid >> 6, lane = tid & 63;
    unsigned char* ws = p.ws;
    const bf16_t* P = (const bf16_t*)(ws + WS_P);
    const bf16_t* OD = (const bf16_t*)(ws + WS_X1);
    const float* BON = (const float*)(ws + WS_BON);
    bf16_t* OC = (bf16_t*)(ws + WS_OC);
    for (int tok = blockIdx.x * 8 + wave; tok < NTOK; tok += gridDim.x * 8) {
        const bf16_t* row = P + (size_t)tok * N0;
        for (int hd = 0; hd < 16; ++hd) { const int ch = hd * 64 + lane;
            const float o = bf2f(OD[(size_t)tok * 1024 + ch]) + bf2f(OD[((size_t)NTOK + tok) * 1024 + ch]);
            const float mu = wave_sum(o) * (1.f / 64.f);
            const float dv = o - mu;
            const float var = wave_sum(dv * dv) * (1.f / 64.f);
            const float gn = dv * rsqrtf(var + 64e-5f) * p.in[22][ch] + p.in[23][ch];
            const float bon = BON[(size_t)tok * 16 + hd] + BON[((size_t)NTOK + tok) * 16 + hd];
            const float vv = bf2f(row[6144 + ch]), zw = bf2f(row[7168 + ch]);
            OC[(size_t)tok * 2048 + 1024 + ch] = f2bf((gn + bon * vv) * silu(zw)); }
    }
}

__device__ void gla_unit(const Params& p, int u, float* ldsf) {
    const int tid = threadIdx.x, lane = tid & 63, w = __builtin_amdgcn_readfirstlane(tid >> 6), fr = lane & 15, fq = lane >> 4;
    unsigned char* ws = p.ws;
    const bf16_t* P1 = (const bf16_t*)(ws + WS_P);
    float* OD = (float*)(ws + WS_P2);
    int z, b, hd, eh, T, tok0; bool sample;
    if (u < 32) { sample = true; z = u >> 4; b = (u >> 3) & 1; hd = (u >> 1) & 3; eh = u & 1; T = 2048; tok0 = NPTOK + b * 2048; }
    else { const int q = u - 32; sample = false; z = q >> 7; b = (q >> 3) & 15; hd = (q >> 1) & 3; eh = q & 1; T = 256; tok0 = b * 256; }
    bf16_t* QE = (bf16_t*)ldsf;
    bf16_t* KE = QE + 64 * 136;
    bf16_t* KDT = KE + 64 * 136;
    bf16_t* VT = KDT + 128 * 72;
    bf16_t* ATT = VT + 128 * 72;
    bf16_t* ST = ATT + 64 * 72;
    float* G = (float*)ST;
    float* L1G = (float*)(ST + 128 * 136);
    float* GK2 = L1G + 1024;
    float* EBL = GK2 + 2048;
    for (int i = tid; i < 2048; i += NTHR) { const int r = i >> 7, d = i & 127; GK2[i] = p.in[27][(size_t)(z * 16 + r) * 512 + hd * 128 + d]; }
    f32x4 Sacc[8];
    if (sample) { const float* s0 = p.in[3] + ((size_t)((b * 2 + z) * 4 + hd)) * 32768 + eh * 128 + fr;
#pragma unroll
        for (int et = 0; et < 8; ++et)
#pragma unroll
            for (int jj = 0; jj < 4; ++jj) Sacc[et][jj] = s0[(size_t)(w * 16 + fq * 4 + jj) * 256 + et * 16]; }
    else {
#pragma unroll
        for (int et = 0; et < 8; ++et) Sacc[et] = (f32x4){0.f, 0.f, 0.f, 0.f}; }
    const int d = tid & 127, tq = tid >> 7;
    const float gbias = p.in[28][z * 512 + hd * 128 + d];
    const int it = w & 3, eg = w >> 2;
    __syncthreads();
#pragma unroll 1
    for (int cb = 0; cb < T; cb += 64) {
        for (int i = tid; i < 1024; i += NTHR) { const int tau = i >> 4, r = i & 15; const int t = z ? (T - 1 - (cb + tau)) : (cb + tau);
            L1G[i] = bf2f(P1[(size_t)(tok0 + t) * N1 + 3072 + z * 16 + r]); }
        __syncthreads();
        { float run = 0.f;
#pragma unroll 4
          for (int i = 0; i < 16; ++i) { const int tau = tq * 16 + i;
            float x = gbias;
#pragma unroll
            for (int r = 0; r < 16; ++r) x += L1G[tau * 16 + r] * GK2[r * 128 + d];
            const float ls = fminf(x, 0.f) - log1pf(__expf(-fabsf(x)));
            run += ls * (1.f / 16.f);
            G[tau * 132 + d] = run; } }
        __syncthreads();
        { const float t0 = G[15 * 132 + d], t1 = G[31 * 132 + d], t2 = G[47 * 132 + d], t3 = G[63 * 132 + d];
          const float blast = t0 + t1 + t2 + t3;
          const float off = tq == 0 ? 0.f : (tq == 1 ? t0 : (tq == 2 ? t0 + t1 : t0 + t1 + t2));
          if (tq == 0) EBL[d] = __expf(blast);
#pragma unroll 4
          for (int i = 0; i < 16; ++i) { const int tau = tq * 16 + i; const int t = z ? (T - 1 - (cb + tau)) : (cb + tau); const size_t row = (size_t)(tok0 + t) * N1;
            const float bc = G[tau * 132 + d] + off;
            const float q = bf2f(P1[row + hd * 128 + d]) * 0.08838834764831845f, k = bf2f(P1[row + 512 + hd * 128 + d]);
            QE[tau * 136 + d] = f2bf(q * __expf(bc)); KE[tau * 136 + d] = f2bf(k * __expf(-bc)); KDT[d * 72 + tau] = f2bf(k * __expf(blast - bc));
            VT[d * 72 + tau] = P1[row + 1024 + hd * 256 + eh * 128 + d]; } }
        __syncthreads();
#pragma unroll
        for (int et = 0; et < 8; ++et) { u32x2 v2; v2.x = pack2(Sacc[et][0], Sacc[et][1]); v2.y = pack2(Sacc[et][2], Sacc[et][3]);
            *(u32x2*)(ST + (et * 16 + fr) * 136 + w * 16 + fq * 4) = v2; }
        __syncthreads();
#pragma unroll
        for (int q2 = 0; q2 < 2; ++q2) { const int tA = 2 * w + q2, ia = tA >> 2, ja = tA & 3;
            f32x4 a4 = (f32x4){0.f, 0.f, 0.f, 0.f};
            if (ja <= ia) a4 = mma_nt(QE + ia * 16 * 136, 136, KE + ja * 16 * 136, 136, 128, a4, fr, fq);
#pragma unroll
            for (int jj = 0; jj < 4; ++jj) { const int i = ia * 16 + fq * 4 + jj, j = ja * 16 + fr; ATT[i * 72 + j] = f2bf(j <= i ? a4[jj] : 0.f); } }
        f32x4 oacc[4];
#pragma unroll
        for (int e4 = 0; e4 < 4; ++e4) oacc[e4] = mma_nt(QE + it * 16 * 136, 136, ST + (eg * 4 + e4) * 16 * 136, 136, 128, (f32x4){0.f, 0.f, 0.f, 0.f}, fr, fq);
        __syncthreads();
#pragma unroll
        for (int e4 = 0; e4 < 4; ++e4) { oacc[e4] = mma_nt(ATT + it * 16 * 72, 72, VT + (eg * 4 + e4) * 16 * 72, 72, 64, oacc[e4], fr, fq);
#pragma unroll
            for (int jj = 0; jj < 4; ++jj) { const int tau = it * 16 + fq * 4 + jj; const int t = z ? (T - 1 - (cb + tau)) : (cb + tau);
                OD[((size_t)z * NTOK + tok0 + t) * 1024 + hd * 256 + eh * 128 + (eg * 4 + e4) * 16 + fr] = oacc[e4][jj]; } }
        { float eb[4];
#pragma unroll
          for (int jj = 0; jj < 4; ++jj) eb[jj] = EBL[w * 16 + fq * 4 + jj];
#pragma unroll
          for (int et = 0; et < 8; ++et) {
#pragma unroll
            for (int jj = 0; jj < 4; ++jj) Sacc[et][jj] *= eb[jj];
            Sacc[et] = mma_nt(KDT + w * 16 * 72, 72, VT + et * 16 * 72, 72, 64, Sacc[et], fr, fq); } }
        __syncthreads();
    }
    if (!sample) { float* so = p.out + (size_t)2 * NPTOK * D + 2097152 + ((size_t)((b * 2 + z) * 4 + hd)) * 32768 + eh * 128 + fr;
#pragma unroll
        for (int et = 0; et < 8; ++et)
#pragma unroll
            for (int jj = 0; jj < 4; ++jj) so[(size_t)(w * 16 + fq * 4 + jj) * 256 + et * 16] = Sacc[et][jj]; }
    __syncthreads();
}

__device__ void phase_gla(const Params& p, float* lds) {
    unsigned* ctr = (unsigned*)(p.ws + WS_CTL) + 16;
    int* slot = (int*)(lds + 32768);
    for (;;) {
        if (threadIdx.x == 0) *slot = (int)atomicAdd(ctr, 1u);
        __syncthreads();
        const int it = *slot;
        __syncthreads();
        if (it >= 288) break;
        gla_unit(p, it, lds);
    }
}

__device__ void phase_gla_post(const Params& p) {
    const int tid = threadIdx.x, wave = tid >> 6, lane = tid & 63;
    unsigned char* ws = p.ws;
    const bf16_t* P1 = (const bf16_t*)(ws + WS_P);
    const float* OD = (const float*)(ws + WS_P2);
    bf16_t* OG = (bf16_t*)(ws + WS_OC);
    for (int tok = blockIdx.x * 8 + wave; tok < NTOK; tok += gridDim.x * 8) {
        for (int hd = 0; hd < 4; ++hd) { const int idx = hd * 256 + lane * 4;
            const f32x4 a = *(const f32x4*)(OD + (size_t)tok * 1024 + idx), b2 = *(const f32x4*)(OD + ((size_t)NTOK + tok) * 1024 + idx);
            const f32x4 o = a + b2;
            const float ss = wave_sum(o[0] * o[0] + o[1] * o[1] + o[2] * o[2] + o[3] * o[3]);
            const float rs = rsqrtf(ss * (1.f / 256.f) + 1e-6f);
            const f32x4 gn = *(const f32x4*)(p.in[29] + lane * 4);
            const u32x2 zz = *(const u32x2*)(P1 + (size_t)tok * N1 + 2048 + idx);
            const float z0 = bflo(zz.x), z1 = bfhi(zz.x), z2 = bflo(zz.y), z3 = bfhi(zz.y);
            u32x2 w; w.x = pack2(o[0] * rs * gn[0] * silu(z0), o[1] * rs * gn[1] * silu(z1)); w.y = pack2(o[2] * rs * gn[2] * silu(z2), o[3] * rs * gn[3] * silu(z3));
            *(u32x2*)(OG + (size_t)tok * 1024 + idx) = w; }
    }
}

__device__ void phase_final(const Params& p) {
    const int tid = threadIdx.x, wave = tid >> 6, lane = tid & 63;
    unsigned char* ws = p.ws;
    const float* MOD = (const float*)(ws + WS_MOD);
    const float* X1 = (const float*)(ws + WS_X1);
    const float* Y = (const float*)(ws + WS_P2);
    for (int tok = blockIdx.x * 8 + wave; tok < NTOK; tok += gridDim.x * 8) {
        const int cond = tok < NPTOK ? 0 : 1 + ((tok - NPTOK) >> 11);
        f32x4 xv[4]; float ss = 0.f;
#pragma unroll
        for (int i = 0; i < 4; ++i) { const int idx = i * 256 + lane * 4;
            const f32x4 x1 = *(const f32x4*)(X1 + (size_t)tok * D + idx);
            const f32x4 ya = *(const f32x4*)(Y + (size_t)tok * D + idx), yb = *(const f32x4*)(Y + (size_t)NTOK * D + (size_t)tok * D + idx);
            const f32x4 gt = *(const f32x4*)(MOD + (1 * 3 + cond) * 3072 + 2048 + idx);
            xv[i] = x1 + gt * (ya + yb);
            ss += xv[i][0] * xv[i][0] + xv[i][1] * xv[i][1] + xv[i][2] * xv[i][2] + xv[i][3] * xv[i][3]; }
        ss = wave_sum(ss);
        const float rstd = rsqrtf(ss * (1.f / 1024.f) + 1e-6f);
#pragma unroll
        for (int i = 0; i < 4; ++i) { const int idx = i * 256 + lane * 4;
            const f32x4 g = *(const f32x4*)(p.in[9] + idx);
            f32x4 o;
#pragma unroll
            for (int j = 0; j < 4; ++j) o[j] = xv[i][j] * rstd * g[j];
            *(f32x4*)(p.out + (size_t)tok * D + idx) = o; }
    }
}

constexpr int NPHASE = 12;
__global__ void __launch_bounds__(NTHR, 2) fwd_megakernel(Params p) {
    extern __shared__ __attribute__((aligned(16))) unsigned char smem[];
    float* ldsf = (float*)smem;
    LAS unsigned char* ldsl = (LAS unsigned char*)smem;
    unsigned char* ws = p.ws;
#define PHASE(n) if (p.ph_lo <= (n) && (n) < p.ph_hi && ((n) == p.ph_lo || (cg::this_grid().sync(), true)))
    PHASE(0) phase_prologue(p, ldsf);
    PHASE(1) phase_h(p, 0);
    PHASE(2) { pg8::Gemm g{(const bf16_t*)(ws + WS_H), (const bf16_t*)(ws + WS_BT0), NTOK, N0, 1024, 1024, 1}; pg8::Order S; S.init(NTOK, N0, 1, gridDim.x, blockIdx.x);
               pg8::EpiBf16 E{(bf16_t*)(ws + WS_P), N0}; pg8::gemm_phase(ldsl, g, S, E); }
    PHASE(3) phase_mix0(p, ldsf);
    PHASE(4) phase_wkv_post(p);
    PHASE(5) { pg8::Gemm g{(const bf16_t*)(ws + WS_OC), (const bf16_t*)(ws + WS_WT0O), NTOK, 1024, 1024, 2048, 2}; pg8::Order S; S.init(NTOK, 1024, 2, gridDim.x, blockIdx.x);
               pg8::EpiF32 E{(float*)(ws + WS_P), 1024, (size_t)NTOK * 1024}; pg8::gemm_phase(ldsl, g, S, E); }
    PHASE(6) phase_h(p, 1);
    PHASE(7) { pg8::Gemm g{(const bf16_t*)(ws + WS_H), (const bf16_t*)(ws + WS_BT1), NTOK, N1, 1024, 1024, 1}; pg8::Order S; S.init(NTOK, N1, 1, gridDim.x, blockIdx.x);
               pg8::EpiBf16 E{(bf16_t*)(ws + WS_P), N1}; pg8::gemm_phase(ldsl, g, S, E); }
    PHASE(8) phase_gla(p, ldsf);
    PHASE(9) phase_gla_post(p);
    PHASE(10) { pg8::Gemm g{(const bf16_t*)(ws + WS_OC), (const bf16_t*)(ws + WS_WT1O), NTOK, 1024, 512, 1024, 2}; pg8::Order S; S.init(NTOK, 1024, 2, gridDim.x, blockIdx.x);
                pg8::EpiF32 E{(float*)(ws + WS_P2), 1024, (size_t)NTOK * 1024}; pg8::gemm_phase(ldsl, g, S, E); }
    PHASE(11) phase_final(p);
}

extern "C" void kernel_launch(void* const* d_in, const int* in_sizes, int n_in, void* d_out, int out_size, void* d_ws, size_t ws_size, hipStream_t stream) {
    static int grid = 0;
    if (grid == 0) {
        if (n_in != 30 || ws_size < WS_END) { fprintf(stderr, "kernel_launch: unexpected n_in %d / ws_size %zu (need %zu)\n", n_in, ws_size, (size_t)WS_END); grid = -1; return; }
        int dev = 0, cus = 0, per_cu = 0;
        hipGetDevice(&dev);
        hipDeviceGetAttribute(&cus, hipDeviceAttributeMultiprocessorCount, dev);
        hipFuncSetAttribute((const void*)fwd_megakernel, hipFuncAttributeMaxDynamicSharedMemorySize, LDS_BYTES);
        hipOccupancyMaxActiveBlocksPerMultiprocessor(&per_cu, (const void*)fwd_megakernel, NTHR, LDS_BYTES);
        if (per_cu < 1) { fprintf(stderr, "kernel_launch: occupancy query returned %d\n", per_cu); per_cu = 1; }
        grid = cus * per_cu;
        (void)hipGetLastError();
    }
    if (grid < 0) return;
    hipMemsetAsync((char*)d_ws + WS_CTL, 0, 256, stream);
    Params p{};
    for (int i = 0; i < 30; ++i) p.in[i] = (const float*)d_in[i];
    p.out = (float*)d_out; p.ws = (unsigned char*)d_ws;
#if MULTI_LAUNCH
    for (int ph = 0; ph < NPHASE; ++ph) { p.ph_lo = ph; p.ph_hi = ph + 1; hipLaunchKernelGGL(fwd_megakernel, dim3(grid), dim3(NTHR), LDS_BYTES, stream, p); }
#else
    p.ph_lo = 0; p.ph_hi = NPHASE;
    void* args[] = {&p};
    hipError_t e = hipLaunchCooperativeKernel((const void*)fwd_megakernel, dim3(grid), dim3(NTHR), args, LDS_BYTES, stream);
    if (e != hipSuccess) fprintf(stderr, "cooperative launch failed: %s (grid %d)\n", hipGetErrorString(e), grid);
#endif
}
```

```cpp
#include <hip/hip_runtime.h>
#include <hip/hip_cooperative_groups.h>
#include <cstdio>
namespace cg = cooperative_groups;

#define LAS __attribute__((address_space(3)))
typedef unsigned short bf16_t;
typedef short bf16x8 __attribute__((ext_vector_type(8)));
typedef float f32x4 __attribute__((ext_vector_type(4)));
typedef unsigned u32x4 __attribute__((ext_vector_type(4)));
typedef unsigned u32x2 __attribute__((ext_vector_type(2)));

#ifndef MULTI_LAUNCH
#define MULTI_LAUNCH 0
#endif

constexpr int D = 1024, NTOK = 8192, NPTOK = 4096;
constexpr int N0 = 8448;
constexpr int N1 = 3328;
constexpr int NTHR = 512;
constexpr int LDS_BYTES = 131072 + 256;

constexpr size_t MB = 1024 * 1024;
constexpr size_t WS_CTL = 0;
constexpr size_t WS_MOD = 4096;
constexpr size_t WS_BON = WS_MOD + 2 * 3 * 3072 * 4;
constexpr size_t WS_BAR = 0x1A0000;
constexpr size_t WS_BT0 = 2 * MB;
constexpr size_t WS_WT0O = WS_BT0 + (size_t)N0 * 1024 * 2;
constexpr size_t WS_BT1 = WS_WT0O + (size_t)1024 * 2048 * 2;
constexpr size_t WS_WT1O = WS_BT1 + (size_t)N1 * 1024 * 2;
constexpr size_t WS_H = WS_WT1O + (size_t)1024 * 1024 * 2;
constexpr size_t WS_OC = WS_H + (size_t)NTOK * 1024 * 2;
constexpr size_t WS_X1 = WS_OC + (size_t)NTOK * 2048 * 2;
constexpr size_t WS_P = WS_X1 + (size_t)NTOK * 1024 * 4;
constexpr size_t WS_P2 = WS_P + 64 * MB;
constexpr size_t WS_END = WS_P + (size_t)NTOK * N0 * 2;

struct Params {
    const float* in[30];
    float* out;
    unsigned char* ws;
    int ph_lo, ph_hi;
};

__device__ __forceinline__ float bf2f(bf16_t h) { return __uint_as_float(((unsigned)h) << 16); }
__device__ __forceinline__ bf16_t f2bf(float f) { unsigned u = __float_as_uint(f); u += 0x7FFFu + ((u >> 16) & 1u); return (bf16_t)(u >> 16); }
__device__ __forceinline__ unsigned pack2(float lo, float hi) { return (unsigned)f2bf(lo) | ((unsigned)f2bf(hi) << 16); }
__device__ __forceinline__ float bflo(unsigned w) { return __uint_as_float(w << 16); }
__device__ __forceinline__ float bfhi(unsigned w) { return __uint_as_float(w & 0xFFFF0000u); }
__device__ __forceinline__ float silu(float x) { return x / (1.f + __expf(-x)); }
__device__ __forceinline__ float wave_sum(float v) {
#pragma unroll
    for (int m = 32; m >= 1; m >>= 1) v += __shfl_xor(v, m, 64);
    return v;
}

namespace pg8 {
constexpr int BM = 256, BK = 64, HALF = 128, HTB = HALF * BK * 2, NXCD = 8, WGM = 8;
__device__ __forceinline__ int lds_byte(int r, int c) { const int st = (r >> 4) * 2 + (c >> 5), rr = r & 15, cc = c & 31, ob = rr * 64 + cc * 2; return st * 1024 + (ob ^ (((ob >> 9) & 1) << 5)); }
__device__ __forceinline__ void stage_rc(int b, int& R, int& C) { const int st = b / 1024, sb = b % 1024, swz = sb ^ (((sb >> 9) & 1) << 5); R = (st >> 1) * 16 + swz / 64; C = (st & 1) * 32 + (swz % 64) / 2; }
__device__ __forceinline__ int perm32(int rho) { const int n = rho >> 4, i = rho & 15; return 8 * (i >> 2) + 4 * n + (i & 3); }

struct Unit { int pm, pn, ks; };
struct Gemm { const bf16_t* A; const bf16_t* Bt; int M, N, K, ld, KS; };

struct Order {
    int nM, nN, nNr, nwg, G, c;
    __device__ void init(int M, int N, int KS, int G_, int c_) { nM = M / BM; nNr = N / BM; nN = nNr * KS; nwg = nM * nN; G = G_; c = c_; }
    __device__ bool next(int i, Unit& u) const {
        const long L = (long)i * G + c; if (L >= nwg) return false;
        int wgid = (int)L; { const int q = nwg / NXCD, r = nwg % NXCD, xcd = wgid % NXCD, off = wgid / NXCD; wgid = (xcd < r ? xcd * (q + 1) : r * (q + 1) + (xcd - r) * q) + off; }
        const int nig = WGM * nN, gid = wgid / nig, fm = gid * WGM, gsz = (nM - fm) < WGM ? (nM - fm) : WGM;
        u.pm = fm + ((wgid % nig) % gsz); const int pn = (wgid % nig) / gsz; u.pn = pn % nNr; u.ks = pn / nNr; return true;
    }
};

__device__ __forceinline__ unsigned cvt_pk_bf16(float lo, float hi) { unsigned r; asm volatile("v_cvt_pk_bf16_f32 %0, %1, %2" : "=v"(r) : "v"(lo), "v"(hi)); return r; }

struct EpiF32 {
    static constexpr bool PERM = false;
    float* C; int ldc; size_t ks_stride;
    __device__ __forceinline__ void operator()(const f32x4 (&acc)[2][2][4][2], const Unit& u, int wr, int wc, int fr, int fq) const {
        const int row0 = u.pm * BM + wr * 64 + fr, col0 = u.pn * BM + wc * 32 + 4 * fq;
        float* Cb = C + (size_t)u.ks * ks_stride;
#pragma unroll
        for (int ai = 0; ai < 2; ++ai)
#pragma unroll
            for (int m = 0; m < 4; ++m) { float* rowp = Cb + (size_t)(row0 + ai * HALF + m * 16) * ldc + col0;
#pragma unroll
                for (int bj = 0; bj < 2; ++bj)
#pragma unroll
                    for (int n = 0; n < 2; ++n) *(f32x4*)(rowp + bj * HALF + n * 16) = acc[ai][bj][m][n]; }
    }
};
struct EpiBf16 {
    static constexpr bool PERM = true;
    bf16_t* O; int ldc;
    __device__ __forceinline__ void operator()(const f32x4 (&acc)[2][2][4][2], const Unit& u, int wr, int wc, int fr, int fq) const {
        const int row0 = u.pm * BM + wr * 64 + fr; const int col0 = u.pn * BM + wc * 32 + 8 * fq;
#pragma unroll
        for (int ai = 0; ai < 2; ++ai)
#pragma unroll
            for (int m = 0; m < 4; ++m) { bf16_t* rowp = O + (size_t)(row0 + ai * HALF + m * 16) * ldc + col0;
#pragma unroll
                for (int bj = 0; bj < 2; ++bj) { const f32x4 v0 = acc[ai][bj][m][0], v1 = acc[ai][bj][m][1];
                    u32x4 w; w.x = cvt_pk_bf16(v0[0], v0[1]); w.y = cvt_pk_bf16(v0[2], v0[3]); w.z = cvt_pk_bf16(v1[0], v1[1]); w.w = cvt_pk_bf16(v1[2], v1[3]);
                    *(u32x4*)(rowp + bj * HALF) = w; } }
    }
};

template <class Epi>
__device__ __forceinline__ void gemm_phase(LAS unsigned char* lds, const Gemm g, const Order& S, const Epi& E) {
    const int tid = threadIdx.x, wid = __builtin_amdgcn_readfirstlane(tid >> 6), lane = tid & 63, wr = wid >> 2, wc = wid & 3, fr = lane & 15, fq = lane >> 4;
    const int K = g.K, nt = K / BK, ld = g.ld;
    unsigned voffA[2], voffB[2];
#pragma unroll
    for (int i = 0; i < 2; ++i) { int R, C; stage_rc(tid * 16 + i * 8192, R, C); const int Rb = Epi::PERM ? ((R & ~31) + perm32(R & 31)) : R;
        voffA[i] = (unsigned)(R * ld + C) * 2u; voffB[i] = (unsigned)(Rb * ld + C) * 2u; }
    const size_t kstep = (size_t)(BK * 2);
    const size_t hstep = (size_t)HALF * ld * 2;
    const size_t tstep = 2 * hstep;
    const size_t ksb = (size_t)K * 2;
    const unsigned ldsw = (unsigned)wid * 1024u;
    const int aoff = lds_byte(wr * 64 + fr, fq * 8), boff = lds_byte(wc * 32 + fr, fq * 8);
#define PG8_SA(b, h) (((b) * 2 + (h)) * HTB)
#define PG8_SB(b, h) ((4 + (b) * 2 + (h)) * HTB)
#define PG8_STAGE(bufoff, gbase, voff) do { _Pragma("unroll") for (int _i = 0; _i < 2; ++_i) \
        __builtin_amdgcn_global_load_lds((const unsigned*)((const char*)(gbase) + (voff)[_i]), (LAS unsigned*)(lds + (bufoff) + ldsw + _i * 8192), 16, 0, 0); } while (0)
#define PG8_LDA(dst, b, h) do { _Pragma("unroll") for (int m = 0; m < 4; ++m) _Pragma("unroll") for (int k = 0; k < 2; ++k) dst[m][k] = *(const LAS bf16x8*)(lds + PG8_SA(b, h) + aoff + m * 2048 + k * 1024); } while (0)
#define PG8_LDB(dst, b, h) do { _Pragma("unroll") for (int n = 0; n < 2; ++n) _Pragma("unroll") for (int k = 0; k < 2; ++k) dst[n][k] = *(const LAS bf16x8*)(lds + PG8_SB(b, h) + boff + n * 2048 + k * 1024); } while (0)
#define PG8_MMA(ai, bj, At, Bt) do { __builtin_amdgcn_s_setprio(1); _Pragma("unroll") for (int m = 0; m < 4; ++m) _Pragma("unroll") for (int n = 0; n < 2; ++n) _Pragma("unroll") for (int k = 0; k < 2; ++k) \
        acc[ai][bj][m][n] = __builtin_amdgcn_mfma_f32_16x16x32_bf16(Bt[n][k], At[m][k], acc[ai][bj][m][n], 0, 0, 0); __builtin_amdgcn_s_setprio(0); } while (0)
#define PG8_WAIT_V(n) asm volatile("s_waitcnt vmcnt(" #n ")" ::: "memory")
#define PG8_WAIT_L(n) asm volatile("s_waitcnt lgkmcnt(" #n ")" ::: "memory")
#define PG8_BAR __builtin_amdgcn_s_barrier()
#define PG8_SCHED __builtin_amdgcn_sched_barrier(0)
    Unit cur, nxt; int ui = 0;
    if (!S.next(0, cur)) return;
    f32x4 acc[2][2][4][2];
#pragma unroll
    for (int a = 0; a < 2; ++a)
#pragma unroll
        for (int b = 0; b < 2; ++b)
#pragma unroll
            for (int m = 0; m < 4; ++m)
#pragma unroll
                for (int n = 0; n < 2; ++n) acc[a][b][m][n] = (f32x4){0.f, 0.f, 0.f, 0.f};
    bf16x8 At[4][2], B0[2][2], B1[2][2];
    const char* cA = (const char*)g.A + (size_t)cur.pm * tstep + (size_t)cur.ks * ksb; const char* cB = (const char*)g.Bt + (size_t)cur.pn * tstep + (size_t)cur.ks * ksb;
    PG8_STAGE(PG8_SB(0, 0), cB, voffB); PG8_STAGE(PG8_SA(0, 0), cA, voffA); PG8_STAGE(PG8_SB(0, 1), cB + hstep, voffB); PG8_STAGE(PG8_SA(0, 1), cA + hstep, voffA);
    if (wr == 1) PG8_BAR;
    PG8_WAIT_V(4); PG8_BAR;
    PG8_STAGE(PG8_SB(1, 0), cB + kstep, voffB); PG8_STAGE(PG8_SA(1, 0), cA + kstep, voffA); PG8_STAGE(PG8_SB(1, 1), cB + hstep + kstep, voffB);
    PG8_WAIT_V(6); PG8_BAR;
    for (;;) {
        const bool has_next = S.next(ui + 1, nxt);
        const char* nA = has_next ? (const char*)g.A + (size_t)nxt.pm * tstep + (size_t)nxt.ks * ksb : cA; const char* nB = has_next ? (const char*)g.Bt + (size_t)nxt.pn * tstep + (size_t)nxt.ks * ksb : cB;
        for (int t = 0; t < nt; t += 2) {
            const bool last = (t == nt - 2);
            const char* a1 = cA + (size_t)(t + 1) * kstep;
            const char* a2 = last ? nA : cA + (size_t)(t + 2) * kstep; const char* b2 = last ? nB : cB + (size_t)(t + 2) * kstep;
            const char* a3 = a2 + kstep; const char* b3 = b2 + kstep;
            PG8_LDB(B0, 0, 0); PG8_SCHED; PG8_LDA(At, 0, 0); PG8_STAGE(PG8_SA(1, 1), a1 + hstep, voffA);
            PG8_WAIT_L(8); PG8_BAR; PG8_WAIT_L(0); PG8_MMA(0, 0, At, B0); PG8_BAR; PG8_SCHED;
            PG8_LDB(B1, 0, 1); PG8_STAGE(PG8_SB(0, 0), b2, voffB);
            PG8_BAR; PG8_WAIT_L(0); PG8_MMA(0, 1, At, B1); PG8_BAR;
            PG8_LDA(At, 0, 1); PG8_STAGE(PG8_SA(0, 0), a2, voffA);
            PG8_BAR; PG8_WAIT_L(0); PG8_MMA(1, 0, At, B0); PG8_BAR; PG8_SCHED;
            PG8_STAGE(PG8_SB(0, 1), b2 + hstep, voffB);
            PG8_WAIT_V(6); PG8_BAR; PG8_MMA(1, 1, At, B1); PG8_BAR;
            PG8_LDB(B0, 1, 0); PG8_SCHED; PG8_LDA(At, 1, 0); PG8_STAGE(PG8_SA(0, 1), a2 + hstep, voffA);
            PG8_WAIT_L(8); PG8_BAR; PG8_WAIT_L(0); PG8_MMA(0, 0, At, B0); PG8_BAR; PG8_SCHED;
            PG8_LDB(B1, 1, 1); PG8_STAGE(PG8_SB(1, 0), b3, voffB);
            PG8_BAR; PG8_WAIT_L(0); PG8_MMA(0, 1, At, B1); PG8_BAR;
            PG8_LDA(At, 1, 1); PG8_STAGE(PG8_SA(1, 0), a3, voffA);
            PG8_BAR; PG8_WAIT_L(0); PG8_MMA(1, 0, At, B0); PG8_BAR; PG8_SCHED;
            PG8_STAGE(PG8_SB(1, 1), b3 + hstep, voffB);
            PG8_WAIT_V(6); PG8_BAR; PG8_MMA(1, 1, At, B1); PG8_BAR;
        }
        E(acc, cur, wr, wc, fr, fq);
        if (!has_next) break;
#pragma unroll
        for (int a = 0; a < 2; ++a)
#pragma unroll
            for (int b = 0; b < 2; ++b)
#pragma unroll
                for (int m = 0; m < 4; ++m)
#pragma unroll
                    for (int n = 0; n < 2; ++n) acc[a][b][m][n] = (f32x4){0.f, 0.f, 0.f, 0.f};
        cur = nxt; cA = nA; cB = nB; ++ui;
    }
    PG8_WAIT_V(0);
    if (wr == 0) PG8_BAR;
    PG8_BAR;
#undef PG8_SA
#undef PG8_SB
#undef PG8_STAGE
#undef PG8_LDA
#undef PG8_LDB
#undef PG8_MMA
#undef PG8_WAIT_V
#undef PG8_WAIT_L
#undef PG8_BAR
#undef PG8_SCHED
}
}

__device__ void transpose_tile(const float* __restrict__ src, int ldsrc, int N, int k0, int n0, bf16_t* __restrict__ dst, int lddst, int dstrow0, float* tile) {
    const int tid = threadIdx.x;
    for (int i = tid; i < 4096; i += NTHR) { const int kk = i >> 6, nn = i & 63; float v = 0.f; if (n0 + nn < N) v = src[(size_t)(k0 + kk) * ldsrc + n0 + nn]; tile[kk * 65 + nn] = v; }
    __syncthreads();
    for (int i = tid; i < 2048; i += NTHR) { const int nn = i >> 5, kp = (i & 31) * 2;
        if (n0 + nn < N) *(unsigned*)(dst + (size_t)(dstrow0 + n0 + nn) * lddst + k0 + kp) = pack2(tile[kp * 65 + nn], tile[(kp + 1) * 65 + nn]); }
    __syncthreads();
}

__device__ void phase_prologue(const Params& p, float* lds) {
    const int tid = threadIdx.x;
    unsigned char* ws = p.ws;
    bf16_t* BT0 = (bf16_t*)(ws + WS_BT0); bf16_t* WT0O = (bf16_t*)(ws + WS_WT0O); bf16_t* BT1 = (bf16_t*)(ws + WS_BT1); bf16_t* WT1O = (bf16_t*)(ws + WS_WT1O);
    float* MOD = (float*)(ws + WS_MOD);
    constexpr int NGEMV = 192, NT = 3680;
    for (int it = blockIdx.x; it < NGEMV + NT; it += gridDim.x) {
        if (it < NGEMV) {
            const int l = it / 96, j0 = (it % 96) * 32;
            float* sc = lds;
            float* red = lds + 3072;
            for (int i = tid; i < 3072; i += NTHR) { const int cnd = i >> 10, k = i & 1023; const float v = cnd == 0 ? p.in[5][k] : p.in[4][(cnd - 1) * 1024 + k]; sc[i] = silu(v); }
            __syncthreads();
            const int col = tid & 31, ksp = tid >> 5;
            float a0 = 0.f, a1 = 0.f, a2 = 0.f;
            const float* w = p.in[7] + (size_t)l * 1024 * 3072 + j0 + col;
            for (int k = ksp * 64; k < ksp * 64 + 64; ++k) { const float wv = w[(size_t)k * 3072]; a0 += sc[k] * wv; a1 += sc[1024 + k] * wv; a2 += sc[2048 + k] * wv; }
            red[(ksp * 3 + 0) * 32 + col] = a0; red[(ksp * 3 + 1) * 32 + col] = a1; red[(ksp * 3 + 2) * 32 + col] = a2;
            __syncthreads();
            if (tid < 96) { const int cnd = tid >> 5, cc = tid & 31; float s = 0.f; for (int q = 0; q < 16; ++q) s += red[(q * 3 + cnd) * 32 + cc];
                MOD[(l * 3 + cnd) * 3072 + j0 + cc] = s + p.in[8][l * 3072 + j0 + cc]; }
            __syncthreads();
        } else {
            int t = it - NGEMV;
            const float* src; int ldsrc, N; bf16_t* dst; int lddst, drow0, nnt;
            if (t < 2048) { src = p.in[10]; ldsrc = 8192; N = 8192; dst = BT0; lddst = 1024; drow0 = 0; nnt = 128; }
            else if (t < 2048 + 32) { t -= 2048; const int z = t >> 4; t &= 15; src = p.in[14] + (size_t)z * 1024 * 64; ldsrc = 64; N = 64; dst = BT0; lddst = 1024; drow0 = 8192 + z * 64; nnt = 1; }
            else if (t < 2048 + 64) { t -= 2048 + 32; const int z = t >> 4; t &= 15; src = p.in[17] + (size_t)z * 1024 * 64; ldsrc = 64; N = 64; dst = BT0; lddst = 1024; drow0 = 8320 + z * 64; nnt = 1; }
            else if (t < 2112 + 512) { t -= 2112; src = p.in[11]; ldsrc = 1024; N = 1024; dst = WT0O; lddst = 2048; drow0 = 0; nnt = 16; }
            else if (t < 2624 + 768) { t -= 2624; src = p.in[24]; ldsrc = 3072; N = 3072; dst = BT1; lddst = 1024; drow0 = 0; nnt = 48; }
            else if (t < 3392 + 32) { t -= 3392; const int z = t >> 4; t &= 15; src = p.in[26] + (size_t)z * 1024 * 16; ldsrc = 16; N = 16; dst = BT1; lddst = 1024; drow0 = 3072 + z * 16; nnt = 1; }
            else { t -= 3424; src = p.in[25]; ldsrc = 1024; N = 1024; dst = WT1O; lddst = 1024; drow0 = 0; nnt = 16; }
            const int kt = t / nnt, ntile = t % nnt;
            transpose_tile(src, ldsrc, N, kt * 64, ntile * 64, dst, lddst, drow0, lds);
        }
    }
    { u32x4* z = (u32x4*)(BT1 + (size_t)3104 * 1024); const int n = 224 * 1024 * 2 / 16;
      for (int i = blockIdx.x * NTHR + tid; i < n; i += gridDim.x * NTHR) z[i] = (u32x4){0u, 0u, 0u, 0u}; }
}

__device__ void phase_h(const Params& p, int layer) {
    const int tid = threadIdx.x, wave = tid >> 6, lane = tid & 63;
    unsigned char* ws = p.ws;
    const float* MOD = (const float*)(ws + WS_MOD);
    bf16_t* H = (bf16_t*)(ws + WS_H);
    float* X1 = (float*)(ws + WS_X1);
    const float* Y = (const float*)(ws + WS_P);
    for (int tok = blockIdx.x * 8 + wave; tok < NTOK; tok += gridDim.x * 8) {
        const float* xr = tok < NPTOK ? p.in[0] + (size_t)tok * D : p.in[1] + (size_t)(tok - NPTOK) * D;
        const int cond = tok < NPTOK ? 0 : 1 + ((tok - NPTOK) >> 11);
        f32x4 xv[4]; float ss = 0.f;
#pragma unroll
        for (int i = 0; i < 4; ++i) { const int idx = i * 256 + lane * 4; xv[i] = *(const f32x4*)(xr + idx);
            if (layer == 1) { const f32x4 ya = *(const f32x4*)(Y + (size_t)tok * D + idx), yb = *(const f32x4*)(Y + (size_t)NTOK * D + (size_t)tok * D + idx);
                const f32x4 gt = *(const f32x4*)(MOD + (0 * 3 + cond) * 3072 + 2048 + idx);
                xv[i] = xv[i] + gt * (ya + yb); *(f32x4*)(X1 + (size_t)tok * D + idx) = xv[i]; }
            ss += xv[i][0] * xv[i][0] + xv[i][1] * xv[i][1] + xv[i][2] * xv[i][2] + xv[i][3] * xv[i][3]; }
        ss = wave_sum(ss);
        const float rstd = rsqrtf(ss * (1.f / 1024.f) + 1e-6f);
#pragma unroll
        for (int i = 0; i < 4; ++i) { const int idx = i * 256 + lane * 4;
            const f32x4 g = *(const f32x4*)(p.in[6] + layer * D + idx);
            const f32x4 sh = *(const f32x4*)(MOD + (layer * 3 + cond) * 3072 + idx), sc = *(const f32x4*)(MOD + (layer * 3 + cond) * 3072 + 1024 + idx);
            f32x4 h;
#pragma unroll
            for (int j = 0; j < 4; ++j) h[j] = xv[i][j] * rstd * g[j] * (1.f + sc[j]) + sh[j];
            u32x2 w; w.x = pack2(h[0], h[1]); w.y = pack2(h[2], h[3]);
            *(u32x2*)(H + (size_t)tok * D + idx) = w; }
    }
}

__device__ __forceinline__ f32x4 mma_nt(const bf16_t* A, int lda, const bf16_t* B, int ldb, int K, f32x4 acc, int fr, int fq) {
    for (int k0 = 0; k0 < K; k0 += 32) {
        const bf16x8 a = *(const bf16x8*)(A + fr * lda + k0 + fq * 8);
        const bf16x8 b = *(const bf16x8*)(B + fr * ldb + k0 + fq * 8);
        acc = __builtin_amdgcn_mfma_f32_16x16x32_bf16(a, b, acc, 0, 0, 0);
    }
    return acc;
}
__device__ __forceinline__ bf16x8 pack8(float a0, float a1, float a2, float a3, float a4, float a5, float a6, float a7) {
    u32x4 w; w.x = pack2(a0, a1); w.y = pack2(a2, a3); w.z = pack2(a4, a5); w.w = pack2(a6, a7);
    return __builtin_bit_cast(bf16x8, w);
}
__device__ void wkv_unit(const Params& p, int u, float* ldsf) {
    const int tid = threadIdx.x, lane = tid & 63, w = __builtin_amdgcn_readfirstlane(tid >> 6), fr = lane & 15, fq = lane >> 4;
    unsigned char* ws = p.ws;
    unsigned char* lds = (unsigned char*)ldsf;
    const bf16_t* P = (const bf16_t*)(ws + WS_P);
    bf16_t* OD = (bf16_t*)(ws + WS_X1);
    float* BON = (float*)(ws + WS_BON);
    int z, b, hd, T, tok0; bool sample;
    if (u < 64) { sample = true; z = u >> 5; b = (u >> 4) & 1; hd = u & 15; T = 2048; tok0 = NPTOK + b * 2048; }
    else { const int q = u - 64; sample = false; z = q >> 8; b = (q >> 4) & 15; hd = q & 15; T = 256; tok0 = b * 256; }
    bf16_t* TLW = (bf16_t*)(lds + 0);
    bf16_t* TLA = (bf16_t*)(lds + 4608);
    float* WA = (float*)(lds + 9216);
    float* LW = (float*)(lds + 26624);
    bf16_t* KTr = (bf16_t*)(lds + 34816);
    bf16_t* BTr = (bf16_t*)(lds + 39424);
    bf16_t* KKH = (bf16_t*)(lds + 44032);
    bf16_t* RH = (bf16_t*)(lds + 48640);
    bf16_t* KBm = (bf16_t*)(lds + 53248);
    bf16_t* VS = (bf16_t*)(lds + 63488);
    float* MM = (float*)(lds + 67584);
    bf16_t* TA = (bf16_t*)(lds + 75776);
    bf16_t* NA = (bf16_t*)(lds + 78336);
    float* PC = (float*)(lds + 80896);
    bf16x8 bw[2];
    { const float* W2 = (w >> 2) ? p.in[18] : p.in[15];
#pragma unroll
      for (int ks = 0; ks < 2; ++ks) { float t8[8];
#pragma unroll
        for (int e = 0; e < 8; ++e) t8[e] = W2[(size_t)(z * 64 + ks * 32 + fq * 8 + e) * 1024 + hd * 64 + (w & 3) * 16 + fr];
        bw[ks] = pack8(t8[0], t8[1], t8[2], t8[3], t8[4], t8[5], t8[6], t8[7]); } }
    f32x4 Sacc[4];
#pragma unroll
    for (int kt = 0; kt < 4; ++kt) Sacc[kt] = (f32x4){0.f, 0.f, 0.f, 0.f};
    if (sample && w < 4) { const float* s0 = p.in[2] + ((size_t)((b * 2 + z) * 16 + hd)) * 4096 + (size_t)(w * 16 + fr) * 64;
#pragma unroll
        for (int kt = 0; kt < 4; ++kt)
#pragma unroll
            for (int jj = 0; jj < 4; ++jj) Sacc[kt][jj] = s0[kt * 16 + fq * 4 + jj]; }
    const int c = lane, ch = hd * 64 + c;
    const int pcol = ((c >> 5) * 32) + (((c >> 2) & 3) * 8) + (((c >> 4) & 1) * 4) + (c & 3);
    const float w0c = p.in[13][z * 1024 + ch], a0c = p.in[16][z * 1024 + ch], kkc = p.in[19][ch], kac = p.in[20][ch], rkc = p.in[21][ch];
    const int stau = tid >> 4, sseg = tid & 15;
    const int scol = 8192 + (sseg < 8 ? z * 64 + sseg * 8 : 128 + z * 64 + (sseg - 8) * 8);
    u32x4 tlraw; bf16_t rraw[4], kraw[4], vraw[4];
#define WKV_LOAD_RAW(tb_) do { \
        { const int t_ = z ? (T - 1 - ((tb_) + stau)) : ((tb_) + stau); tlraw = *(const u32x4*)(P + (size_t)(tok0 + t_) * N0 + scol); } \
        _Pragma("unroll") for (int i_ = 0; i_ < 4; ++i_) { const int tau_ = w + 8 * i_; const int t_ = z ? (T - 1 - ((tb_) + tau_)) : ((tb_) + tau_); const size_t row_ = (size_t)(tok0 + t_) * N0; \
            rraw[i_] = P[row_ + 4096 + ch]; kraw[i_] = P[row_ + 5120 + ch]; vraw[i_] = P[row_ + 6144 + ch]; } } while (0)
    WKV_LOAD_RAW(0);
    __syncthreads();
#pragma unroll 1
    for (int tb = 0; tb < T; tb += 32) {
        { u32x4 o = tlraw;
          if (sseg < 8) { o.x = pack2(tanhf(bflo(tlraw.x)), tanhf(bfhi(tlraw.x))); o.y = pack2(tanhf(bflo(tlraw.y)), tanhf(bfhi(tlraw.y)));
                          o.z = pack2(tanhf(bflo(tlraw.z)), tanhf(bfhi(tlraw.z))); o.w = pack2(tanhf(bflo(tlraw.w)), tanhf(bfhi(tlraw.w))); }
          *(u32x4*)((sseg < 8 ? TLW : TLA) + stau * 72 + (sseg & 7) * 8) = o; }
        float rr[4], kx[4], vv[4];
#pragma unroll
        for (int i = 0; i < 4; ++i) { rr[i] = bf2f(rraw[i]); kx[i] = bf2f(kraw[i]); vv[i] = bf2f(vraw[i]); }
        __syncthreads();
        if (tb + 32 < T) WKV_LOAD_RAW(tb + 32);
        { const bf16_t* TL = (w >> 2) ? TLA : TLW; float* WAo = WA + (w >> 2) * 32 * 68;
#pragma unroll
          for (int mt = 0; mt < 2; ++mt) { f32x4 acc = (f32x4){0.f, 0.f, 0.f, 0.f};
#pragma unroll
            for (int ks = 0; ks < 2; ++ks) { const bf16x8 a = *(const bf16x8*)(TL + (mt * 16 + fr) * 72 + ks * 32 + fq * 8);
                acc = __builtin_amdgcn_mfma_f32_16x16x32_bf16(a, bw[ks], acc, 0, 0, 0); }
#pragma unroll
            for (int jj = 0; jj < 4; ++jj) WAo[(mt * 16 + fq * 4 + jj) * 68 + (w & 3) * 16 + fr] = acc[jj]; } }
        __syncthreads();
        float kkv[4], kmv[4], bv[4], lwv[4];
#pragma unroll
        for (int i = 0; i < 4; ++i) { const int tau = w + 8 * i; const int t = z ? (T - 1 - (tb + tau)) : (tb + tau); const int tokg = tok0 + t;
            const float wr_ = w0c + WA[tau * 68 + c], ap = a0c + WA[32 * 68 + tau * 68 + c];
            const float nx = -wr_; const float sp = fmaxf(nx, 0.f) + log1pf(__expf(-fabsf(nx)));
            const float lw = -__expf(-sp - 0.5f);
            const float iclr = 1.f / (1.f + __expf(-ap));
            const float kkraw = kx[i] * kkc;
            const float ssq = wave_sum(kkraw * kkraw);
            const float kk = kkraw / fmaxf(sqrtf(ssq), 1e-12f);
            const float kmod = kx[i] * (1.f + (iclr - 1.f) * kac);
            const float bon = wave_sum(rr[i] * kmod * rkc);
            if (lane == 0) BON[((size_t)z * NTOK + tokg) * 16 + hd] = bon;
            kkv[i] = kk; kmv[i] = kmod; bv[i] = kk * iclr; lwv[i] = lw;
            LW[tau * 64 + c] = lw; }
        __syncthreads();
#pragma unroll
        for (int i = 0; i < 4; ++i) { const int tau = w + 8 * i; const int j = tau & 15, cn = tau >> 4;
            float cum = 0.f;
            for (int q = 0; q <= j; ++q) cum += LW[(cn * 16 + q) * 64 + c];
            const float Pj = __expf(cum), ipj = __expf(-cum), pm1 = __expf(cum - lwv[i]);
            const bf16_t ktv = f2bf(kmv[i] * ipj), btv = f2bf(bv[i] * ipj);
            KTr[tau * 72 + pcol] = ktv; BTr[tau * 72 + pcol] = btv; KKH[tau * 72 + pcol] = f2bf(kkv[i] * pm1); RH[tau * 72 + pcol] = f2bf(rr[i] * Pj);
            const int sU = (j >> 2) * 8 + (j & 3);
            KBm[(cn * 64 + c) * 40 + sU] = f2bf(-bv[i] * ipj); KBm[(cn * 64 + c) * 40 + sU + 4] = ktv;
            VS[tau * 64 + c] = f2bf(vv[i]);
            if (j == 15) PC[cn * 64 + c] = Pj; }
        __syncthreads();
        { const int cn = w >> 2, which = w & 3;
          const bf16_t* Am = ((which & 1) ? KTr : BTr) + cn * 16 * 72; const bf16_t* Bm = ((which & 2) ? RH : KKH) + cn * 16 * 72;
          const f32x4 acc = mma_nt(Am, 72, Bm, 72, 64, (f32x4){0.f, 0.f, 0.f, 0.f}, fr, fq);
#pragma unroll
          for (int jj = 0; jj < 4; ++jj) { const int i = fq * 4 + jj, j = fr; const bool keep = (which & 2) ? (i <= j) : (i < j);
              MM[((cn * 4 + which) * 16 + i) * 16 + j] = keep ? acc[jj] : 0.f; } }
        __syncthreads();
        if (w == 0 && lane < 32) { const int cn = lane >> 4, col = lane & 15;
            const float* Mb = MM + (cn * 4 + 0) * 256; const float* Mk = MM + (cn * 4 + 1) * 256;
            float Tc[16];
#pragma unroll
            for (int i = 15; i >= 0; --i) { float sacc = (i == col) ? 1.f : 0.f;
#pragma unroll
                for (int l = i + 1; l < 16; ++l) sacc -= Mb[i * 16 + l] * Tc[l];
                Tc[i] = sacc; asm volatile("" ::: "memory"); }
#pragma unroll
            for (int i = 0; i < 16; ++i) { float a1 = 0.f;
#pragma unroll
                for (int l = i + 1; l < 16; ++l) a1 += Mk[i * 16 + l] * Tc[l];
                const int sU = (i >> 2) * 8 + (i & 3);
                TA[(cn * 16 + col) * 40 + sU] = f2bf(Tc[i]); TA[(cn * 16 + col) * 40 + sU + 4] = f2bf(a1); asm volatile("" ::: "memory"); } }
        if (w == 1) {
#pragma unroll
            for (int q = 0; q < 8; ++q) { const int idx = q * 64 + lane; const int cn = idx >> 8, i = (idx >> 4) & 15, j = idx & 15; const int sU = (i >> 2) * 8 + (i & 3);
                NA[(cn * 16 + j) * 40 + sU] = f2bf(-MM[((cn * 4 + 2) * 16 + i) * 16 + j]); NA[(cn * 16 + j) * 40 + sU + 4] = f2bf(MM[((cn * 4 + 3) * 16 + i) * 16 + j]); } }
        __syncthreads();
        if (w < 4) {
#pragma unroll
            for (int cn = 0; cn < 2; ++cn) {
                bf16x8 sb[2];
#pragma unroll
                for (int ks = 0; ks < 2; ++ks) sb[ks] = pack8(Sacc[2 * ks][0], Sacc[2 * ks][1], Sacc[2 * ks][2], Sacc[2 * ks][3], Sacc[2 * ks + 1][0], Sacc[2 * ks + 1][1], Sacc[2 * ks + 1][2], Sacc[2 * ks + 1][3]);
                f32x4 U0 = (f32x4){0.f, 0.f, 0.f, 0.f}, O = (f32x4){0.f, 0.f, 0.f, 0.f};
#pragma unroll
                for (int ks = 0; ks < 2; ++ks) { const bf16x8 a = *(const bf16x8*)(KKH + (cn * 16 + fr) * 72 + ks * 32 + fq * 8);
                    U0 = __builtin_amdgcn_mfma_f32_16x16x32_bf16(a, sb[ks], U0, 0, 0, 0);
                    const bf16x8 ar = *(const bf16x8*)(RH + (cn * 16 + fr) * 72 + ks * 32 + fq * 8);
                    O = __builtin_amdgcn_mfma_f32_16x16x32_bf16(ar, sb[ks], O, 0, 0, 0); }
                float vf[4];
#pragma unroll
                for (int e = 0; e < 4; ++e) vf[e] = bf2f(VS[(cn * 16 + fq * 4 + e) * 64 + w * 16 + fr]);
                const bf16x8 bU0 = pack8(U0[0], U0[1], U0[2], U0[3], vf[0], vf[1], vf[2], vf[3]);
                const bf16x8 ta = *(const bf16x8*)(TA + (cn * 16 + fr) * 40 + fq * 8);
                const f32x4 U = __builtin_amdgcn_mfma_f32_16x16x32_bf16(ta, bU0, (f32x4){0.f, 0.f, 0.f, 0.f}, 0, 0, 0);
                const bf16x8 bUV = pack8(U[0], U[1], U[2], U[3], vf[0], vf[1], vf[2], vf[3]);
                const bf16x8 na = *(const bf16x8*)(NA + (cn * 16 + fr) * 40 + fq * 8);
                O = __builtin_amdgcn_mfma_f32_16x16x32_bf16(na, bUV, O, 0, 0, 0);
#pragma unroll
                for (int jj = 0; jj < 4; ++jj) { const int tau = cn * 16 + fq * 4 + jj; const int t = z ? (T - 1 - (tb + tau)) : (tb + tau);
                    OD[((size_t)z * NTOK + tok0 + t) * 1024 + hd * 64 + w * 16 + fr] = f2bf(O[jj]); }
#pragma unroll
                for (int kt = 0; kt < 4; ++kt) { const bf16x8 kb = *(const bf16x8*)(KBm + (cn * 64 + kt * 16 + fr) * 40 + fq * 8);
                    Sacc[kt] = __builtin_amdgcn_mfma_f32_16x16x32_bf16(kb, bUV, Sacc[kt], 0, 0, 0);
                    const f32x4 pc = *(const f32x4*)(PC + cn * 64 + kt * 16 + fq * 4);
                    Sacc[kt] = Sacc[kt] * pc; }
            }
        }
        __syncthreads();
    }
#undef WKV_LOAD_RAW
    if (!sample && w < 4) { float* so = p.out + (size_t)2 * NPTOK * D + ((size_t)((b * 2 + z) * 16 + hd)) * 4096 + (size_t)(w * 16 + fr) * 64;
#pragma unroll
        for (int kt = 0; kt < 4; ++kt)
#pragma unroll
            for (int jj = 0; jj < 4; ++jj) so[kt * 16 + fq * 4 + jj] = Sacc[kt][jj]; }
    __syncthreads();
}

__device__ void conv_tile(const Params& p, int tile) {
    const int tid = threadIdx.x;
    unsigned char* ws = p.ws;
    const bf16_t* P = (const bf16_t*)(ws + WS_P);
    bf16_t* OC = (bf16_t*)(ws + WS_OC);
    const int cgp = tid & 127, c0 = cgp * 8, sub = tid >> 7;
    float cw0[8], cw1[8], cw2[8];
#pragma unroll
    for (int j = 0; j < 8; ++j) { cw0[j] = p.in[12][c0 + j]; cw1[j] = p.in[12][1024 + c0 + j]; cw2[j] = p.in[12][2048 + c0 + j]; }
    for (int jj = 0; jj < 4; ++jj) {
        const int t = tile * 16 + sub + 4 * jj;
        const int rl = t < NPTOK ? 256 : 64; const int pos = t & (rl - 1);
        const bf16_t* row = P + (size_t)t * N0;
        const u32x4 z4 = (u32x4){0u, 0u, 0u, 0u};
        const u32x4 u1 = *(const u32x4*)(row + c0), g1 = *(const u32x4*)(row + 2048 + c0);
        const u32x4 u0 = pos > 0 ? *(const u32x4*)(row - N0 + c0) : z4, g0 = pos > 0 ? *(const u32x4*)(row - N0 + 2048 + c0) : z4;
        const u32x4 u2 = pos < rl - 1 ? *(const u32x4*)(row + N0 + c0) : z4, g2 = pos < rl - 1 ? *(const u32x4*)(row + N0 + 2048 + c0) : z4;
        const u32x4 gb = *(const u32x4*)(row + 1024 + c0), zc = *(const u32x4*)(row + 3072 + c0);
        u32x4 o;
#pragma unroll
        for (int q = 0; q < 4; ++q) {
            const float y0 = cw0[2 * q] * (bflo(g0[q]) * bflo(u0[q])) + cw1[2 * q] * (bflo(g1[q]) * bflo(u1[q])) + cw2[2 * q] * (bflo(g2[q]) * bflo(u2[q]));
            const float y1 = cw0[2 * q + 1] * (bfhi(g0[q]) * bfhi(u0[q])) + cw1[2 * q + 1] * (bfhi(g1[q]) * bfhi(u1[q])) + cw2[2 * q + 1] * (bfhi(g2[q]) * bfhi(u2[q]));
            o[q] = pack2(silu(bflo(zc[q])) * bflo(gb[q]) * y0, silu(bfhi(zc[q])) * bfhi(gb[q]) * y1);
        }
        *(u32x4*)(OC + (size_t)t * 2048 + c0) = o;
    }
}

__device__ void phase_mix0(const Params& p, float* lds, int rep) {
    unsigned* ctr = (unsigned*)(p.ws + WS_CTL) + rep * 32;
    int* slot = (int*)(lds + 32768);
    constexpr int NSCAN = 576, NCONV = 512;
    for (;;) {
        if (threadIdx.x == 0) *slot = (int)atomicAdd(ctr, 1u);
        __syncthreads();
        const int it = *slot;
        __syncthreads();
        if (it >= NSCAN + NCONV) break;
        if (it < NSCAN) wkv_unit(p, it, lds); else conv_tile(p, it - NSCAN);
    }
}

__device__ void phase_wkv_post(const Params& p) {
    const int tid = threadIdx.x, wave = tid >> 6, lane = tid & 63;
    unsigned char* ws = p.ws;
    const bf16_t* P = (const bf16_t*)(ws + WS_P);
    const bf16_t* OD = (const bf16_t*)(ws + WS_X1);
    const float* BON = (const float*)(ws + WS_BON);
    bf16_t* OC = (bf16_t*)(ws + WS_OC);
    for (int tok = blockIdx.x * 8 + wave; tok < NTOK; tok += gridDim.x * 8) {
        const bf16_t* row = P + (size_t)tok * N0;
        for (int hd = 0; hd < 16; ++hd) { const int ch = hd * 64 + lane;
            const float o = bf2f(OD[(size_t)tok * 1024 + ch]) + bf2f(OD[((size_t)NTOK + tok) * 1024 + ch]);
            const float mu = wave_sum(o) * (1.f / 64.f);
            const float dv = o - mu;
            const float var = wave_sum(dv * dv) * (1.f / 64.f);
            const float gn = dv * rsqrtf(var + 64e-5f) * p.in[22][ch] + p.in[23][ch];
            const float bon = BON[(size_t)tok * 16 + hd] + BON[((size_t)NTOK + tok) * 16 + hd];
            const float vv = bf2f(row[6144 + ch]), zw = bf2f(row[7168 + ch]);
            OC[(size_t)tok * 2048 + 1024 + ch] = f2bf((gn + bon * vv) * silu(zw)); }
    }
}

constexpr size_t WS_QE = WS_H;
constexpr size_t WS_KDT = WS_BT0;
constexpr size_t WS_VT = WS_OC + (size_t)NTOK * 1024 * 2;
constexpr size_t WS_EBL = WS_BON + (size_t)2 * NTOK * 16 * 4;

__device__ void gla_a_item(const Params& p, int item, float* ldsf) {
    const int tid = threadIdx.x, lane = tid & 63, w = __builtin_amdgcn_readfirstlane(tid >> 6), fr = lane & 15, fq = lane >> 4;
    unsigned char* ws = p.ws;
    const bf16_t* P1 = (const bf16_t*)(ws + WS_P);
    float* OD = (float*)(ws + WS_P2);
    bf16_t* QEg = (bf16_t*)(ws + WS_QE); bf16_t* KDTg = (bf16_t*)(ws + WS_KDT); bf16_t* VTg = (bf16_t*)(ws + WS_VT); float* EBLg = (float*)(ws + WS_EBL);
    const int hd = item & 3, c = (item >> 2) & 127, z = item >> 9, tok0 = c * 64;
    bf16_t* QE = (bf16_t*)ldsf;
    bf16_t* KE = QE + 64 * 136;
    bf16_t* VT = KE + 64 * 136;
    bf16_t* ATT = VT + 256 * 72;
    float* G = (float*)(ATT + 64 * 72);
    float* L1G = G + 64 * 132;
    float* GK2 = L1G + 1024;
    for (int i = tid; i < 1024; i += NTHR) { const int t = i >> 4, r = i & 15; L1G[i] = bf2f(P1[(size_t)(tok0 + t) * N1 + 3072 + z * 16 + r]); }
    for (int i = tid; i < 2048; i += NTHR) { const int r = i >> 7, d = i & 127; GK2[i] = p.in[27][(size_t)(z * 16 + r) * 512 + hd * 128 + d]; }
#pragma unroll
    for (int ps = 0; ps < 4; ++ps) { const int t = ps * 16 + (tid >> 5), e8 = (tid & 31) * 8;
        const u32x4 v8 = *(const u32x4*)(P1 + (size_t)(tok0 + t) * N1 + 1024 + hd * 256 + e8);
        VT[(e8 + 0) * 72 + t] = (bf16_t)(v8.x & 0xFFFF); VT[(e8 + 1) * 72 + t] = (bf16_t)(v8.x >> 16); VT[(e8 + 2) * 72 + t] = (bf16_t)(v8.y & 0xFFFF); VT[(e8 + 3) * 72 + t] = (bf16_t)(v8.y >> 16);
        VT[(e8 + 4) * 72 + t] = (bf16_t)(v8.z & 0xFFFF); VT[(e8 + 5) * 72 + t] = (bf16_t)(v8.z >> 16); VT[(e8 + 6) * 72 + t] = (bf16_t)(v8.w & 0xFFFF); VT[(e8 + 7) * 72 + t] = (bf16_t)(v8.w >> 16); }
    const int d = tid & 127, tq = tid >> 7;
    const float gbias = p.in[28][z * 512 + hd * 128 + d];
    bf16_t qraw[16], kraw[16];
#pragma unroll
    for (int i = 0; i < 16; ++i) { const size_t row = (size_t)(tok0 + tq * 16 + i) * N1; qraw[i] = P1[row + hd * 128 + d]; kraw[i] = P1[row + 512 + hd * 128 + d]; }
    __syncthreads();
    { float run = 0.f;
#pragma unroll 4
      for (int i = 0; i < 16; ++i) { const int t = z ? (tq * 16 + 15 - i) : (tq * 16 + i);
        float x = gbias;
#pragma unroll
        for (int r = 0; r < 16; ++r) x += L1G[t * 16 + r] * GK2[r * 128 + d];
        const float ls = fminf(x, 0.f) - __logf(1.f + __expf(-fabsf(x)));
        run += ls * (1.f / 16.f);
        G[t * 132 + d] = run; } }
    __syncthreads();
    { const int lastr = z ? 0 : 15;
      const float t0 = G[(0 + lastr) * 132 + d], t1 = G[(16 + lastr) * 132 + d], t2 = G[(32 + lastr) * 132 + d], t3 = G[(48 + lastr) * 132 + d];
      const float blast = t0 + t1 + t2 + t3;
      float off;
      if (z == 0) off = tq == 0 ? 0.f : (tq == 1 ? t0 : (tq == 2 ? t0 + t1 : t0 + t1 + t2));
      else off = tq == 3 ? 0.f : (tq == 2 ? t3 : (tq == 1 ? t3 + t2 : t3 + t2 + t1));
      if (tq == 0) EBLg[(size_t)(z * 128 + c) * 512 + hd * 128 + d] = __expf(blast);
      unsigned kdp[8];
#pragma unroll
      for (int i = 0; i < 16; ++i) { const int t = tq * 16 + i;
        const float bc = G[t * 132 + d] + off;
        const float q = bf2f(qraw[i]) * 0.08838834764831845f, k = bf2f(kraw[i]);
        const bf16_t qe = f2bf(q * __expf(bc));
        QE[t * 136 + d] = qe; KE[t * 136 + d] = f2bf(k * __expf(-bc));
        QEg[((size_t)z * NTOK + tok0 + t) * 512 + hd * 128 + d] = qe;
        const unsigned kd = (unsigned)f2bf(k * __expf(blast - bc));
        if (i & 1) kdp[i >> 1] |= kd << 16; else kdp[i >> 1] = kd; }
      bf16_t* kdst = KDTg + ((size_t)(((z * 128 + c) * 4 + hd) * 128 + d)) * 64 + tq * 16;
      *(u32x4*)kdst = (u32x4){kdp[0], kdp[1], kdp[2], kdp[3]}; *(u32x4*)(kdst + 8) = (u32x4){kdp[4], kdp[5], kdp[6], kdp[7]}; }
    __syncthreads();
    if (z == 0) {
#pragma unroll
        for (int q4 = 0; q4 < 4; ++q4) { const int idx = q4 * NTHR + tid; const int e = idx >> 3, t8 = (idx & 7) * 8;
            *(u32x4*)(VTg + ((size_t)((c * 4 + hd) * 256 + e)) * 64 + t8) = *(const u32x4*)(VT + e * 72 + t8); } }
#pragma unroll
    for (int q2 = 0; q2 < 2; ++q2) { const int tA = 2 * w + q2, ia = tA >> 2, ja = tA & 3;
        f32x4 a4 = (f32x4){0.f, 0.f, 0.f, 0.f};
        if (z ? (ja >= ia) : (ja <= ia)) a4 = mma_nt(QE + ia * 16 * 136, 136, KE + ja * 16 * 136, 136, 128, a4, fr, fq);
#pragma unroll
        for (int jj = 0; jj < 4; ++jj) { const int i = ia * 16 + fq * 4 + jj, j = ja * 16 + fr; const bool keep = z ? (j >= i) : (j <= i); ATT[i * 72 + j] = f2bf(keep ? a4[jj] : 0.f); } }
    __syncthreads();
    { const int it = w & 3, eg = w >> 2;
#pragma unroll
      for (int e8 = 0; e8 < 8; ++e8) { const int et = eg * 8 + e8;
        const f32x4 o = mma_nt(ATT + it * 16 * 72, 72, VT + et * 16 * 72, 72, 64, (f32x4){0.f, 0.f, 0.f, 0.f}, fr, fq);
#pragma unroll
        for (int jj = 0; jj < 4; ++jj) OD[((size_t)z * NTOK + tok0 + it * 16 + fq * 4 + jj) * 1024 + hd * 256 + et * 16 + fr] = o[jj]; } }
    __syncthreads();
}

__device__ void phase_gla_a(const Params& p, float* lds) {
    for (int it = blockIdx.x; it < 1024; it += gridDim.x) gla_a_item(p, it, lds);
}

struct GlaFrags { bf16x8 kdt[2]; bf16x8 vt[4][2]; bf16x8 qe[4]; f32x4 ebl; f32x4 od[2]; };

__device__ void gla_b_unit(const Params& p, int u, float* ldsf) {
    const int tid = threadIdx.x, lane = tid & 63, w = __builtin_amdgcn_readfirstlane(tid >> 6), fr = lane & 15, fq = lane >> 4;
    unsigned char* ws = p.ws;
    float* OD = (float*)(ws + WS_P2);
    const bf16_t* QEg = (const bf16_t*)(ws + WS_QE); const bf16_t* KDTg = (const bf16_t*)(ws + WS_KDT); const bf16_t* VTg = (const bf16_t*)(ws + WS_VT); const float* EBLg = (const float*)(ws + WS_EBL);
    int z, b, hd, eq, nch, ch0; bool sample;
    if (u < 64) { sample = true; z = u >> 5; b = (u >> 4) & 1; hd = (u >> 2) & 3; eq = u & 3; nch = 32; ch0 = 64 + b * 32; }
    else { const int q = u - 64; sample = false; z = q >> 8; b = (q >> 4) & 15; hd = (q >> 2) & 3; eq = q & 3; nch = 4; ch0 = b * 4; }
    bf16_t* ST = (bf16_t*)ldsf;
    f32x4 Sacc[4];
    if (sample) { const float* s0 = p.in[3] + ((size_t)((b * 2 + z) * 4 + hd)) * 32768 + eq * 64 + fr;
#pragma unroll
        for (int et = 0; et < 4; ++et)
#pragma unroll
            for (int jj = 0; jj < 4; ++jj) Sacc[et][jj] = s0[(size_t)(w * 16 + fq * 4 + jj) * 256 + et * 16]; }
    else {
#pragma unroll
        for (int et = 0; et < 4; ++et) Sacc[et] = (f32x4){0.f, 0.f, 0.f, 0.f}; }
    const int it = w >> 1, e2 = (w & 1) * 2;
#define GLA_LOAD(F, c_) do { const int cc_ = (c_); \
        _Pragma("unroll") for (int ks = 0; ks < 2; ++ks) { (F).kdt[ks] = *(const bf16x8*)(KDTg + ((size_t)(((z * 128 + cc_) * 4 + hd) * 128 + w * 16 + fr)) * 64 + ks * 32 + fq * 8); \
            _Pragma("unroll") for (int et = 0; et < 4; ++et) (F).vt[et][ks] = *(const bf16x8*)(VTg + ((size_t)((cc_ * 4 + hd) * 256 + eq * 64 + et * 16 + fr)) * 64 + ks * 32 + fq * 8); } \
        _Pragma("unroll") for (int ks = 0; ks < 4; ++ks) (F).qe[ks] = *(const bf16x8*)(QEg + ((size_t)z * NTOK + cc_ * 64 + it * 16 + fr) * 512 + hd * 128 + ks * 32 + fq * 8); \
        (F).ebl = *(const f32x4*)(EBLg + (size_t)(z * 128 + cc_) * 512 + hd * 128 + w * 16 + fq * 4); \
        _Pragma("unroll") for (int q2 = 0; q2 < 2; ++q2) _Pragma("unroll") for (int jj = 0; jj < 4; ++jj) \
            (F).od[q2][jj] = OD[((size_t)z * NTOK + cc_ * 64 + it * 16 + fq * 4 + jj) * 1024 + hd * 256 + eq * 64 + (e2 + q2) * 16 + fr]; } while (0)
    GlaFrags cur, nxt;
    GLA_LOAD(cur, ch0 + (z ? nch - 1 : 0));
    __syncthreads();
#pragma unroll 1
    for (int ci = 0; ci < nch; ++ci) {
        const int c = ch0 + (z ? nch - 1 - ci : ci);
        bf16_t* STc = ST + (ci & 1) * 64 * 136;
#pragma unroll
        for (int et = 0; et < 4; ++et) { u32x2 v2; v2.x = pack2(Sacc[et][0], Sacc[et][1]); v2.y = pack2(Sacc[et][2], Sacc[et][3]);
            *(u32x2*)(STc + (et * 16 + fr) * 136 + w * 16 + fq * 4) = v2; }
        if (ci + 1 < nch) GLA_LOAD(nxt, ch0 + (z ? nch - 2 - ci : ci + 1));
        __syncthreads();
#pragma unroll
        for (int et = 0; et < 4; ++et) { Sacc[et] = Sacc[et] * cur.ebl;
#pragma unroll
            for (int ks = 0; ks < 2; ++ks) Sacc[et] = __builtin_amdgcn_mfma_f32_16x16x32_bf16(cur.kdt[ks], cur.vt[et][ks], Sacc[et], 0, 0, 0); }
#pragma unroll
        for (int q2 = 0; q2 < 2; ++q2) { f32x4 o = cur.od[q2];
#pragma unroll
            for (int ks = 0; ks < 4; ++ks) { const bf16x8 bS = *(const bf16x8*)(STc + ((e2 + q2) * 16 + fr) * 136 + ks * 32 + fq * 8);
                o = __builtin_amdgcn_mfma_f32_16x16x32_bf16(cur.qe[ks], bS, o, 0, 0, 0); }
#pragma unroll
            for (int jj = 0; jj < 4; ++jj) OD[((size_t)z * NTOK + c * 64 + it * 16 + fq * 4 + jj) * 1024 + hd * 256 + eq * 64 + (e2 + q2) * 16 + fr] = o[jj]; }
        cur = nxt;
    }
#undef GLA_LOAD
    if (!sample) { float* so = p.out + (size_t)2 * NPTOK * D + 2097152 + ((size_t)((b * 2 + z) * 4 + hd)) * 32768 + eq * 64 + fr;
#pragma unroll
        for (int et = 0; et < 4; ++et)
#pragma unroll
            for (int jj = 0; jj < 4; ++jj) so[(size_t)(w * 16 + fq * 4 + jj) * 256 + et * 16] = Sacc[et][jj]; }
    __syncthreads();
}

__device__ void phase_gla_b(const Params& p, float* lds, int rep) {
    unsigned* ctr = (unsigned*)(p.ws + WS_CTL) + 16 + rep * 32;
    int* slot = (int*)(lds + 32768);
    for (;;) {
        if (threadIdx.x == 0) *slot = (int)atomicAdd(ctr, 1u);
        __syncthreads();
        const int it = *slot;
        __syncthreads();
        if (it >= 576) break;
        gla_b_unit(p, it, lds);
    }
}

__device__ void phase_gla_post(const Params& p) {
    const int tid = threadIdx.x, wave = tid >> 6, lane = tid & 63;
    unsigned char* ws = p.ws;
    const bf16_t* P1 = (const bf16_t*)(ws + WS_P);
    const float* OD = (const float*)(ws + WS_P2);
    bf16_t* OG = (bf16_t*)(ws + WS_OC);
    for (int tok = blockIdx.x * 8 + wave; tok < NTOK; tok += gridDim.x * 8) {
        for (int hd = 0; hd < 4; ++hd) { const int idx = hd * 256 + lane * 4;
            const f32x4 a = *(const f32x4*)(OD + (size_t)tok * 1024 + idx), b2 = *(const f32x4*)(OD + ((size_t)NTOK + tok) * 1024 + idx);
            const f32x4 o = a + b2;
            const float ss = wave_sum(o[0] * o[0] + o[1] * o[1] + o[2] * o[2] + o[3] * o[3]);
            const float rs = rsqrtf(ss * (1.f / 256.f) + 1e-6f);
            const f32x4 gn = *(const f32x4*)(p.in[29] + lane * 4);
            const u32x2 zz = *(const u32x2*)(P1 + (size_t)tok * N1 + 2048 + idx);
            const float z0 = bflo(zz.x), z1 = bfhi(zz.x), z2 = bflo(zz.y), z3 = bfhi(zz.y);
            u32x2 w; w.x = pack2(o[0] * rs * gn[0] * silu(z0), o[1] * rs * gn[1] * silu(z1)); w.y = pack2(o[2] * rs * gn[2] * silu(z2), o[3] * rs * gn[3] * silu(z3));
            *(u32x2*)(OG + (size_t)tok * 1024 + idx) = w; }
    }
}

__device__ void phase_final(const Params& p) {
    const int tid = threadIdx.x, wave = tid >> 6, lane = tid & 63;
    unsigned char* ws = p.ws;
    const float* MOD = (const float*)(ws + WS_MOD);
    const float* X1 = (const float*)(ws + WS_X1);
    const float* Y = (const float*)(ws + WS_P2);
    for (int tok = blockIdx.x * 8 + wave; tok < NTOK; tok += gridDim.x * 8) {
        const int cond = tok < NPTOK ? 0 : 1 + ((tok - NPTOK) >> 11);
        f32x4 xv[4]; float ss = 0.f;
#pragma unroll
        for (int i = 0; i < 4; ++i) { const int idx = i * 256 + lane * 4;
            const f32x4 x1 = *(const f32x4*)(X1 + (size_t)tok * D + idx);
            const f32x4 ya = *(const f32x4*)(Y + (size_t)tok * D + idx), yb = *(const f32x4*)(Y + (size_t)NTOK * D + (size_t)tok * D + idx);
            const f32x4 gt = *(const f32x4*)(MOD + (1 * 3 + cond) * 3072 + 2048 + idx);
            xv[i] = x1 + gt * (ya + yb);
            ss += xv[i][0] * xv[i][0] + xv[i][1] * xv[i][1] + xv[i][2] * xv[i][2] + xv[i][3] * xv[i][3]; }
        ss = wave_sum(ss);
        const float rstd = rsqrtf(ss * (1.f / 1024.f) + 1e-6f);
#pragma unroll
        for (int i = 0; i < 4; ++i) { const int idx = i * 256 + lane * 4;
            const f32x4 g = *(const f32x4*)(p.in[9] + idx);
            f32x4 o;
#pragma unroll
            for (int j = 0; j < 4; ++j) o[j] = xv[i][j] * rstd * g[j];
            *(f32x4*)(p.out + (size_t)tok * D + idx) = o; }
    }
}


#define XB_TMO      128
#define XB_XCNT(j)  (256  + 64 * (j))
#define XB_XSUB(j)  (1280 + 64 * (j))
#define XB_XGEN(j)  (2304 + 64 * (j))
#define XB_TOP      3328
#define XB_TOPGEN   3392
#define XCD_BAR_WORDS 3456
#define XB_SPIN_CAP (1u << 18)

__device__ __forceinline__ unsigned xb_ld(unsigned* p)              { return __hip_atomic_load(p, __ATOMIC_RELAXED, __HIP_MEMORY_SCOPE_AGENT); }
__device__ __forceinline__ unsigned xb_add(unsigned* p, unsigned v) { return __hip_atomic_fetch_add(p, v, __ATOMIC_RELAXED, __HIP_MEMORY_SCOPE_AGENT); }
__device__ __forceinline__ unsigned xb_xcc_id() { return (unsigned)__builtin_amdgcn_s_getreg((3 << 11) | 20) & 0xFu; }
#define XB_SPIN(cond, bar) do { unsigned _sp = 0; while (cond) { __builtin_amdgcn_s_sleep(1); \
    if ((++_sp & 255u) == 0u) { if (xb_ld(&(bar)[XB_TMO])) break; if (_sp > XB_SPIN_CAP) { atomicAdd(&(bar)[XB_TMO], 1u); break; } } } } while (0)

struct XcdBarrier {
    unsigned* bar; unsigned x;
    volatile LAS unsigned* st;
};

__device__ __forceinline__ XcdBarrier xcd_barrier_post(unsigned* bar, volatile LAS unsigned* st) {
    XcdBarrier b; b.bar = bar; b.x = xb_xcc_id(); b.st = st;
    if (threadIdx.x == 0) (void)xb_add(&bar[XB_XCNT(b.x)], 1u);
    return b;
}
__device__ __forceinline__ void xcd_barrier_complete(unsigned* bar, unsigned x, unsigned& nloc, unsigned& nx) {
    const unsigned G = gridDim.x * gridDim.y * gridDim.z;
    unsigned sum, cnt, mine, sp = 0u;
    for (;;) {
        sum = 0u; cnt = 0u; mine = 0u;
#pragma unroll
        for (unsigned j = 0; j < 16; ++j) { const unsigned c = xb_ld(&bar[XB_XCNT(j)]); sum += c; cnt += (c > 0u) ? 1u : 0u; mine = (j == x) ? c : mine; }
        if (sum == G) break;
        __builtin_amdgcn_s_sleep(1);
        if ((++sp & 255u) == 0u) { if (xb_ld(&bar[XB_TMO])) break; if (sp > XB_SPIN_CAP) { atomicAdd(&bar[XB_TMO], 1u); break; } }
    }
    nloc = mine > 0u ? mine : 1u; nx = cnt > 0u ? cnt : 1u;
}

__device__ __forceinline__ void xcd_barrier(const XcdBarrier& b) {
    asm volatile("s_waitcnt vmcnt(0)" ::: "memory");
    __syncthreads();
    if (threadIdx.x == 0) {
        unsigned* bar = b.bar;
        __builtin_amdgcn_s_waitcnt(0);
        unsigned nloc = b.st[0], nx = b.st[1];
        if (nloc == 0u) { xcd_barrier_complete(bar, b.x, nloc, nx); b.st[0] = nloc; b.st[1] = nx; }
        const unsigned old = xb_add(&bar[XB_XSUB(b.x)], 1u);
        const unsigned gen = old / nloc;
        if (old + 1u == (gen + 1u) * nloc) {
            __builtin_amdgcn_fence(__ATOMIC_RELEASE, "agent");
            asm volatile("s_waitcnt vmcnt(0)" ::: "memory");
            const unsigned og = xb_add(&bar[XB_TOP], 1u);
            const unsigned tg = og / nx;
            if (og + 1u == (tg + 1u) * nx) xb_add(&bar[XB_TOPGEN], 1u);
            else XB_SPIN(xb_ld(&bar[XB_TOPGEN]) == tg, bar);
            __builtin_amdgcn_fence(__ATOMIC_ACQUIRE, "agent");
            xb_add(&bar[XB_XGEN(b.x)], 1u);
            asm volatile("s_waitcnt vmcnt(0)" ::: "memory");
        } else {
            XB_SPIN(xb_ld(&bar[XB_XGEN(b.x)]) == gen, bar);
            __builtin_amdgcn_fence(__ATOMIC_ACQUIRE, "agent");
            asm volatile("s_waitcnt vmcnt(0)" ::: "memory");
        }
    }
    __syncthreads();
}


constexpr int NPHASE = 13;
__global__ void __launch_bounds__(NTHR, 2) fwd_megakernel(Params p) {
    extern __shared__ __attribute__((aligned(16))) unsigned char smem[];
    float* ldsf = (float*)smem;
    LAS unsigned char* ldsl = (LAS unsigned char*)smem;
    unsigned char* ws = p.ws;
    volatile LAS unsigned* xst = (volatile LAS unsigned*)(ldsl + 131072 + 16);
    if (threadIdx.x == 0) { xst[0] = 0u; xst[1] = 0u; }
    __syncthreads();
    const XcdBarrier xbar = xcd_barrier_post((unsigned*)(ws + WS_BAR), xst);
    if (p.ph_lo < 0) cg::this_grid().sync();
#ifndef DUP_PHASE
#define DUP_PHASE -1
#endif
#define PHASE(n) if (p.ph_lo <= (n) && (n) < p.ph_hi && ((n) == p.ph_lo || (xcd_barrier(xbar), true))) for (int rep = 0; rep < ((n) == DUP_PHASE ? 2 : 1); ++rep, ((n) == DUP_PHASE ? (xcd_barrier(xbar), 0) : 0))
    PHASE(0) phase_prologue(p, ldsf);
    PHASE(1) phase_h(p, 0);
    PHASE(2) { pg8::Gemm g{(const bf16_t*)(ws + WS_H), (const bf16_t*)(ws + WS_BT0), NTOK, N0, 1024, 1024, 1}; pg8::Order S; S.init(NTOK, N0, 1, gridDim.x, blockIdx.x);
               pg8::EpiBf16 E{(bf16_t*)(ws + WS_P), N0}; pg8::gemm_phase(ldsl, g, S, E); }
    PHASE(3) phase_mix0(p, ldsf, rep);
    PHASE(4) phase_wkv_post(p);
    PHASE(5) { pg8::Gemm g{(const bf16_t*)(ws + WS_OC), (const bf16_t*)(ws + WS_WT0O), NTOK, 1024, 1024, 2048, 2}; pg8::Order S; S.init(NTOK, 1024, 2, gridDim.x, blockIdx.x);
               pg8::EpiF32 E{(float*)(ws + WS_P), 1024, (size_t)NTOK * 1024}; pg8::gemm_phase(ldsl, g, S, E); }
    PHASE(6) phase_h(p, 1);
    PHASE(7) { pg8::Gemm g{(const bf16_t*)(ws + WS_H), (const bf16_t*)(ws + WS_BT1), NTOK, N1, 1024, 1024, 1}; pg8::Order S; S.init(NTOK, N1, 1, gridDim.x, blockIdx.x);
               pg8::EpiBf16 E{(bf16_t*)(ws + WS_P), N1}; pg8::gemm_phase(ldsl, g, S, E); }
    PHASE(8) phase_gla_a(p, ldsf);
    PHASE(9) phase_gla_b(p, ldsf, rep);
    PHASE(10) phase_gla_post(p);
    PHASE(11) { pg8::Gemm g{(const bf16_t*)(ws + WS_OC), (const bf16_t*)(ws + WS_WT1O), NTOK, 1024, 512, 1024, 2}; pg8::Order S; S.init(NTOK, 1024, 2, gridDim.x, blockIdx.x);
                pg8::EpiF32 E{(float*)(ws + WS_P2), 1024, (size_t)NTOK * 1024}; pg8::gemm_phase(ldsl, g, S, E); }
    PHASE(12) phase_final(p);
}

extern "C" void kernel_launch(void* const* d_in, const int* in_sizes, int n_in, void* d_out, int out_size, void* d_ws, size_t ws_size, hipStream_t stream) {
    static int grid = 0;
    if (grid == 0) {
        if (n_in != 30 || ws_size < WS_END) { fprintf(stderr, "kernel_launch: unexpected n_in %d / ws_size %zu (need %zu)\n", n_in, ws_size, (size_t)WS_END); grid = -1; return; }
        int dev = 0, cus = 0, per_cu = 0;
        hipGetDevice(&dev);
        hipDeviceGetAttribute(&cus, hipDeviceAttributeMultiprocessorCount, dev);
        hipFuncSetAttribute((const void*)fwd_megakernel, hipFuncAttributeMaxDynamicSharedMemorySize, LDS_BYTES);
        hipOccupancyMaxActiveBlocksPerMultiprocessor(&per_cu, (const void*)fwd_megakernel, NTHR, LDS_BYTES);
        if (per_cu < 1) { fprintf(stderr, "kernel_launch: occupancy query returned %d\n", per_cu); per_cu = 1; }
        grid = cus * per_cu;
        (void)hipGetLastError();
    }
    if (grid < 0) return;
    hipMemsetAsync((char*)d_ws + WS_CTL, 0, 256, stream);
    hipMemsetAsync((char*)d_ws + WS_BAR, 0, XCD_BAR_WORDS * 4, stream);
    Params p{};
    for (int i = 0; i < 30; ++i) p.in[i] = (const float*)d_in[i];
    p.out = (float*)d_out; p.ws = (unsigned char*)d_ws;
#if MULTI_LAUNCH
    for (int ph = 0; ph < NPHASE; ++ph) { p.ph_lo = ph; p.ph_hi = ph + 1; hipLaunchKernelGGL(fwd_megakernel, dim3(grid), dim3(NTHR), LDS_BYTES, stream, p); }
#else
    p.ph_lo = 0; p.ph_hi = NPHASE;
    void* args[] = {&p};
    hipError_t e = hipLaunchCooperativeKernel((const void*)fwd_megakernel, dim3(grid), dim3(NTHR), args, LDS_BYTES, stream);
    if (e != hipSuccess) fprintf(stderr, "cooperative launch failed: %s (grid %d)\n", hipGetErrorString(e), grid);
#endif
}
```

```cpp
#include <hip/hip_runtime.h>
#include <hip/hip_cooperative_groups.h>
#include <cstdio>
namespace cg = cooperative_groups;

#define LAS __attribute__((address_space(3)))
typedef unsigned short bf16_t;
typedef short bf16x8 __attribute__((ext_vector_type(8)));
typedef float f32x4 __attribute__((ext_vector_type(4)));
typedef unsigned u32x4 __attribute__((ext_vector_type(4)));
typedef unsigned u32x2 __attribute__((ext_vector_type(2)));

#ifndef MULTI_LAUNCH
#define MULTI_LAUNCH 0
#endif

constexpr int D = 1024, NTOK = 8192, NPTOK = 4096;
constexpr int N0 = 8448;
constexpr int N1 = 3328;
constexpr int NTHR = 512;
constexpr int LDS_MAIN = 139264;
constexpr int LDS_BYTES = LDS_MAIN + 256;

constexpr size_t MB = 1024 * 1024;
constexpr size_t WS_CTL = 0;
constexpr size_t WS_MOD = 4096;
constexpr size_t WS_BON = WS_MOD + 2 * 3 * 3072 * 4;
constexpr size_t WS_BAR = 0x1A0000;
constexpr size_t WS_BT0 = 2 * MB;
constexpr size_t WS_WT0O = WS_BT0 + (size_t)N0 * 1024 * 2;
constexpr size_t WS_BT1 = WS_WT0O + (size_t)1024 * 2048 * 2;
constexpr size_t WS_WT1O = WS_BT1 + (size_t)N1 * 1024 * 2;
constexpr size_t WS_H = WS_WT1O + (size_t)1024 * 1024 * 2;
constexpr size_t WS_OC = WS_H + (size_t)NTOK * 1024 * 2;
constexpr size_t WS_X1 = WS_OC + (size_t)NTOK * 2048 * 2;
constexpr size_t WS_P = WS_X1 + (size_t)NTOK * 1024 * 4;
constexpr size_t WS_P2 = WS_P + 64 * MB;
constexpr size_t WS_END = WS_P + (size_t)NTOK * N0 * 2;

struct Params {
    const float* in[30];
    float* out;
    unsigned char* ws;
    int ph_lo, ph_hi;
};

__device__ __forceinline__ float bf2f(bf16_t h) { return __uint_as_float(((unsigned)h) << 16); }
__device__ __forceinline__ bf16_t f2bf(float f) { unsigned u = __float_as_uint(f); u += 0x7FFFu + ((u >> 16) & 1u); return (bf16_t)(u >> 16); }
__device__ __forceinline__ unsigned pack2(float lo, float hi) { return (unsigned)f2bf(lo) | ((unsigned)f2bf(hi) << 16); }
__device__ __forceinline__ float bflo(unsigned w) { return __uint_as_float(w << 16); }
__device__ __forceinline__ float bfhi(unsigned w) { return __uint_as_float(w & 0xFFFF0000u); }
__device__ __forceinline__ float silu(float x) { return x / (1.f + __expf(-x)); }
__device__ __forceinline__ float wave_sum(float v) {
#pragma unroll
    for (int m = 32; m >= 1; m >>= 1) v += __shfl_xor(v, m, 64);
    return v;
}

namespace pg8 {
constexpr int BM = 256, BK = 64, HALF = 128, HTB = HALF * BK * 2, NXCD = 8, WGM = 8;
__device__ __forceinline__ int lds_byte(int r, int c) { const int st = (r >> 4) * 2 + (c >> 5), rr = r & 15, cc = c & 31, ob = rr * 64 + cc * 2; return st * 1024 + (ob ^ (((ob >> 9) & 1) << 5)); }
__device__ __forceinline__ void stage_rc(int b, int& R, int& C) { const int st = b / 1024, sb = b % 1024, swz = sb ^ (((sb >> 9) & 1) << 5); R = (st >> 1) * 16 + swz / 64; C = (st & 1) * 32 + (swz % 64) / 2; }
__device__ __forceinline__ int perm32(int rho) { const int n = rho >> 4, i = rho & 15; return 8 * (i >> 2) + 4 * n + (i & 3); }

struct Unit { int pm, pn, ks; };
struct Gemm { const bf16_t* A; const bf16_t* Bt; int M, N, K, ld, KS; };

struct Order {
    int nM, nN, nNr, nwg, G, c;
    __device__ void init(int M, int N, int KS, int G_, int c_) { nM = M / BM; nNr = N / BM; nN = nNr * KS; nwg = nM * nN; G = G_; c = c_; }
    __device__ bool next(int i, Unit& u) const {
        const long L = (long)i * G + c; if (L >= nwg) return false;
        int wgid = (int)L; { const int q = nwg / NXCD, r = nwg % NXCD, xcd = wgid % NXCD, off = wgid / NXCD; wgid = (xcd < r ? xcd * (q + 1) : r * (q + 1) + (xcd - r) * q) + off; }
        const int nig = WGM * nN, gid = wgid / nig, fm = gid * WGM, gsz = (nM - fm) < WGM ? (nM - fm) : WGM;
        u.pm = fm + ((wgid % nig) % gsz); const int pn = (wgid % nig) / gsz; u.pn = pn % nNr; u.ks = pn / nNr; return true;
    }
};

__device__ __forceinline__ unsigned cvt_pk_bf16(float lo, float hi) { unsigned r; asm volatile("v_cvt_pk_bf16_f32 %0, %1, %2" : "=v"(r) : "v"(lo), "v"(hi)); return r; }

struct EpiF32 {
    static constexpr bool PERM = false;
    float* C; int ldc; size_t ks_stride;
    __device__ __forceinline__ void operator()(const f32x4 (&acc)[2][2][4][2], const Unit& u, int wr, int wc, int fr, int fq) const {
        const int row0 = u.pm * BM + wr * 64 + fr, col0 = u.pn * BM + wc * 32 + 4 * fq;
        float* Cb = C + (size_t)u.ks * ks_stride;
#pragma unroll
        for (int ai = 0; ai < 2; ++ai)
#pragma unroll
            for (int m = 0; m < 4; ++m) { float* rowp = Cb + (size_t)(row0 + ai * HALF + m * 16) * ldc + col0;
#pragma unroll
                for (int bj = 0; bj < 2; ++bj)
#pragma unroll
                    for (int n = 0; n < 2; ++n) *(f32x4*)(rowp + bj * HALF + n * 16) = acc[ai][bj][m][n]; }
    }
};
struct EpiBf16 {
    static constexpr bool PERM = true;
    bf16_t* O; int ldc;
    __device__ __forceinline__ void operator()(const f32x4 (&acc)[2][2][4][2], const Unit& u, int wr, int wc, int fr, int fq) const {
        const int row0 = u.pm * BM + wr * 64 + fr; const int col0 = u.pn * BM + wc * 32 + 8 * fq;
#pragma unroll
        for (int ai = 0; ai < 2; ++ai)
#pragma unroll
            for (int m = 0; m < 4; ++m) { bf16_t* rowp = O + (size_t)(row0 + ai * HALF + m * 16) * ldc + col0;
#pragma unroll
                for (int bj = 0; bj < 2; ++bj) { const f32x4 v0 = acc[ai][bj][m][0], v1 = acc[ai][bj][m][1];
                    u32x4 w; w.x = cvt_pk_bf16(v0[0], v0[1]); w.y = cvt_pk_bf16(v0[2], v0[3]); w.z = cvt_pk_bf16(v1[0], v1[1]); w.w = cvt_pk_bf16(v1[2], v1[3]);
                    *(u32x4*)(rowp + bj * HALF) = w; } }
    }
};

template <class Epi>
__device__ __forceinline__ void gemm_phase(LAS unsigned char* lds, const Gemm g, const Order& S, const Epi& E) {
    const int tid = threadIdx.x, wid = __builtin_amdgcn_readfirstlane(tid >> 6), lane = tid & 63, wr = wid >> 2, wc = wid & 3, fr = lane & 15, fq = lane >> 4;
    const int K = g.K, nt = K / BK, ld = g.ld;
    unsigned voffA[2], voffB[2];
#pragma unroll
    for (int i = 0; i < 2; ++i) { int R, C; stage_rc(tid * 16 + i * 8192, R, C); const int Rb = Epi::PERM ? ((R & ~31) + perm32(R & 31)) : R;
        voffA[i] = (unsigned)(R * ld + C) * 2u; voffB[i] = (unsigned)(Rb * ld + C) * 2u; }
    const size_t kstep = (size_t)(BK * 2);
    const size_t hstep = (size_t)HALF * ld * 2;
    const size_t tstep = 2 * hstep;
    const size_t ksb = (size_t)K * 2;
    const unsigned ldsw = (unsigned)wid * 1024u;
    const int aoff = lds_byte(wr * 64 + fr, fq * 8), boff = lds_byte(wc * 32 + fr, fq * 8);
#define PG8_SA(b, h) (((b) * 2 + (h)) * HTB)
#define PG8_SB(b, h) ((4 + (b) * 2 + (h)) * HTB)
#define PG8_STAGE(bufoff, gbase, voff) do { _Pragma("unroll") for (int _i = 0; _i < 2; ++_i) \
        __builtin_amdgcn_global_load_lds((const unsigned*)((const char*)(gbase) + (voff)[_i]), (LAS unsigned*)(lds + (bufoff) + ldsw + _i * 8192), 16, 0, 0); } while (0)
#define PG8_LDA(dst, b, h) do { _Pragma("unroll") for (int m = 0; m < 4; ++m) _Pragma("unroll") for (int k = 0; k < 2; ++k) dst[m][k] = *(const LAS bf16x8*)(lds + PG8_SA(b, h) + aoff + m * 2048 + k * 1024); } while (0)
#define PG8_LDB(dst, b, h) do { _Pragma("unroll") for (int n = 0; n < 2; ++n) _Pragma("unroll") for (int k = 0; k < 2; ++k) dst[n][k] = *(const LAS bf16x8*)(lds + PG8_SB(b, h) + boff + n * 2048 + k * 1024); } while (0)
#define PG8_MMA(ai, bj, At, Bt) do { __builtin_amdgcn_s_setprio(1); _Pragma("unroll") for (int m = 0; m < 4; ++m) _Pragma("unroll") for (int n = 0; n < 2; ++n) _Pragma("unroll") for (int k = 0; k < 2; ++k) \
        acc[ai][bj][m][n] = __builtin_amdgcn_mfma_f32_16x16x32_bf16(Bt[n][k], At[m][k], acc[ai][bj][m][n], 0, 0, 0); __builtin_amdgcn_s_setprio(0); } while (0)
#define PG8_WAIT_V(n) asm volatile("s_waitcnt vmcnt(" #n ")" ::: "memory")
#define PG8_WAIT_L(n) asm volatile("s_waitcnt lgkmcnt(" #n ")" ::: "memory")
#define PG8_BAR __builtin_amdgcn_s_barrier()
#define PG8_SCHED __builtin_amdgcn_sched_barrier(0)
    Unit cur, nxt; int ui = 0;
    if (!S.next(0, cur)) return;
    f32x4 acc[2][2][4][2];
#pragma unroll
    for (int a = 0; a < 2; ++a)
#pragma unroll
        for (int b = 0; b < 2; ++b)
#pragma unroll
            for (int m = 0; m < 4; ++m)
#pragma unroll
                for (int n = 0; n < 2; ++n) acc[a][b][m][n] = (f32x4){0.f, 0.f, 0.f, 0.f};
    bf16x8 At[4][2], B0[2][2], B1[2][2];
    const char* cA = (const char*)g.A + (size_t)cur.pm * tstep + (size_t)cur.ks * ksb; const char* cB = (const char*)g.Bt + (size_t)cur.pn * tstep + (size_t)cur.ks * ksb;
    PG8_STAGE(PG8_SB(0, 0), cB, voffB); PG8_STAGE(PG8_SA(0, 0), cA, voffA); PG8_STAGE(PG8_SB(0, 1), cB + hstep, voffB); PG8_STAGE(PG8_SA(0, 1), cA + hstep, voffA);
    if (wr == 1) PG8_BAR;
    PG8_WAIT_V(4); PG8_BAR;
    PG8_STAGE(PG8_SB(1, 0), cB + kstep, voffB); PG8_STAGE(PG8_SA(1, 0), cA + kstep, voffA); PG8_STAGE(PG8_SB(1, 1), cB + hstep + kstep, voffB);
    PG8_WAIT_V(6); PG8_BAR;
    for (;;) {
        const bool has_next = S.next(ui + 1, nxt);
        const char* nA = has_next ? (const char*)g.A + (size_t)nxt.pm * tstep + (size_t)nxt.ks * ksb : cA; const char* nB = has_next ? (const char*)g.Bt + (size_t)nxt.pn * tstep + (size_t)nxt.ks * ksb : cB;
        for (int t = 0; t < nt; t += 2) {
            const bool last = (t == nt - 2);
            const char* a1 = cA + (size_t)(t + 1) * kstep;
            const char* a2 = last ? nA : cA + (size_t)(t + 2) * kstep; const char* b2 = last ? nB : cB + (size_t)(t + 2) * kstep;
            const char* a3 = a2 + kstep; const char* b3 = b2 + kstep;
            PG8_LDB(B0, 0, 0); PG8_SCHED; PG8_LDA(At, 0, 0); PG8_STAGE(PG8_SA(1, 1), a1 + hstep, voffA);
            PG8_WAIT_L(8); PG8_BAR; PG8_WAIT_L(0); PG8_MMA(0, 0, At, B0); PG8_BAR; PG8_SCHED;
            PG8_LDB(B1, 0, 1); PG8_STAGE(PG8_SB(0, 0), b2, voffB);
            PG8_BAR; PG8_WAIT_L(0); PG8_MMA(0, 1, At, B1); PG8_BAR;
            PG8_LDA(At, 0, 1); PG8_STAGE(PG8_SA(0, 0), a2, voffA);
            PG8_BAR; PG8_WAIT_L(0); PG8_MMA(1, 0, At, B0); PG8_BAR; PG8_SCHED;
            PG8_STAGE(PG8_SB(0, 1), b2 + hstep, voffB);
            PG8_WAIT_V(6); PG8_BAR; PG8_MMA(1, 1, At, B1); PG8_BAR;
            PG8_LDB(B0, 1, 0); PG8_SCHED; PG8_LDA(At, 1, 0); PG8_STAGE(PG8_SA(0, 1), a2 + hstep, voffA);
            PG8_WAIT_L(8); PG8_BAR; PG8_WAIT_L(0); PG8_MMA(0, 0, At, B0); PG8_BAR; PG8_SCHED;
            PG8_LDB(B1, 1, 1); PG8_STAGE(PG8_SB(1, 0), b3, voffB);
            PG8_BAR; PG8_WAIT_L(0); PG8_MMA(0, 1, At, B1); PG8_BAR;
            PG8_LDA(At, 1, 1); PG8_STAGE(PG8_SA(1, 0), a3, voffA);
            PG8_BAR; PG8_WAIT_L(0); PG8_MMA(1, 0, At, B0); PG8_BAR; PG8_SCHED;
            PG8_STAGE(PG8_SB(1, 1), b3 + hstep, voffB);
            PG8_WAIT_V(6); PG8_BAR; PG8_MMA(1, 1, At, B1); PG8_BAR;
        }
        E(acc, cur, wr, wc, fr, fq);
        if (!has_next) break;
#pragma unroll
        for (int a = 0; a < 2; ++a)
#pragma unroll
            for (int b = 0; b < 2; ++b)
#pragma unroll
                for (int m = 0; m < 4; ++m)
#pragma unroll
                    for (int n = 0; n < 2; ++n) acc[a][b][m][n] = (f32x4){0.f, 0.f, 0.f, 0.f};
        cur = nxt; cA = nA; cB = nB; ++ui;
    }
    PG8_WAIT_V(0);
    if (wr == 0) PG8_BAR;
    PG8_BAR;
#undef PG8_SA
#undef PG8_SB
#undef PG8_STAGE
#undef PG8_LDA
#undef PG8_LDB
#undef PG8_MMA
#undef PG8_WAIT_V
#undef PG8_WAIT_L
#undef PG8_BAR
#undef PG8_SCHED
}
}

__device__ void transpose_tile(const float* __restrict__ src, int ldsrc, int N, int k0, int n0, bf16_t* __restrict__ dst, int lddst, int dstrow0, float* tile) {
    const int tid = threadIdx.x;
    for (int i = tid; i < 4096; i += NTHR) { const int kk = i >> 6, nn = i & 63; float v = 0.f; if (n0 + nn < N) v = src[(size_t)(k0 + kk) * ldsrc + n0 + nn]; tile[kk * 65 + nn] = v; }
    __syncthreads();
    for (int i = tid; i < 2048; i += NTHR) { const int nn = i >> 5, kp = (i & 31) * 2;
        if (n0 + nn < N) *(unsigned*)(dst + (size_t)(dstrow0 + n0 + nn) * lddst + k0 + kp) = pack2(tile[kp * 65 + nn], tile[(kp + 1) * 65 + nn]); }
    __syncthreads();
}

__device__ void phase_prologue(const Params& p, float* lds) {
    const int tid = threadIdx.x;
    unsigned char* ws = p.ws;
    bf16_t* BT0 = (bf16_t*)(ws + WS_BT0); bf16_t* WT0O = (bf16_t*)(ws + WS_WT0O); bf16_t* BT1 = (bf16_t*)(ws + WS_BT1); bf16_t* WT1O = (bf16_t*)(ws + WS_WT1O);
    float* MOD = (float*)(ws + WS_MOD);
    constexpr int NGEMV = 192, NT = 3680;
    for (int it = blockIdx.x; it < NGEMV + NT; it += gridDim.x) {
        if (it < NGEMV) {
            const int l = it / 96, j0 = (it % 96) * 32;
            float* sc = lds;
            float* red = lds + 3072;
            for (int i = tid; i < 3072; i += NTHR) { const int cnd = i >> 10, k = i & 1023; const float v = cnd == 0 ? p.in[5][k] : p.in[4][(cnd - 1) * 1024 + k]; sc[i] = silu(v); }
            __syncthreads();
            const int col = tid & 31, ksp = tid >> 5;
            float a0 = 0.f, a1 = 0.f, a2 = 0.f;
            const float* w = p.in[7] + (size_t)l * 1024 * 3072 + j0 + col;
            for (int k = ksp * 64; k < ksp * 64 + 64; ++k) { const float wv = w[(size_t)k * 3072]; a0 += sc[k] * wv; a1 += sc[1024 + k] * wv; a2 += sc[2048 + k] * wv; }
            red[(ksp * 3 + 0) * 32 + col] = a0; red[(ksp * 3 + 1) * 32 + col] = a1; red[(ksp * 3 + 2) * 32 + col] = a2;
            __syncthreads();
            if (tid < 96) { const int cnd = tid >> 5, cc = tid & 31; float s = 0.f; for (int q = 0; q < 16; ++q) s += red[(q * 3 + cnd) * 32 + cc];
                MOD[(l * 3 + cnd) * 3072 + j0 + cc] = s + p.in[8][l * 3072 + j0 + cc]; }
            __syncthreads();
        } else {
            int t = it - NGEMV;
            const float* src; int ldsrc, N; bf16_t* dst; int lddst, drow0, nnt;
            if (t < 2048) { src = p.in[10]; ldsrc = 8192; N = 8192; dst = BT0; lddst = 1024; drow0 = 0; nnt = 128; }
            else if (t < 2048 + 32) { t -= 2048; const int z = t >> 4; t &= 15; src = p.in[14] + (size_t)z * 1024 * 64; ldsrc = 64; N = 64; dst = BT0; lddst = 1024; drow0 = 8192 + z * 64; nnt = 1; }
            else if (t < 2048 + 64) { t -= 2048 + 32; const int z = t >> 4; t &= 15; src = p.in[17] + (size_t)z * 1024 * 64; ldsrc = 64; N = 64; dst = BT0; lddst = 1024; drow0 = 8320 + z * 64; nnt = 1; }
            else if (t < 2112 + 512) { t -= 2112; src = p.in[11]; ldsrc = 1024; N = 1024; dst = WT0O; lddst = 2048; drow0 = 0; nnt = 16; }
            else if (t < 2624 + 768) { t -= 2624; src = p.in[24]; ldsrc = 3072; N = 3072; dst = BT1; lddst = 1024; drow0 = 0; nnt = 48; }
            else if (t < 3392 + 32) { t -= 3392; const int z = t >> 4; t &= 15; src = p.in[26] + (size_t)z * 1024 * 16; ldsrc = 16; N = 16; dst = BT1; lddst = 1024; drow0 = 3072 + z * 16; nnt = 1; }
            else { t -= 3424; src = p.in[25]; ldsrc = 1024; N = 1024; dst = WT1O; lddst = 1024; drow0 = 0; nnt = 16; }
            const int kt = t / nnt, ntile = t % nnt;
            transpose_tile(src, ldsrc, N, kt * 64, ntile * 64, dst, lddst, drow0, lds);
        }
    }
    { u32x4* z = (u32x4*)(BT1 + (size_t)3104 * 1024); const int n = 224 * 1024 * 2 / 16;
      for (int i = blockIdx.x * NTHR + tid; i < n; i += gridDim.x * NTHR) z[i] = (u32x4){0u, 0u, 0u, 0u}; }
}

__device__ void phase_h(const Params& p, int layer) {
    const int tid = threadIdx.x, wave = tid >> 6, lane = tid & 63;
    unsigned char* ws = p.ws;
    const float* MOD = (const float*)(ws + WS_MOD);
    bf16_t* H = (bf16_t*)(ws + WS_H);
    float* X1 = (float*)(ws + WS_X1);
    const float* Y = (const float*)(ws + WS_P);
    for (int tok = blockIdx.x * 8 + wave; tok < NTOK; tok += gridDim.x * 8) {
        const float* xr = tok < NPTOK ? p.in[0] + (size_t)tok * D : p.in[1] + (size_t)(tok - NPTOK) * D;
        const int cond = tok < NPTOK ? 0 : 1 + ((tok - NPTOK) >> 11);
        f32x4 xv[4]; float ss = 0.f;
#pragma unroll
        for (int i = 0; i < 4; ++i) { const int idx = i * 256 + lane * 4; xv[i] = *(const f32x4*)(xr + idx);
            if (layer == 1) { const f32x4 ya = *(const f32x4*)(Y + (size_t)tok * D + idx), yb = *(const f32x4*)(Y + (size_t)NTOK * D + (size_t)tok * D + idx);
                const f32x4 gt = *(const f32x4*)(MOD + (0 * 3 + cond) * 3072 + 2048 + idx);
                xv[i] = xv[i] + gt * (ya + yb); *(f32x4*)(X1 + (size_t)tok * D + idx) = xv[i]; }
            ss += xv[i][0] * xv[i][0] + xv[i][1] * xv[i][1] + xv[i][2] * xv[i][2] + xv[i][3] * xv[i][3]; }
        ss = wave_sum(ss);
        const float rstd = rsqrtf(ss * (1.f / 1024.f) + 1e-6f);
#pragma unroll
        for (int i = 0; i < 4; ++i) { const int idx = i * 256 + lane * 4;
            const f32x4 g = *(const f32x4*)(p.in[6] + layer * D + idx);
            const f32x4 sh = *(const f32x4*)(MOD + (layer * 3 + cond) * 3072 + idx), sc = *(const f32x4*)(MOD + (layer * 3 + cond) * 3072 + 1024 + idx);
            f32x4 h;
#pragma unroll
            for (int j = 0; j < 4; ++j) h[j] = xv[i][j] * rstd * g[j] * (1.f + sc[j]) + sh[j];
            u32x2 w; w.x = pack2(h[0], h[1]); w.y = pack2(h[2], h[3]);
            *(u32x2*)(H + (size_t)tok * D + idx) = w; }
    }
}

__device__ __forceinline__ f32x4 mma_nt(const bf16_t* A, int lda, const bf16_t* B, int ldb, int K, f32x4 acc, int fr, int fq) {
    for (int k0 = 0; k0 < K; k0 += 32) {
        const bf16x8 a = *(const bf16x8*)(A + fr * lda + k0 + fq * 8);
        const bf16x8 b = *(const bf16x8*)(B + fr * ldb + k0 + fq * 8);
        acc = __builtin_amdgcn_mfma_f32_16x16x32_bf16(a, b, acc, 0, 0, 0);
    }
    return acc;
}
__device__ __forceinline__ bf16x8 pack8(float a0, float a1, float a2, float a3, float a4, float a5, float a6, float a7) {
    u32x4 w; w.x = pack2(a0, a1); w.y = pack2(a2, a3); w.z = pack2(a4, a5); w.w = pack2(a6, a7);
    return __builtin_bit_cast(bf16x8, w);
}
__device__ __forceinline__ float dpp_add(float v, float o) { return v + o; }
__device__ __forceinline__ float wave_sum_fast(float v) {
    v += __int_as_float(__builtin_amdgcn_update_dpp(0, __float_as_int(v), 0xB1, 0xF, 0xF, true));
    v += __int_as_float(__builtin_amdgcn_update_dpp(0, __float_as_int(v), 0x4E, 0xF, 0xF, true));
    v += __int_as_float(__builtin_amdgcn_update_dpp(0, __float_as_int(v), 0x141, 0xF, 0xF, true));
    v += __int_as_float(__builtin_amdgcn_update_dpp(0, __float_as_int(v), 0x140, 0xF, 0xF, true));
    v += __shfl_xor(v, 16, 64); v += __shfl_xor(v, 32, 64);
    return v;
}
__device__ __forceinline__ float fast_tanh(float x) { const float e = __expf(2.f * x); return 1.f - 2.f * __builtin_amdgcn_rcpf(1.f + e); }
typedef float f32x2_t __attribute__((ext_vector_type(2)));
typedef __bf16 bf16x2_t __attribute__((ext_vector_type(2)));
__device__ __forceinline__ unsigned pk2(float lo, float hi) { const f32x2_t v = {lo, hi}; return __builtin_bit_cast(unsigned, __builtin_convertvector(v, bf16x2_t)); }
__device__ __forceinline__ bf16_t f2bf_hw(float f) { return __builtin_bit_cast(bf16_t, (__bf16)f); }
__device__ __forceinline__ bf16x8 pack8h(float a0, float a1, float a2, float a3, float a4, float a5, float a6, float a7) {
    u32x4 w; w.x = pk2(a0, a1); w.y = pk2(a2, a3); w.z = pk2(a4, a5); w.w = pk2(a6, a7);
    return __builtin_bit_cast(bf16x8, w);
}

__device__ void wkv_unit(const Params& p, int u, float* ldsf) {
    const int tid0 = threadIdx.x, lane0 = tid0 & 63, w = __builtin_amdgcn_readfirstlane(tid0 >> 6), fr0 = lane0 & 15, fq0 = lane0 >> 4;
    unsigned char* ws = p.ws;
    unsigned char* lds = (unsigned char*)ldsf;
    const bf16_t* P = (const bf16_t*)(ws + WS_P);
    bf16_t* OD = (bf16_t*)(ws + WS_X1);
    float* BON = (float*)(ws + WS_BON);
    int z, b, hd, T, tok0; bool sample;
    if (u < 64) { sample = true; z = u >> 5; b = (u >> 4) & 1; hd = u & 15; T = 2048; tok0 = NPTOK + b * 2048; }
    else { const int q = u - 64; sample = false; z = q >> 8; b = (q >> 4) & 15; hd = q & 15; T = 256; tok0 = b * 256; }
    bf16_t* TLW = (bf16_t*)(lds + 0);
    bf16_t* TLA = (bf16_t*)(lds + 9216);
    float* HT = (float*)(lds + 18432);
    bf16_t* KTr = (bf16_t*)(lds + 20480);
    bf16_t* BTr = (bf16_t*)(lds + 29696);
    bf16_t* KKH = (bf16_t*)(lds + 38912);
    bf16_t* RH = (bf16_t*)(lds + 48128);
    const bf16_t* VS = (const bf16_t*)(lds + 113664 + 2 * 8192);
    bf16_t* TA = (bf16_t*)(lds + 65536);
    bf16_t* NA = (bf16_t*)(lds + 70656);
    float* PC = (float*)(lds + 75776);
    bf16_t* KBm = (bf16_t*)(lds + 76800);
    float* MM = (float*)(lds + 97280);
    float* WA = (float*)(lds + 76800);
    bf16x8 bw[2];
    { const float* W2 = (w >> 2) ? p.in[18] : p.in[15];
#pragma unroll
      for (int ks = 0; ks < 2; ++ks) { float t8[8];
#pragma unroll
        for (int e = 0; e < 8; ++e) t8[e] = W2[(size_t)(z * 64 + ks * 32 + fq0 * 8 + e) * 1024 + hd * 64 + (w & 3) * 16 + fr0];
        bw[ks] = pack8h(t8[0], t8[1], t8[2], t8[3], t8[4], t8[5], t8[6], t8[7]); } }
    f32x4 Sacc[4];
#pragma unroll
    for (int kt = 0; kt < 4; ++kt) Sacc[kt] = (f32x4){0.f, 0.f, 0.f, 0.f};
    if (sample && w < 4) { const float* s0 = p.in[2] + ((size_t)((b * 2 + z) * 16 + hd)) * 4096 + (size_t)(w * 16 + fr0) * 64;
#pragma unroll
        for (int kt = 0; kt < 4; ++kt)
#pragma unroll
            for (int jj = 0; jj < 4; ++jj) Sacc[kt][jj] = s0[kt * 16 + fq0 * 4 + jj]; }
    const int ch = hd * 64 + lane0;
    const float w0c = p.in[13][z * 1024 + ch], a0c = p.in[16][z * 1024 + ch], kkc = p.in[19][ch], kac = p.in[20][ch], rkc = p.in[21][ch];
    bf16_t* RKV = (bf16_t*)(lds + 113664);
    u32x4 tlraw[2], rkvraw[3];
#define WKV_LOAD_RAW(tb_) do { \
        _Pragma("unroll") for (int h_ = 0; h_ < 2; ++h_) { const int idx_ = tid + h_ * NTHR; const int tau_ = idx_ >> 4, sg_ = idx_ & 15; const int t_ = z ? (T - 1 - ((tb_) + tau_)) : ((tb_) + tau_); \
            tlraw[h_] = *(const u32x4*)(P + (size_t)(tok0 + t_) * N0 + 8192 + (sg_ < 8 ? z * 64 + sg_ * 8 : 128 + z * 64 + (sg_ - 8) * 8)); } \
        { const int tau_ = tid >> 3, sg_ = tid & 7; const int t_ = z ? (T - 1 - ((tb_) + tau_)) : ((tb_) + tau_); const bf16_t* rp_ = P + (size_t)(tok0 + t_) * N0 + 4096 + hd * 64 + sg_ * 8; \
          rkvraw[0] = *(const u32x4*)rp_; rkvraw[1] = *(const u32x4*)(rp_ + 1024); rkvraw[2] = *(const u32x4*)(rp_ + 2048); } } while (0)
    { const int tid = tid0; WKV_LOAD_RAW(0); }
    __syncthreads();
#pragma unroll 1
    for (int tb = 0; tb < T; tb += 64) {
        int tid = tid0; asm volatile("" : "+v"(tid));
        const int lane = tid & 63, fr = lane & 15, fq = lane >> 4, c = lane;
        const int pcol = ((c >> 5) * 32) + (((c >> 2) & 3) * 8) + (((c >> 4) & 1) * 4) + (c & 3);
#pragma unroll
        for (int h = 0; h < 2; ++h) { const int idx = tid + h * NTHR; const int tau = idx >> 4, sg = idx & 15;
            u32x4 o = tlraw[h];
            if (sg < 8) { o.x = pk2(fast_tanh(bflo(o.x)), fast_tanh(bfhi(o.x))); o.y = pk2(fast_tanh(bflo(o.y)), fast_tanh(bfhi(o.y)));
                          o.z = pk2(fast_tanh(bflo(o.z)), fast_tanh(bfhi(o.z))); o.w = pk2(fast_tanh(bflo(o.w)), fast_tanh(bfhi(o.w))); }
            *(u32x4*)((sg < 8 ? TLW : TLA) + tau * 72 + (sg & 7) * 8) = o; }
#pragma unroll
        for (int h = 0; h < 3; ++h) *(u32x4*)(RKV + h * 4096 + (tid >> 3) * 64 + (tid & 7) * 8) = rkvraw[h];
        __syncthreads();
        if (tb + 64 < T) WKV_LOAD_RAW(tb + 64);
        { const bf16_t* TL = (w >> 2) ? TLA : TLW; float* WAo = WA + (w >> 2) * 64 * 68;
#pragma unroll
          for (int mt = 0; mt < 4; ++mt) { f32x4 acc = (f32x4){0.f, 0.f, 0.f, 0.f};
#pragma unroll
            for (int ks = 0; ks < 2; ++ks) { const bf16x8 a = *(const bf16x8*)(TL + (mt * 16 + fr) * 72 + ks * 32 + fq * 8);
                acc = __builtin_amdgcn_mfma_f32_16x16x32_bf16(a, bw[ks], acc, 0, 0, 0); }
#pragma unroll
            for (int jj = 0; jj < 4; ++jj) WAo[(mt * 16 + fq * 4 + jj) * 68 + (w & 3) * 16 + fr] = acc[jj]; } }
        __syncthreads();
        float kkv[8], kmv[8], bv[8], lwv[8], cum[8], rr[8];
        { float run = 0.f;
#pragma unroll
          for (int i = 0; i < 8; ++i) { const int tau = w * 8 + i; const int t = z ? (T - 1 - (tb + tau)) : (tb + tau); const int tokg = tok0 + t;
            const float wr_ = w0c + WA[tau * 68 + c], ap = a0c + WA[64 * 68 + tau * 68 + c];
            const float nx = -wr_; const float sp = fmaxf(nx, 0.f) + __logf(1.f + __expf(-fabsf(nx)));
            const float lw = -__expf(-sp - 0.5f);
            const float iclr = __builtin_amdgcn_rcpf(1.f + __expf(-ap));
            const float kxi = bf2f(RKV[4096 + tau * 64 + c]); rr[i] = bf2f(RKV[tau * 64 + c]);
            const float kkraw = kxi * kkc;
            const float ssq = wave_sum_fast(kkraw * kkraw);
            const float kk = kkraw * __builtin_amdgcn_rsqf(fmaxf(ssq, 1e-24f));
            const float kmod = kxi * (1.f + (iclr - 1.f) * kac);
            const float bon = wave_sum_fast(rr[i] * kmod * rkc);
            if (lane == 0) BON[((size_t)z * NTOK + tokg) * 16 + hd] = bon;
            run += lw;
            kkv[i] = kk; kmv[i] = kmod; bv[i] = kk * iclr; lwv[i] = lw; cum[i] = run; }
          HT[w * 64 + c] = run; }
        __syncthreads();
        { const float off = (w & 1) ? HT[(w - 1) * 64 + c] : 0.f; const int cn = w >> 1;
#pragma unroll
          for (int i = 0; i < 8; ++i) { const int tau = w * 8 + i; const int j = (w & 1) * 8 + i;
            const float cm = cum[i] + off;
            const float Pj = __expf(cm), ipj = __expf(-cm), pm1 = __expf(cm - lwv[i]);
            const unsigned kb2 = pk2(-bv[i] * ipj, kmv[i] * ipj);
            KTr[tau * 72 + pcol] = (bf16_t)(kb2 >> 16); BTr[tau * 72 + pcol] = f2bf_hw(bv[i] * ipj);
            const unsigned kr2 = pk2(kkv[i] * pm1, rr[i] * Pj);
            KKH[tau * 72 + pcol] = (bf16_t)(kr2 & 0xFFFFu); RH[tau * 72 + pcol] = (bf16_t)(kr2 >> 16);
            const int sU = (j >> 2) * 8 + (j & 3);
            KBm[(cn * 64 + c) * 40 + sU] = (bf16_t)(kb2 & 0xFFFFu); KBm[(cn * 64 + c) * 40 + sU + 4] = (bf16_t)(kb2 >> 16);
            if (j == 15) PC[cn * 64 + c] = Pj; } }
        __syncthreads();
#pragma unroll
        for (int q2 = 0; q2 < 2; ++q2) { const int id = w * 2 + q2; const int cn = id >> 2, which = id & 3;
          const bf16_t* Am = ((which & 1) ? KTr : BTr) + cn * 16 * 72; const bf16_t* Bm = ((which & 2) ? RH : KKH) + cn * 16 * 72;
          const f32x4 acc = mma_nt(Am, 72, Bm, 72, 64, (f32x4){0.f, 0.f, 0.f, 0.f}, fr, fq);
          f32x4 o;
#pragma unroll
          for (int jj = 0; jj < 4; ++jj) { const int i = fq * 4 + jj, j = fr; const bool keep = (which & 2) ? (i <= j) : (i < j); o[jj] = keep ? acc[jj] : 0.f; }
          *(f32x4*)(MM + (cn * 4 + which) * 256 + fr * 16 + fq * 4) = o; }
        __syncthreads();
        if (w == 0) { const int cn = lane >> 4, col = lane & 15;
            const float* MbT = MM + (cn * 4 + 0) * 256; const float* MkT = MM + (cn * 4 + 1) * 256;
            float Tc[16], A1[16];
#pragma unroll
            for (int i = 0; i < 16; ++i) { Tc[i] = (i == col) ? 1.f : 0.f; A1[i] = 0.f; }
#pragma unroll
            for (int l = 15; l >= 1; --l) {
                const float tl_ = Tc[l];
#pragma unroll
                for (int v4 = 0; v4 < 4; ++v4) if (v4 * 4 < l) { const f32x4 mb = *(const f32x4*)(MbT + l * 16 + v4 * 4), mk = *(const f32x4*)(MkT + l * 16 + v4 * 4);
#pragma unroll
                    for (int e = 0; e < 4; ++e) if (v4 * 4 + e < l) { Tc[v4 * 4 + e] -= mb[e] * tl_; A1[v4 * 4 + e] += mk[e] * tl_; } }
                asm volatile("" ::: "memory");
            }
            bf16_t* tao = TA + (cn * 16 + col) * 40;
#pragma unroll
            for (int g4 = 0; g4 < 4; ++g4) { u32x4 o; o.x = pk2(Tc[g4 * 4], Tc[g4 * 4 + 1]); o.y = pk2(Tc[g4 * 4 + 2], Tc[g4 * 4 + 3]); o.z = pk2(A1[g4 * 4], A1[g4 * 4 + 1]); o.w = pk2(A1[g4 * 4 + 2], A1[g4 * 4 + 3]);
                *(u32x4*)(tao + g4 * 8) = o; } }
        else if (w <= 4) { const int cn = w - 1, j = lane & 15, ig = lane >> 4;
            const f32x4 nb = *(const f32x4*)(MM + (cn * 4 + 2) * 256 + j * 16 + ig * 4), nk = *(const f32x4*)(MM + (cn * 4 + 3) * 256 + j * 16 + ig * 4);
            u32x4 o; o.x = pk2(-nb[0], -nb[1]); o.y = pk2(-nb[2], -nb[3]); o.z = pk2(nk[0], nk[1]); o.w = pk2(nk[2], nk[3]);
            *(u32x4*)(NA + (cn * 16 + j) * 40 + ig * 8) = o; }
        __syncthreads();
        if (w < 4) {
#pragma unroll 1
            for (int cn = 0; cn < 4; ++cn) {
                bf16x8 sb[2];
#pragma unroll
                for (int ks = 0; ks < 2; ++ks) sb[ks] = pack8h(Sacc[2 * ks][0], Sacc[2 * ks][1], Sacc[2 * ks][2], Sacc[2 * ks][3], Sacc[2 * ks + 1][0], Sacc[2 * ks + 1][1], Sacc[2 * ks + 1][2], Sacc[2 * ks + 1][3]);
                f32x4 U0 = (f32x4){0.f, 0.f, 0.f, 0.f}, O = (f32x4){0.f, 0.f, 0.f, 0.f};
#pragma unroll
                for (int ks = 0; ks < 2; ++ks) { const bf16x8 a = *(const bf16x8*)(KKH + (cn * 16 + fr) * 72 + ks * 32 + fq * 8);
                    U0 = __builtin_amdgcn_mfma_f32_16x16x32_bf16(a, sb[ks], U0, 0, 0, 0);
                    const bf16x8 ar = *(const bf16x8*)(RH + (cn * 16 + fr) * 72 + ks * 32 + fq * 8);
                    O = __builtin_amdgcn_mfma_f32_16x16x32_bf16(ar, sb[ks], O, 0, 0, 0); }
                float vf[4];
#pragma unroll
                for (int e = 0; e < 4; ++e) vf[e] = bf2f(VS[(cn * 16 + fq * 4 + e) * 64 + w * 16 + fr]);
                const bf16x8 bU0 = pack8h(U0[0], U0[1], U0[2], U0[3], vf[0], vf[1], vf[2], vf[3]);
                const bf16x8 ta = *(const bf16x8*)(TA + (cn * 16 + fr) * 40 + fq * 8);
                const f32x4 U = __builtin_amdgcn_mfma_f32_16x16x32_bf16(ta, bU0, (f32x4){0.f, 0.f, 0.f, 0.f}, 0, 0, 0);
                const bf16x8 bUV = pack8h(U[0], U[1], U[2], U[3], vf[0], vf[1], vf[2], vf[3]);
                const bf16x8 na = *(const bf16x8*)(NA + (cn * 16 + fr) * 40 + fq * 8);
                O = __builtin_amdgcn_mfma_f32_16x16x32_bf16(na, bUV, O, 0, 0, 0);
#pragma unroll
                for (int jj = 0; jj < 4; ++jj) { const int tau = cn * 16 + fq * 4 + jj; const int t = z ? (T - 1 - (tb + tau)) : (tb + tau);
                    OD[((size_t)z * NTOK + tok0 + t) * 1024 + hd * 64 + w * 16 + fr] = f2bf_hw(O[jj]); }
#pragma unroll
                for (int kt = 0; kt < 4; ++kt) { const bf16x8 kb = *(const bf16x8*)(KBm + (cn * 64 + kt * 16 + fr) * 40 + fq * 8);
                    Sacc[kt] = __builtin_amdgcn_mfma_f32_16x16x32_bf16(kb, bUV, Sacc[kt], 0, 0, 0);
                    const f32x4 pc = *(const f32x4*)(PC + cn * 64 + kt * 16 + fq * 4);
                    Sacc[kt] = Sacc[kt] * pc; }
            }
        }
        __syncthreads();
    }
#undef WKV_LOAD_RAW
    if (!sample && w < 4) { float* so = p.out + (size_t)2 * NPTOK * D + ((size_t)((b * 2 + z) * 16 + hd)) * 4096 + (size_t)(w * 16 + fr0) * 64;
#pragma unroll
        for (int kt = 0; kt < 4; ++kt)
#pragma unroll
            for (int jj = 0; jj < 4; ++jj) so[kt * 16 + fq0 * 4 + jj] = Sacc[kt][jj]; }
    __syncthreads();
}

__device__ void conv_tile(const Params& p, int tile) {
    const int tid = threadIdx.x;
    unsigned char* ws = p.ws;
    const bf16_t* P = (const bf16_t*)(ws + WS_P);
    bf16_t* OC = (bf16_t*)(ws + WS_OC);
    const int cgp = tid & 127, c0 = cgp * 8, sub = tid >> 7;
    float cw0[8], cw1[8], cw2[8];
#pragma unroll
    for (int j = 0; j < 8; ++j) { cw0[j] = p.in[12][c0 + j]; cw1[j] = p.in[12][1024 + c0 + j]; cw2[j] = p.in[12][2048 + c0 + j]; }
    for (int jj = 0; jj < 4; ++jj) {
        const int t = tile * 16 + sub + 4 * jj;
        const int rl = t < NPTOK ? 256 : 64; const int pos = t & (rl - 1);
        const bf16_t* row = P + (size_t)t * N0;
        const u32x4 z4 = (u32x4){0u, 0u, 0u, 0u};
        const u32x4 u1 = *(const u32x4*)(row + c0), g1 = *(const u32x4*)(row + 2048 + c0);
        const u32x4 u0 = pos > 0 ? *(const u32x4*)(row - N0 + c0) : z4, g0 = pos > 0 ? *(const u32x4*)(row - N0 + 2048 + c0) : z4;
        const u32x4 u2 = pos < rl - 1 ? *(const u32x4*)(row + N0 + c0) : z4, g2 = pos < rl - 1 ? *(const u32x4*)(row + N0 + 2048 + c0) : z4;
        const u32x4 gb = *(const u32x4*)(row + 1024 + c0), zc = *(const u32x4*)(row + 3072 + c0);
        u32x4 o;
#pragma unroll
        for (int q = 0; q < 4; ++q) {
            const float y0 = cw0[2 * q] * (bflo(g0[q]) * bflo(u0[q])) + cw1[2 * q] * (bflo(g1[q]) * bflo(u1[q])) + cw2[2 * q] * (bflo(g2[q]) * bflo(u2[q]));
            const float y1 = cw0[2 * q + 1] * (bfhi(g0[q]) * bfhi(u0[q])) + cw1[2 * q + 1] * (bfhi(g1[q]) * bfhi(u1[q])) + cw2[2 * q + 1] * (bfhi(g2[q]) * bfhi(u2[q]));
            o[q] = pack2(silu(bflo(zc[q])) * bflo(gb[q]) * y0, silu(bfhi(zc[q])) * bfhi(gb[q]) * y1);
        }
        *(u32x4*)(OC + (size_t)t * 2048 + c0) = o;
    }
}

__device__ void phase_mix0(const Params& p, float* lds, int rep) {
    unsigned* ctr = (unsigned*)(p.ws + WS_CTL) + rep * 32;
    int* slot = (int*)(lds + LDS_MAIN / 4);
    constexpr int NSCAN = 576, NCONV = 512;
    for (;;) {
        if (threadIdx.x == 0) *slot = (int)atomicAdd(ctr, 1u);
        __syncthreads();
        const int it = *slot;
        __syncthreads();
        if (it >= NSCAN + NCONV) break;
        if (it < NSCAN) wkv_unit(p, it, lds); else conv_tile(p, it - NSCAN);
    }
}

__device__ void phase_wkv_post(const Params& p) {
    const int tid = threadIdx.x, wave = tid >> 6, lane = tid & 63;
    unsigned char* ws = p.ws;
    const bf16_t* P = (const bf16_t*)(ws + WS_P);
    const bf16_t* OD = (const bf16_t*)(ws + WS_X1);
    const float* BON = (const float*)(ws + WS_BON);
    bf16_t* OC = (bf16_t*)(ws + WS_OC);
    for (int tok = blockIdx.x * 8 + wave; tok < NTOK; tok += gridDim.x * 8) {
        const bf16_t* row = P + (size_t)tok * N0;
        for (int hd = 0; hd < 16; ++hd) { const int ch = hd * 64 + lane;
            const float o = bf2f(OD[(size_t)tok * 1024 + ch]) + bf2f(OD[((size_t)NTOK + tok) * 1024 + ch]);
            const float mu = wave_sum(o) * (1.f / 64.f);
            const float dv = o - mu;
            const float var = wave_sum(dv * dv) * (1.f / 64.f);
            const float gn = dv * rsqrtf(var + 64e-5f) * p.in[22][ch] + p.in[23][ch];
            const float bon = BON[(size_t)tok * 16 + hd] + BON[((size_t)NTOK + tok) * 16 + hd];
            const float vv = bf2f(row[6144 + ch]), zw = bf2f(row[7168 + ch]);
            OC[(size_t)tok * 2048 + 1024 + ch] = f2bf((gn + bon * vv) * silu(zw)); }
    }
}

constexpr size_t WS_QE = WS_H;
constexpr size_t WS_KDT = WS_BT0;
constexpr size_t WS_VT = WS_OC + (size_t)NTOK * 1024 * 2;
constexpr size_t WS_EBL = WS_BON + (size_t)2 * NTOK * 16 * 4;

__device__ void gla_a_item(const Params& p, int item, float* ldsf) {
    const int tid = threadIdx.x, lane = tid & 63, w = __builtin_amdgcn_readfirstlane(tid >> 6), fr = lane & 15, fq = lane >> 4;
    unsigned char* ws = p.ws;
    const bf16_t* P1 = (const bf16_t*)(ws + WS_P);
    float* OD = (float*)(ws + WS_P2);
    bf16_t* QEg = (bf16_t*)(ws + WS_QE); bf16_t* KDTg = (bf16_t*)(ws + WS_KDT); bf16_t* VTg = (bf16_t*)(ws + WS_VT); float* EBLg = (float*)(ws + WS_EBL);
    const int hd = item & 3, c = (item >> 2) & 127, z = item >> 9, tok0 = c * 64;
    bf16_t* QE = (bf16_t*)ldsf;
    bf16_t* KE = QE + 64 * 136;
    bf16_t* VT = KE + 64 * 136;
    bf16_t* ATT = VT + 256 * 72;
    float* G = (float*)(ATT + 64 * 72);
    float* L1G = G + 64 * 132;
    float* GK2 = L1G + 1024;
    for (int i = tid; i < 1024; i += NTHR) { const int t = i >> 4, r = i & 15; L1G[i] = bf2f(P1[(size_t)(tok0 + t) * N1 + 3072 + z * 16 + r]); }
    for (int i = tid; i < 2048; i += NTHR) { const int r = i >> 7, d = i & 127; GK2[i] = p.in[27][(size_t)(z * 16 + r) * 512 + hd * 128 + d]; }
#pragma unroll
    for (int ps = 0; ps < 4; ++ps) { const int t = ps * 16 + (tid >> 5), e8 = (tid & 31) * 8;
        const u32x4 v8 = *(const u32x4*)(P1 + (size_t)(tok0 + t) * N1 + 1024 + hd * 256 + e8);
        VT[(e8 + 0) * 72 + t] = (bf16_t)(v8.x & 0xFFFF); VT[(e8 + 1) * 72 + t] = (bf16_t)(v8.x >> 16); VT[(e8 + 2) * 72 + t] = (bf16_t)(v8.y & 0xFFFF); VT[(e8 + 3) * 72 + t] = (bf16_t)(v8.y >> 16);
        VT[(e8 + 4) * 72 + t] = (bf16_t)(v8.z & 0xFFFF); VT[(e8 + 5) * 72 + t] = (bf16_t)(v8.z >> 16); VT[(e8 + 6) * 72 + t] = (bf16_t)(v8.w & 0xFFFF); VT[(e8 + 7) * 72 + t] = (bf16_t)(v8.w >> 16); }
    const int d = tid & 127, tq = tid >> 7;
    const float gbias = p.in[28][z * 512 + hd * 128 + d];
    bf16_t qraw[16], kraw[16];
#pragma unroll
    for (int i = 0; i < 16; ++i) { const size_t row = (size_t)(tok0 + tq * 16 + i) * N1; qraw[i] = P1[row + hd * 128 + d]; kraw[i] = P1[row + 512 + hd * 128 + d]; }
    __syncthreads();
    { float run = 0.f;
#pragma unroll 4
      for (int i = 0; i < 16; ++i) { const int t = z ? (tq * 16 + 15 - i) : (tq * 16 + i);
        float x = gbias;
#pragma unroll
        for (int r = 0; r < 16; ++r) x += L1G[t * 16 + r] * GK2[r * 128 + d];
        const float ls = fminf(x, 0.f) - __logf(1.f + __expf(-fabsf(x)));
        run += ls * (1.f / 16.f);
        G[t * 132 + d] = run; } }
    __syncthreads();
    { const int lastr = z ? 0 : 15;
      const float t0 = G[(0 + lastr) * 132 + d], t1 = G[(16 + lastr) * 132 + d], t2 = G[(32 + lastr) * 132 + d], t3 = G[(48 + lastr) * 132 + d];
      const float blast = t0 + t1 + t2 + t3;
      float off;
      if (z == 0) off = tq == 0 ? 0.f : (tq == 1 ? t0 : (tq == 2 ? t0 + t1 : t0 + t1 + t2));
      else off = tq == 3 ? 0.f : (tq == 2 ? t3 : (tq == 1 ? t3 + t2 : t3 + t2 + t1));
      if (tq == 0) EBLg[(size_t)(z * 128 + c) * 512 + hd * 128 + d] = __expf(blast);
      unsigned kdp[8];
#pragma unroll
      for (int i = 0; i < 16; ++i) { const int t = tq * 16 + i;
        const float bc = G[t * 132 + d] + off;
        const float q = bf2f(qraw[i]) * 0.08838834764831845f, k = bf2f(kraw[i]);
        const bf16_t qe = f2bf(q * __expf(bc));
        QE[t * 136 + d] = qe; KE[t * 136 + d] = f2bf(k * __expf(-bc));
        QEg[((size_t)z * NTOK + tok0 + t) * 512 + hd * 128 + d] = qe;
        const unsigned kd = (unsigned)f2bf(k * __expf(blast - bc));
        if (i & 1) kdp[i >> 1] |= kd << 16; else kdp[i >> 1] = kd; }
      bf16_t* kdst = KDTg + ((size_t)(((z * 128 + c) * 4 + hd) * 128 + d)) * 64 + tq * 16;
      *(u32x4*)kdst = (u32x4){kdp[0], kdp[1], kdp[2], kdp[3]}; *(u32x4*)(kdst + 8) = (u32x4){kdp[4], kdp[5], kdp[6], kdp[7]}; }
    __syncthreads();
    if (z == 0) {
#pragma unroll
        for (int q4 = 0; q4 < 4; ++q4) { const int idx = q4 * NTHR + tid; const int e = idx >> 3, t8 = (idx & 7) * 8;
            *(u32x4*)(VTg + ((size_t)((c * 4 + hd) * 256 + e)) * 64 + t8) = *(const u32x4*)(VT + e * 72 + t8); } }
#pragma unroll
    for (int q2 = 0; q2 < 2; ++q2) { const int tA = 2 * w + q2, ia = tA >> 2, ja = tA & 3;
        f32x4 a4 = (f32x4){0.f, 0.f, 0.f, 0.f};
        if (z ? (ja >= ia) : (ja <= ia)) a4 = mma_nt(QE + ia * 16 * 136, 136, KE + ja * 16 * 136, 136, 128, a4, fr, fq);
#pragma unroll
        for (int jj = 0; jj < 4; ++jj) { const int i = ia * 16 + fq * 4 + jj, j = ja * 16 + fr; const bool keep = z ? (j >= i) : (j <= i); ATT[i * 72 + j] = f2bf(keep ? a4[jj] : 0.f); } }
    __syncthreads();
    { const int it = w & 3, eg = w >> 2;
#pragma unroll
      for (int e8 = 0; e8 < 8; ++e8) { const int et = eg * 8 + e8;
        const f32x4 o = mma_nt(ATT + it * 16 * 72, 72, VT + et * 16 * 72, 72, 64, (f32x4){0.f, 0.f, 0.f, 0.f}, fr, fq);
#pragma unroll
        for (int jj = 0; jj < 4; ++jj) OD[((size_t)z * NTOK + tok0 + it * 16 + fq * 4 + jj) * 1024 + hd * 256 + et * 16 + fr] = o[jj]; } }
    __syncthreads();
}

__device__ void phase_gla_a(const Params& p, float* lds) {
    for (int it = blockIdx.x; it < 1024; it += gridDim.x) gla_a_item(p, it, lds);
}

struct GlaFrags { bf16x8 kdt[2]; bf16x8 vt[4][2]; bf16x8 qe[4]; f32x4 ebl; f32x4 od[2]; };

__device__ void gla_b_unit(const Params& p, int u, float* ldsf) {
    const int tid = threadIdx.x, lane = tid & 63, w = __builtin_amdgcn_readfirstlane(tid >> 6), fr = lane & 15, fq = lane >> 4;
    unsigned char* ws = p.ws;
    float* OD = (float*)(ws + WS_P2);
    const bf16_t* QEg = (const bf16_t*)(ws + WS_QE); const bf16_t* KDTg = (const bf16_t*)(ws + WS_KDT); const bf16_t* VTg = (const bf16_t*)(ws + WS_VT); const float* EBLg = (const float*)(ws + WS_EBL);
    int z, b, hd, eq, nch, ch0; bool sample;
    if (u < 64) { sample = true; z = u >> 5; b = (u >> 4) & 1; hd = (u >> 2) & 3; eq = u & 3; nch = 32; ch0 = 64 + b * 32; }
    else { const int q = u - 64; sample = false; z = q >> 8; b = (q >> 4) & 15; hd = (q >> 2) & 3; eq = q & 3; nch = 4; ch0 = b * 4; }
    bf16_t* ST = (bf16_t*)ldsf;
    f32x4 Sacc[4];
    if (sample) { const float* s0 = p.in[3] + ((size_t)((b * 2 + z) * 4 + hd)) * 32768 + eq * 64 + fr;
#pragma unroll
        for (int et = 0; et < 4; ++et)
#pragma unroll
            for (int jj = 0; jj < 4; ++jj) Sacc[et][jj] = s0[(size_t)(w * 16 + fq * 4 + jj) * 256 + et * 16]; }
    else {
#pragma unroll
        for (int et = 0; et < 4; ++et) Sacc[et] = (f32x4){0.f, 0.f, 0.f, 0.f}; }
    const int it = w >> 1, e2 = (w & 1) * 2;
#define GLA_LOAD(F, c_) do { const int cc_ = (c_); \
        _Pragma("unroll") for (int ks = 0; ks < 2; ++ks) { (F).kdt[ks] = *(const bf16x8*)(KDTg + ((size_t)(((z * 128 + cc_) * 4 + hd) * 128 + w * 16 + fr)) * 64 + ks * 32 + fq * 8); \
            _Pragma("unroll") for (int et = 0; et < 4; ++et) (F).vt[et][ks] = *(const bf16x8*)(VTg + ((size_t)((cc_ * 4 + hd) * 256 + eq * 64 + et * 16 + fr)) * 64 + ks * 32 + fq * 8); } \
        _Pragma("unroll") for (int ks = 0; ks < 4; ++ks) (F).qe[ks] = *(const bf16x8*)(QEg + ((size_t)z * NTOK + cc_ * 64 + it * 16 + fr) * 512 + hd * 128 + ks * 32 + fq * 8); \
        (F).ebl = *(const f32x4*)(EBLg + (size_t)(z * 128 + cc_) * 512 + hd * 128 + w * 16 + fq * 4); \
        _Pragma("unroll") for (int q2 = 0; q2 < 2; ++q2) _Pragma("unroll") for (int jj = 0; jj < 4; ++jj) \
            (F).od[q2][jj] = OD[((size_t)z * NTOK + cc_ * 64 + it * 16 + fq * 4 + jj) * 1024 + hd * 256 + eq * 64 + (e2 + q2) * 16 + fr]; } while (0)
    GlaFrags cur, nxt;
    GLA_LOAD(cur, ch0 + (z ? nch - 1 : 0));
    __syncthreads();
#pragma unroll 1
    for (int ci = 0; ci < nch; ++ci) {
        const int c = ch0 + (z ? nch - 1 - ci : ci);
        bf16_t* STc = ST + (ci & 1) * 64 * 136;
#pragma unroll
        for (int et = 0; et < 4; ++et) { u32x2 v2; v2.x = pack2(Sacc[et][0], Sacc[et][1]); v2.y = pack2(Sacc[et][2], Sacc[et][3]);
            *(u32x2*)(STc + (et * 16 + fr) * 136 + w * 16 + fq * 4) = v2; }
        if (ci + 1 < nch) GLA_LOAD(nxt, ch0 + (z ? nch - 2 - ci : ci + 1));
        __syncthreads();
#pragma unroll
        for (int et = 0; et < 4; ++et) { Sacc[et] = Sacc[et] * cur.ebl;
#pragma unroll
            for (int ks = 0; ks < 2; ++ks) Sacc[et] = __builtin_amdgcn_mfma_f32_16x16x32_bf16(cur.kdt[ks], cur.vt[et][ks], Sacc[et], 0, 0, 0); }
#pragma unroll
        for (int q2 = 0; q2 < 2; ++q2) { f32x4 o = cur.od[q2];
#pragma unroll
            for (int ks = 0; ks < 4; ++ks) { const bf16x8 bS = *(const bf16x8*)(STc + ((e2 + q2) * 16 + fr) * 136 + ks * 32 + fq * 8);
                o = __builtin_amdgcn_mfma_f32_16x16x32_bf16(cur.qe[ks], bS, o, 0, 0, 0); }
#pragma unroll
            for (int jj = 0; jj < 4; ++jj) OD[((size_t)z * NTOK + c * 64 + it * 16 + fq * 4 + jj) * 1024 + hd * 256 + eq * 64 + (e2 + q2) * 16 + fr] = o[jj]; }
        cur = nxt;
    }
#undef GLA_LOAD
    if (!sample) { float* so = p.out + (size_t)2 * NPTOK * D + 2097152 + ((size_t)((b * 2 + z) * 4 + hd)) * 32768 + eq * 64 + fr;
#pragma unroll
        for (int et = 0; et < 4; ++et)
#pragma unroll
            for (int jj = 0; jj < 4; ++jj) so[(size_t)(w * 16 + fq * 4 + jj) * 256 + et * 16] = Sacc[et][jj]; }
    __syncthreads();
}

__device__ void phase_gla_b(const Params& p, float* lds, int rep) {
    unsigned* ctr = (unsigned*)(p.ws + WS_CTL) + 16 + rep * 32;
    int* slot = (int*)(lds + LDS_MAIN / 4);
    for (;;) {
        if (threadIdx.x == 0) *slot = (int)atomicAdd(ctr, 1u);
        __syncthreads();
        const int it = *slot;
        __syncthreads();
        if (it >= 576) break;
        gla_b_unit(p, it, lds);
    }
}

__device__ void phase_gla_post(const Params& p) {
    const int tid = threadIdx.x, wave = tid >> 6, lane = tid & 63;
    unsigned char* ws = p.ws;
    const bf16_t* P1 = (const bf16_t*)(ws + WS_P);
    const float* OD = (const float*)(ws + WS_P2);
    bf16_t* OG = (bf16_t*)(ws + WS_OC);
    for (int tok = blockIdx.x * 8 + wave; tok < NTOK; tok += gridDim.x * 8) {
        for (int hd = 0; hd < 4; ++hd) { const int idx = hd * 256 + lane * 4;
            const f32x4 a = *(const f32x4*)(OD + (size_t)tok * 1024 + idx), b2 = *(const f32x4*)(OD + ((size_t)NTOK + tok) * 1024 + idx);
            const f32x4 o = a + b2;
            const float ss = wave_sum(o[0] * o[0] + o[1] * o[1] + o[2] * o[2] + o[3] * o[3]);
            const float rs = rsqrtf(ss * (1.f / 256.f) + 1e-6f);
            const f32x4 gn = *(const f32x4*)(p.in[29] + lane * 4);
            const u32x2 zz = *(const u32x2*)(P1 + (size_t)tok * N1 + 2048 + idx);
            const float z0 = bflo(zz.x), z1 = bfhi(zz.x), z2 = bflo(zz.y), z3 = bfhi(zz.y);
            u32x2 w; w.x = pack2(o[0] * rs * gn[0] * silu(z0), o[1] * rs * gn[1] * silu(z1)); w.y = pack2(o[2] * rs * gn[2] * silu(z2), o[3] * rs * gn[3] * silu(z3));
            *(u32x2*)(OG + (size_t)tok * 1024 + idx) = w; }
    }
}

__device__ void phase_final(const Params& p) {
    const int tid = threadIdx.x, wave = tid >> 6, lane = tid & 63;
    unsigned char* ws = p.ws;
    const float* MOD = (const float*)(ws + WS_MOD);
    const float* X1 = (const float*)(ws + WS_X1);
    const float* Y = (const float*)(ws + WS_P2);
    for (int tok = blockIdx.x * 8 + wave; tok < NTOK; tok += gridDim.x * 8) {
        const int cond = tok < NPTOK ? 0 : 1 + ((tok - NPTOK) >> 11);
        f32x4 xv[4]; float ss = 0.f;
#pragma unroll
        for (int i = 0; i < 4; ++i) { const int idx = i * 256 + lane * 4;
            const f32x4 x1 = *(const f32x4*)(X1 + (size_t)tok * D + idx);
            const f32x4 ya = *(const f32x4*)(Y + (size_t)tok * D + idx), yb = *(const f32x4*)(Y + (size_t)NTOK * D + (size_t)tok * D + idx);
            const f32x4 gt = *(const f32x4*)(MOD + (1 * 3 + cond) * 3072 + 2048 + idx);
            xv[i] = x1 + gt * (ya + yb);
            ss += xv[i][0] * xv[i][0] + xv[i][1] * xv[i][1] + xv[i][2] * xv[i][2] + xv[i][3] * xv[i][3]; }
        ss = wave_sum(ss);
        const float rstd = rsqrtf(ss * (1.f / 1024.f) + 1e-6f);
#pragma unroll
        for (int i = 0; i < 4; ++i) { const int idx = i * 256 + lane * 4;
            const f32x4 g = *(const f32x4*)(p.in[9] + idx);
            f32x4 o;
#pragma unroll
            for (int j = 0; j < 4; ++j) o[j] = xv[i][j] * rstd * g[j];
            *(f32x4*)(p.out + (size_t)tok * D + idx) = o; }
    }
}


#define XB_TMO      128
#define XB_XCNT(j)  (256  + 64 * (j))
#define XB_XSUB(j)  (1280 + 64 * (j))
#define XB_XGEN(j)  (2304 + 64 * (j))
#define XB_TOP      3328
#define XB_TOPGEN   3392
#define XCD_BAR_WORDS 3456
#define XB_SPIN_CAP (1u << 18)

__device__ __forceinline__ unsigned xb_ld(unsigned* p)              { return __hip_atomic_load(p, __ATOMIC_RELAXED, __HIP_MEMORY_SCOPE_AGENT); }
__device__ __forceinline__ unsigned xb_add(unsigned* p, unsigned v) { return __hip_atomic_fetch_add(p, v, __ATOMIC_RELAXED, __HIP_MEMORY_SCOPE_AGENT); }
__device__ __forceinline__ unsigned xb_xcc_id() { return (unsigned)__builtin_amdgcn_s_getreg((3 << 11) | 20) & 0xFu; }
#define XB_SPIN(cond, bar) do { unsigned _sp = 0; while (cond) { __builtin_amdgcn_s_sleep(1); \
    if ((++_sp & 255u) == 0u) { if (xb_ld(&(bar)[XB_TMO])) break; if (_sp > XB_SPIN_CAP) { atomicAdd(&(bar)[XB_TMO], 1u); break; } } } } while (0)

struct XcdBarrier {
    unsigned* bar; unsigned x;
    volatile LAS unsigned* st;
};

__device__ __forceinline__ XcdBarrier xcd_barrier_post(unsigned* bar, volatile LAS unsigned* st) {
    XcdBarrier b; b.bar = bar; b.x = xb_xcc_id(); b.st = st;
    if (threadIdx.x == 0) (void)xb_add(&bar[XB_XCNT(b.x)], 1u);
    return b;
}
__device__ __forceinline__ void xcd_barrier_complete(unsigned* bar, unsigned x, unsigned& nloc, unsigned& nx) {
    const unsigned G = gridDim.x * gridDim.y * gridDim.z;
    unsigned sum, cnt, mine, sp = 0u;
    for (;;) {
        sum = 0u; cnt = 0u; mine = 0u;
#pragma unroll
        for (unsigned j = 0; j < 16; ++j) { const unsigned c = xb_ld(&bar[XB_XCNT(j)]); sum += c; cnt += (c > 0u) ? 1u : 0u; mine = (j == x) ? c : mine; }
        if (sum == G) break;
        __builtin_amdgcn_s_sleep(1);
        if ((++sp & 255u) == 0u) { if (xb_ld(&bar[XB_TMO])) break; if (sp > XB_SPIN_CAP) { atomicAdd(&bar[XB_TMO], 1u); break; } }
    }
    nloc = mine > 0u ? mine : 1u; nx = cnt > 0u ? cnt : 1u;
}

__device__ __forceinline__ void xcd_barrier(const XcdBarrier& b) {
    asm volatile("s_waitcnt vmcnt(0)" ::: "memory");
    __syncthreads();
    if (threadIdx.x == 0) {
        unsigned* bar = b.bar;
        __builtin_amdgcn_s_waitcnt(0);
        unsigned nloc = b.st[0], nx = b.st[1];
        if (nloc == 0u) { xcd_barrier_complete(bar, b.x, nloc, nx); b.st[0] = nloc; b.st[1] = nx; }
        const unsigned old = xb_add(&bar[XB_XSUB(b.x)], 1u);
        const unsigned gen = old / nloc;
        if (old + 1u == (gen + 1u) * nloc) {
            __builtin_amdgcn_fence(__ATOMIC_RELEASE, "agent");
            asm volatile("s_waitcnt vmcnt(0)" ::: "memory");
            const unsigned og = xb_add(&bar[XB_TOP], 1u);
            const unsigned tg = og / nx;
            if (og + 1u == (tg + 1u) * nx) xb_add(&bar[XB_TOPGEN], 1u);
            else XB_SPIN(xb_ld(&bar[XB_TOPGEN]) == tg, bar);
            __builtin_amdgcn_fence(__ATOMIC_ACQUIRE, "agent");
            xb_add(&bar[XB_XGEN(b.x)], 1u);
            asm volatile("s_waitcnt vmcnt(0)" ::: "memory");
        } else {
            XB_SPIN(xb_ld(&bar[XB_XGEN(b.x)]) == gen, bar);
            __builtin_amdgcn_fence(__ATOMIC_ACQUIRE, "agent");
            asm volatile("s_waitcnt vmcnt(0)" ::: "memory");
        }
    }
    __syncthreads();
}


constexpr int NPHASE = 13;
__global__ void __launch_bounds__(NTHR, 2) fwd_megakernel(Params p) {
    extern __shared__ __attribute__((aligned(16))) unsigned char smem[];
    float* ldsf = (float*)smem;
    LAS unsigned char* ldsl = (LAS unsigned char*)smem;
    unsigned char* ws = p.ws;
    volatile LAS unsigned* xst = (volatile LAS unsigned*)(ldsl + LDS_MAIN + 16);
    if (threadIdx.x == 0) { xst[0] = 0u; xst[1] = 0u; }
    __syncthreads();
    const XcdBarrier xbar = xcd_barrier_post((unsigned*)(ws + WS_BAR), xst);
    if (p.ph_lo < 0) cg::this_grid().sync();
#ifndef DUP_PHASE
#define DUP_PHASE -1
#endif
#define PHASE(n) if (p.ph_lo <= (n) && (n) < p.ph_hi && ((n) == p.ph_lo || (xcd_barrier(xbar), true))) for (int rep = 0; rep < ((n) == DUP_PHASE ? 2 : 1); ++rep, ((n) == DUP_PHASE ? (xcd_barrier(xbar), 0) : 0))
    PHASE(0) phase_prologue(p, ldsf);
    PHASE(1) phase_h(p, 0);
    PHASE(2) { pg8::Gemm g{(const bf16_t*)(ws + WS_H), (const bf16_t*)(ws + WS_BT0), NTOK, N0, 1024, 1024, 1}; pg8::Order S; S.init(NTOK, N0, 1, gridDim.x, blockIdx.x);
               pg8::EpiBf16 E{(bf16_t*)(ws + WS_P), N0}; pg8::gemm_phase(ldsl, g, S, E); }
    PHASE(3) phase_mix0(p, ldsf, rep);
    PHASE(4) phase_wkv_post(p);
    PHASE(5) { pg8::Gemm g{(const bf16_t*)(ws + WS_OC), (const bf16_t*)(ws + WS_WT0O), NTOK, 1024, 1024, 2048, 2}; pg8::Order S; S.init(NTOK, 1024, 2, gridDim.x, blockIdx.x);
               pg8::EpiF32 E{(float*)(ws + WS_P), 1024, (size_t)NTOK * 1024}; pg8::gemm_phase(ldsl, g, S, E); }
    PHASE(6) phase_h(p, 1);
    PHASE(7) { pg8::Gemm g{(const bf16_t*)(ws + WS_H), (const bf16_t*)(ws + WS_BT1), NTOK, N1, 1024, 1024, 1}; pg8::Order S; S.init(NTOK, N1, 1, gridDim.x, blockIdx.x);
               pg8::EpiBf16 E{(bf16_t*)(ws + WS_P), N1}; pg8::gemm_phase(ldsl, g, S, E); }
    PHASE(8) phase_gla_a(p, ldsf);
    PHASE(9) phase_gla_b(p, ldsf, rep);
    PHASE(10) phase_gla_post(p);
    PHASE(11) { pg8::Gemm g{(const bf16_t*)(ws + WS_OC), (const bf16_t*)(ws + WS_WT1O), NTOK, 1024, 512, 1024, 2}; pg8::Order S; S.init(NTOK, 1024, 2, gridDim.x, blockIdx.x);
                pg8::EpiF32 E{(float*)(ws + WS_P2), 1024, (size_t)NTOK * 1024}; pg8::gemm_phase(ldsl, g, S, E); }
    PHASE(12) phase_final(p);
}

extern "C" void kernel_launch(void* const* d_in, const int* in_sizes, int n_in, void* d_out, int out_size, void* d_ws, size_t ws_size, hipStream_t stream) {
    static int grid = 0;
    if (grid == 0) {
        if (n_in != 30 || ws_size < WS_END) { fprintf(stderr, "kernel_launch: unexpected n_in %d / ws_size %zu (need %zu)\n", n_in, ws_size, (size_t)WS_END); grid = -1; return; }
        int dev = 0, cus = 0, per_cu = 0;
        hipGetDevice(&dev);
        hipDeviceGetAttribute(&cus, hipDeviceAttributeMultiprocessorCount, dev);
        hipFuncSetAttribute((const void*)fwd_megakernel, hipFuncAttributeMaxDynamicSharedMemorySize, LDS_BYTES);
        hipOccupancyMaxActiveBlocksPerMultiprocessor(&per_cu, (const void*)fwd_megakernel, NTHR, LDS_BYTES);
        if (per_cu < 1) { fprintf(stderr, "kernel_launch: occupancy query returned %d\n", per_cu); per_cu = 1; }
        grid = cus * per_cu;
        (void)hipGetLastError();
    }
    if (grid < 0) return;
    hipMemsetAsync((char*)d_ws + WS_CTL, 0, 256, stream);
    hipMemsetAsync((char*)d_ws + WS_BAR, 0, XCD_BAR_WORDS * 4, stream);
    Params p{};
    for (int i = 0; i < 30; ++i) p.in[i] = (const float*)d_in[i];
    p.out = (float*)d_out; p.ws = (unsigned char*)d_ws;
#if MULTI_LAUNCH
    for (int ph = 0; ph < NPHASE; ++ph) { p.ph_lo = ph; p.ph_hi = ph + 1; hipLaunchKernelGGL(fwd_megakernel, dim3(grid), dim3(NTHR), LDS_BYTES, stream, p); }
#else
    p.ph_lo = 0; p.ph_hi = NPHASE;
    void* args[] = {&p};
    hipError_t e = hipLaunchCooperativeKernel((const void*)fwd_megakernel, dim3(grid), dim3(NTHR), args, LDS_BYTES, stream);
    if (e != hipSuccess) fprintf(stderr, "cooperative launch failed: %s (grid %d)\n", hipGetErrorString(e), grid);
#endif
}
```

```cpp
#include <hip/hip_runtime.h>
#include <hip/hip_cooperative_groups.h>
#include <cstdio>
namespace cg = cooperative_groups;

#define LAS __attribute__((address_space(3)))
typedef unsigned short bf16_t;
typedef short bf16x8 __attribute__((ext_vector_type(8)));
typedef float f32x4 __attribute__((ext_vector_type(4)));
typedef unsigned u32x4 __attribute__((ext_vector_type(4)));
typedef unsigned u32x2 __attribute__((ext_vector_type(2)));

#ifndef MULTI_LAUNCH
#define MULTI_LAUNCH 0
#endif

constexpr int D = 1024, NTOK = 8192, NPTOK = 4096;
constexpr int N0 = 8448;
constexpr int N1 = 3328;
constexpr int NTHR = 512;
constexpr int LDS_MAIN = 139264;
constexpr int LDS_BYTES = LDS_MAIN + 256;

constexpr size_t MB = 1024 * 1024;
constexpr size_t WS_CTL = 0;
constexpr size_t WS_MOD = 4096;
constexpr size_t WS_BON = WS_MOD + 2 * 3 * 3072 * 4;
constexpr size_t WS_BAR = 0x1A0000;
constexpr size_t WS_BT0 = 2 * MB;
constexpr size_t WS_WT0O = WS_BT0 + (size_t)N0 * 1024 * 2;
constexpr size_t WS_BT1 = WS_WT0O + (size_t)1024 * 2048 * 2;
constexpr size_t WS_WT1O = WS_BT1 + (size_t)N1 * 1024 * 2;
constexpr size_t WS_H = WS_WT1O + (size_t)1024 * 1024 * 2;
constexpr size_t WS_OC = WS_H + (size_t)NTOK * 1024 * 2;
constexpr size_t WS_X1 = WS_OC + (size_t)NTOK * 2048 * 2;
constexpr size_t WS_P = WS_X1 + (size_t)NTOK * 1024 * 4;
constexpr size_t WS_P2 = WS_P + 64 * MB;
constexpr size_t WS_END = WS_P + (size_t)NTOK * N0 * 2;

struct Params {
    const float* in[30];
    float* out;
    unsigned char* ws;
    int ph_lo, ph_hi;
};

__device__ __forceinline__ float bf2f(bf16_t h) { return __uint_as_float(((unsigned)h) << 16); }
__device__ __forceinline__ bf16_t f2bf(float f) { unsigned u = __float_as_uint(f); u += 0x7FFFu + ((u >> 16) & 1u); return (bf16_t)(u >> 16); }
__device__ __forceinline__ unsigned pack2(float lo, float hi) { return (unsigned)f2bf(lo) | ((unsigned)f2bf(hi) << 16); }
__device__ __forceinline__ float bflo(unsigned w) { return __uint_as_float(w << 16); }
__device__ __forceinline__ float bfhi(unsigned w) { return __uint_as_float(w & 0xFFFF0000u); }
__device__ __forceinline__ float silu(float x) { return x / (1.f + __expf(-x)); }
__device__ __forceinline__ float wave_sum(float v) {
#pragma unroll
    for (int m = 32; m >= 1; m >>= 1) v += __shfl_xor(v, m, 64);
    return v;
}

typedef float f32x2_t __attribute__((ext_vector_type(2)));
typedef __bf16 bf16x2_t __attribute__((ext_vector_type(2)));
__device__ __forceinline__ unsigned pk2(float lo, float hi) { const f32x2_t v = {lo, hi}; return __builtin_bit_cast(unsigned, __builtin_convertvector(v, bf16x2_t)); }
__device__ __forceinline__ bf16_t f2bf_hw(float f) { return __builtin_bit_cast(bf16_t, (__bf16)f); }

namespace pg8 {
constexpr int BM = 256, BK = 64, HALF = 128, HTB = HALF * BK * 2, NXCD = 8, WGM = 8;
__device__ __forceinline__ int lds_byte(int r, int c) { const int st = (r >> 4) * 2 + (c >> 5), rr = r & 15, cc = c & 31, ob = rr * 64 + cc * 2; return st * 1024 + (ob ^ (((ob >> 9) & 1) << 5)); }
__device__ __forceinline__ void stage_rc(int b, int& R, int& C) { const int st = b / 1024, sb = b % 1024, swz = sb ^ (((sb >> 9) & 1) << 5); R = (st >> 1) * 16 + swz / 64; C = (st & 1) * 32 + (swz % 64) / 2; }
__device__ __forceinline__ int perm32(int rho) { const int n = rho >> 4, i = rho & 15; return 8 * (i >> 2) + 4 * n + (i & 3); }

struct Unit { int pm, pn, ks; };
struct Gemm { const bf16_t* A; const bf16_t* Bt; int M, N, K, ld, KS; };

struct Order {
    int nM, nN, nNr, nwg, G, c;
    __device__ void init(int M, int N, int KS, int G_, int c_) { nM = M / BM; nNr = N / BM; nN = nNr * KS; nwg = nM * nN; G = G_; c = c_; }
    __device__ bool next(int i, Unit& u) const {
        const long L = (long)i * G + c; if (L >= nwg) return false;
        int wgid = (int)L; { const int q = nwg / NXCD, r = nwg % NXCD, xcd = wgid % NXCD, off = wgid / NXCD; wgid = (xcd < r ? xcd * (q + 1) : r * (q + 1) + (xcd - r) * q) + off; }
        const int nig = WGM * nN, gid = wgid / nig, fm = gid * WGM, gsz = (nM - fm) < WGM ? (nM - fm) : WGM;
        u.pm = fm + ((wgid % nig) % gsz); const int pn = (wgid % nig) / gsz; u.pn = pn % nNr; u.ks = pn / nNr; return true;
    }
};

__device__ __forceinline__ unsigned cvt_pk_bf16(float lo, float hi) { unsigned r; asm volatile("v_cvt_pk_bf16_f32 %0, %1, %2" : "=v"(r) : "v"(lo), "v"(hi)); return r; }

struct EpiF32 {
    static constexpr bool PERM = false;
    float* C; int ldc; size_t ks_stride;
    __device__ __forceinline__ void operator()(const f32x4 (&acc)[2][2][4][2], const Unit& u, int wr, int wc, int fr, int fq) const {
        const int row0 = u.pm * BM + wr * 64 + fr, col0 = u.pn * BM + wc * 32 + 4 * fq;
        float* Cb = C + (size_t)u.ks * ks_stride;
#pragma unroll
        for (int ai = 0; ai < 2; ++ai)
#pragma unroll
            for (int m = 0; m < 4; ++m) { float* rowp = Cb + (size_t)(row0 + ai * HALF + m * 16) * ldc + col0;
#pragma unroll
                for (int bj = 0; bj < 2; ++bj)
#pragma unroll
                    for (int n = 0; n < 2; ++n) *(f32x4*)(rowp + bj * HALF + n * 16) = acc[ai][bj][m][n]; }
    }
};
struct EpiBf16 {
    static constexpr bool PERM = true;
    bf16_t* O; int ldc;
    __device__ __forceinline__ void operator()(const f32x4 (&acc)[2][2][4][2], const Unit& u, int wr, int wc, int fr, int fq) const {
        const int row0 = u.pm * BM + wr * 64 + fr; const int col0 = u.pn * BM + wc * 32 + 8 * fq;
#pragma unroll
        for (int ai = 0; ai < 2; ++ai)
#pragma unroll
            for (int m = 0; m < 4; ++m) { bf16_t* rowp = O + (size_t)(row0 + ai * HALF + m * 16) * ldc + col0;
#pragma unroll
                for (int bj = 0; bj < 2; ++bj) { const f32x4 v0 = acc[ai][bj][m][0], v1 = acc[ai][bj][m][1];
                    u32x4 w; w.x = cvt_pk_bf16(v0[0], v0[1]); w.y = cvt_pk_bf16(v0[2], v0[3]); w.z = cvt_pk_bf16(v1[0], v1[1]); w.w = cvt_pk_bf16(v1[2], v1[3]);
                    *(u32x4*)(rowp + bj * HALF) = w; } }
    }
};

template <class Epi>
__device__ __forceinline__ void gemm_phase(LAS unsigned char* lds, const Gemm g, const Order& S, const Epi& E) {
    const int tid = threadIdx.x, wid = __builtin_amdgcn_readfirstlane(tid >> 6), lane = tid & 63, wr = wid >> 2, wc = wid & 3, fr = lane & 15, fq = lane >> 4;
    const int K = g.K, nt = K / BK, ld = g.ld;
    unsigned voffA[2], voffB[2];
#pragma unroll
    for (int i = 0; i < 2; ++i) { int R, C; stage_rc(tid * 16 + i * 8192, R, C); const int Rb = Epi::PERM ? ((R & ~31) + perm32(R & 31)) : R;
        voffA[i] = (unsigned)(R * ld + C) * 2u; voffB[i] = (unsigned)(Rb * ld + C) * 2u; }
    const size_t kstep = (size_t)(BK * 2);
    const size_t hstep = (size_t)HALF * ld * 2;
    const size_t tstep = 2 * hstep;
    const size_t ksb = (size_t)K * 2;
    const unsigned ldsw = (unsigned)wid * 1024u;
    const int aoff = lds_byte(wr * 64 + fr, fq * 8), boff = lds_byte(wc * 32 + fr, fq * 8);
#define PG8_SA(b, h) (((b) * 2 + (h)) * HTB)
#define PG8_SB(b, h) ((4 + (b) * 2 + (h)) * HTB)
#define PG8_STAGE(bufoff, gbase, voff) do { _Pragma("unroll") for (int _i = 0; _i < 2; ++_i) \
        __builtin_amdgcn_global_load_lds((const unsigned*)((const char*)(gbase) + (voff)[_i]), (LAS unsigned*)(lds + (bufoff) + ldsw + _i * 8192), 16, 0, 0); } while (0)
#define PG8_LDA(dst, b, h) do { _Pragma("unroll") for (int m = 0; m < 4; ++m) _Pragma("unroll") for (int k = 0; k < 2; ++k) dst[m][k] = *(const LAS bf16x8*)(lds + PG8_SA(b, h) + aoff + m * 2048 + k * 1024); } while (0)
#define PG8_LDB(dst, b, h) do { _Pragma("unroll") for (int n = 0; n < 2; ++n) _Pragma("unroll") for (int k = 0; k < 2; ++k) dst[n][k] = *(const LAS bf16x8*)(lds + PG8_SB(b, h) + boff + n * 2048 + k * 1024); } while (0)
#define PG8_MMA(ai, bj, At, Bt) do { __builtin_amdgcn_s_setprio(1); _Pragma("unroll") for (int m = 0; m < 4; ++m) _Pragma("unroll") for (int n = 0; n < 2; ++n) _Pragma("unroll") for (int k = 0; k < 2; ++k) \
        acc[ai][bj][m][n] = __builtin_amdgcn_mfma_f32_16x16x32_bf16(Bt[n][k], At[m][k], acc[ai][bj][m][n], 0, 0, 0); __builtin_amdgcn_s_setprio(0); } while (0)
#define PG8_WAIT_V(n) asm volatile("s_waitcnt vmcnt(" #n ")" ::: "memory")
#define PG8_WAIT_L(n) asm volatile("s_waitcnt lgkmcnt(" #n ")" ::: "memory")
#define PG8_BAR __builtin_amdgcn_s_barrier()
#define PG8_SCHED __builtin_amdgcn_sched_barrier(0)
    Unit cur, nxt; int ui = 0;
    if (!S.next(0, cur)) return;
    f32x4 acc[2][2][4][2];
#pragma unroll
    for (int a = 0; a < 2; ++a)
#pragma unroll
        for (int b = 0; b < 2; ++b)
#pragma unroll
            for (int m = 0; m < 4; ++m)
#pragma unroll
                for (int n = 0; n < 2; ++n) acc[a][b][m][n] = (f32x4){0.f, 0.f, 0.f, 0.f};
    bf16x8 At[4][2], B0[2][2], B1[2][2];
    const char* cA = (const char*)g.A + (size_t)cur.pm * tstep + (size_t)cur.ks * ksb; const char* cB = (const char*)g.Bt + (size_t)cur.pn * tstep + (size_t)cur.ks * ksb;
    PG8_STAGE(PG8_SB(0, 0), cB, voffB); PG8_STAGE(PG8_SA(0, 0), cA, voffA); PG8_STAGE(PG8_SB(0, 1), cB + hstep, voffB); PG8_STAGE(PG8_SA(0, 1), cA + hstep, voffA);
    if (wr == 1) PG8_BAR;
    PG8_WAIT_V(4); PG8_BAR;
    PG8_STAGE(PG8_SB(1, 0), cB + kstep, voffB); PG8_STAGE(PG8_SA(1, 0), cA + kstep, voffA); PG8_STAGE(PG8_SB(1, 1), cB + hstep + kstep, voffB);
    PG8_WAIT_V(6); PG8_BAR;
    for (;;) {
        const bool has_next = S.next(ui + 1, nxt);
        const char* nA = has_next ? (const char*)g.A + (size_t)nxt.pm * tstep + (size_t)nxt.ks * ksb : cA; const char* nB = has_next ? (const char*)g.Bt + (size_t)nxt.pn * tstep + (size_t)nxt.ks * ksb : cB;
        for (int t = 0; t < nt; t += 2) {
            const bool last = (t == nt - 2);
            const char* a1 = cA + (size_t)(t + 1) * kstep;
            const char* a2 = last ? nA : cA + (size_t)(t + 2) * kstep; const char* b2 = last ? nB : cB + (size_t)(t + 2) * kstep;
            const char* a3 = a2 + kstep; const char* b3 = b2 + kstep;
            PG8_LDB(B0, 0, 0); PG8_SCHED; PG8_LDA(At, 0, 0); PG8_STAGE(PG8_SA(1, 1), a1 + hstep, voffA);
            PG8_WAIT_L(8); PG8_BAR; PG8_WAIT_L(0); PG8_MMA(0, 0, At, B0); PG8_BAR; PG8_SCHED;
            PG8_LDB(B1, 0, 1); PG8_STAGE(PG8_SB(0, 0), b2, voffB);
            PG8_BAR; PG8_WAIT_L(0); PG8_MMA(0, 1, At, B1); PG8_BAR;
            PG8_LDA(At, 0, 1); PG8_STAGE(PG8_SA(0, 0), a2, voffA);
            PG8_BAR; PG8_WAIT_L(0); PG8_MMA(1, 0, At, B0); PG8_BAR; PG8_SCHED;
            PG8_STAGE(PG8_SB(0, 1), b2 + hstep, voffB);
            PG8_WAIT_V(6); PG8_BAR; PG8_MMA(1, 1, At, B1); PG8_BAR;
            PG8_LDB(B0, 1, 0); PG8_SCHED; PG8_LDA(At, 1, 0); PG8_STAGE(PG8_SA(0, 1), a2 + hstep, voffA);
            PG8_WAIT_L(8); PG8_BAR; PG8_WAIT_L(0); PG8_MMA(0, 0, At, B0); PG8_BAR; PG8_SCHED;
            PG8_LDB(B1, 1, 1); PG8_STAGE(PG8_SB(1, 0), b3, voffB);
            PG8_BAR; PG8_WAIT_L(0); PG8_MMA(0, 1, At, B1); PG8_BAR;
            PG8_LDA(At, 1, 1); PG8_STAGE(PG8_SA(1, 0), a3, voffA);
            PG8_BAR; PG8_WAIT_L(0); PG8_MMA(1, 0, At, B0); PG8_BAR; PG8_SCHED;
            PG8_STAGE(PG8_SB(1, 1), b3 + hstep, voffB);
            PG8_WAIT_V(6); PG8_BAR; PG8_MMA(1, 1, At, B1); PG8_BAR;
        }
        E(acc, cur, wr, wc, fr, fq);
        if (!has_next) break;
#pragma unroll
        for (int a = 0; a < 2; ++a)
#pragma unroll
            for (int b = 0; b < 2; ++b)
#pragma unroll
                for (int m = 0; m < 4; ++m)
#pragma unroll
                    for (int n = 0; n < 2; ++n) acc[a][b][m][n] = (f32x4){0.f, 0.f, 0.f, 0.f};
        cur = nxt; cA = nA; cB = nB; ++ui;
    }
    PG8_WAIT_V(0);
    if (wr == 0) PG8_BAR;
    PG8_BAR;
#undef PG8_SA
#undef PG8_SB
#undef PG8_STAGE
#undef PG8_LDA
#undef PG8_LDB
#undef PG8_MMA
#undef PG8_WAIT_V
#undef PG8_WAIT_L
#undef PG8_BAR
#undef PG8_SCHED
}
}

__device__ void transpose_tile(const float* __restrict__ src, int ldsrc, int N, int k0, int n0, bf16_t* __restrict__ dst, int lddst, int dstrow0, float* tile) {
    const int tid = threadIdx.x;
    for (int i = tid; i < 4096; i += NTHR) { const int kk = i >> 6, nn = i & 63; float v = 0.f; if (n0 + nn < N) v = src[(size_t)(k0 + kk) * ldsrc + n0 + nn]; tile[kk * 65 + nn] = v; }
    __syncthreads();
    for (int i = tid; i < 2048; i += NTHR) { const int nn = i >> 5, kp = (i & 31) * 2;
        if (n0 + nn < N) *(unsigned*)(dst + (size_t)(dstrow0 + n0 + nn) * lddst + k0 + kp) = pack2(tile[kp * 65 + nn], tile[(kp + 1) * 65 + nn]); }
    __syncthreads();
}

__device__ void phase_prologue(const Params& p, float* lds) {
    const int tid = threadIdx.x;
    unsigned char* ws = p.ws;
    bf16_t* BT0 = (bf16_t*)(ws + WS_BT0); bf16_t* WT0O = (bf16_t*)(ws + WS_WT0O); bf16_t* BT1 = (bf16_t*)(ws + WS_BT1); bf16_t* WT1O = (bf16_t*)(ws + WS_WT1O);
    float* MOD = (float*)(ws + WS_MOD);
    constexpr int NGEMV = 192, NT = 3680;
    for (int it = blockIdx.x; it < NGEMV + NT; it += gridDim.x) {
        if (it < NGEMV) {
            const int l = it / 96, j0 = (it % 96) * 32;
            float* sc = lds;
            float* red = lds + 3072;
            for (int i = tid; i < 3072; i += NTHR) { const int cnd = i >> 10, k = i & 1023; const float v = cnd == 0 ? p.in[5][k] : p.in[4][(cnd - 1) * 1024 + k]; sc[i] = silu(v); }
            __syncthreads();
            const int col = tid & 31, ksp = tid >> 5;
            float a0 = 0.f, a1 = 0.f, a2 = 0.f;
            const float* w = p.in[7] + (size_t)l * 1024 * 3072 + j0 + col;
#pragma unroll 16
            for (int k = ksp * 64; k < ksp * 64 + 64; ++k) { const float wv = w[(size_t)k * 3072]; a0 += sc[k] * wv; a1 += sc[1024 + k] * wv; a2 += sc[2048 + k] * wv; }
            red[(ksp * 3 + 0) * 32 + col] = a0; red[(ksp * 3 + 1) * 32 + col] = a1; red[(ksp * 3 + 2) * 32 + col] = a2;
            __syncthreads();
            if (tid < 96) { const int cnd = tid >> 5, cc = tid & 31; float s = 0.f; for (int q = 0; q < 16; ++q) s += red[(q * 3 + cnd) * 32 + cc];
                MOD[(l * 3 + cnd) * 3072 + j0 + cc] = s + p.in[8][l * 3072 + j0 + cc]; }
            __syncthreads();
        } else {
            int t = it - NGEMV;
            const float* src; int ldsrc, N; bf16_t* dst; int lddst, drow0, nnt;
            if (t < 2048) { src = p.in[10]; ldsrc = 8192; N = 8192; dst = BT0; lddst = 1024; drow0 = 0; nnt = 128; }
            else if (t < 2048 + 32) { t -= 2048; const int z = t >> 4; t &= 15; src = p.in[14] + (size_t)z * 1024 * 64; ldsrc = 64; N = 64; dst = BT0; lddst = 1024; drow0 = 8192 + z * 64; nnt = 1; }
            else if (t < 2048 + 64) { t -= 2048 + 32; const int z = t >> 4; t &= 15; src = p.in[17] + (size_t)z * 1024 * 64; ldsrc = 64; N = 64; dst = BT0; lddst = 1024; drow0 = 8320 + z * 64; nnt = 1; }
            else if (t < 2112 + 512) { t -= 2112; src = p.in[11]; ldsrc = 1024; N = 1024; dst = WT0O; lddst = 2048; drow0 = 0; nnt = 16; }
            else if (t < 2624 + 768) { t -= 2624; src = p.in[24]; ldsrc = 3072; N = 3072; dst = BT1; lddst = 1024; drow0 = 0; nnt = 48; }
            else if (t < 3392 + 32) { t -= 3392; const int z = t >> 4; t &= 15; src = p.in[26] + (size_t)z * 1024 * 16; ldsrc = 16; N = 16; dst = BT1; lddst = 1024; drow0 = 3072 + z * 16; nnt = 1; }
            else { t -= 3424; src = p.in[25]; ldsrc = 1024; N = 1024; dst = WT1O; lddst = 1024; drow0 = 0; nnt = 16; }
            const int kt = t / nnt, ntile = t % nnt;
            transpose_tile(src, ldsrc, N, kt * 64, ntile * 64, dst, lddst, drow0, lds);
        }
    }
    { u32x4* z = (u32x4*)(BT1 + (size_t)3104 * 1024); const int n = 224 * 1024 * 2 / 16;
      for (int i = blockIdx.x * NTHR + tid; i < n; i += gridDim.x * NTHR) z[i] = (u32x4){0u, 0u, 0u, 0u}; }
}

__device__ void phase_h(const Params& p, int layer) {
    const int tid = threadIdx.x, wave = tid >> 6, lane = tid & 63;
    unsigned char* ws = p.ws;
    const float* MOD = (const float*)(ws + WS_MOD);
    bf16_t* H = (bf16_t*)(ws + WS_H);
    float* X1 = (float*)(ws + WS_X1);
    const float* Y = (const float*)(ws + WS_P);
    for (int tok = blockIdx.x * 8 + wave; tok < NTOK; tok += gridDim.x * 8) {
        const float* xr = tok < NPTOK ? p.in[0] + (size_t)tok * D : p.in[1] + (size_t)(tok - NPTOK) * D;
        const int cond = tok < NPTOK ? 0 : 1 + ((tok - NPTOK) >> 11);
        f32x4 xv[4]; float ss = 0.f;
#pragma unroll
        for (int i = 0; i < 4; ++i) { const int idx = i * 256 + lane * 4; xv[i] = *(const f32x4*)(xr + idx);
            if (layer == 1) { const f32x4 ya = *(const f32x4*)(Y + (size_t)tok * D + idx), yb = *(const f32x4*)(Y + (size_t)NTOK * D + (size_t)tok * D + idx);
                const f32x4 gt = *(const f32x4*)(MOD + (0 * 3 + cond) * 3072 + 2048 + idx);
                xv[i] = xv[i] + gt * (ya + yb); *(f32x4*)(X1 + (size_t)tok * D + idx) = xv[i]; }
            ss += xv[i][0] * xv[i][0] + xv[i][1] * xv[i][1] + xv[i][2] * xv[i][2] + xv[i][3] * xv[i][3]; }
        ss = wave_sum(ss);
        const float rstd = rsqrtf(ss * (1.f / 1024.f) + 1e-6f);
#pragma unroll
        for (int i = 0; i < 4; ++i) { const int idx = i * 256 + lane * 4;
            const f32x4 g = *(const f32x4*)(p.in[6] + layer * D + idx);
            const f32x4 sh = *(const f32x4*)(MOD + (layer * 3 + cond) * 3072 + idx), sc = *(const f32x4*)(MOD + (layer * 3 + cond) * 3072 + 1024 + idx);
            f32x4 h;
#pragma unroll
            for (int j = 0; j < 4; ++j) h[j] = xv[i][j] * rstd * g[j] * (1.f + sc[j]) + sh[j];
            u32x2 w; w.x = pack2(h[0], h[1]); w.y = pack2(h[2], h[3]);
            *(u32x2*)(H + (size_t)tok * D + idx) = w; }
    }
}

__device__ __forceinline__ f32x4 mma_nt(const bf16_t* A, int lda, const bf16_t* B, int ldb, int K, f32x4 acc, int fr, int fq) {
    for (int k0 = 0; k0 < K; k0 += 32) {
        const bf16x8 a = *(const bf16x8*)(A + fr * lda + k0 + fq * 8);
        const bf16x8 b = *(const bf16x8*)(B + fr * ldb + k0 + fq * 8);
        acc = __builtin_amdgcn_mfma_f32_16x16x32_bf16(a, b, acc, 0, 0, 0);
    }
    return acc;
}
__device__ __forceinline__ bf16x8 pack8(float a0, float a1, float a2, float a3, float a4, float a5, float a6, float a7) {
    u32x4 w; w.x = pack2(a0, a1); w.y = pack2(a2, a3); w.z = pack2(a4, a5); w.w = pack2(a6, a7);
    return __builtin_bit_cast(bf16x8, w);
}
__device__ __forceinline__ float dpp_add(float v, float o) { return v + o; }
__device__ __forceinline__ float wave_sum_fast(float v) {
    v += __int_as_float(__builtin_amdgcn_update_dpp(0, __float_as_int(v), 0xB1, 0xF, 0xF, true));
    v += __int_as_float(__builtin_amdgcn_update_dpp(0, __float_as_int(v), 0x4E, 0xF, 0xF, true));
    v += __int_as_float(__builtin_amdgcn_update_dpp(0, __float_as_int(v), 0x141, 0xF, 0xF, true));
    v += __int_as_float(__builtin_amdgcn_update_dpp(0, __float_as_int(v), 0x140, 0xF, 0xF, true));
    v += __shfl_xor(v, 16, 64); v += __shfl_xor(v, 32, 64);
    return v;
}
__device__ __forceinline__ float fast_tanh(float x) { const float e = __expf(2.f * x); return 1.f - 2.f * __builtin_amdgcn_rcpf(1.f + e); }
__device__ __forceinline__ bf16x8 pack8h(float a0, float a1, float a2, float a3, float a4, float a5, float a6, float a7) {
    u32x4 w; w.x = pk2(a0, a1); w.y = pk2(a2, a3); w.z = pk2(a4, a5); w.w = pk2(a6, a7);
    return __builtin_bit_cast(bf16x8, w);
}

__device__ void wkv_unit(const Params& p, int u, float* ldsf) {
    const int tid0 = threadIdx.x, lane0 = tid0 & 63, w = __builtin_amdgcn_readfirstlane(tid0 >> 6), fr0 = lane0 & 15, fq0 = lane0 >> 4;
    unsigned char* ws = p.ws;
    unsigned char* lds = (unsigned char*)ldsf;
    const bf16_t* P = (const bf16_t*)(ws + WS_P);
    bf16_t* OD = (bf16_t*)(ws + WS_X1);
    float* BON = (float*)(ws + WS_BON);
    int z, b, hd, sgm, seqT, tok0; bool sample; const int T = 256;
    if (u < 512) { sample = true; z = u >> 8; b = (u >> 7) & 1; hd = (u >> 3) & 15; sgm = u & 7; seqT = 2048; tok0 = NPTOK + b * 2048; }
    else { const int q = u - 512; sample = false; z = q >> 8; b = (q >> 4) & 15; hd = q & 15; sgm = 0; seqT = 256; tok0 = b * 256; }
    const int qbase = sgm * 256;
    bf16_t* RHO = (bf16_t*)(ws + WS_H);
    float* GH = (float*)(ws + WS_BT0);
    bf16_t* TLW = (bf16_t*)(lds + 0);
    bf16_t* TLA = (bf16_t*)(lds + 9216);
    float* HT = (float*)(lds + 18432);
    bf16_t* KTr = (bf16_t*)(lds + 20480);
    bf16_t* BTr = (bf16_t*)(lds + 29696);
    bf16_t* KKH = (bf16_t*)(lds + 38912);
    bf16_t* RH = (bf16_t*)(lds + 48128);
    const bf16_t* VS = (const bf16_t*)(lds + 113664 + 2 * 8192);
    bf16_t* TA = (bf16_t*)(lds + 65536);
    bf16_t* NA = (bf16_t*)(lds + 70656);
    float* PC = (float*)(lds + 75776);
    bf16_t* KBm = (bf16_t*)(lds + 76800);
    float* MM = (float*)(lds + 97280);
    float* WA = (float*)(lds + 76800);
    bf16x8 bw[2];
    { const float* W2 = (w >> 2) ? p.in[18] : p.in[15];
#pragma unroll
      for (int ks = 0; ks < 2; ++ks) { float t8[8];
#pragma unroll
        for (int e = 0; e < 8; ++e) t8[e] = W2[(size_t)(z * 64 + ks * 32 + fq0 * 8 + e) * 1024 + hd * 64 + (w & 3) * 16 + fr0];
        bw[ks] = pack8h(t8[0], t8[1], t8[2], t8[3], t8[4], t8[5], t8[6], t8[7]); } }
    f32x4 Sacc[4];
#pragma unroll
    for (int kt = 0; kt < 4; ++kt) Sacc[kt] = (f32x4){0.f, 0.f, 0.f, 0.f};
    if (w >= 4) {
#pragma unroll
        for (int kt = 0; kt < 4; ++kt)
#pragma unroll
            for (int jj = 0; jj < 4; ++jj) Sacc[kt][jj] = (kt * 16 + fq0 * 4 + jj == (w - 4) * 16 + fr0) ? 1.f : 0.f; }
    const int ch = hd * 64 + lane0;
    const float w0c = p.in[13][z * 1024 + ch], a0c = p.in[16][z * 1024 + ch], kkc = p.in[19][ch], kac = p.in[20][ch], rkc = p.in[21][ch];
    bf16_t* RKV = (bf16_t*)(lds + 113664);
    u32x4 tlraw[2], rkvraw[3];
#define WKV_LOAD_RAW(tb_) do { \
        _Pragma("unroll") for (int h_ = 0; h_ < 2; ++h_) { const int idx_ = tid + h_ * NTHR; const int tau_ = idx_ >> 4, sg_ = idx_ & 15; const int t_ = z ? (seqT - 1 - (qbase + (tb_) + tau_)) : (qbase + (tb_) + tau_); \
            tlraw[h_] = *(const u32x4*)(P + (size_t)(tok0 + t_) * N0 + 8192 + (sg_ < 8 ? z * 64 + sg_ * 8 : 128 + z * 64 + (sg_ - 8) * 8)); } \
        { const int tau_ = tid >> 3, sg_ = tid & 7; const int t_ = z ? (seqT - 1 - (qbase + (tb_) + tau_)) : (qbase + (tb_) + tau_); const bf16_t* rp_ = P + (size_t)(tok0 + t_) * N0 + 4096 + hd * 64 + sg_ * 8; \
          rkvraw[0] = *(const u32x4*)rp_; rkvraw[1] = *(const u32x4*)(rp_ + 1024); rkvraw[2] = *(const u32x4*)(rp_ + 2048); } } while (0)
    { const int tid = tid0; WKV_LOAD_RAW(0); }
    __syncthreads();
#pragma unroll 1
    for (int tb = 0; tb < T; tb += 64) {
        int tid = tid0; asm volatile("" : "+v"(tid));
        const int lane = tid & 63, fr = lane & 15, fq = lane >> 4, c = lane;
        const int pcol = ((c >> 5) * 32) + (((c >> 2) & 3) * 8) + (((c >> 4) & 1) * 4) + (c & 3);
#pragma unroll
        for (int h = 0; h < 2; ++h) { const int idx = tid + h * NTHR; const int tau = idx >> 4, sg = idx & 15;
            u32x4 o = tlraw[h];
            if (sg < 8) { o.x = pk2(fast_tanh(bflo(o.x)), fast_tanh(bfhi(o.x))); o.y = pk2(fast_tanh(bflo(o.y)), fast_tanh(bfhi(o.y)));
                          o.z = pk2(fast_tanh(bflo(o.z)), fast_tanh(bfhi(o.z))); o.w = pk2(fast_tanh(bflo(o.w)), fast_tanh(bfhi(o.w))); }
            *(u32x4*)((sg < 8 ? TLW : TLA) + tau * 72 + (sg & 7) * 8) = o; }
#pragma unroll
        for (int h = 0; h < 3; ++h) *(u32x4*)(RKV + h * 4096 + (tid >> 3) * 64 + (tid & 7) * 8) = rkvraw[h];
        __syncthreads();
        if (tb + 64 < T) WKV_LOAD_RAW(tb + 64);
        { const bf16_t* TL = (w >> 2) ? TLA : TLW; float* WAo = WA + (w >> 2) * 64 * 68;
#pragma unroll
          for (int mt = 0; mt < 4; ++mt) { f32x4 acc = (f32x4){0.f, 0.f, 0.f, 0.f};
#pragma unroll
            for (int ks = 0; ks < 2; ++ks) { const bf16x8 a = *(const bf16x8*)(TL + (mt * 16 + fr) * 72 + ks * 32 + fq * 8);
                acc = __builtin_amdgcn_mfma_f32_16x16x32_bf16(a, bw[ks], acc, 0, 0, 0); }
#pragma unroll
            for (int jj = 0; jj < 4; ++jj) WAo[(mt * 16 + fq * 4 + jj) * 68 + (w & 3) * 16 + fr] = acc[jj]; } }
        __syncthreads();
        float kkv[8], kmv[8], bv[8], lwv[8], cum[8], rr[8];
        { float run = 0.f;
#pragma unroll
          for (int i = 0; i < 8; ++i) { const int tau = w * 8 + i; const int t = z ? (seqT - 1 - (qbase + tb + tau)) : (qbase + tb + tau); const int tokg = tok0 + t;
            const float wr_ = w0c + WA[tau * 68 + c], ap = a0c + WA[64 * 68 + tau * 68 + c];
            const float nx = -wr_; const float sp = fmaxf(nx, 0.f) + __logf(1.f + __expf(-fabsf(nx)));
            const float lw = -__expf(-sp - 0.5f);
            const float iclr = __builtin_amdgcn_rcpf(1.f + __expf(-ap));
            const float kxi = bf2f(RKV[4096 + tau * 64 + c]); rr[i] = bf2f(RKV[tau * 64 + c]);
            const float kkraw = kxi * kkc;
            const float ssq = wave_sum_fast(kkraw * kkraw);
            const float kk = kkraw * __builtin_amdgcn_rsqf(fmaxf(ssq, 1e-24f));
            const float kmod = kxi * (1.f + (iclr - 1.f) * kac);
            const float bon = wave_sum_fast(rr[i] * kmod * rkc);
            if (lane == 0) BON[((size_t)z * NTOK + tokg) * 16 + hd] = bon;
            run += lw;
            kkv[i] = kk; kmv[i] = kmod; bv[i] = kk * iclr; lwv[i] = lw; cum[i] = run; }
          HT[w * 64 + c] = run; }
        __syncthreads();
        { const float off = (w & 1) ? HT[(w - 1) * 64 + c] : 0.f; const int cn = w >> 1;
#pragma unroll
          for (int i = 0; i < 8; ++i) { const int tau = w * 8 + i; const int j = (w & 1) * 8 + i;
            const float cm = cum[i] + off;
            const float Pj = __expf(cm), ipj = __expf(-cm), pm1 = __expf(cm - lwv[i]);
            const unsigned kb2 = pk2(-bv[i] * ipj, kmv[i] * ipj);
            KTr[tau * 72 + pcol] = (bf16_t)(kb2 >> 16); BTr[tau * 72 + pcol] = f2bf_hw(bv[i] * ipj);
            const unsigned kr2 = pk2(kkv[i] * pm1, rr[i] * Pj);
            KKH[tau * 72 + pcol] = (bf16_t)(kr2 & 0xFFFFu); RH[tau * 72 + pcol] = (bf16_t)(kr2 >> 16);
            const int sU = (j >> 2) * 8 + (j & 3);
            KBm[(cn * 64 + c) * 40 + sU] = (bf16_t)(kb2 & 0xFFFFu); KBm[(cn * 64 + c) * 40 + sU + 4] = (bf16_t)(kb2 >> 16);
            if (j == 15) PC[cn * 64 + c] = Pj; } }
        __syncthreads();
#pragma unroll
        for (int q2 = 0; q2 < 2; ++q2) { const int id = w * 2 + q2; const int cn = id >> 2, which = id & 3;
          const bf16_t* Am = ((which & 1) ? KTr : BTr) + cn * 16 * 72; const bf16_t* Bm = ((which & 2) ? RH : KKH) + cn * 16 * 72;
          const f32x4 acc = mma_nt(Am, 72, Bm, 72, 64, (f32x4){0.f, 0.f, 0.f, 0.f}, fr, fq);
          f32x4 o;
#pragma unroll
          for (int jj = 0; jj < 4; ++jj) { const int i = fq * 4 + jj, j = fr; const bool keep = (which & 2) ? (i <= j) : (i < j); o[jj] = keep ? acc[jj] : 0.f; }
          *(f32x4*)(MM + (cn * 4 + which) * 256 + fr * 16 + fq * 4) = o; }
        __syncthreads();
        if (w == 0) { const int cn = lane >> 4, col = lane & 15;
            const float* MbT = MM + (cn * 4 + 0) * 256; const float* MkT = MM + (cn * 4 + 1) * 256;
            float Tc[16], A1[16];
#pragma unroll
            for (int i = 0; i < 16; ++i) { Tc[i] = (i == col) ? 1.f : 0.f; A1[i] = 0.f; }
#pragma unroll
            for (int l = 15; l >= 1; --l) {
                const float tl_ = Tc[l];
#pragma unroll
                for (int v4 = 0; v4 < 4; ++v4) if (v4 * 4 < l) { const f32x4 mb = *(const f32x4*)(MbT + l * 16 + v4 * 4), mk = *(const f32x4*)(MkT + l * 16 + v4 * 4);
#pragma unroll
                    for (int e = 0; e < 4; ++e) if (v4 * 4 + e < l) { Tc[v4 * 4 + e] -= mb[e] * tl_; A1[v4 * 4 + e] += mk[e] * tl_; } }
                asm volatile("" ::: "memory");
            }
            bf16_t* tao = TA + (cn * 16 + col) * 40;
#pragma unroll
            for (int g4 = 0; g4 < 4; ++g4) { u32x4 o; o.x = pk2(Tc[g4 * 4], Tc[g4 * 4 + 1]); o.y = pk2(Tc[g4 * 4 + 2], Tc[g4 * 4 + 3]); o.z = pk2(A1[g4 * 4], A1[g4 * 4 + 1]); o.w = pk2(A1[g4 * 4 + 2], A1[g4 * 4 + 3]);
                *(u32x4*)(tao + g4 * 8) = o; } }
        else if (w <= 4) { const int cn = w - 1, j = lane & 15, ig = lane >> 4;
            const f32x4 nb = *(const f32x4*)(MM + (cn * 4 + 2) * 256 + j * 16 + ig * 4), nk = *(const f32x4*)(MM + (cn * 4 + 3) * 256 + j * 16 + ig * 4);
            u32x4 o; o.x = pk2(-nb[0], -nb[1]); o.y = pk2(-nb[2], -nb[3]); o.z = pk2(nk[0], nk[1]); o.w = pk2(nk[2], nk[3]);
            *(u32x4*)(NA + (cn * 16 + j) * 40 + ig * 8) = o; }
        __syncthreads();
        if (w < 4 || sample) {
            const int vb = w & 3;
#pragma unroll 1
            for (int cn = 0; cn < 4; ++cn) {
                bf16x8 sb[2];
#pragma unroll
                for (int ks = 0; ks < 2; ++ks) sb[ks] = pack8h(Sacc[2 * ks][0], Sacc[2 * ks][1], Sacc[2 * ks][2], Sacc[2 * ks][3], Sacc[2 * ks + 1][0], Sacc[2 * ks + 1][1], Sacc[2 * ks + 1][2], Sacc[2 * ks + 1][3]);
                f32x4 U0 = (f32x4){0.f, 0.f, 0.f, 0.f}, O = (f32x4){0.f, 0.f, 0.f, 0.f};
#pragma unroll
                for (int ks = 0; ks < 2; ++ks) { const bf16x8 a = *(const bf16x8*)(KKH + (cn * 16 + fr) * 72 + ks * 32 + fq * 8);
                    U0 = __builtin_amdgcn_mfma_f32_16x16x32_bf16(a, sb[ks], U0, 0, 0, 0);
                    const bf16x8 ar = *(const bf16x8*)(RH + (cn * 16 + fr) * 72 + ks * 32 + fq * 8);
                    O = __builtin_amdgcn_mfma_f32_16x16x32_bf16(ar, sb[ks], O, 0, 0, 0); }
                float vf[4];
#pragma unroll
                for (int e = 0; e < 4; ++e) vf[e] = (w < 4) ? bf2f(VS[(cn * 16 + fq * 4 + e) * 64 + vb * 16 + fr]) : 0.f;
                const bf16x8 bU0 = pack8h(U0[0], U0[1], U0[2], U0[3], vf[0], vf[1], vf[2], vf[3]);
                const bf16x8 ta = *(const bf16x8*)(TA + (cn * 16 + fr) * 40 + fq * 8);
                const f32x4 U = __builtin_amdgcn_mfma_f32_16x16x32_bf16(ta, bU0, (f32x4){0.f, 0.f, 0.f, 0.f}, 0, 0, 0);
                const bf16x8 bUV = pack8h(U[0], U[1], U[2], U[3], vf[0], vf[1], vf[2], vf[3]);
                const bf16x8 na = *(const bf16x8*)(NA + (cn * 16 + fr) * 40 + fq * 8);
                O = __builtin_amdgcn_mfma_f32_16x16x32_bf16(na, bUV, O, 0, 0, 0);
#pragma unroll
                for (int jj = 0; jj < 4; ++jj) { const int tau = cn * 16 + fq * 4 + jj; const int t = z ? (seqT - 1 - (qbase + tb + tau)) : (qbase + tb + tau);
                    if (w < 4) OD[((size_t)z * NTOK + tok0 + t) * 1024 + hd * 64 + vb * 16 + fr] = f2bf_hw(O[jj]);
                    else RHO[((size_t)z * 4096 + (tok0 - NPTOK) + t) * 1024 + hd * 64 + vb * 16 + fr] = f2bf_hw(O[jj]); }
#pragma unroll
                for (int kt = 0; kt < 4; ++kt) { const bf16x8 kb = *(const bf16x8*)(KBm + (cn * 64 + kt * 16 + fr) * 40 + fq * 8);
                    Sacc[kt] = __builtin_amdgcn_mfma_f32_16x16x32_bf16(kb, bUV, Sacc[kt], 0, 0, 0);
                    const f32x4 pc = *(const f32x4*)(PC + cn * 64 + kt * 16 + fq * 4);
                    Sacc[kt] = Sacc[kt] * pc; }
            }
        }
        __syncthreads();
    }
#undef WKV_LOAD_RAW
    if (!sample) { if (w < 4) { float* so = p.out + (size_t)2 * NPTOK * D + ((size_t)((b * 2 + z) * 16 + hd)) * 4096 + (size_t)(w * 16 + fr0) * 64;
#pragma unroll
        for (int kt = 0; kt < 4; ++kt)
#pragma unroll
            for (int jj = 0; jj < 4; ++jj) so[kt * 16 + fq0 * 4 + jj] = Sacc[kt][jj]; } }
    else { float* so = GH + ((size_t)u * 2 + (w >> 2)) * 4096 + (size_t)((w & 3) * 16 + fr0) * 64;
#pragma unroll
        for (int kt = 0; kt < 4; ++kt)
#pragma unroll
            for (int jj = 0; jj < 4; ++jj) so[kt * 16 + fq0 * 4 + jj] = Sacc[kt][jj]; }
    __syncthreads();
}

__device__ void wkv_fix_unit(const Params& p, int u, float* ldsf) {
    const int tid = threadIdx.x, lane = tid & 63, w = __builtin_amdgcn_readfirstlane(tid >> 6), fr = lane & 15, fq = lane >> 4;
    unsigned char* ws = p.ws;
    bf16_t* OD = (bf16_t*)(ws + WS_X1);
    const bf16_t* RHO = (const bf16_t*)(ws + WS_H);
    const float* GH = (const float*)(ws + WS_BT0);
    const int z = u >> 7, b = (u >> 6) & 1, hd = (u >> 2) & 15, vq = u & 3;
    float* SS = ldsf;
    float* GL = ldsf + 1024;
    bf16_t* SB = (bf16_t*)(ldsf + 1024 + 4096);
    const int v = tid >> 5, kp = (tid & 31) * 2;
    { const float* s0 = p.in[2] + ((size_t)((b * 2 + z) * 16 + hd)) * 4096 + (size_t)(vq * 16 + v) * 64 + kp; SS[v * 64 + kp] = s0[0]; SS[v * 64 + kp + 1] = s0[1]; }
    __syncthreads();
#pragma unroll 1
    for (int sg = 0; sg < 8; ++sg) {
        const int su = ((z * 2 + b) * 16 + hd) * 8 + sg;
        SB[v * 72 + kp] = f2bf_hw(SS[v * 64 + kp]); SB[v * 72 + kp + 1] = f2bf_hw(SS[v * 64 + kp + 1]);
        if (sg < 7) { const f32x4* gsrc = (const f32x4*)(GH + ((size_t)su * 2 + 1) * 4096);
#pragma unroll
            for (int q = 0; q < 2; ++q) ((f32x4*)GL)[tid + q * NTHR] = gsrc[tid + q * NTHR]; }
        __syncthreads();
        const int tlo = z ? (2048 - (sg + 1) * 256) : sg * 256;
#pragma unroll
        for (int q = 0; q < 2; ++q) { const int mt = 2 * w + q;
            f32x4 acc = (f32x4){0.f, 0.f, 0.f, 0.f};
#pragma unroll
            for (int ks = 0; ks < 2; ++ks) { const bf16x8 a = *(const bf16x8*)(RHO + ((size_t)z * 4096 + b * 2048 + tlo + mt * 16 + fr) * 1024 + hd * 64 + ks * 32 + fq * 8);
                const bf16x8 bb = *(const bf16x8*)(SB + fr * 72 + ks * 32 + fq * 8);
                acc = __builtin_amdgcn_mfma_f32_16x16x32_bf16(a, bb, acc, 0, 0, 0); }
#pragma unroll
            for (int jj = 0; jj < 4; ++jj) { bf16_t* op = OD + ((size_t)z * NTOK + NPTOK + b * 2048 + tlo + mt * 16 + fq * 4 + jj) * 1024 + hd * 64 + vq * 16 + fr;
                *op = f2bf_hw(bf2f(*op) + acc[jj]); } }
        if (sg < 7) {
            const float* hsrc = GH + ((size_t)su * 2 + 0) * 4096 + (size_t)(vq * 16 + v) * 64 + kp;
            float a0 = hsrc[0], a1 = hsrc[1];
#pragma unroll 8
            for (int k2 = 0; k2 < 64; ++k2) { const float sv = SS[v * 64 + k2]; a0 += sv * GL[k2 * 64 + kp]; a1 += sv * GL[k2 * 64 + kp + 1]; }
            __syncthreads();
            SS[v * 64 + kp] = a0; SS[v * 64 + kp + 1] = a1;
        }
        __syncthreads();
    }
}
__device__ void phase_wkv_fix(const Params& p, float* lds) {
    for (int it = blockIdx.x; it < 256; it += gridDim.x) wkv_fix_unit(p, it, lds);
}

__device__ void conv_tile(const Params& p, int tile) {
    const int tid = threadIdx.x;
    unsigned char* ws = p.ws;
    const bf16_t* P = (const bf16_t*)(ws + WS_P);
    bf16_t* OC = (bf16_t*)(ws + WS_OC);
    const int cgp = tid & 127, c0 = cgp * 8, sub = tid >> 7;
    float cw0[8], cw1[8], cw2[8];
#pragma unroll
    for (int j = 0; j < 8; ++j) { cw0[j] = p.in[12][c0 + j]; cw1[j] = p.in[12][1024 + c0 + j]; cw2[j] = p.in[12][2048 + c0 + j]; }
    for (int jj = 0; jj < 4; ++jj) {
        const int t = tile * 16 + sub + 4 * jj;
        const int rl = t < NPTOK ? 256 : 64; const int pos = t & (rl - 1);
        const bf16_t* row = P + (size_t)t * N0;
        const u32x4 z4 = (u32x4){0u, 0u, 0u, 0u};
        const u32x4 u1 = *(const u32x4*)(row + c0), g1 = *(const u32x4*)(row + 2048 + c0);
        const u32x4 u0 = pos > 0 ? *(const u32x4*)(row - N0 + c0) : z4, g0 = pos > 0 ? *(const u32x4*)(row - N0 + 2048 + c0) : z4;
        const u32x4 u2 = pos < rl - 1 ? *(const u32x4*)(row + N0 + c0) : z4, g2 = pos < rl - 1 ? *(const u32x4*)(row + N0 + 2048 + c0) : z4;
        const u32x4 gb = *(const u32x4*)(row + 1024 + c0), zc = *(const u32x4*)(row + 3072 + c0);
        u32x4 o;
#pragma unroll
        for (int q = 0; q < 4; ++q) {
            const float y0 = cw0[2 * q] * (bflo(g0[q]) * bflo(u0[q])) + cw1[2 * q] * (bflo(g1[q]) * bflo(u1[q])) + cw2[2 * q] * (bflo(g2[q]) * bflo(u2[q]));
            const float y1 = cw0[2 * q + 1] * (bfhi(g0[q]) * bfhi(u0[q])) + cw1[2 * q + 1] * (bfhi(g1[q]) * bfhi(u1[q])) + cw2[2 * q + 1] * (bfhi(g2[q]) * bfhi(u2[q]));
            o[q] = pack2(silu(bflo(zc[q])) * bflo(gb[q]) * y0, silu(bfhi(zc[q])) * bfhi(gb[q]) * y1);
        }
        *(u32x4*)(OC + (size_t)t * 2048 + c0) = o;
    }
}

__device__ void phase_mix0(const Params& p, float* lds, int rep) {
    unsigned* ctr = (unsigned*)(p.ws + WS_CTL) + rep * 32;
    int* slot = (int*)(lds + LDS_MAIN / 4);
    constexpr int NSCAN = 1024, NCONV = 512;
    for (;;) {
        if (threadIdx.x == 0) *slot = (int)atomicAdd(ctr, 1u);
        __syncthreads();
        const int it = *slot;
        __syncthreads();
        if (it >= NSCAN + NCONV) break;
        if (it < NSCAN) wkv_unit(p, it, lds); else conv_tile(p, it - NSCAN);
    }
}

__device__ __forceinline__ float quad_sum(float v) {
    v += __int_as_float(__builtin_amdgcn_update_dpp(0, __float_as_int(v), 0xB1, 0xF, 0xF, true));
    v += __int_as_float(__builtin_amdgcn_update_dpp(0, __float_as_int(v), 0x4E, 0xF, 0xF, true));
    return v;
}
__device__ void phase_wkv_post(const Params& p) {
    const int tid = threadIdx.x, wave = tid >> 6, lane = tid & 63;
    unsigned char* ws = p.ws;
    const bf16_t* P = (const bf16_t*)(ws + WS_P);
    const bf16_t* OD = (const bf16_t*)(ws + WS_X1);
    const float* BON = (const float*)(ws + WS_BON);
    bf16_t* OC = (bf16_t*)(ws + WS_OC);
    const int hh = lane >> 2, ch0 = hh * 64 + (lane & 3) * 16;
    for (int tok = blockIdx.x * 8 + wave; tok < NTOK; tok += gridDim.x * 8) {
        const bf16_t* row = P + (size_t)tok * N0;
        u32x4 a0[2], a1[2], vv[2], zz[2];
#pragma unroll
        for (int h = 0; h < 2; ++h) { a0[h] = *(const u32x4*)(OD + (size_t)tok * 1024 + ch0 + h * 8); a1[h] = *(const u32x4*)(OD + ((size_t)NTOK + tok) * 1024 + ch0 + h * 8);
            vv[h] = *(const u32x4*)(row + 6144 + ch0 + h * 8); zz[h] = *(const u32x4*)(row + 7168 + ch0 + h * 8); }
        const float bon = BON[(size_t)tok * 16 + hh] + BON[((size_t)NTOK + tok) * 16 + hh];
        float o[16]; float s1 = 0.f;
#pragma unroll
        for (int h = 0; h < 2; ++h)
#pragma unroll
            for (int q = 0; q < 4; ++q) { o[h * 8 + 2 * q] = bflo(a0[h][q]) + bflo(a1[h][q]); o[h * 8 + 2 * q + 1] = bfhi(a0[h][q]) + bfhi(a1[h][q]); s1 += o[h * 8 + 2 * q] + o[h * 8 + 2 * q + 1]; }
        const float mu = quad_sum(s1) * (1.f / 64.f);
        float s2 = 0.f;
#pragma unroll
        for (int i = 0; i < 16; ++i) { o[i] -= mu; s2 += o[i] * o[i]; }
        const float rs = rsqrtf(quad_sum(s2) * (1.f / 64.f) + 64e-5f);
        float res[16];
#pragma unroll
        for (int g4 = 0; g4 < 4; ++g4) { const f32x4 lw4 = *(const f32x4*)(p.in[22] + ch0 + g4 * 4), lb4 = *(const f32x4*)(p.in[23] + ch0 + g4 * 4);
#pragma unroll
            for (int e = 0; e < 4; ++e) { const int i = g4 * 4 + e; const unsigned vw = vv[i >> 3][(i & 7) >> 1], zw_ = zz[i >> 3][(i & 7) >> 1];
                const float v1 = (i & 1) ? bfhi(vw) : bflo(vw), z1 = (i & 1) ? bfhi(zw_) : bflo(zw_);
                res[i] = (o[i] * rs * lw4[e] + lb4[e] + bon * v1) * silu(z1); } }
#pragma unroll
        for (int h = 0; h < 2; ++h) { u32x4 w4; w4.x = pk2(res[h * 8 + 0], res[h * 8 + 1]); w4.y = pk2(res[h * 8 + 2], res[h * 8 + 3]); w4.z = pk2(res[h * 8 + 4], res[h * 8 + 5]); w4.w = pk2(res[h * 8 + 6], res[h * 8 + 7]);
            *(u32x4*)(OC + (size_t)tok * 2048 + 1024 + ch0 + h * 8) = w4; }
    }
}

constexpr size_t WS_QE = WS_H;
constexpr size_t WS_KDT = WS_BT0;
constexpr size_t WS_VT = WS_OC + (size_t)NTOK * 1024 * 2;
constexpr size_t WS_EBL = WS_BON + (size_t)2 * NTOK * 16 * 4;

__device__ void gla_a_item(const Params& p, int item, float* ldsf) {
    const int tid = threadIdx.x, lane = tid & 63, w = __builtin_amdgcn_readfirstlane(tid >> 6), fr = lane & 15, fq = lane >> 4;
    unsigned char* ws = p.ws;
    const bf16_t* P1 = (const bf16_t*)(ws + WS_P);
    float* OD = (float*)(ws + WS_P2);
    bf16_t* QEg = (bf16_t*)(ws + WS_QE); bf16_t* KDTg = (bf16_t*)(ws + WS_KDT); bf16_t* VTg = (bf16_t*)(ws + WS_VT); float* EBLg = (float*)(ws + WS_EBL);
    const int hd = item & 3, c = (item >> 2) & 127, z = item >> 9, tok0 = c * 64;
    bf16_t* QE = (bf16_t*)ldsf;
    bf16_t* KE = QE + 64 * 136;
    bf16_t* VT = KE + 64 * 136;
    bf16_t* ATT = VT + 256 * 72;
    float* G = (float*)(ATT + 64 * 72);
    float* L1G = G + 64 * 132;
    float* GK2 = L1G + 1024;
    for (int i = tid; i < 1024; i += NTHR) { const int t = i >> 4, r = i & 15; L1G[i] = bf2f(P1[(size_t)(tok0 + t) * N1 + 3072 + z * 16 + r]); }
    for (int i = tid; i < 2048; i += NTHR) { const int r = i >> 7, d = i & 127; GK2[i] = p.in[27][(size_t)(z * 16 + r) * 512 + hd * 128 + d]; }
#pragma unroll
    for (int ps = 0; ps < 4; ++ps) { const int t = ps * 16 + (tid >> 5), e8 = (tid & 31) * 8;
        const u32x4 v8 = *(const u32x4*)(P1 + (size_t)(tok0 + t) * N1 + 1024 + hd * 256 + e8);
        VT[(e8 + 0) * 72 + t] = (bf16_t)(v8.x & 0xFFFF); VT[(e8 + 1) * 72 + t] = (bf16_t)(v8.x >> 16); VT[(e8 + 2) * 72 + t] = (bf16_t)(v8.y & 0xFFFF); VT[(e8 + 3) * 72 + t] = (bf16_t)(v8.y >> 16);
        VT[(e8 + 4) * 72 + t] = (bf16_t)(v8.z & 0xFFFF); VT[(e8 + 5) * 72 + t] = (bf16_t)(v8.z >> 16); VT[(e8 + 6) * 72 + t] = (bf16_t)(v8.w & 0xFFFF); VT[(e8 + 7) * 72 + t] = (bf16_t)(v8.w >> 16); }
    const int d = tid & 127, tq = tid >> 7;
    const float gbias = p.in[28][z * 512 + hd * 128 + d];
    bf16_t qraw[16], kraw[16];
#pragma unroll
    for (int i = 0; i < 16; ++i) { const size_t row = (size_t)(tok0 + tq * 16 + i) * N1; qraw[i] = P1[row + hd * 128 + d]; kraw[i] = P1[row + 512 + hd * 128 + d]; }
    __syncthreads();
    { float run = 0.f;
#pragma unroll 4
      for (int i = 0; i < 16; ++i) { const int t = z ? (tq * 16 + 15 - i) : (tq * 16 + i);
        float x = gbias;
#pragma unroll
        for (int r = 0; r < 16; ++r) x += L1G[t * 16 + r] * GK2[r * 128 + d];
        const float ls = fminf(x, 0.f) - __logf(1.f + __expf(-fabsf(x)));
        run += ls * (1.f / 16.f);
        G[t * 132 + d] = run; } }
    __syncthreads();
    { const int lastr = z ? 0 : 15;
      const float t0 = G[(0 + lastr) * 132 + d], t1 = G[(16 + lastr) * 132 + d], t2 = G[(32 + lastr) * 132 + d], t3 = G[(48 + lastr) * 132 + d];
      const float blast = t0 + t1 + t2 + t3;
      float off;
      if (z == 0) off = tq == 0 ? 0.f : (tq == 1 ? t0 : (tq == 2 ? t0 + t1 : t0 + t1 + t2));
      else off = tq == 3 ? 0.f : (tq == 2 ? t3 : (tq == 1 ? t3 + t2 : t3 + t2 + t1));
      if (tq == 0) EBLg[(size_t)(z * 128 + c) * 512 + hd * 128 + d] = __expf(blast);
      unsigned kdp[8];
#pragma unroll
      for (int i = 0; i < 16; ++i) { const int t = tq * 16 + i;
        const float bc = G[t * 132 + d] + off;
        const float q = bf2f(qraw[i]) * 0.08838834764831845f, k = bf2f(kraw[i]);
        const bf16_t qe = f2bf(q * __expf(bc));
        QE[t * 136 + d] = qe; KE[t * 136 + d] = f2bf(k * __expf(-bc));
        QEg[((size_t)z * NTOK + tok0 + t) * 512 + hd * 128 + d] = qe;
        const unsigned kd = (unsigned)f2bf(k * __expf(blast - bc));
        if (i & 1) kdp[i >> 1] |= kd << 16; else kdp[i >> 1] = kd; }
      bf16_t* kdst = KDTg + ((size_t)(((z * 128 + c) * 4 + hd) * 128 + d)) * 64 + tq * 16;
      *(u32x4*)kdst = (u32x4){kdp[0], kdp[1], kdp[2], kdp[3]}; *(u32x4*)(kdst + 8) = (u32x4){kdp[4], kdp[5], kdp[6], kdp[7]}; }
    __syncthreads();
    if (z == 0) {
#pragma unroll
        for (int q4 = 0; q4 < 4; ++q4) { const int idx = q4 * NTHR + tid; const int e = idx >> 3, t8 = (idx & 7) * 8;
            *(u32x4*)(VTg + ((size_t)((c * 4 + hd) * 256 + e)) * 64 + t8) = *(const u32x4*)(VT + e * 72 + t8); } }
#pragma unroll
    for (int q2 = 0; q2 < 2; ++q2) { const int tA = 2 * w + q2, ia = tA >> 2, ja = tA & 3;
        f32x4 a4 = (f32x4){0.f, 0.f, 0.f, 0.f};
        if (z ? (ja >= ia) : (ja <= ia)) a4 = mma_nt(QE + ia * 16 * 136, 136, KE + ja * 16 * 136, 136, 128, a4, fr, fq);
#pragma unroll
        for (int jj = 0; jj < 4; ++jj) { const int i = ia * 16 + fq * 4 + jj, j = ja * 16 + fr; const bool keep = z ? (j >= i) : (j <= i); ATT[i * 72 + j] = f2bf(keep ? a4[jj] : 0.f); } }
    __syncthreads();
    { const int it = w & 3, eg = w >> 2;
#pragma unroll
      for (int e8 = 0; e8 < 8; ++e8) { const int et = eg * 8 + e8;
        const f32x4 o = mma_nt(ATT + it * 16 * 72, 72, VT + et * 16 * 72, 72, 64, (f32x4){0.f, 0.f, 0.f, 0.f}, fr, fq);
#pragma unroll
        for (int jj = 0; jj < 4; ++jj) OD[((size_t)z * NTOK + tok0 + it * 16 + fq * 4 + jj) * 1024 + hd * 256 + et * 16 + fr] = o[jj]; } }
    __syncthreads();
}

__device__ void phase_gla_a(const Params& p, float* lds) {
    for (int it = blockIdx.x; it < 1024; it += gridDim.x) gla_a_item(p, it, lds);
}

struct GlaFrags { bf16x8 kdt[2]; bf16x8 vt[4][2]; bf16x8 qe[4]; f32x4 ebl; f32x4 od[2]; };

__device__ void gla_b_unit(const Params& p, int u, float* ldsf) {
    const int tid = threadIdx.x, lane = tid & 63, w = __builtin_amdgcn_readfirstlane(tid >> 6), fr = lane & 15, fq = lane >> 4;
    unsigned char* ws = p.ws;
    float* OD = (float*)(ws + WS_P2);
    const bf16_t* QEg = (const bf16_t*)(ws + WS_QE); const bf16_t* KDTg = (const bf16_t*)(ws + WS_KDT); const bf16_t* VTg = (const bf16_t*)(ws + WS_VT); const float* EBLg = (const float*)(ws + WS_EBL);
    int z, b, hd, eq, nch, ch0; bool sample;
    if (u < 64) { sample = true; z = u >> 5; b = (u >> 4) & 1; hd = (u >> 2) & 3; eq = u & 3; nch = 32; ch0 = 64 + b * 32; }
    else { const int q = u - 64; sample = false; z = q >> 8; b = (q >> 4) & 15; hd = (q >> 2) & 3; eq = q & 3; nch = 4; ch0 = b * 4; }
    bf16_t* ST = (bf16_t*)ldsf;
    f32x4 Sacc[4];
    if (sample) { const float* s0 = p.in[3] + ((size_t)((b * 2 + z) * 4 + hd)) * 32768 + eq * 64 + fr;
#pragma unroll
        for (int et = 0; et < 4; ++et)
#pragma unroll
            for (int jj = 0; jj < 4; ++jj) Sacc[et][jj] = s0[(size_t)(w * 16 + fq * 4 + jj) * 256 + et * 16]; }
    else {
#pragma unroll
        for (int et = 0; et < 4; ++et) Sacc[et] = (f32x4){0.f, 0.f, 0.f, 0.f}; }
    const int it = w >> 1, e2 = (w & 1) * 2;
#define GLA_LOAD(F, c_) do { const int cc_ = (c_); \
        _Pragma("unroll") for (int ks = 0; ks < 2; ++ks) { (F).kdt[ks] = *(const bf16x8*)(KDTg + ((size_t)(((z * 128 + cc_) * 4 + hd) * 128 + w * 16 + fr)) * 64 + ks * 32 + fq * 8); \
            _Pragma("unroll") for (int et = 0; et < 4; ++et) (F).vt[et][ks] = *(const bf16x8*)(VTg + ((size_t)((cc_ * 4 + hd) * 256 + eq * 64 + et * 16 + fr)) * 64 + ks * 32 + fq * 8); } \
        _Pragma("unroll") for (int ks = 0; ks < 4; ++ks) (F).qe[ks] = *(const bf16x8*)(QEg + ((size_t)z * NTOK + cc_ * 64 + it * 16 + fr) * 512 + hd * 128 + ks * 32 + fq * 8); \
        (F).ebl = *(const f32x4*)(EBLg + (size_t)(z * 128 + cc_) * 512 + hd * 128 + w * 16 + fq * 4); \
        _Pragma("unroll") for (int q2 = 0; q2 < 2; ++q2) _Pragma("unroll") for (int jj = 0; jj < 4; ++jj) \
            (F).od[q2][jj] = OD[((size_t)z * NTOK + cc_ * 64 + it * 16 + fq * 4 + jj) * 1024 + hd * 256 + eq * 64 + (e2 + q2) * 16 + fr]; } while (0)
    GlaFrags cur, nxt;
    GLA_LOAD(cur, ch0 + (z ? nch - 1 : 0));
    __syncthreads();
#pragma unroll 1
    for (int ci = 0; ci < nch; ++ci) {
        const int c = ch0 + (z ? nch - 1 - ci : ci);
        bf16_t* STc = ST + (ci & 1) * 64 * 136;
#pragma unroll
        for (int et = 0; et < 4; ++et) { u32x2 v2; v2.x = pack2(Sacc[et][0], Sacc[et][1]); v2.y = pack2(Sacc[et][2], Sacc[et][3]);
            *(u32x2*)(STc + (et * 16 + fr) * 136 + w * 16 + fq * 4) = v2; }
        if (ci + 1 < nch) GLA_LOAD(nxt, ch0 + (z ? nch - 2 - ci : ci + 1));
        __syncthreads();
#pragma unroll
        for (int et = 0; et < 4; ++et) { Sacc[et] = Sacc[et] * cur.ebl;
#pragma unroll
            for (int ks = 0; ks < 2; ++ks) Sacc[et] = __builtin_amdgcn_mfma_f32_16x16x32_bf16(cur.kdt[ks], cur.vt[et][ks], Sacc[et], 0, 0, 0); }
#pragma unroll
        for (int q2 = 0; q2 < 2; ++q2) { f32x4 o = cur.od[q2];
#pragma unroll
            for (int ks = 0; ks < 4; ++ks) { const bf16x8 bS = *(const bf16x8*)(STc + ((e2 + q2) * 16 + fr) * 136 + ks * 32 + fq * 8);
                o = __builtin_amdgcn_mfma_f32_16x16x32_bf16(cur.qe[ks], bS, o, 0, 0, 0); }
#pragma unroll
            for (int jj = 0; jj < 4; ++jj) OD[((size_t)z * NTOK + c * 64 + it * 16 + fq * 4 + jj) * 1024 + hd * 256 + eq * 64 + (e2 + q2) * 16 + fr] = o[jj]; }
        cur = nxt;
    }
#undef GLA_LOAD
    if (!sample) { float* so = p.out + (size_t)2 * NPTOK * D + 2097152 + ((size_t)((b * 2 + z) * 4 + hd)) * 32768 + eq * 64 + fr;
#pragma unroll
        for (int et = 0; et < 4; ++et)
#pragma unroll
            for (int jj = 0; jj < 4; ++jj) so[(size_t)(w * 16 + fq * 4 + jj) * 256 + et * 16] = Sacc[et][jj]; }
    __syncthreads();
}

__device__ void phase_gla_b(const Params& p, float* lds, int rep) {
    unsigned* ctr = (unsigned*)(p.ws + WS_CTL) + 16 + rep * 32;
    int* slot = (int*)(lds + LDS_MAIN / 4);
    for (;;) {
        if (threadIdx.x == 0) *slot = (int)atomicAdd(ctr, 1u);
        __syncthreads();
        const int it = *slot;
        __syncthreads();
        if (it >= 576) break;
        gla_b_unit(p, it, lds);
    }
}

__device__ void phase_gla_post(const Params& p) {
    const int tid = threadIdx.x, wave = tid >> 6, lane = tid & 63;
    unsigned char* ws = p.ws;
    const bf16_t* P1 = (const bf16_t*)(ws + WS_P);
    const float* OD = (const float*)(ws + WS_P2);
    bf16_t* OG = (bf16_t*)(ws + WS_OC);
    for (int tok = blockIdx.x * 8 + wave; tok < NTOK; tok += gridDim.x * 8) {
        for (int hd = 0; hd < 4; ++hd) { const int idx = hd * 256 + lane * 4;
            const f32x4 a = *(const f32x4*)(OD + (size_t)tok * 1024 + idx), b2 = *(const f32x4*)(OD + ((size_t)NTOK + tok) * 1024 + idx);
            const f32x4 o = a + b2;
            const float ss = wave_sum(o[0] * o[0] + o[1] * o[1] + o[2] * o[2] + o[3] * o[3]);
            const float rs = rsqrtf(ss * (1.f / 256.f) + 1e-6f);
            const f32x4 gn = *(const f32x4*)(p.in[29] + lane * 4);
            const u32x2 zz = *(const u32x2*)(P1 + (size_t)tok * N1 + 2048 + idx);
            const float z0 = bflo(zz.x), z1 = bfhi(zz.x), z2 = bflo(zz.y), z3 = bfhi(zz.y);
            u32x2 w; w.x = pack2(o[0] * rs * gn[0] * silu(z0), o[1] * rs * gn[1] * silu(z1)); w.y = pack2(o[2] * rs * gn[2] * silu(z2), o[3] * rs * gn[3] * silu(z3));
            *(u32x2*)(OG + (size_t)tok * 1024 + idx) = w; }
    }
}

__device__ void phase_final(const Params& p) {
    const int tid = threadIdx.x, wave = tid >> 6, lane = tid & 63;
    unsigned char* ws = p.ws;
    const float* MOD = (const float*)(ws + WS_MOD);
    const float* X1 = (const float*)(ws + WS_X1);
    const float* Y = (const float*)(ws + WS_P2);
    for (int tok = blockIdx.x * 8 + wave; tok < NTOK; tok += gridDim.x * 8) {
        const int cond = tok < NPTOK ? 0 : 1 + ((tok - NPTOK) >> 11);
        f32x4 xv[4]; float ss = 0.f;
#pragma unroll
        for (int i = 0; i < 4; ++i) { const int idx = i * 256 + lane * 4;
            const f32x4 x1 = *(const f32x4*)(X1 + (size_t)tok * D + idx);
            const f32x4 ya = *(const f32x4*)(Y + (size_t)tok * D + idx), yb = *(const f32x4*)(Y + (size_t)NTOK * D + (size_t)tok * D + idx);
            const f32x4 gt = *(const f32x4*)(MOD + (1 * 3 + cond) * 3072 + 2048 + idx);
            xv[i] = x1 + gt * (ya + yb);
            ss += xv[i][0] * xv[i][0] + xv[i][1] * xv[i][1] + xv[i][2] * xv[i][2] + xv[i][3] * xv[i][3]; }
        ss = wave_sum(ss);
        const float rstd = rsqrtf(ss * (1.f / 1024.f) + 1e-6f);
#pragma unroll
        for (int i = 0; i < 4; ++i) { const int idx = i * 256 + lane * 4;
            const f32x4 g = *(const f32x4*)(p.in[9] + idx);
            f32x4 o;
#pragma unroll
            for (int j = 0; j < 4; ++j) o[j] = xv[i][j] * rstd * g[j];
            *(f32x4*)(p.out + (size_t)tok * D + idx) = o; }
    }
}


#define XB_TMO      128
#define XB_XCNT(j)  (256  + 64 * (j))
#define XB_XSUB(j)  (1280 + 64 * (j))
#define XB_XGEN(j)  (2304 + 64 * (j))
#define XB_TOP      3328
#define XB_TOPGEN   3392
#define XCD_BAR_WORDS 3456
#define XB_SPIN_CAP (1u << 18)

__device__ __forceinline__ unsigned xb_ld(unsigned* p)              { return __hip_atomic_load(p, __ATOMIC_RELAXED, __HIP_MEMORY_SCOPE_AGENT); }
__device__ __forceinline__ unsigned xb_add(unsigned* p, unsigned v) { return __hip_atomic_fetch_add(p, v, __ATOMIC_RELAXED, __HIP_MEMORY_SCOPE_AGENT); }
__device__ __forceinline__ unsigned xb_xcc_id() { return (unsigned)__builtin_amdgcn_s_getreg((3 << 11) | 20) & 0xFu; }
#define XB_SPIN(cond, bar) do { unsigned _sp = 0; while (cond) { __builtin_amdgcn_s_sleep(1); \
    if ((++_sp & 255u) == 0u) { if (xb_ld(&(bar)[XB_TMO])) break; if (_sp > XB_SPIN_CAP) { atomicAdd(&(bar)[XB_TMO], 1u); break; } } } } while (0)

struct XcdBarrier {
    unsigned* bar; unsigned x;
    volatile LAS unsigned* st;
};

__device__ __forceinline__ XcdBarrier xcd_barrier_post(unsigned* bar, volatile LAS unsigned* st) {
    XcdBarrier b; b.bar = bar; b.x = xb_xcc_id(); b.st = st;
    if (threadIdx.x == 0) (void)xb_add(&bar[XB_XCNT(b.x)], 1u);
    return b;
}
__device__ __forceinline__ void xcd_barrier_complete(unsigned* bar, unsigned x, unsigned& nloc, unsigned& nx) {
    const unsigned G = gridDim.x * gridDim.y * gridDim.z;
    unsigned sum, cnt, mine, sp = 0u;
    for (;;) {
        sum = 0u; cnt = 0u; mine = 0u;
#pragma unroll
        for (unsigned j = 0; j < 16; ++j) { const unsigned c = xb_ld(&bar[XB_XCNT(j)]); sum += c; cnt += (c > 0u) ? 1u : 0u; mine = (j == x) ? c : mine; }
        if (sum == G) break;
        __builtin_amdgcn_s_sleep(1);
        if ((++sp & 255u) == 0u) { if (xb_ld(&bar[XB_TMO])) break; if (sp > XB_SPIN_CAP) { atomicAdd(&bar[XB_TMO], 1u); break; } }
    }
    nloc = mine > 0u ? mine : 1u; nx = cnt > 0u ? cnt : 1u;
}

__device__ __forceinline__ void xcd_barrier(const XcdBarrier& b) {
    asm volatile("s_waitcnt vmcnt(0)" ::: "memory");
    __syncthreads();
    if (threadIdx.x == 0) {
        unsigned* bar = b.bar;
        __builtin_amdgcn_s_waitcnt(0);
        unsigned nloc = b.st[0], nx = b.st[1];
        if (nloc == 0u) { xcd_barrier_complete(bar, b.x, nloc, nx); b.st[0] = nloc; b.st[1] = nx; }
        const unsigned old = xb_add(&bar[XB_XSUB(b.x)], 1u);
        const unsigned gen = old / nloc;
        if (old + 1u == (gen + 1u) * nloc) {
            __builtin_amdgcn_fence(__ATOMIC_RELEASE, "agent");
            asm volatile("s_waitcnt vmcnt(0)" ::: "memory");
            const unsigned og = xb_add(&bar[XB_TOP], 1u);
            const unsigned tg = og / nx;
            if (og + 1u == (tg + 1u) * nx) xb_add(&bar[XB_TOPGEN], 1u);
            else XB_SPIN(xb_ld(&bar[XB_TOPGEN]) == tg, bar);
            __builtin_amdgcn_fence(__ATOMIC_ACQUIRE, "agent");
            xb_add(&bar[XB_XGEN(b.x)], 1u);
            asm volatile("s_waitcnt vmcnt(0)" ::: "memory");
        } else {
            XB_SPIN(xb_ld(&bar[XB_XGEN(b.x)]) == gen, bar);
            __builtin_amdgcn_fence(__ATOMIC_ACQUIRE, "agent");
            asm volatile("s_waitcnt vmcnt(0)" ::: "memory");
        }
    }
    __syncthreads();
}


constexpr int NPHASE = 14;
__global__ void __launch_bounds__(NTHR, 2) fwd_megakernel(Params p) {
    extern __shared__ __attribute__((aligned(16))) unsigned char smem[];
    float* ldsf = (float*)smem;
    LAS unsigned char* ldsl = (LAS unsigned char*)smem;
    unsigned char* ws = p.ws;
    volatile LAS unsigned* xst = (volatile LAS unsigned*)(ldsl + LDS_MAIN + 16);
    if (threadIdx.x == 0) { xst[0] = 0u; xst[1] = 0u; }
    __syncthreads();
    const XcdBarrier xbar = xcd_barrier_post((unsigned*)(ws + WS_BAR), xst);
    if (p.ph_lo < 0) cg::this_grid().sync();
#ifndef DUP_PHASE
#define DUP_PHASE -1
#endif
#define PHASE(n) if (p.ph_lo <= (n) && (n) < p.ph_hi && ((n) == p.ph_lo || (xcd_barrier(xbar), true))) for (int rep = 0; rep < ((n) == DUP_PHASE ? 2 : 1); ++rep, ((n) == DUP_PHASE ? (xcd_barrier(xbar), 0) : 0))
    PHASE(0) phase_prologue(p, ldsf);
    PHASE(1) phase_h(p, 0);
    PHASE(2) { pg8::Gemm g{(const bf16_t*)(ws + WS_H), (const bf16_t*)(ws + WS_BT0), NTOK, N0, 1024, 1024, 1}; pg8::Order S; S.init(NTOK, N0, 1, gridDim.x, blockIdx.x);
               pg8::EpiBf16 E{(bf16_t*)(ws + WS_P), N0}; pg8::gemm_phase(ldsl, g, S, E); }
    PHASE(3) phase_mix0(p, ldsf, rep);
    PHASE(4) phase_wkv_fix(p, ldsf);
    PHASE(5) phase_wkv_post(p);
    PHASE(6) { pg8::Gemm g{(const bf16_t*)(ws + WS_OC), (const bf16_t*)(ws + WS_WT0O), NTOK, 1024, 1024, 2048, 2}; pg8::Order S; S.init(NTOK, 1024, 2, gridDim.x, blockIdx.x);
               pg8::EpiF32 E{(float*)(ws + WS_P), 1024, (size_t)NTOK * 1024}; pg8::gemm_phase(ldsl, g, S, E); }
    PHASE(7) phase_h(p, 1);
    PHASE(8) { pg8::Gemm g{(const bf16_t*)(ws + WS_H), (const bf16_t*)(ws + WS_BT1), NTOK, N1, 1024, 1024, 1}; pg8::Order S; S.init(NTOK, N1, 1, gridDim.x, blockIdx.x);
               pg8::EpiBf16 E{(bf16_t*)(ws + WS_P), N1}; pg8::gemm_phase(ldsl, g, S, E); }
    PHASE(9) phase_gla_a(p, ldsf);
    PHASE(10) phase_gla_b(p, ldsf, rep);
    PHASE(11) phase_gla_post(p);
    PHASE(12) { pg8::Gemm g{(const bf16_t*)(ws + WS_OC), (const bf16_t*)(ws + WS_WT1O), NTOK, 1024, 512, 1024, 2}; pg8::Order S; S.init(NTOK, 1024, 2, gridDim.x, blockIdx.x);
                pg8::EpiF32 E{(float*)(ws + WS_P2), 1024, (size_t)NTOK * 1024}; pg8::gemm_phase(ldsl, g, S, E); }
    PHASE(13) phase_final(p);
}

extern "C" void kernel_launch(void* const* d_in, const int* in_sizes, int n_in, void* d_out, int out_size, void* d_ws, size_t ws_size, hipStream_t stream) {
    static int grid = 0;
    if (grid == 0) {
        if (n_in != 30 || ws_size < WS_END) { fprintf(stderr, "kernel_launch: unexpected n_in %d / ws_size %zu (need %zu)\n", n_in, ws_size, (size_t)WS_END); grid = -1; return; }
        int dev = 0, cus = 0, per_cu = 0;
        hipGetDevice(&dev);
        hipDeviceGetAttribute(&cus, hipDeviceAttributeMultiprocessorCount, dev);
        hipFuncSetAttribute((const void*)fwd_megakernel, hipFuncAttributeMaxDynamicSharedMemorySize, LDS_BYTES);
        hipOccupancyMaxActiveBlocksPerMultiprocessor(&per_cu, (const void*)fwd_megakernel, NTHR, LDS_BYTES);
        if (per_cu < 1) { fprintf(stderr, "kernel_launch: occupancy query returned %d\n", per_cu); per_cu = 1; }
        grid = cus * per_cu;
        (void)hipGetLastError();
    }
    if (grid < 0) return;
    hipMemsetAsync((char*)d_ws + WS_CTL, 0, 256, stream);
    hipMemsetAsync((char*)d_ws + WS_BAR, 0, XCD_BAR_WORDS * 4, stream);
    Params p{};
    for (int i = 0; i < 30; ++i) p.in[i] = (const float*)d_in[i];
    p.out = (float*)d_out; p.ws = (unsigned char*)d_ws;
#if MULTI_LAUNCH
    for (int ph = 0; ph < NPHASE; ++ph) { p.ph_lo = ph; p.ph_hi = ph + 1; hipLaunchKernelGGL(fwd_megakernel, dim3(grid), dim3(NTHR), LDS_BYTES, stream, p); }
#else
    p.ph_lo = 0; p.ph_hi = NPHASE;
    void* args[] = {&p};
    hipError_t e = hipLaunchCooperativeKernel((const void*)fwd_megakernel, dim3(grid), dim3(NTHR), args, LDS_BYTES, stream);
    if (e != hipSuccess) fprintf(stderr, "cooperative launch failed: %s (grid %d)\n", hipGetErrorString(e), grid);
#endif
}
```

```cpp
#include <hip/hip_runtime.h>
#include <hip/hip_cooperative_groups.h>
#include <cstdio>
namespace cg = cooperative_groups;

#define LAS __attribute__((address_space(3)))
typedef unsigned short bf16_t;
typedef short bf16x8 __attribute__((ext_vector_type(8)));
typedef float f32x4 __attribute__((ext_vector_type(4)));
typedef unsigned u32x4 __attribute__((ext_vector_type(4)));
typedef unsigned u32x2 __attribute__((ext_vector_type(2)));

#ifndef MULTI_LAUNCH
#define MULTI_LAUNCH 0
#endif

constexpr int D = 1024, NTOK = 8192, NPTOK = 4096;
constexpr int N0 = 8448;
constexpr int N1 = 3328;
constexpr int NTHR = 512;
constexpr int LDS_MAIN = 139264;
constexpr int LDS_BYTES = LDS_MAIN + 256;

constexpr size_t MB = 1024 * 1024;
constexpr size_t WS_CTL = 0;
constexpr size_t WS_MOD = 4096;
constexpr size_t WS_BON = WS_MOD + 2 * 3 * 3072 * 4;
constexpr size_t WS_BAR = 0x1A0000;
constexpr size_t WS_BT0 = 2 * MB;
constexpr size_t WS_WT0O = WS_BT0 + (size_t)N0 * 1024 * 2;
constexpr size_t WS_BT1 = WS_WT0O + (size_t)1024 * 2048 * 2;
constexpr size_t WS_WT1O = WS_BT1 + (size_t)N1 * 1024 * 2;
constexpr size_t WS_H = WS_WT1O + (size_t)1024 * 1024 * 2;
constexpr size_t WS_OC = WS_H + (size_t)NTOK * 1024 * 2;
constexpr size_t WS_X1 = WS_OC + (size_t)NTOK * 2048 * 2;
constexpr size_t WS_P = WS_X1 + (size_t)NTOK * 1024 * 4;
constexpr size_t WS_P2 = WS_P + 64 * MB;
constexpr size_t WS_END = WS_P + (size_t)NTOK * N0 * 2;

struct Params {
    const float* in[30];
    float* out;
    unsigned char* ws;
    int ph_lo, ph_hi;
};

__device__ __forceinline__ float bf2f(bf16_t h) { return __uint_as_float(((unsigned)h) << 16); }
__device__ __forceinline__ bf16_t f2bf(float f) { unsigned u = __float_as_uint(f); u += 0x7FFFu + ((u >> 16) & 1u); return (bf16_t)(u >> 16); }
__device__ __forceinline__ unsigned pack2(float lo, float hi) { return (unsigned)f2bf(lo) | ((unsigned)f2bf(hi) << 16); }
__device__ __forceinline__ float bflo(unsigned w) { return __uint_as_float(w << 16); }
__device__ __forceinline__ float bfhi(unsigned w) { return __uint_as_float(w & 0xFFFF0000u); }
__device__ __forceinline__ float silu(float x) { return x / (1.f + __expf(-x)); }
__device__ __forceinline__ float wave_sum(float v) {
#pragma unroll
    for (int m = 32; m >= 1; m >>= 1) v += __shfl_xor(v, m, 64);
    return v;
}

typedef float f32x2_t __attribute__((ext_vector_type(2)));
typedef __bf16 bf16x2_t __attribute__((ext_vector_type(2)));
__device__ __forceinline__ unsigned pk2(float lo, float hi) { const f32x2_t v = {lo, hi}; return __builtin_bit_cast(unsigned, __builtin_convertvector(v, bf16x2_t)); }
__device__ __forceinline__ bf16_t f2bf_hw(float f) { return __builtin_bit_cast(bf16_t, (__bf16)f); }

__device__ __forceinline__ void lds_barrier() { asm volatile("s_waitcnt lgkmcnt(0)" ::: "memory"); __builtin_amdgcn_s_barrier(); asm volatile("" ::: "memory"); }

namespace pg8 {
constexpr int BM = 256, BK = 64, HALF = 128, HTB = HALF * BK * 2, NXCD = 8, WGM = 8;
__device__ __forceinline__ int lds_byte(int r, int c) { const int st = (r >> 4) * 2 + (c >> 5), rr = r & 15, cc = c & 31, ob = rr * 64 + cc * 2; return st * 1024 + (ob ^ (((ob >> 9) & 1) << 5)); }
__device__ __forceinline__ void stage_rc(int b, int& R, int& C) { const int st = b / 1024, sb = b % 1024, swz = sb ^ (((sb >> 9) & 1) << 5); R = (st >> 1) * 16 + swz / 64; C = (st & 1) * 32 + (swz % 64) / 2; }
__device__ __forceinline__ int perm32(int rho) { const int n = rho >> 4, i = rho & 15; return 8 * (i >> 2) + 4 * n + (i & 3); }

struct Unit { int pm, pn, ks; };
struct Gemm { const bf16_t* A; const bf16_t* Bt; int M, N, K, ld, KS; };

struct Order {
    int nM, nN, nNr, nwg, G, c;
    __device__ void init(int M, int N, int KS, int G_, int c_) { nM = M / BM; nNr = N / BM; nN = nNr * KS; nwg = nM * nN; G = G_; c = c_; }
    __device__ bool next(int i, Unit& u) const {
        const long L = (long)i * G + c; if (L >= nwg) return false;
        int wgid = (int)L; { const int q = nwg / NXCD, r = nwg % NXCD, xcd = wgid % NXCD, off = wgid / NXCD; wgid = (xcd < r ? xcd * (q + 1) : r * (q + 1) + (xcd - r) * q) + off; }
        const int nig = WGM * nN, gid = wgid / nig, fm = gid * WGM, gsz = (nM - fm) < WGM ? (nM - fm) : WGM;
        u.pm = fm + ((wgid % nig) % gsz); const int pn = (wgid % nig) / gsz; u.pn = pn % nNr; u.ks = pn / nNr; return true;
    }
};

__device__ __forceinline__ unsigned cvt_pk_bf16(float lo, float hi) { unsigned r; asm volatile("v_cvt_pk_bf16_f32 %0, %1, %2" : "=v"(r) : "v"(lo), "v"(hi)); return r; }

struct EpiF32 {
    static constexpr bool PERM = false;
    float* C; int ldc; size_t ks_stride;
    __device__ __forceinline__ void operator()(const f32x4 (&acc)[2][2][4][2], const Unit& u, int wr, int wc, int fr, int fq) const {
        const int row0 = u.pm * BM + wr * 64 + fr, col0 = u.pn * BM + wc * 32 + 4 * fq;
        float* Cb = C + (size_t)u.ks * ks_stride;
#pragma unroll
        for (int ai = 0; ai < 2; ++ai)
#pragma unroll
            for (int m = 0; m < 4; ++m) { float* rowp = Cb + (size_t)(row0 + ai * HALF + m * 16) * ldc + col0;
#pragma unroll
                for (int bj = 0; bj < 2; ++bj)
#pragma unroll
                    for (int n = 0; n < 2; ++n) *(f32x4*)(rowp + bj * HALF + n * 16) = acc[ai][bj][m][n]; }
    }
};
struct EpiBf16 {
    static constexpr bool PERM = true;
    bf16_t* O; int ldc;
    __device__ __forceinline__ void operator()(const f32x4 (&acc)[2][2][4][2], const Unit& u, int wr, int wc, int fr, int fq) const {
        const int row0 = u.pm * BM + wr * 64 + fr; const int col0 = u.pn * BM + wc * 32 + 8 * fq;
#pragma unroll
        for (int ai = 0; ai < 2; ++ai)
#pragma unroll
            for (int m = 0; m < 4; ++m) { bf16_t* rowp = O + (size_t)(row0 + ai * HALF + m * 16) * ldc + col0;
#pragma unroll
                for (int bj = 0; bj < 2; ++bj) { const f32x4 v0 = acc[ai][bj][m][0], v1 = acc[ai][bj][m][1];
                    u32x4 w; w.x = cvt_pk_bf16(v0[0], v0[1]); w.y = cvt_pk_bf16(v0[2], v0[3]); w.z = cvt_pk_bf16(v1[0], v1[1]); w.w = cvt_pk_bf16(v1[2], v1[3]);
                    *(u32x4*)(rowp + bj * HALF) = w; } }
    }
};

template <class Epi>
__device__ __forceinline__ void gemm_phase(LAS unsigned char* lds, const Gemm g, const Order& S, const Epi& E) {
    const int tid = threadIdx.x, wid = __builtin_amdgcn_readfirstlane(tid >> 6), lane = tid & 63, wr = wid >> 2, wc = wid & 3, fr = lane & 15, fq = lane >> 4;
    const int K = g.K, nt = K / BK, ld = g.ld;
    unsigned voffA[2], voffB[2];
#pragma unroll
    for (int i = 0; i < 2; ++i) { int R, C; stage_rc(tid * 16 + i * 8192, R, C); const int Rb = Epi::PERM ? ((R & ~31) + perm32(R & 31)) : R;
        voffA[i] = (unsigned)(R * ld + C) * 2u; voffB[i] = (unsigned)(Rb * ld + C) * 2u; }
    const size_t kstep = (size_t)(BK * 2);
    const size_t hstep = (size_t)HALF * ld * 2;
    const size_t tstep = 2 * hstep;
    const size_t ksb = (size_t)K * 2;
    const unsigned ldsw = (unsigned)wid * 1024u;
    const int aoff = lds_byte(wr * 64 + fr, fq * 8), boff = lds_byte(wc * 32 + fr, fq * 8);
#define PG8_SA(b, h) (((b) * 2 + (h)) * HTB)
#define PG8_SB(b, h) ((4 + (b) * 2 + (h)) * HTB)
#define PG8_STAGE(bufoff, gbase, voff) do { _Pragma("unroll") for (int _i = 0; _i < 2; ++_i) \
        __builtin_amdgcn_global_load_lds((const unsigned*)((const char*)(gbase) + (voff)[_i]), (LAS unsigned*)(lds + (bufoff) + ldsw + _i * 8192), 16, 0, 0); } while (0)
#define PG8_LDA(dst, b, h) do { _Pragma("unroll") for (int m = 0; m < 4; ++m) _Pragma("unroll") for (int k = 0; k < 2; ++k) dst[m][k] = *(const LAS bf16x8*)(lds + PG8_SA(b, h) + aoff + m * 2048 + k * 1024); } while (0)
#define PG8_LDB(dst, b, h) do { _Pragma("unroll") for (int n = 0; n < 2; ++n) _Pragma("unroll") for (int k = 0; k < 2; ++k) dst[n][k] = *(const LAS bf16x8*)(lds + PG8_SB(b, h) + boff + n * 2048 + k * 1024); } while (0)
#define PG8_MMA(ai, bj, At, Bt) do { __builtin_amdgcn_s_setprio(1); _Pragma("unroll") for (int m = 0; m < 4; ++m) _Pragma("unroll") for (int n = 0; n < 2; ++n) _Pragma("unroll") for (int k = 0; k < 2; ++k) \
        acc[ai][bj][m][n] = __builtin_amdgcn_mfma_f32_16x16x32_bf16(Bt[n][k], At[m][k], acc[ai][bj][m][n], 0, 0, 0); __builtin_amdgcn_s_setprio(0); } while (0)
#define PG8_WAIT_V(n) asm volatile("s_waitcnt vmcnt(" #n ")" ::: "memory")
#define PG8_WAIT_L(n) asm volatile("s_waitcnt lgkmcnt(" #n ")" ::: "memory")
#define PG8_BAR __builtin_amdgcn_s_barrier()
#define PG8_SCHED __builtin_amdgcn_sched_barrier(0)
    Unit cur, nxt; int ui = 0;
    if (!S.next(0, cur)) return;
    f32x4 acc[2][2][4][2];
#pragma unroll
    for (int a = 0; a < 2; ++a)
#pragma unroll
        for (int b = 0; b < 2; ++b)
#pragma unroll
            for (int m = 0; m < 4; ++m)
#pragma unroll
                for (int n = 0; n < 2; ++n) acc[a][b][m][n] = (f32x4){0.f, 0.f, 0.f, 0.f};
    bf16x8 At[4][2], B0[2][2], B1[2][2];
    const char* cA = (const char*)g.A + (size_t)cur.pm * tstep + (size_t)cur.ks * ksb; const char* cB = (const char*)g.Bt + (size_t)cur.pn * tstep + (size_t)cur.ks * ksb;
    PG8_STAGE(PG8_SB(0, 0), cB, voffB); PG8_STAGE(PG8_SA(0, 0), cA, voffA); PG8_STAGE(PG8_SB(0, 1), cB + hstep, voffB); PG8_STAGE(PG8_SA(0, 1), cA + hstep, voffA);
    if (wr == 1) PG8_BAR;
    PG8_WAIT_V(4); PG8_BAR;
    PG8_STAGE(PG8_SB(1, 0), cB + kstep, voffB); PG8_STAGE(PG8_SA(1, 0), cA + kstep, voffA); PG8_STAGE(PG8_SB(1, 1), cB + hstep + kstep, voffB);
    PG8_WAIT_V(6); PG8_BAR;
    for (;;) {
        const bool has_next = S.next(ui + 1, nxt);
        const char* nA = has_next ? (const char*)g.A + (size_t)nxt.pm * tstep + (size_t)nxt.ks * ksb : cA; const char* nB = has_next ? (const char*)g.Bt + (size_t)nxt.pn * tstep + (size_t)nxt.ks * ksb : cB;
        for (int t = 0; t < nt; t += 2) {
            const bool last = (t == nt - 2);
            const char* a1 = cA + (size_t)(t + 1) * kstep;
            const char* a2 = last ? nA : cA + (size_t)(t + 2) * kstep; const char* b2 = last ? nB : cB + (size_t)(t + 2) * kstep;
            const char* a3 = a2 + kstep; const char* b3 = b2 + kstep;
            PG8_LDB(B0, 0, 0); PG8_SCHED; PG8_LDA(At, 0, 0); PG8_STAGE(PG8_SA(1, 1), a1 + hstep, voffA);
            PG8_WAIT_L(8); PG8_BAR; PG8_WAIT_L(0); PG8_MMA(0, 0, At, B0); PG8_BAR; PG8_SCHED;
            PG8_LDB(B1, 0, 1); PG8_STAGE(PG8_SB(0, 0), b2, voffB);
            PG8_BAR; PG8_WAIT_L(0); PG8_MMA(0, 1, At, B1); PG8_BAR;
            PG8_LDA(At, 0, 1); PG8_STAGE(PG8_SA(0, 0), a2, voffA);
            PG8_BAR; PG8_WAIT_L(0); PG8_MMA(1, 0, At, B0); PG8_BAR; PG8_SCHED;
            PG8_STAGE(PG8_SB(0, 1), b2 + hstep, voffB);
            PG8_WAIT_V(6); PG8_BAR; PG8_MMA(1, 1, At, B1); PG8_BAR;
            PG8_LDB(B0, 1, 0); PG8_SCHED; PG8_LDA(At, 1, 0); PG8_STAGE(PG8_SA(0, 1), a2 + hstep, voffA);
            PG8_WAIT_L(8); PG8_BAR; PG8_WAIT_L(0); PG8_MMA(0, 0, At, B0); PG8_BAR; PG8_SCHED;
            PG8_LDB(B1, 1, 1); PG8_STAGE(PG8_SB(1, 0), b3, voffB);
            PG8_BAR; PG8_WAIT_L(0); PG8_MMA(0, 1, At, B1); PG8_BAR;
            PG8_LDA(At, 1, 1); PG8_STAGE(PG8_SA(1, 0), a3, voffA);
            PG8_BAR; PG8_WAIT_L(0); PG8_MMA(1, 0, At, B0); PG8_BAR; PG8_SCHED;
            PG8_STAGE(PG8_SB(1, 1), b3 + hstep, voffB);
            PG8_WAIT_V(6); PG8_BAR; PG8_MMA(1, 1, At, B1); PG8_BAR;
        }
        E(acc, cur, wr, wc, fr, fq);
        if (!has_next) break;
#pragma unroll
        for (int a = 0; a < 2; ++a)
#pragma unroll
            for (int b = 0; b < 2; ++b)
#pragma unroll
                for (int m = 0; m < 4; ++m)
#pragma unroll
                    for (int n = 0; n < 2; ++n) acc[a][b][m][n] = (f32x4){0.f, 0.f, 0.f, 0.f};
        cur = nxt; cA = nA; cB = nB; ++ui;
    }
    PG8_WAIT_V(0);
    if (wr == 0) PG8_BAR;
    PG8_BAR;
#undef PG8_SA
#undef PG8_SB
#undef PG8_STAGE
#undef PG8_LDA
#undef PG8_LDB
#undef PG8_MMA
#undef PG8_WAIT_V
#undef PG8_WAIT_L
#undef PG8_BAR
#undef PG8_SCHED
}
}

__device__ void transpose_tile(const float* __restrict__ src, int ldsrc, int N, int k0, int n0, bf16_t* __restrict__ dst, int lddst, int dstrow0, float* tile) {
    const int tid = threadIdx.x;
    for (int i = tid; i < 4096; i += NTHR) { const int kk = i >> 6, nn = i & 63; float v = 0.f; if (n0 + nn < N) v = src[(size_t)(k0 + kk) * ldsrc + n0 + nn]; tile[kk * 65 + nn] = v; }
    __syncthreads();
    for (int i = tid; i < 2048; i += NTHR) { const int nn = i >> 5, kp = (i & 31) * 2;
        if (n0 + nn < N) *(unsigned*)(dst + (size_t)(dstrow0 + n0 + nn) * lddst + k0 + kp) = pack2(tile[kp * 65 + nn], tile[(kp + 1) * 65 + nn]); }
    __syncthreads();
}

__device__ void phase_prologue(const Params& p, float* lds) {
    const int tid = threadIdx.x;
    unsigned char* ws = p.ws;
    bf16_t* BT0 = (bf16_t*)(ws + WS_BT0); bf16_t* WT0O = (bf16_t*)(ws + WS_WT0O); bf16_t* BT1 = (bf16_t*)(ws + WS_BT1); bf16_t* WT1O = (bf16_t*)(ws + WS_WT1O);
    float* MOD = (float*)(ws + WS_MOD);
    constexpr int NGEMV = 192, NT = 3680;
    for (int it = blockIdx.x; it < NGEMV + NT; it += gridDim.x) {
        if (it < NGEMV) {
            const int l = it / 96, j0 = (it % 96) * 32;
            float* sc = lds;
            float* red = lds + 3072;
            for (int i = tid; i < 3072; i += NTHR) { const int cnd = i >> 10, k = i & 1023; const float v = cnd == 0 ? p.in[5][k] : p.in[4][(cnd - 1) * 1024 + k]; sc[i] = silu(v); }
            __syncthreads();
            const int col = tid & 31, ksp = tid >> 5;
            float a0 = 0.f, a1 = 0.f, a2 = 0.f;
            const float* w = p.in[7] + (size_t)l * 1024 * 3072 + j0 + col;
#pragma unroll 16
            for (int k = ksp * 64; k < ksp * 64 + 64; ++k) { const float wv = w[(size_t)k * 3072]; a0 += sc[k] * wv; a1 += sc[1024 + k] * wv; a2 += sc[2048 + k] * wv; }
            red[(ksp * 3 + 0) * 32 + col] = a0; red[(ksp * 3 + 1) * 32 + col] = a1; red[(ksp * 3 + 2) * 32 + col] = a2;
            __syncthreads();
            if (tid < 96) { const int cnd = tid >> 5, cc = tid & 31; float s = 0.f; for (int q = 0; q < 16; ++q) s += red[(q * 3 + cnd) * 32 + cc];
                MOD[(l * 3 + cnd) * 3072 + j0 + cc] = s + p.in[8][l * 3072 + j0 + cc]; }
            __syncthreads();
        } else {
            int t = it - NGEMV;
            const float* src; int ldsrc, N; bf16_t* dst; int lddst, drow0, nnt;
            if (t < 2048) { src = p.in[10]; ldsrc = 8192; N = 8192; dst = BT0; lddst = 1024; drow0 = 0; nnt = 128; }
            else if (t < 2048 + 32) { t -= 2048; const int z = t >> 4; t &= 15; src = p.in[14] + (size_t)z * 1024 * 64; ldsrc = 64; N = 64; dst = BT0; lddst = 1024; drow0 = 8192 + z * 64; nnt = 1; }
            else if (t < 2048 + 64) { t -= 2048 + 32; const int z = t >> 4; t &= 15; src = p.in[17] + (size_t)z * 1024 * 64; ldsrc = 64; N = 64; dst = BT0; lddst = 1024; drow0 = 8320 + z * 64; nnt = 1; }
            else if (t < 2112 + 512) { t -= 2112; src = p.in[11]; ldsrc = 1024; N = 1024; dst = WT0O; lddst = 2048; drow0 = 0; nnt = 16; }
            else if (t < 2624 + 768) { t -= 2624; src = p.in[24]; ldsrc = 3072; N = 3072; dst = BT1; lddst = 1024; drow0 = 0; nnt = 48; }
            else if (t < 3392 + 32) { t -= 3392; const int z = t >> 4; t &= 15; src = p.in[26] + (size_t)z * 1024 * 16; ldsrc = 16; N = 16; dst = BT1; lddst = 1024; drow0 = 3072 + z * 16; nnt = 1; }
            else { t -= 3424; src = p.in[25]; ldsrc = 1024; N = 1024; dst = WT1O; lddst = 1024; drow0 = 0; nnt = 16; }
            const int kt = t / nnt, ntile = t % nnt;
            transpose_tile(src, ldsrc, N, kt * 64, ntile * 64, dst, lddst, drow0, lds);
        }
    }
    { u32x4* z = (u32x4*)(BT1 + (size_t)3104 * 1024); const int n = 224 * 1024 * 2 / 16;
      for (int i = blockIdx.x * NTHR + tid; i < n; i += gridDim.x * NTHR) z[i] = (u32x4){0u, 0u, 0u, 0u}; }
}

__device__ void phase_h(const Params& p, int layer) {
    const int tid = threadIdx.x, wave = tid >> 6, lane = tid & 63;
    unsigned char* ws = p.ws;
    const float* MOD = (const float*)(ws + WS_MOD);
    bf16_t* H = (bf16_t*)(ws + WS_H);
    float* X1 = (float*)(ws + WS_X1);
    const float* Y = (const float*)(ws + WS_P);
    for (int tok = blockIdx.x * 8 + wave; tok < NTOK; tok += gridDim.x * 8) {
        const float* xr = tok < NPTOK ? p.in[0] + (size_t)tok * D : p.in[1] + (size_t)(tok - NPTOK) * D;
        const int cond = tok < NPTOK ? 0 : 1 + ((tok - NPTOK) >> 11);
        f32x4 xv[4]; float ss = 0.f;
#pragma unroll
        for (int i = 0; i < 4; ++i) { const int idx = i * 256 + lane * 4; xv[i] = *(const f32x4*)(xr + idx);
            if (layer == 1) { const f32x4 ya = *(const f32x4*)(Y + (size_t)tok * D + idx), yb = *(const f32x4*)(Y + (size_t)NTOK * D + (size_t)tok * D + idx);
                const f32x4 gt = *(const f32x4*)(MOD + (0 * 3 + cond) * 3072 + 2048 + idx);
                xv[i] = xv[i] + gt * (ya + yb); *(f32x4*)(X1 + (size_t)tok * D + idx) = xv[i]; }
            ss += xv[i][0] * xv[i][0] + xv[i][1] * xv[i][1] + xv[i][2] * xv[i][2] + xv[i][3] * xv[i][3]; }
        ss = wave_sum(ss);
        const float rstd = rsqrtf(ss * (1.f / 1024.f) + 1e-6f);
#pragma unroll
        for (int i = 0; i < 4; ++i) { const int idx = i * 256 + lane * 4;
            const f32x4 g = *(const f32x4*)(p.in[6] + layer * D + idx);
            const f32x4 sh = *(const f32x4*)(MOD + (layer * 3 + cond) * 3072 + idx), sc = *(const f32x4*)(MOD + (layer * 3 + cond) * 3072 + 1024 + idx);
            f32x4 h;
#pragma unroll
            for (int j = 0; j < 4; ++j) h[j] = xv[i][j] * rstd * g[j] * (1.f + sc[j]) + sh[j];
            u32x2 w; w.x = pack2(h[0], h[1]); w.y = pack2(h[2], h[3]);
            *(u32x2*)(H + (size_t)tok * D + idx) = w; }
    }
}

__device__ __forceinline__ f32x4 mma_nt(const bf16_t* A, int lda, const bf16_t* B, int ldb, int K, f32x4 acc, int fr, int fq) {
    for (int k0 = 0; k0 < K; k0 += 32) {
        const bf16x8 a = *(const bf16x8*)(A + fr * lda + k0 + fq * 8);
        const bf16x8 b = *(const bf16x8*)(B + fr * ldb + k0 + fq * 8);
        acc = __builtin_amdgcn_mfma_f32_16x16x32_bf16(a, b, acc, 0, 0, 0);
    }
    return acc;
}
__device__ __forceinline__ bf16x8 pack8(float a0, float a1, float a2, float a3, float a4, float a5, float a6, float a7) {
    u32x4 w; w.x = pack2(a0, a1); w.y = pack2(a2, a3); w.z = pack2(a4, a5); w.w = pack2(a6, a7);
    return __builtin_bit_cast(bf16x8, w);
}
__device__ __forceinline__ float dpp_add(float v, float o) { return v + o; }
__device__ __forceinline__ float wave_sum_fast(float v) {
    v += __int_as_float(__builtin_amdgcn_update_dpp(0, __float_as_int(v), 0xB1, 0xF, 0xF, true));
    v += __int_as_float(__builtin_amdgcn_update_dpp(0, __float_as_int(v), 0x4E, 0xF, 0xF, true));
    v += __int_as_float(__builtin_amdgcn_update_dpp(0, __float_as_int(v), 0x141, 0xF, 0xF, true));
    v += __int_as_float(__builtin_amdgcn_update_dpp(0, __float_as_int(v), 0x140, 0xF, 0xF, true));
    v += __shfl_xor(v, 16, 64); v += __shfl_xor(v, 32, 64);
    return v;
}
__device__ __forceinline__ float fast_tanh(float x) { const float e = __expf(2.f * x); return 1.f - 2.f * __builtin_amdgcn_rcpf(1.f + e); }
__device__ __forceinline__ bf16x8 pack8h(float a0, float a1, float a2, float a3, float a4, float a5, float a6, float a7) {
    u32x4 w; w.x = pk2(a0, a1); w.y = pk2(a2, a3); w.z = pk2(a4, a5); w.w = pk2(a6, a7);
    return __builtin_bit_cast(bf16x8, w);
}

__device__ void wkv_unit(const Params& p, int u, float* ldsf) {
    const int tid0 = threadIdx.x, lane0 = tid0 & 63, w = __builtin_amdgcn_readfirstlane(tid0 >> 6), fr0 = lane0 & 15, fq0 = lane0 >> 4;
    unsigned char* ws = p.ws;
    unsigned char* lds = (unsigned char*)ldsf;
    const bf16_t* P = (const bf16_t*)(ws + WS_P);
    bf16_t* OD = (bf16_t*)(ws + WS_X1);
    float* BON = (float*)(ws + WS_BON);
    int z, b, hd, sgm, seqT, tok0; bool sample; const int T = 256;
    if (u < 512) { sample = true; z = u >> 8; b = (u >> 7) & 1; hd = (u >> 3) & 15; sgm = u & 7; seqT = 2048; tok0 = NPTOK + b * 2048; }
    else { const int q = u - 512; sample = false; z = q >> 8; b = (q >> 4) & 15; hd = q & 15; sgm = 0; seqT = 256; tok0 = b * 256; }
    const int qbase = sgm * 256;
    bf16_t* RHO = (bf16_t*)(ws + WS_H);
    float* GH = (float*)(ws + WS_BT0);
    bf16_t* TLW = (bf16_t*)(lds + 0);
    bf16_t* TLA = (bf16_t*)(lds + 9216);
    float* HT = (float*)(lds + 18432);
    bf16_t* KTr = (bf16_t*)(lds + 20480);
    bf16_t* BTr = (bf16_t*)(lds + 29696);
    bf16_t* KKH = (bf16_t*)(lds + 38912);
    bf16_t* RH = (bf16_t*)(lds + 48128);
    const bf16_t* VS = (const bf16_t*)(lds + 113664 + 2 * 8192);
    bf16_t* TA = (bf16_t*)(lds + 65536);
    bf16_t* NA = (bf16_t*)(lds + 70656);
    float* PC = (float*)(lds + 75776);
    bf16_t* KBm = (bf16_t*)(lds + 76800);
    float* MM = (float*)(lds + 97280);
    float* WA = (float*)(lds + 76800);
    bf16x8 bw[2];
    { const float* W2 = (w >> 2) ? p.in[18] : p.in[15];
#pragma unroll
      for (int ks = 0; ks < 2; ++ks) { float t8[8];
#pragma unroll
        for (int e = 0; e < 8; ++e) t8[e] = W2[(size_t)(z * 64 + ks * 32 + fq0 * 8 + e) * 1024 + hd * 64 + (w & 3) * 16 + fr0];
        bw[ks] = pack8h(t8[0], t8[1], t8[2], t8[3], t8[4], t8[5], t8[6], t8[7]); } }
    f32x4 Sacc[4];
#pragma unroll
    for (int kt = 0; kt < 4; ++kt) Sacc[kt] = (f32x4){0.f, 0.f, 0.f, 0.f};
    if (w >= 4) {
#pragma unroll
        for (int kt = 0; kt < 4; ++kt)
#pragma unroll
            for (int jj = 0; jj < 4; ++jj) Sacc[kt][jj] = (kt * 16 + fq0 * 4 + jj == (w - 4) * 16 + fr0) ? 1.f : 0.f; }
    const int ch = hd * 64 + lane0;
    const float w0c = p.in[13][z * 1024 + ch], a0c = p.in[16][z * 1024 + ch], kkc = p.in[19][ch], kac = p.in[20][ch], rkc = p.in[21][ch];
    bf16_t* RKV = (bf16_t*)(lds + 113664);
    u32x4 tlraw[2], rkvraw[3];
#define WKV_LOAD_RAW(tb_) do { \
        _Pragma("unroll") for (int h_ = 0; h_ < 2; ++h_) { const int idx_ = tid + h_ * NTHR; const int tau_ = idx_ >> 4, sg_ = idx_ & 15; const int t_ = z ? (seqT - 1 - (qbase + (tb_) + tau_)) : (qbase + (tb_) + tau_); \
            tlraw[h_] = *(const u32x4*)(P + (size_t)(tok0 + t_) * N0 + 8192 + (sg_ < 8 ? z * 64 + sg_ * 8 : 128 + z * 64 + (sg_ - 8) * 8)); } \
        { const int tau_ = tid >> 3, sg_ = tid & 7; const int t_ = z ? (seqT - 1 - (qbase + (tb_) + tau_)) : (qbase + (tb_) + tau_); const bf16_t* rp_ = P + (size_t)(tok0 + t_) * N0 + 4096 + hd * 64 + sg_ * 8; \
          rkvraw[0] = *(const u32x4*)rp_; rkvraw[1] = *(const u32x4*)(rp_ + 1024); rkvraw[2] = *(const u32x4*)(rp_ + 2048); } } while (0)
    { const int tid = tid0; WKV_LOAD_RAW(0); }
    __syncthreads();
#pragma unroll 1
    for (int tb = 0; tb < T; tb += 64) {
        int tid = tid0; asm volatile("" : "+v"(tid));
        const int lane = tid & 63, fr = lane & 15, fq = lane >> 4, c = lane;
        const int pcol = ((c >> 5) * 32) + (((c >> 2) & 3) * 8) + (((c >> 4) & 1) * 4) + (c & 3);
#pragma unroll
        for (int h = 0; h < 2; ++h) { const int idx = tid + h * NTHR; const int tau = idx >> 4, sg = idx & 15;
            u32x4 o = tlraw[h];
            if (sg < 8) { o.x = pk2(fast_tanh(bflo(o.x)), fast_tanh(bfhi(o.x))); o.y = pk2(fast_tanh(bflo(o.y)), fast_tanh(bfhi(o.y)));
                          o.z = pk2(fast_tanh(bflo(o.z)), fast_tanh(bfhi(o.z))); o.w = pk2(fast_tanh(bflo(o.w)), fast_tanh(bfhi(o.w))); }
            *(u32x4*)((sg < 8 ? TLW : TLA) + tau * 72 + (sg & 7) * 8) = o; }
#pragma unroll
        for (int h = 0; h < 3; ++h) *(u32x4*)(RKV + h * 4096 + (tid >> 3) * 64 + (tid & 7) * 8) = rkvraw[h];
        lds_barrier();
        if (tb + 64 < T) WKV_LOAD_RAW(tb + 64);
        { const bf16_t* TL = (w >> 2) ? TLA : TLW; float* WAo = WA + (w >> 2) * 64 * 68;
#pragma unroll
          for (int mt = 0; mt < 4; ++mt) { f32x4 acc = (f32x4){0.f, 0.f, 0.f, 0.f};
#pragma unroll
            for (int ks = 0; ks < 2; ++ks) { const bf16x8 a = *(const bf16x8*)(TL + (mt * 16 + fr) * 72 + ks * 32 + fq * 8);
                acc = __builtin_amdgcn_mfma_f32_16x16x32_bf16(a, bw[ks], acc, 0, 0, 0); }
#pragma unroll
            for (int jj = 0; jj < 4; ++jj) WAo[(mt * 16 + fq * 4 + jj) * 68 + (w & 3) * 16 + fr] = acc[jj]; } }
        lds_barrier();
        float kkv[8], kmv[8], bv[8], lwv[8], cum[8], rr[8];
        { float run = 0.f;
#pragma unroll
          for (int i = 0; i < 8; ++i) { const int tau = w * 8 + i; const int t = z ? (seqT - 1 - (qbase + tb + tau)) : (qbase + tb + tau); const int tokg = tok0 + t;
            const float wr_ = w0c + WA[tau * 68 + c], ap = a0c + WA[64 * 68 + tau * 68 + c];
            const float nx = -wr_; const float sp = fmaxf(nx, 0.f) + __logf(1.f + __expf(-fabsf(nx)));
            const float lw = -__expf(-sp - 0.5f);
            const float iclr = __builtin_amdgcn_rcpf(1.f + __expf(-ap));
            const float kxi = bf2f(RKV[4096 + tau * 64 + c]); rr[i] = bf2f(RKV[tau * 64 + c]);
            const float kkraw = kxi * kkc;
            const float ssq = wave_sum_fast(kkraw * kkraw);
            const float kk = kkraw * __builtin_amdgcn_rsqf(fmaxf(ssq, 1e-24f));
            const float kmod = kxi * (1.f + (iclr - 1.f) * kac);
            const float bon = wave_sum_fast(rr[i] * kmod * rkc);
            if (lane == 0) BON[((size_t)z * NTOK + tokg) * 16 + hd] = bon;
            run += lw;
            kkv[i] = kk; kmv[i] = kmod; bv[i] = kk * iclr; lwv[i] = lw; cum[i] = run; }
          HT[w * 64 + c] = run; }
        lds_barrier();
        { const float off = (w & 1) ? HT[(w - 1) * 64 + c] : 0.f; const int cn = w >> 1;
#pragma unroll
          for (int i = 0; i < 8; ++i) { const int tau = w * 8 + i; const int j = (w & 1) * 8 + i;
            const float cm = cum[i] + off;
            const float Pj = __expf(cm), ipj = __expf(-cm), pm1 = __expf(cm - lwv[i]);
            const unsigned kb2 = pk2(-bv[i] * ipj, kmv[i] * ipj);
            KTr[tau * 72 + pcol] = (bf16_t)(kb2 >> 16); BTr[tau * 72 + pcol] = f2bf_hw(bv[i] * ipj);
            const unsigned kr2 = pk2(kkv[i] * pm1, rr[i] * Pj);
            KKH[tau * 72 + pcol] = (bf16_t)(kr2 & 0xFFFFu); RH[tau * 72 + pcol] = (bf16_t)(kr2 >> 16);
            const int sU = (j >> 2) * 8 + (j & 3);
            KBm[(cn * 64 + c) * 40 + sU] = (bf16_t)(kb2 & 0xFFFFu); KBm[(cn * 64 + c) * 40 + sU + 4] = (bf16_t)(kb2 >> 16);
            if (j == 15) PC[cn * 64 + c] = Pj; } }
        lds_barrier();
#pragma unroll
        for (int q2 = 0; q2 < 2; ++q2) { const int id = w * 2 + q2; const int cn = id >> 2, which = id & 3;
          const bf16_t* Am = ((which & 1) ? KTr : BTr) + cn * 16 * 72; const bf16_t* Bm = ((which & 2) ? RH : KKH) + cn * 16 * 72;
          const f32x4 acc = mma_nt(Am, 72, Bm, 72, 64, (f32x4){0.f, 0.f, 0.f, 0.f}, fr, fq);
          f32x4 o;
#pragma unroll
          for (int jj = 0; jj < 4; ++jj) { const int i = fq * 4 + jj, j = fr; const bool keep = (which & 2) ? (i <= j) : (i < j); o[jj] = keep ? acc[jj] : 0.f; }
          *(f32x4*)(MM + (cn * 4 + which) * 256 + fr * 16 + fq * 4) = o; }
        lds_barrier();
        if (w == 0) { const int cn = lane >> 4, col = lane & 15;
            const float* MbT = MM + (cn * 4 + 0) * 256; const float* MkT = MM + (cn * 4 + 1) * 256;
            float Tc[16], A1[16];
#pragma unroll
            for (int i = 0; i < 16; ++i) { Tc[i] = (i == col) ? 1.f : 0.f; A1[i] = 0.f; }
#pragma unroll
            for (int l = 15; l >= 1; --l) {
                const float tl_ = Tc[l];
#pragma unroll
                for (int v4 = 0; v4 < 4; ++v4) if (v4 * 4 < l) { const f32x4 mb = *(const f32x4*)(MbT + l * 16 + v4 * 4), mk = *(const f32x4*)(MkT + l * 16 + v4 * 4);
#pragma unroll
                    for (int e = 0; e < 4; ++e) if (v4 * 4 + e < l) { Tc[v4 * 4 + e] -= mb[e] * tl_; A1[v4 * 4 + e] += mk[e] * tl_; } }
                asm volatile("" ::: "memory");
            }
            bf16_t* tao = TA + (cn * 16 + col) * 40;
#pragma unroll
            for (int g4 = 0; g4 < 4; ++g4) { u32x4 o; o.x = pk2(Tc[g4 * 4], Tc[g4 * 4 + 1]); o.y = pk2(Tc[g4 * 4 + 2], Tc[g4 * 4 + 3]); o.z = pk2(A1[g4 * 4], A1[g4 * 4 + 1]); o.w = pk2(A1[g4 * 4 + 2], A1[g4 * 4 + 3]);
                *(u32x4*)(tao + g4 * 8) = o; } }
        else if (w <= 4) { const int cn = w - 1, j = lane & 15, ig = lane >> 4;
            const f32x4 nb = *(const f32x4*)(MM + (cn * 4 + 2) * 256 + j * 16 + ig * 4), nk = *(const f32x4*)(MM + (cn * 4 + 3) * 256 + j * 16 + ig * 4);
            u32x4 o; o.x = pk2(-nb[0], -nb[1]); o.y = pk2(-nb[2], -nb[3]); o.z = pk2(nk[0], nk[1]); o.w = pk2(nk[2], nk[3]);
            *(u32x4*)(NA + (cn * 16 + j) * 40 + ig * 8) = o; }
        lds_barrier();
        if (w < 4 || sample) {
            const int vb = w & 3;
#pragma unroll 1
            for (int cn = 0; cn < 4; ++cn) {
                bf16x8 sb[2];
#pragma unroll
                for (int ks = 0; ks < 2; ++ks) sb[ks] = pack8h(Sacc[2 * ks][0], Sacc[2 * ks][1], Sacc[2 * ks][2], Sacc[2 * ks][3], Sacc[2 * ks + 1][0], Sacc[2 * ks + 1][1], Sacc[2 * ks + 1][2], Sacc[2 * ks + 1][3]);
                f32x4 U0 = (f32x4){0.f, 0.f, 0.f, 0.f}, O = (f32x4){0.f, 0.f, 0.f, 0.f};
#pragma unroll
                for (int ks = 0; ks < 2; ++ks) { const bf16x8 a = *(const bf16x8*)(KKH + (cn * 16 + fr) * 72 + ks * 32 + fq * 8);
                    U0 = __builtin_amdgcn_mfma_f32_16x16x32_bf16(a, sb[ks], U0, 0, 0, 0);
                    const bf16x8 ar = *(const bf16x8*)(RH + (cn * 16 + fr) * 72 + ks * 32 + fq * 8);
                    O = __builtin_amdgcn_mfma_f32_16x16x32_bf16(ar, sb[ks], O, 0, 0, 0); }
                float vf[4];
#pragma unroll
                for (int e = 0; e < 4; ++e) vf[e] = (w < 4) ? bf2f(VS[(cn * 16 + fq * 4 + e) * 64 + vb * 16 + fr]) : 0.f;
                const bf16x8 bU0 = pack8h(U0[0], U0[1], U0[2], U0[3], vf[0], vf[1], vf[2], vf[3]);
                const bf16x8 ta = *(const bf16x8*)(TA + (cn * 16 + fr) * 40 + fq * 8);
                const f32x4 U = __builtin_amdgcn_mfma_f32_16x16x32_bf16(ta, bU0, (f32x4){0.f, 0.f, 0.f, 0.f}, 0, 0, 0);
                const bf16x8 bUV = pack8h(U[0], U[1], U[2], U[3], vf[0], vf[1], vf[2], vf[3]);
                const bf16x8 na = *(const bf16x8*)(NA + (cn * 16 + fr) * 40 + fq * 8);
                O = __builtin_amdgcn_mfma_f32_16x16x32_bf16(na, bUV, O, 0, 0, 0);
#pragma unroll
                for (int jj = 0; jj < 4; ++jj) { const int tau = cn * 16 + fq * 4 + jj; const int t = z ? (seqT - 1 - (qbase + tb + tau)) : (qbase + tb + tau);
                    if (w < 4) OD[((size_t)z * NTOK + tok0 + t) * 1024 + hd * 64 + vb * 16 + fr] = f2bf_hw(O[jj]);
                    else RHO[((size_t)z * 4096 + (tok0 - NPTOK) + t) * 1024 + hd * 64 + vb * 16 + fr] = f2bf_hw(O[jj]); }
#pragma unroll
                for (int kt = 0; kt < 4; ++kt) { const bf16x8 kb = *(const bf16x8*)(KBm + (cn * 64 + kt * 16 + fr) * 40 + fq * 8);
                    Sacc[kt] = __builtin_amdgcn_mfma_f32_16x16x32_bf16(kb, bUV, Sacc[kt], 0, 0, 0);
                    const f32x4 pc = *(const f32x4*)(PC + cn * 64 + kt * 16 + fq * 4);
                    Sacc[kt] = Sacc[kt] * pc; }
            }
        }
        lds_barrier();
    }
#undef WKV_LOAD_RAW
    if (!sample) { if (w < 4) { float* so = p.out + (size_t)2 * NPTOK * D + ((size_t)((b * 2 + z) * 16 + hd)) * 4096 + (size_t)(w * 16 + fr0) * 64;
#pragma unroll
        for (int kt = 0; kt < 4; ++kt)
#pragma unroll
            for (int jj = 0; jj < 4; ++jj) so[kt * 16 + fq0 * 4 + jj] = Sacc[kt][jj]; } }
    else { float* so = GH + ((size_t)u * 2 + (w >> 2)) * 4096 + (size_t)((w & 3) * 16 + fr0) * 64;
#pragma unroll
        for (int kt = 0; kt < 4; ++kt)
#pragma unroll
            for (int jj = 0; jj < 4; ++jj) so[kt * 16 + fq0 * 4 + jj] = Sacc[kt][jj]; }
    __syncthreads();
}

__device__ void wkv_fix_unit(const Params& p, int u, float* ldsf) {
    const int tid = threadIdx.x, lane = tid & 63, w = __builtin_amdgcn_readfirstlane(tid >> 6), fr = lane & 15, fq = lane >> 4;
    unsigned char* ws = p.ws;
    bf16_t* OD = (bf16_t*)(ws + WS_X1);
    const bf16_t* RHO = (const bf16_t*)(ws + WS_H);
    const float* GH = (const float*)(ws + WS_BT0);
    const int z = u >> 7, b = (u >> 6) & 1, hd = (u >> 2) & 15, vq = u & 3;
    float* SS = ldsf;
    float* GL = ldsf + 1024;
    bf16_t* SB = (bf16_t*)(ldsf + 1024 + 4096);
    const int v = tid >> 5, kp = (tid & 31) * 2;
    { const float* s0 = p.in[2] + ((size_t)((b * 2 + z) * 16 + hd)) * 4096 + (size_t)(vq * 16 + v) * 64 + kp; SS[v * 64 + kp] = s0[0]; SS[v * 64 + kp + 1] = s0[1]; }
    __syncthreads();
#pragma unroll 1
    for (int sg = 0; sg < 8; ++sg) {
        const int su = ((z * 2 + b) * 16 + hd) * 8 + sg;
        SB[v * 72 + kp] = f2bf_hw(SS[v * 64 + kp]); SB[v * 72 + kp + 1] = f2bf_hw(SS[v * 64 + kp + 1]);
        if (sg < 7) { const f32x4* gsrc = (const f32x4*)(GH + ((size_t)su * 2 + 1) * 4096);
#pragma unroll
            for (int q = 0; q < 2; ++q) ((f32x4*)GL)[tid + q * NTHR] = gsrc[tid + q * NTHR]; }
        __syncthreads();
        const int tlo = z ? (2048 - (sg + 1) * 256) : sg * 256;
#pragma unroll
        for (int q = 0; q < 2; ++q) { const int mt = 2 * w + q;
            f32x4 acc = (f32x4){0.f, 0.f, 0.f, 0.f};
#pragma unroll
            for (int ks = 0; ks < 2; ++ks) { const bf16x8 a = *(const bf16x8*)(RHO + ((size_t)z * 4096 + b * 2048 + tlo + mt * 16 + fr) * 1024 + hd * 64 + ks * 32 + fq * 8);
                const bf16x8 bb = *(const bf16x8*)(SB + fr * 72 + ks * 32 + fq * 8);
                acc = __builtin_amdgcn_mfma_f32_16x16x32_bf16(a, bb, acc, 0, 0, 0); }
#pragma unroll
            for (int jj = 0; jj < 4; ++jj) { bf16_t* op = OD + ((size_t)z * NTOK + NPTOK + b * 2048 + tlo + mt * 16 + fq * 4 + jj) * 1024 + hd * 64 + vq * 16 + fr;
                *op = f2bf_hw(bf2f(*op) + acc[jj]); } }
        if (sg < 7) {
            const float* hsrc = GH + ((size_t)su * 2 + 0) * 4096 + (size_t)(vq * 16 + v) * 64 + kp;
            float a0 = hsrc[0], a1 = hsrc[1];
#pragma unroll 8
            for (int k2 = 0; k2 < 64; ++k2) { const float sv = SS[v * 64 + k2]; a0 += sv * GL[k2 * 64 + kp]; a1 += sv * GL[k2 * 64 + kp + 1]; }
            __syncthreads();
            SS[v * 64 + kp] = a0; SS[v * 64 + kp + 1] = a1;
        }
        __syncthreads();
    }
}
__device__ void phase_wkv_fix(const Params& p, float* lds) {
    for (int it = blockIdx.x; it < 256; it += gridDim.x) wkv_fix_unit(p, it, lds);
}

__device__ void conv_tile(const Params& p, int tile) {
    const int tid = threadIdx.x;
    unsigned char* ws = p.ws;
    const bf16_t* P = (const bf16_t*)(ws + WS_P);
    bf16_t* OC = (bf16_t*)(ws + WS_OC);
    const int cgp = tid & 127, c0 = cgp * 8, sub = tid >> 7;
    float cw0[8], cw1[8], cw2[8];
#pragma unroll
    for (int j = 0; j < 8; ++j) { cw0[j] = p.in[12][c0 + j]; cw1[j] = p.in[12][1024 + c0 + j]; cw2[j] = p.in[12][2048 + c0 + j]; }
    for (int jj = 0; jj < 4; ++jj) {
        const int t = tile * 16 + sub + 4 * jj;
        const int rl = t < NPTOK ? 256 : 64; const int pos = t & (rl - 1);
        const bf16_t* row = P + (size_t)t * N0;
        const u32x4 z4 = (u32x4){0u, 0u, 0u, 0u};
        const u32x4 u1 = *(const u32x4*)(row + c0), g1 = *(const u32x4*)(row + 2048 + c0);
        const u32x4 u0 = pos > 0 ? *(const u32x4*)(row - N0 + c0) : z4, g0 = pos > 0 ? *(const u32x4*)(row - N0 + 2048 + c0) : z4;
        const u32x4 u2 = pos < rl - 1 ? *(const u32x4*)(row + N0 + c0) : z4, g2 = pos < rl - 1 ? *(const u32x4*)(row + N0 + 2048 + c0) : z4;
        const u32x4 gb = *(const u32x4*)(row + 1024 + c0), zc = *(const u32x4*)(row + 3072 + c0);
        u32x4 o;
#pragma unroll
        for (int q = 0; q < 4; ++q) {
            const float y0 = cw0[2 * q] * (bflo(g0[q]) * bflo(u0[q])) + cw1[2 * q] * (bflo(g1[q]) * bflo(u1[q])) + cw2[2 * q] * (bflo(g2[q]) * bflo(u2[q]));
            const float y1 = cw0[2 * q + 1] * (bfhi(g0[q]) * bfhi(u0[q])) + cw1[2 * q + 1] * (bfhi(g1[q]) * bfhi(u1[q])) + cw2[2 * q + 1] * (bfhi(g2[q]) * bfhi(u2[q]));
            o[q] = pack2(silu(bflo(zc[q])) * bflo(gb[q]) * y0, silu(bfhi(zc[q])) * bfhi(gb[q]) * y1);
        }
        *(u32x4*)(OC + (size_t)t * 2048 + c0) = o;
    }
}

__device__ void phase_mix0(const Params& p, float* lds, int rep) {
    unsigned* ctr = (unsigned*)(p.ws + WS_CTL) + rep * 32;
    int* slot = (int*)(lds + LDS_MAIN / 4);
    constexpr int NSCAN = 1024, NCONV = 512;
    for (;;) {
        if (threadIdx.x == 0) *slot = (int)atomicAdd(ctr, 1u);
        __syncthreads();
        const int it = *slot;
        __syncthreads();
        if (it >= NSCAN + NCONV) break;
        if (it < NSCAN) wkv_unit(p, it, lds); else conv_tile(p, it - NSCAN);
    }
}

__device__ __forceinline__ float quad_sum(float v) {
    v += __int_as_float(__builtin_amdgcn_update_dpp(0, __float_as_int(v), 0xB1, 0xF, 0xF, true));
    v += __int_as_float(__builtin_amdgcn_update_dpp(0, __float_as_int(v), 0x4E, 0xF, 0xF, true));
    return v;
}
__device__ void phase_wkv_post(const Params& p) {
    const int tid = threadIdx.x, wave = tid >> 6, lane = tid & 63;
    unsigned char* ws = p.ws;
    const bf16_t* P = (const bf16_t*)(ws + WS_P);
    const bf16_t* OD = (const bf16_t*)(ws + WS_X1);
    const float* BON = (const float*)(ws + WS_BON);
    bf16_t* OC = (bf16_t*)(ws + WS_OC);
    const int hh = lane >> 2, ch0 = hh * 64 + (lane & 3) * 16;
    for (int tok = blockIdx.x * 8 + wave; tok < NTOK; tok += gridDim.x * 8) {
        const bf16_t* row = P + (size_t)tok * N0;
        u32x4 a0[2], a1[2], vv[2], zz[2];
#pragma unroll
        for (int h = 0; h < 2; ++h) { a0[h] = *(const u32x4*)(OD + (size_t)tok * 1024 + ch0 + h * 8); a1[h] = *(const u32x4*)(OD + ((size_t)NTOK + tok) * 1024 + ch0 + h * 8);
            vv[h] = *(const u32x4*)(row + 6144 + ch0 + h * 8); zz[h] = *(const u32x4*)(row + 7168 + ch0 + h * 8); }
        const float bon = BON[(size_t)tok * 16 + hh] + BON[((size_t)NTOK + tok) * 16 + hh];
        float o[16]; float s1 = 0.f;
#pragma unroll
        for (int h = 0; h < 2; ++h)
#pragma unroll
            for (int q = 0; q < 4; ++q) { o[h * 8 + 2 * q] = bflo(a0[h][q]) + bflo(a1[h][q]); o[h * 8 + 2 * q + 1] = bfhi(a0[h][q]) + bfhi(a1[h][q]); s1 += o[h * 8 + 2 * q] + o[h * 8 + 2 * q + 1]; }
        const float mu = quad_sum(s1) * (1.f / 64.f);
        float s2 = 0.f;
#pragma unroll
        for (int i = 0; i < 16; ++i) { o[i] -= mu; s2 += o[i] * o[i]; }
        const float rs = rsqrtf(quad_sum(s2) * (1.f / 64.f) + 64e-5f);
        float res[16];
#pragma unroll
        for (int g4 = 0; g4 < 4; ++g4) { const f32x4 lw4 = *(const f32x4*)(p.in[22] + ch0 + g4 * 4), lb4 = *(const f32x4*)(p.in[23] + ch0 + g4 * 4);
#pragma unroll
            for (int e = 0; e < 4; ++e) { const int i = g4 * 4 + e; const unsigned vw = vv[i >> 3][(i & 7) >> 1], zw_ = zz[i >> 3][(i & 7) >> 1];
                const float v1 = (i & 1) ? bfhi(vw) : bflo(vw), z1 = (i & 1) ? bfhi(zw_) : bflo(zw_);
                res[i] = (o[i] * rs * lw4[e] + lb4[e] + bon * v1) * silu(z1); } }
#pragma unroll
        for (int h = 0; h < 2; ++h) { u32x4 w4; w4.x = pk2(res[h * 8 + 0], res[h * 8 + 1]); w4.y = pk2(res[h * 8 + 2], res[h * 8 + 3]); w4.z = pk2(res[h * 8 + 4], res[h * 8 + 5]); w4.w = pk2(res[h * 8 + 6], res[h * 8 + 7]);
            *(u32x4*)(OC + (size_t)tok * 2048 + 1024 + ch0 + h * 8) = w4; }
    }
}

constexpr size_t WS_QE = WS_H;
constexpr size_t WS_KDT = WS_BT0;
constexpr size_t WS_VT = WS_OC + (size_t)NTOK * 1024 * 2;
constexpr size_t WS_EBL = WS_BON + (size_t)2 * NTOK * 16 * 4;
constexpr size_t WS_ATT = WS_P + 52 * MB;

__device__ void gla_a_item(const Params& p, int item, float* ldsf) {
    const int tid = threadIdx.x, lane = tid & 63, w = __builtin_amdgcn_readfirstlane(tid >> 6), fr = lane & 15, fq = lane >> 4;
    unsigned char* ws = p.ws;
    const bf16_t* P1 = (const bf16_t*)(ws + WS_P);
    float* OD = (float*)(ws + WS_P2);
    bf16_t* QEg = (bf16_t*)(ws + WS_QE); bf16_t* KDTg = (bf16_t*)(ws + WS_KDT); bf16_t* VTg = (bf16_t*)(ws + WS_VT); float* EBLg = (float*)(ws + WS_EBL);
    const int hd = item & 3, c = (item >> 2) & 127, z = item >> 9, tok0 = c * 64;
    bf16_t* QE = (bf16_t*)ldsf;
    bf16_t* KE = QE + 64 * 136;
    bf16_t* VT = KE + 64 * 136;
    bf16_t* ATT = VT + 256 * 72;
    float* G = (float*)(ATT + 64 * 72);
    float* L1G = G + 64 * 132;
    float* GK2 = L1G + 1024;
    for (int i = tid; i < 1024; i += NTHR) { const int t = i >> 4, r = i & 15; L1G[i] = bf2f(P1[(size_t)(tok0 + t) * N1 + 3072 + z * 16 + r]); }
    for (int i = tid; i < 2048; i += NTHR) { const int r = i >> 7, d = i & 127; GK2[i] = p.in[27][(size_t)(z * 16 + r) * 512 + hd * 128 + d]; }
#pragma unroll
    for (int ps = 0; ps < 4; ++ps) { const int t = ps * 16 + (tid >> 5), e8 = (tid & 31) * 8;
        const u32x4 v8 = *(const u32x4*)(P1 + (size_t)(tok0 + t) * N1 + 1024 + hd * 256 + e8);
        VT[(e8 + 0) * 72 + t] = (bf16_t)(v8.x & 0xFFFF); VT[(e8 + 1) * 72 + t] = (bf16_t)(v8.x >> 16); VT[(e8 + 2) * 72 + t] = (bf16_t)(v8.y & 0xFFFF); VT[(e8 + 3) * 72 + t] = (bf16_t)(v8.y >> 16);
        VT[(e8 + 4) * 72 + t] = (bf16_t)(v8.z & 0xFFFF); VT[(e8 + 5) * 72 + t] = (bf16_t)(v8.z >> 16); VT[(e8 + 6) * 72 + t] = (bf16_t)(v8.w & 0xFFFF); VT[(e8 + 7) * 72 + t] = (bf16_t)(v8.w >> 16); }
    const int d = tid & 127, tq = tid >> 7;
    const float gbias = p.in[28][z * 512 + hd * 128 + d];
    bf16_t qraw[16], kraw[16];
#pragma unroll
    for (int i = 0; i < 16; ++i) { const size_t row = (size_t)(tok0 + tq * 16 + i) * N1; qraw[i] = P1[row + hd * 128 + d]; kraw[i] = P1[row + 512 + hd * 128 + d]; }
    __syncthreads();
    { float run = 0.f;
#pragma unroll 4
      for (int i = 0; i < 16; ++i) { const int t = z ? (tq * 16 + 15 - i) : (tq * 16 + i);
        float x = gbias;
#pragma unroll
        for (int r = 0; r < 16; ++r) x += L1G[t * 16 + r] * GK2[r * 128 + d];
        const float ls = fminf(x, 0.f) - __logf(1.f + __expf(-fabsf(x)));
        run += ls * (1.f / 16.f);
        G[t * 132 + d] = run; } }
    __syncthreads();
    { const int lastr = z ? 0 : 15;
      const float t0 = G[(0 + lastr) * 132 + d], t1 = G[(16 + lastr) * 132 + d], t2 = G[(32 + lastr) * 132 + d], t3 = G[(48 + lastr) * 132 + d];
      const float blast = t0 + t1 + t2 + t3;
      float off;
      if (z == 0) off = tq == 0 ? 0.f : (tq == 1 ? t0 : (tq == 2 ? t0 + t1 : t0 + t1 + t2));
      else off = tq == 3 ? 0.f : (tq == 2 ? t3 : (tq == 1 ? t3 + t2 : t3 + t2 + t1));
      if (tq == 0) EBLg[(size_t)(z * 128 + c) * 512 + hd * 128 + d] = __expf(blast);
      unsigned kdp[8];
#pragma unroll
      for (int i = 0; i < 16; ++i) { const int t = tq * 16 + i;
        const float bc = G[t * 132 + d] + off;
        const float q = bf2f(qraw[i]) * 0.08838834764831845f, k = bf2f(kraw[i]);
        const bf16_t qe = f2bf(q * __expf(bc));
        QE[t * 136 + d] = qe; KE[t * 136 + d] = f2bf(k * __expf(-bc));
        QEg[((size_t)z * NTOK + tok0 + t) * 512 + hd * 128 + d] = qe;
        const unsigned kd = (unsigned)f2bf(k * __expf(blast - bc));
        if (i & 1) kdp[i >> 1] |= kd << 16; else kdp[i >> 1] = kd; }
      bf16_t* kdst = KDTg + ((size_t)(((z * 128 + c) * 4 + hd) * 128 + d)) * 64 + tq * 16;
      *(u32x4*)kdst = (u32x4){kdp[0], kdp[1], kdp[2], kdp[3]}; *(u32x4*)(kdst + 8) = (u32x4){kdp[4], kdp[5], kdp[6], kdp[7]}; }
    __syncthreads();
    if (z == 0) {
#pragma unroll
        for (int q4 = 0; q4 < 4; ++q4) { const int idx = q4 * NTHR + tid; const int e = idx >> 3, t8 = (idx & 7) * 8;
            *(u32x4*)(VTg + ((size_t)((c * 4 + hd) * 256 + e)) * 64 + t8) = *(const u32x4*)(VT + e * 72 + t8); } }
#pragma unroll
    for (int q2 = 0; q2 < 2; ++q2) { const int tA = 2 * w + q2, ia = tA >> 2, ja = tA & 3;
        f32x4 a4 = (f32x4){0.f, 0.f, 0.f, 0.f};
        if (z ? (ja >= ia) : (ja <= ia)) a4 = mma_nt(QE + ia * 16 * 136, 136, KE + ja * 16 * 136, 136, 128, a4, fr, fq);
#pragma unroll
        for (int jj = 0; jj < 4; ++jj) { const int i = ia * 16 + fq * 4 + jj, j = ja * 16 + fr; const bool keep = z ? (j >= i) : (j <= i); ATT[i * 72 + j] = f2bf(keep ? a4[jj] : 0.f); } }
    __syncthreads();
    { bf16_t* ATTg = (bf16_t*)(ws + WS_ATT) + ((size_t)((z * 128 + c) * 4 + hd)) * 4096;
      const int i = tid >> 3, j8 = (tid & 7) * 8;
      *(u32x4*)(ATTg + i * 64 + j8) = *(const u32x4*)(ATT + i * 72 + j8); }
    __syncthreads();
}

__device__ void phase_gla_a(const Params& p, float* lds) {
    for (int it = blockIdx.x; it < 1024; it += gridDim.x) gla_a_item(p, it, lds);
}

struct GlaFrags { bf16x8 kdt[2]; u32x4 vts; u32x4 qes[2]; bf16x8 att[2]; f32x4 ebl; };

__device__ void gla_b_unit(const Params& p, int u, float* ldsf) {
    const int tid = threadIdx.x, lane = tid & 63, w = __builtin_amdgcn_readfirstlane(tid >> 6), fr = lane & 15, fq = lane >> 4;
    unsigned char* ws = p.ws;
    float* OD = (float*)(ws + WS_P2);
    const bf16_t* QEg = (const bf16_t*)(ws + WS_QE); const bf16_t* KDTg = (const bf16_t*)(ws + WS_KDT); const bf16_t* VTg = (const bf16_t*)(ws + WS_VT); const float* EBLg = (const float*)(ws + WS_EBL);
    const bf16_t* ATTg = (const bf16_t*)(ws + WS_ATT);
    int z, b, hd, eq, nch, ch0; bool sample;
    if (u < 64) { sample = true; z = u >> 5; b = (u >> 4) & 1; hd = (u >> 2) & 3; eq = u & 3; nch = 32; ch0 = 64 + b * 32; }
    else { const int q = u - 64; sample = false; z = q >> 8; b = (q >> 4) & 15; hd = (q >> 2) & 3; eq = q & 3; nch = 4; ch0 = b * 4; }
    bf16_t* ST = (bf16_t*)ldsf;
    bf16_t* VTL = ST + 2 * 64 * 136;
    bf16_t* QEL = VTL + 2 * 64 * 72;
    f32x4 Sacc[4];
    if (sample) { const float* s0 = p.in[3] + ((size_t)((b * 2 + z) * 4 + hd)) * 32768 + eq * 64 + fr;
#pragma unroll
        for (int et = 0; et < 4; ++et)
#pragma unroll
            for (int jj = 0; jj < 4; ++jj) Sacc[et][jj] = s0[(size_t)(w * 16 + fq * 4 + jj) * 256 + et * 16]; }
    else {
#pragma unroll
        for (int et = 0; et < 4; ++et) Sacc[et] = (f32x4){0.f, 0.f, 0.f, 0.f}; }
    const int it = w >> 1, e2 = (w & 1) * 2;
    const int ve = tid >> 3, vt8 = (tid & 7) * 8;
#define GLB_LOAD(F, c_) do { const int cc_ = (c_); \
        _Pragma("unroll") for (int ks = 0; ks < 2; ++ks) { (F).kdt[ks] = *(const bf16x8*)(KDTg + ((size_t)(((z * 128 + cc_) * 4 + hd) * 128 + w * 16 + fr)) * 64 + ks * 32 + fq * 8); \
            (F).att[ks] = *(const bf16x8*)(ATTg + ((size_t)((z * 128 + cc_) * 4 + hd)) * 4096 + (it * 16 + fr) * 64 + ks * 32 + fq * 8); } \
        (F).vts = *(const u32x4*)(VTg + ((size_t)((cc_ * 4 + hd) * 256 + eq * 64 + ve)) * 64 + vt8); \
        _Pragma("unroll") for (int h_ = 0; h_ < 2; ++h_) (F).qes[h_] = *(const u32x4*)(QEg + ((size_t)z * NTOK + cc_ * 64 + ve) * 512 + hd * 128 + h_ * 64 + vt8); \
        (F).ebl = *(const f32x4*)(EBLg + (size_t)(z * 128 + cc_) * 512 + hd * 128 + w * 16 + fq * 4); } while (0)
#define GLB_STEP(CUR, NX2, ci_) do { const int ci = (ci_); if (ci < nch) { \
        const int c = ch0 + (z ? nch - 1 - ci : ci); \
        bf16_t* STc = ST + (ci & 1) * 64 * 136; bf16_t* VTc = VTL + (ci & 1) * 64 * 72; \
        _Pragma("unroll") for (int et = 0; et < 4; ++et) { u32x2 v2; v2.x = pk2(Sacc[et][0], Sacc[et][1]); v2.y = pk2(Sacc[et][2], Sacc[et][3]); \
            *(u32x2*)(STc + (et * 16 + fr) * 136 + w * 16 + fq * 4) = v2; } \
        *(u32x4*)(VTc + ve * 72 + vt8) = (CUR).vts; \
        bf16_t* QEc = QEL + (ci & 1) * 64 * 136; \
        *(u32x4*)(QEc + ve * 136 + vt8) = (CUR).qes[0]; *(u32x4*)(QEc + ve * 136 + 64 + vt8) = (CUR).qes[1]; \
        if (ci + 2 < nch) GLB_LOAD(NX2, ch0 + (z ? nch - 3 - ci : ci + 2)); \
        lds_barrier(); \
        _Pragma("unroll") for (int et = 0; et < 4; ++et) { Sacc[et] = Sacc[et] * (CUR).ebl; \
            _Pragma("unroll") for (int ks = 0; ks < 2; ++ks) { const bf16x8 vf = *(const bf16x8*)(VTc + (et * 16 + fr) * 72 + ks * 32 + fq * 8); \
                Sacc[et] = __builtin_amdgcn_mfma_f32_16x16x32_bf16((CUR).kdt[ks], vf, Sacc[et], 0, 0, 0); } } \
        _Pragma("unroll") for (int q2 = 0; q2 < 2; ++q2) { f32x4 o = (f32x4){0.f, 0.f, 0.f, 0.f}; \
            _Pragma("unroll") for (int ks = 0; ks < 2; ++ks) { const bf16x8 vf = *(const bf16x8*)(VTc + ((e2 + q2) * 16 + fr) * 72 + ks * 32 + fq * 8); \
                o = __builtin_amdgcn_mfma_f32_16x16x32_bf16((CUR).att[ks], vf, o, 0, 0, 0); } \
            _Pragma("unroll") for (int ks = 0; ks < 4; ++ks) { const bf16x8 bS = *(const bf16x8*)(STc + ((e2 + q2) * 16 + fr) * 136 + ks * 32 + fq * 8); \
                const bf16x8 aq = *(const bf16x8*)(QEc + (it * 16 + fr) * 136 + ks * 32 + fq * 8); \
                o = __builtin_amdgcn_mfma_f32_16x16x32_bf16(aq, bS, o, 0, 0, 0); } \
            _Pragma("unroll") for (int jj = 0; jj < 4; ++jj) OD[((size_t)z * NTOK + c * 64 + it * 16 + fq * 4 + jj) * 1024 + hd * 256 + eq * 64 + (e2 + q2) * 16 + fr] = o[jj]; } } } while (0)
    GlaFrags fa, fb, fc;
    GLB_LOAD(fa, ch0 + (z ? nch - 1 : 0));
    GLB_LOAD(fb, ch0 + (z ? nch - 2 : 1));
    __syncthreads();
#pragma unroll 1
    for (int ci3 = 0; ci3 < nch; ci3 += 3) { GLB_STEP(fa, fc, ci3); GLB_STEP(fb, fa, ci3 + 1); GLB_STEP(fc, fb, ci3 + 2); }
#undef GLB_STEP
#undef GLB_LOAD
    if (!sample) { float* so = p.out + (size_t)2 * NPTOK * D + 2097152 + ((size_t)((b * 2 + z) * 4 + hd)) * 32768 + eq * 64 + fr;
#pragma unroll
        for (int et = 0; et < 4; ++et)
#pragma unroll
            for (int jj = 0; jj < 4; ++jj) so[(size_t)(w * 16 + fq * 4 + jj) * 256 + et * 16] = Sacc[et][jj]; }
    __syncthreads();
}

__device__ void phase_gla_b(const Params& p, float* lds, int rep) {
    unsigned* ctr = (unsigned*)(p.ws + WS_CTL) + 16 + rep * 32;
    int* slot = (int*)(lds + LDS_MAIN / 4);
    for (;;) {
        if (threadIdx.x == 0) *slot = (int)atomicAdd(ctr, 1u);
        __syncthreads();
        const int it = *slot;
        __syncthreads();
        if (it >= 576) break;
        gla_b_unit(p, it, lds);
    }
}

__device__ void phase_gla_post(const Params& p) {
    const int tid = threadIdx.x, wave = tid >> 6, lane = tid & 63;
    unsigned char* ws = p.ws;
    const bf16_t* P1 = (const bf16_t*)(ws + WS_P);
    const float* OD = (const float*)(ws + WS_P2);
    bf16_t* OG = (bf16_t*)(ws + WS_OC);
    for (int tok = blockIdx.x * 8 + wave; tok < NTOK; tok += gridDim.x * 8) {
        for (int hd = 0; hd < 4; ++hd) { const int idx = hd * 256 + lane * 4;
            const f32x4 a = *(const f32x4*)(OD + (size_t)tok * 1024 + idx), b2 = *(const f32x4*)(OD + ((size_t)NTOK + tok) * 1024 + idx);
            const f32x4 o = a + b2;
            const float ss = wave_sum(o[0] * o[0] + o[1] * o[1] + o[2] * o[2] + o[3] * o[3]);
            const float rs = rsqrtf(ss * (1.f / 256.f) + 1e-6f);
            const f32x4 gn = *(const f32x4*)(p.in[29] + lane * 4);
            const u32x2 zz = *(const u32x2*)(P1 + (size_t)tok * N1 + 2048 + idx);
            const float z0 = bflo(zz.x), z1 = bfhi(zz.x), z2 = bflo(zz.y), z3 = bfhi(zz.y);
            u32x2 w; w.x = pack2(o[0] * rs * gn[0] * silu(z0), o[1] * rs * gn[1] * silu(z1)); w.y = pack2(o[2] * rs * gn[2] * silu(z2), o[3] * rs * gn[3] * silu(z3));
            *(u32x2*)(OG + (size_t)tok * 1024 + idx) = w; }
    }
}

__device__ void phase_final(const Params& p) {
    const int tid = threadIdx.x, wave = tid >> 6, lane = tid & 63;
    unsigned char* ws = p.ws;
    const float* MOD = (const float*)(ws + WS_MOD);
    const float* X1 = (const float*)(ws + WS_X1);
    const float* Y = (const float*)(ws + WS_P2);
    for (int tok = blockIdx.x * 8 + wave; tok < NTOK; tok += gridDim.x * 8) {
        const int cond = tok < NPTOK ? 0 : 1 + ((tok - NPTOK) >> 11);
        f32x4 xv[4]; float ss = 0.f;
#pragma unroll
        for (int i = 0; i < 4; ++i) { const int idx = i * 256 + lane * 4;
            const f32x4 x1 = *(const f32x4*)(X1 + (size_t)tok * D + idx);
            const f32x4 ya = *(const f32x4*)(Y + (size_t)tok * D + idx), yb = *(const f32x4*)(Y + (size_t)NTOK * D + (size_t)tok * D + idx);
            const f32x4 gt = *(const f32x4*)(MOD + (1 * 3 + cond) * 3072 + 2048 + idx);
            xv[i] = x1 + gt * (ya + yb);
            ss += xv[i][0] * xv[i][0] + xv[i][1] * xv[i][1] + xv[i][2] * xv[i][2] + xv[i][3] * xv[i][3]; }
        ss = wave_sum(ss);
        const float rstd = rsqrtf(ss * (1.f / 1024.f) + 1e-6f);
#pragma unroll
        for (int i = 0; i < 4; ++i) { const int idx = i * 256 + lane * 4;
            const f32x4 g = *(const f32x4*)(p.in[9] + idx);
            f32x4 o;
#pragma unroll
            for (int j = 0; j < 4; ++j) o[j] = xv[i][j] * rstd * g[j];
            *(f32x4*)(p.out + (size_t)tok * D + idx) = o; }
    }
}


#define XB_TMO      128
#define XB_XCNT(j)  (256  + 64 * (j))
#define XB_XSUB(j)  (1280 + 64 * (j))
#define XB_XGEN(j)  (2304 + 64 * (j))
#define XB_TOP      3328
#define XB_TOPGEN   3392
#define XCD_BAR_WORDS 3456
#define XB_SPIN_CAP (1u << 18)

__device__ __forceinline__ unsigned xb_ld(unsigned* p)              { return __hip_atomic_load(p, __ATOMIC_RELAXED, __HIP_MEMORY_SCOPE_AGENT); }
__device__ __forceinline__ unsigned xb_add(unsigned* p, unsigned v) { return __hip_atomic_fetch_add(p, v, __ATOMIC_RELAXED, __HIP_MEMORY_SCOPE_AGENT); }
__device__ __forceinline__ unsigned xb_xcc_id() { return (unsigned)__builtin_amdgcn_s_getreg((3 << 11) | 20) & 0xFu; }
#define XB_SPIN(cond, bar) do { unsigned _sp = 0; while (cond) { __builtin_amdgcn_s_sleep(1); \
    if ((++_sp & 255u) == 0u) { if (xb_ld(&(bar)[XB_TMO])) break; if (_sp > XB_SPIN_CAP) { atomicAdd(&(bar)[XB_TMO], 1u); break; } } } } while (0)

struct XcdBarrier {
    unsigned* bar; unsigned x;
    volatile LAS unsigned* st;
};

__device__ __forceinline__ XcdBarrier xcd_barrier_post(unsigned* bar, volatile LAS unsigned* st) {
    XcdBarrier b; b.bar = bar; b.x = xb_xcc_id(); b.st = st;
    if (threadIdx.x == 0) (void)xb_add(&bar[XB_XCNT(b.x)], 1u);
    return b;
}
__device__ __forceinline__ void xcd_barrier_complete(unsigned* bar, unsigned x, unsigned& nloc, unsigned& nx) {
    const unsigned G = gridDim.x * gridDim.y * gridDim.z;
    unsigned sum, cnt, mine, sp = 0u;
    for (;;) {
        sum = 0u; cnt = 0u; mine = 0u;
#pragma unroll
        for (unsigned j = 0; j < 16; ++j) { const unsigned c = xb_ld(&bar[XB_XCNT(j)]); sum += c; cnt += (c > 0u) ? 1u : 0u; mine = (j == x) ? c : mine; }
        if (sum == G) break;
        __builtin_amdgcn_s_sleep(1);
        if ((++sp & 255u) == 0u) { if (xb_ld(&bar[XB_TMO])) break; if (sp > XB_SPIN_CAP) { atomicAdd(&bar[XB_TMO], 1u); break; } }
    }
    nloc = mine > 0u ? mine : 1u; nx = cnt > 0u ? cnt : 1u;
}

__device__ __forceinline__ void xcd_barrier(const XcdBarrier& b) {
    asm volatile("s_waitcnt vmcnt(0)" ::: "memory");
    __syncthreads();
    if (threadIdx.x == 0) {
        unsigned* bar = b.bar;
        __builtin_amdgcn_s_waitcnt(0);
        unsigned nloc = b.st[0], nx = b.st[1];
        if (nloc == 0u) { xcd_barrier_complete(bar, b.x, nloc, nx); b.st[0] = nloc; b.st[1] = nx; }
        const unsigned old = xb_add(&bar[XB_XSUB(b.x)], 1u);
        const unsigned gen = old / nloc;
        if (old + 1u == (gen + 1u) * nloc) {
            __builtin_amdgcn_fence(__ATOMIC_RELEASE, "agent");
            asm volatile("s_waitcnt vmcnt(0)" ::: "memory");
            const unsigned og = xb_add(&bar[XB_TOP], 1u);
            const unsigned tg = og / nx;
            if (og + 1u == (tg + 1u) * nx) xb_add(&bar[XB_TOPGEN], 1u);
            else XB_SPIN(xb_ld(&bar[XB_TOPGEN]) == tg, bar);
            __builtin_amdgcn_fence(__ATOMIC_ACQUIRE, "agent");
            xb_add(&bar[XB_XGEN(b.x)], 1u);
            asm volatile("s_waitcnt vmcnt(0)" ::: "memory");
        } else {
            XB_SPIN(xb_ld(&bar[XB_XGEN(b.x)]) == gen, bar);
            __builtin_amdgcn_fence(__ATOMIC_ACQUIRE, "agent");
            asm volatile("s_waitcnt vmcnt(0)" ::: "memory");
        }
    }
    __syncthreads();
}


constexpr int NPHASE = 14;
__global__ void __launch_bounds__(NTHR, 2) fwd_megakernel(Params p) {
    extern __shared__ __attribute__((aligned(16))) unsigned char smem[];
    float* ldsf = (float*)smem;
    LAS unsigned char* ldsl = (LAS unsigned char*)smem;
    unsigned char* ws = p.ws;
    volatile LAS unsigned* xst = (volatile LAS unsigned*)(ldsl + LDS_MAIN + 16);
    if (threadIdx.x == 0) { xst[0] = 0u; xst[1] = 0u; }
    __syncthreads();
    const XcdBarrier xbar = xcd_barrier_post((unsigned*)(ws + WS_BAR), xst);
    if (p.ph_lo < 0) cg::this_grid().sync();
#ifndef DUP_PHASE
#define DUP_PHASE -1
#endif
#define PHASE(n) if (p.ph_lo <= (n) && (n) < p.ph_hi && ((n) == p.ph_lo || (xcd_barrier(xbar), true))) for (int rep = 0; rep < ((n) == DUP_PHASE ? 2 : 1); ++rep, ((n) == DUP_PHASE ? (xcd_barrier(xbar), 0) : 0))
    PHASE(0) phase_prologue(p, ldsf);
    PHASE(1) phase_h(p, 0);
    PHASE(2) { pg8::Gemm g{(const bf16_t*)(ws + WS_H), (const bf16_t*)(ws + WS_BT0), NTOK, N0, 1024, 1024, 1}; pg8::Order S; S.init(NTOK, N0, 1, gridDim.x, blockIdx.x);
               pg8::EpiBf16 E{(bf16_t*)(ws + WS_P), N0}; pg8::gemm_phase(ldsl, g, S, E); }
    PHASE(3) phase_mix0(p, ldsf, rep);
    PHASE(4) phase_wkv_fix(p, ldsf);
    PHASE(5) phase_wkv_post(p);
    PHASE(6) { pg8::Gemm g{(const bf16_t*)(ws + WS_OC), (const bf16_t*)(ws + WS_WT0O), NTOK, 1024, 1024, 2048, 2}; pg8::Order S; S.init(NTOK, 1024, 2, gridDim.x, blockIdx.x);
               pg8::EpiF32 E{(float*)(ws + WS_P), 1024, (size_t)NTOK * 1024}; pg8::gemm_phase(ldsl, g, S, E); }
    PHASE(7) phase_h(p, 1);
    PHASE(8) { pg8::Gemm g{(const bf16_t*)(ws + WS_H), (const bf16_t*)(ws + WS_BT1), NTOK, N1, 1024, 1024, 1}; pg8::Order S; S.init(NTOK, N1, 1, gridDim.x, blockIdx.x);
               pg8::EpiBf16 E{(bf16_t*)(ws + WS_P), N1}; pg8::gemm_phase(ldsl, g, S, E); }
    PHASE(9) phase_gla_a(p, ldsf);
    PHASE(10) phase_gla_b(p, ldsf, rep);
    PHASE(11) phase_gla_post(p);
    PHASE(12) { pg8::Gemm g{(const bf16_t*)(ws + WS_OC), (const bf16_t*)(ws + WS_WT1O), NTOK, 1024, 512, 1024, 2}; pg8::Order S; S.init(NTOK, 1024, 2, gridDim.x, blockIdx.x);
                pg8::EpiF32 E{(float*)(ws + WS_P2), 1024, (size_t)NTOK * 1024}; pg8::gemm_phase(ldsl, g, S, E); }
    PHASE(13) phase_final(p);
}

extern "C" void kernel_launch(void* const* d_in, const int* in_sizes, int n_in, void* d_out, int out_size, void* d_ws, size_t ws_size, hipStream_t stream) {
    static int grid = 0;
    if (grid == 0) {
        if (n_in != 30 || ws_size < WS_END) { fprintf(stderr, "kernel_launch: unexpected n_in %d / ws_size %zu (need %zu)\n", n_in, ws_size, (size_t)WS_END); grid = -1; return; }
        int dev = 0, cus = 0, per_cu = 0;
        hipGetDevice(&dev);
        hipDeviceGetAttribute(&cus, hipDeviceAttributeMultiprocessorCount, dev);
        hipFuncSetAttribute((const void*)fwd_megakernel, hipFuncAttributeMaxDynamicSharedMemorySize, LDS_BYTES);
        hipOccupancyMaxActiveBlocksPerMultiprocessor(&per_cu, (const void*)fwd_megakernel, NTHR, LDS_BYTES);
        if (per_cu < 1) { fprintf(stderr, "kernel_launch: occupancy query returned %d\n", per_cu); per_cu = 1; }
        grid = cus * per_cu;
        (void)hipGetLastError();
    }
    if (grid < 0) return;
    hipMemsetAsync((char*)d_ws + WS_CTL, 0, 256, stream);
    hipMemsetAsync((char*)d_ws + WS_BAR, 0, XCD_BAR_WORDS * 4, stream);
    Params p{};
    for (int i = 0; i < 30; ++i) p.in[i] = (const float*)d_in[i];
    p.out = (float*)d_out; p.ws = (unsigned char*)d_ws;
#if MULTI_LAUNCH
    for (int ph = 0; ph < NPHASE; ++ph) { p.ph_lo = ph; p.ph_hi = ph + 1; hipLaunchKernelGGL(fwd_megakernel, dim3(grid), dim3(NTHR), LDS_BYTES, stream, p); }
#else
    p.ph_lo = 0; p.ph_hi = NPHASE;
    void* args[] = {&p};
    hipError_t e = hipLaunchCooperativeKernel((const void*)fwd_megakernel, dim3(grid), dim3(NTHR), args, LDS_BYTES, stream);
    if (e != hipSuccess) fprintf(stderr, "cooperative launch failed: %s (grid %d)\n", hipGetErrorString(e), grid);
#endif
}
```

```cpp
#include <hip/hip_runtime.h>
#include <hip/hip_cooperative_groups.h>
#include <cstdio>
namespace cg = cooperative_groups;

#define LAS __attribute__((address_space(3)))
typedef unsigned short bf16_t;
typedef short bf16x8 __attribute__((ext_vector_type(8)));
typedef float f32x4 __attribute__((ext_vector_type(4)));
typedef unsigned u32x4 __attribute__((ext_vector_type(4)));
typedef unsigned u32x2 __attribute__((ext_vector_type(2)));

#ifndef MULTI_LAUNCH
#define MULTI_LAUNCH 0
#endif

constexpr int D = 1024, NTOK = 8192, NPTOK = 4096;
constexpr int N0 = 8448;
constexpr int N1 = 3328;
constexpr int NTHR = 512;
constexpr int LDS_MAIN = 139264;
constexpr int LDS_BYTES = LDS_MAIN + 256;

constexpr size_t MB = 1024 * 1024;
constexpr size_t WS_CTL = 0;
constexpr size_t WS_MOD = 4096;
constexpr size_t WS_BON = WS_MOD + 2 * 3 * 3072 * 4;
constexpr size_t WS_BAR = 0x1A0000;
constexpr size_t WS_BT0 = 2 * MB;
constexpr size_t WS_WT0O = WS_BT0 + (size_t)N0 * 1024 * 2;
constexpr size_t WS_BT1 = WS_WT0O + (size_t)1024 * 2048 * 2;
constexpr size_t WS_WT1O = WS_BT1 + (size_t)N1 * 1024 * 2;
constexpr size_t WS_H = WS_WT1O + (size_t)1024 * 1024 * 2;
constexpr size_t WS_OC = WS_H + (size_t)NTOK * 1024 * 2;
constexpr size_t WS_X1 = WS_OC + (size_t)NTOK * 2048 * 2;
constexpr size_t WS_P = WS_X1 + (size_t)NTOK * 1024 * 4;
constexpr size_t WS_P2 = WS_P + 64 * MB;
constexpr size_t WS_END = WS_P + (size_t)NTOK * N0 * 2;

struct Params {
    const float* in[30];
    float* out;
    unsigned char* ws;
    int ph_lo, ph_hi;
};

__device__ __forceinline__ float bf2f(bf16_t h) { return __uint_as_float(((unsigned)h) << 16); }
__device__ __forceinline__ bf16_t f2bf(float f) { unsigned u = __float_as_uint(f); u += 0x7FFFu + ((u >> 16) & 1u); return (bf16_t)(u >> 16); }
__device__ __forceinline__ unsigned pack2(float lo, float hi) { return (unsigned)f2bf(lo) | ((unsigned)f2bf(hi) << 16); }
__device__ __forceinline__ float bflo(unsigned w) { return __uint_as_float(w << 16); }
__device__ __forceinline__ float bfhi(unsigned w) { return __uint_as_float(w & 0xFFFF0000u); }
__device__ __forceinline__ float silu(float x) { return x / (1.f + __expf(-x)); }
__device__ __forceinline__ float wave_sum(float v) {
#pragma unroll
    for (int m = 32; m >= 1; m >>= 1) v += __shfl_xor(v, m, 64);
    return v;
}

typedef float f32x2_t __attribute__((ext_vector_type(2)));
typedef __bf16 bf16x2_t __attribute__((ext_vector_type(2)));
__device__ __forceinline__ unsigned pk2(float lo, float hi) { const f32x2_t v = {lo, hi}; return __builtin_bit_cast(unsigned, __builtin_convertvector(v, bf16x2_t)); }
__device__ __forceinline__ bf16_t f2bf_hw(float f) { return __builtin_bit_cast(bf16_t, (__bf16)f); }

__device__ __forceinline__ void lds_barrier() { asm volatile("s_waitcnt lgkmcnt(0)" ::: "memory"); __builtin_amdgcn_s_barrier(); asm volatile("" ::: "memory"); }

namespace pg8 {
constexpr int BM = 256, BK = 64, HALF = 128, HTB = HALF * BK * 2, NXCD = 8, WGM = 8;
__device__ __forceinline__ int lds_byte(int r, int c) { const int st = (r >> 4) * 2 + (c >> 5), rr = r & 15, cc = c & 31, ob = rr * 64 + cc * 2; return st * 1024 + (ob ^ (((ob >> 9) & 1) << 5)); }
__device__ __forceinline__ void stage_rc(int b, int& R, int& C) { const int st = b / 1024, sb = b % 1024, swz = sb ^ (((sb >> 9) & 1) << 5); R = (st >> 1) * 16 + swz / 64; C = (st & 1) * 32 + (swz % 64) / 2; }
__device__ __forceinline__ int perm32(int rho) { const int n = rho >> 4, i = rho & 15; return 8 * (i >> 2) + 4 * n + (i & 3); }

struct Unit { int pm, pn, ks; };
struct Gemm { const bf16_t* A; const bf16_t* Bt; int M, N, K, ld, KS; };

struct Order {
    int nM, nN, nNr, nwg, G, c;
    __device__ void init(int M, int N, int KS, int G_, int c_) { nM = M / BM; nNr = N / BM; nN = nNr * KS; nwg = nM * nN; G = G_; c = c_; }
    __device__ bool next(int i, Unit& u) const {
        const long L = (long)i * G + c; if (L >= nwg) return false;
        int wgid = (int)L; { const int q = nwg / NXCD, r = nwg % NXCD, xcd = wgid % NXCD, off = wgid / NXCD; wgid = (xcd < r ? xcd * (q + 1) : r * (q + 1) + (xcd - r) * q) + off; }
        const int nig = WGM * nN, gid = wgid / nig, fm = gid * WGM, gsz = (nM - fm) < WGM ? (nM - fm) : WGM;
        u.pm = fm + ((wgid % nig) % gsz); const int pn = (wgid % nig) / gsz; u.pn = pn % nNr; u.ks = pn / nNr; return true;
    }
};

__device__ __forceinline__ unsigned cvt_pk_bf16(float lo, float hi) { unsigned r; asm volatile("v_cvt_pk_bf16_f32 %0, %1, %2" : "=v"(r) : "v"(lo), "v"(hi)); return r; }

struct EpiF32 {
    static constexpr bool PERM = false;
    float* C; int ldc; size_t ks_stride;
    __device__ __forceinline__ void operator()(const f32x4 (&acc)[2][2][4][2], const Unit& u, int wr, int wc, int fr, int fq) const {
        const int row0 = u.pm * BM + wr * 64 + fr, col0 = u.pn * BM + wc * 32 + 4 * fq;
        float* Cb = C + (size_t)u.ks * ks_stride;
#pragma unroll
        for (int ai = 0; ai < 2; ++ai)
#pragma unroll
            for (int m = 0; m < 4; ++m) { float* rowp = Cb + (size_t)(row0 + ai * HALF + m * 16) * ldc + col0;
#pragma unroll
                for (int bj = 0; bj < 2; ++bj)
#pragma unroll
                    for (int n = 0; n < 2; ++n) *(f32x4*)(rowp + bj * HALF + n * 16) = acc[ai][bj][m][n]; }
    }
};
struct EpiBf16 {
    static constexpr bool PERM = true;
    bf16_t* O; int ldc;
    __device__ __forceinline__ void operator()(const f32x4 (&acc)[2][2][4][2], const Unit& u, int wr, int wc, int fr, int fq) const {
        const int row0 = u.pm * BM + wr * 64 + fr; const int col0 = u.pn * BM + wc * 32 + 8 * fq;
#pragma unroll
        for (int ai = 0; ai < 2; ++ai)
#pragma unroll
            for (int m = 0; m < 4; ++m) { bf16_t* rowp = O + (size_t)(row0 + ai * HALF + m * 16) * ldc + col0;
#pragma unroll
                for (int bj = 0; bj < 2; ++bj) { const f32x4 v0 = acc[ai][bj][m][0], v1 = acc[ai][bj][m][1];
                    u32x4 w; w.x = cvt_pk_bf16(v0[0], v0[1]); w.y = cvt_pk_bf16(v0[2], v0[3]); w.z = cvt_pk_bf16(v1[0], v1[1]); w.w = cvt_pk_bf16(v1[2], v1[3]);
                    *(u32x4*)(rowp + bj * HALF) = w; } }
    }
};

template <class Epi>
__device__ __forceinline__ void gemm_phase(LAS unsigned char* lds, const Gemm g, const Order& S, const Epi& E) {
    const int tid = threadIdx.x, wid = __builtin_amdgcn_readfirstlane(tid >> 6), lane = tid & 63, wr = wid >> 2, wc = wid & 3, fr = lane & 15, fq = lane >> 4;
    const int K = g.K, nt = K / BK, ld = g.ld;
    unsigned voffA[2], voffB[2];
#pragma unroll
    for (int i = 0; i < 2; ++i) { int R, C; stage_rc(tid * 16 + i * 8192, R, C); const int Rb = Epi::PERM ? ((R & ~31) + perm32(R & 31)) : R;
        voffA[i] = (unsigned)(R * ld + C) * 2u; voffB[i] = (unsigned)(Rb * ld + C) * 2u; }
    const size_t kstep = (size_t)(BK * 2);
    const size_t hstep = (size_t)HALF * ld * 2;
    const size_t tstep = 2 * hstep;
    const size_t ksb = (size_t)K * 2;
    const unsigned ldsw = (unsigned)wid * 1024u;
    const int aoff = lds_byte(wr * 64 + fr, fq * 8), boff = lds_byte(wc * 32 + fr, fq * 8);
#define PG8_SA(b, h) (((b) * 2 + (h)) * HTB)
#define PG8_SB(b, h) ((4 + (b) * 2 + (h)) * HTB)
#define PG8_STAGE(bufoff, gbase, voff) do { _Pragma("unroll") for (int _i = 0; _i < 2; ++_i) \
        __builtin_amdgcn_global_load_lds((const unsigned*)((const char*)(gbase) + (voff)[_i]), (LAS unsigned*)(lds + (bufoff) + ldsw + _i * 8192), 16, 0, 0); } while (0)
#define PG8_LDA(dst, b, h) do { _Pragma("unroll") for (int m = 0; m < 4; ++m) _Pragma("unroll") for (int k = 0; k < 2; ++k) dst[m][k] = *(const LAS bf16x8*)(lds + PG8_SA(b, h) + aoff + m * 2048 + k * 1024); } while (0)
#define PG8_LDB(dst, b, h) do { _Pragma("unroll") for (int n = 0; n < 2; ++n) _Pragma("unroll") for (int k = 0; k < 2; ++k) dst[n][k] = *(const LAS bf16x8*)(lds + PG8_SB(b, h) + boff + n * 2048 + k * 1024); } while (0)
#define PG8_MMA(ai, bj, At, Bt) do { __builtin_amdgcn_s_setprio(1); _Pragma("unroll") for (int m = 0; m < 4; ++m) _Pragma("unroll") for (int n = 0; n < 2; ++n) _Pragma("unroll") for (int k = 0; k < 2; ++k) \
        acc[ai][bj][m][n] = __builtin_amdgcn_mfma_f32_16x16x32_bf16(Bt[n][k], At[m][k], acc[ai][bj][m][n], 0, 0, 0); __builtin_amdgcn_s_setprio(0); } while (0)
#define PG8_WAIT_V(n) asm volatile("s_waitcnt vmcnt(" #n ")" ::: "memory")
#define PG8_WAIT_L(n) asm volatile("s_waitcnt lgkmcnt(" #n ")" ::: "memory")
#define PG8_BAR __builtin_amdgcn_s_barrier()
#define PG8_SCHED __builtin_amdgcn_sched_barrier(0)
    Unit cur, nxt; int ui = 0;
    if (!S.next(0, cur)) return;
    f32x4 acc[2][2][4][2];
#pragma unroll
    for (int a = 0; a < 2; ++a)
#pragma unroll
        for (int b = 0; b < 2; ++b)
#pragma unroll
            for (int m = 0; m < 4; ++m)
#pragma unroll
                for (int n = 0; n < 2; ++n) acc[a][b][m][n] = (f32x4){0.f, 0.f, 0.f, 0.f};
    bf16x8 At[4][2], B0[2][2], B1[2][2];
    const char* cA = (const char*)g.A + (size_t)cur.pm * tstep + (size_t)cur.ks * ksb; const char* cB = (const char*)g.Bt + (size_t)cur.pn * tstep + (size_t)cur.ks * ksb;
    PG8_STAGE(PG8_SB(0, 0), cB, voffB); PG8_STAGE(PG8_SA(0, 0), cA, voffA); PG8_STAGE(PG8_SB(0, 1), cB + hstep, voffB); PG8_STAGE(PG8_SA(0, 1), cA + hstep, voffA);
    if (wr == 1) PG8_BAR;
    PG8_WAIT_V(4); PG8_BAR;
    PG8_STAGE(PG8_SB(1, 0), cB + kstep, voffB); PG8_STAGE(PG8_SA(1, 0), cA + kstep, voffA); PG8_STAGE(PG8_SB(1, 1), cB + hstep + kstep, voffB);
    PG8_WAIT_V(6); PG8_BAR;
    for (;;) {
        const bool has_next = S.next(ui + 1, nxt);
        const char* nA = has_next ? (const char*)g.A + (size_t)nxt.pm * tstep + (size_t)nxt.ks * ksb : cA; const char* nB = has_next ? (const char*)g.Bt + (size_t)nxt.pn * tstep + (size_t)nxt.ks * ksb : cB;
        for (int t = 0; t < nt; t += 2) {
            const bool last = (t == nt - 2);
            const char* a1 = cA + (size_t)(t + 1) * kstep;
            const char* a2 = last ? nA : cA + (size_t)(t + 2) * kstep; const char* b2 = last ? nB : cB + (size_t)(t + 2) * kstep;
            const char* a3 = a2 + kstep; const char* b3 = b2 + kstep;
            PG8_LDB(B0, 0, 0); PG8_SCHED; PG8_LDA(At, 0, 0); PG8_STAGE(PG8_SA(1, 1), a1 + hstep, voffA);
            PG8_WAIT_L(8); PG8_BAR; PG8_WAIT_L(0); PG8_MMA(0, 0, At, B0); PG8_BAR; PG8_SCHED;
            PG8_LDB(B1, 0, 1); PG8_STAGE(PG8_SB(0, 0), b2, voffB);
            PG8_BAR; PG8_WAIT_L(0); PG8_MMA(0, 1, At, B1); PG8_BAR;
            PG8_LDA(At, 0, 1); PG8_STAGE(PG8_SA(0, 0), a2, voffA);
            PG8_BAR; PG8_WAIT_L(0); PG8_MMA(1, 0, At, B0); PG8_BAR; PG8_SCHED;
            PG8_STAGE(PG8_SB(0, 1), b2 + hstep, voffB);
            PG8_WAIT_V(6); PG8_BAR; PG8_MMA(1, 1, At, B1); PG8_BAR;
            PG8_LDB(B0, 1, 0); PG8_SCHED; PG8_LDA(At, 1, 0); PG8_STAGE(PG8_SA(0, 1), a2 + hstep, voffA);
            PG8_WAIT_L(8); PG8_BAR; PG8_WAIT_L(0); PG8_MMA(0, 0, At, B0); PG8_BAR; PG8_SCHED;
            PG8_LDB(B1, 1, 1); PG8_STAGE(PG8_SB(1, 0), b3, voffB);
            PG8_BAR; PG8_WAIT_L(0); PG8_MMA(0, 1, At, B1); PG8_BAR;
            PG8_LDA(At, 1, 1); PG8_STAGE(PG8_SA(1, 0), a3, voffA);
            PG8_BAR; PG8_WAIT_L(0); PG8_MMA(1, 0, At, B0); PG8_BAR; PG8_SCHED;
            PG8_STAGE(PG8_SB(1, 1), b3 + hstep, voffB);
            PG8_WAIT_V(6); PG8_BAR; PG8_MMA(1, 1, At, B1); PG8_BAR;
        }
        E(acc, cur, wr, wc, fr, fq);
        if (!has_next) break;
#pragma unroll
        for (int a = 0; a < 2; ++a)
#pragma unroll
            for (int b = 0; b < 2; ++b)
#pragma unroll
                for (int m = 0; m < 4; ++m)
#pragma unroll
                    for (int n = 0; n < 2; ++n) acc[a][b][m][n] = (f32x4){0.f, 0.f, 0.f, 0.f};
        cur = nxt; cA = nA; cB = nB; ++ui;
    }
    PG8_WAIT_V(0);
    if (wr == 0) PG8_BAR;
    PG8_BAR;
#undef PG8_SA
#undef PG8_SB
#undef PG8_STAGE
#undef PG8_LDA
#undef PG8_LDB
#undef PG8_MMA
#undef PG8_WAIT_V
#undef PG8_WAIT_L
#undef PG8_BAR
#undef PG8_SCHED
}
}

struct TJob { const float* src; bf16_t* dst; int ldsrc, N, lddst, drow0, k0, n0; };
__device__ __forceinline__ TJob tjob_of(const Params& p, int t) {
    unsigned char* ws = p.ws;
    bf16_t* BT0 = (bf16_t*)(ws + WS_BT0); bf16_t* WT0O = (bf16_t*)(ws + WS_WT0O); bf16_t* BT1 = (bf16_t*)(ws + WS_BT1); bf16_t* WT1O = (bf16_t*)(ws + WS_WT1O);
    TJob j; int nnt;
    if (t < 1024) { j.src = p.in[10]; j.ldsrc = 8192; j.N = 8192; j.dst = BT0; j.lddst = 1024; j.drow0 = 0; nnt = 64; }
    else if (t < 1024 + 32) { t -= 1024; const int z = t >> 4; t &= 15; j.src = p.in[14] + (size_t)z * 1024 * 64; j.ldsrc = 64; j.N = 64; j.dst = BT0; j.lddst = 1024; j.drow0 = 8192 + z * 64; nnt = 1; }
    else if (t < 1024 + 64) { t -= 1024 + 32; const int z = t >> 4; t &= 15; j.src = p.in[17] + (size_t)z * 1024 * 64; j.ldsrc = 64; j.N = 64; j.dst = BT0; j.lddst = 1024; j.drow0 = 8320 + z * 64; nnt = 1; }
    else if (t < 1088 + 256) { t -= 1088; j.src = p.in[11]; j.ldsrc = 1024; j.N = 1024; j.dst = WT0O; j.lddst = 2048; j.drow0 = 0; nnt = 8; }
    else if (t < 1344 + 384) { t -= 1344; j.src = p.in[24]; j.ldsrc = 3072; j.N = 3072; j.dst = BT1; j.lddst = 1024; j.drow0 = 0; nnt = 24; }
    else if (t < 1728 + 32) { t -= 1728; const int z = t >> 4; t &= 15; j.src = p.in[26] + (size_t)z * 1024 * 16; j.ldsrc = 16; j.N = 16; j.dst = BT1; j.lddst = 1024; j.drow0 = 3072 + z * 16; nnt = 1; }
    else { t -= 1760; j.src = p.in[25]; j.ldsrc = 1024; j.N = 1024; j.dst = WT1O; j.lddst = 1024; j.drow0 = 0; nnt = 8; }
    j.k0 = (t / nnt) * 64; j.n0 = (t % nnt) * 128; return j;
}
__device__ __forceinline__ void tjob_load(const TJob& j, f32x4 (&r)[4]) {
    const int tid = threadIdx.x, c4 = (tid & 31) * 4;
#pragma unroll
    for (int i = 0; i < 4; ++i) { const int kk = (tid >> 5) + 16 * i;
        r[i] = (j.n0 + c4 < j.N) ? *(const f32x4*)(j.src + (size_t)(j.k0 + kk) * j.ldsrc + j.n0 + c4) : (f32x4){0.f, 0.f, 0.f, 0.f}; }
}

__device__ void phase_prologue(const Params& p, float* lds) {
    const int tid = threadIdx.x;
    unsigned char* ws = p.ws;
    bf16_t* BT1 = (bf16_t*)(ws + WS_BT1);
    float* MOD = (float*)(ws + WS_MOD);
    constexpr int NGEMV = 192, NT = 1888;
    for (int it = blockIdx.x; it < NGEMV; it += gridDim.x) {
        const int l = it / 96, j0 = (it % 96) * 32;
        float* sc = lds;
        float* red = lds + 3072;
        for (int i = tid; i < 3072; i += NTHR) { const int cnd = i >> 10, k = i & 1023; const float v = cnd == 0 ? p.in[5][k] : p.in[4][(cnd - 1) * 1024 + k]; sc[i] = silu(v); }
        __syncthreads();
        const int col = tid & 31, ksp = tid >> 5;
        float a0 = 0.f, a1 = 0.f, a2 = 0.f;
        const float* w = p.in[7] + (size_t)l * 1024 * 3072 + j0 + col;
#pragma unroll 16
        for (int k = ksp * 64; k < ksp * 64 + 64; ++k) { const float wv = w[(size_t)k * 3072]; a0 += sc[k] * wv; a1 += sc[1024 + k] * wv; a2 += sc[2048 + k] * wv; }
        red[(ksp * 3 + 0) * 32 + col] = a0; red[(ksp * 3 + 1) * 32 + col] = a1; red[(ksp * 3 + 2) * 32 + col] = a2;
        __syncthreads();
        if (tid < 96) { const int cnd = tid >> 5, cc = tid & 31; float s = 0.f; for (int q = 0; q < 16; ++q) s += red[(q * 3 + cnd) * 32 + cc];
            MOD[(l * 3 + cnd) * 3072 + j0 + cc] = s + p.in[8][l * 3072 + j0 + cc]; }
        __syncthreads();
    }
    { float* tile = lds;
      int it = (int)((blockIdx.x + 64u) % gridDim.x);
      f32x4 cur[4], nxt[4];
      TJob jc = tjob_of(p, it < NT ? it : 0);
      if (it < NT) tjob_load(jc, cur);
      for (; it < NT; it += gridDim.x) {
          const int c4 = (tid & 31) * 4;
#pragma unroll
          for (int i = 0; i < 4; ++i) { const int kk = (tid >> 5) + 16 * i; tile[kk * 129 + c4] = cur[i][0]; tile[kk * 129 + c4 + 1] = cur[i][1]; tile[kk * 129 + c4 + 2] = cur[i][2]; tile[kk * 129 + c4 + 3] = cur[i][3]; }
          const int itn = it + gridDim.x;
          const TJob jn = tjob_of(p, itn < NT ? itn : 0);
          if (itn < NT) tjob_load(jn, nxt);
          __syncthreads();
#pragma unroll
          for (int q = 0; q < 2; ++q) { const int idx = tid + q * NTHR; const int nn = idx >> 3, k8 = (idx & 7) * 8;
              if (jc.n0 + nn < jc.N) { u32x4 o; o.x = pk2(tile[(k8 + 0) * 129 + nn], tile[(k8 + 1) * 129 + nn]); o.y = pk2(tile[(k8 + 2) * 129 + nn], tile[(k8 + 3) * 129 + nn]);
                  o.z = pk2(tile[(k8 + 4) * 129 + nn], tile[(k8 + 5) * 129 + nn]); o.w = pk2(tile[(k8 + 6) * 129 + nn], tile[(k8 + 7) * 129 + nn]);
                  *(u32x4*)(jc.dst + (size_t)(jc.drow0 + jc.n0 + nn) * jc.lddst + jc.k0 + k8) = o; } }
          __syncthreads();
          jc = jn;
#pragma unroll
          for (int i = 0; i < 4; ++i) cur[i] = nxt[i];
      } }
    { u32x4* z = (u32x4*)(BT1 + (size_t)3104 * 1024); const int n = 224 * 1024 * 2 / 16;
      for (int i = blockIdx.x * NTHR + tid; i < n; i += gridDim.x * NTHR) z[i] = (u32x4){0u, 0u, 0u, 0u}; }
}

__device__ void phase_h(const Params& p, int layer) {
    const int tid = threadIdx.x, wave = tid >> 6, lane = tid & 63;
    unsigned char* ws = p.ws;
    const float* MOD = (const float*)(ws + WS_MOD);
    bf16_t* H = (bf16_t*)(ws + WS_H);
    float* X1 = (float*)(ws + WS_X1);
    const float* Y = (const float*)(ws + WS_P);
    for (int tok = blockIdx.x * 8 + wave; tok < NTOK; tok += gridDim.x * 8) {
        const float* xr = tok < NPTOK ? p.in[0] + (size_t)tok * D : p.in[1] + (size_t)(tok - NPTOK) * D;
        const int cond = tok < NPTOK ? 0 : 1 + ((tok - NPTOK) >> 11);
        f32x4 xv[4]; float ss = 0.f;
#pragma unroll
        for (int i = 0; i < 4; ++i) { const int idx = i * 256 + lane * 4; xv[i] = *(const f32x4*)(xr + idx);
            if (layer == 1) { const f32x4 ya = *(const f32x4*)(Y + (size_t)tok * D + idx), yb = *(const f32x4*)(Y + (size_t)NTOK * D + (size_t)tok * D + idx);
                const f32x4 gt = *(const f32x4*)(MOD + (0 * 3 + cond) * 3072 + 2048 + idx);
                xv[i] = xv[i] + gt * (ya + yb); *(f32x4*)(X1 + (size_t)tok * D + idx) = xv[i]; }
            ss += xv[i][0] * xv[i][0] + xv[i][1] * xv[i][1] + xv[i][2] * xv[i][2] + xv[i][3] * xv[i][3]; }
        ss = wave_sum(ss);
        const float rstd = rsqrtf(ss * (1.f / 1024.f) + 1e-6f);
#pragma unroll
        for (int i = 0; i < 4; ++i) { const int idx = i * 256 + lane * 4;
            const f32x4 g = *(const f32x4*)(p.in[6] + layer * D + idx);
            const f32x4 sh = *(const f32x4*)(MOD + (layer * 3 + cond) * 3072 + idx), sc = *(const f32x4*)(MOD + (layer * 3 + cond) * 3072 + 1024 + idx);
            f32x4 h;
#pragma unroll
            for (int j = 0; j < 4; ++j) h[j] = xv[i][j] * rstd * g[j] * (1.f + sc[j]) + sh[j];
            u32x2 w; w.x = pack2(h[0], h[1]); w.y = pack2(h[2], h[3]);
            *(u32x2*)(H + (size_t)tok * D + idx) = w; }
    }
}

__device__ __forceinline__ f32x4 mma_nt(const bf16_t* A, int lda, const bf16_t* B, int ldb, int K, f32x4 acc, int fr, int fq) {
    for (int k0 = 0; k0 < K; k0 += 32) {
        const bf16x8 a = *(const bf16x8*)(A + fr * lda + k0 + fq * 8);
        const bf16x8 b = *(const bf16x8*)(B + fr * ldb + k0 + fq * 8);
        acc = __builtin_amdgcn_mfma_f32_16x16x32_bf16(a, b, acc, 0, 0, 0);
    }
    return acc;
}
__device__ __forceinline__ bf16x8 pack8(float a0, float a1, float a2, float a3, float a4, float a5, float a6, float a7) {
    u32x4 w; w.x = pack2(a0, a1); w.y = pack2(a2, a3); w.z = pack2(a4, a5); w.w = pack2(a6, a7);
    return __builtin_bit_cast(bf16x8, w);
}
__device__ __forceinline__ float dpp_add(float v, float o) { return v + o; }
__device__ __forceinline__ float wave_sum_fast(float v) {
    v += __int_as_float(__builtin_amdgcn_update_dpp(0, __float_as_int(v), 0xB1, 0xF, 0xF, true));
    v += __int_as_float(__builtin_amdgcn_update_dpp(0, __float_as_int(v), 0x4E, 0xF, 0xF, true));
    v += __int_as_float(__builtin_amdgcn_update_dpp(0, __float_as_int(v), 0x141, 0xF, 0xF, true));
    v += __int_as_float(__builtin_amdgcn_update_dpp(0, __float_as_int(v), 0x140, 0xF, 0xF, true));
    v += __shfl_xor(v, 16, 64); v += __shfl_xor(v, 32, 64);
    return v;
}
__device__ __forceinline__ float fast_tanh(float x) { const float e = __expf(2.f * x); return 1.f - 2.f * __builtin_amdgcn_rcpf(1.f + e); }
__device__ __forceinline__ bf16x8 pack8h(float a0, float a1, float a2, float a3, float a4, float a5, float a6, float a7) {
    u32x4 w; w.x = pk2(a0, a1); w.y = pk2(a2, a3); w.z = pk2(a4, a5); w.w = pk2(a6, a7);
    return __builtin_bit_cast(bf16x8, w);
}

__device__ void wkv_unit(const Params& p, int u, float* ldsf) {
    const int tid0 = threadIdx.x, lane0 = tid0 & 63, w = __builtin_amdgcn_readfirstlane(tid0 >> 6), fr0 = lane0 & 15, fq0 = lane0 >> 4;
    unsigned char* ws = p.ws;
    unsigned char* lds = (unsigned char*)ldsf;
    const bf16_t* P = (const bf16_t*)(ws + WS_P);
    bf16_t* OD = (bf16_t*)(ws + WS_X1);
    float* BON = (float*)(ws + WS_BON);
    int z, b, hd, sgm, seqT, tok0; bool sample; const int T = 256;
    if (u < 512) { sample = true; z = u >> 8; b = (u >> 7) & 1; hd = (u >> 3) & 15; sgm = u & 7; seqT = 2048; tok0 = NPTOK + b * 2048; }
    else { const int q = u - 512; sample = false; z = q >> 8; b = (q >> 4) & 15; hd = q & 15; sgm = 0; seqT = 256; tok0 = b * 256; }
    const int qbase = sgm * 256;
    bf16_t* RHO = (bf16_t*)(ws + WS_H);
    float* GH = (float*)(ws + WS_BT0);
    bf16_t* TLW = (bf16_t*)(lds + 0);
    bf16_t* TLA = (bf16_t*)(lds + 9216);
    float* HT = (float*)(lds + 18432);
    bf16_t* KTr = (bf16_t*)(lds + 20480);
    bf16_t* BTr = (bf16_t*)(lds + 29696);
    bf16_t* KKH = (bf16_t*)(lds + 38912);
    bf16_t* RH = (bf16_t*)(lds + 48128);
    const bf16_t* VS = (const bf16_t*)(lds + 113664 + 2 * 8192);
    bf16_t* TA = (bf16_t*)(lds + 65536);
    bf16_t* NA = (bf16_t*)(lds + 70656);
    float* PC = (float*)(lds + 75776);
    bf16_t* KBm = (bf16_t*)(lds + 76800);
    float* MM = (float*)(lds + 97280);
    float* WA = (float*)(lds + 76800);
    bf16x8 bw[2];
    { const float* W2 = (w >> 2) ? p.in[18] : p.in[15];
#pragma unroll
      for (int ks = 0; ks < 2; ++ks) { float t8[8];
#pragma unroll
        for (int e = 0; e < 8; ++e) t8[e] = W2[(size_t)(z * 64 + ks * 32 + fq0 * 8 + e) * 1024 + hd * 64 + (w & 3) * 16 + fr0];
        bw[ks] = pack8h(t8[0], t8[1], t8[2], t8[3], t8[4], t8[5], t8[6], t8[7]); } }
    f32x4 Sacc[4];
#pragma unroll
    for (int kt = 0; kt < 4; ++kt) Sacc[kt] = (f32x4){0.f, 0.f, 0.f, 0.f};
    if (w >= 4) {
#pragma unroll
        for (int kt = 0; kt < 4; ++kt)
#pragma unroll
            for (int jj = 0; jj < 4; ++jj) Sacc[kt][jj] = (kt * 16 + fq0 * 4 + jj == (w - 4) * 16 + fr0) ? 1.f : 0.f; }
    const int ch = hd * 64 + lane0;
    const float w0c = p.in[13][z * 1024 + ch], a0c = p.in[16][z * 1024 + ch], kkc = p.in[19][ch], kac = p.in[20][ch], rkc = p.in[21][ch];
    bf16_t* RKV = (bf16_t*)(lds + 113664);
    u32x4 tlraw[2], rkvraw[3];
#define WKV_LOAD_RAW(tb_) do { \
        _Pragma("unroll") for (int h_ = 0; h_ < 2; ++h_) { const int idx_ = tid + h_ * NTHR; const int tau_ = idx_ >> 4, sg_ = idx_ & 15; const int t_ = z ? (seqT - 1 - (qbase + (tb_) + tau_)) : (qbase + (tb_) + tau_); \
            tlraw[h_] = *(const u32x4*)(P + (size_t)(tok0 + t_) * N0 + 8192 + (sg_ < 8 ? z * 64 + sg_ * 8 : 128 + z * 64 + (sg_ - 8) * 8)); } \
        { const int tau_ = tid >> 3, sg_ = tid & 7; const int t_ = z ? (seqT - 1 - (qbase + (tb_) + tau_)) : (qbase + (tb_) + tau_); const bf16_t* rp_ = P + (size_t)(tok0 + t_) * N0 + 4096 + hd * 64 + sg_ * 8; \
          rkvraw[0] = *(const u32x4*)rp_; rkvraw[1] = *(const u32x4*)(rp_ + 1024); rkvraw[2] = *(const u32x4*)(rp_ + 2048); } } while (0)
    { const int tid = tid0; WKV_LOAD_RAW(0); }
    __syncthreads();
#pragma unroll 1
    for (int tb = 0; tb < T; tb += 64) {
        int tid = tid0; asm volatile("" : "+v"(tid));
        const int lane = tid & 63, fr = lane & 15, fq = lane >> 4, c = lane;
        const int pcol = ((c >> 5) * 32) + (((c >> 2) & 3) * 8) + (((c >> 4) & 1) * 4) + (c & 3);
#pragma unroll
        for (int h = 0; h < 2; ++h) { const int idx = tid + h * NTHR; const int tau = idx >> 4, sg = idx & 15;
            u32x4 o = tlraw[h];
            if (sg < 8) { o.x = pk2(fast_tanh(bflo(o.x)), fast_tanh(bfhi(o.x))); o.y = pk2(fast_tanh(bflo(o.y)), fast_tanh(bfhi(o.y)));
                          o.z = pk2(fast_tanh(bflo(o.z)), fast_tanh(bfhi(o.z))); o.w = pk2(fast_tanh(bflo(o.w)), fast_tanh(bfhi(o.w))); }
            *(u32x4*)((sg < 8 ? TLW : TLA) + tau * 72 + (sg & 7) * 8) = o; }
#pragma unroll
        for (int h = 0; h < 3; ++h) *(u32x4*)(RKV + h * 4096 + (tid >> 3) * 64 + (tid & 7) * 8) = rkvraw[h];
        lds_barrier();
        if (tb + 64 < T) WKV_LOAD_RAW(tb + 64);
        { const bf16_t* TL = (w >> 2) ? TLA : TLW; float* WAo = WA + (w >> 2) * 64 * 68;
#pragma unroll
          for (int mt = 0; mt < 4; ++mt) { f32x4 acc = (f32x4){0.f, 0.f, 0.f, 0.f};
#pragma unroll
            for (int ks = 0; ks < 2; ++ks) { const bf16x8 a = *(const bf16x8*)(TL + (mt * 16 + fr) * 72 + ks * 32 + fq * 8);
                acc = __builtin_amdgcn_mfma_f32_16x16x32_bf16(a, bw[ks], acc, 0, 0, 0); }
#pragma unroll
            for (int jj = 0; jj < 4; ++jj) WAo[(mt * 16 + fq * 4 + jj) * 68 + (w & 3) * 16 + fr] = acc[jj]; } }
        lds_barrier();
        float kkv[8], kmv[8], bv[8], lwv[8], cum[8], rr[8];
        { float run = 0.f;
#pragma unroll
          for (int i = 0; i < 8; ++i) { const int tau = w * 8 + i; const int t = z ? (seqT - 1 - (qbase + tb + tau)) : (qbase + tb + tau); const int tokg = tok0 + t;
            const float wr_ = w0c + WA[tau * 68 + c], ap = a0c + WA[64 * 68 + tau * 68 + c];
            const float nx = -wr_; const float sp = fmaxf(nx, 0.f) + __logf(1.f + __expf(-fabsf(nx)));
            const float lw = -__expf(-sp - 0.5f);
            const float iclr = __builtin_amdgcn_rcpf(1.f + __expf(-ap));
            const float kxi = bf2f(RKV[4096 + tau * 64 + c]); rr[i] = bf2f(RKV[tau * 64 + c]);
            const float kkraw = kxi * kkc;
            const float ssq = wave_sum_fast(kkraw * kkraw);
            const float kk = kkraw * __builtin_amdgcn_rsqf(fmaxf(ssq, 1e-24f));
            const float kmod = kxi * (1.f + (iclr - 1.f) * kac);
            const float bon = wave_sum_fast(rr[i] * kmod * rkc);
            if (lane == 0) BON[((size_t)z * NTOK + tokg) * 16 + hd] = bon;
            run += lw;
            kkv[i] = kk; kmv[i] = kmod; bv[i] = kk * iclr; lwv[i] = lw; cum[i] = run; }
          HT[w * 64 + c] = run; }
        lds_barrier();
        { const float off = (w & 1) ? HT[(w - 1) * 64 + c] : 0.f; const int cn = w >> 1;
#pragma unroll
          for (int i = 0; i < 8; ++i) { const int tau = w * 8 + i; const int j = (w & 1) * 8 + i;
            const float cm = cum[i] + off;
            const float Pj = __expf(cm), ipj = __expf(-cm), pm1 = __expf(cm - lwv[i]);
            const unsigned kb2 = pk2(-bv[i] * ipj, kmv[i] * ipj);
            KTr[tau * 72 + pcol] = (bf16_t)(kb2 >> 16); BTr[tau * 72 + pcol] = f2bf_hw(bv[i] * ipj);
            const unsigned kr2 = pk2(kkv[i] * pm1, rr[i] * Pj);
            KKH[tau * 72 + pcol] = (bf16_t)(kr2 & 0xFFFFu); RH[tau * 72 + pcol] = (bf16_t)(kr2 >> 16);
            const int sU = (j >> 2) * 8 + (j & 3);
            KBm[(cn * 64 + c) * 40 + sU] = (bf16_t)(kb2 & 0xFFFFu); KBm[(cn * 64 + c) * 40 + sU + 4] = (bf16_t)(kb2 >> 16);
            if (j == 15) PC[cn * 64 + c] = Pj; } }
        lds_barrier();
#pragma unroll
        for (int q2 = 0; q2 < 2; ++q2) { const int id = w * 2 + q2; const int cn = id >> 2, which = id & 3;
          const bf16_t* Am = ((which & 1) ? KTr : BTr) + cn * 16 * 72; const bf16_t* Bm = ((which & 2) ? RH : KKH) + cn * 16 * 72;
          const f32x4 acc = mma_nt(Am, 72, Bm, 72, 64, (f32x4){0.f, 0.f, 0.f, 0.f}, fr, fq);
          f32x4 o;
#pragma unroll
          for (int jj = 0; jj < 4; ++jj) { const int i = fq * 4 + jj, j = fr; const bool keep = (which & 2) ? (i <= j) : (i < j); o[jj] = keep ? acc[jj] : 0.f; }
          *(f32x4*)(MM + (cn * 4 + which) * 256 + fr * 16 + fq * 4) = o; }
        lds_barrier();
        if (w == 0) { const int cn = lane >> 4, col = lane & 15;
            const float* MbT = MM + (cn * 4 + 0) * 256; const float* MkT = MM + (cn * 4 + 1) * 256;
            float Tc[16], A1[16];
#pragma unroll
            for (int i = 0; i < 16; ++i) { Tc[i] = (i == col) ? 1.f : 0.f; A1[i] = 0.f; }
#pragma unroll
            for (int l = 15; l >= 1; --l) {
                const float tl_ = Tc[l];
#pragma unroll
                for (int v4 = 0; v4 < 4; ++v4) if (v4 * 4 < l) { const f32x4 mb = *(const f32x4*)(MbT + l * 16 + v4 * 4), mk = *(const f32x4*)(MkT + l * 16 + v4 * 4);
#pragma unroll
                    for (int e = 0; e < 4; ++e) if (v4 * 4 + e < l) { Tc[v4 * 4 + e] -= mb[e] * tl_; A1[v4 * 4 + e] += mk[e] * tl_; } }
                asm volatile("" ::: "memory");
            }
            bf16_t* tao = TA + (cn * 16 + col) * 40;
#pragma unroll
            for (int g4 = 0; g4 < 4; ++g4) { u32x4 o; o.x = pk2(Tc[g4 * 4], Tc[g4 * 4 + 1]); o.y = pk2(Tc[g4 * 4 + 2], Tc[g4 * 4 + 3]); o.z = pk2(A1[g4 * 4], A1[g4 * 4 + 1]); o.w = pk2(A1[g4 * 4 + 2], A1[g4 * 4 + 3]);
                *(u32x4*)(tao + g4 * 8) = o; } }
        else if (w <= 4) { const int cn = w - 1, j = lane & 15, ig = lane >> 4;
            const f32x4 nb = *(const f32x4*)(MM + (cn * 4 + 2) * 256 + j * 16 + ig * 4), nk = *(const f32x4*)(MM + (cn * 4 + 3) * 256 + j * 16 + ig * 4);
            u32x4 o; o.x = pk2(-nb[0], -nb[1]); o.y = pk2(-nb[2], -nb[3]); o.z = pk2(nk[0], nk[1]); o.w = pk2(nk[2], nk[3]);
            *(u32x4*)(NA + (cn * 16 + j) * 40 + ig * 8) = o; }
        lds_barrier();
        if (w < 4 || sample) {
            const int vb = w & 3;
#pragma unroll 1
            for (int cn = 0; cn < 4; ++cn) {
                bf16x8 sb[2];
#pragma unroll
                for (int ks = 0; ks < 2; ++ks) sb[ks] = pack8h(Sacc[2 * ks][0], Sacc[2 * ks][1], Sacc[2 * ks][2], Sacc[2 * ks][3], Sacc[2 * ks + 1][0], Sacc[2 * ks + 1][1], Sacc[2 * ks + 1][2], Sacc[2 * ks + 1][3]);
                f32x4 U0 = (f32x4){0.f, 0.f, 0.f, 0.f}, O = (f32x4){0.f, 0.f, 0.f, 0.f};
#pragma unroll
                for (int ks = 0; ks < 2; ++ks) { const bf16x8 a = *(const bf16x8*)(KKH + (cn * 16 + fr) * 72 + ks * 32 + fq * 8);
                    U0 = __builtin_amdgcn_mfma_f32_16x16x32_bf16(a, sb[ks], U0, 0, 0, 0);
                    const bf16x8 ar = *(const bf16x8*)(RH + (cn * 16 + fr) * 72 + ks * 32 + fq * 8);
                    O = __builtin_amdgcn_mfma_f32_16x16x32_bf16(ar, sb[ks], O, 0, 0, 0); }
                float vf[4];
#pragma unroll
                for (int e = 0; e < 4; ++e) vf[e] = (w < 4) ? bf2f(VS[(cn * 16 + fq * 4 + e) * 64 + vb * 16 + fr]) : 0.f;
                const bf16x8 bU0 = pack8h(U0[0], U0[1], U0[2], U0[3], vf[0], vf[1], vf[2], vf[3]);
                const bf16x8 ta = *(const bf16x8*)(TA + (cn * 16 + fr) * 40 + fq * 8);
                const f32x4 U = __builtin_amdgcn_mfma_f32_16x16x32_bf16(ta, bU0, (f32x4){0.f, 0.f, 0.f, 0.f}, 0, 0, 0);
                const bf16x8 bUV = pack8h(U[0], U[1], U[2], U[3], vf[0], vf[1], vf[2], vf[3]);
                const bf16x8 na = *(const bf16x8*)(NA + (cn * 16 + fr) * 40 + fq * 8);
                O = __builtin_amdgcn_mfma_f32_16x16x32_bf16(na, bUV, O, 0, 0, 0);
#pragma unroll
                for (int jj = 0; jj < 4; ++jj) { const int tau = cn * 16 + fq * 4 + jj; const int t = z ? (seqT - 1 - (qbase + tb + tau)) : (qbase + tb + tau);
                    if (w < 4) OD[((size_t)z * NTOK + tok0 + t) * 1024 + hd * 64 + vb * 16 + fr] = f2bf_hw(O[jj]);
                    else RHO[((size_t)z * 4096 + (tok0 - NPTOK) + t) * 1024 + hd * 64 + vb * 16 + fr] = f2bf_hw(O[jj]); }
#pragma unroll
                for (int kt = 0; kt < 4; ++kt) { const bf16x8 kb = *(const bf16x8*)(KBm + (cn * 64 + kt * 16 + fr) * 40 + fq * 8);
                    Sacc[kt] = __builtin_amdgcn_mfma_f32_16x16x32_bf16(kb, bUV, Sacc[kt], 0, 0, 0);
                    const f32x4 pc = *(const f32x4*)(PC + cn * 64 + kt * 16 + fq * 4);
                    Sacc[kt] = Sacc[kt] * pc; }
            }
        }
        lds_barrier();
    }
#undef WKV_LOAD_RAW
    if (!sample) { if (w < 4) { float* so = p.out + (size_t)2 * NPTOK * D + ((size_t)((b * 2 + z) * 16 + hd)) * 4096 + (size_t)(w * 16 + fr0) * 64;
#pragma unroll
        for (int kt = 0; kt < 4; ++kt)
#pragma unroll
            for (int jj = 0; jj < 4; ++jj) so[kt * 16 + fq0 * 4 + jj] = Sacc[kt][jj]; } }
    else { float* so = GH + ((size_t)u * 2 + (w >> 2)) * 4096 + (size_t)((w & 3) * 16 + fr0) * 64;
#pragma unroll
        for (int kt = 0; kt < 4; ++kt)
#pragma unroll
            for (int jj = 0; jj < 4; ++jj) so[kt * 16 + fq0 * 4 + jj] = Sacc[kt][jj]; }
    __syncthreads();
}

__device__ void wkv_fix_unit(const Params& p, int u, float* ldsf) {
    const int tid = threadIdx.x, lane = tid & 63, w = __builtin_amdgcn_readfirstlane(tid >> 6), fr = lane & 15, fq = lane >> 4;
    unsigned char* ws = p.ws;
    bf16_t* OD = (bf16_t*)(ws + WS_X1);
    const bf16_t* RHO = (const bf16_t*)(ws + WS_H);
    const float* GH = (const float*)(ws + WS_BT0);
    const int z = u >> 7, b = (u >> 6) & 1, hd = (u >> 2) & 15, vq = u & 3;
    float* SS = ldsf;
    float* GL = ldsf + 1024;
    bf16_t* SB = (bf16_t*)(ldsf + 1024 + 4096);
    const int v = tid >> 5, kp = (tid & 31) * 2;
    { const float* s0 = p.in[2] + ((size_t)((b * 2 + z) * 16 + hd)) * 4096 + (size_t)(vq * 16 + v) * 64 + kp; SS[v * 64 + kp] = s0[0]; SS[v * 64 + kp + 1] = s0[1]; }
    __syncthreads();
#pragma unroll 1
    for (int sg = 0; sg < 8; ++sg) {
        const int su = ((z * 2 + b) * 16 + hd) * 8 + sg;
        SB[v * 72 + kp] = f2bf_hw(SS[v * 64 + kp]); SB[v * 72 + kp + 1] = f2bf_hw(SS[v * 64 + kp + 1]);
        if (sg < 7) { const f32x4* gsrc = (const f32x4*)(GH + ((size_t)su * 2 + 1) * 4096);
#pragma unroll
            for (int q = 0; q < 2; ++q) ((f32x4*)GL)[tid + q * NTHR] = gsrc[tid + q * NTHR]; }
        __syncthreads();
        const int tlo = z ? (2048 - (sg + 1) * 256) : sg * 256;
#pragma unroll
        for (int q = 0; q < 2; ++q) { const int mt = 2 * w + q;
            f32x4 acc = (f32x4){0.f, 0.f, 0.f, 0.f};
#pragma unroll
            for (int ks = 0; ks < 2; ++ks) { const bf16x8 a = *(const bf16x8*)(RHO + ((size_t)z * 4096 + b * 2048 + tlo + mt * 16 + fr) * 1024 + hd * 64 + ks * 32 + fq * 8);
                const bf16x8 bb = *(const bf16x8*)(SB + fr * 72 + ks * 32 + fq * 8);
                acc = __builtin_amdgcn_mfma_f32_16x16x32_bf16(a, bb, acc, 0, 0, 0); }
#pragma unroll
            for (int jj = 0; jj < 4; ++jj) { bf16_t* op = OD + ((size_t)z * NTOK + NPTOK + b * 2048 + tlo + mt * 16 + fq * 4 + jj) * 1024 + hd * 64 + vq * 16 + fr;
                *op = f2bf_hw(bf2f(*op) + acc[jj]); } }
        if (sg < 7) {
            const float* hsrc = GH + ((size_t)su * 2 + 0) * 4096 + (size_t)(vq * 16 + v) * 64 + kp;
            float a0 = hsrc[0], a1 = hsrc[1];
#pragma unroll 8
            for (int k2 = 0; k2 < 64; ++k2) { const float sv = SS[v * 64 + k2]; a0 += sv * GL[k2 * 64 + kp]; a1 += sv * GL[k2 * 64 + kp + 1]; }
            __syncthreads();
            SS[v * 64 + kp] = a0; SS[v * 64 + kp + 1] = a1;
        }
        __syncthreads();
    }
}
__device__ void phase_wkv_fix(const Params& p, float* lds) {
    for (int it = blockIdx.x; it < 256; it += gridDim.x) wkv_fix_unit(p, it, lds);
}

__device__ void conv_tile(const Params& p, int tile) {
    const int tid = threadIdx.x;
    unsigned char* ws = p.ws;
    const bf16_t* P = (const bf16_t*)(ws + WS_P);
    bf16_t* OC = (bf16_t*)(ws + WS_OC);
    const int cgp = tid & 127, c0 = cgp * 8, sub = tid >> 7;
    float cw0[8], cw1[8], cw2[8];
#pragma unroll
    for (int j = 0; j < 8; ++j) { cw0[j] = p.in[12][c0 + j]; cw1[j] = p.in[12][1024 + c0 + j]; cw2[j] = p.in[12][2048 + c0 + j]; }
    for (int jj = 0; jj < 4; ++jj) {
        const int t = tile * 16 + sub + 4 * jj;
        const int rl = t < NPTOK ? 256 : 64; const int pos = t & (rl - 1);
        const bf16_t* row = P + (size_t)t * N0;
        const u32x4 z4 = (u32x4){0u, 0u, 0u, 0u};
        const u32x4 u1 = *(const u32x4*)(row + c0), g1 = *(const u32x4*)(row + 2048 + c0);
        const u32x4 u0 = pos > 0 ? *(const u32x4*)(row - N0 + c0) : z4, g0 = pos > 0 ? *(const u32x4*)(row - N0 + 2048 + c0) : z4;
        const u32x4 u2 = pos < rl - 1 ? *(const u32x4*)(row + N0 + c0) : z4, g2 = pos < rl - 1 ? *(const u32x4*)(row + N0 + 2048 + c0) : z4;
        const u32x4 gb = *(const u32x4*)(row + 1024 + c0), zc = *(const u32x4*)(row + 3072 + c0);
        u32x4 o;
#pragma unroll
        for (int q = 0; q < 4; ++q) {
            const float y0 = cw0[2 * q] * (bflo(g0[q]) * bflo(u0[q])) + cw1[2 * q] * (bflo(g1[q]) * bflo(u1[q])) + cw2[2 * q] * (bflo(g2[q]) * bflo(u2[q]));
            const float y1 = cw0[2 * q + 1] * (bfhi(g0[q]) * bfhi(u0[q])) + cw1[2 * q + 1] * (bfhi(g1[q]) * bfhi(u1[q])) + cw2[2 * q + 1] * (bfhi(g2[q]) * bfhi(u2[q]));
            o[q] = pack2(silu(bflo(zc[q])) * bflo(gb[q]) * y0, silu(bfhi(zc[q])) * bfhi(gb[q]) * y1);
        }
        *(u32x4*)(OC + (size_t)t * 2048 + c0) = o;
    }
}

__device__ void phase_mix0(const Params& p, float* lds, int rep) {
    unsigned* ctr = (unsigned*)(p.ws + WS_CTL) + rep * 32;
    int* slot = (int*)(lds + LDS_MAIN / 4);
    constexpr int NSCAN = 1024, NCONV = 512;
    for (;;) {
        if (threadIdx.x == 0) *slot = (int)atomicAdd(ctr, 1u);
        __syncthreads();
        const int it = *slot;
        __syncthreads();
        if (it >= NSCAN + NCONV) break;
        if (it < NSCAN) wkv_unit(p, it, lds); else conv_tile(p, it - NSCAN);
    }
}

__device__ __forceinline__ float quad_sum(float v) {
    v += __int_as_float(__builtin_amdgcn_update_dpp(0, __float_as_int(v), 0xB1, 0xF, 0xF, true));
    v += __int_as_float(__builtin_amdgcn_update_dpp(0, __float_as_int(v), 0x4E, 0xF, 0xF, true));
    return v;
}
__device__ void phase_wkv_post(const Params& p) {
    const int tid = threadIdx.x, wave = tid >> 6, lane = tid & 63;
    unsigned char* ws = p.ws;
    const bf16_t* P = (const bf16_t*)(ws + WS_P);
    const bf16_t* OD = (const bf16_t*)(ws + WS_X1);
    const float* BON = (const float*)(ws + WS_BON);
    bf16_t* OC = (bf16_t*)(ws + WS_OC);
    const int hh = lane >> 2, ch0 = hh * 64 + (lane & 3) * 16;
    for (int tok = blockIdx.x * 8 + wave; tok < NTOK; tok += gridDim.x * 8) {
        const bf16_t* row = P + (size_t)tok * N0;
        u32x4 a0[2], a1[2], vv[2], zz[2];
#pragma unroll
        for (int h = 0; h < 2; ++h) { a0[h] = *(const u32x4*)(OD + (size_t)tok * 1024 + ch0 + h * 8); a1[h] = *(const u32x4*)(OD + ((size_t)NTOK + tok) * 1024 + ch0 + h * 8);
            vv[h] = *(const u32x4*)(row + 6144 + ch0 + h * 8); zz[h] = *(const u32x4*)(row + 7168 + ch0 + h * 8); }
        const float bon = BON[(size_t)tok * 16 + hh] + BON[((size_t)NTOK + tok) * 16 + hh];
        float o[16]; float s1 = 0.f;
#pragma unroll
        for (int h = 0; h < 2; ++h)
#pragma unroll
            for (int q = 0; q < 4; ++q) { o[h * 8 + 2 * q] = bflo(a0[h][q]) + bflo(a1[h][q]); o[h * 8 + 2 * q + 1] = bfhi(a0[h][q]) + bfhi(a1[h][q]); s1 += o[h * 8 + 2 * q] + o[h * 8 + 2 * q + 1]; }
        const float mu = quad_sum(s1) * (1.f / 64.f);
        float s2 = 0.f;
#pragma unroll
        for (int i = 0; i < 16; ++i) { o[i] -= mu; s2 += o[i] * o[i]; }
        const float rs = rsqrtf(quad_sum(s2) * (1.f / 64.f) + 64e-5f);
        float res[16];
#pragma unroll
        for (int g4 = 0; g4 < 4; ++g4) { const f32x4 lw4 = *(const f32x4*)(p.in[22] + ch0 + g4 * 4), lb4 = *(const f32x4*)(p.in[23] + ch0 + g4 * 4);
#pragma unroll
            for (int e = 0; e < 4; ++e) { const int i = g4 * 4 + e; const unsigned vw = vv[i >> 3][(i & 7) >> 1], zw_ = zz[i >> 3][(i & 7) >> 1];
                const float v1 = (i & 1) ? bfhi(vw) : bflo(vw), z1 = (i & 1) ? bfhi(zw_) : bflo(zw_);
                res[i] = (o[i] * rs * lw4[e] + lb4[e] + bon * v1) * silu(z1); } }
#pragma unroll
        for (int h = 0; h < 2; ++h) { u32x4 w4; w4.x = pk2(res[h * 8 + 0], res[h * 8 + 1]); w4.y = pk2(res[h * 8 + 2], res[h * 8 + 3]); w4.z = pk2(res[h * 8 + 4], res[h * 8 + 5]); w4.w = pk2(res[h * 8 + 6], res[h * 8 + 7]);
            *(u32x4*)(OC + (size_t)tok * 2048 + 1024 + ch0 + h * 8) = w4; }
    }
}

constexpr size_t WS_QE = WS_H;
constexpr size_t WS_KDT = WS_BT0;
constexpr size_t WS_VT = WS_OC + (size_t)NTOK * 1024 * 2;
constexpr size_t WS_EBL = WS_BON + (size_t)2 * NTOK * 16 * 4;
constexpr size_t WS_ATT = WS_P + 52 * MB;

__device__ void gla_a_item(const Params& p, int item, float* ldsf) {
    const int tid = threadIdx.x, lane = tid & 63, w = __builtin_amdgcn_readfirstlane(tid >> 6), fr = lane & 15, fq = lane >> 4;
    unsigned char* ws = p.ws;
    const bf16_t* P1 = (const bf16_t*)(ws + WS_P);
    float* OD = (float*)(ws + WS_P2);
    bf16_t* QEg = (bf16_t*)(ws + WS_QE); bf16_t* KDTg = (bf16_t*)(ws + WS_KDT); bf16_t* VTg = (bf16_t*)(ws + WS_VT); float* EBLg = (float*)(ws + WS_EBL);
    const int hd = item & 3, c = (item >> 2) & 127, z = item >> 9, tok0 = c * 64;
    bf16_t* QE = (bf16_t*)ldsf;
    bf16_t* KE = QE + 64 * 136;
    bf16_t* VT = KE + 64 * 136;
    bf16_t* ATT = VT + 256 * 72;
    float* G = (float*)(ATT + 64 * 72);
    float* L1G = G + 64 * 132;
    float* GK2 = L1G + 1024;
    for (int i = tid; i < 1024; i += NTHR) { const int t = i >> 4, r = i & 15; L1G[i] = bf2f(P1[(size_t)(tok0 + t) * N1 + 3072 + z * 16 + r]); }
    for (int i = tid; i < 2048; i += NTHR) { const int r = i >> 7, d = i & 127; GK2[i] = p.in[27][(size_t)(z * 16 + r) * 512 + hd * 128 + d]; }
#pragma unroll
    for (int ps = 0; ps < 4; ++ps) { const int t = lane, e8 = (ps * 8 + w) * 8;
        const u32x4 v8 = *(const u32x4*)(P1 + (size_t)(tok0 + t) * N1 + 1024 + hd * 256 + e8);
        VT[(e8 + 0) * 72 + t] = (bf16_t)(v8.x & 0xFFFF); VT[(e8 + 1) * 72 + t] = (bf16_t)(v8.x >> 16); VT[(e8 + 2) * 72 + t] = (bf16_t)(v8.y & 0xFFFF); VT[(e8 + 3) * 72 + t] = (bf16_t)(v8.y >> 16);
        VT[(e8 + 4) * 72 + t] = (bf16_t)(v8.z & 0xFFFF); VT[(e8 + 5) * 72 + t] = (bf16_t)(v8.z >> 16); VT[(e8 + 6) * 72 + t] = (bf16_t)(v8.w & 0xFFFF); VT[(e8 + 7) * 72 + t] = (bf16_t)(v8.w >> 16); }
    const int d = tid & 127, tq = tid >> 7;
    const float gbias = p.in[28][z * 512 + hd * 128 + d];
    bf16_t qraw[16], kraw[16];
#pragma unroll
    for (int i = 0; i < 16; ++i) { const size_t row = (size_t)(tok0 + tq * 16 + i) * N1; qraw[i] = P1[row + hd * 128 + d]; kraw[i] = P1[row + 512 + hd * 128 + d]; }
    __syncthreads();
    { float run = 0.f;
#pragma unroll 4
      for (int i = 0; i < 16; ++i) { const int t = z ? (tq * 16 + 15 - i) : (tq * 16 + i);
        float x = gbias;
#pragma unroll
        for (int r = 0; r < 16; ++r) x += L1G[t * 16 + r] * GK2[r * 128 + d];
        const float ls = fminf(x, 0.f) - __logf(1.f + __expf(-fabsf(x)));
        run += ls * (1.f / 16.f);
        G[t * 132 + d] = run; } }
    __syncthreads();
    { const int lastr = z ? 0 : 15;
      const float t0 = G[(0 + lastr) * 132 + d], t1 = G[(16 + lastr) * 132 + d], t2 = G[(32 + lastr) * 132 + d], t3 = G[(48 + lastr) * 132 + d];
      const float blast = t0 + t1 + t2 + t3;
      float off;
      if (z == 0) off = tq == 0 ? 0.f : (tq == 1 ? t0 : (tq == 2 ? t0 + t1 : t0 + t1 + t2));
      else off = tq == 3 ? 0.f : (tq == 2 ? t3 : (tq == 1 ? t3 + t2 : t3 + t2 + t1));
      if (tq == 0) EBLg[(size_t)(z * 128 + c) * 512 + hd * 128 + d] = __expf(blast);
      unsigned kdp[8];
#pragma unroll
      for (int i = 0; i < 16; ++i) { const int t = tq * 16 + i;
        const float bc = G[t * 132 + d] + off;
        const float q = bf2f(qraw[i]) * 0.08838834764831845f, k = bf2f(kraw[i]);
        const bf16_t qe = f2bf(q * __expf(bc));
        QE[t * 136 + d] = qe; KE[t * 136 + d] = f2bf(k * __expf(-bc));
        const unsigned kd = (unsigned)f2bf(k * __expf(blast - bc));
        if (i & 1) kdp[i >> 1] |= kd << 16; else kdp[i >> 1] = kd; }
      bf16_t* kdst = KDTg + ((size_t)(((z * 128 + c) * 4 + hd) * 128 + d)) * 64 + tq * 16;
      *(u32x4*)kdst = (u32x4){kdp[0], kdp[1], kdp[2], kdp[3]}; *(u32x4*)(kdst + 8) = (u32x4){kdp[4], kdp[5], kdp[6], kdp[7]}; }
    __syncthreads();
#pragma unroll
    for (int q2 = 0; q2 < 2; ++q2) { const int idx = q2 * NTHR + tid; const int t = idx >> 4, d8 = (idx & 15) * 8;
        *(u32x4*)(QEg + ((size_t)z * NTOK + tok0 + t) * 512 + hd * 128 + d8) = *(const u32x4*)(QE + t * 136 + d8); }
    if (z == 0) {
#pragma unroll
        for (int q4 = 0; q4 < 4; ++q4) { const int idx = q4 * NTHR + tid; const int e = idx >> 3, t8 = (idx & 7) * 8;
            *(u32x4*)(VTg + ((size_t)((c * 4 + hd) * 256 + e)) * 64 + t8) = *(const u32x4*)(VT + e * 72 + t8); } }
#pragma unroll
    for (int q2 = 0; q2 < 2; ++q2) { const int tA = 2 * w + q2, ia = tA >> 2, ja = tA & 3;
        f32x4 a4 = (f32x4){0.f, 0.f, 0.f, 0.f};
        if (z ? (ja >= ia) : (ja <= ia)) a4 = mma_nt(QE + ia * 16 * 136, 136, KE + ja * 16 * 136, 136, 128, a4, fr, fq);
#pragma unroll
        for (int jj = 0; jj < 4; ++jj) { const int i = ia * 16 + fq * 4 + jj, j = ja * 16 + fr; const bool keep = z ? (j >= i) : (j <= i); ATT[i * 72 + j] = f2bf(keep ? a4[jj] : 0.f); } }
    __syncthreads();
    { bf16_t* ATTg = (bf16_t*)(ws + WS_ATT) + ((size_t)((z * 128 + c) * 4 + hd)) * 4096;
      const int i = tid >> 3, j8 = (tid & 7) * 8;
      *(u32x4*)(ATTg + i * 64 + j8) = *(const u32x4*)(ATT + i * 72 + j8); }
    __syncthreads();
}

__device__ void phase_gla_a(const Params& p, float* lds) {
    for (int it = blockIdx.x; it < 1024; it += gridDim.x) gla_a_item(p, it, lds);
}

struct GlaFrags { bf16x8 kdt[2]; u32x4 vts; u32x4 qes[2]; bf16x8 att[2]; f32x4 ebl; };

__device__ void gla_b_unit(const Params& p, int u, float* ldsf) {
    const int tid = threadIdx.x, lane = tid & 63, w = __builtin_amdgcn_readfirstlane(tid >> 6), fr = lane & 15, fq = lane >> 4;
    unsigned char* ws = p.ws;
    float* OD = (float*)(ws + WS_P2);
    const bf16_t* QEg = (const bf16_t*)(ws + WS_QE); const bf16_t* KDTg = (const bf16_t*)(ws + WS_KDT); const bf16_t* VTg = (const bf16_t*)(ws + WS_VT); const float* EBLg = (const float*)(ws + WS_EBL);
    const bf16_t* ATTg = (const bf16_t*)(ws + WS_ATT);
    int z, b, hd, eq, nch, ch0; bool sample;
    if (u < 64) { sample = true; z = u >> 5; b = (u >> 4) & 1; hd = (u >> 2) & 3; eq = u & 3; nch = 32; ch0 = 64 + b * 32; }
    else { const int q = u - 64; sample = false; z = q >> 8; b = (q >> 4) & 15; hd = (q >> 2) & 3; eq = q & 3; nch = 4; ch0 = b * 4; }
    bf16_t* ST = (bf16_t*)ldsf;
    bf16_t* VTL = ST + 2 * 64 * 136;
    bf16_t* QEL = VTL + 2 * 64 * 72;
    f32x4 Sacc[4];
    if (sample) { const float* s0 = p.in[3] + ((size_t)((b * 2 + z) * 4 + hd)) * 32768 + eq * 64 + fr;
#pragma unroll
        for (int et = 0; et < 4; ++et)
#pragma unroll
            for (int jj = 0; jj < 4; ++jj) Sacc[et][jj] = s0[(size_t)(w * 16 + fq * 4 + jj) * 256 + et * 16]; }
    else {
#pragma unroll
        for (int et = 0; et < 4; ++et) Sacc[et] = (f32x4){0.f, 0.f, 0.f, 0.f}; }
    const int it = w >> 1, e2 = (w & 1) * 2;
    const int ve = tid >> 3, vt8 = (tid & 7) * 8;
#define GLB_LOAD(F, c_) do { const int cc_ = (c_); \
        _Pragma("unroll") for (int ks = 0; ks < 2; ++ks) { (F).kdt[ks] = *(const bf16x8*)(KDTg + ((size_t)(((z * 128 + cc_) * 4 + hd) * 128 + w * 16 + fr)) * 64 + ks * 32 + fq * 8); \
            (F).att[ks] = *(const bf16x8*)(ATTg + ((size_t)((z * 128 + cc_) * 4 + hd)) * 4096 + (it * 16 + fr) * 64 + ks * 32 + fq * 8); } \
        (F).vts = *(const u32x4*)(VTg + ((size_t)((cc_ * 4 + hd) * 256 + eq * 64 + ve)) * 64 + vt8); \
        _Pragma("unroll") for (int h_ = 0; h_ < 2; ++h_) (F).qes[h_] = *(const u32x4*)(QEg + ((size_t)z * NTOK + cc_ * 64 + ve) * 512 + hd * 128 + h_ * 64 + vt8); \
        (F).ebl = *(const f32x4*)(EBLg + (size_t)(z * 128 + cc_) * 512 + hd * 128 + w * 16 + fq * 4); } while (0)
#define GLB_STEP(CUR, NX2, ci_) do { const int ci = (ci_); if (ci < nch) { \
        const int c = ch0 + (z ? nch - 1 - ci : ci); \
        bf16_t* STc = ST + (ci & 1) * 64 * 136; bf16_t* VTc = VTL + (ci & 1) * 64 * 72; \
        _Pragma("unroll") for (int et = 0; et < 4; ++et) { u32x2 v2; v2.x = pk2(Sacc[et][0], Sacc[et][1]); v2.y = pk2(Sacc[et][2], Sacc[et][3]); \
            *(u32x2*)(STc + (et * 16 + fr) * 136 + w * 16 + fq * 4) = v2; } \
        *(u32x4*)(VTc + ve * 72 + vt8) = (CUR).vts; \
        bf16_t* QEc = QEL + (ci & 1) * 64 * 136; \
        *(u32x4*)(QEc + ve * 136 + vt8) = (CUR).qes[0]; *(u32x4*)(QEc + ve * 136 + 64 + vt8) = (CUR).qes[1]; \
        if (ci + 2 < nch) GLB_LOAD(NX2, ch0 + (z ? nch - 3 - ci : ci + 2)); \
        lds_barrier(); \
        _Pragma("unroll") for (int et = 0; et < 4; ++et) { Sacc[et] = Sacc[et] * (CUR).ebl; \
            _Pragma("unroll") for (int ks = 0; ks < 2; ++ks) { const bf16x8 vf = *(const bf16x8*)(VTc + (et * 16 + fr) * 72 + ks * 32 + fq * 8); \
                Sacc[et] = __builtin_amdgcn_mfma_f32_16x16x32_bf16((CUR).kdt[ks], vf, Sacc[et], 0, 0, 0); } } \
        _Pragma("unroll") for (int q2 = 0; q2 < 2; ++q2) { f32x4 o = (f32x4){0.f, 0.f, 0.f, 0.f}; \
            _Pragma("unroll") for (int ks = 0; ks < 2; ++ks) { const bf16x8 vf = *(const bf16x8*)(VTc + ((e2 + q2) * 16 + fr) * 72 + ks * 32 + fq * 8); \
                o = __builtin_amdgcn_mfma_f32_16x16x32_bf16((CUR).att[ks], vf, o, 0, 0, 0); } \
            _Pragma("unroll") for (int ks = 0; ks < 4; ++ks) { const bf16x8 bS = *(const bf16x8*)(STc + ((e2 + q2) * 16 + fr) * 136 + ks * 32 + fq * 8); \
                const bf16x8 aq = *(const bf16x8*)(QEc + (it * 16 + fr) * 136 + ks * 32 + fq * 8); \
                o = __builtin_amdgcn_mfma_f32_16x16x32_bf16(aq, bS, o, 0, 0, 0); } \
            _Pragma("unroll") for (int jj = 0; jj < 4; ++jj) OD[((size_t)z * NTOK + c * 64 + it * 16 + fq * 4 + jj) * 1024 + hd * 256 + eq * 64 + (e2 + q2) * 16 + fr] = o[jj]; } } } while (0)
    GlaFrags fa, fb, fc;
    GLB_LOAD(fa, ch0 + (z ? nch - 1 : 0));
    GLB_LOAD(fb, ch0 + (z ? nch - 2 : 1));
    __syncthreads();
#pragma unroll 1
    for (int ci3 = 0; ci3 < nch; ci3 += 3) { GLB_STEP(fa, fc, ci3); GLB_STEP(fb, fa, ci3 + 1); GLB_STEP(fc, fb, ci3 + 2); }
#undef GLB_STEP
#undef GLB_LOAD
    if (!sample) { float* so = p.out + (size_t)2 * NPTOK * D + 2097152 + ((size_t)((b * 2 + z) * 4 + hd)) * 32768 + eq * 64 + fr;
#pragma unroll
        for (int et = 0; et < 4; ++et)
#pragma unroll
            for (int jj = 0; jj < 4; ++jj) so[(size_t)(w * 16 + fq * 4 + jj) * 256 + et * 16] = Sacc[et][jj]; }
    __syncthreads();
}

__device__ void phase_gla_b(const Params& p, float* lds, int rep) {
    unsigned* ctr = (unsigned*)(p.ws + WS_CTL) + 16 + rep * 32;
    int* slot = (int*)(lds + LDS_MAIN / 4);
    for (;;) {
        if (threadIdx.x == 0) *slot = (int)atomicAdd(ctr, 1u);
        __syncthreads();
        const int it = *slot;
        __syncthreads();
        if (it >= 576) break;
        gla_b_unit(p, it, lds);
    }
}

__device__ void phase_gla_post(const Params& p) {
    const int tid = threadIdx.x, wave = tid >> 6, lane = tid & 63;
    unsigned char* ws = p.ws;
    const bf16_t* P1 = (const bf16_t*)(ws + WS_P);
    const float* OD = (const float*)(ws + WS_P2);
    bf16_t* OG = (bf16_t*)(ws + WS_OC);
    for (int tok = blockIdx.x * 8 + wave; tok < NTOK; tok += gridDim.x * 8) {
        for (int hd = 0; hd < 4; ++hd) { const int idx = hd * 256 + lane * 4;
            const f32x4 a = *(const f32x4*)(OD + (size_t)tok * 1024 + idx), b2 = *(const f32x4*)(OD + ((size_t)NTOK + tok) * 1024 + idx);
            const f32x4 o = a + b2;
            const float ss = wave_sum(o[0] * o[0] + o[1] * o[1] + o[2] * o[2] + o[3] * o[3]);
            const float rs = rsqrtf(ss * (1.f / 256.f) + 1e-6f);
            const f32x4 gn = *(const f32x4*)(p.in[29] + lane * 4);
            const u32x2 zz = *(const u32x2*)(P1 + (size_t)tok * N1 + 2048 + idx);
            const float z0 = bflo(zz.x), z1 = bfhi(zz.x), z2 = bflo(zz.y), z3 = bfhi(zz.y);
            u32x2 w; w.x = pack2(o[0] * rs * gn[0] * silu(z0), o[1] * rs * gn[1] * silu(z1)); w.y = pack2(o[2] * rs * gn[2] * silu(z2), o[3] * rs * gn[3] * silu(z3));
            *(u32x2*)(OG + (size_t)tok * 1024 + idx) = w; }
    }
}

__device__ void phase_final(const Params& p) {
    const int tid = threadIdx.x, wave = tid >> 6, lane = tid & 63;
    unsigned char* ws = p.ws;
    const float* MOD = (const float*)(ws + WS_MOD);
    const float* X1 = (const float*)(ws + WS_X1);
    const float* Y = (const float*)(ws + WS_P2);
    for (int tok = blockIdx.x * 8 + wave; tok < NTOK; tok += gridDim.x * 8) {
        const int cond = tok < NPTOK ? 0 : 1 + ((tok - NPTOK) >> 11);
        f32x4 xv[4]; float ss = 0.f;
#pragma unroll
        for (int i = 0; i < 4; ++i) { const int idx = i * 256 + lane * 4;
            const f32x4 x1 = *(const f32x4*)(X1 + (size_t)tok * D + idx);
            const f32x4 ya = *(const f32x4*)(Y + (size_t)tok * D + idx), yb = *(const f32x4*)(Y + (size_t)NTOK * D + (size_t)tok * D + idx);
            const f32x4 gt = *(const f32x4*)(MOD + (1 * 3 + cond) * 3072 + 2048 + idx);
            xv[i] = x1 + gt * (ya + yb);
            ss += xv[i][0] * xv[i][0] + xv[i][1] * xv[i][1] + xv[i][2] * xv[i][2] + xv[i][3] * xv[i][3]; }
        ss = wave_sum(ss);
        const float rstd = rsqrtf(ss * (1.f / 1024.f) + 1e-6f);
#pragma unroll
        for (int i = 0; i < 4; ++i) { const int idx = i * 256 + lane * 4;
            const f32x4 g = *(const f32x4*)(p.in[9] + idx);
            f32x4 o;
#pragma unroll
            for (int j = 0; j < 4; ++j) o[j] = xv[i][j] * rstd * g[j];
            *(f32x4*)(p.out + (size_t)tok * D + idx) = o; }
    }
}


#define XB_TMO      128
#define XB_XCNT(j)  (256  + 64 * (j))
#define XB_XSUB(j)  (1280 + 64 * (j))
#define XB_XGEN(j)  (2304 + 64 * (j))
#define XB_TOP      3328
#define XB_TOPGEN   3392
#define XCD_BAR_WORDS 3456
#define XB_SPIN_CAP (1u << 18)

__device__ __forceinline__ unsigned xb_ld(unsigned* p)              { return __hip_atomic_load(p, __ATOMIC_RELAXED, __HIP_MEMORY_SCOPE_AGENT); }
__device__ __forceinline__ unsigned xb_add(unsigned* p, unsigned v) { return __hip_atomic_fetch_add(p, v, __ATOMIC_RELAXED, __HIP_MEMORY_SCOPE_AGENT); }
__device__ __forceinline__ unsigned xb_xcc_id() { return (unsigned)__builtin_amdgcn_s_getreg((3 << 11) | 20) & 0xFu; }
#define XB_SPIN(cond, bar) do { unsigned _sp = 0; while (cond) { __builtin_amdgcn_s_sleep(1); \
    if ((++_sp & 255u) == 0u) { if (xb_ld(&(bar)[XB_TMO])) break; if (_sp > XB_SPIN_CAP) { atomicAdd(&(bar)[XB_TMO], 1u); break; } } } } while (0)

struct XcdBarrier {
    unsigned* bar; unsigned x;
    volatile LAS unsigned* st;
};

__device__ __forceinline__ XcdBarrier xcd_barrier_post(unsigned* bar, volatile LAS unsigned* st) {
    XcdBarrier b; b.bar = bar; b.x = xb_xcc_id(); b.st = st;
    if (threadIdx.x == 0) (void)xb_add(&bar[XB_XCNT(b.x)], 1u);
    return b;
}
__device__ __forceinline__ void xcd_barrier_complete(unsigned* bar, unsigned x, unsigned& nloc, unsigned& nx) {
    const unsigned G = gridDim.x * gridDim.y * gridDim.z;
    unsigned sum, cnt, mine, sp = 0u;
    for (;;) {
        sum = 0u; cnt = 0u; mine = 0u;
#pragma unroll
        for (unsigned j = 0; j < 16; ++j) { const unsigned c = xb_ld(&bar[XB_XCNT(j)]); sum += c; cnt += (c > 0u) ? 1u : 0u; mine = (j == x) ? c : mine; }
        if (sum == G) break;
        __builtin_amdgcn_s_sleep(1);
        if ((++sp & 255u) == 0u) { if (xb_ld(&bar[XB_TMO])) break; if (sp > XB_SPIN_CAP) { atomicAdd(&bar[XB_TMO], 1u); break; } }
    }
    nloc = mine > 0u ? mine : 1u; nx = cnt > 0u ? cnt : 1u;
}

__device__ __forceinline__ void xcd_barrier(const XcdBarrier& b) {
    asm volatile("s_waitcnt vmcnt(0)" ::: "memory");
    __syncthreads();
    if (threadIdx.x == 0) {
        unsigned* bar = b.bar;
        __builtin_amdgcn_s_waitcnt(0);
        unsigned nloc = b.st[0], nx = b.st[1];
        if (nloc == 0u) { xcd_barrier_complete(bar, b.x, nloc, nx); b.st[0] = nloc; b.st[1] = nx; }
        const unsigned old = xb_add(&bar[XB_XSUB(b.x)], 1u);
        const unsigned gen = old / nloc;
        if (old + 1u == (gen + 1u) * nloc) {
            __builtin_amdgcn_fence(__ATOMIC_RELEASE, "agent");
            asm volatile("s_waitcnt vmcnt(0)" ::: "memory");
            const unsigned og = xb_add(&bar[XB_TOP], 1u);
            const unsigned tg = og / nx;
            if (og + 1u == (tg + 1u) * nx) xb_add(&bar[XB_TOPGEN], 1u);
            else XB_SPIN(xb_ld(&bar[XB_TOPGEN]) == tg, bar);
            __builtin_amdgcn_fence(__ATOMIC_ACQUIRE, "agent");
            xb_add(&bar[XB_XGEN(b.x)], 1u);
            asm volatile("s_waitcnt vmcnt(0)" ::: "memory");
        } else {
            XB_SPIN(xb_ld(&bar[XB_XGEN(b.x)]) == gen, bar);
            __builtin_amdgcn_fence(__ATOMIC_ACQUIRE, "agent");
            asm volatile("s_waitcnt vmcnt(0)" ::: "memory");
        }
    }
    __syncthreads();
}


constexpr int NPHASE = 14;
__global__ void __launch_bounds__(NTHR, 2) fwd_megakernel(Params p) {
    extern __shared__ __attribute__((aligned(16))) unsigned char smem[];
    float* ldsf = (float*)smem;
    LAS unsigned char* ldsl = (LAS unsigned char*)smem;
    unsigned char* ws = p.ws;
    volatile LAS unsigned* xst = (volatile LAS unsigned*)(ldsl + LDS_MAIN + 16);
    if (threadIdx.x == 0) { xst[0] = 0u; xst[1] = 0u; }
    __syncthreads();
    const XcdBarrier xbar = xcd_barrier_post((unsigned*)(ws + WS_BAR), xst);
    if (p.ph_lo < 0) cg::this_grid().sync();
#ifndef DUP_PHASE
#define DUP_PHASE -1
#endif
#define PHASE(n) if (p.ph_lo <= (n) && (n) < p.ph_hi && ((n) == p.ph_lo || (xcd_barrier(xbar), true))) for (int rep = 0; rep < ((n) == DUP_PHASE ? 2 : 1); ++rep, ((n) == DUP_PHASE ? (xcd_barrier(xbar), 0) : 0))
    PHASE(0) phase_prologue(p, ldsf);
    PHASE(1) phase_h(p, 0);
    PHASE(2) { pg8::Gemm g{(const bf16_t*)(ws + WS_H), (const bf16_t*)(ws + WS_BT0), NTOK, N0, 1024, 1024, 1}; pg8::Order S; S.init(NTOK, N0, 1, gridDim.x, blockIdx.x);
               pg8::EpiBf16 E{(bf16_t*)(ws + WS_P), N0}; pg8::gemm_phase(ldsl, g, S, E); }
    PHASE(3) phase_mix0(p, ldsf, rep);
    PHASE(4) phase_wkv_fix(p, ldsf);
    PHASE(5) phase_wkv_post(p);
    PHASE(6) { pg8::Gemm g{(const bf16_t*)(ws + WS_OC), (const bf16_t*)(ws + WS_WT0O), NTOK, 1024, 1024, 2048, 2}; pg8::Order S; S.init(NTOK, 1024, 2, gridDim.x, blockIdx.x);
               pg8::EpiF32 E{(float*)(ws + WS_P), 1024, (size_t)NTOK * 1024}; pg8::gemm_phase(ldsl, g, S, E); }
    PHASE(7) phase_h(p, 1);
    PHASE(8) { pg8::Gemm g{(const bf16_t*)(ws + WS_H), (const bf16_t*)(ws + WS_BT1), NTOK, N1, 1024, 1024, 1}; pg8::Order S; S.init(NTOK, N1, 1, gridDim.x, blockIdx.x);
               pg8::EpiBf16 E{(bf16_t*)(ws + WS_P), N1}; pg8::gemm_phase(ldsl, g, S, E); }
    PHASE(9) phase_gla_a(p, ldsf);
    PHASE(10) phase_gla_b(p, ldsf, rep);
    PHASE(11) phase_gla_post(p);
    PHASE(12) { pg8::Gemm g{(const bf16_t*)(ws + WS_OC), (const bf16_t*)(ws + WS_WT1O), NTOK, 1024, 512, 1024, 2}; pg8::Order S; S.init(NTOK, 1024, 2, gridDim.x, blockIdx.x);
                pg8::EpiF32 E{(float*)(ws + WS_P2), 1024, (size_t)NTOK * 1024}; pg8::gemm_phase(ldsl, g, S, E); }
    PHASE(13) phase_final(p);
}

extern "C" void kernel_launch(void* const* d_in, const int* in_sizes, int n_in, void* d_out, int out_size, void* d_ws, size_t ws_size, hipStream_t stream) {
    static int grid = 0;
    if (grid == 0) {
        if (n_in != 30 || ws_size < WS_END) { fprintf(stderr, "kernel_launch: unexpected n_in %d / ws_size %zu (need %zu)\n", n_in, ws_size, (size_t)WS_END); grid = -1; return; }
        int dev = 0, cus = 0, per_cu = 0;
        hipGetDevice(&dev);
        hipDeviceGetAttribute(&cus, hipDeviceAttributeMultiprocessorCount, dev);
        hipFuncSetAttribute((const void*)fwd_megakernel, hipFuncAttributeMaxDynamicSharedMemorySize, LDS_BYTES);
        hipOccupancyMaxActiveBlocksPerMultiprocessor(&per_cu, (const void*)fwd_megakernel, NTHR, LDS_BYTES);
        if (per_cu < 1) { fprintf(stderr, "kernel_launch: occupancy query returned %d\n", per_cu); per_cu = 1; }
        grid = cus * per_cu;
        (void)hipGetLastError();
    }
    if (grid < 0) return;
    hipMemsetAsync((char*)d_ws + WS_CTL, 0, 256, stream);
    hipMemsetAsync((char*)d_ws + WS_BAR, 0, XCD_BAR_WORDS * 4, stream);
    Params p{};
    for (int i = 0; i < 30; ++i) p.in[i] = (const float*)d_in[i];
    p.out = (float*)d_out; p.ws = (unsigned char*)d_ws;
#if MULTI_LAUNCH
    for (int ph = 0; ph < NPHASE; ++ph) { p.ph_lo = ph; p.ph_hi = ph + 1; hipLaunchKernelGGL(fwd_megakernel, dim3(grid), dim3(NTHR), LDS_BYTES, stream, p); }
#else
    p.ph_lo = 0; p.ph_hi = NPHASE;
    void* args[] = {&p};
    hipError_t e = hipLaunchCooperativeKernel((const void*)fwd_megakernel, dim3(grid), dim3(NTHR), args, LDS_BYTES, stream);
    if (e != hipSuccess) fprintf(stderr, "cooperative launch failed: %s (grid %d)\n", hipGetErrorString(e), grid);
#endif
}
```

```cpp
#include <hip/hip_runtime.h>
#include <hip/hip_cooperative_groups.h>
#include <cstdio>
namespace cg = cooperative_groups;

#define LAS __attribute__((address_space(3)))
typedef unsigned short bf16_t;
typedef short bf16x8 __attribute__((ext_vector_type(8)));
typedef float f32x4 __attribute__((ext_vector_type(4)));
typedef unsigned u32x4 __attribute__((ext_vector_type(4)));
typedef unsigned u32x2 __attribute__((ext_vector_type(2)));

#ifndef MULTI_LAUNCH
#define MULTI_LAUNCH 0
#endif

constexpr int D = 1024, NTOK = 8192, NPTOK = 4096;
constexpr int N0 = 8448;
constexpr int N1 = 3328;
constexpr int NTHR = 512;
constexpr int LDS_MAIN = 139264;
constexpr int LDS_BYTES = LDS_MAIN + 256;

constexpr size_t MB = 1024 * 1024;
constexpr size_t WS_CTL = 0;
constexpr size_t WS_MOD = 4096;
constexpr size_t WS_BON = WS_MOD + 2 * 3 * 3072 * 4;
constexpr size_t WS_BAR = 0x1A0000;
constexpr size_t WS_BT0 = 2 * MB;
constexpr size_t WS_WT0O = WS_BT0 + (size_t)N0 * 1024 * 2;
constexpr size_t WS_BT1 = WS_WT0O + (size_t)1024 * 2048 * 2;
constexpr size_t WS_WT1O = WS_BT1 + (size_t)N1 * 1024 * 2;
constexpr size_t WS_H = WS_WT1O + (size_t)1024 * 1024 * 2;
constexpr size_t WS_OC = WS_H + (size_t)NTOK * 1024 * 2;
constexpr size_t WS_X1 = WS_OC + (size_t)NTOK * 2048 * 2;
constexpr size_t WS_P = WS_X1 + (size_t)NTOK * 1024 * 4;
constexpr size_t WS_P2 = WS_P + 64 * MB;
constexpr size_t WS_END = WS_P + (size_t)NTOK * N0 * 2;

struct Params {
    const float* in[30];
    float* out;
    unsigned char* ws;
    int ph_lo, ph_hi;
};

__device__ __forceinline__ float bf2f(bf16_t h) { return __uint_as_float(((unsigned)h) << 16); }
__device__ __forceinline__ bf16_t f2bf(float f) { unsigned u = __float_as_uint(f); u += 0x7FFFu + ((u >> 16) & 1u); return (bf16_t)(u >> 16); }
__device__ __forceinline__ unsigned pack2(float lo, float hi) { return (unsigned)f2bf(lo) | ((unsigned)f2bf(hi) << 16); }
__device__ __forceinline__ float bflo(unsigned w) { return __uint_as_float(w << 16); }
__device__ __forceinline__ float bfhi(unsigned w) { return __uint_as_float(w & 0xFFFF0000u); }
__device__ __forceinline__ float fexp(float x) { return __builtin_amdgcn_exp2f(x * 1.44269504f); }
__device__ __forceinline__ float flog(float x) { return __builtin_amdgcn_logf(x) * 0.69314718f; }
__device__ __forceinline__ float silu(float x) { return x * __builtin_amdgcn_rcpf(1.f + fexp(-x)); }
__device__ __forceinline__ float wave_sum(float v) {
#pragma unroll
    for (int m = 32; m >= 1; m >>= 1) v += __shfl_xor(v, m, 64);
    return v;
}

typedef float f32x2_t __attribute__((ext_vector_type(2)));
typedef __bf16 bf16x2_t __attribute__((ext_vector_type(2)));
__device__ __forceinline__ unsigned pk2(float lo, float hi) { const f32x2_t v = {lo, hi}; return __builtin_bit_cast(unsigned, __builtin_convertvector(v, bf16x2_t)); }
__device__ __forceinline__ bf16_t f2bf_hw(float f) { return __builtin_bit_cast(bf16_t, (__bf16)f); }

__device__ __forceinline__ void lds_barrier() { asm volatile("s_waitcnt lgkmcnt(0)" ::: "memory"); __builtin_amdgcn_s_barrier(); asm volatile("" ::: "memory"); }

namespace pg8 {
constexpr int BM = 256, BK = 64, HALF = 128, HTB = HALF * BK * 2, NXCD = 8, WGM = 8;
__device__ __forceinline__ int lds_byte(int r, int c) { const int st = (r >> 4) * 2 + (c >> 5), rr = r & 15, cc = c & 31, ob = rr * 64 + cc * 2; return st * 1024 + (ob ^ (((ob >> 9) & 1) << 5)); }
__device__ __forceinline__ void stage_rc(int b, int& R, int& C) { const int st = b / 1024, sb = b % 1024, swz = sb ^ (((sb >> 9) & 1) << 5); R = (st >> 1) * 16 + swz / 64; C = (st & 1) * 32 + (swz % 64) / 2; }
__device__ __forceinline__ int perm32(int rho) { const int n = rho >> 4, i = rho & 15; return 8 * (i >> 2) + 4 * n + (i & 3); }

struct Unit { int pm, pn, ks; };
struct Gemm { const bf16_t* A; const bf16_t* Bt; int M, N, K, ld, KS; };

struct Order {
    int nM, nN, nNr, nwg, G, c;
    __device__ void init(int M, int N, int KS, int G_, int c_) { nM = M / BM; nNr = N / BM; nN = nNr * KS; nwg = nM * nN; G = G_; c = c_; }
    __device__ bool next(int i, Unit& u) const {
        const long L = (long)i * G + c; if (L >= nwg) return false;
        int wgid = (int)L; { const int q = nwg / NXCD, r = nwg % NXCD, xcd = wgid % NXCD, off = wgid / NXCD; wgid = (xcd < r ? xcd * (q + 1) : r * (q + 1) + (xcd - r) * q) + off; }
        const int nig = WGM * nN, gid = wgid / nig, fm = gid * WGM, gsz = (nM - fm) < WGM ? (nM - fm) : WGM;
        u.pm = fm + ((wgid % nig) % gsz); const int pn = (wgid % nig) / gsz; u.pn = pn % nNr; u.ks = pn / nNr; return true;
    }
};

__device__ __forceinline__ unsigned cvt_pk_bf16(float lo, float hi) { unsigned r; asm volatile("v_cvt_pk_bf16_f32 %0, %1, %2" : "=v"(r) : "v"(lo), "v"(hi)); return r; }

struct EpiF32 {
    static constexpr bool PERM = false;
    float* C; int ldc; size_t ks_stride;
    __device__ __forceinline__ void operator()(const f32x4 (&acc)[2][2][4][2], const Unit& u, int wr, int wc, int fr, int fq) const {
        const int row0 = u.pm * BM + wr * 64 + fr, col0 = u.pn * BM + wc * 32 + 4 * fq;
        float* Cb = C + (size_t)u.ks * ks_stride;
#pragma unroll
        for (int ai = 0; ai < 2; ++ai)
#pragma unroll
            for (int m = 0; m < 4; ++m) { float* rowp = Cb + (size_t)(row0 + ai * HALF + m * 16) * ldc + col0;
#pragma unroll
                for (int bj = 0; bj < 2; ++bj)
#pragma unroll
                    for (int n = 0; n < 2; ++n) *(f32x4*)(rowp + bj * HALF + n * 16) = acc[ai][bj][m][n]; }
    }
};
struct EpiBf16 {
    static constexpr bool PERM = true;
    bf16_t* O; int ldc;
    __device__ __forceinline__ void operator()(const f32x4 (&acc)[2][2][4][2], const Unit& u, int wr, int wc, int fr, int fq) const {
        const int row0 = u.pm * BM + wr * 64 + fr; const int col0 = u.pn * BM + wc * 32 + 8 * fq;
#pragma unroll
        for (int ai = 0; ai < 2; ++ai)
#pragma unroll
            for (int m = 0; m < 4; ++m) { bf16_t* rowp = O + (size_t)(row0 + ai * HALF + m * 16) * ldc + col0;
#pragma unroll
                for (int bj = 0; bj < 2; ++bj) { const f32x4 v0 = acc[ai][bj][m][0], v1 = acc[ai][bj][m][1];
                    u32x4 w; w.x = cvt_pk_bf16(v0[0], v0[1]); w.y = cvt_pk_bf16(v0[2], v0[3]); w.z = cvt_pk_bf16(v1[0], v1[1]); w.w = cvt_pk_bf16(v1[2], v1[3]);
                    *(u32x4*)(rowp + bj * HALF) = w; } }
    }
};

template <class Epi>
__device__ __forceinline__ void gemm_phase(LAS unsigned char* lds, const Gemm g, const Order& S, const Epi& E) {
    const int tid = threadIdx.x, wid = __builtin_amdgcn_readfirstlane(tid >> 6), lane = tid & 63, wr = wid >> 2, wc = wid & 3, fr = lane & 15, fq = lane >> 4;
    const int K = g.K, nt = K / BK, ld = g.ld;
    unsigned voffA[2], voffB[2];
#pragma unroll
    for (int i = 0; i < 2; ++i) { int R, C; stage_rc(tid * 16 + i * 8192, R, C); const int Rb = Epi::PERM ? ((R & ~31) + perm32(R & 31)) : R;
        voffA[i] = (unsigned)(R * ld + C) * 2u; voffB[i] = (unsigned)(Rb * ld + C) * 2u; }
    const size_t kstep = (size_t)(BK * 2);
    const size_t hstep = (size_t)HALF * ld * 2;
    const size_t tstep = 2 * hstep;
    const size_t ksb = (size_t)K * 2;
    const unsigned ldsw = (unsigned)wid * 1024u;
    const int aoff = lds_byte(wr * 64 + fr, fq * 8), boff = lds_byte(wc * 32 + fr, fq * 8);
#define PG8_SA(b, h) (((b) * 2 + (h)) * HTB)
#define PG8_SB(b, h) ((4 + (b) * 2 + (h)) * HTB)
#define PG8_STAGE(bufoff, gbase, voff) do { _Pragma("unroll") for (int _i = 0; _i < 2; ++_i) \
        __builtin_amdgcn_global_load_lds((const unsigned*)((const char*)(gbase) + (voff)[_i]), (LAS unsigned*)(lds + (bufoff) + ldsw + _i * 8192), 16, 0, 0); } while (0)
#define PG8_LDA(dst, b, h) do { _Pragma("unroll") for (int m = 0; m < 4; ++m) _Pragma("unroll") for (int k = 0; k < 2; ++k) dst[m][k] = *(const LAS bf16x8*)(lds + PG8_SA(b, h) + aoff + m * 2048 + k * 1024); } while (0)
#define PG8_LDB(dst, b, h) do { _Pragma("unroll") for (int n = 0; n < 2; ++n) _Pragma("unroll") for (int k = 0; k < 2; ++k) dst[n][k] = *(const LAS bf16x8*)(lds + PG8_SB(b, h) + boff + n * 2048 + k * 1024); } while (0)
#define PG8_MMA(ai, bj, At, Bt) do { __builtin_amdgcn_s_setprio(1); _Pragma("unroll") for (int m = 0; m < 4; ++m) _Pragma("unroll") for (int n = 0; n < 2; ++n) _Pragma("unroll") for (int k = 0; k < 2; ++k) \
        acc[ai][bj][m][n] = __builtin_amdgcn_mfma_f32_16x16x32_bf16(Bt[n][k], At[m][k], acc[ai][bj][m][n], 0, 0, 0); __builtin_amdgcn_s_setprio(0); } while (0)
#define PG8_WAIT_V(n) asm volatile("s_waitcnt vmcnt(" #n ")" ::: "memory")
#define PG8_WAIT_L(n) asm volatile("s_waitcnt lgkmcnt(" #n ")" ::: "memory")
#define PG8_BAR __builtin_amdgcn_s_barrier()
#define PG8_SCHED __builtin_amdgcn_sched_barrier(0)
    Unit cur, nxt; int ui = 0;
    if (!S.next(0, cur)) return;
    f32x4 acc[2][2][4][2];
#pragma unroll
    for (int a = 0; a < 2; ++a)
#pragma unroll
        for (int b = 0; b < 2; ++b)
#pragma unroll
            for (int m = 0; m < 4; ++m)
#pragma unroll
                for (int n = 0; n < 2; ++n) acc[a][b][m][n] = (f32x4){0.f, 0.f, 0.f, 0.f};
    bf16x8 At[4][2], B0[2][2], B1[2][2];
    const char* cA = (const char*)g.A + (size_t)cur.pm * tstep + (size_t)cur.ks * ksb; const char* cB = (const char*)g.Bt + (size_t)cur.pn * tstep + (size_t)cur.ks * ksb;
    PG8_STAGE(PG8_SB(0, 0), cB, voffB); PG8_STAGE(PG8_SA(0, 0), cA, voffA); PG8_STAGE(PG8_SB(0, 1), cB + hstep, voffB); PG8_STAGE(PG8_SA(0, 1), cA + hstep, voffA);
    if (wr == 1) PG8_BAR;
    PG8_WAIT_V(4); PG8_BAR;
    PG8_STAGE(PG8_SB(1, 0), cB + kstep, voffB); PG8_STAGE(PG8_SA(1, 0), cA + kstep, voffA); PG8_STAGE(PG8_SB(1, 1), cB + hstep + kstep, voffB);
    PG8_WAIT_V(6); PG8_BAR;
    for (;;) {
        const bool has_next = S.next(ui + 1, nxt);
        const char* nA = has_next ? (const char*)g.A + (size_t)nxt.pm * tstep + (size_t)nxt.ks * ksb : cA; const char* nB = has_next ? (const char*)g.Bt + (size_t)nxt.pn * tstep + (size_t)nxt.ks * ksb : cB;
        for (int t = 0; t < nt; t += 2) {
            const bool last = (t == nt - 2);
            const char* a1 = cA + (size_t)(t + 1) * kstep;
            const char* a2 = last ? nA : cA + (size_t)(t + 2) * kstep; const char* b2 = last ? nB : cB + (size_t)(t + 2) * kstep;
            const char* a3 = a2 + kstep; const char* b3 = b2 + kstep;
            PG8_LDB(B0, 0, 0); PG8_SCHED; PG8_LDA(At, 0, 0); PG8_STAGE(PG8_SA(1, 1), a1 + hstep, voffA);
            PG8_WAIT_L(8); PG8_BAR; PG8_WAIT_L(0); PG8_MMA(0, 0, At, B0); PG8_BAR; PG8_SCHED;
            PG8_LDB(B1, 0, 1); PG8_STAGE(PG8_SB(0, 0), b2, voffB);
            PG8_BAR; PG8_WAIT_L(0); PG8_MMA(0, 1, At, B1); PG8_BAR;
            PG8_LDA(At, 0, 1); PG8_STAGE(PG8_SA(0, 0), a2, voffA);
            PG8_BAR; PG8_WAIT_L(0); PG8_MMA(1, 0, At, B0); PG8_BAR; PG8_SCHED;
            PG8_STAGE(PG8_SB(0, 1), b2 + hstep, voffB);
            PG8_WAIT_V(6); PG8_BAR; PG8_MMA(1, 1, At, B1); PG8_BAR;
            PG8_LDB(B0, 1, 0); PG8_SCHED; PG8_LDA(At, 1, 0); PG8_STAGE(PG8_SA(0, 1), a2 + hstep, voffA);
            PG8_WAIT_L(8); PG8_BAR; PG8_WAIT_L(0); PG8_MMA(0, 0, At, B0); PG8_BAR; PG8_SCHED;
            PG8_LDB(B1, 1, 1); PG8_STAGE(PG8_SB(1, 0), b3, voffB);
            PG8_BAR; PG8_WAIT_L(0); PG8_MMA(0, 1, At, B1); PG8_BAR;
            PG8_LDA(At, 1, 1); PG8_STAGE(PG8_SA(1, 0), a3, voffA);
            PG8_BAR; PG8_WAIT_L(0); PG8_MMA(1, 0, At, B0); PG8_BAR; PG8_SCHED;
            PG8_STAGE(PG8_SB(1, 1), b3 + hstep, voffB);
            PG8_WAIT_V(6); PG8_BAR; PG8_MMA(1, 1, At, B1); PG8_BAR;
        }
        E(acc, cur, wr, wc, fr, fq);
        if (!has_next) break;
#pragma unroll
        for (int a = 0; a < 2; ++a)
#pragma unroll
            for (int b = 0; b < 2; ++b)
#pragma unroll
                for (int m = 0; m < 4; ++m)
#pragma unroll
                    for (int n = 0; n < 2; ++n) acc[a][b][m][n] = (f32x4){0.f, 0.f, 0.f, 0.f};
        cur = nxt; cA = nA; cB = nB; ++ui;
    }
    PG8_WAIT_V(0);
    if (wr == 0) PG8_BAR;
    PG8_BAR;
#undef PG8_SA
#undef PG8_SB
#undef PG8_STAGE
#undef PG8_LDA
#undef PG8_LDB
#undef PG8_MMA
#undef PG8_WAIT_V
#undef PG8_WAIT_L
#undef PG8_BAR
#undef PG8_SCHED
}
}

struct TJob { const float* src; bf16_t* dst; int ldsrc, N, lddst, drow0, k0, n0; };
__device__ __forceinline__ TJob tjob_of(const Params& p, int t) {
    unsigned char* ws = p.ws;
    bf16_t* BT0 = (bf16_t*)(ws + WS_BT0); bf16_t* WT0O = (bf16_t*)(ws + WS_WT0O); bf16_t* BT1 = (bf16_t*)(ws + WS_BT1); bf16_t* WT1O = (bf16_t*)(ws + WS_WT1O);
    TJob j; int nnt;
    if (t < 1024) { j.src = p.in[10]; j.ldsrc = 8192; j.N = 8192; j.dst = BT0; j.lddst = 1024; j.drow0 = 0; nnt = 64; }
    else if (t < 1024 + 32) { t -= 1024; const int z = t >> 4; t &= 15; j.src = p.in[14] + (size_t)z * 1024 * 64; j.ldsrc = 64; j.N = 64; j.dst = BT0; j.lddst = 1024; j.drow0 = 8192 + z * 64; nnt = 1; }
    else if (t < 1024 + 64) { t -= 1024 + 32; const int z = t >> 4; t &= 15; j.src = p.in[17] + (size_t)z * 1024 * 64; j.ldsrc = 64; j.N = 64; j.dst = BT0; j.lddst = 1024; j.drow0 = 8320 + z * 64; nnt = 1; }
    else if (t < 1088 + 256) { t -= 1088; j.src = p.in[11]; j.ldsrc = 1024; j.N = 1024; j.dst = WT0O; j.lddst = 2048; j.drow0 = 0; nnt = 8; }
    else if (t < 1344 + 384) { t -= 1344; j.src = p.in[24]; j.ldsrc = 3072; j.N = 3072; j.dst = BT1; j.lddst = 1024; j.drow0 = 0; nnt = 24; }
    else if (t < 1728 + 32) { t -= 1728; const int z = t >> 4; t &= 15; j.src = p.in[26] + (size_t)z * 1024 * 16; j.ldsrc = 16; j.N = 16; j.dst = BT1; j.lddst = 1024; j.drow0 = 3072 + z * 16; nnt = 1; }
    else { t -= 1760; j.src = p.in[25]; j.ldsrc = 1024; j.N = 1024; j.dst = WT1O; j.lddst = 1024; j.drow0 = 0; nnt = 8; }
    j.k0 = (t / nnt) * 64; j.n0 = (t % nnt) * 128; return j;
}
__device__ __forceinline__ void tjob_load(const TJob& j, f32x4 (&r)[4]) {
    const int tid = threadIdx.x, c4 = (tid & 31) * 4;
#pragma unroll
    for (int i = 0; i < 4; ++i) { const int kk = (tid >> 5) + 16 * i;
        r[i] = (j.n0 + c4 < j.N) ? *(const f32x4*)(j.src + (size_t)(j.k0 + kk) * j.ldsrc + j.n0 + c4) : (f32x4){0.f, 0.f, 0.f, 0.f}; }
}

__device__ void phase_prologue(const Params& p, float* lds) {
    const int tid = threadIdx.x;
    unsigned char* ws = p.ws;
    bf16_t* BT1 = (bf16_t*)(ws + WS_BT1);
    float* MOD = (float*)(ws + WS_MOD);
    constexpr int NGEMV = 192, NT = 1888;
    for (int it = blockIdx.x; it < NGEMV; it += gridDim.x) {
        const int l = it / 96, j0 = (it % 96) * 32;
        float* sc = lds;
        float* red = lds + 3072;
        for (int i = tid; i < 3072; i += NTHR) { const int cnd = i >> 10, k = i & 1023; const float v = cnd == 0 ? p.in[5][k] : p.in[4][(cnd - 1) * 1024 + k]; sc[i] = silu(v); }
        __syncthreads();
        const int col = tid & 31, ksp = tid >> 5;
        float a0 = 0.f, a1 = 0.f, a2 = 0.f;
        const float* w = p.in[7] + (size_t)l * 1024 * 3072 + j0 + col;
#pragma unroll 16
        for (int k = ksp * 64; k < ksp * 64 + 64; ++k) { const float wv = w[(size_t)k * 3072]; a0 += sc[k] * wv; a1 += sc[1024 + k] * wv; a2 += sc[2048 + k] * wv; }
        red[(ksp * 3 + 0) * 32 + col] = a0; red[(ksp * 3 + 1) * 32 + col] = a1; red[(ksp * 3 + 2) * 32 + col] = a2;
        __syncthreads();
        if (tid < 96) { const int cnd = tid >> 5, cc = tid & 31; float s = 0.f; for (int q = 0; q < 16; ++q) s += red[(q * 3 + cnd) * 32 + cc];
            MOD[(l * 3 + cnd) * 3072 + j0 + cc] = s + p.in[8][l * 3072 + j0 + cc]; }
        __syncthreads();
    }
    { float* tile = lds;
      int it = (int)((blockIdx.x + 64u) % gridDim.x);
      f32x4 cur[4], nxt[4];
      TJob jc = tjob_of(p, it < NT ? it : 0);
      if (it < NT) tjob_load(jc, cur);
      for (; it < NT; it += gridDim.x) {
          const int c4 = (tid & 31) * 4;
#pragma unroll
          for (int i = 0; i < 4; ++i) { const int kk = (tid >> 5) + 16 * i; tile[kk * 129 + c4] = cur[i][0]; tile[kk * 129 + c4 + 1] = cur[i][1]; tile[kk * 129 + c4 + 2] = cur[i][2]; tile[kk * 129 + c4 + 3] = cur[i][3]; }
          const int itn = it + gridDim.x;
          const TJob jn = tjob_of(p, itn < NT ? itn : 0);
          if (itn < NT) tjob_load(jn, nxt);
          __syncthreads();
#pragma unroll
          for (int q = 0; q < 2; ++q) { const int idx = tid + q * NTHR; const int nn = idx >> 3, k8 = (idx & 7) * 8;
              if (jc.n0 + nn < jc.N) { u32x4 o; o.x = pk2(tile[(k8 + 0) * 129 + nn], tile[(k8 + 1) * 129 + nn]); o.y = pk2(tile[(k8 + 2) * 129 + nn], tile[(k8 + 3) * 129 + nn]);
                  o.z = pk2(tile[(k8 + 4) * 129 + nn], tile[(k8 + 5) * 129 + nn]); o.w = pk2(tile[(k8 + 6) * 129 + nn], tile[(k8 + 7) * 129 + nn]);
                  *(u32x4*)(jc.dst + (size_t)(jc.drow0 + jc.n0 + nn) * jc.lddst + jc.k0 + k8) = o; } }
          __syncthreads();
          jc = jn;
#pragma unroll
          for (int i = 0; i < 4; ++i) cur[i] = nxt[i];
      } }
    { u32x4* z = (u32x4*)(BT1 + (size_t)3104 * 1024); const int n = 224 * 1024 * 2 / 16;
      for (int i = blockIdx.x * NTHR + tid; i < n; i += gridDim.x * NTHR) z[i] = (u32x4){0u, 0u, 0u, 0u}; }
}

__device__ void phase_h(const Params& p, int layer, float* ldsf) {
    const int tid = threadIdx.x, wave = __builtin_amdgcn_readfirstlane(tid >> 6), lane = tid & 63, fr = lane & 15, fq = lane >> 4;
    unsigned char* ws = p.ws;
    const float* MOD = (const float*)(ws + WS_MOD);
    bf16_t* H = (bf16_t*)(ws + WS_H);
    float* X1 = (float*)(ws + WS_X1);
    const float* Y = (const float*)(ws + WS_P);
    bf16_t* HL = (bf16_t*)ldsf;
    for (int tb = blockIdx.x * 32; tb < NTOK; tb += gridDim.x * 32) {
#pragma unroll 1
        for (int q = 0; q < 4; ++q) { const int tl = wave * 4 + q, tok = tb + tl;
            const float* xr = tok < NPTOK ? p.in[0] + (size_t)tok * D : p.in[1] + (size_t)(tok - NPTOK) * D;
            const int cond = tok < NPTOK ? 0 : 1 + ((tok - NPTOK) >> 11);
            f32x4 xv[4]; float ss = 0.f;
#pragma unroll
            for (int i = 0; i < 4; ++i) { const int idx = i * 256 + lane * 4; xv[i] = *(const f32x4*)(xr + idx);
                if (layer == 1) { const f32x4 ya = *(const f32x4*)(Y + (size_t)tok * D + idx), yb = *(const f32x4*)(Y + (size_t)NTOK * D + (size_t)tok * D + idx);
                    const f32x4 gt = *(const f32x4*)(MOD + (0 * 3 + cond) * 3072 + 2048 + idx);
                    xv[i] = xv[i] + gt * (ya + yb); *(f32x4*)(X1 + (size_t)tok * D + idx) = xv[i]; }
                ss += xv[i][0] * xv[i][0] + xv[i][1] * xv[i][1] + xv[i][2] * xv[i][2] + xv[i][3] * xv[i][3]; }
            ss = wave_sum(ss);
            const float rstd = rsqrtf(ss * (1.f / 1024.f) + 1e-6f);
#pragma unroll
            for (int i = 0; i < 4; ++i) { const int idx = i * 256 + lane * 4;
                const f32x4 g = *(const f32x4*)(p.in[6] + layer * D + idx);
                const f32x4 sh = *(const f32x4*)(MOD + (layer * 3 + cond) * 3072 + idx), sc = *(const f32x4*)(MOD + (layer * 3 + cond) * 3072 + 1024 + idx);
                f32x4 h;
#pragma unroll
                for (int j = 0; j < 4; ++j) h[j] = xv[i][j] * rstd * g[j] * (1.f + sc[j]) + sh[j];
                u32x2 w2; w2.x = pk2(h[0], h[1]); w2.y = pk2(h[2], h[3]);
                *(u32x2*)(H + (size_t)tok * D + idx) = w2;
                if (layer == 0) *(u32x2*)(HL + tl * 1032 + idx) = w2; } }
        if (layer == 0) {
            __syncthreads();
            const bf16_t* BL = (const bf16_t*)(ws + WS_BT0) + (size_t)8192 * 1024;
            bf16_t* P = (bf16_t*)(ws + WS_P);
            f32x4 acc[2][2];
#pragma unroll
            for (int mt = 0; mt < 2; ++mt)
#pragma unroll
                for (int n2 = 0; n2 < 2; ++n2) acc[mt][n2] = (f32x4){0.f, 0.f, 0.f, 0.f};
#pragma unroll 16
            for (int ks = 0; ks < 32; ++ks) {
                bf16x8 af[2], bfr[2];
#pragma unroll
                for (int mt = 0; mt < 2; ++mt) af[mt] = *(const bf16x8*)(HL + (mt * 16 + fr) * 1032 + ks * 32 + fq * 8);
#pragma unroll
                for (int n2 = 0; n2 < 2; ++n2) bfr[n2] = *(const bf16x8*)(BL + (size_t)((wave * 2 + n2) * 16 + fr) * 1024 + ks * 32 + fq * 8);
#pragma unroll
                for (int mt = 0; mt < 2; ++mt)
#pragma unroll
                    for (int n2 = 0; n2 < 2; ++n2) acc[mt][n2] = __builtin_amdgcn_mfma_f32_16x16x32_bf16(af[mt], bfr[n2], acc[mt][n2], 0, 0, 0);
            }
#pragma unroll
            for (int mt = 0; mt < 2; ++mt)
#pragma unroll
                for (int n2 = 0; n2 < 2; ++n2)
#pragma unroll
                    for (int jj = 0; jj < 4; ++jj) P[(size_t)(tb + mt * 16 + fq * 4 + jj) * N0 + 8192 + (wave * 2 + n2) * 16 + fr] = f2bf_hw(acc[mt][n2][jj]);
            __syncthreads();
        }
    }
}

__device__ __forceinline__ f32x4 mma_nt(const bf16_t* A, int lda, const bf16_t* B, int ldb, int K, f32x4 acc, int fr, int fq) {
    for (int k0 = 0; k0 < K; k0 += 32) {
        const bf16x8 a = *(const bf16x8*)(A + fr * lda + k0 + fq * 8);
        const bf16x8 b = *(const bf16x8*)(B + fr * ldb + k0 + fq * 8);
        acc = __builtin_amdgcn_mfma_f32_16x16x32_bf16(a, b, acc, 0, 0, 0);
    }
    return acc;
}
__device__ __forceinline__ bf16x8 pack8(float a0, float a1, float a2, float a3, float a4, float a5, float a6, float a7) {
    u32x4 w; w.x = pack2(a0, a1); w.y = pack2(a2, a3); w.z = pack2(a4, a5); w.w = pack2(a6, a7);
    return __builtin_bit_cast(bf16x8, w);
}
__device__ __forceinline__ float dpp_add(float v, float o) { return v + o; }
__device__ __forceinline__ float wave_sum_fast(float v) {
    v += __int_as_float(__builtin_amdgcn_update_dpp(0, __float_as_int(v), 0xB1, 0xF, 0xF, true));
    v += __int_as_float(__builtin_amdgcn_update_dpp(0, __float_as_int(v), 0x4E, 0xF, 0xF, true));
    v += __int_as_float(__builtin_amdgcn_update_dpp(0, __float_as_int(v), 0x141, 0xF, 0xF, true));
    v += __int_as_float(__builtin_amdgcn_update_dpp(0, __float_as_int(v), 0x140, 0xF, 0xF, true));
    v += __shfl_xor(v, 16, 64); v += __shfl_xor(v, 32, 64);
    return v;
}
__device__ __forceinline__ float wave_sum_dpp(float v) {
    v += __int_as_float(__builtin_amdgcn_update_dpp(0, __float_as_int(v), 0xB1, 0xF, 0xF, true));
    v += __int_as_float(__builtin_amdgcn_update_dpp(0, __float_as_int(v), 0x4E, 0xF, 0xF, true));
    v += __int_as_float(__builtin_amdgcn_update_dpp(0, __float_as_int(v), 0x141, 0xF, 0xF, true));
    v += __int_as_float(__builtin_amdgcn_update_dpp(0, __float_as_int(v), 0x140, 0xF, 0xF, true));
    v += __int_as_float(__builtin_amdgcn_update_dpp(0, __float_as_int(v), 0x142, 0xA, 0xF, false));
    v += __int_as_float(__builtin_amdgcn_update_dpp(0, __float_as_int(v), 0x143, 0xC, 0xF, false));
    return __int_as_float(__builtin_amdgcn_readlane(__float_as_int(v), 63));
}
__device__ __forceinline__ float wave_sum_lane63(float v) {
    v += __int_as_float(__builtin_amdgcn_update_dpp(0, __float_as_int(v), 0xB1, 0xF, 0xF, true));
    v += __int_as_float(__builtin_amdgcn_update_dpp(0, __float_as_int(v), 0x4E, 0xF, 0xF, true));
    v += __int_as_float(__builtin_amdgcn_update_dpp(0, __float_as_int(v), 0x141, 0xF, 0xF, true));
    v += __int_as_float(__builtin_amdgcn_update_dpp(0, __float_as_int(v), 0x140, 0xF, 0xF, true));
    v += __int_as_float(__builtin_amdgcn_update_dpp(0, __float_as_int(v), 0x142, 0xA, 0xF, false));
    v += __int_as_float(__builtin_amdgcn_update_dpp(0, __float_as_int(v), 0x143, 0xC, 0xF, false));
    return v;
}
__device__ __forceinline__ float fast_tanh(float x) { const float e = fexp(2.f * x); return 1.f - 2.f * __builtin_amdgcn_rcpf(1.f + e); }
__device__ __forceinline__ bf16x8 pack8h(float a0, float a1, float a2, float a3, float a4, float a5, float a6, float a7) {
    u32x4 w; w.x = pk2(a0, a1); w.y = pk2(a2, a3); w.z = pk2(a4, a5); w.w = pk2(a6, a7);
    return __builtin_bit_cast(bf16x8, w);
}

__device__ void wkv_unit(const Params& p, int u, float* ldsf) {
    const int tid0 = threadIdx.x, lane0 = tid0 & 63, w = __builtin_amdgcn_readfirstlane(tid0 >> 6), fr0 = lane0 & 15, fq0 = lane0 >> 4;
    unsigned char* ws = p.ws;
    unsigned char* lds = (unsigned char*)ldsf;
    const bf16_t* P = (const bf16_t*)(ws + WS_P);
    bf16_t* OD = (bf16_t*)(ws + WS_X1);
    float* BON = (float*)(ws + WS_BON);
    int z, b, hd, sgm, seqT, tok0; bool sample; const int T = 256;
    if (u < 512) { sample = true; z = u >> 8; b = (u >> 7) & 1; hd = (u >> 3) & 15; sgm = u & 7; seqT = 2048; tok0 = NPTOK + b * 2048; }
    else { const int q = u - 512; sample = false; z = q >> 8; b = (q >> 4) & 15; hd = q & 15; sgm = 0; seqT = 256; tok0 = b * 256; }
    const int qbase = sgm * 256;
    bf16_t* RHO = (bf16_t*)(ws + WS_H);
    float* GH = (float*)(ws + WS_BT0);
    bf16_t* TLW = (bf16_t*)(lds + 0);
    bf16_t* TLA = (bf16_t*)(lds + 9216);
    float* HT = (float*)(lds + 18432);
    bf16_t* KTr = (bf16_t*)(lds + 20480);
    bf16_t* BTr = (bf16_t*)(lds + 29696);
    bf16_t* KKH = (bf16_t*)(lds + 38912);
    bf16_t* RH = (bf16_t*)(lds + 48128);
    const bf16_t* VS = (const bf16_t*)(lds + 113664 + 2 * 8192);
    bf16_t* TA = (bf16_t*)(lds + 65536);
    bf16_t* NA = (bf16_t*)(lds + 70656);
    float* PC = (float*)(lds + 75776);
    bf16_t* KBm = (bf16_t*)(lds + 76800);
    float* MM = (float*)(lds + 97280);
    float* WA = (float*)(lds + 76800);
    bf16x8 bw[2];
    { const float* W2 = (w >> 2) ? p.in[18] : p.in[15];
#pragma unroll
      for (int ks = 0; ks < 2; ++ks) { float t8[8];
#pragma unroll
        for (int e = 0; e < 8; ++e) t8[e] = W2[(size_t)(z * 64 + ks * 32 + fq0 * 8 + e) * 1024 + hd * 64 + (w & 3) * 16 + fr0];
        bw[ks] = pack8h(t8[0], t8[1], t8[2], t8[3], t8[4], t8[5], t8[6], t8[7]); } }
    f32x4 Sacc[4];
#pragma unroll
    for (int kt = 0; kt < 4; ++kt) Sacc[kt] = (f32x4){0.f, 0.f, 0.f, 0.f};
    if (w >= 4) {
#pragma unroll
        for (int kt = 0; kt < 4; ++kt)
#pragma unroll
            for (int jj = 0; jj < 4; ++jj) Sacc[kt][jj] = (kt * 16 + fq0 * 4 + jj == (w - 4) * 16 + fr0) ? 1.f : 0.f; }
    const int ch = hd * 64 + lane0;
    const float w0c = p.in[13][z * 1024 + ch], a0c = p.in[16][z * 1024 + ch], kkc = p.in[19][ch], kac = p.in[20][ch], rkc = p.in[21][ch];
    bf16_t* RKV = (bf16_t*)(lds + 113664);
    u32x4 tlraw[2], rkvraw[3];
#define WKV_LOAD_RAW(tb_) do { \
        _Pragma("unroll") for (int h_ = 0; h_ < 2; ++h_) { const int idx_ = tid + h_ * NTHR; const int tau_ = idx_ >> 4, sg_ = idx_ & 15; const int t_ = z ? (seqT - 1 - (qbase + (tb_) + tau_)) : (qbase + (tb_) + tau_); \
            tlraw[h_] = *(const u32x4*)(P + (size_t)(tok0 + t_) * N0 + 8192 + (sg_ < 8 ? z * 64 + sg_ * 8 : 128 + z * 64 + (sg_ - 8) * 8)); } \
        { const int tau_ = tid >> 3, sg_ = tid & 7; const int t_ = z ? (seqT - 1 - (qbase + (tb_) + tau_)) : (qbase + (tb_) + tau_); const bf16_t* rp_ = P + (size_t)(tok0 + t_) * N0 + 4096 + hd * 64 + sg_ * 8; \
          rkvraw[0] = *(const u32x4*)rp_; rkvraw[1] = *(const u32x4*)(rp_ + 1024); rkvraw[2] = *(const u32x4*)(rp_ + 2048); } } while (0)
    { const int tid = tid0; WKV_LOAD_RAW(0); }
    __syncthreads();
#pragma unroll 1
    for (int tb = 0; tb < T; tb += 64) {
        int tid = tid0; asm volatile("" : "+v"(tid));
        const int lane = tid & 63, fr = lane & 15, fq = lane >> 4, c = lane;
        const int pcol = ((c >> 5) * 32) + (((c >> 2) & 3) * 8) + (((c >> 4) & 1) * 4) + (c & 3);
#pragma unroll
        for (int h = 0; h < 2; ++h) { const int idx = tid + h * NTHR; const int tau = idx >> 4, sg = idx & 15;
            u32x4 o = tlraw[h];
            if (sg < 8) { o.x = pk2(fast_tanh(bflo(o.x)), fast_tanh(bfhi(o.x))); o.y = pk2(fast_tanh(bflo(o.y)), fast_tanh(bfhi(o.y)));
                          o.z = pk2(fast_tanh(bflo(o.z)), fast_tanh(bfhi(o.z))); o.w = pk2(fast_tanh(bflo(o.w)), fast_tanh(bfhi(o.w))); }
            *(u32x4*)((sg < 8 ? TLW : TLA) + tau * 72 + (sg & 7) * 8) = o; }
#pragma unroll
        for (int h = 0; h < 3; ++h) *(u32x4*)(RKV + h * 4096 + (tid >> 3) * 64 + (tid & 7) * 8) = rkvraw[h];
        lds_barrier();
        if (tb + 64 < T) WKV_LOAD_RAW(tb + 64);
        { const bf16_t* TL = (w >> 2) ? TLA : TLW; float* WAo = WA + (w >> 2) * 64 * 68;
#pragma unroll
          for (int mt = 0; mt < 4; ++mt) { f32x4 acc = (f32x4){0.f, 0.f, 0.f, 0.f};
#pragma unroll
            for (int ks = 0; ks < 2; ++ks) { const bf16x8 a = *(const bf16x8*)(TL + (mt * 16 + fr) * 72 + ks * 32 + fq * 8);
                acc = __builtin_amdgcn_mfma_f32_16x16x32_bf16(a, bw[ks], acc, 0, 0, 0); }
#pragma unroll
            for (int jj = 0; jj < 4; ++jj) WAo[(mt * 16 + fq * 4 + jj) * 68 + (w & 3) * 16 + fr] = acc[jj]; } }
        lds_barrier();
        float kkv[8], kmv[8], bv[8], lwv[8], cum[8], rr[8];
        { float run = 0.f;
#pragma unroll
          for (int i = 0; i < 8; ++i) { const int tau = w * 8 + i; const int t = z ? (seqT - 1 - (qbase + tb + tau)) : (qbase + tb + tau); const int tokg = tok0 + t;
            const float wr_ = w0c + WA[tau * 68 + c], ap = a0c + WA[64 * 68 + tau * 68 + c];
            const float nx = -wr_; const float sp = fmaxf(nx, 0.f) + flog(1.f + fexp(-fabsf(nx)));
            const float lw = -fexp(-sp - 0.5f);
            const float iclr = __builtin_amdgcn_rcpf(1.f + fexp(-ap));
            const float kxi = bf2f(RKV[4096 + tau * 64 + c]); rr[i] = bf2f(RKV[tau * 64 + c]);
            const float kkraw = kxi * kkc;
            const float ssq = wave_sum_fast(kkraw * kkraw);
            const float kk = kkraw * __builtin_amdgcn_rsqf(fmaxf(ssq, 1e-24f));
            const float kmod = kxi * (1.f + (iclr - 1.f) * kac);
            const float bon = wave_sum_lane63(rr[i] * kmod * rkc);
            if (lane == 63) BON[((size_t)z * NTOK + tokg) * 16 + hd] = bon;
            run += lw;
            kkv[i] = kk; kmv[i] = kmod; bv[i] = kk * iclr; lwv[i] = lw; cum[i] = run; }
          HT[w * 64 + c] = run; }
        lds_barrier();
        { const float off = (w & 1) ? HT[(w - 1) * 64 + c] : 0.f; const int cn = w >> 1;
#pragma unroll
          for (int i = 0; i < 8; ++i) { const int tau = w * 8 + i; const int j = (w & 1) * 8 + i;
            const float cm = cum[i] + off;
            const float Pj = fexp(cm), ipj = fexp(-cm), pm1 = fexp(cm - lwv[i]);
            const unsigned kb2 = pk2(-bv[i] * ipj, kmv[i] * ipj);
            KTr[tau * 72 + pcol] = (bf16_t)(kb2 >> 16); BTr[tau * 72 + pcol] = f2bf_hw(bv[i] * ipj);
            const unsigned kr2 = pk2(kkv[i] * pm1, rr[i] * Pj);
            KKH[tau * 72 + pcol] = (bf16_t)(kr2 & 0xFFFFu); RH[tau * 72 + pcol] = (bf16_t)(kr2 >> 16);
            const int sU = (j >> 2) * 8 + (j & 3);
            KBm[(cn * 64 + c) * 40 + sU] = (bf16_t)(kb2 & 0xFFFFu); KBm[(cn * 64 + c) * 40 + sU + 4] = (bf16_t)(kb2 >> 16);
            if (j == 15) PC[cn * 64 + c] = Pj; } }
        lds_barrier();
#pragma unroll
        for (int q2 = 0; q2 < 2; ++q2) { const int id = w * 2 + q2; const int cn = id >> 2, which = id & 3;
          const bf16_t* Am = ((which & 1) ? KTr : BTr) + cn * 16 * 72; const bf16_t* Bm = ((which & 2) ? RH : KKH) + cn * 16 * 72;
          const f32x4 acc = mma_nt(Am, 72, Bm, 72, 64, (f32x4){0.f, 0.f, 0.f, 0.f}, fr, fq);
          f32x4 o;
#pragma unroll
          for (int jj = 0; jj < 4; ++jj) { const int i = fq * 4 + jj, j = fr; const bool keep = (which & 2) ? (i <= j) : (i < j); o[jj] = keep ? acc[jj] : 0.f; }
          *(f32x4*)(MM + (cn * 4 + which) * 256 + fr * 16 + fq * 4) = o; }
        lds_barrier();
        if (w < 4) { const int cn = w, col = lane >> 2, rg = lane & 3;
            const float* MbT = MM + (cn * 4 + 0) * 256 + rg * 4; const float* MkT = MM + (cn * 4 + 1) * 256 + rg * 4;
            float Tc[4], A1[4];
#pragma unroll
            for (int e = 0; e < 4; ++e) { Tc[e] = (rg * 4 + e == col) ? 1.f : 0.f; A1[e] = 0.f; }
#define INV_STEP(l, CTRL) do { const f32x4 mb = *(const f32x4*)(MbT + (l) * 16), mk = *(const f32x4*)(MkT + (l) * 16); \
                const float tl_ = __int_as_float(__builtin_amdgcn_update_dpp(0, __float_as_int(Tc[(l) & 3]), CTRL, 0xF, 0xF, true)); \
                Tc[0] -= mb[0] * tl_; Tc[1] -= mb[1] * tl_; Tc[2] -= mb[2] * tl_; Tc[3] -= mb[3] * tl_; \
                A1[0] += mk[0] * tl_; A1[1] += mk[1] * tl_; A1[2] += mk[2] * tl_; A1[3] += mk[3] * tl_; } while (0)
            INV_STEP(15, 0xFF); INV_STEP(14, 0xFF); INV_STEP(13, 0xFF); INV_STEP(12, 0xFF);
            INV_STEP(11, 0xAA); INV_STEP(10, 0xAA); INV_STEP(9, 0xAA); INV_STEP(8, 0xAA);
            INV_STEP(7, 0x55); INV_STEP(6, 0x55); INV_STEP(5, 0x55); INV_STEP(4, 0x55);
            INV_STEP(3, 0x00); INV_STEP(2, 0x00); INV_STEP(1, 0x00);
#undef INV_STEP
            u32x4 o; o.x = pk2(Tc[0], Tc[1]); o.y = pk2(Tc[2], Tc[3]); o.z = pk2(A1[0], A1[1]); o.w = pk2(A1[2], A1[3]);
            *(u32x4*)(TA + (cn * 16 + col) * 40 + rg * 8) = o; }
        else { const int cn = w - 4, j = lane & 15, ig = lane >> 4;
            const f32x4 nb = *(const f32x4*)(MM + (cn * 4 + 2) * 256 + j * 16 + ig * 4), nk = *(const f32x4*)(MM + (cn * 4 + 3) * 256 + j * 16 + ig * 4);
            u32x4 o; o.x = pk2(-nb[0], -nb[1]); o.y = pk2(-nb[2], -nb[3]); o.z = pk2(nk[0], nk[1]); o.w = pk2(nk[2], nk[3]);
            *(u32x4*)(NA + (cn * 16 + j) * 40 + ig * 8) = o; }
        lds_barrier();
        if (w < 4 || sample) {
            const int vb = w & 3;
#pragma unroll 1
            for (int cn = 0; cn < 4; ++cn) {
                bf16x8 sb[2];
#pragma unroll
                for (int ks = 0; ks < 2; ++ks) sb[ks] = pack8h(Sacc[2 * ks][0], Sacc[2 * ks][1], Sacc[2 * ks][2], Sacc[2 * ks][3], Sacc[2 * ks + 1][0], Sacc[2 * ks + 1][1], Sacc[2 * ks + 1][2], Sacc[2 * ks + 1][3]);
                f32x4 U0 = (f32x4){0.f, 0.f, 0.f, 0.f}, O = (f32x4){0.f, 0.f, 0.f, 0.f};
#pragma unroll
                for (int ks = 0; ks < 2; ++ks) { const bf16x8 a = *(const bf16x8*)(KKH + (cn * 16 + fr) * 72 + ks * 32 + fq * 8);
                    U0 = __builtin_amdgcn_mfma_f32_16x16x32_bf16(a, sb[ks], U0, 0, 0, 0);
                    const bf16x8 ar = *(const bf16x8*)(RH + (cn * 16 + fr) * 72 + ks * 32 + fq * 8);
                    O = __builtin_amdgcn_mfma_f32_16x16x32_bf16(ar, sb[ks], O, 0, 0, 0); }
                float vf[4];
#pragma unroll
                for (int e = 0; e < 4; ++e) vf[e] = (w < 4) ? bf2f(VS[(cn * 16 + fq * 4 + e) * 64 + vb * 16 + fr]) : 0.f;
                const bf16x8 bU0 = pack8h(U0[0], U0[1], U0[2], U0[3], vf[0], vf[1], vf[2], vf[3]);
                const bf16x8 ta = *(const bf16x8*)(TA + (cn * 16 + fr) * 40 + fq * 8);
                const f32x4 U = __builtin_amdgcn_mfma_f32_16x16x32_bf16(ta, bU0, (f32x4){0.f, 0.f, 0.f, 0.f}, 0, 0, 0);
                const bf16x8 bUV = pack8h(U[0], U[1], U[2], U[3], vf[0], vf[1], vf[2], vf[3]);
                const bf16x8 na = *(const bf16x8*)(NA + (cn * 16 + fr) * 40 + fq * 8);
                O = __builtin_amdgcn_mfma_f32_16x16x32_bf16(na, bUV, O, 0, 0, 0);
#pragma unroll
                for (int jj = 0; jj < 4; ++jj) { const int tau = cn * 16 + fq * 4 + jj; const int t = z ? (seqT - 1 - (qbase + tb + tau)) : (qbase + tb + tau);
                    if (w < 4) OD[((size_t)z * NTOK + tok0 + t) * 1024 + hd * 64 + vb * 16 + fr] = f2bf_hw(O[jj]);
                    else RHO[((size_t)z * 4096 + (tok0 - NPTOK) + t) * 1024 + hd * 64 + vb * 16 + fr] = f2bf_hw(O[jj]); }
#pragma unroll
                for (int kt = 0; kt < 4; ++kt) { const bf16x8 kb = *(const bf16x8*)(KBm + (cn * 64 + kt * 16 + fr) * 40 + fq * 8);
                    Sacc[kt] = __builtin_amdgcn_mfma_f32_16x16x32_bf16(kb, bUV, Sacc[kt], 0, 0, 0);
                    const f32x4 pc = *(const f32x4*)(PC + cn * 64 + kt * 16 + fq * 4);
                    Sacc[kt] = Sacc[kt] * pc; }
            }
        }
        lds_barrier();
    }
#undef WKV_LOAD_RAW
    if (!sample) { if (w < 4) { float* so = p.out + (size_t)2 * NPTOK * D + ((size_t)((b * 2 + z) * 16 + hd)) * 4096 + (size_t)(w * 16 + fr0) * 64;
#pragma unroll
        for (int kt = 0; kt < 4; ++kt)
#pragma unroll
            for (int jj = 0; jj < 4; ++jj) so[kt * 16 + fq0 * 4 + jj] = Sacc[kt][jj]; } }
    else { float* so = GH + ((size_t)u * 2 + (w >> 2)) * 4096 + (size_t)((w & 3) * 16 + fr0) * 64;
#pragma unroll
        for (int kt = 0; kt < 4; ++kt)
#pragma unroll
            for (int jj = 0; jj < 4; ++jj) so[kt * 16 + fq0 * 4 + jj] = Sacc[kt][jj]; }
    __syncthreads();
}

__device__ void wkv_fix_unit(const Params& p, int u, float* ldsf) {
    const int tid = threadIdx.x, lane = tid & 63, w = __builtin_amdgcn_readfirstlane(tid >> 6), fr = lane & 15, fq = lane >> 4;
    unsigned char* ws = p.ws;
    bf16_t* OD = (bf16_t*)(ws + WS_X1);
    const bf16_t* RHO = (const bf16_t*)(ws + WS_H);
    const float* GH = (const float*)(ws + WS_BT0);
    const int z = u >> 7, b = (u >> 6) & 1, hd = (u >> 2) & 15, vq = u & 3;
    float* SS = ldsf;
    float* GL = ldsf + 1024;
    bf16_t* SB = (bf16_t*)(ldsf + 1024 + 4096);
    const int v = tid >> 5, kp = (tid & 31) * 2;
    { const float* s0 = p.in[2] + ((size_t)((b * 2 + z) * 16 + hd)) * 4096 + (size_t)(vq * 16 + v) * 64 + kp; SS[v * 64 + kp] = s0[0]; SS[v * 64 + kp + 1] = s0[1]; }
    __syncthreads();
#pragma unroll 1
    for (int sg = 0; sg < 8; ++sg) {
        const int su = ((z * 2 + b) * 16 + hd) * 8 + sg;
        SB[v * 72 + kp] = f2bf_hw(SS[v * 64 + kp]); SB[v * 72 + kp + 1] = f2bf_hw(SS[v * 64 + kp + 1]);
        if (sg < 7) { const f32x4* gsrc = (const f32x4*)(GH + ((size_t)su * 2 + 1) * 4096);
#pragma unroll
            for (int q = 0; q < 2; ++q) ((f32x4*)GL)[tid + q * NTHR] = gsrc[tid + q * NTHR]; }
        __syncthreads();
        const int tlo = z ? (2048 - (sg + 1) * 256) : sg * 256;
#pragma unroll
        for (int q = 0; q < 2; ++q) { const int mt = 2 * w + q;
            f32x4 acc = (f32x4){0.f, 0.f, 0.f, 0.f};
#pragma unroll
            for (int ks = 0; ks < 2; ++ks) { const bf16x8 a = *(const bf16x8*)(RHO + ((size_t)z * 4096 + b * 2048 + tlo + mt * 16 + fr) * 1024 + hd * 64 + ks * 32 + fq * 8);
                const bf16x8 bb = *(const bf16x8*)(SB + fr * 72 + ks * 32 + fq * 8);
                acc = __builtin_amdgcn_mfma_f32_16x16x32_bf16(a, bb, acc, 0, 0, 0); }
#pragma unroll
            for (int jj = 0; jj < 4; ++jj) { bf16_t* op = OD + ((size_t)z * NTOK + NPTOK + b * 2048 + tlo + mt * 16 + fq * 4 + jj) * 1024 + hd * 64 + vq * 16 + fr;
                *op = f2bf_hw(bf2f(*op) + acc[jj]); } }
        if (sg < 7) {
            const float* hsrc = GH + ((size_t)su * 2 + 0) * 4096 + (size_t)(vq * 16 + v) * 64 + kp;
            float a0 = hsrc[0], a1 = hsrc[1];
#pragma unroll 8
            for (int k2 = 0; k2 < 64; ++k2) { const float sv = SS[v * 64 + k2]; a0 += sv * GL[k2 * 64 + kp]; a1 += sv * GL[k2 * 64 + kp + 1]; }
            __syncthreads();
            SS[v * 64 + kp] = a0; SS[v * 64 + kp + 1] = a1;
        }
        __syncthreads();
    }
}
__device__ void phase_wkv_fix(const Params& p, float* lds) {
    for (int it = blockIdx.x; it < 256; it += gridDim.x) wkv_fix_unit(p, it, lds);
}

__device__ void conv_tile(const Params& p, int tile) {
    const int tid = threadIdx.x;
    unsigned char* ws = p.ws;
    const bf16_t* P = (const bf16_t*)(ws + WS_P);
    bf16_t* OC = (bf16_t*)(ws + WS_OC);
    const int cgp = tid & 127, c0 = cgp * 8, sub = tid >> 7;
    float cw0[8], cw1[8], cw2[8];
#pragma unroll
    for (int j = 0; j < 8; ++j) { cw0[j] = p.in[12][c0 + j]; cw1[j] = p.in[12][1024 + c0 + j]; cw2[j] = p.in[12][2048 + c0 + j]; }
    for (int jj = 0; jj < 4; ++jj) {
        const int t = tile * 16 + sub + 4 * jj;
        const int rl = t < NPTOK ? 256 : 64; const int pos = t & (rl - 1);
        const bf16_t* row = P + (size_t)t * N0;
        const u32x4 z4 = (u32x4){0u, 0u, 0u, 0u};
        const u32x4 u1 = *(const u32x4*)(row + c0), g1 = *(const u32x4*)(row + 2048 + c0);
        const u32x4 u0 = pos > 0 ? *(const u32x4*)(row - N0 + c0) : z4, g0 = pos > 0 ? *(const u32x4*)(row - N0 + 2048 + c0) : z4;
        const u32x4 u2 = pos < rl - 1 ? *(const u32x4*)(row + N0 + c0) : z4, g2 = pos < rl - 1 ? *(const u32x4*)(row + N0 + 2048 + c0) : z4;
        const u32x4 gb = *(const u32x4*)(row + 1024 + c0), zc = *(const u32x4*)(row + 3072 + c0);
        u32x4 o;
#pragma unroll
        for (int q = 0; q < 4; ++q) {
            const float y0 = cw0[2 * q] * (bflo(g0[q]) * bflo(u0[q])) + cw1[2 * q] * (bflo(g1[q]) * bflo(u1[q])) + cw2[2 * q] * (bflo(g2[q]) * bflo(u2[q]));
            const float y1 = cw0[2 * q + 1] * (bfhi(g0[q]) * bfhi(u0[q])) + cw1[2 * q + 1] * (bfhi(g1[q]) * bfhi(u1[q])) + cw2[2 * q + 1] * (bfhi(g2[q]) * bfhi(u2[q]));
            o[q] = pack2(silu(bflo(zc[q])) * bflo(gb[q]) * y0, silu(bfhi(zc[q])) * bfhi(gb[q]) * y1);
        }
        *(u32x4*)(OC + (size_t)t * 2048 + c0) = o;
    }
}

__device__ void phase_mix0(const Params& p, float* lds, int rep) {
    unsigned* ctr = (unsigned*)(p.ws + WS_CTL) + rep * 32;
    int* slot = (int*)(lds + LDS_MAIN / 4);
    constexpr int NSCAN = 1024, NCONV = 512;
    for (;;) {
        if (threadIdx.x == 0) *slot = (int)atomicAdd(ctr, 1u);
        __syncthreads();
        const int it = *slot;
        __syncthreads();
        if (it >= NSCAN + NCONV) break;
        if (it < NSCAN) wkv_unit(p, it, lds); else conv_tile(p, it - NSCAN);
    }
}

__device__ __forceinline__ float quad_sum(float v) {
    v += __int_as_float(__builtin_amdgcn_update_dpp(0, __float_as_int(v), 0xB1, 0xF, 0xF, true));
    v += __int_as_float(__builtin_amdgcn_update_dpp(0, __float_as_int(v), 0x4E, 0xF, 0xF, true));
    return v;
}
__device__ void phase_wkv_post(const Params& p) {
    const int tid = threadIdx.x, wave = tid >> 6, lane = tid & 63;
    unsigned char* ws = p.ws;
    const bf16_t* P = (const bf16_t*)(ws + WS_P);
    const bf16_t* OD = (const bf16_t*)(ws + WS_X1);
    const float* BON = (const float*)(ws + WS_BON);
    bf16_t* OC = (bf16_t*)(ws + WS_OC);
    const int hh = lane >> 2, ch0 = hh * 64 + (lane & 3) * 16;
    for (int tok = blockIdx.x * 8 + wave; tok < NTOK; tok += gridDim.x * 8) {
        const bf16_t* row = P + (size_t)tok * N0;
        u32x4 a0[2], a1[2], vv[2], zz[2];
#pragma unroll
        for (int h = 0; h < 2; ++h) { a0[h] = *(const u32x4*)(OD + (size_t)tok * 1024 + ch0 + h * 8); a1[h] = *(const u32x4*)(OD + ((size_t)NTOK + tok) * 1024 + ch0 + h * 8);
            vv[h] = *(const u32x4*)(row + 6144 + ch0 + h * 8); zz[h] = *(const u32x4*)(row + 7168 + ch0 + h * 8); }
        const float bon = BON[(size_t)tok * 16 + hh] + BON[((size_t)NTOK + tok) * 16 + hh];
        float o[16]; float s1 = 0.f;
#pragma unroll
        for (int h = 0; h < 2; ++h)
#pragma unroll
            for (int q = 0; q < 4; ++q) { o[h * 8 + 2 * q] = bflo(a0[h][q]) + bflo(a1[h][q]); o[h * 8 + 2 * q + 1] = bfhi(a0[h][q]) + bfhi(a1[h][q]); s1 += o[h * 8 + 2 * q] + o[h * 8 + 2 * q + 1]; }
        const float mu = quad_sum(s1) * (1.f / 64.f);
        float s2 = 0.f;
#pragma unroll
        for (int i = 0; i < 16; ++i) { o[i] -= mu; s2 += o[i] * o[i]; }
        const float rs = rsqrtf(quad_sum(s2) * (1.f / 64.f) + 64e-5f);
        float res[16];
#pragma unroll
        for (int g4 = 0; g4 < 4; ++g4) { const f32x4 lw4 = *(const f32x4*)(p.in[22] + ch0 + g4 * 4), lb4 = *(const f32x4*)(p.in[23] + ch0 + g4 * 4);
#pragma unroll
            for (int e = 0; e < 4; ++e) { const int i = g4 * 4 + e; const unsigned vw = vv[i >> 3][(i & 7) >> 1], zw_ = zz[i >> 3][(i & 7) >> 1];
                const float v1 = (i & 1) ? bfhi(vw) : bflo(vw), z1 = (i & 1) ? bfhi(zw_) : bflo(zw_);
                res[i] = (o[i] * rs * lw4[e] + lb4[e] + bon * v1) * silu(z1); } }
#pragma unroll
        for (int h = 0; h < 2; ++h) { u32x4 w4; w4.x = pk2(res[h * 8 + 0], res[h * 8 + 1]); w4.y = pk2(res[h * 8 + 2], res[h * 8 + 3]); w4.z = pk2(res[h * 8 + 4], res[h * 8 + 5]); w4.w = pk2(res[h * 8 + 6], res[h * 8 + 7]);
            *(u32x4*)(OC + (size_t)tok * 2048 + 1024 + ch0 + h * 8) = w4; }
    }
}

constexpr size_t WS_QE = WS_H;
constexpr size_t WS_KDT = WS_BT0;
constexpr size_t WS_VT = WS_OC + (size_t)NTOK * 1024 * 2;
constexpr size_t WS_EBL = WS_BON + (size_t)2 * NTOK * 16 * 4;
constexpr size_t WS_ATT = WS_P + 52 * MB;

__device__ void gla_a_item(const Params& p, int item, float* ldsf) {
    const int tid = threadIdx.x, lane = tid & 63, w = __builtin_amdgcn_readfirstlane(tid >> 6), fr = lane & 15, fq = lane >> 4;
    unsigned char* ws = p.ws;
    const bf16_t* P1 = (const bf16_t*)(ws + WS_P);
    float* OD = (float*)(ws + WS_P2);
    bf16_t* QEg = (bf16_t*)(ws + WS_QE); bf16_t* KDTg = (bf16_t*)(ws + WS_KDT); bf16_t* VTg = (bf16_t*)(ws + WS_VT); float* EBLg = (float*)(ws + WS_EBL);
    const int hd = item & 3, c = (item >> 2) & 127, z = item >> 9, tok0 = c * 64;
    bf16_t* QE = (bf16_t*)ldsf;
    bf16_t* KE = QE + 64 * 136;
    bf16_t* VT = KE + 64 * 136;
    bf16_t* ATT = VT + 256 * 72;
    float* G = (float*)(ATT + 64 * 72);
    float* L1G = G + 64 * 132;
    float* GK2 = L1G + 1024;
    for (int i = tid; i < 1024; i += NTHR) { const int t = i >> 4, r = i & 15; L1G[i] = bf2f(P1[(size_t)(tok0 + t) * N1 + 3072 + z * 16 + r]); }
    for (int i = tid; i < 2048; i += NTHR) { const int r = i >> 7, d = i & 127; GK2[i] = p.in[27][(size_t)(z * 16 + r) * 512 + hd * 128 + d]; }
#pragma unroll
    for (int ps = 0; ps < 4; ++ps) { const int t = lane, e8 = (ps * 8 + w) * 8;
        const u32x4 v8 = *(const u32x4*)(P1 + (size_t)(tok0 + t) * N1 + 1024 + hd * 256 + e8);
        VT[(e8 + 0) * 72 + t] = (bf16_t)(v8.x & 0xFFFF); VT[(e8 + 1) * 72 + t] = (bf16_t)(v8.x >> 16); VT[(e8 + 2) * 72 + t] = (bf16_t)(v8.y & 0xFFFF); VT[(e8 + 3) * 72 + t] = (bf16_t)(v8.y >> 16);
        VT[(e8 + 4) * 72 + t] = (bf16_t)(v8.z & 0xFFFF); VT[(e8 + 5) * 72 + t] = (bf16_t)(v8.z >> 16); VT[(e8 + 6) * 72 + t] = (bf16_t)(v8.w & 0xFFFF); VT[(e8 + 7) * 72 + t] = (bf16_t)(v8.w >> 16); }
    const int d = tid & 127, tq = tid >> 7;
    const float gbias = p.in[28][z * 512 + hd * 128 + d];
    bf16_t qraw[16], kraw[16];
#pragma unroll
    for (int i = 0; i < 16; ++i) { const size_t row = (size_t)(tok0 + tq * 16 + i) * N1; qraw[i] = P1[row + hd * 128 + d]; kraw[i] = P1[row + 512 + hd * 128 + d]; }
    __syncthreads();
    { float run = 0.f;
#pragma unroll 4
      for (int i = 0; i < 16; ++i) { const int t = z ? (tq * 16 + 15 - i) : (tq * 16 + i);
        float x = gbias;
#pragma unroll
        for (int r = 0; r < 16; ++r) x += L1G[t * 16 + r] * GK2[r * 128 + d];
        const float ls = fminf(x, 0.f) - flog(1.f + fexp(-fabsf(x)));
        run += ls * (1.f / 16.f);
        G[t * 132 + d] = run; } }
    __syncthreads();
    { const int lastr = z ? 0 : 15;
      const float t0 = G[(0 + lastr) * 132 + d], t1 = G[(16 + lastr) * 132 + d], t2 = G[(32 + lastr) * 132 + d], t3 = G[(48 + lastr) * 132 + d];
      const float blast = t0 + t1 + t2 + t3;
      float off;
      if (z == 0) off = tq == 0 ? 0.f : (tq == 1 ? t0 : (tq == 2 ? t0 + t1 : t0 + t1 + t2));
      else off = tq == 3 ? 0.f : (tq == 2 ? t3 : (tq == 1 ? t3 + t2 : t3 + t2 + t1));
      if (tq == 0) EBLg[(size_t)(z * 128 + c) * 512 + hd * 128 + d] = fexp(blast);
      unsigned kdp[8];
#pragma unroll
      for (int i = 0; i < 16; ++i) { const int t = tq * 16 + i;
        const float bc = G[t * 132 + d] + off;
        const float q = bf2f(qraw[i]) * 0.08838834764831845f, k = bf2f(kraw[i]);
        const bf16_t qe = f2bf(q * fexp(bc));
        QE[t * 136 + d] = qe; KE[t * 136 + d] = f2bf(k * fexp(-bc));
        const unsigned kd = (unsigned)f2bf(k * fexp(blast - bc));
        if (i & 1) kdp[i >> 1] |= kd << 16; else kdp[i >> 1] = kd; }
      bf16_t* kdst = KDTg + ((size_t)(((z * 128 + c) * 4 + hd) * 128 + d)) * 64 + tq * 16;
      *(u32x4*)kdst = (u32x4){kdp[0], kdp[1], kdp[2], kdp[3]}; *(u32x4*)(kdst + 8) = (u32x4){kdp[4], kdp[5], kdp[6], kdp[7]}; }
    __syncthreads();
#pragma unroll
    for (int q2 = 0; q2 < 2; ++q2) { const int idx = q2 * NTHR + tid; const int t = idx >> 4, d8 = (idx & 15) * 8;
        *(u32x4*)(QEg + ((size_t)z * NTOK + tok0 + t) * 512 + hd * 128 + d8) = *(const u32x4*)(QE + t * 136 + d8); }
    if (z == 0) {
#pragma unroll
        for (int q4 = 0; q4 < 4; ++q4) { const int idx = q4 * NTHR + tid; const int e = idx >> 3, t8 = (idx & 7) * 8;
            *(u32x4*)(VTg + ((size_t)((c * 4 + hd) * 256 + e)) * 64 + t8) = *(const u32x4*)(VT + e * 72 + t8); } }
#pragma unroll
    for (int q2 = 0; q2 < 2; ++q2) { const int tA = 2 * w + q2, ia = tA >> 2, ja = tA & 3;
        f32x4 a4 = (f32x4){0.f, 0.f, 0.f, 0.f};
        if (z ? (ja >= ia) : (ja <= ia)) a4 = mma_nt(QE + ia * 16 * 136, 136, KE + ja * 16 * 136, 136, 128, a4, fr, fq);
#pragma unroll
        for (int jj = 0; jj < 4; ++jj) { const int i = ia * 16 + fq * 4 + jj, j = ja * 16 + fr; const bool keep = z ? (j >= i) : (j <= i); ATT[i * 72 + j] = f2bf(keep ? a4[jj] : 0.f); } }
    __syncthreads();
    { bf16_t* ATTg = (bf16_t*)(ws + WS_ATT) + ((size_t)((z * 128 + c) * 4 + hd)) * 4096;
      const int i = tid >> 3, j8 = (tid & 7) * 8;
      *(u32x4*)(ATTg + i * 64 + j8) = *(const u32x4*)(ATT + i * 72 + j8); }
    __syncthreads();
}

__device__ void phase_gla_a(const Params& p, float* lds) {
    for (int it = blockIdx.x; it < 1024; it += gridDim.x) gla_a_item(p, it, lds);
}

struct GlaFrags { bf16x8 kdt[2]; u32x4 vts; u32x4 qes[2]; bf16x8 att[2]; f32x4 ebl; };

__device__ void gla_b_unit(const Params& p, int u, float* ldsf) {
    const int tid = threadIdx.x, lane = tid & 63, w = __builtin_amdgcn_readfirstlane(tid >> 6), fr = lane & 15, fq = lane >> 4;
    unsigned char* ws = p.ws;
    float* OD = (float*)(ws + WS_P2);
    const bf16_t* QEg = (const bf16_t*)(ws + WS_QE); const bf16_t* KDTg = (const bf16_t*)(ws + WS_KDT); const bf16_t* VTg = (const bf16_t*)(ws + WS_VT); const float* EBLg = (const float*)(ws + WS_EBL);
    const bf16_t* ATTg = (const bf16_t*)(ws + WS_ATT);
    int z, b, hd, eq, nch, ch0; bool sample;
    if (u < 64) { sample = true; z = u >> 5; b = (u >> 4) & 1; hd = (u >> 2) & 3; eq = u & 3; nch = 32; ch0 = 64 + b * 32; }
    else { const int q = u - 64; sample = false; z = q >> 8; b = (q >> 4) & 15; hd = (q >> 2) & 3; eq = q & 3; nch = 4; ch0 = b * 4; }
    bf16_t* ST = (bf16_t*)ldsf;
    bf16_t* VTL = ST + 2 * 64 * 136;
    bf16_t* QEL = VTL + 2 * 64 * 72;
    f32x4 Sacc[4];
    if (sample) { const float* s0 = p.in[3] + ((size_t)((b * 2 + z) * 4 + hd)) * 32768 + eq * 64 + fr;
#pragma unroll
        for (int et = 0; et < 4; ++et)
#pragma unroll
            for (int jj = 0; jj < 4; ++jj) Sacc[et][jj] = s0[(size_t)(w * 16 + fq * 4 + jj) * 256 + et * 16]; }
    else {
#pragma unroll
        for (int et = 0; et < 4; ++et) Sacc[et] = (f32x4){0.f, 0.f, 0.f, 0.f}; }
    const int it = w >> 1, e2 = (w & 1) * 2;
    const int ve = tid >> 3, vt8 = (tid & 7) * 8;
#define GLB_LOAD(F, c_) do { const int cc_ = (c_); \
        _Pragma("unroll") for (int ks = 0; ks < 2; ++ks) { (F).kdt[ks] = *(const bf16x8*)(KDTg + ((size_t)(((z * 128 + cc_) * 4 + hd) * 128 + w * 16 + fr)) * 64 + ks * 32 + fq * 8); \
            (F).att[ks] = *(const bf16x8*)(ATTg + ((size_t)((z * 128 + cc_) * 4 + hd)) * 4096 + (it * 16 + fr) * 64 + ks * 32 + fq * 8); } \
        (F).vts = *(const u32x4*)(VTg + ((size_t)((cc_ * 4 + hd) * 256 + eq * 64 + ve)) * 64 + vt8); \
        _Pragma("unroll") for (int h_ = 0; h_ < 2; ++h_) (F).qes[h_] = *(const u32x4*)(QEg + ((size_t)z * NTOK + cc_ * 64 + ve) * 512 + hd * 128 + h_ * 64 + vt8); \
        (F).ebl = *(const f32x4*)(EBLg + (size_t)(z * 128 + cc_) * 512 + hd * 128 + w * 16 + fq * 4); } while (0)
#define GLB_STEP(CUR, NX2, ci_) do { const int ci = (ci_); if (ci < nch) { \
        const int c = ch0 + (z ? nch - 1 - ci : ci); \
        bf16_t* STc = ST + (ci & 1) * 64 * 136; bf16_t* VTc = VTL + (ci & 1) * 64 * 72; \
        _Pragma("unroll") for (int et = 0; et < 4; ++et) { u32x2 v2; v2.x = pk2(Sacc[et][0], Sacc[et][1]); v2.y = pk2(Sacc[et][2], Sacc[et][3]); \
            *(u32x2*)(STc + (et * 16 + fr) * 136 + w * 16 + fq * 4) = v2; } \
        *(u32x4*)(VTc + ve * 72 + vt8) = (CUR).vts; \
        bf16_t* QEc = QEL + (ci & 1) * 64 * 136; \
        *(u32x4*)(QEc + ve * 136 + vt8) = (CUR).qes[0]; *(u32x4*)(QEc + ve * 136 + 64 + vt8) = (CUR).qes[1]; \
        if (ci + 2 < nch) GLB_LOAD(NX2, ch0 + (z ? nch - 3 - ci : ci + 2)); \
        lds_barrier(); \
        _Pragma("unroll") for (int et = 0; et < 4; ++et) { Sacc[et] = Sacc[et] * (CUR).ebl; \
            _Pragma("unroll") for (int ks = 0; ks < 2; ++ks) { const bf16x8 vf = *(const bf16x8*)(VTc + (et * 16 + fr) * 72 + ks * 32 + fq * 8); \
                Sacc[et] = __builtin_amdgcn_mfma_f32_16x16x32_bf16((CUR).kdt[ks], vf, Sacc[et], 0, 0, 0); } } \
        _Pragma("unroll") for (int q2 = 0; q2 < 2; ++q2) { f32x4 o = (f32x4){0.f, 0.f, 0.f, 0.f}; \
            _Pragma("unroll") for (int ks = 0; ks < 2; ++ks) { const bf16x8 vf = *(const bf16x8*)(VTc + ((e2 + q2) * 16 + fr) * 72 + ks * 32 + fq * 8); \
                o = __builtin_amdgcn_mfma_f32_16x16x32_bf16((CUR).att[ks], vf, o, 0, 0, 0); } \
            _Pragma("unroll") for (int ks = 0; ks < 4; ++ks) { const bf16x8 bS = *(const bf16x8*)(STc + ((e2 + q2) * 16 + fr) * 136 + ks * 32 + fq * 8); \
                const bf16x8 aq = *(const bf16x8*)(QEc + (it * 16 + fr) * 136 + ks * 32 + fq * 8); \
                o = __builtin_amdgcn_mfma_f32_16x16x32_bf16(aq, bS, o, 0, 0, 0); } \
            _Pragma("unroll") for (int jj = 0; jj < 4; ++jj) OD[((size_t)z * NTOK + c * 64 + it * 16 + fq * 4 + jj) * 1024 + hd * 256 + eq * 64 + (e2 + q2) * 16 + fr] = o[jj]; } } } while (0)
    GlaFrags fa, fb, fc;
    GLB_LOAD(fa, ch0 + (z ? nch - 1 : 0));
    GLB_LOAD(fb, ch0 + (z ? nch - 2 : 1));
    __syncthreads();
#pragma unroll 1
    for (int ci3 = 0; ci3 < nch; ci3 += 3) { GLB_STEP(fa, fc, ci3); GLB_STEP(fb, fa, ci3 + 1); GLB_STEP(fc, fb, ci3 + 2); }
#undef GLB_STEP
#undef GLB_LOAD
    if (!sample) { float* so = p.out + (size_t)2 * NPTOK * D + 2097152 + ((size_t)((b * 2 + z) * 4 + hd)) * 32768 + eq * 64 + fr;
#pragma unroll
        for (int et = 0; et < 4; ++et)
#pragma unroll
            for (int jj = 0; jj < 4; ++jj) so[(size_t)(w * 16 + fq * 4 + jj) * 256 + et * 16] = Sacc[et][jj]; }
    __syncthreads();
}

__device__ void phase_gla_b(const Params& p, float* lds, int rep) {
    unsigned* ctr = (unsigned*)(p.ws + WS_CTL) + 16 + rep * 32;
    int* slot = (int*)(lds + LDS_MAIN / 4);
    for (;;) {
        if (threadIdx.x == 0) *slot = (int)atomicAdd(ctr, 1u);
        __syncthreads();
        const int it = *slot;
        __syncthreads();
        if (it >= 576) break;
        gla_b_unit(p, it, lds);
    }
}

__device__ void phase_gla_post(const Params& p) {
    const int tid = threadIdx.x, wave = tid >> 6, lane = tid & 63;
    unsigned char* ws = p.ws;
    const bf16_t* P1 = (const bf16_t*)(ws + WS_P);
    const float* OD = (const float*)(ws + WS_P2);
    bf16_t* OG = (bf16_t*)(ws + WS_OC);
    for (int tok = blockIdx.x * 8 + wave; tok < NTOK; tok += gridDim.x * 8) {
        for (int hd = 0; hd < 4; ++hd) { const int idx = hd * 256 + lane * 4;
            const f32x4 a = *(const f32x4*)(OD + (size_t)tok * 1024 + idx), b2 = *(const f32x4*)(OD + ((size_t)NTOK + tok) * 1024 + idx);
            const f32x4 o = a + b2;
            const float ss = wave_sum(o[0] * o[0] + o[1] * o[1] + o[2] * o[2] + o[3] * o[3]);
            const float rs = rsqrtf(ss * (1.f / 256.f) + 1e-6f);
            const f32x4 gn = *(const f32x4*)(p.in[29] + lane * 4);
            const u32x2 zz = *(const u32x2*)(P1 + (size_t)tok * N1 + 2048 + idx);
            const float z0 = bflo(zz.x), z1 = bfhi(zz.x), z2 = bflo(zz.y), z3 = bfhi(zz.y);
            u32x2 w; w.x = pack2(o[0] * rs * gn[0] * silu(z0), o[1] * rs * gn[1] * silu(z1)); w.y = pack2(o[2] * rs * gn[2] * silu(z2), o[3] * rs * gn[3] * silu(z3));
            *(u32x2*)(OG + (size_t)tok * 1024 + idx) = w; }
    }
}

__device__ void phase_final(const Params& p) {
    const int tid = threadIdx.x, wave = tid >> 6, lane = tid & 63;
    unsigned char* ws = p.ws;
    const float* MOD = (const float*)(ws + WS_MOD);
    const float* X1 = (const float*)(ws + WS_X1);
    const float* Y = (const float*)(ws + WS_P2);
    for (int tok = blockIdx.x * 8 + wave; tok < NTOK; tok += gridDim.x * 8) {
        const int cond = tok < NPTOK ? 0 : 1 + ((tok - NPTOK) >> 11);
        f32x4 xv[4]; float ss = 0.f;
#pragma unroll
        for (int i = 0; i < 4; ++i) { const int idx = i * 256 + lane * 4;
            const f32x4 x1 = *(const f32x4*)(X1 + (size_t)tok * D + idx);
            const f32x4 ya = *(const f32x4*)(Y + (size_t)tok * D + idx), yb = *(const f32x4*)(Y + (size_t)NTOK * D + (size_t)tok * D + idx);
            const f32x4 gt = *(const f32x4*)(MOD + (1 * 3 + cond) * 3072 + 2048 + idx);
            xv[i] = x1 + gt * (ya + yb);
            ss += xv[i][0] * xv[i][0] + xv[i][1] * xv[i][1] + xv[i][2] * xv[i][2] + xv[i][3] * xv[i][3]; }
        ss = wave_sum(ss);
        const float rstd = rsqrtf(ss * (1.f / 1024.f) + 1e-6f);
#pragma unroll
        for (int i = 0; i < 4; ++i) { const int idx = i * 256 + lane * 4;
            const f32x4 g = *(const f32x4*)(p.in[9] + idx);
            f32x4 o;
#pragma unroll
            for (int j = 0; j < 4; ++j) o[j] = xv[i][j] * rstd * g[j];
            *(f32x4*)(p.out + (size_t)tok * D + idx) = o; }
    }
}


#define XB_TMO      128
#define XB_XCNT(j)  (256  + 64 * (j))
#define XB_XSUB(j)  (1280 + 64 * (j))
#define XB_XGEN(j)  (2304 + 64 * (j))
#define XB_TOP      3328
#define XB_TOPGEN   3392
#define XCD_BAR_WORDS 3456
#define XB_SPIN_CAP (1u << 18)

__device__ __forceinline__ unsigned xb_ld(unsigned* p)              { return __hip_atomic_load(p, __ATOMIC_RELAXED, __HIP_MEMORY_SCOPE_AGENT); }
__device__ __forceinline__ unsigned xb_add(unsigned* p, unsigned v) { return __hip_atomic_fetch_add(p, v, __ATOMIC_RELAXED, __HIP_MEMORY_SCOPE_AGENT); }
__device__ __forceinline__ unsigned xb_xcc_id() { return (unsigned)__builtin_amdgcn_s_getreg((3 << 11) | 20) & 0xFu; }
#define XB_SPIN(cond, bar) do { unsigned _sp = 0; while (cond) { __builtin_amdgcn_s_sleep(1); \
    if ((++_sp & 255u) == 0u) { if (xb_ld(&(bar)[XB_TMO])) break; if (_sp > XB_SPIN_CAP) { atomicAdd(&(bar)[XB_TMO], 1u); break; } } } } while (0)

struct XcdBarrier {
    unsigned* bar; unsigned x;
    volatile LAS unsigned* st;
};

__device__ __forceinline__ XcdBarrier xcd_barrier_post(unsigned* bar, volatile LAS unsigned* st) {
    XcdBarrier b; b.bar = bar; b.x = xb_xcc_id(); b.st = st;
    if (threadIdx.x == 0) (void)xb_add(&bar[XB_XCNT(b.x)], 1u);
    return b;
}
__device__ __forceinline__ void xcd_barrier_complete(unsigned* bar, unsigned x, unsigned& nloc, unsigned& nx) {
    const unsigned G = gridDim.x * gridDim.y * gridDim.z;
    unsigned sum, cnt, mine, sp = 0u;
    for (;;) {
        sum = 0u; cnt = 0u; mine = 0u;
#pragma unroll
        for (unsigned j = 0; j < 16; ++j) { const unsigned c = xb_ld(&bar[XB_XCNT(j)]); sum += c; cnt += (c > 0u) ? 1u : 0u; mine = (j == x) ? c : mine; }
        if (sum == G) break;
        __builtin_amdgcn_s_sleep(1);
        if ((++sp & 255u) == 0u) { if (xb_ld(&bar[XB_TMO])) break; if (sp > XB_SPIN_CAP) { atomicAdd(&bar[XB_TMO], 1u); break; } }
    }
    nloc = mine > 0u ? mine : 1u; nx = cnt > 0u ? cnt : 1u;
}

__device__ __forceinline__ void xcd_barrier(const XcdBarrier& b) {
    asm volatile("s_waitcnt vmcnt(0)" ::: "memory");
    __syncthreads();
    if (threadIdx.x == 0) {
        unsigned* bar = b.bar;
        __builtin_amdgcn_s_waitcnt(0);
        unsigned nloc = b.st[0], nx = b.st[1];
        if (nloc == 0u) { xcd_barrier_complete(bar, b.x, nloc, nx); b.st[0] = nloc; b.st[1] = nx; }
        const unsigned old = xb_add(&bar[XB_XSUB(b.x)], 1u);
        const unsigned gen = old / nloc;
        if (old + 1u == (gen + 1u) * nloc) {
            __builtin_amdgcn_fence(__ATOMIC_RELEASE, "agent");
            asm volatile("s_waitcnt vmcnt(0)" ::: "memory");
            const unsigned og = xb_add(&bar[XB_TOP], 1u);
            const unsigned tg = og / nx;
            if (og + 1u == (tg + 1u) * nx) xb_add(&bar[XB_TOPGEN], 1u);
            else XB_SPIN(xb_ld(&bar[XB_TOPGEN]) == tg, bar);
            __builtin_amdgcn_fence(__ATOMIC_ACQUIRE, "agent");
            xb_add(&bar[XB_XGEN(b.x)], 1u);
            asm volatile("s_waitcnt vmcnt(0)" ::: "memory");
        } else {
            XB_SPIN(xb_ld(&bar[XB_XGEN(b.x)]) == gen, bar);
            __builtin_amdgcn_fence(__ATOMIC_ACQUIRE, "agent");
            asm volatile("s_waitcnt vmcnt(0)" ::: "memory");
        }
    }
    __syncthreads();
}


constexpr int NPHASE = 14;
__global__ void __launch_bounds__(NTHR, 2) fwd_megakernel(Params p) {
    extern __shared__ __attribute__((aligned(16))) unsigned char smem[];
    float* ldsf = (float*)smem;
    LAS unsigned char* ldsl = (LAS unsigned char*)smem;
    unsigned char* ws = p.ws;
    volatile LAS unsigned* xst = (volatile LAS unsigned*)(ldsl + LDS_MAIN + 16);
    if (threadIdx.x == 0) { xst[0] = 0u; xst[1] = 0u; }
    __syncthreads();
    const XcdBarrier xbar = xcd_barrier_post((unsigned*)(ws + WS_BAR), xst);
    if (p.ph_lo < 0) cg::this_grid().sync();
#ifndef DUP_PHASE
#define DUP_PHASE -1
#endif
#define PHASE(n) if (p.ph_lo <= (n) && (n) < p.ph_hi && ((n) == p.ph_lo || (xcd_barrier(xbar), true))) for (int rep = 0; rep < ((n) == DUP_PHASE ? 2 : 1); ++rep, ((n) == DUP_PHASE ? (xcd_barrier(xbar), 0) : 0))
    PHASE(0) phase_prologue(p, ldsf);
    PHASE(1) phase_h(p, 0, ldsf);
    PHASE(2) { pg8::Gemm g{(const bf16_t*)(ws + WS_H), (const bf16_t*)(ws + WS_BT0), NTOK, 8192, 1024, 1024, 1}; pg8::Order S; S.init(NTOK, 8192, 1, gridDim.x, blockIdx.x);
               pg8::EpiBf16 E{(bf16_t*)(ws + WS_P), N0}; pg8::gemm_phase(ldsl, g, S, E); }
    PHASE(3) phase_mix0(p, ldsf, rep);
    PHASE(4) phase_wkv_fix(p, ldsf);
    PHASE(5) phase_wkv_post(p);
    PHASE(6) { pg8::Gemm g{(const bf16_t*)(ws + WS_OC), (const bf16_t*)(ws + WS_WT0O), NTOK, 1024, 1024, 2048, 2}; pg8::Order S; S.init(NTOK, 1024, 2, gridDim.x, blockIdx.x);
               pg8::EpiF32 E{(float*)(ws + WS_P), 1024, (size_t)NTOK * 1024}; pg8::gemm_phase(ldsl, g, S, E); }
    PHASE(7) phase_h(p, 1, ldsf);
    PHASE(8) { pg8::Gemm g{(const bf16_t*)(ws + WS_H), (const bf16_t*)(ws + WS_BT1), NTOK, N1, 1024, 1024, 1}; pg8::Order S; S.init(NTOK, N1, 1, gridDim.x, blockIdx.x);
               pg8::EpiBf16 E{(bf16_t*)(ws + WS_P), N1}; pg8::gemm_phase(ldsl, g, S, E); }
    PHASE(9) phase_gla_a(p, ldsf);
    PHASE(10) phase_gla_b(p, ldsf, rep);
    PHASE(11) phase_gla_post(p);
    PHASE(12) { pg8::Gemm g{(const bf16_t*)(ws + WS_OC), (const bf16_t*)(ws + WS_WT1O), NTOK, 1024, 512, 1024, 2}; pg8::Order S; S.init(NTOK, 1024, 2, gridDim.x, blockIdx.x);
                pg8::EpiF32 E{(float*)(ws + WS_P2), 1024, (size_t)NTOK * 1024}; pg8::gemm_phase(ldsl, g, S, E); }
    PHASE(13) phase_final(p);
}

extern "C" void kernel_launch(void* const* d_in, const int* in_sizes, int n_in, void* d_out, int out_size, void* d_ws, size_t ws_size, hipStream_t stream) {
    static int grid = 0;
    if (grid == 0) {
        if (n_in != 30 || ws_size < WS_END) { fprintf(stderr, "kernel_launch: unexpected n_in %d / ws_size %zu (need %zu)\n", n_in, ws_size, (size_t)WS_END); grid = -1; return; }
        int dev = 0, cus = 0, per_cu = 0;
        hipGetDevice(&dev);
        hipDeviceGetAttribute(&cus, hipDeviceAttributeMultiprocessorCount, dev);
        hipFuncSetAttribute((const void*)fwd_megakernel, hipFuncAttributeMaxDynamicSharedMemorySize, LDS_BYTES);
        hipOccupancyMaxActiveBlocksPerMultiprocessor(&per_cu, (const void*)fwd_megakernel, NTHR, LDS_BYTES);
        if (per_cu < 1) { fprintf(stderr, "kernel_launch: occupancy query returned %d\n", per_cu); per_cu = 1; }
        grid = cus * per_cu;
        (void)hipGetLastError();
    }
    if (grid < 0) return;
    hipMemsetAsync((char*)d_ws + WS_CTL, 0, 256, stream);
    hipMemsetAsync((char*)d_ws + WS_BAR, 0, XCD_BAR_WORDS * 4, stream);
    Params p{};
    for (int i = 0; i < 30; ++i) p.in[i] = (const float*)d_in[i];
    p.out = (float*)d_out; p.ws = (unsigned char*)d_ws;
#if MULTI_LAUNCH
    for (int ph = 0; ph < NPHASE; ++ph) { p.ph_lo = ph; p.ph_hi = ph + 1; hipLaunchKernelGGL(fwd_megakernel, dim3(grid), dim3(NTHR), LDS_BYTES, stream, p); }
#else
    p.ph_lo = 0; p.ph_hi = NPHASE;
    void* args[] = {&p};
    hipError_t e = hipLaunchCooperativeKernel((const void*)fwd_megakernel, dim3(grid), dim3(NTHR), args, LDS_BYTES, stream);
    if (e != hipSuccess) fprintf(stderr, "cooperative launch failed: %s (grid %d)\n", hipGetErrorString(e), grid);
#endif
}
```

```cpp
#include <hip/hip_runtime.h>
#include <hip/hip_cooperative_groups.h>
#include <cstdio>
namespace cg = cooperative_groups;

#define LAS __attribute__((address_space(3)))
typedef unsigned short bf16_t;
typedef short bf16x8 __attribute__((ext_vector_type(8)));
typedef float f32x4 __attribute__((ext_vector_type(4)));
typedef unsigned u32x4 __attribute__((ext_vector_type(4)));
typedef unsigned u32x2 __attribute__((ext_vector_type(2)));

#ifndef MULTI_LAUNCH
#define MULTI_LAUNCH 0
#endif

constexpr int D = 1024, NTOK = 8192, NPTOK = 4096;
constexpr int N0 = 8448;
constexpr int N1 = 3328;
constexpr int NTHR = 512;
constexpr int LDS_MAIN = 139264;
constexpr int LDS_BYTES = LDS_MAIN + 256;

constexpr size_t MB = 1024 * 1024;
constexpr size_t WS_CTL = 0x1A0000 + 14336;
constexpr size_t WS_MOD = 4096;
constexpr size_t WS_BON = WS_MOD + 2 * 3 * 3072 * 4;
constexpr size_t WS_BAR = 0x1A0000;
constexpr size_t WS_BT0 = 2 * MB;
constexpr size_t WS_WT0O = WS_BT0 + (size_t)N0 * 1024 * 2;
constexpr size_t WS_BT1 = WS_WT0O + (size_t)1024 * 2048 * 2;
constexpr size_t WS_WT1O = WS_BT1 + (size_t)N1 * 1024 * 2;
constexpr size_t WS_H = WS_WT1O + (size_t)1024 * 1024 * 2;
constexpr size_t WS_OC = WS_H + (size_t)NTOK * 1024 * 2;
constexpr size_t WS_X1 = WS_OC + (size_t)NTOK * 2048 * 2;
constexpr size_t WS_P = WS_X1 + (size_t)NTOK * 1024 * 4;
constexpr size_t WS_P2 = WS_P + 64 * MB;
constexpr size_t WS_END = WS_P + (size_t)NTOK * N0 * 2;

struct Params {
    const float* in[30];
    float* out;
    unsigned char* ws;
    int ph_lo, ph_hi;
};

__device__ __forceinline__ float bf2f(bf16_t h) { return __uint_as_float(((unsigned)h) << 16); }
__device__ __forceinline__ bf16_t f2bf(float f) { unsigned u = __float_as_uint(f); u += 0x7FFFu + ((u >> 16) & 1u); return (bf16_t)(u >> 16); }
__device__ __forceinline__ unsigned pack2(float lo, float hi) { return (unsigned)f2bf(lo) | ((unsigned)f2bf(hi) << 16); }
__device__ __forceinline__ float bflo(unsigned w) { return __uint_as_float(w << 16); }
__device__ __forceinline__ float bfhi(unsigned w) { return __uint_as_float(w & 0xFFFF0000u); }
__device__ __forceinline__ float fexp(float x) { return __builtin_amdgcn_exp2f(x * 1.44269504f); }
__device__ __forceinline__ float flog(float x) { return __builtin_amdgcn_logf(x) * 0.69314718f; }
__device__ __forceinline__ float silu(float x) { return x * __builtin_amdgcn_rcpf(1.f + fexp(-x)); }
__device__ __forceinline__ float wave_sum(float v) {
#pragma unroll
    for (int m = 32; m >= 1; m >>= 1) v += __shfl_xor(v, m, 64);
    return v;
}

typedef float f32x2_t __attribute__((ext_vector_type(2)));
typedef __bf16 bf16x2_t __attribute__((ext_vector_type(2)));
__device__ __forceinline__ unsigned pk2(float lo, float hi) { const f32x2_t v = {lo, hi}; return __builtin_bit_cast(unsigned, __builtin_convertvector(v, bf16x2_t)); }
__device__ __forceinline__ bf16_t f2bf_hw(float f) { return __builtin_bit_cast(bf16_t, (__bf16)f); }

__device__ __forceinline__ void lds_barrier() { asm volatile("s_waitcnt lgkmcnt(0)" ::: "memory"); __builtin_amdgcn_s_barrier(); asm volatile("" ::: "memory"); }

namespace pg8 {
constexpr int BM = 256, BK = 64, HALF = 128, HTB = HALF * BK * 2, NXCD = 8, WGM = 8;
__device__ __forceinline__ int lds_byte(int r, int c) { const int st = (r >> 4) * 2 + (c >> 5), rr = r & 15, cc = c & 31, ob = rr * 64 + cc * 2; return st * 1024 + (ob ^ (((ob >> 9) & 1) << 5)); }
__device__ __forceinline__ void stage_rc(int b, int& R, int& C) { const int st = b / 1024, sb = b % 1024, swz = sb ^ (((sb >> 9) & 1) << 5); R = (st >> 1) * 16 + swz / 64; C = (st & 1) * 32 + (swz % 64) / 2; }
__device__ __forceinline__ int perm32(int rho) { const int n = rho >> 4, i = rho & 15; return 8 * (i >> 2) + 4 * n + (i & 3); }

struct Unit { int pm, pn, ks; };
struct Gemm { const bf16_t* A; const bf16_t* Bt; int M, N, K, ld, KS; };

struct Order {
    int nM, nN, nNr, nwg, G, c;
    __device__ void init(int M, int N, int KS, int G_, int c_) { nM = M / BM; nNr = N / BM; nN = nNr * KS; nwg = nM * nN; G = G_; c = c_; }
    __device__ bool next(int i, Unit& u) const {
        const long L = (long)i * G + c; if (L >= nwg) return false;
        int wgid = (int)L; { const int q = nwg / NXCD, r = nwg % NXCD, xcd = wgid % NXCD, off = wgid / NXCD; wgid = (xcd < r ? xcd * (q + 1) : r * (q + 1) + (xcd - r) * q) + off; }
        const int nig = WGM * nN, gid = wgid / nig, fm = gid * WGM, gsz = (nM - fm) < WGM ? (nM - fm) : WGM;
        u.pm = fm + ((wgid % nig) % gsz); const int pn = (wgid % nig) / gsz; u.pn = pn % nNr; u.ks = pn / nNr; return true;
    }
};

__device__ __forceinline__ unsigned cvt_pk_bf16(float lo, float hi) { unsigned r; asm volatile("v_cvt_pk_bf16_f32 %0, %1, %2" : "=v"(r) : "v"(lo), "v"(hi)); return r; }

struct EpiF32 {
    static constexpr bool PERM = false;
    float* C; int ldc; size_t ks_stride;
    __device__ __forceinline__ void operator()(const f32x4 (&acc)[2][2][4][2], const Unit& u, int wr, int wc, int fr, int fq) const {
        const int row0 = u.pm * BM + wr * 64 + fr, col0 = u.pn * BM + wc * 32 + 4 * fq;
        float* Cb = C + (size_t)u.ks * ks_stride;
#pragma unroll
        for (int ai = 0; ai < 2; ++ai)
#pragma unroll
            for (int m = 0; m < 4; ++m) { float* rowp = Cb + (size_t)(row0 + ai * HALF + m * 16) * ldc + col0;
#pragma unroll
                for (int bj = 0; bj < 2; ++bj)
#pragma unroll
                    for (int n = 0; n < 2; ++n) *(f32x4*)(rowp + bj * HALF + n * 16) = acc[ai][bj][m][n]; }
    }
};
struct EpiBf16 {
    static constexpr bool PERM = true;
    bf16_t* O; int ldc;
    __device__ __forceinline__ void operator()(const f32x4 (&acc)[2][2][4][2], const Unit& u, int wr, int wc, int fr, int fq) const {
        const int row0 = u.pm * BM + wr * 64 + fr; const int col0 = u.pn * BM + wc * 32 + 8 * fq;
#pragma unroll
        for (int ai = 0; ai < 2; ++ai)
#pragma unroll
            for (int m = 0; m < 4; ++m) { bf16_t* rowp = O + (size_t)(row0 + ai * HALF + m * 16) * ldc + col0;
#pragma unroll
                for (int bj = 0; bj < 2; ++bj) { const f32x4 v0 = acc[ai][bj][m][0], v1 = acc[ai][bj][m][1];
                    u32x4 w; w.x = cvt_pk_bf16(v0[0], v0[1]); w.y = cvt_pk_bf16(v0[2], v0[3]); w.z = cvt_pk_bf16(v1[0], v1[1]); w.w = cvt_pk_bf16(v1[2], v1[3]);
                    *(u32x4*)(rowp + bj * HALF) = w; } }
    }
};

template <class Epi>
__device__ __forceinline__ void gemm_phase(LAS unsigned char* lds, const Gemm g, const Order& S, const Epi& E) {
    const int tid = threadIdx.x, wid = __builtin_amdgcn_readfirstlane(tid >> 6), lane = tid & 63, wr = wid >> 2, wc = wid & 3, fr = lane & 15, fq = lane >> 4;
    const int K = g.K, nt = K / BK, ld = g.ld;
    unsigned voffA[2], voffB[2];
#pragma unroll
    for (int i = 0; i < 2; ++i) { int R, C; stage_rc(tid * 16 + i * 8192, R, C); const int Rb = Epi::PERM ? ((R & ~31) + perm32(R & 31)) : R;
        voffA[i] = (unsigned)(R * ld + C) * 2u; voffB[i] = (unsigned)(Rb * ld + C) * 2u; }
    const size_t kstep = (size_t)(BK * 2);
    const size_t hstep = (size_t)HALF * ld * 2;
    const size_t tstep = 2 * hstep;
    const size_t ksb = (size_t)K * 2;
    const unsigned ldsw = (unsigned)wid * 1024u;
    const int aoff = lds_byte(wr * 64 + fr, fq * 8), boff = lds_byte(wc * 32 + fr, fq * 8);
#define PG8_SA(b, h) (((b) * 2 + (h)) * HTB)
#define PG8_SB(b, h) ((4 + (b) * 2 + (h)) * HTB)
#define PG8_STAGE(bufoff, gbase, voff) do { _Pragma("unroll") for (int _i = 0; _i < 2; ++_i) \
        __builtin_amdgcn_global_load_lds((const unsigned*)((const char*)(gbase) + (voff)[_i]), (LAS unsigned*)(lds + (bufoff) + ldsw + _i * 8192), 16, 0, 0); } while (0)
#define PG8_LDA(dst, b, h) do { _Pragma("unroll") for (int m = 0; m < 4; ++m) _Pragma("unroll") for (int k = 0; k < 2; ++k) dst[m][k] = *(const LAS bf16x8*)(lds + PG8_SA(b, h) + aoff + m * 2048 + k * 1024); } while (0)
#define PG8_LDB(dst, b, h) do { _Pragma("unroll") for (int n = 0; n < 2; ++n) _Pragma("unroll") for (int k = 0; k < 2; ++k) dst[n][k] = *(const LAS bf16x8*)(lds + PG8_SB(b, h) + boff + n * 2048 + k * 1024); } while (0)
#define PG8_MMA(ai, bj, At, Bt) do { __builtin_amdgcn_s_setprio(1); _Pragma("unroll") for (int m = 0; m < 4; ++m) _Pragma("unroll") for (int n = 0; n < 2; ++n) _Pragma("unroll") for (int k = 0; k < 2; ++k) \
        acc[ai][bj][m][n] = __builtin_amdgcn_mfma_f32_16x16x32_bf16(Bt[n][k], At[m][k], acc[ai][bj][m][n], 0, 0, 0); __builtin_amdgcn_s_setprio(0); } while (0)
#define PG8_WAIT_V(n) asm volatile("s_waitcnt vmcnt(" #n ")" ::: "memory")
#define PG8_WAIT_L(n) asm volatile("s_waitcnt lgkmcnt(" #n ")" ::: "memory")
#define PG8_BAR __builtin_amdgcn_s_barrier()
#define PG8_SCHED __builtin_amdgcn_sched_barrier(0)
    Unit cur, nxt; int ui = 0;
    if (!S.next(0, cur)) return;
    f32x4 acc[2][2][4][2];
#pragma unroll
    for (int a = 0; a < 2; ++a)
#pragma unroll
        for (int b = 0; b < 2; ++b)
#pragma unroll
            for (int m = 0; m < 4; ++m)
#pragma unroll
                for (int n = 0; n < 2; ++n) acc[a][b][m][n] = (f32x4){0.f, 0.f, 0.f, 0.f};
    bf16x8 At[4][2], B0[2][2], B1[2][2];
    const char* cA = (const char*)g.A + (size_t)cur.pm * tstep + (size_t)cur.ks * ksb; const char* cB = (const char*)g.Bt + (size_t)cur.pn * tstep + (size_t)cur.ks * ksb;
    PG8_STAGE(PG8_SB(0, 0), cB, voffB); PG8_STAGE(PG8_SA(0, 0), cA, voffA); PG8_STAGE(PG8_SB(0, 1), cB + hstep, voffB); PG8_STAGE(PG8_SA(0, 1), cA + hstep, voffA);
    if (wr == 1) PG8_BAR;
    PG8_WAIT_V(4); PG8_BAR;
    PG8_STAGE(PG8_SB(1, 0), cB + kstep, voffB); PG8_STAGE(PG8_SA(1, 0), cA + kstep, voffA); PG8_STAGE(PG8_SB(1, 1), cB + hstep + kstep, voffB);
    PG8_WAIT_V(6); PG8_BAR;
    for (;;) {
        const bool has_next = S.next(ui + 1, nxt);
        const char* nA = has_next ? (const char*)g.A + (size_t)nxt.pm * tstep + (size_t)nxt.ks * ksb : cA; const char* nB = has_next ? (const char*)g.Bt + (size_t)nxt.pn * tstep + (size_t)nxt.ks * ksb : cB;
        for (int t = 0; t < nt; t += 2) {
            const bool last = (t == nt - 2);
            const char* a1 = cA + (size_t)(t + 1) * kstep;
            const char* a2 = last ? nA : cA + (size_t)(t + 2) * kstep; const char* b2 = last ? nB : cB + (size_t)(t + 2) * kstep;
            const char* a3 = a2 + kstep; const char* b3 = b2 + kstep;
            PG8_LDB(B0, 0, 0); PG8_SCHED; PG8_LDA(At, 0, 0); PG8_STAGE(PG8_SA(1, 1), a1 + hstep, voffA);
            PG8_WAIT_L(8); PG8_BAR; PG8_WAIT_L(0); PG8_MMA(0, 0, At, B0); PG8_BAR; PG8_SCHED;
            PG8_LDB(B1, 0, 1); PG8_STAGE(PG8_SB(0, 0), b2, voffB);
            PG8_BAR; PG8_WAIT_L(0); PG8_MMA(0, 1, At, B1); PG8_BAR;
            PG8_LDA(At, 0, 1); PG8_STAGE(PG8_SA(0, 0), a2, voffA);
            PG8_BAR; PG8_WAIT_L(0); PG8_MMA(1, 0, At, B0); PG8_BAR; PG8_SCHED;
            PG8_STAGE(PG8_SB(0, 1), b2 + hstep, voffB);
            PG8_WAIT_V(6); PG8_BAR; PG8_MMA(1, 1, At, B1); PG8_BAR;
            PG8_LDB(B0, 1, 0); PG8_SCHED; PG8_LDA(At, 1, 0); PG8_STAGE(PG8_SA(0, 1), a2 + hstep, voffA);
            PG8_WAIT_L(8); PG8_BAR; PG8_WAIT_L(0); PG8_MMA(0, 0, At, B0); PG8_BAR; PG8_SCHED;
            PG8_LDB(B1, 1, 1); PG8_STAGE(PG8_SB(1, 0), b3, voffB);
            PG8_BAR; PG8_WAIT_L(0); PG8_MMA(0, 1, At, B1); PG8_BAR;
            PG8_LDA(At, 1, 1); PG8_STAGE(PG8_SA(1, 0), a3, voffA);
            PG8_BAR; PG8_WAIT_L(0); PG8_MMA(1, 0, At, B0); PG8_BAR; PG8_SCHED;
            PG8_STAGE(PG8_SB(1, 1), b3 + hstep, voffB);
            PG8_WAIT_V(6); PG8_BAR; PG8_MMA(1, 1, At, B1); PG8_BAR;
        }
        E(acc, cur, wr, wc, fr, fq);
        if (!has_next) break;
#pragma unroll
        for (int a = 0; a < 2; ++a)
#pragma unroll
            for (int b = 0; b < 2; ++b)
#pragma unroll
                for (int m = 0; m < 4; ++m)
#pragma unroll
                    for (int n = 0; n < 2; ++n) acc[a][b][m][n] = (f32x4){0.f, 0.f, 0.f, 0.f};
        cur = nxt; cA = nA; cB = nB; ++ui;
    }
    PG8_WAIT_V(0);
    if (wr == 0) PG8_BAR;
    PG8_BAR;
#undef PG8_SA
#undef PG8_SB
#undef PG8_STAGE
#undef PG8_LDA
#undef PG8_LDB
#undef PG8_MMA
#undef PG8_WAIT_V
#undef PG8_WAIT_L
#undef PG8_BAR
#undef PG8_SCHED
}
}

struct TJob { const float* src; bf16_t* dst; int ldsrc, N, lddst, drow0, k0, n0; };
__device__ __forceinline__ TJob tjob_of(const Params& p, int t) {
    unsigned char* ws = p.ws;
    bf16_t* BT0 = (bf16_t*)(ws + WS_BT0); bf16_t* WT0O = (bf16_t*)(ws + WS_WT0O); bf16_t* BT1 = (bf16_t*)(ws + WS_BT1); bf16_t* WT1O = (bf16_t*)(ws + WS_WT1O);
    TJob j; int nnt;
    if (t < 1024) { j.src = p.in[10]; j.ldsrc = 8192; j.N = 8192; j.dst = BT0; j.lddst = 1024; j.drow0 = 0; nnt = 64; }
    else if (t < 1024 + 32) { t -= 1024; const int z = t >> 4; t &= 15; j.src = p.in[14] + (size_t)z * 1024 * 64; j.ldsrc = 64; j.N = 64; j.dst = BT0; j.lddst = 1024; j.drow0 = 8192 + z * 64; nnt = 1; }
    else if (t < 1024 + 64) { t -= 1024 + 32; const int z = t >> 4; t &= 15; j.src = p.in[17] + (size_t)z * 1024 * 64; j.ldsrc = 64; j.N = 64; j.dst = BT0; j.lddst = 1024; j.drow0 = 8320 + z * 64; nnt = 1; }
    else if (t < 1088 + 256) { t -= 1088; j.src = p.in[11]; j.ldsrc = 1024; j.N = 1024; j.dst = WT0O; j.lddst = 2048; j.drow0 = 0; nnt = 8; }
    else if (t < 1344 + 384) { t -= 1344; j.src = p.in[24]; j.ldsrc = 3072; j.N = 3072; j.dst = BT1; j.lddst = 1024; j.drow0 = 0; nnt = 24; }
    else if (t < 1728 + 32) { t -= 1728; const int z = t >> 4; t &= 15; j.src = p.in[26] + (size_t)z * 1024 * 16; j.ldsrc = 16; j.N = 16; j.dst = BT1; j.lddst = 1024; j.drow0 = 3072 + z * 16; nnt = 1; }
    else { t -= 1760; j.src = p.in[25]; j.ldsrc = 1024; j.N = 1024; j.dst = WT1O; j.lddst = 1024; j.drow0 = 0; nnt = 8; }
    j.k0 = (t / nnt) * 64; j.n0 = (t % nnt) * 128; return j;
}
__device__ __forceinline__ void tjob_load(const TJob& j, f32x4 (&r)[4]) {
    const int tid = threadIdx.x, c4 = (tid & 31) * 4;
#pragma unroll
    for (int i = 0; i < 4; ++i) { const int kk = (tid >> 5) + 16 * i;
        r[i] = (j.n0 + c4 < j.N) ? *(const f32x4*)(j.src + (size_t)(j.k0 + kk) * j.ldsrc + j.n0 + c4) : (f32x4){0.f, 0.f, 0.f, 0.f}; }
}

__device__ void transpose_jobs(const Params& p, float* lds, int t_lo, int t_hi, int rot) {
    const int tid = threadIdx.x;
    float* tile = lds;
    int it = t_lo + (int)((blockIdx.x + (unsigned)rot) % gridDim.x);
    f32x4 cur[4], nxt[4];
    TJob jc = tjob_of(p, it < t_hi ? it : t_lo);
    if (it < t_hi) tjob_load(jc, cur);
    for (; it < t_hi; it += gridDim.x) {
        const int c4 = (tid & 31) * 4;
#pragma unroll
        for (int i = 0; i < 4; ++i) { const int kk = (tid >> 5) + 16 * i; tile[kk * 129 + c4] = cur[i][0]; tile[kk * 129 + c4 + 1] = cur[i][1]; tile[kk * 129 + c4 + 2] = cur[i][2]; tile[kk * 129 + c4 + 3] = cur[i][3]; }
        const int itn = it + gridDim.x;
        const TJob jn = tjob_of(p, itn < t_hi ? itn : t_lo);
        if (itn < t_hi) tjob_load(jn, nxt);
        __syncthreads();
#pragma unroll
        for (int q = 0; q < 2; ++q) { const int idx = tid + q * NTHR; const int nn = idx >> 3, k8 = (idx & 7) * 8;
            if (jc.n0 + nn < jc.N) { u32x4 o; o.x = pk2(tile[(k8 + 0) * 129 + nn], tile[(k8 + 1) * 129 + nn]); o.y = pk2(tile[(k8 + 2) * 129 + nn], tile[(k8 + 3) * 129 + nn]);
                o.z = pk2(tile[(k8 + 4) * 129 + nn], tile[(k8 + 5) * 129 + nn]); o.w = pk2(tile[(k8 + 6) * 129 + nn], tile[(k8 + 7) * 129 + nn]);
                *(u32x4*)(jc.dst + (size_t)(jc.drow0 + jc.n0 + nn) * jc.lddst + jc.k0 + k8) = o; } }
        __syncthreads();
        jc = jn;
#pragma unroll
        for (int i = 0; i < 4; ++i) cur[i] = nxt[i];
    }
}

__device__ void phase_prologue(const Params& p, float* lds) {
    const int tid = threadIdx.x;
    unsigned char* ws = p.ws;
    bf16_t* BT1 = (bf16_t*)(ws + WS_BT1);
    float* MOD = (float*)(ws + WS_MOD);
    constexpr int NGEMV = 192;
    for (int it = blockIdx.x; it < NGEMV; it += gridDim.x) {
        const int l = it / 96, j0 = (it % 96) * 32;
        float* sc = lds;
        float* red = lds + 3072;
        for (int i = tid; i < 3072; i += NTHR) { const int cnd = i >> 10, k = i & 1023; const float v = cnd == 0 ? p.in[5][k] : p.in[4][(cnd - 1) * 1024 + k]; sc[i] = silu(v); }
        __syncthreads();
        const int col = tid & 31, ksp = tid >> 5;
        float a0 = 0.f, a1 = 0.f, a2 = 0.f;
        const float* w = p.in[7] + (size_t)l * 1024 * 3072 + j0 + col;
#pragma unroll 16
        for (int k = ksp * 64; k < ksp * 64 + 64; ++k) { const float wv = w[(size_t)k * 3072]; a0 += sc[k] * wv; a1 += sc[1024 + k] * wv; a2 += sc[2048 + k] * wv; }
        red[(ksp * 3 + 0) * 32 + col] = a0; red[(ksp * 3 + 1) * 32 + col] = a1; red[(ksp * 3 + 2) * 32 + col] = a2;
        __syncthreads();
        if (tid < 96) { const int cnd = tid >> 5, cc = tid & 31; float s = 0.f; for (int q = 0; q < 16; ++q) s += red[(q * 3 + cnd) * 32 + cc];
            MOD[(l * 3 + cnd) * 3072 + j0 + cc] = s + p.in[8][l * 3072 + j0 + cc]; }
        __syncthreads();
    }
    transpose_jobs(p, lds, 0, 1088, 64);
}
__device__ void phase_late_weights(const Params& p, float* lds) {
    const int tid = threadIdx.x;
    bf16_t* BT1 = (bf16_t*)(p.ws + WS_BT1);
    transpose_jobs(p, lds, 1088, 1888, 0);
    { u32x4* z = (u32x4*)(BT1 + (size_t)3104 * 1024); const int n = 224 * 1024 * 2 / 16;
      for (int i = blockIdx.x * NTHR + tid; i < n; i += gridDim.x * NTHR) z[i] = (u32x4){0u, 0u, 0u, 0u}; }
}

__device__ void phase_h(const Params& p, int layer, float* ldsf) {
    const int tid = threadIdx.x, wave = __builtin_amdgcn_readfirstlane(tid >> 6), lane = tid & 63, fr = lane & 15, fq = lane >> 4;
    unsigned char* ws = p.ws;
    const float* MOD = (const float*)(ws + WS_MOD);
    bf16_t* H = (bf16_t*)(ws + WS_H);
    float* X1 = (float*)(ws + WS_X1);
    const float* Y = (const float*)(ws + WS_P);
    bf16_t* HL = (bf16_t*)ldsf;
    for (int tb = blockIdx.x * 32; tb < NTOK; tb += gridDim.x * 32) {
#pragma unroll 1
        for (int q = 0; q < 4; ++q) { const int tl = wave * 4 + q, tok = tb + tl;
            const float* xr = tok < NPTOK ? p.in[0] + (size_t)tok * D : p.in[1] + (size_t)(tok - NPTOK) * D;
            const int cond = tok < NPTOK ? 0 : 1 + ((tok - NPTOK) >> 11);
            f32x4 xv[4]; float ss = 0.f;
#pragma unroll
            for (int i = 0; i < 4; ++i) { const int idx = i * 256 + lane * 4; xv[i] = *(const f32x4*)(xr + idx);
                if (layer == 1) { const f32x4 ya = *(const f32x4*)(Y + (size_t)tok * D + idx), yb = *(const f32x4*)(Y + (size_t)NTOK * D + (size_t)tok * D + idx);
                    const f32x4 gt = *(const f32x4*)(MOD + (0 * 3 + cond) * 3072 + 2048 + idx);
                    xv[i] = xv[i] + gt * (ya + yb); *(f32x4*)(X1 + (size_t)tok * D + idx) = xv[i]; }
                ss += xv[i][0] * xv[i][0] + xv[i][1] * xv[i][1] + xv[i][2] * xv[i][2] + xv[i][3] * xv[i][3]; }
            ss = wave_sum(ss);
            const float rstd = rsqrtf(ss * (1.f / 1024.f) + 1e-6f);
#pragma unroll
            for (int i = 0; i < 4; ++i) { const int idx = i * 256 + lane * 4;
                const f32x4 g = *(const f32x4*)(p.in[6] + layer * D + idx);
                const f32x4 sh = *(const f32x4*)(MOD + (layer * 3 + cond) * 3072 + idx), sc = *(const f32x4*)(MOD + (layer * 3 + cond) * 3072 + 1024 + idx);
                f32x4 h;
#pragma unroll
                for (int j = 0; j < 4; ++j) h[j] = xv[i][j] * rstd * g[j] * (1.f + sc[j]) + sh[j];
                u32x2 w2; w2.x = pk2(h[0], h[1]); w2.y = pk2(h[2], h[3]);
                *(u32x2*)(H + (size_t)tok * D + idx) = w2;
                if (layer == 0) *(u32x2*)(HL + tl * 1032 + idx) = w2; } }
        if (layer == 0) {
            __syncthreads();
            const bf16_t* BL = (const bf16_t*)(ws + WS_BT0) + (size_t)8192 * 1024;
            bf16_t* P = (bf16_t*)(ws + WS_P);
            f32x4 acc[2][2];
#pragma unroll
            for (int mt = 0; mt < 2; ++mt)
#pragma unroll
                for (int n2 = 0; n2 < 2; ++n2) acc[mt][n2] = (f32x4){0.f, 0.f, 0.f, 0.f};
#pragma unroll 16
            for (int ks = 0; ks < 32; ++ks) {
                bf16x8 af[2], bfr[2];
#pragma unroll
                for (int mt = 0; mt < 2; ++mt) af[mt] = *(const bf16x8*)(HL + (mt * 16 + fr) * 1032 + ks * 32 + fq * 8);
#pragma unroll
                for (int n2 = 0; n2 < 2; ++n2) bfr[n2] = *(const bf16x8*)(BL + (size_t)((wave * 2 + n2) * 16 + fr) * 1024 + ks * 32 + fq * 8);
#pragma unroll
                for (int mt = 0; mt < 2; ++mt)
#pragma unroll
                    for (int n2 = 0; n2 < 2; ++n2) acc[mt][n2] = __builtin_amdgcn_mfma_f32_16x16x32_bf16(af[mt], bfr[n2], acc[mt][n2], 0, 0, 0);
            }
#pragma unroll
            for (int mt = 0; mt < 2; ++mt)
#pragma unroll
                for (int n2 = 0; n2 < 2; ++n2)
#pragma unroll
                    for (int jj = 0; jj < 4; ++jj) P[(size_t)(tb + mt * 16 + fq * 4 + jj) * N0 + 8192 + (wave * 2 + n2) * 16 + fr] = f2bf_hw(acc[mt][n2][jj]);
            __syncthreads();
        }
    }
}

__device__ __forceinline__ f32x4 mma_nt(const bf16_t* A, int lda, const bf16_t* B, int ldb, int K, f32x4 acc, int fr, int fq) {
    for (int k0 = 0; k0 < K; k0 += 32) {
        const bf16x8 a = *(const bf16x8*)(A + fr * lda + k0 + fq * 8);
        const bf16x8 b = *(const bf16x8*)(B + fr * ldb + k0 + fq * 8);
        acc = __builtin_amdgcn_mfma_f32_16x16x32_bf16(a, b, acc, 0, 0, 0);
    }
    return acc;
}
__device__ __forceinline__ bf16x8 pack8(float a0, float a1, float a2, float a3, float a4, float a5, float a6, float a7) {
    u32x4 w; w.x = pack2(a0, a1); w.y = pack2(a2, a3); w.z = pack2(a4, a5); w.w = pack2(a6, a7);
    return __builtin_bit_cast(bf16x8, w);
}
__device__ __forceinline__ float dpp_add(float v, float o) { return v + o; }
__device__ __forceinline__ float wave_sum_fast(float v) {
    v += __int_as_float(__builtin_amdgcn_update_dpp(0, __float_as_int(v), 0xB1, 0xF, 0xF, true));
    v += __int_as_float(__builtin_amdgcn_update_dpp(0, __float_as_int(v), 0x4E, 0xF, 0xF, true));
    v += __int_as_float(__builtin_amdgcn_update_dpp(0, __float_as_int(v), 0x141, 0xF, 0xF, true));
    v += __int_as_float(__builtin_amdgcn_update_dpp(0, __float_as_int(v), 0x140, 0xF, 0xF, true));
    v += __shfl_xor(v, 16, 64); v += __shfl_xor(v, 32, 64);
    return v;
}
__device__ __forceinline__ float wave_sum_dpp(float v) {
    v += __int_as_float(__builtin_amdgcn_update_dpp(0, __float_as_int(v), 0xB1, 0xF, 0xF, true));
    v += __int_as_float(__builtin_amdgcn_update_dpp(0, __float_as_int(v), 0x4E, 0xF, 0xF, true));
    v += __int_as_float(__builtin_amdgcn_update_dpp(0, __float_as_int(v), 0x141, 0xF, 0xF, true));
    v += __int_as_float(__builtin_amdgcn_update_dpp(0, __float_as_int(v), 0x140, 0xF, 0xF, true));
    v += __int_as_float(__builtin_amdgcn_update_dpp(0, __float_as_int(v), 0x142, 0xA, 0xF, false));
    v += __int_as_float(__builtin_amdgcn_update_dpp(0, __float_as_int(v), 0x143, 0xC, 0xF, false));
    return __int_as_float(__builtin_amdgcn_readlane(__float_as_int(v), 63));
}
__device__ __forceinline__ float wave_sum_lane63(float v) {
    v += __int_as_float(__builtin_amdgcn_update_dpp(0, __float_as_int(v), 0xB1, 0xF, 0xF, true));
    v += __int_as_float(__builtin_amdgcn_update_dpp(0, __float_as_int(v), 0x4E, 0xF, 0xF, true));
    v += __int_as_float(__builtin_amdgcn_update_dpp(0, __float_as_int(v), 0x141, 0xF, 0xF, true));
    v += __int_as_float(__builtin_amdgcn_update_dpp(0, __float_as_int(v), 0x140, 0xF, 0xF, true));
    v += __int_as_float(__builtin_amdgcn_update_dpp(0, __float_as_int(v), 0x142, 0xA, 0xF, false));
    v += __int_as_float(__builtin_amdgcn_update_dpp(0, __float_as_int(v), 0x143, 0xC, 0xF, false));
    return v;
}
__device__ __forceinline__ float fast_tanh(float x) { const float e = fexp(2.f * x); return 1.f - 2.f * __builtin_amdgcn_rcpf(1.f + e); }
__device__ __forceinline__ bf16x8 pack8h(float a0, float a1, float a2, float a3, float a4, float a5, float a6, float a7) {
    u32x4 w; w.x = pk2(a0, a1); w.y = pk2(a2, a3); w.z = pk2(a4, a5); w.w = pk2(a6, a7);
    return __builtin_bit_cast(bf16x8, w);
}

__device__ void wkv_unit(const Params& p, int u, float* ldsf) {
    const int tid0 = threadIdx.x, lane0 = tid0 & 63, w = __builtin_amdgcn_readfirstlane(tid0 >> 6), fr0 = lane0 & 15, fq0 = lane0 >> 4;
    unsigned char* ws = p.ws;
    unsigned char* lds = (unsigned char*)ldsf;
    const bf16_t* P = (const bf16_t*)(ws + WS_P);
    bf16_t* OD = (bf16_t*)(ws + WS_X1);
    float* BON = (float*)(ws + WS_BON);
    int z, b, hd, sgm, seqT, tok0; bool sample; const int T = 256;
    if (u < 512) { sample = true; z = u >> 8; b = (u >> 7) & 1; hd = (u >> 3) & 15; sgm = u & 7; seqT = 2048; tok0 = NPTOK + b * 2048; }
    else { const int q = u - 512; sample = false; z = q >> 8; b = (q >> 4) & 15; hd = q & 15; sgm = 0; seqT = 256; tok0 = b * 256; }
    const int qbase = sgm * 256;
    bf16_t* RHO = (bf16_t*)(ws + WS_H);
    float* GH = (float*)(ws + WS_BT0);
    bf16_t* TLW = (bf16_t*)(lds + 0);
    bf16_t* TLA = (bf16_t*)(lds + 9216);
    float* HT = (float*)(lds + 18432);
    float* BONL = (float*)(lds + 57344);
    bf16_t* KTr = (bf16_t*)(lds + 20480);
    bf16_t* BTr = (bf16_t*)(lds + 29696);
    bf16_t* KKH = (bf16_t*)(lds + 38912);
    bf16_t* RH = (bf16_t*)(lds + 48128);
    const bf16_t* VS = (const bf16_t*)(lds + 113664 + 2 * 8192);
    bf16_t* TA = (bf16_t*)(lds + 65536);
    bf16_t* NA = (bf16_t*)(lds + 70656);
    float* PC = (float*)(lds + 75776);
    bf16_t* KBm = (bf16_t*)(lds + 76800);
    float* MM = (float*)(lds + 97280);
    float* WA = (float*)(lds + 76800);
    bf16x8 bw[2];
    { const float* W2 = (w >> 2) ? p.in[18] : p.in[15];
#pragma unroll
      for (int ks = 0; ks < 2; ++ks) { float t8[8];
#pragma unroll
        for (int e = 0; e < 8; ++e) t8[e] = W2[(size_t)(z * 64 + ks * 32 + fq0 * 8 + e) * 1024 + hd * 64 + (w & 3) * 16 + fr0];
        bw[ks] = pack8h(t8[0], t8[1], t8[2], t8[3], t8[4], t8[5], t8[6], t8[7]); } }
    f32x4 Sacc[4];
#pragma unroll
    for (int kt = 0; kt < 4; ++kt) Sacc[kt] = (f32x4){0.f, 0.f, 0.f, 0.f};
    if (w >= 4) {
#pragma unroll
        for (int kt = 0; kt < 4; ++kt)
#pragma unroll
            for (int jj = 0; jj < 4; ++jj) Sacc[kt][jj] = (kt * 16 + fq0 * 4 + jj == (w - 4) * 16 + fr0) ? 1.f : 0.f; }
    const int ch = hd * 64 + lane0;
    const float w0c = p.in[13][z * 1024 + ch], a0c = p.in[16][z * 1024 + ch], kkc = p.in[19][ch], kac = p.in[20][ch], rkc = p.in[21][ch];
    bf16_t* RKV = (bf16_t*)(lds + 113664);
    u32x4 tlraw[2], rkvraw[3];
#define WKV_LOAD_RAW(tb_) do { \
        _Pragma("unroll") for (int h_ = 0; h_ < 2; ++h_) { const int idx_ = tid + h_ * NTHR; const int tau_ = idx_ >> 4, sg_ = idx_ & 15; const int t_ = z ? (seqT - 1 - (qbase + (tb_) + tau_)) : (qbase + (tb_) + tau_); \
            tlraw[h_] = *(const u32x4*)(P + (size_t)(tok0 + t_) * N0 + 8192 + (sg_ < 8 ? z * 64 + sg_ * 8 : 128 + z * 64 + (sg_ - 8) * 8)); } \
        { const int tau_ = tid >> 3, sg_ = tid & 7; const int t_ = z ? (seqT - 1 - (qbase + (tb_) + tau_)) : (qbase + (tb_) + tau_); const bf16_t* rp_ = P + (size_t)(tok0 + t_) * N0 + 4096 + hd * 64 + sg_ * 8; \
          rkvraw[0] = *(const u32x4*)rp_; rkvraw[1] = *(const u32x4*)(rp_ + 1024); rkvraw[2] = *(const u32x4*)(rp_ + 2048); } } while (0)
    { const int tid = tid0; WKV_LOAD_RAW(0); }
    __syncthreads();
#pragma unroll 1
    for (int tb = 0; tb < T; tb += 64) {
        int tid = tid0; asm volatile("" : "+v"(tid));
        const int lane = tid & 63, fr = lane & 15, fq = lane >> 4, c = lane;
        const int pcol = ((c >> 5) * 32) + (((c >> 2) & 3) * 8) + (((c >> 4) & 1) * 4) + (c & 3);
#pragma unroll
        for (int h = 0; h < 2; ++h) { const int idx = tid + h * NTHR; const int tau = idx >> 4, sg = idx & 15;
            u32x4 o = tlraw[h];
            if (sg < 8) { o.x = pk2(fast_tanh(bflo(o.x)), fast_tanh(bfhi(o.x))); o.y = pk2(fast_tanh(bflo(o.y)), fast_tanh(bfhi(o.y)));
                          o.z = pk2(fast_tanh(bflo(o.z)), fast_tanh(bfhi(o.z))); o.w = pk2(fast_tanh(bflo(o.w)), fast_tanh(bfhi(o.w))); }
            *(u32x4*)((sg < 8 ? TLW : TLA) + tau * 72 + (sg & 7) * 8) = o; }
#pragma unroll
        for (int h = 0; h < 3; ++h) *(u32x4*)(RKV + h * 4096 + (tid >> 3) * 64 + (tid & 7) * 8) = rkvraw[h];
        lds_barrier();
        if (tb + 64 < T) WKV_LOAD_RAW(tb + 64);
        { const bf16_t* TL = (w >> 2) ? TLA : TLW; float* WAo = WA + (w >> 2) * 64 * 68;
#pragma unroll
          for (int mt = 0; mt < 4; ++mt) { f32x4 acc = (f32x4){0.f, 0.f, 0.f, 0.f};
#pragma unroll
            for (int ks = 0; ks < 2; ++ks) { const bf16x8 a = *(const bf16x8*)(TL + (mt * 16 + fr) * 72 + ks * 32 + fq * 8);
                acc = __builtin_amdgcn_mfma_f32_16x16x32_bf16(a, bw[ks], acc, 0, 0, 0); }
#pragma unroll
            for (int jj = 0; jj < 4; ++jj) WAo[(mt * 16 + fq * 4 + jj) * 68 + (w & 3) * 16 + fr] = acc[jj]; } }
        lds_barrier();
        float kkv[8], kmv[8], bv[8], lwv[8], cum[8], rr[8], bonv[8];
        { float run = 0.f;
#pragma unroll
          for (int i = 0; i < 8; ++i) { const int tau = w * 8 + i; const int t = z ? (seqT - 1 - (qbase + tb + tau)) : (qbase + tb + tau); const int tokg = tok0 + t;
            const float wr_ = w0c + WA[tau * 68 + c], ap = a0c + WA[64 * 68 + tau * 68 + c];
            const float nx = -wr_; const float sp = fmaxf(nx, 0.f) + flog(1.f + fexp(-fabsf(nx)));
            const float lw = -fexp(-sp - 0.5f);
            const float iclr = __builtin_amdgcn_rcpf(1.f + fexp(-ap));
            const float kxi = bf2f(RKV[4096 + tau * 64 + c]); rr[i] = bf2f(RKV[tau * 64 + c]);
            const float kkraw = kxi * kkc;
            const float ssq = wave_sum_fast(kkraw * kkraw);
            const float kk = kkraw * __builtin_amdgcn_rsqf(fmaxf(ssq, 1e-24f));
            const float kmod = kxi * (1.f + (iclr - 1.f) * kac);
            bonv[i] = wave_sum_lane63(rr[i] * kmod * rkc);
            run += lw;
            kkv[i] = kk; kmv[i] = kmod; bv[i] = kk * iclr; lwv[i] = lw; cum[i] = run; }
          HT[w * 64 + c] = run;
          if (lane == 63) {
#pragma unroll
            for (int i = 0; i < 8; ++i) BONL[w * 8 + i] = bonv[i]; } }
        lds_barrier();
        if (tid < 64) { const int t = z ? (seqT - 1 - (qbase + tb + tid)) : (qbase + tb + tid); BON[((size_t)z * NTOK + tok0 + t) * 16 + hd] = BONL[tid]; }
        { const float off = (w & 1) ? HT[(w - 1) * 64 + c] : 0.f; const int cn = w >> 1;
          unsigned kbq[8];
#pragma unroll
          for (int i = 0; i < 8; ++i) { const int tau = w * 8 + i; const int j = (w & 1) * 8 + i;
            const float cm = cum[i] + off;
            const float Pj = fexp(cm), ipj = fexp(-cm), pm1 = fexp(cm - lwv[i]);
            const unsigned kb2 = pk2(-bv[i] * ipj, kmv[i] * ipj);
            KTr[tau * 72 + pcol] = (bf16_t)(kb2 >> 16); BTr[tau * 72 + pcol] = f2bf_hw(bv[i] * ipj);
            const unsigned kr2 = pk2(kkv[i] * pm1, rr[i] * Pj);
            KKH[tau * 72 + pcol] = (bf16_t)(kr2 & 0xFFFFu); RH[tau * 72 + pcol] = (bf16_t)(kr2 >> 16);
            kbq[i] = kb2;
            if (j == 15) PC[cn * 64 + c] = Pj; }
#pragma unroll
          for (int g = 0; g < 2; ++g) { u32x4 o;
              o.x = (kbq[g * 4 + 0] & 0xFFFFu) | (kbq[g * 4 + 1] << 16); o.y = (kbq[g * 4 + 2] & 0xFFFFu) | (kbq[g * 4 + 3] << 16);
              o.z = (kbq[g * 4 + 0] >> 16) | (kbq[g * 4 + 1] & 0xFFFF0000u); o.w = (kbq[g * 4 + 2] >> 16) | (kbq[g * 4 + 3] & 0xFFFF0000u);
              *(u32x4*)(KBm + (cn * 64 + c) * 40 + ((w & 1) * 2 + g) * 8) = o; } }
        lds_barrier();
#pragma unroll
        for (int q2 = 0; q2 < 2; ++q2) { const int id = w * 2 + q2; const int cn = id >> 2, which = id & 3;
          const bf16_t* Am = ((which & 1) ? KTr : BTr) + cn * 16 * 72; const bf16_t* Bm = ((which & 2) ? RH : KKH) + cn * 16 * 72;
          const f32x4 acc = mma_nt(Am, 72, Bm, 72, 64, (f32x4){0.f, 0.f, 0.f, 0.f}, fr, fq);
          f32x4 o;
#pragma unroll
          for (int jj = 0; jj < 4; ++jj) { const int i = fq * 4 + jj, j = fr; const bool keep = (which & 2) ? (i <= j) : (i < j); o[jj] = keep ? acc[jj] : 0.f; }
          *(f32x4*)(MM + (cn * 4 + which) * 256 + fr * 16 + fq * 4) = o; }
        lds_barrier();
        if (w < 4) { const int cn = w, col = lane >> 2, rg = lane & 3;
            const float* MbT = MM + (cn * 4 + 0) * 256 + rg * 4; const float* MkT = MM + (cn * 4 + 1) * 256 + rg * 4;
            float Tc[4], A1[4];
#pragma unroll
            for (int e = 0; e < 4; ++e) { Tc[e] = (rg * 4 + e == col) ? 1.f : 0.f; A1[e] = 0.f; }
#define INV_STEP(l, CTRL) do { const f32x4 mb = *(const f32x4*)(MbT + (l) * 16), mk = *(const f32x4*)(MkT + (l) * 16); \
                const float tl_ = __int_as_float(__builtin_amdgcn_update_dpp(0, __float_as_int(Tc[(l) & 3]), CTRL, 0xF, 0xF, true)); \
                Tc[0] -= mb[0] * tl_; Tc[1] -= mb[1] * tl_; Tc[2] -= mb[2] * tl_; Tc[3] -= mb[3] * tl_; \
                A1[0] += mk[0] * tl_; A1[1] += mk[1] * tl_; A1[2] += mk[2] * tl_; A1[3] += mk[3] * tl_; } while (0)
            INV_STEP(15, 0xFF); INV_STEP(14, 0xFF); INV_STEP(13, 0xFF); INV_STEP(12, 0xFF);
            INV_STEP(11, 0xAA); INV_STEP(10, 0xAA); INV_STEP(9, 0xAA); INV_STEP(8, 0xAA);
            INV_STEP(7, 0x55); INV_STEP(6, 0x55); INV_STEP(5, 0x55); INV_STEP(4, 0x55);
            INV_STEP(3, 0x00); INV_STEP(2, 0x00); INV_STEP(1, 0x00);
#undef INV_STEP
            u32x4 o; o.x = pk2(Tc[0], Tc[1]); o.y = pk2(Tc[2], Tc[3]); o.z = pk2(A1[0], A1[1]); o.w = pk2(A1[2], A1[3]);
            *(u32x4*)(TA + (cn * 16 + col) * 40 + rg * 8) = o; }
        else { const int cn = w - 4, j = lane & 15, ig = lane >> 4;
            const f32x4 nb = *(const f32x4*)(MM + (cn * 4 + 2) * 256 + j * 16 + ig * 4), nk = *(const f32x4*)(MM + (cn * 4 + 3) * 256 + j * 16 + ig * 4);
            u32x4 o; o.x = pk2(-nb[0], -nb[1]); o.y = pk2(-nb[2], -nb[3]); o.z = pk2(nk[0], nk[1]); o.w = pk2(nk[2], nk[3]);
            *(u32x4*)(NA + (cn * 16 + j) * 40 + ig * 8) = o; }
        lds_barrier();
        if (w < 4 || sample) {
            const int vb = w & 3;
            const int t0s = z ? (seqT - 1 - (qbase + tb)) : (qbase + tb);
            const long tstep = z ? -1024 : 1024;
            bf16_t* obase = (w < 4) ? OD + ((size_t)z * NTOK + tok0 + t0s) * 1024 + hd * 64 + vb * 16 + fr : RHO + ((size_t)z * 4096 + (tok0 - NPTOK) + t0s) * 1024 + hd * 64 + vb * 16 + fr;
#pragma unroll 1
            for (int cn = 0; cn < 4; ++cn) {
                bf16x8 sb[2];
#pragma unroll
                for (int ks = 0; ks < 2; ++ks) sb[ks] = pack8h(Sacc[2 * ks][0], Sacc[2 * ks][1], Sacc[2 * ks][2], Sacc[2 * ks][3], Sacc[2 * ks + 1][0], Sacc[2 * ks + 1][1], Sacc[2 * ks + 1][2], Sacc[2 * ks + 1][3]);
                f32x4 U0 = (f32x4){0.f, 0.f, 0.f, 0.f}, O = (f32x4){0.f, 0.f, 0.f, 0.f};
#pragma unroll
                for (int ks = 0; ks < 2; ++ks) { const bf16x8 a = *(const bf16x8*)(KKH + (cn * 16 + fr) * 72 + ks * 32 + fq * 8);
                    U0 = __builtin_amdgcn_mfma_f32_16x16x32_bf16(a, sb[ks], U0, 0, 0, 0);
                    const bf16x8 ar = *(const bf16x8*)(RH + (cn * 16 + fr) * 72 + ks * 32 + fq * 8);
                    O = __builtin_amdgcn_mfma_f32_16x16x32_bf16(ar, sb[ks], O, 0, 0, 0); }
                float vf[4];
#pragma unroll
                for (int e = 0; e < 4; ++e) vf[e] = (w < 4) ? bf2f(VS[(cn * 16 + fq * 4 + e) * 64 + vb * 16 + fr]) : 0.f;
                const bf16x8 bU0 = pack8h(U0[0], U0[1], U0[2], U0[3], vf[0], vf[1], vf[2], vf[3]);
                const bf16x8 ta = *(const bf16x8*)(TA + (cn * 16 + fr) * 40 + fq * 8);
                const f32x4 U = __builtin_amdgcn_mfma_f32_16x16x32_bf16(ta, bU0, (f32x4){0.f, 0.f, 0.f, 0.f}, 0, 0, 0);
                const bf16x8 bUV = pack8h(U[0], U[1], U[2], U[3], vf[0], vf[1], vf[2], vf[3]);
                const bf16x8 na = *(const bf16x8*)(NA + (cn * 16 + fr) * 40 + fq * 8);
                O = __builtin_amdgcn_mfma_f32_16x16x32_bf16(na, bUV, O, 0, 0, 0);
#pragma unroll
                for (int jj = 0; jj < 4; ++jj) obase[(long)(cn * 16 + fq * 4 + jj) * tstep] = f2bf_hw(O[jj]);
#pragma unroll
                for (int kt = 0; kt < 4; ++kt) { const bf16x8 kb = *(const bf16x8*)(KBm + (cn * 64 + kt * 16 + fr) * 40 + fq * 8);
                    Sacc[kt] = __builtin_amdgcn_mfma_f32_16x16x32_bf16(kb, bUV, Sacc[kt], 0, 0, 0);
                    const f32x4 pc = *(const f32x4*)(PC + cn * 64 + kt * 16 + fq * 4);
                    Sacc[kt] = Sacc[kt] * pc; }
            }
        }
        lds_barrier();
    }
#undef WKV_LOAD_RAW
    if (!sample) { if (w < 4) { float* so = p.out + (size_t)2 * NPTOK * D + ((size_t)((b * 2 + z) * 16 + hd)) * 4096 + (size_t)(w * 16 + fr0) * 64;
#pragma unroll
        for (int kt = 0; kt < 4; ++kt)
#pragma unroll
            for (int jj = 0; jj < 4; ++jj) so[kt * 16 + fq0 * 4 + jj] = Sacc[kt][jj]; } }
    else { float* so = GH + ((size_t)u * 2 + (w >> 2)) * 4096 + (size_t)((w & 3) * 16 + fr0) * 64;
#pragma unroll
        for (int kt = 0; kt < 4; ++kt)
#pragma unroll
            for (int jj = 0; jj < 4; ++jj) so[kt * 16 + fq0 * 4 + jj] = Sacc[kt][jj]; }
    __syncthreads();
}

__device__ void wkv_fix_unit(const Params& p, int u, float* ldsf) {
    const int tid = threadIdx.x, lane = tid & 63, w = __builtin_amdgcn_readfirstlane(tid >> 6), fr = lane & 15, fq = lane >> 4;
    unsigned char* ws = p.ws;
    bf16_t* OD = (bf16_t*)(ws + WS_X1);
    const bf16_t* RHO = (const bf16_t*)(ws + WS_H);
    const float* GH = (const float*)(ws + WS_BT0);
    const int z = u >> 7, b = (u >> 6) & 1, hd = (u >> 2) & 15, vq = u & 3;
    float* SS = ldsf;
    float* GL = ldsf + 1024;
    bf16_t* SB = (bf16_t*)(ldsf + 1024 + 4096);
    const int v = tid >> 5, kp = (tid & 31) * 2;
    { const float* s0 = p.in[2] + ((size_t)((b * 2 + z) * 16 + hd)) * 4096 + (size_t)(vq * 16 + v) * 64 + kp; SS[v * 64 + kp] = s0[0]; SS[v * 64 + kp + 1] = s0[1]; }
    __syncthreads();
#pragma unroll 1
    for (int sg = 0; sg < 8; ++sg) {
        const int su = ((z * 2 + b) * 16 + hd) * 8 + sg;
        SB[v * 72 + kp] = f2bf_hw(SS[v * 64 + kp]); SB[v * 72 + kp + 1] = f2bf_hw(SS[v * 64 + kp + 1]);
        if (sg < 7) { const f32x4* gsrc = (const f32x4*)(GH + ((size_t)su * 2 + 1) * 4096);
#pragma unroll
            for (int q = 0; q < 2; ++q) ((f32x4*)GL)[tid + q * NTHR] = gsrc[tid + q * NTHR]; }
        __syncthreads();
        const int tlo = z ? (2048 - (sg + 1) * 256) : sg * 256;
#pragma unroll
        for (int q = 0; q < 2; ++q) { const int mt = 2 * w + q;
            f32x4 acc = (f32x4){0.f, 0.f, 0.f, 0.f};
#pragma unroll
            for (int ks = 0; ks < 2; ++ks) { const bf16x8 a = *(const bf16x8*)(RHO + ((size_t)z * 4096 + b * 2048 + tlo + mt * 16 + fr) * 1024 + hd * 64 + ks * 32 + fq * 8);
                const bf16x8 bb = *(const bf16x8*)(SB + fr * 72 + ks * 32 + fq * 8);
                acc = __builtin_amdgcn_mfma_f32_16x16x32_bf16(a, bb, acc, 0, 0, 0); }
#pragma unroll
            for (int jj = 0; jj < 4; ++jj) { bf16_t* op = OD + ((size_t)z * NTOK + NPTOK + b * 2048 + tlo + mt * 16 + fq * 4 + jj) * 1024 + hd * 64 + vq * 16 + fr;
                *op = f2bf_hw(bf2f(*op) + acc[jj]); } }
        if (sg < 7) {
            const float* hsrc = GH + ((size_t)su * 2 + 0) * 4096 + (size_t)(vq * 16 + v) * 64 + kp;
            float a0 = hsrc[0], a1 = hsrc[1];
#pragma unroll 8
            for (int k2 = 0; k2 < 64; ++k2) { const float sv = SS[v * 64 + k2]; a0 += sv * GL[k2 * 64 + kp]; a1 += sv * GL[k2 * 64 + kp + 1]; }
            __syncthreads();
            SS[v * 64 + kp] = a0; SS[v * 64 + kp + 1] = a1;
        }
        __syncthreads();
    }
}
__device__ void phase_wkv_fix(const Params& p, float* lds) {
    for (int it = blockIdx.x; it < 256; it += gridDim.x) wkv_fix_unit(p, it, lds);
}

__device__ void conv_tile(const Params& p, int tile) {
    const int tid = threadIdx.x;
    unsigned char* ws = p.ws;
    const bf16_t* P = (const bf16_t*)(ws + WS_P);
    bf16_t* OC = (bf16_t*)(ws + WS_OC);
    const int cgp = tid & 127, c0 = cgp * 8, sub = tid >> 7;
    float cw0[8], cw1[8], cw2[8];
#pragma unroll
    for (int j = 0; j < 8; ++j) { cw0[j] = p.in[12][c0 + j]; cw1[j] = p.in[12][1024 + c0 + j]; cw2[j] = p.in[12][2048 + c0 + j]; }
    for (int jj = 0; jj < 4; ++jj) {
        const int t = tile * 16 + sub + 4 * jj;
        const int rl = t < NPTOK ? 256 : 64; const int pos = t & (rl - 1);
        const bf16_t* row = P + (size_t)t * N0;
        const u32x4 z4 = (u32x4){0u, 0u, 0u, 0u};
        const u32x4 u1 = *(const u32x4*)(row + c0), g1 = *(const u32x4*)(row + 2048 + c0);
        const u32x4 u0 = pos > 0 ? *(const u32x4*)(row - N0 + c0) : z4, g0 = pos > 0 ? *(const u32x4*)(row - N0 + 2048 + c0) : z4;
        const u32x4 u2 = pos < rl - 1 ? *(const u32x4*)(row + N0 + c0) : z4, g2 = pos < rl - 1 ? *(const u32x4*)(row + N0 + 2048 + c0) : z4;
        const u32x4 gb = *(const u32x4*)(row + 1024 + c0), zc = *(const u32x4*)(row + 3072 + c0);
        u32x4 o;
#pragma unroll
        for (int q = 0; q < 4; ++q) {
            const float y0 = cw0[2 * q] * (bflo(g0[q]) * bflo(u0[q])) + cw1[2 * q] * (bflo(g1[q]) * bflo(u1[q])) + cw2[2 * q] * (bflo(g2[q]) * bflo(u2[q]));
            const float y1 = cw0[2 * q + 1] * (bfhi(g0[q]) * bfhi(u0[q])) + cw1[2 * q + 1] * (bfhi(g1[q]) * bfhi(u1[q])) + cw2[2 * q + 1] * (bfhi(g2[q]) * bfhi(u2[q]));
            o[q] = pack2(silu(bflo(zc[q])) * bflo(gb[q]) * y0, silu(bfhi(zc[q])) * bfhi(gb[q]) * y1);
        }
        *(u32x4*)(OC + (size_t)t * 2048 + c0) = o;
    }
}

__device__ void phase_mix0(const Params& p, float* lds, int rep) {
    unsigned* ctr = (unsigned*)(p.ws + WS_CTL) + rep * 32;
    int* slot = (int*)(lds + LDS_MAIN / 4);
    constexpr int NSCAN = 1024, NCONV = 512;
    for (;;) {
        if (threadIdx.x == 0) *slot = (int)atomicAdd(ctr, 1u);
        __syncthreads();
        const int it = *slot;
        __syncthreads();
        if (it >= NSCAN + NCONV) break;
        if (it < NSCAN) wkv_unit(p, it, lds); else conv_tile(p, it - NSCAN);
    }
}

__device__ __forceinline__ float quad_sum(float v) {
    v += __int_as_float(__builtin_amdgcn_update_dpp(0, __float_as_int(v), 0xB1, 0xF, 0xF, true));
    v += __int_as_float(__builtin_amdgcn_update_dpp(0, __float_as_int(v), 0x4E, 0xF, 0xF, true));
    return v;
}
__device__ void phase_wkv_post(const Params& p) {
    const int tid = threadIdx.x, wave = tid >> 6, lane = tid & 63;
    unsigned char* ws = p.ws;
    const bf16_t* P = (const bf16_t*)(ws + WS_P);
    const bf16_t* OD = (const bf16_t*)(ws + WS_X1);
    const float* BON = (const float*)(ws + WS_BON);
    bf16_t* OC = (bf16_t*)(ws + WS_OC);
    const int hh = lane >> 2, ch0 = hh * 64 + (lane & 3) * 16;
    for (int tok = blockIdx.x * 8 + wave; tok < NTOK; tok += gridDim.x * 8) {
        const bf16_t* row = P + (size_t)tok * N0;
        u32x4 a0[2], a1[2], vv[2], zz[2];
#pragma unroll
        for (int h = 0; h < 2; ++h) { a0[h] = *(const u32x4*)(OD + (size_t)tok * 1024 + ch0 + h * 8); a1[h] = *(const u32x4*)(OD + ((size_t)NTOK + tok) * 1024 + ch0 + h * 8);
            vv[h] = *(const u32x4*)(row + 6144 + ch0 + h * 8); zz[h] = *(const u32x4*)(row + 7168 + ch0 + h * 8); }
        const float bon = BON[(size_t)tok * 16 + hh] + BON[((size_t)NTOK + tok) * 16 + hh];
        float o[16]; float s1 = 0.f;
#pragma unroll
        for (int h = 0; h < 2; ++h)
#pragma unroll
            for (int q = 0; q < 4; ++q) { o[h * 8 + 2 * q] = bflo(a0[h][q]) + bflo(a1[h][q]); o[h * 8 + 2 * q + 1] = bfhi(a0[h][q]) + bfhi(a1[h][q]); s1 += o[h * 8 + 2 * q] + o[h * 8 + 2 * q + 1]; }
        const float mu = quad_sum(s1) * (1.f / 64.f);
        float s2 = 0.f;
#pragma unroll
        for (int i = 0; i < 16; ++i) { o[i] -= mu; s2 += o[i] * o[i]; }
        const float rs = rsqrtf(quad_sum(s2) * (1.f / 64.f) + 64e-5f);
        float res[16];
#pragma unroll
        for (int g4 = 0; g4 < 4; ++g4) { const f32x4 lw4 = *(const f32x4*)(p.in[22] + ch0 + g4 * 4), lb4 = *(const f32x4*)(p.in[23] + ch0 + g4 * 4);
#pragma unroll
            for (int e = 0; e < 4; ++e) { const int i = g4 * 4 + e; const unsigned vw = vv[i >> 3][(i & 7) >> 1], zw_ = zz[i >> 3][(i & 7) >> 1];
                const float v1 = (i & 1) ? bfhi(vw) : bflo(vw), z1 = (i & 1) ? bfhi(zw_) : bflo(zw_);
                res[i] = (o[i] * rs * lw4[e] + lb4[e] + bon * v1) * silu(z1); } }
#pragma unroll
        for (int h = 0; h < 2; ++h) { u32x4 w4; w4.x = pk2(res[h * 8 + 0], res[h * 8 + 1]); w4.y = pk2(res[h * 8 + 2], res[h * 8 + 3]); w4.z = pk2(res[h * 8 + 4], res[h * 8 + 5]); w4.w = pk2(res[h * 8 + 6], res[h * 8 + 7]);
            *(u32x4*)(OC + (size_t)tok * 2048 + 1024 + ch0 + h * 8) = w4; }
    }
}

constexpr size_t WS_QE = WS_H;
constexpr size_t WS_KDT = WS_BT0;
constexpr size_t WS_VT = WS_OC + (size_t)NTOK * 1024 * 2;
constexpr size_t WS_EBL = WS_BON + (size_t)2 * NTOK * 16 * 4;
constexpr size_t WS_ATT = WS_P + 52 * MB;

__device__ void gla_a_item(const Params& p, int item, float* ldsf) {
    const int tid = threadIdx.x, lane = tid & 63, w = __builtin_amdgcn_readfirstlane(tid >> 6), fr = lane & 15, fq = lane >> 4;
    unsigned char* ws = p.ws;
    const bf16_t* P1 = (const bf16_t*)(ws + WS_P);
    float* OD = (float*)(ws + WS_P2);
    bf16_t* QEg = (bf16_t*)(ws + WS_QE); bf16_t* KDTg = (bf16_t*)(ws + WS_KDT); bf16_t* VTg = (bf16_t*)(ws + WS_VT); float* EBLg = (float*)(ws + WS_EBL);
    const int hd = item & 3, c = (item >> 2) & 127, z = item >> 9, tok0 = c * 64;
    bf16_t* QE = (bf16_t*)ldsf;
    bf16_t* KE = QE + 64 * 136;
    bf16_t* VT = KE + 64 * 136;
    bf16_t* ATT = VT + 256 * 72;
    float* G = (float*)(ATT + 64 * 72);
    float* L1G = G + 64 * 132;
    float* GK2 = L1G + 1024;
    for (int i = tid; i < 1024; i += NTHR) { const int t = i >> 4, r = i & 15; L1G[i] = bf2f(P1[(size_t)(tok0 + t) * N1 + 3072 + z * 16 + r]); }
    for (int i = tid; i < 2048; i += NTHR) { const int r = i >> 7, d = i & 127; GK2[i] = p.in[27][(size_t)(z * 16 + r) * 512 + hd * 128 + d]; }
#pragma unroll
    for (int ps = 0; ps < 4; ++ps) { const int t = lane, e8 = (ps * 8 + w) * 8;
        const u32x4 v8 = *(const u32x4*)(P1 + (size_t)(tok0 + t) * N1 + 1024 + hd * 256 + e8);
        VT[(e8 + 0) * 72 + t] = (bf16_t)(v8.x & 0xFFFF); VT[(e8 + 1) * 72 + t] = (bf16_t)(v8.x >> 16); VT[(e8 + 2) * 72 + t] = (bf16_t)(v8.y & 0xFFFF); VT[(e8 + 3) * 72 + t] = (bf16_t)(v8.y >> 16);
        VT[(e8 + 4) * 72 + t] = (bf16_t)(v8.z & 0xFFFF); VT[(e8 + 5) * 72 + t] = (bf16_t)(v8.z >> 16); VT[(e8 + 6) * 72 + t] = (bf16_t)(v8.w & 0xFFFF); VT[(e8 + 7) * 72 + t] = (bf16_t)(v8.w >> 16); }
    const int d = tid & 127, tq = tid >> 7;
    const float gbias = p.in[28][z * 512 + hd * 128 + d];
    bf16_t qraw[16], kraw[16];
#pragma unroll
    for (int i = 0; i < 16; ++i) { const size_t row = (size_t)(tok0 + tq * 16 + i) * N1; qraw[i] = P1[row + hd * 128 + d]; kraw[i] = P1[row + 512 + hd * 128 + d]; }
    __syncthreads();
    { float run = 0.f;
#pragma unroll 4
      for (int i = 0; i < 16; ++i) { const int t = z ? (tq * 16 + 15 - i) : (tq * 16 + i);
        float x = gbias;
#pragma unroll
        for (int r = 0; r < 16; ++r) x += L1G[t * 16 + r] * GK2[r * 128 + d];
        const float ls = fminf(x, 0.f) - flog(1.f + fexp(-fabsf(x)));
        run += ls * (1.f / 16.f);
        G[t * 132 + d] = run; } }
    __syncthreads();
    { const int lastr = z ? 0 : 15;
      const float t0 = G[(0 + lastr) * 132 + d], t1 = G[(16 + lastr) * 132 + d], t2 = G[(32 + lastr) * 132 + d], t3 = G[(48 + lastr) * 132 + d];
      const float blast = t0 + t1 + t2 + t3;
      float off;
      if (z == 0) off = tq == 0 ? 0.f : (tq == 1 ? t0 : (tq == 2 ? t0 + t1 : t0 + t1 + t2));
      else off = tq == 3 ? 0.f : (tq == 2 ? t3 : (tq == 1 ? t3 + t2 : t3 + t2 + t1));
      if (tq == 0) EBLg[(size_t)(z * 128 + c) * 512 + hd * 128 + d] = fexp(blast);
      unsigned kdp[8];
#pragma unroll
      for (int i = 0; i < 16; ++i) { const int t = tq * 16 + i;
        const float bc = G[t * 132 + d] + off;
        const float q = bf2f(qraw[i]) * 0.08838834764831845f, k = bf2f(kraw[i]);
        const bf16_t qe = f2bf(q * fexp(bc));
        QE[t * 136 + d] = qe; KE[t * 136 + d] = f2bf(k * fexp(-bc));
        const unsigned kd = (unsigned)f2bf(k * fexp(blast - bc));
        if (i & 1) kdp[i >> 1] |= kd << 16; else kdp[i >> 1] = kd; }
      bf16_t* kdst = KDTg + ((size_t)(((z * 128 + c) * 4 + hd) * 128 + d)) * 64 + tq * 16;
      *(u32x4*)kdst = (u32x4){kdp[0], kdp[1], kdp[2], kdp[3]}; *(u32x4*)(kdst + 8) = (u32x4){kdp[4], kdp[5], kdp[6], kdp[7]}; }
    __syncthreads();
#pragma unroll
    for (int q2 = 0; q2 < 2; ++q2) { const int idx = q2 * NTHR + tid; const int t = idx >> 4, d8 = (idx & 15) * 8;
        *(u32x4*)(QEg + ((size_t)z * NTOK + tok0 + t) * 512 + hd * 128 + d8) = *(const u32x4*)(QE + t * 136 + d8); }
    if (z == 0) {
#pragma unroll
        for (int q4 = 0; q4 < 4; ++q4) { const int idx = q4 * NTHR + tid; const int e = idx >> 3, t8 = (idx & 7) * 8;
            *(u32x4*)(VTg + ((size_t)((c * 4 + hd) * 256 + e)) * 64 + t8) = *(const u32x4*)(VT + e * 72 + t8); } }
#pragma unroll
    for (int q2 = 0; q2 < 2; ++q2) { const int tA = 2 * w + q2, ia = tA >> 2, ja = tA & 3;
        f32x4 a4 = (f32x4){0.f, 0.f, 0.f, 0.f};
        if (z ? (ja >= ia) : (ja <= ia)) a4 = mma_nt(QE + ia * 16 * 136, 136, KE + ja * 16 * 136, 136, 128, a4, fr, fq);
#pragma unroll
        for (int jj = 0; jj < 4; ++jj) { const int i = ia * 16 + fq * 4 + jj, j = ja * 16 + fr; const bool keep = z ? (j >= i) : (j <= i); ATT[i * 72 + j] = f2bf(keep ? a4[jj] : 0.f); } }
    __syncthreads();
    { bf16_t* ATTg = (bf16_t*)(ws + WS_ATT) + ((size_t)((z * 128 + c) * 4 + hd)) * 4096;
      const int i = tid >> 3, j8 = (tid & 7) * 8;
      *(u32x4*)(ATTg + i * 64 + j8) = *(const u32x4*)(ATT + i * 72 + j8); }
    __syncthreads();
}

__device__ void phase_gla_a(const Params& p, float* lds) {
    for (int it = blockIdx.x; it < 1024; it += gridDim.x) gla_a_item(p, it, lds);
}

struct GlaFrags { bf16x8 kdt[2]; u32x4 vts; u32x4 qes[2]; bf16x8 att[2]; f32x4 ebl; };

__device__ void gla_b_unit(const Params& p, int u, float* ldsf) {
    const int tid = threadIdx.x, lane = tid & 63, w = __builtin_amdgcn_readfirstlane(tid >> 6), fr = lane & 15, fq = lane >> 4;
    unsigned char* ws = p.ws;
    float* OD = (float*)(ws + WS_P2);
    const bf16_t* QEg = (const bf16_t*)(ws + WS_QE); const bf16_t* KDTg = (const bf16_t*)(ws + WS_KDT); const bf16_t* VTg = (const bf16_t*)(ws + WS_VT); const float* EBLg = (const float*)(ws + WS_EBL);
    const bf16_t* ATTg = (const bf16_t*)(ws + WS_ATT);
    int z, b, hd, eq, nch, ch0; bool sample;
    if (u < 64) { sample = true; z = u >> 5; b = (u >> 4) & 1; hd = (u >> 2) & 3; eq = u & 3; nch = 32; ch0 = 64 + b * 32; }
    else { const int q = u - 64; sample = false; z = q >> 8; b = (q >> 4) & 15; hd = (q >> 2) & 3; eq = q & 3; nch = 4; ch0 = b * 4; }
    bf16_t* ST = (bf16_t*)ldsf;
    bf16_t* VTL = ST + 2 * 64 * 136;
    bf16_t* QEL = VTL + 2 * 64 * 72;
    f32x4 Sacc[4];
    if (sample) { const float* s0 = p.in[3] + ((size_t)((b * 2 + z) * 4 + hd)) * 32768 + eq * 64 + fr;
#pragma unroll
        for (int et = 0; et < 4; ++et)
#pragma unroll
            for (int jj = 0; jj < 4; ++jj) Sacc[et][jj] = s0[(size_t)(w * 16 + fq * 4 + jj) * 256 + et * 16]; }
    else {
#pragma unroll
        for (int et = 0; et < 4; ++et) Sacc[et] = (f32x4){0.f, 0.f, 0.f, 0.f}; }
    const int it = w >> 1, e2 = (w & 1) * 2;
    const int ve = tid >> 3, vt8 = (tid & 7) * 8;
#define GLB_LOAD(F, c_) do { const int cc_ = (c_); \
        _Pragma("unroll") for (int ks = 0; ks < 2; ++ks) { (F).kdt[ks] = *(const bf16x8*)(KDTg + ((size_t)(((z * 128 + cc_) * 4 + hd) * 128 + w * 16 + fr)) * 64 + ks * 32 + fq * 8); \
            (F).att[ks] = *(const bf16x8*)(ATTg + ((size_t)((z * 128 + cc_) * 4 + hd)) * 4096 + (it * 16 + fr) * 64 + ks * 32 + fq * 8); } \
        (F).vts = *(const u32x4*)(VTg + ((size_t)((cc_ * 4 + hd) * 256 + eq * 64 + ve)) * 64 + vt8); \
        _Pragma("unroll") for (int h_ = 0; h_ < 2; ++h_) (F).qes[h_] = *(const u32x4*)(QEg + ((size_t)z * NTOK + cc_ * 64 + ve) * 512 + hd * 128 + h_ * 64 + vt8); \
        (F).ebl = *(const f32x4*)(EBLg + (size_t)(z * 128 + cc_) * 512 + hd * 128 + w * 16 + fq * 4); } while (0)
#define GLB_STEP(CUR, NX2, ci_) do { const int ci = (ci_); if (ci < nch) { \
        const int c = ch0 + (z ? nch - 1 - ci : ci); \
        bf16_t* STc = ST + (ci & 1) * 64 * 136; bf16_t* VTc = VTL + (ci & 1) * 64 * 72; \
        _Pragma("unroll") for (int et = 0; et < 4; ++et) { u32x2 v2; v2.x = pk2(Sacc[et][0], Sacc[et][1]); v2.y = pk2(Sacc[et][2], Sacc[et][3]); \
            *(u32x2*)(STc + (et * 16 + fr) * 136 + w * 16 + fq * 4) = v2; } \
        *(u32x4*)(VTc + ve * 72 + vt8) = (CUR).vts; \
        bf16_t* QEc = QEL + (ci & 1) * 64 * 136; \
        *(u32x4*)(QEc + ve * 136 + vt8) = (CUR).qes[0]; *(u32x4*)(QEc + ve * 136 + 64 + vt8) = (CUR).qes[1]; \
        if (ci + 2 < nch) GLB_LOAD(NX2, ch0 + (z ? nch - 3 - ci : ci + 2)); \
        lds_barrier(); \
        _Pragma("unroll") for (int et = 0; et < 4; ++et) { Sacc[et] = Sacc[et] * (CUR).ebl; \
            _Pragma("unroll") for (int ks = 0; ks < 2; ++ks) { const bf16x8 vf = *(const bf16x8*)(VTc + (et * 16 + fr) * 72 + ks * 32 + fq * 8); \
                Sacc[et] = __builtin_amdgcn_mfma_f32_16x16x32_bf16((CUR).kdt[ks], vf, Sacc[et], 0, 0, 0); } } \
        _Pragma("unroll") for (int q2 = 0; q2 < 2; ++q2) { f32x4 o = (f32x4){0.f, 0.f, 0.f, 0.f}; \
            _Pragma("unroll") for (int ks = 0; ks < 2; ++ks) { const bf16x8 vf = *(const bf16x8*)(VTc + ((e2 + q2) * 16 + fr) * 72 + ks * 32 + fq * 8); \
                o = __builtin_amdgcn_mfma_f32_16x16x32_bf16((CUR).att[ks], vf, o, 0, 0, 0); } \
            _Pragma("unroll") for (int ks = 0; ks < 4; ++ks) { const bf16x8 bS = *(const bf16x8*)(STc + ((e2 + q2) * 16 + fr) * 136 + ks * 32 + fq * 8); \
                const bf16x8 aq = *(const bf16x8*)(QEc + (it * 16 + fr) * 136 + ks * 32 + fq * 8); \
                o = __builtin_amdgcn_mfma_f32_16x16x32_bf16(aq, bS, o, 0, 0, 0); } \
            _Pragma("unroll") for (int jj = 0; jj < 4; ++jj) OD[((size_t)z * NTOK + c * 64 + it * 16 + fq * 4 + jj) * 1024 + hd * 256 + eq * 64 + (e2 + q2) * 16 + fr] = o[jj]; } } } while (0)
    GlaFrags fa, fb, fc;
    GLB_LOAD(fa, ch0 + (z ? nch - 1 : 0));
    GLB_LOAD(fb, ch0 + (z ? nch - 2 : 1));
    __syncthreads();
#pragma unroll 1
    for (int ci3 = 0; ci3 < nch; ci3 += 3) { GLB_STEP(fa, fc, ci3); GLB_STEP(fb, fa, ci3 + 1); GLB_STEP(fc, fb, ci3 + 2); }
#undef GLB_STEP
#undef GLB_LOAD
    if (!sample) { float* so = p.out + (size_t)2 * NPTOK * D + 2097152 + ((size_t)((b * 2 + z) * 4 + hd)) * 32768 + eq * 64 + fr;
#pragma unroll
        for (int et = 0; et < 4; ++et)
#pragma unroll
            for (int jj = 0; jj < 4; ++jj) so[(size_t)(w * 16 + fq * 4 + jj) * 256 + et * 16] = Sacc[et][jj]; }
    __syncthreads();
}

__device__ void phase_gla_b(const Params& p, float* lds, int rep) {
    unsigned* ctr = (unsigned*)(p.ws + WS_CTL) + 16 + rep * 32;
    int* slot = (int*)(lds + LDS_MAIN / 4);
    for (;;) {
        if (threadIdx.x == 0) *slot = (int)atomicAdd(ctr, 1u);
        __syncthreads();
        const int it = *slot;
        __syncthreads();
        if (it >= 576) break;
        gla_b_unit(p, it, lds);
    }
}

__device__ void phase_gla_post(const Params& p) {
    const int tid = threadIdx.x, wave = tid >> 6, lane = tid & 63;
    unsigned char* ws = p.ws;
    const bf16_t* P1 = (const bf16_t*)(ws + WS_P);
    const float* OD = (const float*)(ws + WS_P2);
    bf16_t* OG = (bf16_t*)(ws + WS_OC);
    for (int tok = blockIdx.x * 8 + wave; tok < NTOK; tok += gridDim.x * 8) {
        for (int hd = 0; hd < 4; ++hd) { const int idx = hd * 256 + lane * 4;
            const f32x4 a = *(const f32x4*)(OD + (size_t)tok * 1024 + idx), b2 = *(const f32x4*)(OD + ((size_t)NTOK + tok) * 1024 + idx);
            const f32x4 o = a + b2;
            const float ss = wave_sum(o[0] * o[0] + o[1] * o[1] + o[2] * o[2] + o[3] * o[3]);
            const float rs = rsqrtf(ss * (1.f / 256.f) + 1e-6f);
            const f32x4 gn = *(const f32x4*)(p.in[29] + lane * 4);
            const u32x2 zz = *(const u32x2*)(P1 + (size_t)tok * N1 + 2048 + idx);
            const float z0 = bflo(zz.x), z1 = bfhi(zz.x), z2 = bflo(zz.y), z3 = bfhi(zz.y);
            u32x2 w; w.x = pack2(o[0] * rs * gn[0] * silu(z0), o[1] * rs * gn[1] * silu(z1)); w.y = pack2(o[2] * rs * gn[2] * silu(z2), o[3] * rs * gn[3] * silu(z3));
            *(u32x2*)(OG + (size_t)tok * 1024 + idx) = w; }
    }
}

__device__ void phase_final(const Params& p) {
    const int tid = threadIdx.x, wave = tid >> 6, lane = tid & 63;
    unsigned char* ws = p.ws;
    const float* MOD = (const float*)(ws + WS_MOD);
    const float* X1 = (const float*)(ws + WS_X1);
    const float* Y = (const float*)(ws + WS_P2);
    for (int tok = blockIdx.x * 8 + wave; tok < NTOK; tok += gridDim.x * 8) {
        const int cond = tok < NPTOK ? 0 : 1 + ((tok - NPTOK) >> 11);
        f32x4 xv[4]; float ss = 0.f;
#pragma unroll
        for (int i = 0; i < 4; ++i) { const int idx = i * 256 + lane * 4;
            const f32x4 x1 = *(const f32x4*)(X1 + (size_t)tok * D + idx);
            const f32x4 ya = *(const f32x4*)(Y + (size_t)tok * D + idx), yb = *(const f32x4*)(Y + (size_t)NTOK * D + (size_t)tok * D + idx);
            const f32x4 gt = *(const f32x4*)(MOD + (1 * 3 + cond) * 3072 + 2048 + idx);
            xv[i] = x1 + gt * (ya + yb);
            ss += xv[i][0] * xv[i][0] + xv[i][1] * xv[i][1] + xv[i][2] * xv[i][2] + xv[i][3] * xv[i][3]; }
        ss = wave_sum(ss);
        const float rstd = rsqrtf(ss * (1.f / 1024.f) + 1e-6f);
#pragma unroll
        for (int i = 0; i < 4; ++i) { const int idx = i * 256 + lane * 4;
            const f32x4 g = *(const f32x4*)(p.in[9] + idx);
            f32x4 o;
#pragma unroll
            for (int j = 0; j < 4; ++j) o[j] = xv[i][j] * rstd * g[j];
            *(f32x4*)(p.out + (size_t)tok * D + idx) = o; }
    }
}


#define XB_TMO      128
#define XB_XCNT(j)  (256  + 64 * (j))
#define XB_XSUB(j)  (1280 + 64 * (j))
#define XB_XGEN(j)  (2304 + 64 * (j))
#define XB_TOP      3328
#define XB_TOPGEN   3392
#define XCD_BAR_WORDS 3456
#define XB_SPIN_CAP (1u << 18)

__device__ __forceinline__ unsigned xb_ld(unsigned* p)              { return __hip_atomic_load(p, __ATOMIC_RELAXED, __HIP_MEMORY_SCOPE_AGENT); }
__device__ __forceinline__ unsigned xb_add(unsigned* p, unsigned v) { return __hip_atomic_fetch_add(p, v, __ATOMIC_RELAXED, __HIP_MEMORY_SCOPE_AGENT); }
__device__ __forceinline__ unsigned xb_xcc_id() { return (unsigned)__builtin_amdgcn_s_getreg((3 << 11) | 20) & 0xFu; }
#define XB_SPIN(cond, bar) do { unsigned _sp = 0; while (cond) { __builtin_amdgcn_s_sleep(1); \
    if ((++_sp & 255u) == 0u) { if (xb_ld(&(bar)[XB_TMO])) break; if (_sp > XB_SPIN_CAP) { atomicAdd(&(bar)[XB_TMO], 1u); break; } } } } while (0)

struct XcdBarrier {
    unsigned* bar; unsigned x;
    volatile LAS unsigned* st;
};

__device__ __forceinline__ XcdBarrier xcd_barrier_post(unsigned* bar, volatile LAS unsigned* st) {
    XcdBarrier b; b.bar = bar; b.x = xb_xcc_id(); b.st = st;
    if (threadIdx.x == 0) (void)xb_add(&bar[XB_XCNT(b.x)], 1u);
    return b;
}
__device__ __forceinline__ void xcd_barrier_complete(unsigned* bar, unsigned x, unsigned& nloc, unsigned& nx) {
    const unsigned G = gridDim.x * gridDim.y * gridDim.z;
    unsigned sum, cnt, mine, sp = 0u;
    for (;;) {
        sum = 0u; cnt = 0u; mine = 0u;
#pragma unroll
        for (unsigned j = 0; j < 16; ++j) { const unsigned c = xb_ld(&bar[XB_XCNT(j)]); sum += c; cnt += (c > 0u) ? 1u : 0u; mine = (j == x) ? c : mine; }
        if (sum == G) break;
        __builtin_amdgcn_s_sleep(1);
        if ((++sp & 255u) == 0u) { if (xb_ld(&bar[XB_TMO])) break; if (sp > XB_SPIN_CAP) { atomicAdd(&bar[XB_TMO], 1u); break; } }
    }
    nloc = mine > 0u ? mine : 1u; nx = cnt > 0u ? cnt : 1u;
}

__device__ __forceinline__ void xcd_barrier(const XcdBarrier& b) {
    asm volatile("s_waitcnt vmcnt(0)" ::: "memory");
    __syncthreads();
    if (threadIdx.x == 0) {
        unsigned* bar = b.bar;
        __builtin_amdgcn_s_waitcnt(0);
        unsigned nloc = b.st[0], nx = b.st[1];
        if (nloc == 0u) { xcd_barrier_complete(bar, b.x, nloc, nx); b.st[0] = nloc; b.st[1] = nx; }
        const unsigned old = xb_add(&bar[XB_XSUB(b.x)], 1u);
        const unsigned gen = old / nloc;
        if (old + 1u == (gen + 1u) * nloc) {
            __builtin_amdgcn_fence(__ATOMIC_RELEASE, "agent");
            asm volatile("s_waitcnt vmcnt(0)" ::: "memory");
            const unsigned og = xb_add(&bar[XB_TOP], 1u);
            const unsigned tg = og / nx;
            if (og + 1u == (tg + 1u) * nx) xb_add(&bar[XB_TOPGEN], 1u);
            else XB_SPIN(xb_ld(&bar[XB_TOPGEN]) == tg, bar);
            __builtin_amdgcn_fence(__ATOMIC_ACQUIRE, "agent");
            xb_add(&bar[XB_XGEN(b.x)], 1u);
            asm volatile("s_waitcnt vmcnt(0)" ::: "memory");
        } else {
            XB_SPIN(xb_ld(&bar[XB_XGEN(b.x)]) == gen, bar);
            __builtin_amdgcn_fence(__ATOMIC_ACQUIRE, "agent");
            asm volatile("s_waitcnt vmcnt(0)" ::: "memory");
        }
    }
    __syncthreads();
}


constexpr int NPHASE = 14;
__global__ void __launch_bounds__(NTHR, 2) fwd_megakernel(Params p) {
    extern __shared__ __attribute__((aligned(16))) unsigned char smem[];
    float* ldsf = (float*)smem;
    LAS unsigned char* ldsl = (LAS unsigned char*)smem;
    unsigned char* ws = p.ws;
    volatile LAS unsigned* xst = (volatile LAS unsigned*)(ldsl + LDS_MAIN + 16);
    if (threadIdx.x == 0) { xst[0] = 0u; xst[1] = 0u; }
    __syncthreads();
    const XcdBarrier xbar = xcd_barrier_post((unsigned*)(ws + WS_BAR), xst);
    if (p.ph_lo < 0) cg::this_grid().sync();
#ifndef DUP_PHASE
#define DUP_PHASE -1
#endif
#define PHASE(n) if (p.ph_lo <= (n) && (n) < p.ph_hi && ((n) == p.ph_lo || (xcd_barrier(xbar), true))) for (int rep = 0; rep < ((n) == DUP_PHASE ? 2 : 1); ++rep, ((n) == DUP_PHASE ? (xcd_barrier(xbar), 0) : 0))
    PHASE(0) phase_prologue(p, ldsf);
    PHASE(1) phase_h(p, 0, ldsf);
    PHASE(2) { pg8::Gemm g{(const bf16_t*)(ws + WS_H), (const bf16_t*)(ws + WS_BT0), NTOK, 8192, 1024, 1024, 1}; pg8::Order S; S.init(NTOK, 8192, 1, gridDim.x, blockIdx.x);
               pg8::EpiBf16 E{(bf16_t*)(ws + WS_P), N0}; pg8::gemm_phase(ldsl, g, S, E); }
    PHASE(3) phase_mix0(p, ldsf, rep);
    PHASE(4) { phase_wkv_fix(p, ldsf); phase_late_weights(p, ldsf); }
    PHASE(5) phase_wkv_post(p);
    PHASE(6) { pg8::Gemm g{(const bf16_t*)(ws + WS_OC), (const bf16_t*)(ws + WS_WT0O), NTOK, 1024, 1024, 2048, 2}; pg8::Order S; S.init(NTOK, 1024, 2, gridDim.x, blockIdx.x);
               pg8::EpiF32 E{(float*)(ws + WS_P), 1024, (size_t)NTOK * 1024}; pg8::gemm_phase(ldsl, g, S, E); }
    PHASE(7) phase_h(p, 1, ldsf);
    PHASE(8) { pg8::Gemm g{(const bf16_t*)(ws + WS_H), (const bf16_t*)(ws + WS_BT1), NTOK, N1, 1024, 1024, 1}; pg8::Order S; S.init(NTOK, N1, 1, gridDim.x, blockIdx.x);
               pg8::EpiBf16 E{(bf16_t*)(ws + WS_P), N1}; pg8::gemm_phase(ldsl, g, S, E); }
    PHASE(9) phase_gla_a(p, ldsf);
    PHASE(10) phase_gla_b(p, ldsf, rep);
    PHASE(11) phase_gla_post(p);
    PHASE(12) { pg8::Gemm g{(const bf16_t*)(ws + WS_OC), (const bf16_t*)(ws + WS_WT1O), NTOK, 1024, 512, 1024, 2}; pg8::Order S; S.init(NTOK, 1024, 2, gridDim.x, blockIdx.x);
                pg8::EpiF32 E{(float*)(ws + WS_P2), 1024, (size_t)NTOK * 1024}; pg8::gemm_phase(ldsl, g, S, E); }
    PHASE(13) phase_final(p);
}

extern "C" void kernel_launch(void* const* d_in, const int* in_sizes, int n_in, void* d_out, int out_size, void* d_ws, size_t ws_size, hipStream_t stream) {
    static int grid = 0;
    if (grid == 0) {
        if (n_in != 30 || ws_size < WS_END) { fprintf(stderr, "kernel_launch: unexpected n_in %d / ws_size %zu (need %zu)\n", n_in, ws_size, (size_t)WS_END); grid = -1; return; }
        int dev = 0, cus = 0, per_cu = 0;
        hipGetDevice(&dev);
        hipDeviceGetAttribute(&cus, hipDeviceAttributeMultiprocessorCount, dev);
        hipFuncSetAttribute((const void*)fwd_megakernel, hipFuncAttributeMaxDynamicSharedMemorySize, LDS_BYTES);
        hipOccupancyMaxActiveBlocksPerMultiprocessor(&per_cu, (const void*)fwd_megakernel, NTHR, LDS_BYTES);
        if (per_cu < 1) { fprintf(stderr, "kernel_launch: occupancy query returned %d\n", per_cu); per_cu = 1; }
        grid = cus * per_cu;
        (void)hipGetLastError();
    }
    if (grid < 0) return;
    static_assert(XCD_BAR_WORDS * 4 <= 14336, "barrier words overlap the queue counters");
    hipMemsetAsync((char*)d_ws + WS_BAR, 0, 14336 + 256, stream);
    Params p{};
    for (int i = 0; i < 30; ++i) p.in[i] = (const float*)d_in[i];
    p.out = (float*)d_out; p.ws = (unsigned char*)d_ws;
#if MULTI_LAUNCH
    for (int ph = 0; ph < NPHASE; ++ph) { p.ph_lo = ph; p.ph_hi = ph + 1; hipLaunchKernelGGL(fwd_megakernel, dim3(grid), dim3(NTHR), LDS_BYTES, stream, p); }
#else
    p.ph_lo = 0; p.ph_hi = NPHASE;
    void* args[] = {&p};
    hipError_t e = hipLaunchCooperativeKernel((const void*)fwd_megakernel, dim3(grid), dim3(NTHR), args, LDS_BYTES, stream);
    if (e != hipSuccess) fprintf(stderr, "cooperative launch failed: %s (grid %d)\n", hipGetErrorString(e), grid);
#endif
}
```

```cpp
#include <hip/hip_runtime.h>
#include <hip/hip_cooperative_groups.h>
#include <cstdio>
namespace cg = cooperative_groups;

#define LAS __attribute__((address_space(3)))
typedef unsigned short bf16_t;
typedef short bf16x8 __attribute__((ext_vector_type(8)));
typedef float f32x4 __attribute__((ext_vector_type(4)));
typedef unsigned u32x4 __attribute__((ext_vector_type(4)));
typedef unsigned u32x2 __attribute__((ext_vector_type(2)));

#ifndef MULTI_LAUNCH
#define MULTI_LAUNCH 0
#endif

constexpr int D = 1024, NTOK = 8192, NPTOK = 4096;
constexpr int N0 = 8448;
constexpr int N1 = 3328;
constexpr int NTHR = 512;
constexpr int LDS_MAIN = 139264;
constexpr int LDS_BYTES = LDS_MAIN + 256;

constexpr size_t MB = 1024 * 1024;
constexpr size_t WS_CTL = 0x1A0000 + 14336;
constexpr size_t WS_MOD = 4096;
constexpr size_t WS_BON = WS_MOD + 2 * 3 * 3072 * 4;
constexpr size_t WS_BAR = 0x1A0000;
constexpr size_t WS_BT0 = 2 * MB;
constexpr size_t WS_WT0O = WS_BT0 + (size_t)N0 * 1024 * 2;
constexpr size_t WS_BT1 = WS_WT0O + (size_t)1024 * 2048 * 2;
constexpr size_t WS_WT1O = WS_BT1 + (size_t)N1 * 1024 * 2;
constexpr size_t WS_H = WS_WT1O + (size_t)1024 * 1024 * 2;
constexpr size_t WS_OC = WS_H + (size_t)NTOK * 1024 * 2;
constexpr size_t WS_X1 = WS_OC + (size_t)NTOK * 2048 * 2;
constexpr size_t WS_P = WS_X1 + (size_t)NTOK * 1024 * 4;
constexpr size_t WS_P2 = WS_P + 64 * MB;
constexpr size_t WS_END = WS_P + (size_t)NTOK * N0 * 2;

struct Params {
    const float* in[30];
    float* out;
    unsigned char* ws;
    int ph_lo, ph_hi;
};

__device__ __forceinline__ float bf2f(bf16_t h) { return __uint_as_float(((unsigned)h) << 16); }
__device__ __forceinline__ bf16_t f2bf(float f) { unsigned u = __float_as_uint(f); u += 0x7FFFu + ((u >> 16) & 1u); return (bf16_t)(u >> 16); }
__device__ __forceinline__ unsigned pack2(float lo, float hi) { return (unsigned)f2bf(lo) | ((unsigned)f2bf(hi) << 16); }
__device__ __forceinline__ float bflo(unsigned w) { return __uint_as_float(w << 16); }
__device__ __forceinline__ float bfhi(unsigned w) { return __uint_as_float(w & 0xFFFF0000u); }
__device__ __forceinline__ float fexp(float x) { return __builtin_amdgcn_exp2f(x * 1.44269504f); }
__device__ __forceinline__ float flog(float x) { return __builtin_amdgcn_logf(x) * 0.69314718f; }
__device__ __forceinline__ float silu(float x) { return x * __builtin_amdgcn_rcpf(1.f + fexp(-x)); }
__device__ __forceinline__ float wave_sum(float v) {
#pragma unroll
    for (int m = 32; m >= 1; m >>= 1) v += __shfl_xor(v, m, 64);
    return v;
}

typedef float f32x2_t __attribute__((ext_vector_type(2)));
typedef __bf16 bf16x2_t __attribute__((ext_vector_type(2)));
__device__ __forceinline__ unsigned pk2(float lo, float hi) { const f32x2_t v = {lo, hi}; return __builtin_bit_cast(unsigned, __builtin_convertvector(v, bf16x2_t)); }
__device__ __forceinline__ bf16_t f2bf_hw(float f) { return __builtin_bit_cast(bf16_t, (__bf16)f); }

__device__ __forceinline__ void lds_barrier() { asm volatile("s_waitcnt lgkmcnt(0)" ::: "memory"); __builtin_amdgcn_s_barrier(); asm volatile("" ::: "memory"); }

namespace pg8 {
constexpr int BM = 256, BK = 64, HALF = 128, HTB = HALF * BK * 2, NXCD = 8, WGM = 8;
__device__ __forceinline__ int lds_byte(int r, int c) { const int st = (r >> 4) * 2 + (c >> 5), rr = r & 15, cc = c & 31, ob = rr * 64 + cc * 2; return st * 1024 + (ob ^ (((ob >> 9) & 1) << 5)); }
__device__ __forceinline__ void stage_rc(int b, int& R, int& C) { const int st = b / 1024, sb = b % 1024, swz = sb ^ (((sb >> 9) & 1) << 5); R = (st >> 1) * 16 + swz / 64; C = (st & 1) * 32 + (swz % 64) / 2; }
__device__ __forceinline__ int perm32(int rho) { const int n = rho >> 4, i = rho & 15; return 8 * (i >> 2) + 4 * n + (i & 3); }

struct Unit { int pm, pn, ks; };
struct Gemm { const bf16_t* A; const bf16_t* Bt; int M, N, K, ld, KS; };

struct Order {
    int nM, nN, nNr, nwg, G, c;
    __device__ void init(int M, int N, int KS, int G_, int c_) { nM = M / BM; nNr = N / BM; nN = nNr * KS; nwg = nM * nN; G = G_; c = c_; }
    __device__ bool next(int i, Unit& u) const {
        const long L = (long)i * G + c; if (L >= nwg) return false;
        int wgid = (int)L; { const int q = nwg / NXCD, r = nwg % NXCD, xcd = wgid % NXCD, off = wgid / NXCD; wgid = (xcd < r ? xcd * (q + 1) : r * (q + 1) + (xcd - r) * q) + off; }
        const int nig = WGM * nN, gid = wgid / nig, fm = gid * WGM, gsz = (nM - fm) < WGM ? (nM - fm) : WGM;
        u.pm = fm + ((wgid % nig) % gsz); const int pn = (wgid % nig) / gsz; u.pn = pn % nNr; u.ks = pn / nNr; return true;
    }
};

__device__ __forceinline__ unsigned cvt_pk_bf16(float lo, float hi) { unsigned r; asm volatile("v_cvt_pk_bf16_f32 %0, %1, %2" : "=v"(r) : "v"(lo), "v"(hi)); return r; }

struct EpiF32 {
    static constexpr bool PERM = false;
    float* C; int ldc; size_t ks_stride;
    __device__ __forceinline__ void operator()(const f32x4 (&acc)[2][2][4][2], const Unit& u, int wr, int wc, int fr, int fq) const {
        const int row0 = u.pm * BM + wr * 64 + fr, col0 = u.pn * BM + wc * 32 + 4 * fq;
        float* Cb = C + (size_t)u.ks * ks_stride;
#pragma unroll
        for (int ai = 0; ai < 2; ++ai)
#pragma unroll
            for (int m = 0; m < 4; ++m) { float* rowp = Cb + (size_t)(row0 + ai * HALF + m * 16) * ldc + col0;
#pragma unroll
                for (int bj = 0; bj < 2; ++bj)
#pragma unroll
                    for (int n = 0; n < 2; ++n) *(f32x4*)(rowp + bj * HALF + n * 16) = acc[ai][bj][m][n]; }
    }
};
struct EpiBf16 {
    static constexpr bool PERM = true;
    bf16_t* O; int ldc;
    __device__ __forceinline__ void operator()(const f32x4 (&acc)[2][2][4][2], const Unit& u, int wr, int wc, int fr, int fq) const {
        const int row0 = u.pm * BM + wr * 64 + fr; const int col0 = u.pn * BM + wc * 32 + 8 * fq;
#pragma unroll
        for (int ai = 0; ai < 2; ++ai)
#pragma unroll
            for (int m = 0; m < 4; ++m) { bf16_t* rowp = O + (size_t)(row0 + ai * HALF + m * 16) * ldc + col0;
#pragma unroll
                for (int bj = 0; bj < 2; ++bj) { const f32x4 v0 = acc[ai][bj][m][0], v1 = acc[ai][bj][m][1];
                    u32x4 w; w.x = cvt_pk_bf16(v0[0], v0[1]); w.y = cvt_pk_bf16(v0[2], v0[3]); w.z = cvt_pk_bf16(v1[0], v1[1]); w.w = cvt_pk_bf16(v1[2], v1[3]);
                    *(u32x4*)(rowp + bj * HALF) = w; } }
    }
};

template <class Epi>
__device__ __forceinline__ void gemm_phase(LAS unsigned char* lds, const Gemm g, const Order& S, const Epi& E) {
    const int tid = threadIdx.x, wid = __builtin_amdgcn_readfirstlane(tid >> 6), lane = tid & 63, wr = wid >> 2, wc = wid & 3, fr = lane & 15, fq = lane >> 4;
    const int K = g.K, nt = K / BK, ld = g.ld;
    unsigned voffA[2], voffB[2];
#pragma unroll
    for (int i = 0; i < 2; ++i) { int R, C; stage_rc(tid * 16 + i * 8192, R, C); const int Rb = Epi::PERM ? ((R & ~31) + perm32(R & 31)) : R;
        voffA[i] = (unsigned)(R * ld + C) * 2u; voffB[i] = (unsigned)(Rb * ld + C) * 2u; }
    const size_t kstep = (size_t)(BK * 2);
    const size_t hstep = (size_t)HALF * ld * 2;
    const size_t tstep = 2 * hstep;
    const size_t ksb = (size_t)K * 2;
    const unsigned ldsw = (unsigned)wid * 1024u;
    const int aoff = lds_byte(wr * 64 + fr, fq * 8), boff = lds_byte(wc * 32 + fr, fq * 8);
#define PG8_SA(b, h) (((b) * 2 + (h)) * HTB)
#define PG8_SB(b, h) ((4 + (b) * 2 + (h)) * HTB)
#define PG8_STAGE(bufoff, gbase, voff) do { _Pragma("unroll") for (int _i = 0; _i < 2; ++_i) \
        __builtin_amdgcn_global_load_lds((const unsigned*)((const char*)(gbase) + (voff)[_i]), (LAS unsigned*)(lds + (bufoff) + ldsw + _i * 8192), 16, 0, 0); } while (0)
#define PG8_LDA(dst, b, h) do { _Pragma("unroll") for (int m = 0; m < 4; ++m) _Pragma("unroll") for (int k = 0; k < 2; ++k) dst[m][k] = *(const LAS bf16x8*)(lds + PG8_SA(b, h) + aoff + m * 2048 + k * 1024); } while (0)
#define PG8_LDB(dst, b, h) do { _Pragma("unroll") for (int n = 0; n < 2; ++n) _Pragma("unroll") for (int k = 0; k < 2; ++k) dst[n][k] = *(const LAS bf16x8*)(lds + PG8_SB(b, h) + boff + n * 2048 + k * 1024); } while (0)
#define PG8_MMA(ai, bj, At, Bt) do { __builtin_amdgcn_s_setprio(1); _Pragma("unroll") for (int m = 0; m < 4; ++m) _Pragma("unroll") for (int n = 0; n < 2; ++n) _Pragma("unroll") for (int k = 0; k < 2; ++k) \
        acc[ai][bj][m][n] = __builtin_amdgcn_mfma_f32_16x16x32_bf16(Bt[n][k], At[m][k], acc[ai][bj][m][n], 0, 0, 0); __builtin_amdgcn_s_setprio(0); } while (0)
#define PG8_WAIT_V(n) asm volatile("s_waitcnt vmcnt(" #n ")" ::: "memory")
#define PG8_WAIT_L(n) asm volatile("s_waitcnt lgkmcnt(" #n ")" ::: "memory")
#define PG8_BAR __builtin_amdgcn_s_barrier()
#define PG8_SCHED __builtin_amdgcn_sched_barrier(0)
    Unit cur, nxt; int ui = 0;
    if (!S.next(0, cur)) return;
    f32x4 acc[2][2][4][2];
#pragma unroll
    for (int a = 0; a < 2; ++a)
#pragma unroll
        for (int b = 0; b < 2; ++b)
#pragma unroll
            for (int m = 0; m < 4; ++m)
#pragma unroll
                for (int n = 0; n < 2; ++n) acc[a][b][m][n] = (f32x4){0.f, 0.f, 0.f, 0.f};
    bf16x8 At[4][2], B0[2][2], B1[2][2];
    const char* cA = (const char*)g.A + (size_t)cur.pm * tstep + (size_t)cur.ks * ksb; const char* cB = (const char*)g.Bt + (size_t)cur.pn * tstep + (size_t)cur.ks * ksb;
    PG8_STAGE(PG8_SB(0, 0), cB, voffB); PG8_STAGE(PG8_SA(0, 0), cA, voffA); PG8_STAGE(PG8_SB(0, 1), cB + hstep, voffB); PG8_STAGE(PG8_SA(0, 1), cA + hstep, voffA);
    if (wr == 1) PG8_BAR;
    PG8_WAIT_V(4); PG8_BAR;
    PG8_STAGE(PG8_SB(1, 0), cB + kstep, voffB); PG8_STAGE(PG8_SA(1, 0), cA + kstep, voffA); PG8_STAGE(PG8_SB(1, 1), cB + hstep + kstep, voffB);
    PG8_WAIT_V(6); PG8_BAR;
    for (;;) {
        const bool has_next = S.next(ui + 1, nxt);
        const char* nA = has_next ? (const char*)g.A + (size_t)nxt.pm * tstep + (size_t)nxt.ks * ksb : cA; const char* nB = has_next ? (const char*)g.Bt + (size_t)nxt.pn * tstep + (size_t)nxt.ks * ksb : cB;
        for (int t = 0; t < nt; t += 2) {
            const bool last = (t == nt - 2);
            const char* a1 = cA + (size_t)(t + 1) * kstep;
            const char* a2 = last ? nA : cA + (size_t)(t + 2) * kstep; const char* b2 = last ? nB : cB + (size_t)(t + 2) * kstep;
            const char* a3 = a2 + kstep; const char* b3 = b2 + kstep;
            PG8_LDB(B0, 0, 0); PG8_SCHED; PG8_LDA(At, 0, 0); PG8_STAGE(PG8_SA(1, 1), a1 + hstep, voffA);
            PG8_WAIT_L(8); PG8_BAR; PG8_WAIT_L(0); PG8_MMA(0, 0, At, B0); PG8_BAR; PG8_SCHED;
            PG8_LDB(B1, 0, 1); PG8_STAGE(PG8_SB(0, 0), b2, voffB);
            PG8_BAR; PG8_WAIT_L(0); PG8_MMA(0, 1, At, B1); PG8_BAR;
            PG8_LDA(At, 0, 1); PG8_STAGE(PG8_SA(0, 0), a2, voffA);
            PG8_BAR; PG8_WAIT_L(0); PG8_MMA(1, 0, At, B0); PG8_BAR; PG8_SCHED;
            PG8_STAGE(PG8_SB(0, 1), b2 + hstep, voffB);
            PG8_WAIT_V(6); PG8_BAR; PG8_MMA(1, 1, At, B1); PG8_BAR;
            PG8_LDB(B0, 1, 0); PG8_SCHED; PG8_LDA(At, 1, 0); PG8_STAGE(PG8_SA(0, 1), a2 + hstep, voffA);
            PG8_WAIT_L(8); PG8_BAR; PG8_WAIT_L(0); PG8_MMA(0, 0, At, B0); PG8_BAR; PG8_SCHED;
            PG8_LDB(B1, 1, 1); PG8_STAGE(PG8_SB(1, 0), b3, voffB);
            PG8_BAR; PG8_WAIT_L(0); PG8_MMA(0, 1, At, B1); PG8_BAR;
            PG8_LDA(At, 1, 1); PG8_STAGE(PG8_SA(1, 0), a3, voffA);
            PG8_BAR; PG8_WAIT_L(0); PG8_MMA(1, 0, At, B0); PG8_BAR; PG8_SCHED;
            PG8_STAGE(PG8_SB(1, 1), b3 + hstep, voffB);
            PG8_WAIT_V(6); PG8_BAR; PG8_MMA(1, 1, At, B1); PG8_BAR;
        }
        E(acc, cur, wr, wc, fr, fq);
        if (!has_next) break;
#pragma unroll
        for (int a = 0; a < 2; ++a)
#pragma unroll
            for (int b = 0; b < 2; ++b)
#pragma unroll
                for (int m = 0; m < 4; ++m)
#pragma unroll
                    for (int n = 0; n < 2; ++n) acc[a][b][m][n] = (f32x4){0.f, 0.f, 0.f, 0.f};
        cur = nxt; cA = nA; cB = nB; ++ui;
    }
    PG8_WAIT_V(0);
    if (wr == 0) PG8_BAR;
    PG8_BAR;
#undef PG8_SA
#undef PG8_SB
#undef PG8_STAGE
#undef PG8_LDA
#undef PG8_LDB
#undef PG8_MMA
#undef PG8_WAIT_V
#undef PG8_WAIT_L
#undef PG8_BAR
#undef PG8_SCHED
}
}

struct TJob { const float* src; bf16_t* dst; int ldsrc, N, lddst, drow0, k0, n0; };
__device__ __forceinline__ TJob tjob_of(const Params& p, int t) {
    unsigned char* ws = p.ws;
    bf16_t* BT0 = (bf16_t*)(ws + WS_BT0); bf16_t* WT0O = (bf16_t*)(ws + WS_WT0O); bf16_t* BT1 = (bf16_t*)(ws + WS_BT1); bf16_t* WT1O = (bf16_t*)(ws + WS_WT1O);
    TJob j; int nnt;
    if (t < 1024) { j.src = p.in[10]; j.ldsrc = 8192; j.N = 8192; j.dst = BT0; j.lddst = 1024; j.drow0 = 0; nnt = 64; }
    else if (t < 1024 + 32) { t -= 1024; const int z = t >> 4; t &= 15; j.src = p.in[14] + (size_t)z * 1024 * 64; j.ldsrc = 64; j.N = 64; j.dst = BT0; j.lddst = 1024; j.drow0 = 8192 + z * 64; nnt = 1; }
    else if (t < 1024 + 64) { t -= 1024 + 32; const int z = t >> 4; t &= 15; j.src = p.in[17] + (size_t)z * 1024 * 64; j.ldsrc = 64; j.N = 64; j.dst = BT0; j.lddst = 1024; j.drow0 = 8320 + z * 64; nnt = 1; }
    else if (t < 1088 + 256) { t -= 1088; j.src = p.in[11]; j.ldsrc = 1024; j.N = 1024; j.dst = WT0O; j.lddst = 2048; j.drow0 = 0; nnt = 8; }
    else if (t < 1344 + 384) { t -= 1344; j.src = p.in[24]; j.ldsrc = 3072; j.N = 3072; j.dst = BT1; j.lddst = 1024; j.drow0 = 0; nnt = 24; }
    else if (t < 1728 + 32) { t -= 1728; const int z = t >> 4; t &= 15; j.src = p.in[26] + (size_t)z * 1024 * 16; j.ldsrc = 16; j.N = 16; j.dst = BT1; j.lddst = 1024; j.drow0 = 3072 + z * 16; nnt = 1; }
    else { t -= 1760; j.src = p.in[25]; j.ldsrc = 1024; j.N = 1024; j.dst = WT1O; j.lddst = 1024; j.drow0 = 0; nnt = 8; }
    j.k0 = (t / nnt) * 64; j.n0 = (t % nnt) * 128; return j;
}
__device__ __forceinline__ void tjob_load(const TJob& j, f32x4 (&r)[4]) {
    const int tid = threadIdx.x, c4 = (tid & 31) * 4;
#pragma unroll
    for (int i = 0; i < 4; ++i) { const int kk = (tid >> 5) + 16 * i;
        r[i] = (j.n0 + c4 < j.N) ? *(const f32x4*)(j.src + (size_t)(j.k0 + kk) * j.ldsrc + j.n0 + c4) : (f32x4){0.f, 0.f, 0.f, 0.f}; }
}

__device__ void transpose_jobs(const Params& p, float* lds, int t_lo, int t_hi, int rot) {
    const int tid = threadIdx.x;
    float* tile = lds;
    int it = t_lo + (int)((blockIdx.x + (unsigned)rot) % gridDim.x);
    f32x4 cur[4], nxt[4];
    TJob jc = tjob_of(p, it < t_hi ? it : t_lo);
    if (it < t_hi) tjob_load(jc, cur);
    for (; it < t_hi; it += gridDim.x) {
        const int c4 = (tid & 31) * 4;
#pragma unroll
        for (int i = 0; i < 4; ++i) { const int kk = (tid >> 5) + 16 * i; tile[kk * 129 + c4] = cur[i][0]; tile[kk * 129 + c4 + 1] = cur[i][1]; tile[kk * 129 + c4 + 2] = cur[i][2]; tile[kk * 129 + c4 + 3] = cur[i][3]; }
        const int itn = it + gridDim.x;
        const TJob jn = tjob_of(p, itn < t_hi ? itn : t_lo);
        if (itn < t_hi) tjob_load(jn, nxt);
        __syncthreads();
#pragma unroll
        for (int q = 0; q < 2; ++q) { const int idx = tid + q * NTHR; const int nn = idx >> 3, k8 = (idx & 7) * 8;
            if (jc.n0 + nn < jc.N) { u32x4 o; o.x = pk2(tile[(k8 + 0) * 129 + nn], tile[(k8 + 1) * 129 + nn]); o.y = pk2(tile[(k8 + 2) * 129 + nn], tile[(k8 + 3) * 129 + nn]);
                o.z = pk2(tile[(k8 + 4) * 129 + nn], tile[(k8 + 5) * 129 + nn]); o.w = pk2(tile[(k8 + 6) * 129 + nn], tile[(k8 + 7) * 129 + nn]);
                *(u32x4*)(jc.dst + (size_t)(jc.drow0 + jc.n0 + nn) * jc.lddst + jc.k0 + k8) = o; } }
        __syncthreads();
        jc = jn;
#pragma unroll
        for (int i = 0; i < 4; ++i) cur[i] = nxt[i];
    }
}

__device__ void phase_prologue(const Params& p, float* lds) {
    const int tid = threadIdx.x;
    unsigned char* ws = p.ws;
    bf16_t* BT1 = (bf16_t*)(ws + WS_BT1);
    float* MOD = (float*)(ws + WS_MOD);
    constexpr int NGEMV = 192;
    for (int it = blockIdx.x; it < NGEMV; it += gridDim.x) {
        const int l = it / 96, j0 = (it % 96) * 32;
        float* sc = lds;
        float* red = lds + 3072;
        for (int i = tid; i < 3072; i += NTHR) { const int cnd = i >> 10, k = i & 1023; const float v = cnd == 0 ? p.in[5][k] : p.in[4][(cnd - 1) * 1024 + k]; sc[i] = silu(v); }
        __syncthreads();
        const int col = tid & 31, ksp = tid >> 5;
        float a0 = 0.f, a1 = 0.f, a2 = 0.f;
        const float* w = p.in[7] + (size_t)l * 1024 * 3072 + j0 + col;
#pragma unroll 16
        for (int k = ksp * 64; k < ksp * 64 + 64; ++k) { const float wv = w[(size_t)k * 3072]; a0 += sc[k] * wv; a1 += sc[1024 + k] * wv; a2 += sc[2048 + k] * wv; }
        red[(ksp * 3 + 0) * 32 + col] = a0; red[(ksp * 3 + 1) * 32 + col] = a1; red[(ksp * 3 + 2) * 32 + col] = a2;
        __syncthreads();
        if (tid < 96) { const int cnd = tid >> 5, cc = tid & 31; float s = 0.f; for (int q = 0; q < 16; ++q) s += red[(q * 3 + cnd) * 32 + cc];
            MOD[(l * 3 + cnd) * 3072 + j0 + cc] = s + p.in[8][l * 3072 + j0 + cc]; }
        __syncthreads();
    }
    transpose_jobs(p, lds, 0, 1088, 64);
}
__device__ void phase_late_weights(const Params& p, float* lds) {
    const int tid = threadIdx.x;
    bf16_t* BT1 = (bf16_t*)(p.ws + WS_BT1);
    transpose_jobs(p, lds, 1088, 1888, 0);
    { u32x4* z = (u32x4*)(BT1 + (size_t)3104 * 1024); const int n = 224 * 1024 * 2 / 16;
      for (int i = blockIdx.x * NTHR + tid; i < n; i += gridDim.x * NTHR) z[i] = (u32x4){0u, 0u, 0u, 0u}; }
}

__device__ void phase_h(const Params& p, int layer, float* ldsf) {
    const int tid = threadIdx.x, wave = __builtin_amdgcn_readfirstlane(tid >> 6), lane = tid & 63, fr = lane & 15, fq = lane >> 4;
    unsigned char* ws = p.ws;
    const float* MOD = (const float*)(ws + WS_MOD);
    bf16_t* H = (bf16_t*)(ws + WS_H);
    float* X1 = (float*)(ws + WS_X1);
    const float* Y = (const float*)(ws + WS_P);
    bf16_t* HL = (bf16_t*)ldsf;
    for (int tb = blockIdx.x * 32; tb < NTOK; tb += gridDim.x * 32) {
#pragma unroll 1
        for (int q = 0; q < 4; ++q) { const int tl = wave * 4 + q, tok = tb + tl;
            const float* xr = tok < NPTOK ? p.in[0] + (size_t)tok * D : p.in[1] + (size_t)(tok - NPTOK) * D;
            const int cond = tok < NPTOK ? 0 : 1 + ((tok - NPTOK) >> 11);
            f32x4 xv[4]; float ss = 0.f;
#pragma unroll
            for (int i = 0; i < 4; ++i) { const int idx = i * 256 + lane * 4; xv[i] = *(const f32x4*)(xr + idx);
                if (layer == 1) { const f32x4 ya = *(const f32x4*)(Y + (size_t)tok * D + idx), yb = *(const f32x4*)(Y + (size_t)NTOK * D + (size_t)tok * D + idx);
                    const f32x4 gt = *(const f32x4*)(MOD + (0 * 3 + cond) * 3072 + 2048 + idx);
                    xv[i] = xv[i] + gt * (ya + yb); *(f32x4*)(X1 + (size_t)tok * D + idx) = xv[i]; }
                ss += xv[i][0] * xv[i][0] + xv[i][1] * xv[i][1] + xv[i][2] * xv[i][2] + xv[i][3] * xv[i][3]; }
            ss = wave_sum(ss);
            const float rstd = rsqrtf(ss * (1.f / 1024.f) + 1e-6f);
#pragma unroll
            for (int i = 0; i < 4; ++i) { const int idx = i * 256 + lane * 4;
                const f32x4 g = *(const f32x4*)(p.in[6] + layer * D + idx);
                const f32x4 sh = *(const f32x4*)(MOD + (layer * 3 + cond) * 3072 + idx), sc = *(const f32x4*)(MOD + (layer * 3 + cond) * 3072 + 1024 + idx);
                f32x4 h;
#pragma unroll
                for (int j = 0; j < 4; ++j) h[j] = xv[i][j] * rstd * g[j] * (1.f + sc[j]) + sh[j];
                u32x2 w2; w2.x = pk2(h[0], h[1]); w2.y = pk2(h[2], h[3]);
                *(u32x2*)(H + (size_t)tok * D + idx) = w2;
                if (layer == 0) *(u32x2*)(HL + tl * 1032 + idx) = w2; } }
        if (layer == 0) {
            __syncthreads();
            const bf16_t* BL = (const bf16_t*)(ws + WS_BT0) + (size_t)8192 * 1024;
            bf16_t* P = (bf16_t*)(ws + WS_P);
            f32x4 acc[2][2];
#pragma unroll
            for (int mt = 0; mt < 2; ++mt)
#pragma unroll
                for (int n2 = 0; n2 < 2; ++n2) acc[mt][n2] = (f32x4){0.f, 0.f, 0.f, 0.f};
#pragma unroll 16
            for (int ks = 0; ks < 32; ++ks) {
                bf16x8 af[2], bfr[2];
#pragma unroll
                for (int mt = 0; mt < 2; ++mt) af[mt] = *(const bf16x8*)(HL + (mt * 16 + fr) * 1032 + ks * 32 + fq * 8);
#pragma unroll
                for (int n2 = 0; n2 < 2; ++n2) bfr[n2] = *(const bf16x8*)(BL + (size_t)((wave * 2 + n2) * 16 + fr) * 1024 + ks * 32 + fq * 8);
#pragma unroll
                for (int mt = 0; mt < 2; ++mt)
#pragma unroll
                    for (int n2 = 0; n2 < 2; ++n2) acc[mt][n2] = __builtin_amdgcn_mfma_f32_16x16x32_bf16(af[mt], bfr[n2], acc[mt][n2], 0, 0, 0);
            }
#pragma unroll
            for (int mt = 0; mt < 2; ++mt)
#pragma unroll
                for (int n2 = 0; n2 < 2; ++n2)
#pragma unroll
                    for (int jj = 0; jj < 4; ++jj) P[(size_t)(tb + mt * 16 + fq * 4 + jj) * N0 + 8192 + (wave * 2 + n2) * 16 + fr] = f2bf_hw(acc[mt][n2][jj]);
            __syncthreads();
        }
    }
}

__device__ __forceinline__ f32x4 mma_nt(const bf16_t* A, int lda, const bf16_t* B, int ldb, int K, f32x4 acc, int fr, int fq) {
    for (int k0 = 0; k0 < K; k0 += 32) {
        const bf16x8 a = *(const bf16x8*)(A + fr * lda + k0 + fq * 8);
        const bf16x8 b = *(const bf16x8*)(B + fr * ldb + k0 + fq * 8);
        acc = __builtin_amdgcn_mfma_f32_16x16x32_bf16(a, b, acc, 0, 0, 0);
    }
    return acc;
}
__device__ __forceinline__ bf16x8 pack8(float a0, float a1, float a2, float a3, float a4, float a5, float a6, float a7) {
    u32x4 w; w.x = pack2(a0, a1); w.y = pack2(a2, a3); w.z = pack2(a4, a5); w.w = pack2(a6, a7);
    return __builtin_bit_cast(bf16x8, w);
}
__device__ __forceinline__ float dpp_add(float v, float o) { return v + o; }
__device__ __forceinline__ float wave_sum_fast(float v) {
    v += __int_as_float(__builtin_amdgcn_update_dpp(0, __float_as_int(v), 0xB1, 0xF, 0xF, true));
    v += __int_as_float(__builtin_amdgcn_update_dpp(0, __float_as_int(v), 0x4E, 0xF, 0xF, true));
    v += __int_as_float(__builtin_amdgcn_update_dpp(0, __float_as_int(v), 0x141, 0xF, 0xF, true));
    v += __int_as_float(__builtin_amdgcn_update_dpp(0, __float_as_int(v), 0x140, 0xF, 0xF, true));
    v += __shfl_xor(v, 16, 64); v += __shfl_xor(v, 32, 64);
    return v;
}
__device__ __forceinline__ float wave_sum_dpp(float v) {
    v += __int_as_float(__builtin_amdgcn_update_dpp(0, __float_as_int(v), 0xB1, 0xF, 0xF, true));
    v += __int_as_float(__builtin_amdgcn_update_dpp(0, __float_as_int(v), 0x4E, 0xF, 0xF, true));
    v += __int_as_float(__builtin_amdgcn_update_dpp(0, __float_as_int(v), 0x141, 0xF, 0xF, true));
    v += __int_as_float(__builtin_amdgcn_update_dpp(0, __float_as_int(v), 0x140, 0xF, 0xF, true));
    v += __int_as_float(__builtin_amdgcn_update_dpp(0, __float_as_int(v), 0x142, 0xA, 0xF, false));
    v += __int_as_float(__builtin_amdgcn_update_dpp(0, __float_as_int(v), 0x143, 0xC, 0xF, false));
    return __int_as_float(__builtin_amdgcn_readlane(__float_as_int(v), 63));
}
__device__ __forceinline__ float wave_sum_lane63(float v) {
    v += __int_as_float(__builtin_amdgcn_update_dpp(0, __float_as_int(v), 0xB1, 0xF, 0xF, true));
    v += __int_as_float(__builtin_amdgcn_update_dpp(0, __float_as_int(v), 0x4E, 0xF, 0xF, true));
    v += __int_as_float(__builtin_amdgcn_update_dpp(0, __float_as_int(v), 0x141, 0xF, 0xF, true));
    v += __int_as_float(__builtin_amdgcn_update_dpp(0, __float_as_int(v), 0x140, 0xF, 0xF, true));
    v += __int_as_float(__builtin_amdgcn_update_dpp(0, __float_as_int(v), 0x142, 0xA, 0xF, false));
    v += __int_as_float(__builtin_amdgcn_update_dpp(0, __float_as_int(v), 0x143, 0xC, 0xF, false));
    return v;
}
__device__ __forceinline__ float fast_tanh(float x) { const float e = fexp(2.f * x); return 1.f - 2.f * __builtin_amdgcn_rcpf(1.f + e); }
__device__ __forceinline__ bf16x8 pack8h(float a0, float a1, float a2, float a3, float a4, float a5, float a6, float a7) {
    u32x4 w; w.x = pk2(a0, a1); w.y = pk2(a2, a3); w.z = pk2(a4, a5); w.w = pk2(a6, a7);
    return __builtin_bit_cast(bf16x8, w);
}

__device__ void wkv_unit(const Params& p, int u, float* ldsf) {
    const int tid0 = threadIdx.x, lane0 = tid0 & 63, w = __builtin_amdgcn_readfirstlane(tid0 >> 6), fr0 = lane0 & 15, fq0 = lane0 >> 4;
    unsigned char* ws = p.ws;
    unsigned char* lds = (unsigned char*)ldsf;
    const bf16_t* P = (const bf16_t*)(ws + WS_P);
    bf16_t* OD = (bf16_t*)(ws + WS_X1);
    float* BON = (float*)(ws + WS_BON);
    int z, b, hd, sgm, seqT, tok0; bool sample; const int T = 256;
    if (u < 512) { sample = true; z = u >> 8; b = (u >> 7) & 1; hd = (u >> 3) & 15; sgm = u & 7; seqT = 2048; tok0 = NPTOK + b * 2048; }
    else { const int q = u - 512; sample = false; z = q >> 8; b = (q >> 4) & 15; hd = q & 15; sgm = 0; seqT = 256; tok0 = b * 256; }
    const int qbase = sgm * 256;
    bf16_t* RHO = (bf16_t*)(ws + WS_H);
    float* GH = (float*)(ws + WS_BT0);
    bf16_t* TLW = (bf16_t*)(lds + 0);
    bf16_t* TLA = (bf16_t*)(lds + 9216);
    float* HT = (float*)(lds + 18432);
    float* BONL = (float*)(lds + 57344);
    bf16_t* KTr = (bf16_t*)(lds + 20480);
    bf16_t* BTr = (bf16_t*)(lds + 29696);
    bf16_t* KKH = (bf16_t*)(lds + 38912);
    bf16_t* RH = (bf16_t*)(lds + 48128);
    const bf16_t* VS = (const bf16_t*)(lds + 113664 + 2 * 8192);
    bf16_t* TA = (bf16_t*)(lds + 65536);
    bf16_t* NA = (bf16_t*)(lds + 70656);
    float* PC = (float*)(lds + 75776);
    bf16_t* KBm = (bf16_t*)(lds + 76800);
    float* MM = (float*)(lds + 97280);
    float* WA = (float*)(lds + 76800);
    bf16x8 bw[2];
    { const float* W2 = (w >> 2) ? p.in[18] : p.in[15];
#pragma unroll
      for (int ks = 0; ks < 2; ++ks) { float t8[8];
#pragma unroll
        for (int e = 0; e < 8; ++e) t8[e] = W2[(size_t)(z * 64 + ks * 32 + fq0 * 8 + e) * 1024 + hd * 64 + (w & 3) * 16 + fr0];
        bw[ks] = pack8h(t8[0], t8[1], t8[2], t8[3], t8[4], t8[5], t8[6], t8[7]); } }
    f32x4 Sacc[4];
#pragma unroll
    for (int kt = 0; kt < 4; ++kt) Sacc[kt] = (f32x4){0.f, 0.f, 0.f, 0.f};
    if (w >= 4) {
#pragma unroll
        for (int kt = 0; kt < 4; ++kt)
#pragma unroll
            for (int jj = 0; jj < 4; ++jj) Sacc[kt][jj] = (kt * 16 + fq0 * 4 + jj == (w - 4) * 16 + fr0) ? 1.f : 0.f; }
    const int ch = hd * 64 + lane0;
    const float w0c = p.in[13][z * 1024 + ch], a0c = p.in[16][z * 1024 + ch], kkc = p.in[19][ch], kac = p.in[20][ch], rkc = p.in[21][ch];
    bf16_t* RKV = (bf16_t*)(lds + 113664);
    u32x4 tlraw[2], rkvraw[3];
#define WKV_LOAD_RAW(tb_) do { \
        _Pragma("unroll") for (int h_ = 0; h_ < 2; ++h_) { const int idx_ = tid + h_ * NTHR; const int tau_ = idx_ >> 4, sg_ = idx_ & 15; const int t_ = z ? (seqT - 1 - (qbase + (tb_) + tau_)) : (qbase + (tb_) + tau_); \
            tlraw[h_] = *(const u32x4*)(P + (size_t)(tok0 + t_) * N0 + 8192 + (sg_ < 8 ? z * 64 + sg_ * 8 : 128 + z * 64 + (sg_ - 8) * 8)); } \
        { const int tau_ = tid >> 3, sg_ = tid & 7; const int t_ = z ? (seqT - 1 - (qbase + (tb_) + tau_)) : (qbase + (tb_) + tau_); const bf16_t* rp_ = P + (size_t)(tok0 + t_) * N0 + 4096 + hd * 64 + sg_ * 8; \
          rkvraw[0] = *(const u32x4*)rp_; rkvraw[1] = *(const u32x4*)(rp_ + 1024); rkvraw[2] = *(const u32x4*)(rp_ + 2048); } } while (0)
    { const int tid = tid0; WKV_LOAD_RAW(0); }
    __syncthreads();
#pragma unroll 1
    for (int tb = 0; tb < T; tb += 64) {
        int tid = tid0; asm volatile("" : "+v"(tid));
        const int lane = tid & 63, fr = lane & 15, fq = lane >> 4, c = lane;
        const int pcol = ((c >> 5) * 32) + (((c >> 2) & 3) * 8) + (((c >> 4) & 1) * 4) + (c & 3);
#pragma unroll
        for (int h = 0; h < 2; ++h) { const int idx = tid + h * NTHR; const int tau = idx >> 4, sg = idx & 15;
            u32x4 o = tlraw[h];
            if (sg < 8) { o.x = pk2(fast_tanh(bflo(o.x)), fast_tanh(bfhi(o.x))); o.y = pk2(fast_tanh(bflo(o.y)), fast_tanh(bfhi(o.y)));
                          o.z = pk2(fast_tanh(bflo(o.z)), fast_tanh(bfhi(o.z))); o.w = pk2(fast_tanh(bflo(o.w)), fast_tanh(bfhi(o.w))); }
            *(u32x4*)((sg < 8 ? TLW : TLA) + tau * 72 + (sg & 7) * 8) = o; }
#pragma unroll
        for (int h = 0; h < 3; ++h) *(u32x4*)(RKV + h * 4096 + (tid >> 3) * 64 + (tid & 7) * 8) = rkvraw[h];
        lds_barrier();
        if (tb + 64 < T) WKV_LOAD_RAW(tb + 64);
        { const bf16_t* TL = (w >> 2) ? TLA : TLW; float* WAo = WA + (w >> 2) * 64 * 68;
#pragma unroll
          for (int mt = 0; mt < 4; ++mt) { f32x4 acc = (f32x4){0.f, 0.f, 0.f, 0.f};
#pragma unroll
            for (int ks = 0; ks < 2; ++ks) { const bf16x8 a = *(const bf16x8*)(TL + (mt * 16 + fr) * 72 + ks * 32 + fq * 8);
                acc = __builtin_amdgcn_mfma_f32_16x16x32_bf16(a, bw[ks], acc, 0, 0, 0); }
#pragma unroll
            for (int jj = 0; jj < 4; ++jj) WAo[(mt * 16 + fq * 4 + jj) * 68 + (w & 3) * 16 + fr] = acc[jj]; } }
        lds_barrier();
        float kkv[8], kmv[8], bv[8], lwv[8], cum[8], rr[8], bonv[8];
        { float run = 0.f;
#pragma unroll
          for (int i = 0; i < 8; ++i) { const int tau = w * 8 + i; const int t = z ? (seqT - 1 - (qbase + tb + tau)) : (qbase + tb + tau); const int tokg = tok0 + t;
            const float wr_ = w0c + WA[tau * 68 + c], ap = a0c + WA[64 * 68 + tau * 68 + c];
            const float nx = -wr_; const float sp = fmaxf(nx, 0.f) + flog(1.f + fexp(-fabsf(nx)));
            const float lw = -fexp(-sp - 0.5f);
            const float iclr = __builtin_amdgcn_rcpf(1.f + fexp(-ap));
            const float kxi = bf2f(RKV[4096 + tau * 64 + c]); rr[i] = bf2f(RKV[tau * 64 + c]);
            const float kkraw = kxi * kkc;
            const float ssq = wave_sum_fast(kkraw * kkraw);
            const float kk = kkraw * __builtin_amdgcn_rsqf(fmaxf(ssq, 1e-24f));
            const float kmod = kxi * (1.f + (iclr - 1.f) * kac);
            bonv[i] = wave_sum_lane63(rr[i] * kmod * rkc);
            run += lw;
            kkv[i] = kk; kmv[i] = kmod; bv[i] = kk * iclr; lwv[i] = lw; cum[i] = run; }
          HT[w * 64 + c] = run;
          if (lane == 63) {
#pragma unroll
            for (int i = 0; i < 8; ++i) BONL[w * 8 + i] = bonv[i]; } }
        lds_barrier();
        if (tid < 64) { const int t = z ? (seqT - 1 - (qbase + tb + tid)) : (qbase + tb + tid); BON[((size_t)z * NTOK + tok0 + t) * 16 + hd] = BONL[tid]; }
        { const float off = (w & 1) ? HT[(w - 1) * 64 + c] : 0.f; const int cn = w >> 1;
          unsigned kbq[8];
#pragma unroll
          for (int i = 0; i < 8; ++i) { const int tau = w * 8 + i; const int j = (w & 1) * 8 + i;
            const float cm = cum[i] + off;
            const float Pj = fexp(cm), ipj = fexp(-cm), pm1 = fexp(cm - lwv[i]);
            const unsigned kb2 = pk2(-bv[i] * ipj, kmv[i] * ipj);
            KTr[tau * 72 + pcol] = (bf16_t)(kb2 >> 16); BTr[tau * 72 + pcol] = f2bf_hw(bv[i] * ipj);
            const unsigned kr2 = pk2(kkv[i] * pm1, rr[i] * Pj);
            KKH[tau * 72 + pcol] = (bf16_t)(kr2 & 0xFFFFu); RH[tau * 72 + pcol] = (bf16_t)(kr2 >> 16);
            kbq[i] = kb2;
            if (j == 15) PC[cn * 64 + c] = Pj; }
#pragma unroll
          for (int g = 0; g < 2; ++g) { u32x4 o;
              o.x = (kbq[g * 4 + 0] & 0xFFFFu) | (kbq[g * 4 + 1] << 16); o.y = (kbq[g * 4 + 2] & 0xFFFFu) | (kbq[g * 4 + 3] << 16);
              o.z = (kbq[g * 4 + 0] >> 16) | (kbq[g * 4 + 1] & 0xFFFF0000u); o.w = (kbq[g * 4 + 2] >> 16) | (kbq[g * 4 + 3] & 0xFFFF0000u);
              *(u32x4*)(KBm + (cn * 64 + c) * 40 + ((w & 1) * 2 + g) * 8) = o; } }
        lds_barrier();
#pragma unroll
        for (int q2 = 0; q2 < 2; ++q2) { const int id = w * 2 + q2; const int cn = id >> 2, which = id & 3;
          const bf16_t* Am = ((which & 1) ? KTr : BTr) + cn * 16 * 72; const bf16_t* Bm = ((which & 2) ? RH : KKH) + cn * 16 * 72;
          const f32x4 acc = mma_nt(Am, 72, Bm, 72, 64, (f32x4){0.f, 0.f, 0.f, 0.f}, fr, fq);
          f32x4 o;
#pragma unroll
          for (int jj = 0; jj < 4; ++jj) { const int i = fq * 4 + jj, j = fr; const bool keep = (which & 2) ? (i <= j) : (i < j); o[jj] = keep ? acc[jj] : 0.f; }
          *(f32x4*)(MM + (cn * 4 + which) * 256 + fr * 16 + fq * 4) = o; }
        lds_barrier();
        if (w < 4) { const int cn = w, col = lane >> 2, rg = lane & 3;
            const float* MbT = MM + (cn * 4 + 0) * 256 + rg * 4; const float* MkT = MM + (cn * 4 + 1) * 256 + rg * 4;
            float Tc[4], A1[4];
#pragma unroll
            for (int e = 0; e < 4; ++e) { Tc[e] = (rg * 4 + e == col) ? 1.f : 0.f; A1[e] = 0.f; }
#define INV_STEP(l, CTRL) do { const f32x4 mb = *(const f32x4*)(MbT + (l) * 16), mk = *(const f32x4*)(MkT + (l) * 16); \
                const float tl_ = __int_as_float(__builtin_amdgcn_update_dpp(0, __float_as_int(Tc[(l) & 3]), CTRL, 0xF, 0xF, true)); \
                Tc[0] -= mb[0] * tl_; Tc[1] -= mb[1] * tl_; Tc[2] -= mb[2] * tl_; Tc[3] -= mb[3] * tl_; \
                A1[0] += mk[0] * tl_; A1[1] += mk[1] * tl_; A1[2] += mk[2] * tl_; A1[3] += mk[3] * tl_; } while (0)
            INV_STEP(15, 0xFF); INV_STEP(14, 0xFF); INV_STEP(13, 0xFF); INV_STEP(12, 0xFF);
            INV_STEP(11, 0xAA); INV_STEP(10, 0xAA); INV_STEP(9, 0xAA); INV_STEP(8, 0xAA);
            INV_STEP(7, 0x55); INV_STEP(6, 0x55); INV_STEP(5, 0x55); INV_STEP(4, 0x55);
            INV_STEP(3, 0x00); INV_STEP(2, 0x00); INV_STEP(1, 0x00);
#undef INV_STEP
            u32x4 o; o.x = pk2(Tc[0], Tc[1]); o.y = pk2(Tc[2], Tc[3]); o.z = pk2(A1[0], A1[1]); o.w = pk2(A1[2], A1[3]);
            *(u32x4*)(TA + (cn * 16 + col) * 40 + rg * 8) = o; }
        else { const int cn = w - 4, j = lane & 15, ig = lane >> 4;
            const f32x4 nb = *(const f32x4*)(MM + (cn * 4 + 2) * 256 + j * 16 + ig * 4), nk = *(const f32x4*)(MM + (cn * 4 + 3) * 256 + j * 16 + ig * 4);
            u32x4 o; o.x = pk2(-nb[0], -nb[1]); o.y = pk2(-nb[2], -nb[3]); o.z = pk2(nk[0], nk[1]); o.w = pk2(nk[2], nk[3]);
            *(u32x4*)(NA + (cn * 16 + j) * 40 + ig * 8) = o; }
        lds_barrier();
        if (w < 4 || sample) {
            const int vb = w & 3;
            const int t0s = z ? (seqT - 1 - (qbase + tb)) : (qbase + tb);
            const long tstep = z ? -1024 : 1024;
            bf16_t* obase = (w < 4) ? OD + ((size_t)z * NTOK + tok0 + t0s) * 1024 + hd * 64 + vb * 16 + fr : RHO + ((size_t)z * 4096 + (tok0 - NPTOK) + t0s) * 1024 + hd * 64 + vb * 16 + fr;
#pragma unroll 1
            for (int cn = 0; cn < 4; ++cn) {
                bf16x8 sb[2];
#pragma unroll
                for (int ks = 0; ks < 2; ++ks) sb[ks] = pack8h(Sacc[2 * ks][0], Sacc[2 * ks][1], Sacc[2 * ks][2], Sacc[2 * ks][3], Sacc[2 * ks + 1][0], Sacc[2 * ks + 1][1], Sacc[2 * ks + 1][2], Sacc[2 * ks + 1][3]);
                f32x4 U0 = (f32x4){0.f, 0.f, 0.f, 0.f}, O = (f32x4){0.f, 0.f, 0.f, 0.f};
#pragma unroll
                for (int ks = 0; ks < 2; ++ks) { const bf16x8 a = *(const bf16x8*)(KKH + (cn * 16 + fr) * 72 + ks * 32 + fq * 8);
                    U0 = __builtin_amdgcn_mfma_f32_16x16x32_bf16(a, sb[ks], U0, 0, 0, 0);
                    const bf16x8 ar = *(const bf16x8*)(RH + (cn * 16 + fr) * 72 + ks * 32 + fq * 8);
                    O = __builtin_amdgcn_mfma_f32_16x16x32_bf16(ar, sb[ks], O, 0, 0, 0); }
                float vf[4];
#pragma unroll
                for (int e = 0; e < 4; ++e) vf[e] = (w < 4) ? bf2f(VS[(cn * 16 + fq * 4 + e) * 64 + vb * 16 + fr]) : 0.f;
                const bf16x8 bU0 = pack8h(U0[0], U0[1], U0[2], U0[3], vf[0], vf[1], vf[2], vf[3]);
                const bf16x8 ta = *(const bf16x8*)(TA + (cn * 16 + fr) * 40 + fq * 8);
                const f32x4 U = __builtin_amdgcn_mfma_f32_16x16x32_bf16(ta, bU0, (f32x4){0.f, 0.f, 0.f, 0.f}, 0, 0, 0);
                const bf16x8 bUV = pack8h(U[0], U[1], U[2], U[3], vf[0], vf[1], vf[2], vf[3]);
                const bf16x8 na = *(const bf16x8*)(NA + (cn * 16 + fr) * 40 + fq * 8);
                O = __builtin_amdgcn_mfma_f32_16x16x32_bf16(na, bUV, O, 0, 0, 0);
#pragma unroll
                for (int jj = 0; jj < 4; ++jj) obase[(long)(cn * 16 + fq * 4 + jj) * tstep] = f2bf_hw(O[jj]);
#pragma unroll
                for (int kt = 0; kt < 4; ++kt) { const bf16x8 kb = *(const bf16x8*)(KBm + (cn * 64 + kt * 16 + fr) * 40 + fq * 8);
                    Sacc[kt] = __builtin_amdgcn_mfma_f32_16x16x32_bf16(kb, bUV, Sacc[kt], 0, 0, 0);
                    const f32x4 pc = *(const f32x4*)(PC + cn * 64 + kt * 16 + fq * 4);
                    Sacc[kt] = Sacc[kt] * pc; }
            }
        }
        lds_barrier();
    }
#undef WKV_LOAD_RAW
    if (!sample) { if (w < 4) { float* so = p.out + (size_t)2 * NPTOK * D + ((size_t)((b * 2 + z) * 16 + hd)) * 4096 + (size_t)(w * 16 + fr0) * 64;
#pragma unroll
        for (int kt = 0; kt < 4; ++kt)
#pragma unroll
            for (int jj = 0; jj < 4; ++jj) so[kt * 16 + fq0 * 4 + jj] = Sacc[kt][jj]; } }
    else { float* so = GH + ((size_t)u * 2 + (w >> 2)) * 4096 + (size_t)((w & 3) * 16 + fr0) * 64;
#pragma unroll
        for (int kt = 0; kt < 4; ++kt)
#pragma unroll
            for (int jj = 0; jj < 4; ++jj) so[kt * 16 + fq0 * 4 + jj] = Sacc[kt][jj]; }
    __syncthreads();
}

__device__ void wkv_fix_unit(const Params& p, int u, float* ldsf) {
    const int tid = threadIdx.x, lane = tid & 63, w = __builtin_amdgcn_readfirstlane(tid >> 6), fr = lane & 15, fq = lane >> 4;
    unsigned char* ws = p.ws;
    bf16_t* OD = (bf16_t*)(ws + WS_X1);
    const bf16_t* RHO = (const bf16_t*)(ws + WS_H);
    const float* GH = (const float*)(ws + WS_BT0);
    const int z = u >> 7, b = (u >> 6) & 1, hd = (u >> 2) & 15, vq = u & 3;
    float* SS = ldsf;
    float* GL = ldsf + 1024;
    bf16_t* SB = (bf16_t*)(ldsf + 1024 + 4096);
    const int v = tid >> 5, kp = (tid & 31) * 2;
    { const float* s0 = p.in[2] + ((size_t)((b * 2 + z) * 16 + hd)) * 4096 + (size_t)(vq * 16 + v) * 64 + kp; SS[v * 64 + kp] = s0[0]; SS[v * 64 + kp + 1] = s0[1]; }
    __syncthreads();
#pragma unroll 1
    for (int sg = 0; sg < 8; ++sg) {
        const int su = ((z * 2 + b) * 16 + hd) * 8 + sg;
        SB[v * 72 + kp] = f2bf_hw(SS[v * 64 + kp]); SB[v * 72 + kp + 1] = f2bf_hw(SS[v * 64 + kp + 1]);
        if (sg < 7) { const f32x4* gsrc = (const f32x4*)(GH + ((size_t)su * 2 + 1) * 4096);
#pragma unroll
            for (int q = 0; q < 2; ++q) ((f32x4*)GL)[tid + q * NTHR] = gsrc[tid + q * NTHR]; }
        __syncthreads();
        const int tlo = z ? (2048 - (sg + 1) * 256) : sg * 256;
#pragma unroll
        for (int q = 0; q < 2; ++q) { const int mt = 2 * w + q;
            f32x4 acc = (f32x4){0.f, 0.f, 0.f, 0.f};
#pragma unroll
            for (int ks = 0; ks < 2; ++ks) { const bf16x8 a = *(const bf16x8*)(RHO + ((size_t)z * 4096 + b * 2048 + tlo + mt * 16 + fr) * 1024 + hd * 64 + ks * 32 + fq * 8);
                const bf16x8 bb = *(const bf16x8*)(SB + fr * 72 + ks * 32 + fq * 8);
                acc = __builtin_amdgcn_mfma_f32_16x16x32_bf16(a, bb, acc, 0, 0, 0); }
#pragma unroll
            for (int jj = 0; jj < 4; ++jj) { bf16_t* op = OD + ((size_t)z * NTOK + NPTOK + b * 2048 + tlo + mt * 16 + fq * 4 + jj) * 1024 + hd * 64 + vq * 16 + fr;
                *op = f2bf_hw(bf2f(*op) + acc[jj]); } }
        if (sg < 7) {
            const float* hsrc = GH + ((size_t)su * 2 + 0) * 4096 + (size_t)(vq * 16 + v) * 64 + kp;
            float a0 = hsrc[0], a1 = hsrc[1];
#pragma unroll 8
            for (int k2 = 0; k2 < 64; ++k2) { const float sv = SS[v * 64 + k2]; a0 += sv * GL[k2 * 64 + kp]; a1 += sv * GL[k2 * 64 + kp + 1]; }
            __syncthreads();
            SS[v * 64 + kp] = a0; SS[v * 64 + kp + 1] = a1;
        }
        __syncthreads();
    }
}
__device__ void phase_wkv_fix(const Params& p, float* lds) {
    for (int it = blockIdx.x; it < 256; it += gridDim.x) wkv_fix_unit(p, it, lds);
}

__device__ void conv_tile(const Params& p, int tile) {
    const int tid = threadIdx.x;
    unsigned char* ws = p.ws;
    const bf16_t* P = (const bf16_t*)(ws + WS_P);
    bf16_t* OC = (bf16_t*)(ws + WS_OC);
    const int cgp = tid & 127, c0 = cgp * 8, sub = tid >> 7;
    float cw0[8], cw1[8], cw2[8];
#pragma unroll
    for (int j = 0; j < 8; ++j) { cw0[j] = p.in[12][c0 + j]; cw1[j] = p.in[12][1024 + c0 + j]; cw2[j] = p.in[12][2048 + c0 + j]; }
    for (int jj = 0; jj < 4; ++jj) {
        const int t = tile * 16 + sub + 4 * jj;
        const int rl = t < NPTOK ? 256 : 64; const int pos = t & (rl - 1);
        const bf16_t* row = P + (size_t)t * N0;
        const u32x4 z4 = (u32x4){0u, 0u, 0u, 0u};
        const u32x4 u1 = *(const u32x4*)(row + c0), g1 = *(const u32x4*)(row + 2048 + c0);
        const u32x4 u0 = pos > 0 ? *(const u32x4*)(row - N0 + c0) : z4, g0 = pos > 0 ? *(const u32x4*)(row - N0 + 2048 + c0) : z4;
        const u32x4 u2 = pos < rl - 1 ? *(const u32x4*)(row + N0 + c0) : z4, g2 = pos < rl - 1 ? *(const u32x4*)(row + N0 + 2048 + c0) : z4;
        const u32x4 gb = *(const u32x4*)(row + 1024 + c0), zc = *(const u32x4*)(row + 3072 + c0);
        u32x4 o;
#pragma unroll
        for (int q = 0; q < 4; ++q) {
            const float y0 = cw0[2 * q] * (bflo(g0[q]) * bflo(u0[q])) + cw1[2 * q] * (bflo(g1[q]) * bflo(u1[q])) + cw2[2 * q] * (bflo(g2[q]) * bflo(u2[q]));
            const float y1 = cw0[2 * q + 1] * (bfhi(g0[q]) * bfhi(u0[q])) + cw1[2 * q + 1] * (bfhi(g1[q]) * bfhi(u1[q])) + cw2[2 * q + 1] * (bfhi(g2[q]) * bfhi(u2[q]));
            o[q] = pack2(silu(bflo(zc[q])) * bflo(gb[q]) * y0, silu(bfhi(zc[q])) * bfhi(gb[q]) * y1);
        }
        *(u32x4*)(OC + (size_t)t * 2048 + c0) = o;
    }
}

__device__ void phase_mix0(const Params& p, float* lds, int rep) {
    unsigned* ctr = (unsigned*)(p.ws + WS_CTL) + rep * 32;
    int* slot = (int*)(lds + LDS_MAIN / 4);
    constexpr int NSCAN = 1024, NCONV = 512;
    for (;;) {
        if (threadIdx.x == 0) *slot = (int)atomicAdd(ctr, 1u);
        __syncthreads();
        const int it = *slot;
        __syncthreads();
        if (it >= NSCAN + NCONV) break;
        if (it < NSCAN) wkv_unit(p, it, lds); else conv_tile(p, it - NSCAN);
    }
}

__device__ __forceinline__ float quad_sum(float v) {
    v += __int_as_float(__builtin_amdgcn_update_dpp(0, __float_as_int(v), 0xB1, 0xF, 0xF, true));
    v += __int_as_float(__builtin_amdgcn_update_dpp(0, __float_as_int(v), 0x4E, 0xF, 0xF, true));
    return v;
}
__device__ void phase_wkv_post(const Params& p) {
    const int tid = threadIdx.x, wave = tid >> 6, lane = tid & 63;
    unsigned char* ws = p.ws;
    const bf16_t* P = (const bf16_t*)(ws + WS_P);
    const bf16_t* OD = (const bf16_t*)(ws + WS_X1);
    const float* BON = (const float*)(ws + WS_BON);
    bf16_t* OC = (bf16_t*)(ws + WS_OC);
    const int hh = lane >> 2, ch0 = hh * 64 + (lane & 3) * 16;
    for (int tok = blockIdx.x * 8 + wave; tok < NTOK; tok += gridDim.x * 8) {
        const bf16_t* row = P + (size_t)tok * N0;
        u32x4 a0[2], a1[2], vv[2], zz[2];
#pragma unroll
        for (int h = 0; h < 2; ++h) { a0[h] = *(const u32x4*)(OD + (size_t)tok * 1024 + ch0 + h * 8); a1[h] = *(const u32x4*)(OD + ((size_t)NTOK + tok) * 1024 + ch0 + h * 8);
            vv[h] = *(const u32x4*)(row + 6144 + ch0 + h * 8); zz[h] = *(const u32x4*)(row + 7168 + ch0 + h * 8); }
        const float bon = BON[(size_t)tok * 16 + hh] + BON[((size_t)NTOK + tok) * 16 + hh];
        float o[16]; float s1 = 0.f;
#pragma unroll
        for (int h = 0; h < 2; ++h)
#pragma unroll
            for (int q = 0; q < 4; ++q) { o[h * 8 + 2 * q] = bflo(a0[h][q]) + bflo(a1[h][q]); o[h * 8 + 2 * q + 1] = bfhi(a0[h][q]) + bfhi(a1[h][q]); s1 += o[h * 8 + 2 * q] + o[h * 8 + 2 * q + 1]; }
        const float mu = quad_sum(s1) * (1.f / 64.f);
        float s2 = 0.f;
#pragma unroll
        for (int i = 0; i < 16; ++i) { o[i] -= mu; s2 += o[i] * o[i]; }
        const float rs = rsqrtf(quad_sum(s2) * (1.f / 64.f) + 64e-5f);
        float res[16];
#pragma unroll
        for (int g4 = 0; g4 < 4; ++g4) { const f32x4 lw4 = *(const f32x4*)(p.in[22] + ch0 + g4 * 4), lb4 = *(const f32x4*)(p.in[23] + ch0 + g4 * 4);
#pragma unroll
            for (int e = 0; e < 4; ++e) { const int i = g4 * 4 + e; const unsigned vw = vv[i >> 3][(i & 7) >> 1], zw_ = zz[i >> 3][(i & 7) >> 1];
                const float v1 = (i & 1) ? bfhi(vw) : bflo(vw), z1 = (i & 1) ? bfhi(zw_) : bflo(zw_);
                res[i] = (o[i] * rs * lw4[e] + lb4[e] + bon * v1) * silu(z1); } }
#pragma unroll
        for (int h = 0; h < 2; ++h) { u32x4 w4; w4.x = pk2(res[h * 8 + 0], res[h * 8 + 1]); w4.y = pk2(res[h * 8 + 2], res[h * 8 + 3]); w4.z = pk2(res[h * 8 + 4], res[h * 8 + 5]); w4.w = pk2(res[h * 8 + 6], res[h * 8 + 7]);
            *(u32x4*)(OC + (size_t)tok * 2048 + 1024 + ch0 + h * 8) = w4; }
    }
}

constexpr size_t WS_QE = WS_H;
constexpr size_t WS_KDT = WS_BT0;
constexpr size_t WS_VT = WS_OC + (size_t)NTOK * 1024 * 2;
constexpr size_t WS_EBL = WS_BON + (size_t)2 * NTOK * 16 * 4;
constexpr size_t WS_ATT = WS_P + 52 * MB;

__device__ void gla_a_item(const Params& p, int item, float* ldsf) {
    const int tid = threadIdx.x, lane = tid & 63, w = __builtin_amdgcn_readfirstlane(tid >> 6), fr = lane & 15, fq = lane >> 4;
    unsigned char* ws = p.ws;
    const bf16_t* P1 = (const bf16_t*)(ws + WS_P);
    float* OD = (float*)(ws + WS_P2);
    bf16_t* QEg = (bf16_t*)(ws + WS_QE); bf16_t* KDTg = (bf16_t*)(ws + WS_KDT); bf16_t* VTg = (bf16_t*)(ws + WS_VT); float* EBLg = (float*)(ws + WS_EBL);
    const int hd = item & 3, c = (item >> 2) & 127, z = item >> 9, tok0 = c * 64;
    bf16_t* QE = (bf16_t*)ldsf;
    bf16_t* KE = QE + 64 * 136;
    bf16_t* VT = KE + 64 * 136;
    bf16_t* ATT = VT + 256 * 72;
    float* G = (float*)(ATT + 64 * 72);
    float* L1G = G + 64 * 132;
    float* GK2 = L1G + 1024;
    for (int i = tid; i < 1024; i += NTHR) { const int t = i >> 4, r = i & 15; L1G[i] = bf2f(P1[(size_t)(tok0 + t) * N1 + 3072 + z * 16 + r]); }
    for (int i = tid; i < 2048; i += NTHR) { const int r = i >> 7, d = i & 127; GK2[i] = p.in[27][(size_t)(z * 16 + r) * 512 + hd * 128 + d]; }
#pragma unroll
    for (int ps = 0; ps < 4; ++ps) { const int t = lane, e8 = (ps * 8 + w) * 8;
        const u32x4 v8 = *(const u32x4*)(P1 + (size_t)(tok0 + t) * N1 + 1024 + hd * 256 + e8);
        VT[(e8 + 0) * 72 + t] = (bf16_t)(v8.x & 0xFFFF); VT[(e8 + 1) * 72 + t] = (bf16_t)(v8.x >> 16); VT[(e8 + 2) * 72 + t] = (bf16_t)(v8.y & 0xFFFF); VT[(e8 + 3) * 72 + t] = (bf16_t)(v8.y >> 16);
        VT[(e8 + 4) * 72 + t] = (bf16_t)(v8.z & 0xFFFF); VT[(e8 + 5) * 72 + t] = (bf16_t)(v8.z >> 16); VT[(e8 + 6) * 72 + t] = (bf16_t)(v8.w & 0xFFFF); VT[(e8 + 7) * 72 + t] = (bf16_t)(v8.w >> 16); }
    const int d = tid & 127, tq = tid >> 7;
    const float gbias = p.in[28][z * 512 + hd * 128 + d];
    bf16_t qraw[16], kraw[16];
#pragma unroll
    for (int i = 0; i < 16; ++i) { const size_t row = (size_t)(tok0 + tq * 16 + i) * N1; qraw[i] = P1[row + hd * 128 + d]; kraw[i] = P1[row + 512 + hd * 128 + d]; }
    __syncthreads();
    { float run = 0.f;
#pragma unroll 4
      for (int i = 0; i < 16; ++i) { const int t = z ? (tq * 16 + 15 - i) : (tq * 16 + i);
        float x = gbias;
#pragma unroll
        for (int r = 0; r < 16; ++r) x += L1G[t * 16 + r] * GK2[r * 128 + d];
        const float ls = fminf(x, 0.f) - flog(1.f + fexp(-fabsf(x)));
        run += ls * (1.f / 16.f);
        G[t * 132 + d] = run; } }
    __syncthreads();
    { const int lastr = z ? 0 : 15;
      const float t0 = G[(0 + lastr) * 132 + d], t1 = G[(16 + lastr) * 132 + d], t2 = G[(32 + lastr) * 132 + d], t3 = G[(48 + lastr) * 132 + d];
      const float blast = t0 + t1 + t2 + t3;
      float off;
      if (z == 0) off = tq == 0 ? 0.f : (tq == 1 ? t0 : (tq == 2 ? t0 + t1 : t0 + t1 + t2));
      else off = tq == 3 ? 0.f : (tq == 2 ? t3 : (tq == 1 ? t3 + t2 : t3 + t2 + t1));
      if (tq == 0) EBLg[(size_t)(z * 128 + c) * 512 + hd * 128 + d] = fexp(blast);
      unsigned kdp[8];
#pragma unroll
      for (int i = 0; i < 16; ++i) { const int t = tq * 16 + i;
        const float bc = G[t * 132 + d] + off;
        const float q = bf2f(qraw[i]) * 0.08838834764831845f, k = bf2f(kraw[i]);
        const bf16_t qe = f2bf(q * fexp(bc));
        QE[t * 136 + d] = qe; KE[t * 136 + d] = f2bf(k * fexp(-bc));
        const unsigned kd = (unsigned)f2bf(k * fexp(blast - bc));
        if (i & 1) kdp[i >> 1] |= kd << 16; else kdp[i >> 1] = kd; }
      bf16_t* kdst = KDTg + ((size_t)(((z * 128 + c) * 4 + hd) * 128 + d)) * 64 + tq * 16;
      *(u32x4*)kdst = (u32x4){kdp[0], kdp[1], kdp[2], kdp[3]}; *(u32x4*)(kdst + 8) = (u32x4){kdp[4], kdp[5], kdp[6], kdp[7]}; }
    __syncthreads();
#pragma unroll
    for (int q2 = 0; q2 < 2; ++q2) { const int idx = q2 * NTHR + tid; const int t = idx >> 4, d8 = (idx & 15) * 8;
        *(u32x4*)(QEg + ((size_t)z * NTOK + tok0 + t) * 512 + hd * 128 + d8) = *(const u32x4*)(QE + t * 136 + d8); }
    if (z == 0) {
#pragma unroll
        for (int q4 = 0; q4 < 4; ++q4) { const int idx = q4 * NTHR + tid; const int e = idx >> 3, t8 = (idx & 7) * 8;
            *(u32x4*)(VTg + ((size_t)((c * 4 + hd) * 256 + e)) * 64 + t8) = *(const u32x4*)(VT + e * 72 + t8); } }
#pragma unroll
    for (int q2 = 0; q2 < 2; ++q2) { const int tA = 2 * w + q2, ia = tA >> 2, ja = tA & 3;
        f32x4 a4 = (f32x4){0.f, 0.f, 0.f, 0.f};
        if (z ? (ja >= ia) : (ja <= ia)) a4 = mma_nt(QE + ia * 16 * 136, 136, KE + ja * 16 * 136, 136, 128, a4, fr, fq);
#pragma unroll
        for (int jj = 0; jj < 4; ++jj) { const int i = ia * 16 + fq * 4 + jj, j = ja * 16 + fr; const bool keep = z ? (j >= i) : (j <= i); ATT[i * 72 + j] = f2bf(keep ? a4[jj] : 0.f); } }
    __syncthreads();
    { bf16_t* ATTg = (bf16_t*)(ws + WS_ATT) + ((size_t)((z * 128 + c) * 4 + hd)) * 4096;
      const int i = tid >> 3, j8 = (tid & 7) * 8;
      *(u32x4*)(ATTg + i * 64 + j8) = *(const u32x4*)(ATT + i * 72 + j8); }
    __syncthreads();
}

__device__ void phase_gla_a(const Params& p, float* lds) {
    for (int it = blockIdx.x; it < 1024; it += gridDim.x) gla_a_item(p, it, lds);
}

struct GlaFrags { bf16x8 kdt[2]; u32x4 vts; u32x4 qes[2]; bf16x8 att[2]; f32x4 ebl; };

template <int NE>
__device__ __forceinline__ void gla_b_unit_t(const Params& p, int z, int b, int hd, int e0, int nch, int ch0, bool sample, float* ldsf) {
    const int tid = threadIdx.x, lane = tid & 63, w = __builtin_amdgcn_readfirstlane(tid >> 6), fr = lane & 15, fq = lane >> 4;
    unsigned char* ws = p.ws;
    float* OD = (float*)(ws + WS_P2);
    const bf16_t* QEg = (const bf16_t*)(ws + WS_QE); const bf16_t* KDTg = (const bf16_t*)(ws + WS_KDT); const bf16_t* VTg = (const bf16_t*)(ws + WS_VT); const float* EBLg = (const float*)(ws + WS_EBL);
    const bf16_t* ATTg = (const bf16_t*)(ws + WS_ATT);
    constexpr int NQ = NE / 2;
    bf16_t* ST = (bf16_t*)ldsf;
    bf16_t* VTL = ST + 2 * 64 * 136;
    bf16_t* QEL = VTL + 2 * 64 * 72;
    f32x4 Sacc[NE];
    if (sample) { const float* s0 = p.in[3] + ((size_t)((b * 2 + z) * 4 + hd)) * 32768 + e0 + fr;
#pragma unroll
        for (int et = 0; et < NE; ++et)
#pragma unroll
            for (int jj = 0; jj < 4; ++jj) Sacc[et][jj] = s0[(size_t)(w * 16 + fq * 4 + jj) * 256 + et * 16]; }
    else {
#pragma unroll
        for (int et = 0; et < NE; ++et) Sacc[et] = (f32x4){0.f, 0.f, 0.f, 0.f}; }
    const int it = w >> 1, e2 = (w & 1) * NQ;
    const int ve = tid >> 3, vt8 = (tid & 7) * 8;
#define GLB_LOAD(F, c_) do { const int cc_ = (c_); \
        _Pragma("unroll") for (int ks = 0; ks < 2; ++ks) { (F).kdt[ks] = *(const bf16x8*)(KDTg + ((size_t)(((z * 128 + cc_) * 4 + hd) * 128 + w * 16 + fr)) * 64 + ks * 32 + fq * 8); \
            (F).att[ks] = *(const bf16x8*)(ATTg + ((size_t)((z * 128 + cc_) * 4 + hd)) * 4096 + (it * 16 + fr) * 64 + ks * 32 + fq * 8); } \
        if (ve < NE * 16) (F).vts = *(const u32x4*)(VTg + ((size_t)((cc_ * 4 + hd) * 256 + e0 + ve)) * 64 + vt8); \
        _Pragma("unroll") for (int h_ = 0; h_ < 2; ++h_) (F).qes[h_] = *(const u32x4*)(QEg + ((size_t)z * NTOK + cc_ * 64 + ve) * 512 + hd * 128 + h_ * 64 + vt8); \
        (F).ebl = *(const f32x4*)(EBLg + (size_t)(z * 128 + cc_) * 512 + hd * 128 + w * 16 + fq * 4); } while (0)
#define GLB_STEP(CUR, NX2, ci_) do { const int ci = (ci_); if (ci < nch) { \
        const int c = ch0 + (z ? nch - 1 - ci : ci); \
        bf16_t* STc = ST + (ci & 1) * 64 * 136; bf16_t* VTc = VTL + (ci & 1) * 64 * 72; \
        _Pragma("unroll") for (int et = 0; et < NE; ++et) { u32x2 v2; v2.x = pk2(Sacc[et][0], Sacc[et][1]); v2.y = pk2(Sacc[et][2], Sacc[et][3]); \
            *(u32x2*)(STc + (et * 16 + fr) * 136 + w * 16 + fq * 4) = v2; } \
        if (ve < NE * 16) *(u32x4*)(VTc + ve * 72 + vt8) = (CUR).vts; \
        bf16_t* QEc = QEL + (ci & 1) * 64 * 136; \
        *(u32x4*)(QEc + ve * 136 + vt8) = (CUR).qes[0]; *(u32x4*)(QEc + ve * 136 + 64 + vt8) = (CUR).qes[1]; \
        if (ci + 2 < nch) GLB_LOAD(NX2, ch0 + (z ? nch - 3 - ci : ci + 2)); \
        lds_barrier(); \
        _Pragma("unroll") for (int et = 0; et < NE; ++et) { Sacc[et] = Sacc[et] * (CUR).ebl; \
            _Pragma("unroll") for (int ks = 0; ks < 2; ++ks) { const bf16x8 vf = *(const bf16x8*)(VTc + (et * 16 + fr) * 72 + ks * 32 + fq * 8); \
                Sacc[et] = __builtin_amdgcn_mfma_f32_16x16x32_bf16((CUR).kdt[ks], vf, Sacc[et], 0, 0, 0); } } \
        _Pragma("unroll") for (int q2 = 0; q2 < NQ; ++q2) { f32x4 o = (f32x4){0.f, 0.f, 0.f, 0.f}; \
            _Pragma("unroll") for (int ks = 0; ks < 2; ++ks) { const bf16x8 vf = *(const bf16x8*)(VTc + ((e2 + q2) * 16 + fr) * 72 + ks * 32 + fq * 8); \
                o = __builtin_amdgcn_mfma_f32_16x16x32_bf16((CUR).att[ks], vf, o, 0, 0, 0); } \
            _Pragma("unroll") for (int ks = 0; ks < 4; ++ks) { const bf16x8 bS = *(const bf16x8*)(STc + ((e2 + q2) * 16 + fr) * 136 + ks * 32 + fq * 8); \
                const bf16x8 aq = *(const bf16x8*)(QEc + (it * 16 + fr) * 136 + ks * 32 + fq * 8); \
                o = __builtin_amdgcn_mfma_f32_16x16x32_bf16(aq, bS, o, 0, 0, 0); } \
            _Pragma("unroll") for (int jj = 0; jj < 4; ++jj) OD[((size_t)z * NTOK + c * 64 + it * 16 + fq * 4 + jj) * 1024 + hd * 256 + e0 + (e2 + q2) * 16 + fr] = o[jj]; } } } while (0)
    GlaFrags fa, fb, fc; fa.vts = fb.vts = fc.vts = (u32x4){0u, 0u, 0u, 0u};
    GLB_LOAD(fa, ch0 + (z ? nch - 1 : 0));
    GLB_LOAD(fb, ch0 + (z ? nch - 2 : 1));
    __syncthreads();
#pragma unroll 1
    for (int ci3 = 0; ci3 < nch; ci3 += 3) { GLB_STEP(fa, fc, ci3); GLB_STEP(fb, fa, ci3 + 1); GLB_STEP(fc, fb, ci3 + 2); }
#undef GLB_STEP
#undef GLB_LOAD
    if (!sample) { float* so = p.out + (size_t)2 * NPTOK * D + 2097152 + ((size_t)((b * 2 + z) * 4 + hd)) * 32768 + e0 + fr;
#pragma unroll
        for (int et = 0; et < NE; ++et)
#pragma unroll
            for (int jj = 0; jj < 4; ++jj) so[(size_t)(w * 16 + fq * 4 + jj) * 256 + et * 16] = Sacc[et][jj]; }
    __syncthreads();
}

__device__ void gla_b_unit(const Params& p, int u, float* ldsf) {
    if (u < 128) gla_b_unit_t<2>(p, u >> 6, (u >> 5) & 1, (u >> 3) & 3, (u & 7) * 32, 32, 64 + ((u >> 5) & 1) * 32, true, ldsf);
    else { const int q = u - 128; gla_b_unit_t<4>(p, q >> 8, (q >> 4) & 15, (q >> 2) & 3, (q & 3) * 64, 4, ((q >> 4) & 15) * 4, false, ldsf); }
}

__device__ void phase_gla_b(const Params& p, float* lds, int rep) {
    unsigned* ctr = (unsigned*)(p.ws + WS_CTL) + 16 + rep * 32;
    int* slot = (int*)(lds + LDS_MAIN / 4);
    for (;;) {
        if (threadIdx.x == 0) *slot = (int)atomicAdd(ctr, 1u);
        __syncthreads();
        const int it = *slot;
        __syncthreads();
        if (it >= 640) break;
        gla_b_unit(p, it, lds);
    }
}

__device__ void phase_gla_post(const Params& p) {
    const int tid = threadIdx.x, wave = tid >> 6, lane = tid & 63;
    unsigned char* ws = p.ws;
    const bf16_t* P1 = (const bf16_t*)(ws + WS_P);
    const float* OD = (const float*)(ws + WS_P2);
    bf16_t* OG = (bf16_t*)(ws + WS_OC);
    for (int tok = blockIdx.x * 8 + wave; tok < NTOK; tok += gridDim.x * 8) {
        for (int hd = 0; hd < 4; ++hd) { const int idx = hd * 256 + lane * 4;
            const f32x4 a = *(const f32x4*)(OD + (size_t)tok * 1024 + idx), b2 = *(const f32x4*)(OD + ((size_t)NTOK + tok) * 1024 + idx);
            const f32x4 o = a + b2;
            const float ss = wave_sum(o[0] * o[0] + o[1] * o[1] + o[2] * o[2] + o[3] * o[3]);
            const float rs = rsqrtf(ss * (1.f / 256.f) + 1e-6f);
            const f32x4 gn = *(const f32x4*)(p.in[29] + lane * 4);
            const u32x2 zz = *(const u32x2*)(P1 + (size_t)tok * N1 + 2048 + idx);
            const float z0 = bflo(zz.x), z1 = bfhi(zz.x), z2 = bflo(zz.y), z3 = bfhi(zz.y);
            u32x2 w; w.x = pack2(o[0] * rs * gn[0] * silu(z0), o[1] * rs * gn[1] * silu(z1)); w.y = pack2(o[2] * rs * gn[2] * silu(z2), o[3] * rs * gn[3] * silu(z3));
            *(u32x2*)(OG + (size_t)tok * 1024 + idx) = w; }
    }
}

__device__ void phase_final(const Params& p) {
    const int tid = threadIdx.x, wave = tid >> 6, lane = tid & 63;
    unsigned char* ws = p.ws;
    const float* MOD = (const float*)(ws + WS_MOD);
    const float* X1 = (const float*)(ws + WS_X1);
    const float* Y = (const float*)(ws + WS_P2);
    for (int tok = blockIdx.x * 8 + wave; tok < NTOK; tok += gridDim.x * 8) {
        const int cond = tok < NPTOK ? 0 : 1 + ((tok - NPTOK) >> 11);
        f32x4 xv[4]; float ss = 0.f;
#pragma unroll
        for (int i = 0; i < 4; ++i) { const int idx = i * 256 + lane * 4;
            const f32x4 x1 = *(const f32x4*)(X1 + (size_t)tok * D + idx);
            const f32x4 ya = *(const f32x4*)(Y + (size_t)tok * D + idx), yb = *(const f32x4*)(Y + (size_t)NTOK * D + (size_t)tok * D + idx);
            const f32x4 gt = *(const f32x4*)(MOD + (1 * 3 + cond) * 3072 + 2048 + idx);
            xv[i] = x1 + gt * (ya + yb);
            ss += xv[i][0] * xv[i][0] + xv[i][1] * xv[i][1] + xv[i][2] * xv[i][2] + xv[i][3] * xv[i][3]; }
        ss = wave_sum(ss);
        const float rstd = rsqrtf(ss * (1.f / 1024.f) + 1e-6f);
#pragma unroll
        for (int i = 0; i < 4; ++i) { const int idx = i * 256 + lane * 4;
            const f32x4 g = *(const f32x4*)(p.in[9] + idx);
            f32x4 o;
#pragma unroll
            for (int j = 0; j < 4; ++j) o[j] = xv[i][j] * rstd * g[j];
            *(f32x4*)(p.out + (size_t)tok * D + idx) = o; }
    }
}


#define XB_TMO      128
#define XB_XCNT(j)  (256  + 64 * (j))
#define XB_XSUB(j)  (1280 + 64 * (j))
#define XB_XGEN(j)  (2304 + 64 * (j))
#define XB_TOP      3328
#define XB_TOPGEN   3392
#define XCD_BAR_WORDS 3456
#define XB_SPIN_CAP (1u << 18)

__device__ __forceinline__ unsigned xb_ld(unsigned* p)              { return __hip_atomic_load(p, __ATOMIC_RELAXED, __HIP_MEMORY_SCOPE_AGENT); }
__device__ __forceinline__ unsigned xb_add(unsigned* p, unsigned v) { return __hip_atomic_fetch_add(p, v, __ATOMIC_RELAXED, __HIP_MEMORY_SCOPE_AGENT); }
__device__ __forceinline__ unsigned xb_xcc_id() { return (unsigned)__builtin_amdgcn_s_getreg((3 << 11) | 20) & 0xFu; }
#define XB_SPIN(cond, bar) do { unsigned _sp = 0; while (cond) { __builtin_amdgcn_s_sleep(1); \
    if ((++_sp & 255u) == 0u) { if (xb_ld(&(bar)[XB_TMO])) break; if (_sp > XB_SPIN_CAP) { atomicAdd(&(bar)[XB_TMO], 1u); break; } } } } while (0)

struct XcdBarrier {
    unsigned* bar; unsigned x;
    volatile LAS unsigned* st;
};

__device__ __forceinline__ XcdBarrier xcd_barrier_post(unsigned* bar, volatile LAS unsigned* st) {
    XcdBarrier b; b.bar = bar; b.x = xb_xcc_id(); b.st = st;
    if (threadIdx.x == 0) (void)xb_add(&bar[XB_XCNT(b.x)], 1u);
    return b;
}
__device__ __forceinline__ void xcd_barrier_complete(unsigned* bar, unsigned x, unsigned& nloc, unsigned& nx) {
    const unsigned G = gridDim.x * gridDim.y * gridDim.z;
    unsigned sum, cnt, mine, sp = 0u;
    for (;;) {
        sum = 0u; cnt = 0u; mine = 0u;
#pragma unroll
        for (unsigned j = 0; j < 16; ++j) { const unsigned c = xb_ld(&bar[XB_XCNT(j)]); sum += c; cnt += (c > 0u) ? 1u : 0u; mine = (j == x) ? c : mine; }
        if (sum == G) break;
        __builtin_amdgcn_s_sleep(1);
        if ((++sp & 255u) == 0u) { if (xb_ld(&bar[XB_TMO])) break; if (sp > XB_SPIN_CAP) { atomicAdd(&bar[XB_TMO], 1u); break; } }
    }
    nloc = mine > 0u ? mine : 1u; nx = cnt > 0u ? cnt : 1u;
}

__device__ __forceinline__ void xcd_barrier(const XcdBarrier& b) {
    asm volatile("s_waitcnt vmcnt(0)" ::: "memory");
    __syncthreads();
    if (threadIdx.x == 0) {
        unsigned* bar = b.bar;
        __builtin_amdgcn_s_waitcnt(0);
        unsigned nloc = b.st[0], nx = b.st[1];
        if (nloc == 0u) { xcd_barrier_complete(bar, b.x, nloc, nx); b.st[0] = nloc; b.st[1] = nx; }
        const unsigned old = xb_add(&bar[XB_XSUB(b.x)], 1u);
        const unsigned gen = old / nloc;
        if (old + 1u == (gen + 1u) * nloc) {
            __builtin_amdgcn_fence(__ATOMIC_RELEASE, "agent");
            asm volatile("s_waitcnt vmcnt(0)" ::: "memory");
            const unsigned og = xb_add(&bar[XB_TOP], 1u);
            const unsigned tg = og / nx;
            if (og + 1u == (tg + 1u) * nx) xb_add(&bar[XB_TOPGEN], 1u);
            else XB_SPIN(xb_ld(&bar[XB_TOPGEN]) == tg, bar);
            __builtin_amdgcn_fence(__ATOMIC_ACQUIRE, "agent");
            xb_add(&bar[XB_XGEN(b.x)], 1u);
            asm volatile("s_waitcnt vmcnt(0)" ::: "memory");
        } else {
            XB_SPIN(xb_ld(&bar[XB_XGEN(b.x)]) == gen, bar);
            __builtin_amdgcn_fence(__ATOMIC_ACQUIRE, "agent");
            asm volatile("s_waitcnt vmcnt(0)" ::: "memory");
        }
    }
    __syncthreads();
}


constexpr int NPHASE = 14;
__global__ void __launch_bounds__(NTHR, 2) fwd_megakernel(Params p) {
    extern __shared__ __attribute__((aligned(16))) unsigned char smem[];
    float* ldsf = (float*)smem;
    LAS unsigned char* ldsl = (LAS unsigned char*)smem;
    unsigned char* ws = p.ws;
    volatile LAS unsigned* xst = (volatile LAS unsigned*)(ldsl + LDS_MAIN + 16);
    if (threadIdx.x == 0) { xst[0] = 0u; xst[1] = 0u; }
    __syncthreads();
    const XcdBarrier xbar = xcd_barrier_post((unsigned*)(ws + WS_BAR), xst);
    if (p.ph_lo < 0) cg::this_grid().sync();
#ifndef DUP_PHASE
#define DUP_PHASE -1
#endif
#define PHASE(n) if (p.ph_lo <= (n) && (n) < p.ph_hi && ((n) == p.ph_lo || (xcd_barrier(xbar), true))) for (int rep = 0; rep < ((n) == DUP_PHASE ? 2 : 1); ++rep, ((n) == DUP_PHASE ? (xcd_barrier(xbar), 0) : 0))
    PHASE(0) phase_prologue(p, ldsf);
    PHASE(1) phase_h(p, 0, ldsf);
    PHASE(2) { pg8::Gemm g{(const bf16_t*)(ws + WS_H), (const bf16_t*)(ws + WS_BT0), NTOK, 8192, 1024, 1024, 1}; pg8::Order S; S.init(NTOK, 8192, 1, gridDim.x, blockIdx.x);
               pg8::EpiBf16 E{(bf16_t*)(ws + WS_P), N0}; pg8::gemm_phase(ldsl, g, S, E); }
    PHASE(3) phase_mix0(p, ldsf, rep);
    PHASE(4) { phase_wkv_fix(p, ldsf); phase_late_weights(p, ldsf); }
    PHASE(5) phase_wkv_post(p);
    PHASE(6) { pg8::Gemm g{(const bf16_t*)(ws + WS_OC), (const bf16_t*)(ws + WS_WT0O), NTOK, 1024, 1024, 2048, 2}; pg8::Order S; S.init(NTOK, 1024, 2, gridDim.x, blockIdx.x);
               pg8::EpiF32 E{(float*)(ws + WS_P), 1024, (size_t)NTOK * 1024}; pg8::gemm_phase(ldsl, g, S, E); }
    PHASE(7) phase_h(p, 1, ldsf);
    PHASE(8) { pg8::Gemm g{(const bf16_t*)(ws + WS_H), (const bf16_t*)(ws + WS_BT1), NTOK, N1, 1024, 1024, 1}; pg8::Order S; S.init(NTOK, N1, 1, gridDim.x, blockIdx.x);
               pg8::EpiBf16 E{(bf16_t*)(ws + WS_P), N1}; pg8::gemm_phase(ldsl, g, S, E); }
    PHASE(9) phase_gla_a(p, ldsf);
    PHASE(10) phase_gla_b(p, ldsf, rep);
    PHASE(11) phase_gla_post(p);
    PHASE(12) { pg8::Gemm g{(const bf16_t*)(ws + WS_OC), (const bf16_t*)(ws + WS_WT1O), NTOK, 1024, 512, 1024, 2}; pg8::Order S; S.init(NTOK, 1024, 2, gridDim.x, blockIdx.x);
                pg8::EpiF32 E{(float*)(ws + WS_P2), 1024, (size_t)NTOK * 1024}; pg8::gemm_phase(ldsl, g, S, E); }
    PHASE(13) phase_final(p);
}

extern "C" void kernel_launch(void* const* d_in, const int* in_sizes, int n_in, void* d_out, int out_size, void* d_ws, size_t ws_size, hipStream_t stream) {
    static int grid = 0;
    if (grid == 0) {
        if (n_in != 30 || ws_size < WS_END) { fprintf(stderr, "kernel_launch: unexpected n_in %d / ws_size %zu (need %zu)\n", n_in, ws_size, (size_t)WS_END); grid = -1; return; }
        int dev = 0, cus = 0, per_cu = 0;
        hipGetDevice(&dev);
        hipDeviceGetAttribute(&cus, hipDeviceAttributeMultiprocessorCount, dev);
        hipFuncSetAttribute((const void*)fwd_megakernel, hipFuncAttributeMaxDynamicSharedMemorySize, LDS_BYTES);
        hipOccupancyMaxActiveBlocksPerMultiprocessor(&per_cu, (const void*)fwd_megakernel, NTHR, LDS_BYTES);
        if (per_cu < 1) { fprintf(stderr, "kernel_launch: occupancy query returned %d\n", per_cu); per_cu = 1; }
        grid = cus * per_cu;
        (void)hipGetLastError();
    }
    if (grid < 0) return;
    static_assert(XCD_BAR_WORDS * 4 <= 14336, "barrier words overlap the queue counters");
    hipMemsetAsync((char*)d_ws + WS_BAR, 0, 14336 + 256, stream);
    Params p{};
    for (int i = 0; i < 30; ++i) p.in[i] = (const float*)d_in[i];
    p.out = (float*)d_out; p.ws = (unsigned char*)d_ws;
#if MULTI_LAUNCH
    for (int ph = 0; ph < NPHASE; ++ph) { p.ph_lo = ph; p.ph_hi = ph + 1; hipLaunchKernelGGL(fwd_megakernel, dim3(grid), dim3(NTHR), LDS_BYTES, stream, p); }
#else
    p.ph_lo = 0; p.ph_hi = NPHASE;
    void* args[] = {&p};
    hipError_t e = hipLaunchCooperativeKernel((const void*)fwd_megakernel, dim3(grid), dim3(NTHR), args, LDS_BYTES, stream);
    if (e != hipSuccess) fprintf(stderr, "cooperative launch failed: %s (grid %d)\n", hipGetErrorString(e), grid);
#endif
}
```

```cpp
#include <hip/hip_runtime.h>
#include <hip/hip_cooperative_groups.h>
#include <cstdio>
namespace cg = cooperative_groups;

#define LAS __attribute__((address_space(3)))
typedef unsigned short bf16_t;
typedef short bf16x8 __attribute__((ext_vector_type(8)));
typedef float f32x4 __attribute__((ext_vector_type(4)));
typedef unsigned u32x4 __attribute__((ext_vector_type(4)));
typedef unsigned u32x2 __attribute__((ext_vector_type(2)));

#ifndef MULTI_LAUNCH
#define MULTI_LAUNCH 0
#endif

constexpr int D = 1024, NTOK = 8192, NPTOK = 4096;
constexpr int N0 = 8448;
constexpr int N1 = 3328;
constexpr int NTHR = 512;
constexpr int LDS_MAIN = 139264;
constexpr int LDS_BYTES = LDS_MAIN + 256;

constexpr size_t MB = 1024 * 1024;
constexpr size_t WS_CTL = 0x1A0000 + 14336;
constexpr size_t WS_MOD = 4096;
constexpr size_t WS_BON = WS_MOD + 2 * 3 * 3072 * 4;
constexpr size_t WS_BAR = 0x1A0000;
constexpr size_t WS_BT0 = 2 * MB;
constexpr size_t WS_WT0O = WS_BT0 + (size_t)N0 * 1024 * 2;
constexpr size_t WS_BT1 = WS_WT0O + (size_t)1024 * 2048 * 2;
constexpr size_t WS_WT1O = WS_BT1 + (size_t)N1 * 1024 * 2;
constexpr size_t WS_H = WS_WT1O + (size_t)1024 * 1024 * 2;
constexpr size_t WS_OC = WS_H + (size_t)NTOK * 1024 * 2;
constexpr size_t WS_X1 = WS_OC + (size_t)NTOK * 2048 * 2;
constexpr size_t WS_P = WS_X1 + (size_t)NTOK * 1024 * 4;
constexpr size_t WS_P2 = WS_P + 64 * MB;
constexpr size_t WS_END = WS_P + (size_t)NTOK * N0 * 2;

struct Params {
    const float* in[30];
    float* out;
    unsigned char* ws;
    int ph_lo, ph_hi;
};

__device__ __forceinline__ float bf2f(bf16_t h) { return __uint_as_float(((unsigned)h) << 16); }
__device__ __forceinline__ bf16_t f2bf(float f) { unsigned u = __float_as_uint(f); u += 0x7FFFu + ((u >> 16) & 1u); return (bf16_t)(u >> 16); }
__device__ __forceinline__ unsigned pack2(float lo, float hi) { return (unsigned)f2bf(lo) | ((unsigned)f2bf(hi) << 16); }
__device__ __forceinline__ float bflo(unsigned w) { return __uint_as_float(w << 16); }
__device__ __forceinline__ float bfhi(unsigned w) { return __uint_as_float(w & 0xFFFF0000u); }
__device__ __forceinline__ float fexp(float x) { return __builtin_amdgcn_exp2f(x * 1.44269504f); }
__device__ __forceinline__ float flog(float x) { return __builtin_amdgcn_logf(x) * 0.69314718f; }
__device__ __forceinline__ float silu(float x) { return x * __builtin_amdgcn_rcpf(1.f + fexp(-x)); }
__device__ __forceinline__ float wave_sum(float v) {
#pragma unroll
    for (int m = 32; m >= 1; m >>= 1) v += __shfl_xor(v, m, 64);
    return v;
}

typedef float f32x2_t __attribute__((ext_vector_type(2)));
typedef __bf16 bf16x2_t __attribute__((ext_vector_type(2)));
__device__ __forceinline__ unsigned pk2(float lo, float hi) { const f32x2_t v = {lo, hi}; return __builtin_bit_cast(unsigned, __builtin_convertvector(v, bf16x2_t)); }
__device__ __forceinline__ bf16_t f2bf_hw(float f) { return __builtin_bit_cast(bf16_t, (__bf16)f); }

__device__ __forceinline__ void lds_barrier() { asm volatile("s_waitcnt lgkmcnt(0)" ::: "memory"); __builtin_amdgcn_s_barrier(); asm volatile("" ::: "memory"); }

namespace pg8 {
constexpr int BM = 256, BK = 64, HALF = 128, HTB = HALF * BK * 2, NXCD = 8, WGM = 8;
__device__ __forceinline__ int lds_byte(int r, int c) { const int st = (r >> 4) * 2 + (c >> 5), rr = r & 15, cc = c & 31, ob = rr * 64 + cc * 2; return st * 1024 + (ob ^ (((ob >> 9) & 1) << 5)); }
__device__ __forceinline__ void stage_rc(int b, int& R, int& C) { const int st = b / 1024, sb = b % 1024, swz = sb ^ (((sb >> 9) & 1) << 5); R = (st >> 1) * 16 + swz / 64; C = (st & 1) * 32 + (swz % 64) / 2; }
__device__ __forceinline__ int perm32(int rho) { const int n = rho >> 4, i = rho & 15; return 8 * (i >> 2) + 4 * n + (i & 3); }

struct Unit { int pm, pn, ks; };
struct Gemm { const bf16_t* A; const bf16_t* Bt; int M, N, K, ld, KS; };

struct Order {
    int nM, nN, nNr, nwg, G, c;
    __device__ void init(int M, int N, int KS, int G_, int c_) { nM = M / BM; nNr = N / BM; nN = nNr * KS; nwg = nM * nN; G = G_; c = c_; }
    __device__ bool next(int i, Unit& u) const {
        const long L = (long)i * G + c; if (L >= nwg) return false;
        int wgid = (int)L; { const int q = nwg / NXCD, r = nwg % NXCD, xcd = wgid % NXCD, off = wgid / NXCD; wgid = (xcd < r ? xcd * (q + 1) : r * (q + 1) + (xcd - r) * q) + off; }
        const int nig = WGM * nN, gid = wgid / nig, fm = gid * WGM, gsz = (nM - fm) < WGM ? (nM - fm) : WGM;
        u.pm = fm + ((wgid % nig) % gsz); const int pn = (wgid % nig) / gsz; u.pn = pn % nNr; u.ks = pn / nNr; return true;
    }
};

__device__ __forceinline__ unsigned cvt_pk_bf16(float lo, float hi) { unsigned r; asm volatile("v_cvt_pk_bf16_f32 %0, %1, %2" : "=v"(r) : "v"(lo), "v"(hi)); return r; }

struct EpiF32 {
    static constexpr bool PERM = false;
    float* C; int ldc; size_t ks_stride;
    __device__ __forceinline__ void operator()(const f32x4 (&acc)[2][2][4][2], const Unit& u, int wr, int wc, int fr, int fq) const {
        const int row0 = u.pm * BM + wr * 64 + fr, col0 = u.pn * BM + wc * 32 + 4 * fq;
        float* Cb = C + (size_t)u.ks * ks_stride;
#pragma unroll
        for (int ai = 0; ai < 2; ++ai)
#pragma unroll
            for (int m = 0; m < 4; ++m) { float* rowp = Cb + (size_t)(row0 + ai * HALF + m * 16) * ldc + col0;
#pragma unroll
                for (int bj = 0; bj < 2; ++bj)
#pragma unroll
                    for (int n = 0; n < 2; ++n) *(f32x4*)(rowp + bj * HALF + n * 16) = acc[ai][bj][m][n]; }
    }
};
struct EpiBf16 {
    static constexpr bool PERM = true;
    bf16_t* O; int ldc;
    __device__ __forceinline__ void operator()(const f32x4 (&acc)[2][2][4][2], const Unit& u, int wr, int wc, int fr, int fq) const {
        const int row0 = u.pm * BM + wr * 64 + fr; const int col0 = u.pn * BM + wc * 32 + 8 * fq;
#pragma unroll
        for (int ai = 0; ai < 2; ++ai)
#pragma unroll
            for (int m = 0; m < 4; ++m) { bf16_t* rowp = O + (size_t)(row0 + ai * HALF + m * 16) * ldc + col0;
#pragma unroll
                for (int bj = 0; bj < 2; ++bj) { const f32x4 v0 = acc[ai][bj][m][0], v1 = acc[ai][bj][m][1];
                    u32x4 w; w.x = cvt_pk_bf16(v0[0], v0[1]); w.y = cvt_pk_bf16(v0[2], v0[3]); w.z = cvt_pk_bf16(v1[0], v1[1]); w.w = cvt_pk_bf16(v1[2], v1[3]);
                    *(u32x4*)(rowp + bj * HALF) = w; } }
    }
};

template <class Epi>
__device__ __forceinline__ void gemm_phase(LAS unsigned char* lds, const Gemm g, const Order& S, const Epi& E) {
    const int tid = threadIdx.x, wid = __builtin_amdgcn_readfirstlane(tid >> 6), lane = tid & 63, wr = wid >> 2, wc = wid & 3, fr = lane & 15, fq = lane >> 4;
    const int K = g.K, nt = K / BK, ld = g.ld;
    unsigned voffA[2], voffB[2];
#pragma unroll
    for (int i = 0; i < 2; ++i) { int R, C; stage_rc(tid * 16 + i * 8192, R, C); const int Rb = Epi::PERM ? ((R & ~31) + perm32(R & 31)) : R;
        voffA[i] = (unsigned)(R * ld + C) * 2u; voffB[i] = (unsigned)(Rb * ld + C) * 2u; }
    const size_t kstep = (size_t)(BK * 2);
    const size_t hstep = (size_t)HALF * ld * 2;
    const size_t tstep = 2 * hstep;
    const size_t ksb = (size_t)K * 2;
    const unsigned ldsw = (unsigned)wid * 1024u;
    const int aoff = lds_byte(wr * 64 + fr, fq * 8), boff = lds_byte(wc * 32 + fr, fq * 8);
#define PG8_SA(b, h) (((b) * 2 + (h)) * HTB)
#define PG8_SB(b, h) ((4 + (b) * 2 + (h)) * HTB)
#define PG8_STAGE(bufoff, gbase, voff) do { _Pragma("unroll") for (int _i = 0; _i < 2; ++_i) \
        __builtin_amdgcn_global_load_lds((const unsigned*)((const char*)(gbase) + (voff)[_i]), (LAS unsigned*)(lds + (bufoff) + ldsw + _i * 8192), 16, 0, 0); } while (0)
#define PG8_LDA(dst, b, h) do { _Pragma("unroll") for (int m = 0; m < 4; ++m) _Pragma("unroll") for (int k = 0; k < 2; ++k) dst[m][k] = *(const LAS bf16x8*)(lds + PG8_SA(b, h) + aoff + m * 2048 + k * 1024); } while (0)
#define PG8_LDB(dst, b, h) do { _Pragma("unroll") for (int n = 0; n < 2; ++n) _Pragma("unroll") for (int k = 0; k < 2; ++k) dst[n][k] = *(const LAS bf16x8*)(lds + PG8_SB(b, h) + boff + n * 2048 + k * 1024); } while (0)
#define PG8_MMA(ai, bj, At, Bt) do { __builtin_amdgcn_s_setprio(1); _Pragma("unroll") for (int m = 0; m < 4; ++m) _Pragma("unroll") for (int n = 0; n < 2; ++n) _Pragma("unroll") for (int k = 0; k < 2; ++k) \
        acc[ai][bj][m][n] = __builtin_amdgcn_mfma_f32_16x16x32_bf16(Bt[n][k], At[m][k], acc[ai][bj][m][n], 0, 0, 0); __builtin_amdgcn_s_setprio(0); } while (0)
#define PG8_WAIT_V(n) asm volatile("s_waitcnt vmcnt(" #n ")" ::: "memory")
#define PG8_WAIT_L(n) asm volatile("s_waitcnt lgkmcnt(" #n ")" ::: "memory")
#define PG8_BAR __builtin_amdgcn_s_barrier()
#define PG8_SCHED __builtin_amdgcn_sched_barrier(0)
    Unit cur, nxt; int ui = 0;
    if (!S.next(0, cur)) return;
    f32x4 acc[2][2][4][2];
#pragma unroll
    for (int a = 0; a < 2; ++a)
#pragma unroll
        for (int b = 0; b < 2; ++b)
#pragma unroll
            for (int m = 0; m < 4; ++m)
#pragma unroll
                for (int n = 0; n < 2; ++n) acc[a][b][m][n] = (f32x4){0.f, 0.f, 0.f, 0.f};
    bf16x8 At[4][2], B0[2][2], B1[2][2];
    const char* cA = (const char*)g.A + (size_t)cur.pm * tstep + (size_t)cur.ks * ksb; const char* cB = (const char*)g.Bt + (size_t)cur.pn * tstep + (size_t)cur.ks * ksb;
    PG8_STAGE(PG8_SB(0, 0), cB, voffB); PG8_STAGE(PG8_SA(0, 0), cA, voffA); PG8_STAGE(PG8_SB(0, 1), cB + hstep, voffB); PG8_STAGE(PG8_SA(0, 1), cA + hstep, voffA);
    if (wr == 1) PG8_BAR;
    PG8_WAIT_V(4); PG8_BAR;
    PG8_STAGE(PG8_SB(1, 0), cB + kstep, voffB); PG8_STAGE(PG8_SA(1, 0), cA + kstep, voffA); PG8_STAGE(PG8_SB(1, 1), cB + hstep + kstep, voffB);
    PG8_WAIT_V(6); PG8_BAR;
    for (;;) {
        const bool has_next = S.next(ui + 1, nxt);
        const char* nA = has_next ? (const char*)g.A + (size_t)nxt.pm * tstep + (size_t)nxt.ks * ksb : cA; const char* nB = has_next ? (const char*)g.Bt + (size_t)nxt.pn * tstep + (size_t)nxt.ks * ksb : cB;
        for (int t = 0; t < nt; t += 2) {
            const bool last = (t == nt - 2);
            const char* a1 = cA + (size_t)(t + 1) * kstep;
            const char* a2 = last ? nA : cA + (size_t)(t + 2) * kstep; const char* b2 = last ? nB : cB + (size_t)(t + 2) * kstep;
            const char* a3 = a2 + kstep; const char* b3 = b2 + kstep;
            PG8_LDB(B0, 0, 0); PG8_SCHED; PG8_LDA(At, 0, 0); PG8_STAGE(PG8_SA(1, 1), a1 + hstep, voffA);
            PG8_WAIT_L(8); PG8_BAR; PG8_WAIT_L(0); PG8_MMA(0, 0, At, B0); PG8_BAR; PG8_SCHED;
            PG8_LDB(B1, 0, 1); PG8_STAGE(PG8_SB(0, 0), b2, voffB);
            PG8_BAR; PG8_WAIT_L(0); PG8_MMA(0, 1, At, B1); PG8_BAR;
            PG8_LDA(At, 0, 1); PG8_STAGE(PG8_SA(0, 0), a2, voffA);
            PG8_BAR; PG8_WAIT_L(0); PG8_MMA(1, 0, At, B0); PG8_BAR; PG8_SCHED;
            PG8_STAGE(PG8_SB(0, 1), b2 + hstep, voffB);
            PG8_WAIT_V(6); PG8_BAR; PG8_MMA(1, 1, At, B1); PG8_BAR;
            PG8_LDB(B0, 1, 0); PG8_SCHED; PG8_LDA(At, 1, 0); PG8_STAGE(PG8_SA(0, 1), a2 + hstep, voffA);
            PG8_WAIT_L(8); PG8_BAR; PG8_WAIT_L(0); PG8_MMA(0, 0, At, B0); PG8_BAR; PG8_SCHED;
            PG8_LDB(B1, 1, 1); PG8_STAGE(PG8_SB(1, 0), b3, voffB);
            PG8_BAR; PG8_WAIT_L(0); PG8_MMA(0, 1, At, B1); PG8_BAR;
            PG8_LDA(At, 1, 1); PG8_STAGE(PG8_SA(1, 0), a3, voffA);
            PG8_BAR; PG8_WAIT_L(0); PG8_MMA(1, 0, At, B0); PG8_BAR; PG8_SCHED;
            PG8_STAGE(PG8_SB(1, 1), b3 + hstep, voffB);
            PG8_WAIT_V(6); PG8_BAR; PG8_MMA(1, 1, At, B1); PG8_BAR;
        }
        E(acc, cur, wr, wc, fr, fq);
        if (!has_next) break;
#pragma unroll
        for (int a = 0; a < 2; ++a)
#pragma unroll
            for (int b = 0; b < 2; ++b)
#pragma unroll
                for (int m = 0; m < 4; ++m)
#pragma unroll
                    for (int n = 0; n < 2; ++n) acc[a][b][m][n] = (f32x4){0.f, 0.f, 0.f, 0.f};
        cur = nxt; cA = nA; cB = nB; ++ui;
    }
    PG8_WAIT_V(0);
    if (wr == 0) PG8_BAR;
    PG8_BAR;
#undef PG8_SA
#undef PG8_SB
#undef PG8_STAGE
#undef PG8_LDA
#undef PG8_LDB
#undef PG8_MMA
#undef PG8_WAIT_V
#undef PG8_WAIT_L
#undef PG8_BAR
#undef PG8_SCHED
}
}

struct TJob { const float* src; bf16_t* dst; int ldsrc, N, lddst, drow0, k0, n0; };
__device__ __forceinline__ TJob tjob_of(const Params& p, int t) {
    unsigned char* ws = p.ws;
    bf16_t* BT0 = (bf16_t*)(ws + WS_BT0); bf16_t* WT0O = (bf16_t*)(ws + WS_WT0O); bf16_t* BT1 = (bf16_t*)(ws + WS_BT1); bf16_t* WT1O = (bf16_t*)(ws + WS_WT1O);
    TJob j; int nnt;
    if (t < 1024) { j.src = p.in[10]; j.ldsrc = 8192; j.N = 8192; j.dst = BT0; j.lddst = 1024; j.drow0 = 0; nnt = 64; }
    else if (t < 1024 + 32) { t -= 1024; const int z = t >> 4; t &= 15; j.src = p.in[14] + (size_t)z * 1024 * 64; j.ldsrc = 64; j.N = 64; j.dst = BT0; j.lddst = 1024; j.drow0 = 8192 + z * 64; nnt = 1; }
    else if (t < 1024 + 64) { t -= 1024 + 32; const int z = t >> 4; t &= 15; j.src = p.in[17] + (size_t)z * 1024 * 64; j.ldsrc = 64; j.N = 64; j.dst = BT0; j.lddst = 1024; j.drow0 = 8320 + z * 64; nnt = 1; }
    else if (t < 1088 + 256) { t -= 1088; j.src = p.in[11]; j.ldsrc = 1024; j.N = 1024; j.dst = WT0O; j.lddst = 2048; j.drow0 = 0; nnt = 8; }
    else if (t < 1344 + 384) { t -= 1344; j.src = p.in[24]; j.ldsrc = 3072; j.N = 3072; j.dst = BT1; j.lddst = 1024; j.drow0 = 0; nnt = 24; }
    else if (t < 1728 + 32) { t -= 1728; const int z = t >> 4; t &= 15; j.src = p.in[26] + (size_t)z * 1024 * 16; j.ldsrc = 16; j.N = 16; j.dst = BT1; j.lddst = 1024; j.drow0 = 3072 + z * 16; nnt = 1; }
    else { t -= 1760; j.src = p.in[25]; j.ldsrc = 1024; j.N = 1024; j.dst = WT1O; j.lddst = 1024; j.drow0 = 0; nnt = 8; }
    j.k0 = (t / nnt) * 64; j.n0 = (t % nnt) * 128; return j;
}
__device__ __forceinline__ void tjob_load(const TJob& j, f32x4 (&r)[4]) {
    const int tid = threadIdx.x, c4 = (tid & 31) * 4;
#pragma unroll
    for (int i = 0; i < 4; ++i) { const int kk = (tid >> 5) + 16 * i;
        r[i] = (j.n0 + c4 < j.N) ? *(const f32x4*)(j.src + (size_t)(j.k0 + kk) * j.ldsrc + j.n0 + c4) : (f32x4){0.f, 0.f, 0.f, 0.f}; }
}

__device__ void transpose_jobs(const Params& p, float* lds, int t_lo, int t_hi, int rot) {
    const int tid = threadIdx.x;
    float* tile = lds;
    int it = t_lo + (int)((blockIdx.x + (unsigned)rot) % gridDim.x);
    f32x4 cur[4], nxt[4];
    TJob jc = tjob_of(p, it < t_hi ? it : t_lo);
    if (it < t_hi) tjob_load(jc, cur);
    for (; it < t_hi; it += gridDim.x) {
        const int c4 = (tid & 31) * 4;
#pragma unroll
        for (int i = 0; i < 4; ++i) { const int kk = (tid >> 5) + 16 * i; tile[kk * 129 + c4] = cur[i][0]; tile[kk * 129 + c4 + 1] = cur[i][1]; tile[kk * 129 + c4 + 2] = cur[i][2]; tile[kk * 129 + c4 + 3] = cur[i][3]; }
        const int itn = it + gridDim.x;
        const TJob jn = tjob_of(p, itn < t_hi ? itn : t_lo);
        if (itn < t_hi) tjob_load(jn, nxt);
        __syncthreads();
#pragma unroll
        for (int q = 0; q < 2; ++q) { const int idx = tid + q * NTHR; const int nn = idx >> 3, k8 = (idx & 7) * 8;
            if (jc.n0 + nn < jc.N) { u32x4 o; o.x = pk2(tile[(k8 + 0) * 129 + nn], tile[(k8 + 1) * 129 + nn]); o.y = pk2(tile[(k8 + 2) * 129 + nn], tile[(k8 + 3) * 129 + nn]);
                o.z = pk2(tile[(k8 + 4) * 129 + nn], tile[(k8 + 5) * 129 + nn]); o.w = pk2(tile[(k8 + 6) * 129 + nn], tile[(k8 + 7) * 129 + nn]);
                *(u32x4*)(jc.dst + (size_t)(jc.drow0 + jc.n0 + nn) * jc.lddst + jc.k0 + k8) = o; } }
        __syncthreads();
        jc = jn;
#pragma unroll
        for (int i = 0; i < 4; ++i) cur[i] = nxt[i];
    }
}

__device__ void phase_prologue(const Params& p, float* lds) {
    const int tid = threadIdx.x;
    unsigned char* ws = p.ws;
    bf16_t* BT1 = (bf16_t*)(ws + WS_BT1);
    float* MOD = (float*)(ws + WS_MOD);
    constexpr int NGEMV = 192;
    for (int it = blockIdx.x; it < NGEMV; it += gridDim.x) {
        const int l = it / 96, j0 = (it % 96) * 32;
        float* sc = lds;
        float* red = lds + 3072;
        for (int i = tid; i < 3072; i += NTHR) { const int cnd = i >> 10, k = i & 1023; const float v = cnd == 0 ? p.in[5][k] : p.in[4][(cnd - 1) * 1024 + k]; sc[i] = silu(v); }
        __syncthreads();
        const int col = tid & 31, ksp = tid >> 5;
        float a0 = 0.f, a1 = 0.f, a2 = 0.f;
        const float* w = p.in[7] + (size_t)l * 1024 * 3072 + j0 + col;
#pragma unroll 16
        for (int k = ksp * 64; k < ksp * 64 + 64; ++k) { const float wv = w[(size_t)k * 3072]; a0 += sc[k] * wv; a1 += sc[1024 + k] * wv; a2 += sc[2048 + k] * wv; }
        red[(ksp * 3 + 0) * 32 + col] = a0; red[(ksp * 3 + 1) * 32 + col] = a1; red[(ksp * 3 + 2) * 32 + col] = a2;
        __syncthreads();
        if (tid < 96) { const int cnd = tid >> 5, cc = tid & 31; float s = 0.f; for (int q = 0; q < 16; ++q) s += red[(q * 3 + cnd) * 32 + cc];
            MOD[(l * 3 + cnd) * 3072 + j0 + cc] = s + p.in[8][l * 3072 + j0 + cc]; }
        __syncthreads();
    }
    transpose_jobs(p, lds, 0, 1088, 64);
}
__device__ void phase_late_weights(const Params& p, float* lds) {
    const int tid = threadIdx.x;
    bf16_t* BT1 = (bf16_t*)(p.ws + WS_BT1);
    transpose_jobs(p, lds, 1088, 1888, 0);
    { u32x4* z = (u32x4*)(BT1 + (size_t)3104 * 1024); const int n = 224 * 1024 * 2 / 16;
      for (int i = blockIdx.x * NTHR + tid; i < n; i += gridDim.x * NTHR) z[i] = (u32x4){0u, 0u, 0u, 0u}; }
}

__device__ void phase_h(const Params& p, int layer, float* ldsf) {
    const int tid = threadIdx.x, wave = __builtin_amdgcn_readfirstlane(tid >> 6), lane = tid & 63, fr = lane & 15, fq = lane >> 4;
    unsigned char* ws = p.ws;
    const float* MOD = (const float*)(ws + WS_MOD);
    bf16_t* H = (bf16_t*)(ws + WS_H);
    float* X1 = (float*)(ws + WS_X1);
    const float* Y = (const float*)(ws + WS_P);
    bf16_t* HL = (bf16_t*)ldsf;
    for (int tb = blockIdx.x * 32; tb < NTOK; tb += gridDim.x * 32) {
#pragma unroll 1
        for (int q = 0; q < 4; ++q) { const int tl = wave * 4 + q, tok = tb + tl;
            const float* xr = tok < NPTOK ? p.in[0] + (size_t)tok * D : p.in[1] + (size_t)(tok - NPTOK) * D;
            const int cond = tok < NPTOK ? 0 : 1 + ((tok - NPTOK) >> 11);
            f32x4 xv[4]; float ss = 0.f;
#pragma unroll
            for (int i = 0; i < 4; ++i) { const int idx = i * 256 + lane * 4; xv[i] = *(const f32x4*)(xr + idx);
                if (layer == 1) { const f32x4 ya = *(const f32x4*)(Y + (size_t)tok * D + idx), yb = *(const f32x4*)(Y + (size_t)NTOK * D + (size_t)tok * D + idx);
                    const f32x4 gt = *(const f32x4*)(MOD + (0 * 3 + cond) * 3072 + 2048 + idx);
                    xv[i] = xv[i] + gt * (ya + yb); *(f32x4*)(X1 + (size_t)tok * D + idx) = xv[i]; }
                ss += xv[i][0] * xv[i][0] + xv[i][1] * xv[i][1] + xv[i][2] * xv[i][2] + xv[i][3] * xv[i][3]; }
            ss = wave_sum(ss);
            const float rstd = rsqrtf(ss * (1.f / 1024.f) + 1e-6f);
#pragma unroll
            for (int i = 0; i < 4; ++i) { const int idx = i * 256 + lane * 4;
                const f32x4 g = *(const f32x4*)(p.in[6] + layer * D + idx);
                const f32x4 sh = *(const f32x4*)(MOD + (layer * 3 + cond) * 3072 + idx), sc = *(const f32x4*)(MOD + (layer * 3 + cond) * 3072 + 1024 + idx);
                f32x4 h;
#pragma unroll
                for (int j = 0; j < 4; ++j) h[j] = xv[i][j] * rstd * g[j] * (1.f + sc[j]) + sh[j];
                u32x2 w2; w2.x = pk2(h[0], h[1]); w2.y = pk2(h[2], h[3]);
                *(u32x2*)(H + (size_t)tok * D + idx) = w2;
                if (layer == 0) *(u32x2*)(HL + tl * 1032 + idx) = w2; } }
        if (layer == 0) {
            __syncthreads();
            const bf16_t* BL = (const bf16_t*)(ws + WS_BT0) + (size_t)8192 * 1024;
            bf16_t* P = (bf16_t*)(ws + WS_P);
            f32x4 acc[2][2];
#pragma unroll
            for (int mt = 0; mt < 2; ++mt)
#pragma unroll
                for (int n2 = 0; n2 < 2; ++n2) acc[mt][n2] = (f32x4){0.f, 0.f, 0.f, 0.f};
#pragma unroll 16
            for (int ks = 0; ks < 32; ++ks) {
                bf16x8 af[2], bfr[2];
#pragma unroll
                for (int mt = 0; mt < 2; ++mt) af[mt] = *(const bf16x8*)(HL + (mt * 16 + fr) * 1032 + ks * 32 + fq * 8);
#pragma unroll
                for (int n2 = 0; n2 < 2; ++n2) bfr[n2] = *(const bf16x8*)(BL + (size_t)((wave * 2 + n2) * 16 + fr) * 1024 + ks * 32 + fq * 8);
#pragma unroll
                for (int mt = 0; mt < 2; ++mt)
#pragma unroll
                    for (int n2 = 0; n2 < 2; ++n2) acc[mt][n2] = __builtin_amdgcn_mfma_f32_16x16x32_bf16(af[mt], bfr[n2], acc[mt][n2], 0, 0, 0);
            }
#pragma unroll
            for (int mt = 0; mt < 2; ++mt)
#pragma unroll
                for (int n2 = 0; n2 < 2; ++n2)
#pragma unroll
                    for (int jj = 0; jj < 4; ++jj) P[(size_t)(tb + mt * 16 + fq * 4 + jj) * N0 + 8192 + (wave * 2 + n2) * 16 + fr] = f2bf_hw(acc[mt][n2][jj]);
            __syncthreads();
        }
    }
}

__device__ __forceinline__ f32x4 mma_nt(const bf16_t* A, int lda, const bf16_t* B, int ldb, int K, f32x4 acc, int fr, int fq) {
    for (int k0 = 0; k0 < K; k0 += 32) {
        const bf16x8 a = *(const bf16x8*)(A + fr * lda + k0 + fq * 8);
        const bf16x8 b = *(const bf16x8*)(B + fr * ldb + k0 + fq * 8);
        acc = __builtin_amdgcn_mfma_f32_16x16x32_bf16(a, b, acc, 0, 0, 0);
    }
    return acc;
}
__device__ __forceinline__ bf16x8 pack8(float a0, float a1, float a2, float a3, float a4, float a5, float a6, float a7) {
    u32x4 w; w.x = pack2(a0, a1); w.y = pack2(a2, a3); w.z = pack2(a4, a5); w.w = pack2(a6, a7);
    return __builtin_bit_cast(bf16x8, w);
}
__device__ __forceinline__ float dpp_add(float v, float o) { return v + o; }
__device__ __forceinline__ float wave_sum_fast(float v) {
    v += __int_as_float(__builtin_amdgcn_update_dpp(0, __float_as_int(v), 0xB1, 0xF, 0xF, true));
    v += __int_as_float(__builtin_amdgcn_update_dpp(0, __float_as_int(v), 0x4E, 0xF, 0xF, true));
    v += __int_as_float(__builtin_amdgcn_update_dpp(0, __float_as_int(v), 0x141, 0xF, 0xF, true));
    v += __int_as_float(__builtin_amdgcn_update_dpp(0, __float_as_int(v), 0x140, 0xF, 0xF, true));
    v += __shfl_xor(v, 16, 64); v += __shfl_xor(v, 32, 64);
    return v;
}
__device__ __forceinline__ float wave_sum_dpp(float v) {
    v += __int_as_float(__builtin_amdgcn_update_dpp(0, __float_as_int(v), 0xB1, 0xF, 0xF, true));
    v += __int_as_float(__builtin_amdgcn_update_dpp(0, __float_as_int(v), 0x4E, 0xF, 0xF, true));
    v += __int_as_float(__builtin_amdgcn_update_dpp(0, __float_as_int(v), 0x141, 0xF, 0xF, true));
    v += __int_as_float(__builtin_amdgcn_update_dpp(0, __float_as_int(v), 0x140, 0xF, 0xF, true));
    v += __int_as_float(__builtin_amdgcn_update_dpp(0, __float_as_int(v), 0x142, 0xA, 0xF, false));
    v += __int_as_float(__builtin_amdgcn_update_dpp(0, __float_as_int(v), 0x143, 0xC, 0xF, false));
    return __int_as_float(__builtin_amdgcn_readlane(__float_as_int(v), 63));
}
__device__ __forceinline__ float wave_sum_lane63(float v) {
    v += __int_as_float(__builtin_amdgcn_update_dpp(0, __float_as_int(v), 0xB1, 0xF, 0xF, true));
    v += __int_as_float(__builtin_amdgcn_update_dpp(0, __float_as_int(v), 0x4E, 0xF, 0xF, true));
    v += __int_as_float(__builtin_amdgcn_update_dpp(0, __float_as_int(v), 0x141, 0xF, 0xF, true));
    v += __int_as_float(__builtin_amdgcn_update_dpp(0, __float_as_int(v), 0x140, 0xF, 0xF, true));
    v += __int_as_float(__builtin_amdgcn_update_dpp(0, __float_as_int(v), 0x142, 0xA, 0xF, false));
    v += __int_as_float(__builtin_amdgcn_update_dpp(0, __float_as_int(v), 0x143, 0xC, 0xF, false));
    return v;
}
__device__ __forceinline__ float fast_tanh(float x) { const float e = fexp(2.f * x); return 1.f - 2.f * __builtin_amdgcn_rcpf(1.f + e); }
__device__ __forceinline__ bf16x8 pack8h(float a0, float a1, float a2, float a3, float a4, float a5, float a6, float a7) {
    u32x4 w; w.x = pk2(a0, a1); w.y = pk2(a2, a3); w.z = pk2(a4, a5); w.w = pk2(a6, a7);
    return __builtin_bit_cast(bf16x8, w);
}

__device__ void wkv_unit(const Params& p, int u, float* ldsf) {
    const int tid0 = threadIdx.x, lane0 = tid0 & 63, w = __builtin_amdgcn_readfirstlane(tid0 >> 6), fr0 = lane0 & 15, fq0 = lane0 >> 4;
    unsigned char* ws = p.ws;
    unsigned char* lds = (unsigned char*)ldsf;
    const bf16_t* P = (const bf16_t*)(ws + WS_P);
    bf16_t* OD = (bf16_t*)(ws + WS_X1);
    float* BON = (float*)(ws + WS_BON);
    int z, b, hd, sgm, seqT, tok0; bool sample; const int T = 256;
    if (u < 512) { sample = true; z = u >> 8; b = (u >> 7) & 1; hd = (u >> 3) & 15; sgm = u & 7; seqT = 2048; tok0 = NPTOK + b * 2048; }
    else { const int q = u - 512; sample = false; z = q >> 8; b = (q >> 4) & 15; hd = q & 15; sgm = 0; seqT = 256; tok0 = b * 256; }
    const int qbase = sgm * 256;
    bf16_t* RHO = (bf16_t*)(ws + WS_H);
    float* GH = (float*)(ws + WS_BT0);
    bf16_t* TLW = (bf16_t*)(lds + 0);
    bf16_t* TLA = (bf16_t*)(lds + 9216);
    float* HT = (float*)(lds + 18432);
    float* BONL = (float*)(lds + 57344);
    bf16_t* KTr = (bf16_t*)(lds + 20480);
    bf16_t* BTr = (bf16_t*)(lds + 29696);
    bf16_t* KKH = (bf16_t*)(lds + 38912);
    bf16_t* RH = (bf16_t*)(lds + 48128);
    const bf16_t* VS = (const bf16_t*)(lds + 113664 + 2 * 8192);
    bf16_t* TA = (bf16_t*)(lds + 65536);
    bf16_t* NA = (bf16_t*)(lds + 70656);
    float* PC = (float*)(lds + 75776);
    bf16_t* KBm = (bf16_t*)(lds + 76800);
    float* MM = (float*)(lds + 97280);
    float* WA = (float*)(lds + 76800);
    bf16x8 bw[2];
    { const float* W2 = (w >> 2) ? p.in[18] : p.in[15];
#pragma unroll
      for (int ks = 0; ks < 2; ++ks) { float t8[8];
#pragma unroll
        for (int e = 0; e < 8; ++e) t8[e] = W2[(size_t)(z * 64 + ks * 32 + fq0 * 8 + e) * 1024 + hd * 64 + (w & 3) * 16 + fr0];
        bw[ks] = pack8h(t8[0], t8[1], t8[2], t8[3], t8[4], t8[5], t8[6], t8[7]); } }
    f32x4 Sacc[4];
#pragma unroll
    for (int kt = 0; kt < 4; ++kt) Sacc[kt] = (f32x4){0.f, 0.f, 0.f, 0.f};
    if (w >= 4) {
#pragma unroll
        for (int kt = 0; kt < 4; ++kt)
#pragma unroll
            for (int jj = 0; jj < 4; ++jj) Sacc[kt][jj] = (kt * 16 + fq0 * 4 + jj == (w - 4) * 16 + fr0) ? 1.f : 0.f; }
    const int ch = hd * 64 + lane0;
    const float w0c = p.in[13][z * 1024 + ch], a0c = p.in[16][z * 1024 + ch], kkc = p.in[19][ch], kac = p.in[20][ch], rkc = p.in[21][ch];
    bf16_t* RKV = (bf16_t*)(lds + 113664);
    u32x4 tlraw[2], rkvraw[3];
#define WKV_LOAD_RAW(tb_) do { \
        _Pragma("unroll") for (int h_ = 0; h_ < 2; ++h_) { const int idx_ = tid + h_ * NTHR; const int tau_ = idx_ >> 4, sg_ = idx_ & 15; const int t_ = z ? (seqT - 1 - (qbase + (tb_) + tau_)) : (qbase + (tb_) + tau_); \
            tlraw[h_] = *(const u32x4*)(P + (size_t)(tok0 + t_) * N0 + 8192 + (sg_ < 8 ? z * 64 + sg_ * 8 : 128 + z * 64 + (sg_ - 8) * 8)); } \
        { const int tau_ = tid >> 3, sg_ = tid & 7; const int t_ = z ? (seqT - 1 - (qbase + (tb_) + tau_)) : (qbase + (tb_) + tau_); const bf16_t* rp_ = P + (size_t)(tok0 + t_) * N0 + 4096 + hd * 64 + sg_ * 8; \
          rkvraw[0] = *(const u32x4*)rp_; rkvraw[1] = *(const u32x4*)(rp_ + 1024); rkvraw[2] = *(const u32x4*)(rp_ + 2048); } } while (0)
    { const int tid = tid0; WKV_LOAD_RAW(0); }
    __syncthreads();
#pragma unroll 1
    for (int tb = 0; tb < T; tb += 64) {
        int tid = tid0; asm volatile("" : "+v"(tid));
        const int lane = tid & 63, fr = lane & 15, fq = lane >> 4, c = lane;
        const int pcol = ((c >> 5) * 32) + (((c >> 2) & 3) * 8) + (((c >> 4) & 1) * 4) + (c & 3);
#pragma unroll
        for (int h = 0; h < 2; ++h) { const int idx = tid + h * NTHR; const int tau = idx >> 4, sg = idx & 15;
            u32x4 o = tlraw[h];
            if (sg < 8) { o.x = pk2(fast_tanh(bflo(o.x)), fast_tanh(bfhi(o.x))); o.y = pk2(fast_tanh(bflo(o.y)), fast_tanh(bfhi(o.y)));
                          o.z = pk2(fast_tanh(bflo(o.z)), fast_tanh(bfhi(o.z))); o.w = pk2(fast_tanh(bflo(o.w)), fast_tanh(bfhi(o.w))); }
            *(u32x4*)((sg < 8 ? TLW : TLA) + tau * 72 + (sg & 7) * 8) = o; }
#pragma unroll
        for (int h = 0; h < 3; ++h) *(u32x4*)(RKV + h * 4096 + (tid >> 3) * 64 + (tid & 7) * 8) = rkvraw[h];
        lds_barrier();
        if (tb + 64 < T) WKV_LOAD_RAW(tb + 64);
        { const bf16_t* TL = (w >> 2) ? TLA : TLW; float* WAo = WA + (w >> 2) * 64 * 68;
#pragma unroll
          for (int mt = 0; mt < 4; ++mt) { f32x4 acc = (f32x4){0.f, 0.f, 0.f, 0.f};
#pragma unroll
            for (int ks = 0; ks < 2; ++ks) { const bf16x8 a = *(const bf16x8*)(TL + (mt * 16 + fr) * 72 + ks * 32 + fq * 8);
                acc = __builtin_amdgcn_mfma_f32_16x16x32_bf16(a, bw[ks], acc, 0, 0, 0); }
#pragma unroll
            for (int jj = 0; jj < 4; ++jj) WAo[(mt * 16 + fq * 4 + jj) * 68 + (w & 3) * 16 + fr] = acc[jj]; } }
        lds_barrier();
        float kkv[8], kmv[8], bv[8], lwv[8], cum[8], rr[8], bonv[8];
        { float run = 0.f;
#pragma unroll
          for (int i = 0; i < 8; ++i) { const int tau = w * 8 + i; const int t = z ? (seqT - 1 - (qbase + tb + tau)) : (qbase + tb + tau); const int tokg = tok0 + t;
            const float wr_ = w0c + WA[tau * 68 + c], ap = a0c + WA[64 * 68 + tau * 68 + c];
            const float nx = -wr_; const float sp = fmaxf(nx, 0.f) + flog(1.f + fexp(-fabsf(nx)));
            const float lw = -fexp(-sp - 0.5f);
            const float iclr = __builtin_amdgcn_rcpf(1.f + fexp(-ap));
            const float kxi = bf2f(RKV[4096 + tau * 64 + c]); rr[i] = bf2f(RKV[tau * 64 + c]);
            const float kkraw = kxi * kkc;
            const float ssq = wave_sum_fast(kkraw * kkraw);
            const float kk = kkraw * __builtin_amdgcn_rsqf(fmaxf(ssq, 1e-24f));
            const float kmod = kxi * (1.f + (iclr - 1.f) * kac);
            bonv[i] = wave_sum_lane63(rr[i] * kmod * rkc);
            run += lw;
            kkv[i] = kk; kmv[i] = kmod; bv[i] = kk * iclr; lwv[i] = lw; cum[i] = run; }
          HT[w * 64 + c] = run;
          if (lane == 63) {
#pragma unroll
            for (int i = 0; i < 8; ++i) BONL[w * 8 + i] = bonv[i]; } }
        lds_barrier();
        if (tid < 64) { const int t = z ? (seqT - 1 - (qbase + tb + tid)) : (qbase + tb + tid); BON[((size_t)z * NTOK + tok0 + t) * 16 + hd] = BONL[tid]; }
        { const float off = (w & 1) ? HT[(w - 1) * 64 + c] : 0.f; const int cn = w >> 1;
          unsigned kbq[8];
#pragma unroll
          for (int i = 0; i < 8; ++i) { const int tau = w * 8 + i; const int j = (w & 1) * 8 + i;
            const float cm = cum[i] + off;
            const float Pj = fexp(cm), ipj = fexp(-cm), pm1 = fexp(cm - lwv[i]);
            const unsigned kb2 = pk2(-bv[i] * ipj, kmv[i] * ipj);
            KTr[tau * 72 + pcol] = (bf16_t)(kb2 >> 16); BTr[tau * 72 + pcol] = f2bf_hw(bv[i] * ipj);
            const unsigned kr2 = pk2(kkv[i] * pm1, rr[i] * Pj);
            KKH[tau * 72 + pcol] = (bf16_t)(kr2 & 0xFFFFu); RH[tau * 72 + pcol] = (bf16_t)(kr2 >> 16);
            kbq[i] = kb2;
            if (j == 15) PC[cn * 64 + c] = Pj; }
#pragma unroll
          for (int g = 0; g < 2; ++g) { u32x4 o;
              o.x = (kbq[g * 4 + 0] & 0xFFFFu) | (kbq[g * 4 + 1] << 16); o.y = (kbq[g * 4 + 2] & 0xFFFFu) | (kbq[g * 4 + 3] << 16);
              o.z = (kbq[g * 4 + 0] >> 16) | (kbq[g * 4 + 1] & 0xFFFF0000u); o.w = (kbq[g * 4 + 2] >> 16) | (kbq[g * 4 + 3] & 0xFFFF0000u);
              *(u32x4*)(KBm + (cn * 64 + c) * 40 + ((w & 1) * 2 + g) * 8) = o; } }
        lds_barrier();
#pragma unroll
        for (int q2 = 0; q2 < 2; ++q2) { const int id = w * 2 + q2; const int cn = id >> 2, which = id & 3;
          const bf16_t* Am = ((which & 1) ? KTr : BTr) + cn * 16 * 72; const bf16_t* Bm = ((which & 2) ? RH : KKH) + cn * 16 * 72;
          const f32x4 acc = mma_nt(Am, 72, Bm, 72, 64, (f32x4){0.f, 0.f, 0.f, 0.f}, fr, fq);
          f32x4 o;
#pragma unroll
          for (int jj = 0; jj < 4; ++jj) { const int i = fq * 4 + jj, j = fr; const bool keep = (which & 2) ? (i <= j) : (i < j); o[jj] = keep ? acc[jj] : 0.f; }
          *(f32x4*)(MM + (cn * 4 + which) * 256 + fr * 16 + fq * 4) = o; }
        lds_barrier();
        if (w < 4) { const int cn = w, col = lane >> 2, rg = lane & 3;
            const float* MbT = MM + (cn * 4 + 0) * 256 + rg * 4; const float* MkT = MM + (cn * 4 + 1) * 256 + rg * 4;
            float Tc[4], A1[4];
#pragma unroll
            for (int e = 0; e < 4; ++e) { Tc[e] = (rg * 4 + e == col) ? 1.f : 0.f; A1[e] = 0.f; }
#define INV_STEP(l, CTRL) do { const f32x4 mb = *(const f32x4*)(MbT + (l) * 16), mk = *(const f32x4*)(MkT + (l) * 16); \
                const float tl_ = __int_as_float(__builtin_amdgcn_update_dpp(0, __float_as_int(Tc[(l) & 3]), CTRL, 0xF, 0xF, true)); \
                Tc[0] -= mb[0] * tl_; Tc[1] -= mb[1] * tl_; Tc[2] -= mb[2] * tl_; Tc[3] -= mb[3] * tl_; \
                A1[0] += mk[0] * tl_; A1[1] += mk[1] * tl_; A1[2] += mk[2] * tl_; A1[3] += mk[3] * tl_; } while (0)
            INV_STEP(15, 0xFF); INV_STEP(14, 0xFF); INV_STEP(13, 0xFF); INV_STEP(12, 0xFF);
            INV_STEP(11, 0xAA); INV_STEP(10, 0xAA); INV_STEP(9, 0xAA); INV_STEP(8, 0xAA);
            INV_STEP(7, 0x55); INV_STEP(6, 0x55); INV_STEP(5, 0x55); INV_STEP(4, 0x55);
            INV_STEP(3, 0x00); INV_STEP(2, 0x00); INV_STEP(1, 0x00);
#undef INV_STEP
            u32x4 o; o.x = pk2(Tc[0], Tc[1]); o.y = pk2(Tc[2], Tc[3]); o.z = pk2(A1[0], A1[1]); o.w = pk2(A1[2], A1[3]);
            *(u32x4*)(TA + (cn * 16 + col) * 40 + rg * 8) = o; }
        else { const int cn = w - 4, j = lane & 15, ig = lane >> 4;
            const f32x4 nb = *(const f32x4*)(MM + (cn * 4 + 2) * 256 + j * 16 + ig * 4), nk = *(const f32x4*)(MM + (cn * 4 + 3) * 256 + j * 16 + ig * 4);
            u32x4 o; o.x = pk2(-nb[0], -nb[1]); o.y = pk2(-nb[2], -nb[3]); o.z = pk2(nk[0], nk[1]); o.w = pk2(nk[2], nk[3]);
            *(u32x4*)(NA + (cn * 16 + j) * 40 + ig * 8) = o; }
        lds_barrier();
        if (w < 4 || sample) {
            const int vb = w & 3;
            const int t0s = z ? (seqT - 1 - (qbase + tb)) : (qbase + tb);
            const long tstep = z ? -1024 : 1024;
            bf16_t* obase = (w < 4) ? OD + ((size_t)z * NTOK + tok0 + t0s) * 1024 + hd * 64 + vb * 16 + fr : RHO + ((size_t)z * 4096 + (tok0 - NPTOK) + t0s) * 1024 + hd * 64 + vb * 16 + fr;
#pragma unroll 1
            for (int cn = 0; cn < 4; ++cn) {
                bf16x8 sb[2];
#pragma unroll
                for (int ks = 0; ks < 2; ++ks) sb[ks] = pack8h(Sacc[2 * ks][0], Sacc[2 * ks][1], Sacc[2 * ks][2], Sacc[2 * ks][3], Sacc[2 * ks + 1][0], Sacc[2 * ks + 1][1], Sacc[2 * ks + 1][2], Sacc[2 * ks + 1][3]);
                f32x4 U0 = (f32x4){0.f, 0.f, 0.f, 0.f}, O = (f32x4){0.f, 0.f, 0.f, 0.f};
#pragma unroll
                for (int ks = 0; ks < 2; ++ks) { const bf16x8 a = *(const bf16x8*)(KKH + (cn * 16 + fr) * 72 + ks * 32 + fq * 8);
                    U0 = __builtin_amdgcn_mfma_f32_16x16x32_bf16(a, sb[ks], U0, 0, 0, 0);
                    const bf16x8 ar = *(const bf16x8*)(RH + (cn * 16 + fr) * 72 + ks * 32 + fq * 8);
                    O = __builtin_amdgcn_mfma_f32_16x16x32_bf16(ar, sb[ks], O, 0, 0, 0); }
                float vf[4];
#pragma unroll
                for (int e = 0; e < 4; ++e) vf[e] = (w < 4) ? bf2f(VS[(cn * 16 + fq * 4 + e) * 64 + vb * 16 + fr]) : 0.f;
                const bf16x8 bU0 = pack8h(U0[0], U0[1], U0[2], U0[3], vf[0], vf[1], vf[2], vf[3]);
                const bf16x8 ta = *(const bf16x8*)(TA + (cn * 16 + fr) * 40 + fq * 8);
                const f32x4 U = __builtin_amdgcn_mfma_f32_16x16x32_bf16(ta, bU0, (f32x4){0.f, 0.f, 0.f, 0.f}, 0, 0, 0);
                const bf16x8 bUV = pack8h(U[0], U[1], U[2], U[3], vf[0], vf[1], vf[2], vf[3]);
                const bf16x8 na = *(const bf16x8*)(NA + (cn * 16 + fr) * 40 + fq * 8);
                O = __builtin_amdgcn_mfma_f32_16x16x32_bf16(na, bUV, O, 0, 0, 0);
#pragma unroll
                for (int jj = 0; jj < 4; ++jj) obase[(long)(cn * 16 + fq * 4 + jj) * tstep] = f2bf_hw(O[jj]);
#pragma unroll
                for (int kt = 0; kt < 4; ++kt) { const bf16x8 kb = *(const bf16x8*)(KBm + (cn * 64 + kt * 16 + fr) * 40 + fq * 8);
                    Sacc[kt] = __builtin_amdgcn_mfma_f32_16x16x32_bf16(kb, bUV, Sacc[kt], 0, 0, 0);
                    const f32x4 pc = *(const f32x4*)(PC + cn * 64 + kt * 16 + fq * 4);
                    Sacc[kt] = Sacc[kt] * pc; }
            }
        }
        lds_barrier();
    }
#undef WKV_LOAD_RAW
    if (!sample) { if (w < 4) { float* so = p.out + (size_t)2 * NPTOK * D + ((size_t)((b * 2 + z) * 16 + hd)) * 4096 + (size_t)(w * 16 + fr0) * 64;
#pragma unroll
        for (int kt = 0; kt < 4; ++kt)
#pragma unroll
            for (int jj = 0; jj < 4; ++jj) so[kt * 16 + fq0 * 4 + jj] = Sacc[kt][jj]; } }
    else { float* so = GH + ((size_t)u * 2 + (w >> 2)) * 4096 + (size_t)((w & 3) * 16 + fr0) * 64;
#pragma unroll
        for (int kt = 0; kt < 4; ++kt)
#pragma unroll
            for (int jj = 0; jj < 4; ++jj) so[kt * 16 + fq0 * 4 + jj] = Sacc[kt][jj]; }
    __syncthreads();
}

__device__ void wkv_fix_unit(const Params& p, int u, float* ldsf) {
    const int tid = threadIdx.x, lane = tid & 63, w = __builtin_amdgcn_readfirstlane(tid >> 6), fr = lane & 15, fq = lane >> 4;
    unsigned char* ws = p.ws;
    bf16_t* OD = (bf16_t*)(ws + WS_X1);
    const bf16_t* RHO = (const bf16_t*)(ws + WS_H);
    const float* GH = (const float*)(ws + WS_BT0);
    const int z = u >> 7, b = (u >> 6) & 1, hd = (u >> 2) & 15, vq = u & 3;
    float* SS = ldsf;
    float* GL = ldsf + 1024;
    bf16_t* SB = (bf16_t*)(ldsf + 1024 + 4096);
    const int v = tid >> 5, kp = (tid & 31) * 2;
    { const float* s0 = p.in[2] + ((size_t)((b * 2 + z) * 16 + hd)) * 4096 + (size_t)(vq * 16 + v) * 64 + kp; SS[v * 64 + kp] = s0[0]; SS[v * 64 + kp + 1] = s0[1]; }
    __syncthreads();
#pragma unroll 1
    for (int sg = 0; sg < 8; ++sg) {
        const int su = ((z * 2 + b) * 16 + hd) * 8 + sg;
        SB[v * 72 + kp] = f2bf_hw(SS[v * 64 + kp]); SB[v * 72 + kp + 1] = f2bf_hw(SS[v * 64 + kp + 1]);
        if (sg < 7) { const f32x4* gsrc = (const f32x4*)(GH + ((size_t)su * 2 + 1) * 4096);
#pragma unroll
            for (int q = 0; q < 2; ++q) ((f32x4*)GL)[tid + q * NTHR] = gsrc[tid + q * NTHR]; }
        __syncthreads();
        const int tlo = z ? (2048 - (sg + 1) * 256) : sg * 256;
#pragma unroll
        for (int q = 0; q < 2; ++q) { const int mt = 2 * w + q;
            f32x4 acc = (f32x4){0.f, 0.f, 0.f, 0.f};
#pragma unroll
            for (int ks = 0; ks < 2; ++ks) { const bf16x8 a = *(const bf16x8*)(RHO + ((size_t)z * 4096 + b * 2048 + tlo + mt * 16 + fr) * 1024 + hd * 64 + ks * 32 + fq * 8);
                const bf16x8 bb = *(const bf16x8*)(SB + fr * 72 + ks * 32 + fq * 8);
                acc = __builtin_amdgcn_mfma_f32_16x16x32_bf16(a, bb, acc, 0, 0, 0); }
#pragma unroll
            for (int jj = 0; jj < 4; ++jj) { bf16_t* op = OD + ((size_t)z * NTOK + NPTOK + b * 2048 + tlo + mt * 16 + fq * 4 + jj) * 1024 + hd * 64 + vq * 16 + fr;
                *op = f2bf_hw(bf2f(*op) + acc[jj]); } }
        if (sg < 7) {
            const float* hsrc = GH + ((size_t)su * 2 + 0) * 4096 + (size_t)(vq * 16 + v) * 64 + kp;
            float a0 = hsrc[0], a1 = hsrc[1];
#pragma unroll 8
            for (int k2 = 0; k2 < 64; ++k2) { const float sv = SS[v * 64 + k2]; a0 += sv * GL[k2 * 64 + kp]; a1 += sv * GL[k2 * 64 + kp + 1]; }
            __syncthreads();
            SS[v * 64 + kp] = a0; SS[v * 64 + kp + 1] = a1;
        }
        __syncthreads();
    }
}
__device__ void phase_wkv_fix(const Params& p, float* lds) {
    for (int it = blockIdx.x; it < 256; it += gridDim.x) wkv_fix_unit(p, it, lds);
}

__device__ void conv_tile(const Params& p, int tile) {
    const int tid = threadIdx.x;
    unsigned char* ws = p.ws;
    const bf16_t* P = (const bf16_t*)(ws + WS_P);
    bf16_t* OC = (bf16_t*)(ws + WS_OC);
    const int cgp = tid & 127, c0 = cgp * 8, sub = tid >> 7;
    float cw0[8], cw1[8], cw2[8];
#pragma unroll
    for (int j = 0; j < 8; ++j) { cw0[j] = p.in[12][c0 + j]; cw1[j] = p.in[12][1024 + c0 + j]; cw2[j] = p.in[12][2048 + c0 + j]; }
    for (int jj = 0; jj < 4; ++jj) {
        const int t = tile * 16 + sub + 4 * jj;
        const int rl = t < NPTOK ? 256 : 64; const int pos = t & (rl - 1);
        const bf16_t* row = P + (size_t)t * N0;
        const u32x4 z4 = (u32x4){0u, 0u, 0u, 0u};
        const u32x4 u1 = *(const u32x4*)(row + c0), g1 = *(const u32x4*)(row + 2048 + c0);
        const u32x4 u0 = pos > 0 ? *(const u32x4*)(row - N0 + c0) : z4, g0 = pos > 0 ? *(const u32x4*)(row - N0 + 2048 + c0) : z4;
        const u32x4 u2 = pos < rl - 1 ? *(const u32x4*)(row + N0 + c0) : z4, g2 = pos < rl - 1 ? *(const u32x4*)(row + N0 + 2048 + c0) : z4;
        const u32x4 gb = *(const u32x4*)(row + 1024 + c0), zc = *(const u32x4*)(row + 3072 + c0);
        u32x4 o;
#pragma unroll
        for (int q = 0; q < 4; ++q) {
            const float y0 = cw0[2 * q] * (bflo(g0[q]) * bflo(u0[q])) + cw1[2 * q] * (bflo(g1[q]) * bflo(u1[q])) + cw2[2 * q] * (bflo(g2[q]) * bflo(u2[q]));
            const float y1 = cw0[2 * q + 1] * (bfhi(g0[q]) * bfhi(u0[q])) + cw1[2 * q + 1] * (bfhi(g1[q]) * bfhi(u1[q])) + cw2[2 * q + 1] * (bfhi(g2[q]) * bfhi(u2[q]));
            o[q] = pack2(silu(bflo(zc[q])) * bflo(gb[q]) * y0, silu(bfhi(zc[q])) * bfhi(gb[q]) * y1);
        }
        *(u32x4*)(OC + (size_t)t * 2048 + c0) = o;
    }
}

__device__ void phase_mix0(const Params& p, float* lds, int rep) {
    (void)rep;
    constexpr int NSCAN = 1024, NCONV = 512;
    for (int it = blockIdx.x; it < NSCAN + NCONV; it += gridDim.x) {
        if (it < NSCAN) wkv_unit(p, it, lds); else conv_tile(p, it - NSCAN);
    }
}

__device__ __forceinline__ float quad_sum(float v) {
    v += __int_as_float(__builtin_amdgcn_update_dpp(0, __float_as_int(v), 0xB1, 0xF, 0xF, true));
    v += __int_as_float(__builtin_amdgcn_update_dpp(0, __float_as_int(v), 0x4E, 0xF, 0xF, true));
    return v;
}
__device__ void phase_wkv_post(const Params& p) {
    const int tid = threadIdx.x, wave = tid >> 6, lane = tid & 63;
    unsigned char* ws = p.ws;
    const bf16_t* P = (const bf16_t*)(ws + WS_P);
    const bf16_t* OD = (const bf16_t*)(ws + WS_X1);
    const float* BON = (const float*)(ws + WS_BON);
    bf16_t* OC = (bf16_t*)(ws + WS_OC);
    const int hh = lane >> 2, ch0 = hh * 64 + (lane & 3) * 16;
    for (int tok = blockIdx.x * 8 + wave; tok < NTOK; tok += gridDim.x * 8) {
        const bf16_t* row = P + (size_t)tok * N0;
        u32x4 a0[2], a1[2], vv[2], zz[2];
#pragma unroll
        for (int h = 0; h < 2; ++h) { a0[h] = *(const u32x4*)(OD + (size_t)tok * 1024 + ch0 + h * 8); a1[h] = *(const u32x4*)(OD + ((size_t)NTOK + tok) * 1024 + ch0 + h * 8);
            vv[h] = *(const u32x4*)(row + 6144 + ch0 + h * 8); zz[h] = *(const u32x4*)(row + 7168 + ch0 + h * 8); }
        const float bon = BON[(size_t)tok * 16 + hh] + BON[((size_t)NTOK + tok) * 16 + hh];
        float o[16]; float s1 = 0.f;
#pragma unroll
        for (int h = 0; h < 2; ++h)
#pragma unroll
            for (int q = 0; q < 4; ++q) { o[h * 8 + 2 * q] = bflo(a0[h][q]) + bflo(a1[h][q]); o[h * 8 + 2 * q + 1] = bfhi(a0[h][q]) + bfhi(a1[h][q]); s1 += o[h * 8 + 2 * q] + o[h * 8 + 2 * q + 1]; }
        const float mu = quad_sum(s1) * (1.f / 64.f);
        float s2 = 0.f;
#pragma unroll
        for (int i = 0; i < 16; ++i) { o[i] -= mu; s2 += o[i] * o[i]; }
        const float rs = rsqrtf(quad_sum(s2) * (1.f / 64.f) + 64e-5f);
        float res[16];
#pragma unroll
        for (int g4 = 0; g4 < 4; ++g4) { const f32x4 lw4 = *(const f32x4*)(p.in[22] + ch0 + g4 * 4), lb4 = *(const f32x4*)(p.in[23] + ch0 + g4 * 4);
#pragma unroll
            for (int e = 0; e < 4; ++e) { const int i = g4 * 4 + e; const unsigned vw = vv[i >> 3][(i & 7) >> 1], zw_ = zz[i >> 3][(i & 7) >> 1];
                const float v1 = (i & 1) ? bfhi(vw) : bflo(vw), z1 = (i & 1) ? bfhi(zw_) : bflo(zw_);
                res[i] = (o[i] * rs * lw4[e] + lb4[e] + bon * v1) * silu(z1); } }
#pragma unroll
        for (int h = 0; h < 2; ++h) { u32x4 w4; w4.x = pk2(res[h * 8 + 0], res[h * 8 + 1]); w4.y = pk2(res[h * 8 + 2], res[h * 8 + 3]); w4.z = pk2(res[h * 8 + 4], res[h * 8 + 5]); w4.w = pk2(res[h * 8 + 6], res[h * 8 + 7]);
            *(u32x4*)(OC + (size_t)tok * 2048 + 1024 + ch0 + h * 8) = w4; }
    }
}

constexpr size_t WS_QE = WS_H;
constexpr size_t WS_KDT = WS_BT0;
constexpr size_t WS_VT = WS_OC + (size_t)NTOK * 1024 * 2;
constexpr size_t WS_EBL = WS_BON + (size_t)2 * NTOK * 16 * 4;
constexpr size_t WS_ATT = WS_P + 52 * MB;

__device__ void gla_a_item(const Params& p, int item, float* ldsf) {
    const int tid = threadIdx.x, lane = tid & 63, w = __builtin_amdgcn_readfirstlane(tid >> 6), fr = lane & 15, fq = lane >> 4;
    unsigned char* ws = p.ws;
    const bf16_t* P1 = (const bf16_t*)(ws + WS_P);
    float* OD = (float*)(ws + WS_P2);
    bf16_t* QEg = (bf16_t*)(ws + WS_QE); bf16_t* KDTg = (bf16_t*)(ws + WS_KDT); bf16_t* VTg = (bf16_t*)(ws + WS_VT); float* EBLg = (float*)(ws + WS_EBL);
    const int hd = item & 3, c = (item >> 2) & 127, z = item >> 9, tok0 = c * 64;
    bf16_t* QE = (bf16_t*)ldsf;
    bf16_t* KE = QE + 64 * 136;
    bf16_t* VT = KE + 64 * 136;
    bf16_t* ATT = VT + 256 * 72;
    float* G = (float*)(ATT + 64 * 72);
    float* L1G = G + 64 * 132;
    float* GK2 = L1G + 1024;
    for (int i = tid; i < 1024; i += NTHR) { const int t = i >> 4, r = i & 15; L1G[i] = bf2f(P1[(size_t)(tok0 + t) * N1 + 3072 + z * 16 + r]); }
    for (int i = tid; i < 2048; i += NTHR) { const int r = i >> 7, d = i & 127; GK2[i] = p.in[27][(size_t)(z * 16 + r) * 512 + hd * 128 + d]; }
#pragma unroll
    for (int ps = 0; ps < 4; ++ps) { const int t = lane, e8 = (ps * 8 + w) * 8;
        const u32x4 v8 = *(const u32x4*)(P1 + (size_t)(tok0 + t) * N1 + 1024 + hd * 256 + e8);
        VT[(e8 + 0) * 72 + t] = (bf16_t)(v8.x & 0xFFFF); VT[(e8 + 1) * 72 + t] = (bf16_t)(v8.x >> 16); VT[(e8 + 2) * 72 + t] = (bf16_t)(v8.y & 0xFFFF); VT[(e8 + 3) * 72 + t] = (bf16_t)(v8.y >> 16);
        VT[(e8 + 4) * 72 + t] = (bf16_t)(v8.z & 0xFFFF); VT[(e8 + 5) * 72 + t] = (bf16_t)(v8.z >> 16); VT[(e8 + 6) * 72 + t] = (bf16_t)(v8.w & 0xFFFF); VT[(e8 + 7) * 72 + t] = (bf16_t)(v8.w >> 16); }
    const int d = tid & 127, tq = tid >> 7;
    const float gbias = p.in[28][z * 512 + hd * 128 + d];
    bf16_t qraw[16], kraw[16];
#pragma unroll
    for (int i = 0; i < 16; ++i) { const size_t row = (size_t)(tok0 + tq * 16 + i) * N1; qraw[i] = P1[row + hd * 128 + d]; kraw[i] = P1[row + 512 + hd * 128 + d]; }
    __syncthreads();
    { float run = 0.f;
#pragma unroll 4
      for (int i = 0; i < 16; ++i) { const int t = z ? (tq * 16 + 15 - i) : (tq * 16 + i);
        float x = gbias;
#pragma unroll
        for (int r = 0; r < 16; ++r) x += L1G[t * 16 + r] * GK2[r * 128 + d];
        const float ls = fminf(x, 0.f) - flog(1.f + fexp(-fabsf(x)));
        run += ls * (1.f / 16.f);
        G[t * 132 + d] = run; } }
    __syncthreads();
    { const int lastr = z ? 0 : 15;
      const float t0 = G[(0 + lastr) * 132 + d], t1 = G[(16 + lastr) * 132 + d], t2 = G[(32 + lastr) * 132 + d], t3 = G[(48 + lastr) * 132 + d];
      const float blast = t0 + t1 + t2 + t3;
      float off;
      if (z == 0) off = tq == 0 ? 0.f : (tq == 1 ? t0 : (tq == 2 ? t0 + t1 : t0 + t1 + t2));
      else off = tq == 3 ? 0.f : (tq == 2 ? t3 : (tq == 1 ? t3 + t2 : t3 + t2 + t1));
      if (tq == 0) EBLg[(size_t)(z * 128 + c) * 512 + hd * 128 + d] = fexp(blast);
      unsigned kdp[8];
#pragma unroll
      for (int i = 0; i < 16; ++i) { const int t = tq * 16 + i;
        const float bc = G[t * 132 + d] + off;
        const float q = bf2f(qraw[i]) * 0.08838834764831845f, k = bf2f(kraw[i]);
        const bf16_t qe = f2bf(q * fexp(bc));
        QE[t * 136 + d] = qe; KE[t * 136 + d] = f2bf(k * fexp(-bc));
        const unsigned kd = (unsigned)f2bf(k * fexp(blast - bc));
        if (i & 1) kdp[i >> 1] |= kd << 16; else kdp[i >> 1] = kd; }
      bf16_t* kdst = KDTg + ((size_t)(((z * 128 + c) * 4 + hd) * 128 + d)) * 64 + tq * 16;
      *(u32x4*)kdst = (u32x4){kdp[0], kdp[1], kdp[2], kdp[3]}; *(u32x4*)(kdst + 8) = (u32x4){kdp[4], kdp[5], kdp[6], kdp[7]}; }
    __syncthreads();
#pragma unroll
    for (int q2 = 0; q2 < 2; ++q2) { const int idx = q2 * NTHR + tid; const int t = idx >> 4, d8 = (idx & 15) * 8;
        *(u32x4*)(QEg + ((size_t)z * NTOK + tok0 + t) * 512 + hd * 128 + d8) = *(const u32x4*)(QE + t * 136 + d8); }
    if (z == 0) {
#pragma unroll
        for (int q4 = 0; q4 < 4; ++q4) { const int idx = q4 * NTHR + tid; const int e = idx >> 3, t8 = (idx & 7) * 8;
            *(u32x4*)(VTg + ((size_t)((c * 4 + hd) * 256 + e)) * 64 + t8) = *(const u32x4*)(VT + e * 72 + t8); } }
#pragma unroll
    for (int q2 = 0; q2 < 2; ++q2) { const int tA = 2 * w + q2, ia = tA >> 2, ja = tA & 3;
        f32x4 a4 = (f32x4){0.f, 0.f, 0.f, 0.f};
        if (z ? (ja >= ia) : (ja <= ia)) a4 = mma_nt(QE + ia * 16 * 136, 136, KE + ja * 16 * 136, 136, 128, a4, fr, fq);
#pragma unroll
        for (int jj = 0; jj < 4; ++jj) { const int i = ia * 16 + fq * 4 + jj, j = ja * 16 + fr; const bool keep = z ? (j >= i) : (j <= i); ATT[i * 72 + j] = f2bf(keep ? a4[jj] : 0.f); } }
    __syncthreads();
    { bf16_t* ATTg = (bf16_t*)(ws + WS_ATT) + ((size_t)((z * 128 + c) * 4 + hd)) * 4096;
      const int i = tid >> 3, j8 = (tid & 7) * 8;
      *(u32x4*)(ATTg + i * 64 + j8) = *(const u32x4*)(ATT + i * 72 + j8); }
    __syncthreads();
}

__device__ void phase_gla_a(const Params& p, float* lds) {
    for (int it = blockIdx.x; it < 1024; it += gridDim.x) gla_a_item(p, it, lds);
}

struct GlaFrags { bf16x8 kdt[2]; u32x4 vts; u32x4 qes[2]; bf16x8 att[2]; f32x4 ebl; };

template <int NE>
__device__ __forceinline__ void gla_b_unit_t(const Params& p, int z, int b, int hd, int e0, int nch, int ch0, bool sample, float* ldsf) {
    const int tid = threadIdx.x, lane = tid & 63, w = __builtin_amdgcn_readfirstlane(tid >> 6), fr = lane & 15, fq = lane >> 4;
    unsigned char* ws = p.ws;
    float* OD = (float*)(ws + WS_P2);
    const bf16_t* QEg = (const bf16_t*)(ws + WS_QE); const bf16_t* KDTg = (const bf16_t*)(ws + WS_KDT); const bf16_t* VTg = (const bf16_t*)(ws + WS_VT); const float* EBLg = (const float*)(ws + WS_EBL);
    const bf16_t* ATTg = (const bf16_t*)(ws + WS_ATT);
    constexpr int NQ = NE / 2;
    bf16_t* ST = (bf16_t*)ldsf;
    bf16_t* VTL = ST + 2 * 64 * 136;
    bf16_t* QEL = VTL + 2 * 64 * 72;
    f32x4 Sacc[NE];
    if (sample) { const float* s0 = p.in[3] + ((size_t)((b * 2 + z) * 4 + hd)) * 32768 + e0 + fr;
#pragma unroll
        for (int et = 0; et < NE; ++et)
#pragma unroll
            for (int jj = 0; jj < 4; ++jj) Sacc[et][jj] = s0[(size_t)(w * 16 + fq * 4 + jj) * 256 + et * 16]; }
    else {
#pragma unroll
        for (int et = 0; et < NE; ++et) Sacc[et] = (f32x4){0.f, 0.f, 0.f, 0.f}; }
    const int it = w >> 1, e2 = (w & 1) * NQ;
    const int ve = tid >> 3, vt8 = (tid & 7) * 8;
#define GLB_LOAD(F, c_) do { const int cc_ = (c_); \
        _Pragma("unroll") for (int ks = 0; ks < 2; ++ks) { (F).kdt[ks] = *(const bf16x8*)(KDTg + ((size_t)(((z * 128 + cc_) * 4 + hd) * 128 + w * 16 + fr)) * 64 + ks * 32 + fq * 8); \
            (F).att[ks] = *(const bf16x8*)(ATTg + ((size_t)((z * 128 + cc_) * 4 + hd)) * 4096 + (it * 16 + fr) * 64 + ks * 32 + fq * 8); } \
        if (ve < NE * 16) (F).vts = *(const u32x4*)(VTg + ((size_t)((cc_ * 4 + hd) * 256 + e0 + ve)) * 64 + vt8); \
        _Pragma("unroll") for (int h_ = 0; h_ < 2; ++h_) (F).qes[h_] = *(const u32x4*)(QEg + ((size_t)z * NTOK + cc_ * 64 + ve) * 512 + hd * 128 + h_ * 64 + vt8); \
        (F).ebl = *(const f32x4*)(EBLg + (size_t)(z * 128 + cc_) * 512 + hd * 128 + w * 16 + fq * 4); } while (0)
#define GLB_STEP(CUR, NX2, ci_) do { const int ci = (ci_); if (ci < nch) { \
        const int c = ch0 + (z ? nch - 1 - ci : ci); \
        bf16_t* STc = ST + (ci & 1) * 64 * 136; bf16_t* VTc = VTL + (ci & 1) * 64 * 72; \
        _Pragma("unroll") for (int et = 0; et < NE; ++et) { u32x2 v2; v2.x = pk2(Sacc[et][0], Sacc[et][1]); v2.y = pk2(Sacc[et][2], Sacc[et][3]); \
            *(u32x2*)(STc + (et * 16 + fr) * 136 + w * 16 + fq * 4) = v2; } \
        if (ve < NE * 16) *(u32x4*)(VTc + ve * 72 + vt8) = (CUR).vts; \
        bf16_t* QEc = QEL + (ci & 1) * 64 * 136; \
        *(u32x4*)(QEc + ve * 136 + vt8) = (CUR).qes[0]; *(u32x4*)(QEc + ve * 136 + 64 + vt8) = (CUR).qes[1]; \
        if (ci + 2 < nch) GLB_LOAD(NX2, ch0 + (z ? nch - 3 - ci : ci + 2)); \
        lds_barrier(); \
        _Pragma("unroll") for (int et = 0; et < NE; ++et) { Sacc[et] = Sacc[et] * (CUR).ebl; \
            _Pragma("unroll") for (int ks = 0; ks < 2; ++ks) { const bf16x8 vf = *(const bf16x8*)(VTc + (et * 16 + fr) * 72 + ks * 32 + fq * 8); \
                Sacc[et] = __builtin_amdgcn_mfma_f32_16x16x32_bf16((CUR).kdt[ks], vf, Sacc[et], 0, 0, 0); } } \
        _Pragma("unroll") for (int q2 = 0; q2 < NQ; ++q2) { f32x4 o = (f32x4){0.f, 0.f, 0.f, 0.f}; \
            _Pragma("unroll") for (int ks = 0; ks < 2; ++ks) { const bf16x8 vf = *(const bf16x8*)(VTc + ((e2 + q2) * 16 + fr) * 72 + ks * 32 + fq * 8); \
                o = __builtin_amdgcn_mfma_f32_16x16x32_bf16((CUR).att[ks], vf, o, 0, 0, 0); } \
            _Pragma("unroll") for (int ks = 0; ks < 4; ++ks) { const bf16x8 bS = *(const bf16x8*)(STc + ((e2 + q2) * 16 + fr) * 136 + ks * 32 + fq * 8); \
                const bf16x8 aq = *(const bf16x8*)(QEc + (it * 16 + fr) * 136 + ks * 32 + fq * 8); \
                o = __builtin_amdgcn_mfma_f32_16x16x32_bf16(aq, bS, o, 0, 0, 0); } \
            _Pragma("unroll") for (int jj = 0; jj < 4; ++jj) OD[((size_t)z * NTOK + c * 64 + it * 16 + fq * 4 + jj) * 1024 + hd * 256 + e0 + (e2 + q2) * 16 + fr] = o[jj]; } } } while (0)
    GlaFrags fa, fb, fc; fa.vts = fb.vts = fc.vts = (u32x4){0u, 0u, 0u, 0u};
    GLB_LOAD(fa, ch0 + (z ? nch - 1 : 0));
    GLB_LOAD(fb, ch0 + (z ? nch - 2 : 1));
    __syncthreads();
#pragma unroll 1
    for (int ci3 = 0; ci3 < nch; ci3 += 3) { GLB_STEP(fa, fc, ci3); GLB_STEP(fb, fa, ci3 + 1); GLB_STEP(fc, fb, ci3 + 2); }
#undef GLB_STEP
#undef GLB_LOAD
    if (!sample) { float* so = p.out + (size_t)2 * NPTOK * D + 2097152 + ((size_t)((b * 2 + z) * 4 + hd)) * 32768 + e0 + fr;
#pragma unroll
        for (int et = 0; et < NE; ++et)
#pragma unroll
            for (int jj = 0; jj < 4; ++jj) so[(size_t)(w * 16 + fq * 4 + jj) * 256 + et * 16] = Sacc[et][jj]; }
    __syncthreads();
}

__device__ void gla_b_unit(const Params& p, int u, float* ldsf) {
    if (u < 128) gla_b_unit_t<2>(p, u >> 6, (u >> 5) & 1, (u >> 3) & 3, (u & 7) * 32, 32, 64 + ((u >> 5) & 1) * 32, true, ldsf);
    else { const int q = u - 128; gla_b_unit_t<4>(p, q >> 8, (q >> 4) & 15, (q >> 2) & 3, (q & 3) * 64, 4, ((q >> 4) & 15) * 4, false, ldsf); }
}

__device__ void phase_gla_b(const Params& p, float* lds, int rep) {
    unsigned* ctr = (unsigned*)(p.ws + WS_CTL) + 16 + rep * 32;
    int* slot = (int*)(lds + LDS_MAIN / 4);
    for (;;) {
        if (threadIdx.x == 0) *slot = (int)atomicAdd(ctr, 1u);
        __syncthreads();
        const int it = *slot;
        __syncthreads();
        if (it >= 640) break;
        gla_b_unit(p, it, lds);
    }
}

__device__ void phase_gla_post(const Params& p) {
    const int tid = threadIdx.x, wave = tid >> 6, lane = tid & 63;
    unsigned char* ws = p.ws;
    const bf16_t* P1 = (const bf16_t*)(ws + WS_P);
    const float* OD = (const float*)(ws + WS_P2);
    bf16_t* OG = (bf16_t*)(ws + WS_OC);
    for (int tok = blockIdx.x * 8 + wave; tok < NTOK; tok += gridDim.x * 8) {
        for (int hd = 0; hd < 4; ++hd) { const int idx = hd * 256 + lane * 4;
            const f32x4 a = *(const f32x4*)(OD + (size_t)tok * 1024 + idx), b2 = *(const f32x4*)(OD + ((size_t)NTOK + tok) * 1024 + idx);
            const f32x4 o = a + b2;
            const float ss = wave_sum(o[0] * o[0] + o[1] * o[1] + o[2] * o[2] + o[3] * o[3]);
            const float rs = rsqrtf(ss * (1.f / 256.f) + 1e-6f);
            const f32x4 gn = *(const f32x4*)(p.in[29] + lane * 4);
            const u32x2 zz = *(const u32x2*)(P1 + (size_t)tok * N1 + 2048 + idx);
            const float z0 = bflo(zz.x), z1 = bfhi(zz.x), z2 = bflo(zz.y), z3 = bfhi(zz.y);
            u32x2 w; w.x = pack2(o[0] * rs * gn[0] * silu(z0), o[1] * rs * gn[1] * silu(z1)); w.y = pack2(o[2] * rs * gn[2] * silu(z2), o[3] * rs * gn[3] * silu(z3));
            *(u32x2*)(OG + (size_t)tok * 1024 + idx) = w; }
    }
}

__device__ void phase_final(const Params& p) {
    const int tid = threadIdx.x, wave = tid >> 6, lane = tid & 63;
    unsigned char* ws = p.ws;
    const float* MOD = (const float*)(ws + WS_MOD);
    const float* X1 = (const float*)(ws + WS_X1);
    const float* Y = (const float*)(ws + WS_P2);
    for (int tok = blockIdx.x * 8 + wave; tok < NTOK; tok += gridDim.x * 8) {
        const int cond = tok < NPTOK ? 0 : 1 + ((tok - NPTOK) >> 11);
        f32x4 xv[4]; float ss = 0.f;
#pragma unroll
        for (int i = 0; i < 4; ++i) { const int idx = i * 256 + lane * 4;
            const f32x4 x1 = *(const f32x4*)(X1 + (size_t)tok * D + idx);
            const f32x4 ya = *(const f32x4*)(Y + (size_t)tok * D + idx), yb = *(const f32x4*)(Y + (size_t)NTOK * D + (size_t)tok * D + idx);
            const f32x4 gt = *(const f32x4*)(MOD + (1 * 3 + cond) * 3072 + 2048 + idx);
            xv[i] = x1 + gt * (ya + yb);
            ss += xv[i][0] * xv[i][0] + xv[i][1] * xv[i][1] + xv[i][2] * xv[i][2] + xv[i][3] * xv[i][3]; }
        ss = wave_sum(ss);
        const float rstd = rsqrtf(ss * (1.f / 1024.f) + 1e-6f);
#pragma unroll
        for (int i = 0; i < 4; ++i) { const int idx = i * 256 + lane * 4;
            const f32x4 g = *(const f32x4*)(p.in[9] + idx);
            f32x4 o;
#pragma unroll
            for (int j = 0; j < 4; ++j) o[j] = xv[i][j] * rstd * g[j];
            *(f32x4*)(p.out + (size_t)tok * D + idx) = o; }
    }
}


#define XB_TMO      128
#define XB_XCNT(j)  (256  + 64 * (j))
#define XB_XSUB(j)  (1280 + 64 * (j))
#define XB_XGEN(j)  (2304 + 64 * (j))
#define XB_TOP      3328
#define XB_TOPGEN   3392
#define XCD_BAR_WORDS 3456
#define XB_SPIN_CAP (1u << 18)

__device__ __forceinline__ unsigned xb_ld(unsigned* p)              { return __hip_atomic_load(p, __ATOMIC_RELAXED, __HIP_MEMORY_SCOPE_AGENT); }
__device__ __forceinline__ unsigned xb_add(unsigned* p, unsigned v) { return __hip_atomic_fetch_add(p, v, __ATOMIC_RELAXED, __HIP_MEMORY_SCOPE_AGENT); }
__device__ __forceinline__ unsigned xb_xcc_id() { return (unsigned)__builtin_amdgcn_s_getreg((3 << 11) | 20) & 0xFu; }
#define XB_SPIN(cond, bar) do { unsigned _sp = 0; while (cond) { __builtin_amdgcn_s_sleep(1); \
    if ((++_sp & 255u) == 0u) { if (xb_ld(&(bar)[XB_TMO])) break; if (_sp > XB_SPIN_CAP) { atomicAdd(&(bar)[XB_TMO], 1u); break; } } } } while (0)

struct XcdBarrier {
    unsigned* bar; unsigned x;
    volatile LAS unsigned* st;
};

__device__ __forceinline__ XcdBarrier xcd_barrier_post(unsigned* bar, volatile LAS unsigned* st) {
    XcdBarrier b; b.bar = bar; b.x = xb_xcc_id(); b.st = st;
    if (threadIdx.x == 0) (void)xb_add(&bar[XB_XCNT(b.x)], 1u);
    return b;
}
__device__ __forceinline__ void xcd_barrier_complete(unsigned* bar, unsigned x, unsigned& nloc, unsigned& nx) {
    const unsigned G = gridDim.x * gridDim.y * gridDim.z;
    unsigned sum, cnt, mine, sp = 0u;
    for (;;) {
        sum = 0u; cnt = 0u; mine = 0u;
#pragma unroll
        for (unsigned j = 0; j < 16; ++j) { const unsigned c = xb_ld(&bar[XB_XCNT(j)]); sum += c; cnt += (c > 0u) ? 1u : 0u; mine = (j == x) ? c : mine; }
        if (sum == G) break;
        __builtin_amdgcn_s_sleep(1);
        if ((++sp & 255u) == 0u) { if (xb_ld(&bar[XB_TMO])) break; if (sp > XB_SPIN_CAP) { atomicAdd(&bar[XB_TMO], 1u); break; } }
    }
    nloc = mine > 0u ? mine : 1u; nx = cnt > 0u ? cnt : 1u;
}

__device__ __forceinline__ void xcd_barrier(const XcdBarrier& b) {
    asm volatile("s_waitcnt vmcnt(0)" ::: "memory");
    __syncthreads();
    if (threadIdx.x == 0) {
        unsigned* bar = b.bar;
        __builtin_amdgcn_s_waitcnt(0);
        unsigned nloc = b.st[0], nx = b.st[1];
        if (nloc == 0u) { xcd_barrier_complete(bar, b.x, nloc, nx); b.st[0] = nloc; b.st[1] = nx; }
        const unsigned old = xb_add(&bar[XB_XSUB(b.x)], 1u);
        const unsigned gen = old / nloc;
        if (old + 1u == (gen + 1u) * nloc) {
            __builtin_amdgcn_fence(__ATOMIC_RELEASE, "agent");
            asm volatile("s_waitcnt vmcnt(0)" ::: "memory");
            const unsigned og = xb_add(&bar[XB_TOP], 1u);
            const unsigned tg = og / nx;
            if (og + 1u == (tg + 1u) * nx) xb_add(&bar[XB_TOPGEN], 1u);
            else XB_SPIN(xb_ld(&bar[XB_TOPGEN]) == tg, bar);
            __builtin_amdgcn_fence(__ATOMIC_ACQUIRE, "agent");
            xb_add(&bar[XB_XGEN(b.x)], 1u);
            asm volatile("s_waitcnt vmcnt(0)" ::: "memory");
        } else {
            XB_SPIN(xb_ld(&bar[XB_XGEN(b.x)]) == gen, bar);
            __builtin_amdgcn_fence(__ATOMIC_ACQUIRE, "agent");
            asm volatile("s_waitcnt vmcnt(0)" ::: "memory");
        }
    }
    __syncthreads();
}


constexpr int NPHASE = 14;
__global__ void __launch_bounds__(NTHR, 2) fwd_megakernel(Params p) {
    extern __shared__ __attribute__((aligned(16))) unsigned char smem[];
    float* ldsf = (float*)smem;
    LAS unsigned char* ldsl = (LAS unsigned char*)smem;
    unsigned char* ws = p.ws;
    volatile LAS unsigned* xst = (volatile LAS unsigned*)(ldsl + LDS_MAIN + 16);
    if (threadIdx.x == 0) { xst[0] = 0u; xst[1] = 0u; }
    __syncthreads();
    const XcdBarrier xbar = xcd_barrier_post((unsigned*)(ws + WS_BAR), xst);
    if (p.ph_lo < 0) cg::this_grid().sync();
#ifndef DUP_PHASE
#define DUP_PHASE -1
#endif
#define PHASE(n) if (p.ph_lo <= (n) && (n) < p.ph_hi && ((n) == p.ph_lo || (xcd_barrier(xbar), true))) for (int rep = 0; rep < ((n) == DUP_PHASE ? 2 : 1); ++rep, ((n) == DUP_PHASE ? (xcd_barrier(xbar), 0) : 0))
    PHASE(0) phase_prologue(p, ldsf);
    PHASE(1) phase_h(p, 0, ldsf);
    PHASE(2) { pg8::Gemm g{(const bf16_t*)(ws + WS_H), (const bf16_t*)(ws + WS_BT0), NTOK, 8192, 1024, 1024, 1}; pg8::Order S; S.init(NTOK, 8192, 1, gridDim.x, blockIdx.x);
               pg8::EpiBf16 E{(bf16_t*)(ws + WS_P), N0}; pg8::gemm_phase(ldsl, g, S, E); }
    PHASE(3) phase_mix0(p, ldsf, rep);
    PHASE(4) { phase_wkv_fix(p, ldsf); phase_late_weights(p, ldsf); }
    PHASE(5) phase_wkv_post(p);
    PHASE(6) { pg8::Gemm g{(const bf16_t*)(ws + WS_OC), (const bf16_t*)(ws + WS_WT0O), NTOK, 1024, 1024, 2048, 2}; pg8::Order S; S.init(NTOK, 1024, 2, gridDim.x, blockIdx.x);
               pg8::EpiF32 E{(float*)(ws + WS_P), 1024, (size_t)NTOK * 1024}; pg8::gemm_phase(ldsl, g, S, E); }
    PHASE(7) phase_h(p, 1, ldsf);
    PHASE(8) { pg8::Gemm g{(const bf16_t*)(ws + WS_H), (const bf16_t*)(ws + WS_BT1), NTOK, N1, 1024, 1024, 1}; pg8::Order S; S.init(NTOK, N1, 1, gridDim.x, blockIdx.x);
               pg8::EpiBf16 E{(bf16_t*)(ws + WS_P), N1}; pg8::gemm_phase(ldsl, g, S, E); }
    PHASE(9) phase_gla_a(p, ldsf);
    PHASE(10) phase_gla_b(p, ldsf, rep);
    PHASE(11) phase_gla_post(p);
    PHASE(12) { pg8::Gemm g{(const bf16_t*)(ws + WS_OC), (const bf16_t*)(ws + WS_WT1O), NTOK, 1024, 512, 1024, 2}; pg8::Order S; S.init(NTOK, 1024, 2, gridDim.x, blockIdx.x);
                pg8::EpiF32 E{(float*)(ws + WS_P2), 1024, (size_t)NTOK * 1024}; pg8::gemm_phase(ldsl, g, S, E); }
    PHASE(13) phase_final(p);
}

extern "C" void kernel_launch(void* const* d_in, const int* in_sizes, int n_in, void* d_out, int out_size, void* d_ws, size_t ws_size, hipStream_t stream) {
    static int grid = 0;
    if (grid == 0) {
        if (n_in != 30 || ws_size < WS_END) { fprintf(stderr, "kernel_launch: unexpected n_in %d / ws_size %zu (need %zu)\n", n_in, ws_size, (size_t)WS_END); grid = -1; return; }
        int dev = 0, cus = 0, per_cu = 0;
        hipGetDevice(&dev);
        hipDeviceGetAttribute(&cus, hipDeviceAttributeMultiprocessorCount, dev);
        hipFuncSetAttribute((const void*)fwd_megakernel, hipFuncAttributeMaxDynamicSharedMemorySize, LDS_BYTES);
        hipOccupancyMaxActiveBlocksPerMultiprocessor(&per_cu, (const void*)fwd_megakernel, NTHR, LDS_BYTES);
        if (per_cu < 1) { fprintf(stderr, "kernel_launch: occupancy query returned %d\n", per_cu); per_cu = 1; }
        grid = cus * per_cu;
        (void)hipGetLastError();
    }
    if (grid < 0) return;
    static_assert(XCD_BAR_WORDS * 4 <= 14336, "barrier words overlap the queue counters");
    hipMemsetAsync((char*)d_ws + WS_BAR, 0, 14336 + 256, stream);
    Params p{};
    for (int i = 0; i < 30; ++i) p.in[i] = (const float*)d_in[i];
    p.out = (float*)d_out; p.ws = (unsigned char*)d_ws;
#if MULTI_LAUNCH
    for (int ph = 0; ph < NPHASE; ++ph) { p.ph_lo = ph; p.ph_hi = ph + 1; hipLaunchKernelGGL(fwd_megakernel, dim3(grid), dim3(NTHR), LDS_BYTES, stream, p); }
#else
    p.ph_lo = 0; p.ph_hi = NPHASE;
    void* args[] = {&p};
    hipError_t e = hipLaunchCooperativeKernel((const void*)fwd_megakernel, dim3(grid), dim3(NTHR), args, LDS_BYTES, stream);
    if (e != hipSuccess) fprintf(stderr, "cooperative launch failed: %s (grid %d)\n", hipGetErrorString(e), grid);
#endif
}
```

```cpp
#include <hip/hip_runtime.h>
#include <hip/hip_cooperative_groups.h>
#include <cstdio>
namespace cg = cooperative_groups;

#define LAS __attribute__((address_space(3)))
typedef unsigned short bf16_t;
typedef short bf16x8 __attribute__((ext_vector_type(8)));
typedef float f32x4 __attribute__((ext_vector_type(4)));
typedef unsigned u32x4 __attribute__((ext_vector_type(4)));
typedef unsigned u32x2 __attribute__((ext_vector_type(2)));

#ifndef MULTI_LAUNCH
#define MULTI_LAUNCH 0
#endif

constexpr int D = 1024, NTOK = 8192, NPTOK = 4096;
constexpr int N0 = 8448;
constexpr int N1 = 3328;
constexpr int NTHR = 512;
constexpr int LDS_MAIN = 139264;
constexpr int LDS_BYTES = LDS_MAIN + 256;

constexpr size_t MB = 1024 * 1024;
constexpr size_t WS_CTL = 0x1A0000 + 14336;
constexpr size_t WS_MOD = 4096;
constexpr size_t WS_BON = WS_MOD + 2 * 3 * 3072 * 4;
constexpr size_t WS_BAR = 0x1A0000;
constexpr size_t WS_BT0 = 2 * MB;
constexpr size_t WS_WT0O = WS_BT0 + (size_t)N0 * 1024 * 2;
constexpr size_t WS_BT1 = WS_WT0O + (size_t)1024 * 2048 * 2;
constexpr size_t WS_WT1O = WS_BT1 + (size_t)N1 * 1024 * 2;
constexpr size_t WS_H = WS_WT1O + (size_t)1024 * 1024 * 2;
constexpr size_t WS_OC = WS_H + (size_t)NTOK * 1024 * 2;
constexpr size_t WS_X1 = WS_OC + (size_t)NTOK * 2048 * 2;
constexpr size_t WS_P = WS_X1 + (size_t)NTOK * 1024 * 4;
constexpr size_t WS_P2 = WS_P + 64 * MB;
constexpr size_t WS_END = WS_P + (size_t)NTOK * N0 * 2;

struct Params {
    const float* in[30];
    float* out;
    unsigned char* ws;
    int ph_lo, ph_hi;
};

__device__ __forceinline__ float bf2f(bf16_t h) { return __uint_as_float(((unsigned)h) << 16); }
__device__ __forceinline__ bf16_t f2bf(float f) { unsigned u = __float_as_uint(f); u += 0x7FFFu + ((u >> 16) & 1u); return (bf16_t)(u >> 16); }
__device__ __forceinline__ unsigned pack2(float lo, float hi) { return (unsigned)f2bf(lo) | ((unsigned)f2bf(hi) << 16); }
__device__ __forceinline__ float bflo(unsigned w) { return __uint_as_float(w << 16); }
__device__ __forceinline__ float bfhi(unsigned w) { return __uint_as_float(w & 0xFFFF0000u); }
__device__ __forceinline__ float fexp(float x) { return __builtin_amdgcn_exp2f(x * 1.44269504f); }
__device__ __forceinline__ float flog(float x) { return __builtin_amdgcn_logf(x) * 0.69314718f; }
__device__ __forceinline__ float silu(float x) { return x * __builtin_amdgcn_rcpf(1.f + fexp(-x)); }
__device__ __forceinline__ float wave_sum(float v) {
#pragma unroll
    for (int m = 32; m >= 1; m >>= 1) v += __shfl_xor(v, m, 64);
    return v;
}

typedef float f32x2_t __attribute__((ext_vector_type(2)));
typedef __bf16 bf16x2_t __attribute__((ext_vector_type(2)));
__device__ __forceinline__ unsigned pk2(float lo, float hi) { const f32x2_t v = {lo, hi}; return __builtin_bit_cast(unsigned, __builtin_convertvector(v, bf16x2_t)); }
__device__ __forceinline__ bf16_t f2bf_hw(float f) { return __builtin_bit_cast(bf16_t, (__bf16)f); }

__device__ __forceinline__ void lds_barrier() { asm volatile("s_waitcnt lgkmcnt(0)" ::: "memory"); __builtin_amdgcn_s_barrier(); asm volatile("" ::: "memory"); }

namespace pg8 {
constexpr int BM = 256, BK = 64, HALF = 128, HTB = HALF * BK * 2, NXCD = 8, WGM = 8;
__device__ __forceinline__ int lds_byte(int r, int c) { const int st = (r >> 4) * 2 + (c >> 5), rr = r & 15, cc = c & 31, ob = rr * 64 + cc * 2; return st * 1024 + (ob ^ (((ob >> 9) & 1) << 5)); }
__device__ __forceinline__ void stage_rc(int b, int& R, int& C) { const int st = b / 1024, sb = b % 1024, swz = sb ^ (((sb >> 9) & 1) << 5); R = (st >> 1) * 16 + swz / 64; C = (st & 1) * 32 + (swz % 64) / 2; }
__device__ __forceinline__ int perm32(int rho) { const int n = rho >> 4, i = rho & 15; return 8 * (i >> 2) + 4 * n + (i & 3); }

struct Unit { int pm, pn, ks; };
struct Gemm { const bf16_t* A; const bf16_t* Bt; int M, N, K, ld, KS; };

struct Order {
    int nM, nN, nNr, nwg, G, c;
    __device__ void init(int M, int N, int KS, int G_, int c_) { nM = M / BM; nNr = N / BM; nN = nNr * KS; nwg = nM * nN; G = G_; c = c_; }
    __device__ bool next(int i, Unit& u) const {
        const long L = (long)i * G + c; if (L >= nwg) return false;
        int wgid = (int)L; { const int q = nwg / NXCD, r = nwg % NXCD, xcd = wgid % NXCD, off = wgid / NXCD; wgid = (xcd < r ? xcd * (q + 1) : r * (q + 1) + (xcd - r) * q) + off; }
        const int nig = WGM * nN, gid = wgid / nig, fm = gid * WGM, gsz = (nM - fm) < WGM ? (nM - fm) : WGM;
        u.pm = fm + ((wgid % nig) % gsz); const int pn = (wgid % nig) / gsz; u.pn = pn % nNr; u.ks = pn / nNr; return true;
    }
};

__device__ __forceinline__ unsigned cvt_pk_bf16(float lo, float hi) { unsigned r; asm volatile("v_cvt_pk_bf16_f32 %0, %1, %2" : "=v"(r) : "v"(lo), "v"(hi)); return r; }

struct EpiF32 {
    static constexpr bool PERM = false;
    float* C; int ldc; size_t ks_stride;
    __device__ __forceinline__ void operator()(const f32x4 (&acc)[2][2][4][2], const Unit& u, int wr, int wc, int fr, int fq) const {
        const int row0 = u.pm * BM + wr * 64 + fr, col0 = u.pn * BM + wc * 32 + 4 * fq;
        float* Cb = C + (size_t)u.ks * ks_stride;
#pragma unroll
        for (int ai = 0; ai < 2; ++ai)
#pragma unroll
            for (int m = 0; m < 4; ++m) { float* rowp = Cb + (size_t)(row0 + ai * HALF + m * 16) * ldc + col0;
#pragma unroll
                for (int bj = 0; bj < 2; ++bj)
#pragma unroll
                    for (int n = 0; n < 2; ++n) *(f32x4*)(rowp + bj * HALF + n * 16) = acc[ai][bj][m][n]; }
    }
};
struct EpiBf16 {
    static constexpr bool PERM = true;
    bf16_t* O; int ldc; size_t ks_stride;
    __device__ __forceinline__ void operator()(const f32x4 (&acc)[2][2][4][2], const Unit& u, int wr, int wc, int fr, int fq) const {
        const int row0 = u.pm * BM + wr * 64 + fr; const int col0 = u.pn * BM + wc * 32 + 8 * fq;
        bf16_t* Ob = O + (size_t)u.ks * ks_stride;
#pragma unroll
        for (int ai = 0; ai < 2; ++ai)
#pragma unroll
            for (int m = 0; m < 4; ++m) { bf16_t* rowp = Ob + (size_t)(row0 + ai * HALF + m * 16) * ldc + col0;
#pragma unroll
                for (int bj = 0; bj < 2; ++bj) { const f32x4 v0 = acc[ai][bj][m][0], v1 = acc[ai][bj][m][1];
                    u32x4 w; w.x = cvt_pk_bf16(v0[0], v0[1]); w.y = cvt_pk_bf16(v0[2], v0[3]); w.z = cvt_pk_bf16(v1[0], v1[1]); w.w = cvt_pk_bf16(v1[2], v1[3]);
                    *(u32x4*)(rowp + bj * HALF) = w; } }
    }
};

template <class Epi>
__device__ __forceinline__ void gemm_phase(LAS unsigned char* lds, const Gemm g, const Order& S, const Epi& E) {
    const int tid = threadIdx.x, wid = __builtin_amdgcn_readfirstlane(tid >> 6), lane = tid & 63, wr = wid >> 2, wc = wid & 3, fr = lane & 15, fq = lane >> 4;
    const int K = g.K, nt = K / BK, ld = g.ld;
    unsigned voffA[2], voffB[2];
#pragma unroll
    for (int i = 0; i < 2; ++i) { int R, C; stage_rc(tid * 16 + i * 8192, R, C); const int Rb = Epi::PERM ? ((R & ~31) + perm32(R & 31)) : R;
        voffA[i] = (unsigned)(R * ld + C) * 2u; voffB[i] = (unsigned)(Rb * ld + C) * 2u; }
    const size_t kstep = (size_t)(BK * 2);
    const size_t hstep = (size_t)HALF * ld * 2;
    const size_t tstep = 2 * hstep;
    const size_t ksb = (size_t)K * 2;
    const unsigned ldsw = (unsigned)wid * 1024u;
    const int aoff = lds_byte(wr * 64 + fr, fq * 8), boff = lds_byte(wc * 32 + fr, fq * 8);
#define PG8_SA(b, h) (((b) * 2 + (h)) * HTB)
#define PG8_SB(b, h) ((4 + (b) * 2 + (h)) * HTB)
#define PG8_STAGE(bufoff, gbase, voff) do { _Pragma("unroll") for (int _i = 0; _i < 2; ++_i) \
        __builtin_amdgcn_global_load_lds((const unsigned*)((const char*)(gbase) + (voff)[_i]), (LAS unsigned*)(lds + (bufoff) + ldsw + _i * 8192), 16, 0, 0); } while (0)
#define PG8_LDA(dst, b, h) do { _Pragma("unroll") for (int m = 0; m < 4; ++m) _Pragma("unroll") for (int k = 0; k < 2; ++k) dst[m][k] = *(const LAS bf16x8*)(lds + PG8_SA(b, h) + aoff + m * 2048 + k * 1024); } while (0)
#define PG8_LDB(dst, b, h) do { _Pragma("unroll") for (int n = 0; n < 2; ++n) _Pragma("unroll") for (int k = 0; k < 2; ++k) dst[n][k] = *(const LAS bf16x8*)(lds + PG8_SB(b, h) + boff + n * 2048 + k * 1024); } while (0)
#define PG8_MMA(ai, bj, At, Bt) do { __builtin_amdgcn_s_setprio(1); _Pragma("unroll") for (int m = 0; m < 4; ++m) _Pragma("unroll") for (int n = 0; n < 2; ++n) _Pragma("unroll") for (int k = 0; k < 2; ++k) \
        acc[ai][bj][m][n] = __builtin_amdgcn_mfma_f32_16x16x32_bf16(Bt[n][k], At[m][k], acc[ai][bj][m][n], 0, 0, 0); __builtin_amdgcn_s_setprio(0); } while (0)
#define PG8_WAIT_V(n) asm volatile("s_waitcnt vmcnt(" #n ")" ::: "memory")
#define PG8_WAIT_L(n) asm volatile("s_waitcnt lgkmcnt(" #n ")" ::: "memory")
#define PG8_BAR __builtin_amdgcn_s_barrier()
#define PG8_SCHED __builtin_amdgcn_sched_barrier(0)
    Unit cur, nxt; int ui = 0;
    if (!S.next(0, cur)) return;
    f32x4 acc[2][2][4][2];
#pragma unroll
    for (int a = 0; a < 2; ++a)
#pragma unroll
        for (int b = 0; b < 2; ++b)
#pragma unroll
            for (int m = 0; m < 4; ++m)
#pragma unroll
                for (int n = 0; n < 2; ++n) acc[a][b][m][n] = (f32x4){0.f, 0.f, 0.f, 0.f};
    bf16x8 At[4][2], B0[2][2], B1[2][2];
    const char* cA = (const char*)g.A + (size_t)cur.pm * tstep + (size_t)cur.ks * ksb; const char* cB = (const char*)g.Bt + (size_t)cur.pn * tstep + (size_t)cur.ks * ksb;
    PG8_STAGE(PG8_SB(0, 0), cB, voffB); PG8_STAGE(PG8_SA(0, 0), cA, voffA); PG8_STAGE(PG8_SB(0, 1), cB + hstep, voffB); PG8_STAGE(PG8_SA(0, 1), cA + hstep, voffA);
    if (wr == 1) PG8_BAR;
    PG8_WAIT_V(4); PG8_BAR;
    PG8_STAGE(PG8_SB(1, 0), cB + kstep, voffB); PG8_STAGE(PG8_SA(1, 0), cA + kstep, voffA); PG8_STAGE(PG8_SB(1, 1), cB + hstep + kstep, voffB);
    PG8_WAIT_V(6); PG8_BAR;
    for (;;) {
        const bool has_next = S.next(ui + 1, nxt);
        const char* nA = has_next ? (const char*)g.A + (size_t)nxt.pm * tstep + (size_t)nxt.ks * ksb : cA; const char* nB = has_next ? (const char*)g.Bt + (size_t)nxt.pn * tstep + (size_t)nxt.ks * ksb : cB;
        for (int t = 0; t < nt; t += 2) {
            const bool last = (t == nt - 2);
            const char* a1 = cA + (size_t)(t + 1) * kstep;
            const char* a2 = last ? nA : cA + (size_t)(t + 2) * kstep; const char* b2 = last ? nB : cB + (size_t)(t + 2) * kstep;
            const char* a3 = a2 + kstep; const char* b3 = b2 + kstep;
            PG8_LDB(B0, 0, 0); PG8_SCHED; PG8_LDA(At, 0, 0); PG8_STAGE(PG8_SA(1, 1), a1 + hstep, voffA);
            PG8_WAIT_L(8); PG8_BAR; PG8_WAIT_L(0); PG8_MMA(0, 0, At, B0); PG8_BAR; PG8_SCHED;
            PG8_LDB(B1, 0, 1); PG8_STAGE(PG8_SB(0, 0), b2, voffB);
            PG8_BAR; PG8_WAIT_L(0); PG8_MMA(0, 1, At, B1); PG8_BAR;
            PG8_LDA(At, 0, 1); PG8_STAGE(PG8_SA(0, 0), a2, voffA);
            PG8_BAR; PG8_WAIT_L(0); PG8_MMA(1, 0, At, B0); PG8_BAR; PG8_SCHED;
            PG8_STAGE(PG8_SB(0, 1), b2 + hstep, voffB);
            PG8_WAIT_V(6); PG8_BAR; PG8_MMA(1, 1, At, B1); PG8_BAR;
            PG8_LDB(B0, 1, 0); PG8_SCHED; PG8_LDA(At, 1, 0); PG8_STAGE(PG8_SA(0, 1), a2 + hstep, voffA);
            PG8_WAIT_L(8); PG8_BAR; PG8_WAIT_L(0); PG8_MMA(0, 0, At, B0); PG8_BAR; PG8_SCHED;
            PG8_LDB(B1, 1, 1); PG8_STAGE(PG8_SB(1, 0), b3, voffB);
            PG8_BAR; PG8_WAIT_L(0); PG8_MMA(0, 1, At, B1); PG8_BAR;
            PG8_LDA(At, 1, 1); PG8_STAGE(PG8_SA(1, 0), a3, voffA);
            PG8_BAR; PG8_WAIT_L(0); PG8_MMA(1, 0, At, B0); PG8_BAR; PG8_SCHED;
            PG8_STAGE(PG8_SB(1, 1), b3 + hstep, voffB);
            PG8_WAIT_V(6); PG8_BAR; PG8_MMA(1, 1, At, B1); PG8_BAR;
        }
        E(acc, cur, wr, wc, fr, fq);
        if (!has_next) break;
#pragma unroll
        for (int a = 0; a < 2; ++a)
#pragma unroll
            for (int b = 0; b < 2; ++b)
#pragma unroll
                for (int m = 0; m < 4; ++m)
#pragma unroll
                    for (int n = 0; n < 2; ++n) acc[a][b][m][n] = (f32x4){0.f, 0.f, 0.f, 0.f};
        cur = nxt; cA = nA; cB = nB; ++ui;
    }
    PG8_WAIT_V(0);
    if (wr == 0) PG8_BAR;
    PG8_BAR;
#undef PG8_SA
#undef PG8_SB
#undef PG8_STAGE
#undef PG8_LDA
#undef PG8_LDB
#undef PG8_MMA
#undef PG8_WAIT_V
#undef PG8_WAIT_L
#undef PG8_BAR
#undef PG8_SCHED
}
}

struct TJob { const float* src; bf16_t* dst; int ldsrc, N, lddst, drow0, k0, n0; };
__device__ __forceinline__ TJob tjob_of(const Params& p, int t) {
    unsigned char* ws = p.ws;
    bf16_t* BT0 = (bf16_t*)(ws + WS_BT0); bf16_t* WT0O = (bf16_t*)(ws + WS_WT0O); bf16_t* BT1 = (bf16_t*)(ws + WS_BT1); bf16_t* WT1O = (bf16_t*)(ws + WS_WT1O);
    TJob j; int nnt;
    if (t < 1024) { j.src = p.in[10]; j.ldsrc = 8192; j.N = 8192; j.dst = BT0; j.lddst = 1024; j.drow0 = 0; nnt = 64; }
    else if (t < 1024 + 32) { t -= 1024; const int z = t >> 4; t &= 15; j.src = p.in[14] + (size_t)z * 1024 * 64; j.ldsrc = 64; j.N = 64; j.dst = BT0; j.lddst = 1024; j.drow0 = 8192 + z * 64; nnt = 1; }
    else if (t < 1024 + 64) { t -= 1024 + 32; const int z = t >> 4; t &= 15; j.src = p.in[17] + (size_t)z * 1024 * 64; j.ldsrc = 64; j.N = 64; j.dst = BT0; j.lddst = 1024; j.drow0 = 8320 + z * 64; nnt = 1; }
    else if (t < 1088 + 256) { t -= 1088; j.src = p.in[11]; j.ldsrc = 1024; j.N = 1024; j.dst = WT0O; j.lddst = 2048; j.drow0 = 0; nnt = 8; }
    else if (t < 1344 + 384) { t -= 1344; j.src = p.in[24]; j.ldsrc = 3072; j.N = 3072; j.dst = BT1; j.lddst = 1024; j.drow0 = 0; nnt = 24; }
    else if (t < 1728 + 32) { t -= 1728; const int z = t >> 4; t &= 15; j.src = p.in[26] + (size_t)z * 1024 * 16; j.ldsrc = 16; j.N = 16; j.dst = BT1; j.lddst = 1024; j.drow0 = 3072 + z * 16; nnt = 1; }
    else { t -= 1760; j.src = p.in[25]; j.ldsrc = 1024; j.N = 1024; j.dst = WT1O; j.lddst = 1024; j.drow0 = 0; nnt = 8; }
    j.k0 = (t / nnt) * 64; j.n0 = (t % nnt) * 128; return j;
}
__device__ __forceinline__ void tjob_load(const TJob& j, f32x4 (&r)[4]) {
    const int tid = threadIdx.x, c4 = (tid & 31) * 4;
#pragma unroll
    for (int i = 0; i < 4; ++i) { const int kk = (tid >> 5) + 16 * i;
        r[i] = (j.n0 + c4 < j.N) ? *(const f32x4*)(j.src + (size_t)(j.k0 + kk) * j.ldsrc + j.n0 + c4) : (f32x4){0.f, 0.f, 0.f, 0.f}; }
}

__device__ void transpose_jobs(const Params& p, float* lds, int t_lo, int t_hi, int rot) {
    const int tid = threadIdx.x;
    float* tile = lds;
    int it = t_lo + (int)((blockIdx.x + (unsigned)rot) % gridDim.x);
    f32x4 cur[4], nxt[4];
    TJob jc = tjob_of(p, it < t_hi ? it : t_lo);
    if (it < t_hi) tjob_load(jc, cur);
    for (; it < t_hi; it += gridDim.x) {
        const int c4 = (tid & 31) * 4;
#pragma unroll
        for (int i = 0; i < 4; ++i) { const int kk = (tid >> 5) + 16 * i; tile[kk * 129 + c4] = cur[i][0]; tile[kk * 129 + c4 + 1] = cur[i][1]; tile[kk * 129 + c4 + 2] = cur[i][2]; tile[kk * 129 + c4 + 3] = cur[i][3]; }
        const int itn = it + gridDim.x;
        const TJob jn = tjob_of(p, itn < t_hi ? itn : t_lo);
        if (itn < t_hi) tjob_load(jn, nxt);
        __syncthreads();
#pragma unroll
        for (int q = 0; q < 2; ++q) { const int idx = tid + q * NTHR; const int nn = idx >> 3, k8 = (idx & 7) * 8;
            if (jc.n0 + nn < jc.N) { u32x4 o; o.x = pk2(tile[(k8 + 0) * 129 + nn], tile[(k8 + 1) * 129 + nn]); o.y = pk2(tile[(k8 + 2) * 129 + nn], tile[(k8 + 3) * 129 + nn]);
                o.z = pk2(tile[(k8 + 4) * 129 + nn], tile[(k8 + 5) * 129 + nn]); o.w = pk2(tile[(k8 + 6) * 129 + nn], tile[(k8 + 7) * 129 + nn]);
                *(u32x4*)(jc.dst + (size_t)(jc.drow0 + jc.n0 + nn) * jc.lddst + jc.k0 + k8) = o; } }
        __syncthreads();
        jc = jn;
#pragma unroll
        for (int i = 0; i < 4; ++i) cur[i] = nxt[i];
    }
}

__device__ void phase_prologue(const Params& p, float* lds) {
    const int tid = threadIdx.x;
    unsigned char* ws = p.ws;
    bf16_t* BT1 = (bf16_t*)(ws + WS_BT1);
    float* MOD = (float*)(ws + WS_MOD);
    constexpr int NGEMV = 192;
    for (int it = blockIdx.x; it < NGEMV; it += gridDim.x) {
        const int l = it / 96, j0 = (it % 96) * 32;
        float* sc = lds;
        float* red = lds + 3072;
        for (int i = tid; i < 3072; i += NTHR) { const int cnd = i >> 10, k = i & 1023; const float v = cnd == 0 ? p.in[5][k] : p.in[4][(cnd - 1) * 1024 + k]; sc[i] = silu(v); }
        __syncthreads();
        const int col = tid & 31, ksp = tid >> 5;
        float a0 = 0.f, a1 = 0.f, a2 = 0.f;
        const float* w = p.in[7] + (size_t)l * 1024 * 3072 + j0 + col;
#pragma unroll 16
        for (int k = ksp * 64; k < ksp * 64 + 64; ++k) { const float wv = w[(size_t)k * 3072]; a0 += sc[k] * wv; a1 += sc[1024 + k] * wv; a2 += sc[2048 + k] * wv; }
        red[(ksp * 3 + 0) * 32 + col] = a0; red[(ksp * 3 + 1) * 32 + col] = a1; red[(ksp * 3 + 2) * 32 + col] = a2;
        __syncthreads();
        if (tid < 96) { const int cnd = tid >> 5, cc = tid & 31; float s = 0.f; for (int q = 0; q < 16; ++q) s += red[(q * 3 + cnd) * 32 + cc];
            MOD[(l * 3 + cnd) * 3072 + j0 + cc] = s + p.in[8][l * 3072 + j0 + cc]; }
        __syncthreads();
    }
    transpose_jobs(p, lds, 0, 1088, 64);
}
__device__ void phase_late_weights(const Params& p, float* lds) {
    const int tid = threadIdx.x;
    bf16_t* BT1 = (bf16_t*)(p.ws + WS_BT1);
    transpose_jobs(p, lds, 1088, 1888, 0);
    { u32x4* z = (u32x4*)(BT1 + (size_t)3104 * 1024); const int n = 224 * 1024 * 2 / 16;
      for (int i = blockIdx.x * NTHR + tid; i < n; i += gridDim.x * NTHR) z[i] = (u32x4){0u, 0u, 0u, 0u}; }
}

__device__ void phase_h(const Params& p, int layer, float* ldsf) {
    const int tid = threadIdx.x, wave = __builtin_amdgcn_readfirstlane(tid >> 6), lane = tid & 63, fr = lane & 15, fq = lane >> 4;
    unsigned char* ws = p.ws;
    const float* MOD = (const float*)(ws + WS_MOD);
    bf16_t* H = (bf16_t*)(ws + WS_H);
    float* X1 = (float*)(ws + WS_X1);
    const bf16_t* Y = (const bf16_t*)(ws + WS_P);
    bf16_t* HL = (bf16_t*)ldsf;
    for (int tb = blockIdx.x * 32; tb < NTOK; tb += gridDim.x * 32) {
#pragma unroll 1
        for (int q = 0; q < 4; ++q) { const int tl = wave * 4 + q, tok = tb + tl;
            const float* xr = tok < NPTOK ? p.in[0] + (size_t)tok * D : p.in[1] + (size_t)(tok - NPTOK) * D;
            const int cond = tok < NPTOK ? 0 : 1 + ((tok - NPTOK) >> 11);
            f32x4 xv[4]; float ss = 0.f;
#pragma unroll
            for (int i = 0; i < 4; ++i) { const int idx = i * 256 + lane * 4; xv[i] = *(const f32x4*)(xr + idx);
                if (layer == 1) { const u32x2 pa = *(const u32x2*)(Y + (size_t)tok * D + idx), pb = *(const u32x2*)(Y + (size_t)NTOK * D + (size_t)tok * D + idx);
                    const f32x4 ya = (f32x4){bflo(pa.x), bfhi(pa.x), bflo(pa.y), bfhi(pa.y)}, yb = (f32x4){bflo(pb.x), bfhi(pb.x), bflo(pb.y), bfhi(pb.y)};
                    const f32x4 gt = *(const f32x4*)(MOD + (0 * 3 + cond) * 3072 + 2048 + idx);
                    xv[i] = xv[i] + gt * (ya + yb); *(f32x4*)(X1 + (size_t)tok * D + idx) = xv[i]; }
                ss += xv[i][0] * xv[i][0] + xv[i][1] * xv[i][1] + xv[i][2] * xv[i][2] + xv[i][3] * xv[i][3]; }
            ss = wave_sum(ss);
            const float rstd = rsqrtf(ss * (1.f / 1024.f) + 1e-6f);
#pragma unroll
            for (int i = 0; i < 4; ++i) { const int idx = i * 256 + lane * 4;
                const f32x4 g = *(const f32x4*)(p.in[6] + layer * D + idx);
                const f32x4 sh = *(const f32x4*)(MOD + (layer * 3 + cond) * 3072 + idx), sc = *(const f32x4*)(MOD + (layer * 3 + cond) * 3072 + 1024 + idx);
                f32x4 h;
#pragma unroll
                for (int j = 0; j < 4; ++j) h[j] = xv[i][j] * rstd * g[j] * (1.f + sc[j]) + sh[j];
                u32x2 w2; w2.x = pk2(h[0], h[1]); w2.y = pk2(h[2], h[3]);
                *(u32x2*)(H + (size_t)tok * D + idx) = w2;
                if (layer == 0) *(u32x2*)(HL + tl * 1032 + idx) = w2; } }
        if (layer == 0) {
            __syncthreads();
            const bf16_t* BL = (const bf16_t*)(ws + WS_BT0) + (size_t)8192 * 1024;
            bf16_t* P = (bf16_t*)(ws + WS_P);
            f32x4 acc[2][2];
#pragma unroll
            for (int mt = 0; mt < 2; ++mt)
#pragma unroll
                for (int n2 = 0; n2 < 2; ++n2) acc[mt][n2] = (f32x4){0.f, 0.f, 0.f, 0.f};
#pragma unroll 16
            for (int ks = 0; ks < 32; ++ks) {
                bf16x8 af[2], bfr[2];
#pragma unroll
                for (int mt = 0; mt < 2; ++mt) af[mt] = *(const bf16x8*)(HL + (mt * 16 + fr) * 1032 + ks * 32 + fq * 8);
#pragma unroll
                for (int n2 = 0; n2 < 2; ++n2) bfr[n2] = *(const bf16x8*)(BL + (size_t)((wave * 2 + n2) * 16 + fr) * 1024 + ks * 32 + fq * 8);
#pragma unroll
                for (int mt = 0; mt < 2; ++mt)
#pragma unroll
                    for (int n2 = 0; n2 < 2; ++n2) acc[mt][n2] = __builtin_amdgcn_mfma_f32_16x16x32_bf16(af[mt], bfr[n2], acc[mt][n2], 0, 0, 0);
            }
#pragma unroll
            for (int mt = 0; mt < 2; ++mt)
#pragma unroll
                for (int n2 = 0; n2 < 2; ++n2)
#pragma unroll
                    for (int jj = 0; jj < 4; ++jj) P[(size_t)(tb + mt * 16 + fq * 4 + jj) * N0 + 8192 + (wave * 2 + n2) * 16 + fr] = f2bf_hw(acc[mt][n2][jj]);
            __syncthreads();
        }
    }
}

__device__ __forceinline__ f32x4 mma_nt(const bf16_t* A, int lda, const bf16_t* B, int ldb, int K, f32x4 acc, int fr, int fq) {
    for (int k0 = 0; k0 < K; k0 += 32) {
        const bf16x8 a = *(const bf16x8*)(A + fr * lda + k0 + fq * 8);
        const bf16x8 b = *(const bf16x8*)(B + fr * ldb + k0 + fq * 8);
        acc = __builtin_amdgcn_mfma_f32_16x16x32_bf16(a, b, acc, 0, 0, 0);
    }
    return acc;
}
__device__ __forceinline__ bf16x8 pack8(float a0, float a1, float a2, float a3, float a4, float a5, float a6, float a7) {
    u32x4 w; w.x = pack2(a0, a1); w.y = pack2(a2, a3); w.z = pack2(a4, a5); w.w = pack2(a6, a7);
    return __builtin_bit_cast(bf16x8, w);
}
__device__ __forceinline__ float dpp_add(float v, float o) { return v + o; }
__device__ __forceinline__ float wave_sum_fast(float v) {
    v += __int_as_float(__builtin_amdgcn_update_dpp(0, __float_as_int(v), 0xB1, 0xF, 0xF, true));
    v += __int_as_float(__builtin_amdgcn_update_dpp(0, __float_as_int(v), 0x4E, 0xF, 0xF, true));
    v += __int_as_float(__builtin_amdgcn_update_dpp(0, __float_as_int(v), 0x141, 0xF, 0xF, true));
    v += __int_as_float(__builtin_amdgcn_update_dpp(0, __float_as_int(v), 0x140, 0xF, 0xF, true));
    v += __shfl_xor(v, 16, 64); v += __shfl_xor(v, 32, 64);
    return v;
}
__device__ __forceinline__ float wave_sum_dpp(float v) {
    v += __int_as_float(__builtin_amdgcn_update_dpp(0, __float_as_int(v), 0xB1, 0xF, 0xF, true));
    v += __int_as_float(__builtin_amdgcn_update_dpp(0, __float_as_int(v), 0x4E, 0xF, 0xF, true));
    v += __int_as_float(__builtin_amdgcn_update_dpp(0, __float_as_int(v), 0x141, 0xF, 0xF, true));
    v += __int_as_float(__builtin_amdgcn_update_dpp(0, __float_as_int(v), 0x140, 0xF, 0xF, true));
    v += __int_as_float(__builtin_amdgcn_update_dpp(0, __float_as_int(v), 0x142, 0xA, 0xF, false));
    v += __int_as_float(__builtin_amdgcn_update_dpp(0, __float_as_int(v), 0x143, 0xC, 0xF, false));
    return __int_as_float(__builtin_amdgcn_readlane(__float_as_int(v), 63));
}
__device__ __forceinline__ float wave_sum_lane63(float v) {
    v += __int_as_float(__builtin_amdgcn_update_dpp(0, __float_as_int(v), 0xB1, 0xF, 0xF, true));
    v += __int_as_float(__builtin_amdgcn_update_dpp(0, __float_as_int(v), 0x4E, 0xF, 0xF, true));
    v += __int_as_float(__builtin_amdgcn_update_dpp(0, __float_as_int(v), 0x141, 0xF, 0xF, true));
    v += __int_as_float(__builtin_amdgcn_update_dpp(0, __float_as_int(v), 0x140, 0xF, 0xF, true));
    v += __int_as_float(__builtin_amdgcn_update_dpp(0, __float_as_int(v), 0x142, 0xA, 0xF, false));
    v += __int_as_float(__builtin_amdgcn_update_dpp(0, __float_as_int(v), 0x143, 0xC, 0xF, false));
    return v;
}
__device__ __forceinline__ float fast_tanh(float x) { const float e = fexp(2.f * x); return 1.f - 2.f * __builtin_amdgcn_rcpf(1.f + e); }
__device__ __forceinline__ bf16x8 pack8h(float a0, float a1, float a2, float a3, float a4, float a5, float a6, float a7) {
    u32x4 w; w.x = pk2(a0, a1); w.y = pk2(a2, a3); w.z = pk2(a4, a5); w.w = pk2(a6, a7);
    return __builtin_bit_cast(bf16x8, w);
}

__device__ void wkv_unit(const Params& p, int u, float* ldsf) {
    const int tid0 = threadIdx.x, lane0 = tid0 & 63, w = __builtin_amdgcn_readfirstlane(tid0 >> 6), fr0 = lane0 & 15, fq0 = lane0 >> 4;
    unsigned char* ws = p.ws;
    unsigned char* lds = (unsigned char*)ldsf;
    const bf16_t* P = (const bf16_t*)(ws + WS_P);
    bf16_t* OD = (bf16_t*)(ws + WS_X1);
    float* BON = (float*)(ws + WS_BON);
    int z, b, hd, sgm, seqT, tok0; bool sample; const int T = 256;
    if (u < 512) { sample = true; z = u >> 8; b = (u >> 7) & 1; hd = (u >> 3) & 15; sgm = u & 7; seqT = 2048; tok0 = NPTOK + b * 2048; }
    else { const int q = u - 512; sample = false; z = q >> 8; b = (q >> 4) & 15; hd = q & 15; sgm = 0; seqT = 256; tok0 = b * 256; }
    const int qbase = sgm * 256;
    bf16_t* RHO = (bf16_t*)(ws + WS_H);
    float* GH = (float*)(ws + WS_BT0);
    bf16_t* TLW = (bf16_t*)(lds + 0);
    bf16_t* TLA = (bf16_t*)(lds + 9216);
    float* HT = (float*)(lds + 18432);
    float* BONL = (float*)(lds + 57344);
    bf16_t* KTr = (bf16_t*)(lds + 20480);
    bf16_t* BTr = (bf16_t*)(lds + 29696);
    bf16_t* KKH = (bf16_t*)(lds + 38912);
    bf16_t* RH = (bf16_t*)(lds + 48128);
    const bf16_t* VS = (const bf16_t*)(lds + 113664 + 2 * 8192);
    bf16_t* TA = (bf16_t*)(lds + 65536);
    bf16_t* NA = (bf16_t*)(lds + 70656);
    float* PC = (float*)(lds + 75776);
    bf16_t* KBm = (bf16_t*)(lds + 76800);
    float* MM = (float*)(lds + 97280);
    float* WA = (float*)(lds + 76800);
    bf16x8 bw[2];
    { const float* W2 = (w >> 2) ? p.in[18] : p.in[15];
#pragma unroll
      for (int ks = 0; ks < 2; ++ks) { float t8[8];
#pragma unroll
        for (int e = 0; e < 8; ++e) t8[e] = W2[(size_t)(z * 64 + ks * 32 + fq0 * 8 + e) * 1024 + hd * 64 + (w & 3) * 16 + fr0];
        bw[ks] = pack8h(t8[0], t8[1], t8[2], t8[3], t8[4], t8[5], t8[6], t8[7]); } }
    f32x4 Sacc[4];
#pragma unroll
    for (int kt = 0; kt < 4; ++kt) Sacc[kt] = (f32x4){0.f, 0.f, 0.f, 0.f};
    if (w >= 4) {
#pragma unroll
        for (int kt = 0; kt < 4; ++kt)
#pragma unroll
            for (int jj = 0; jj < 4; ++jj) Sacc[kt][jj] = (kt * 16 + fq0 * 4 + jj == (w - 4) * 16 + fr0) ? 1.f : 0.f; }
    const int ch = hd * 64 + lane0;
    const float w0c = p.in[13][z * 1024 + ch], a0c = p.in[16][z * 1024 + ch], kkc = p.in[19][ch], kac = p.in[20][ch], rkc = p.in[21][ch];
    bf16_t* RKV = (bf16_t*)(lds + 113664);
    u32x4 tlraw[2], rkvraw[3];
#define WKV_LOAD_RAW(tb_) do { \
        _Pragma("unroll") for (int h_ = 0; h_ < 2; ++h_) { const int idx_ = tid + h_ * NTHR; const int tau_ = idx_ >> 4, sg_ = idx_ & 15; const int t_ = z ? (seqT - 1 - (qbase + (tb_) + tau_)) : (qbase + (tb_) + tau_); \
            tlraw[h_] = *(const u32x4*)(P + (size_t)(tok0 + t_) * N0 + 8192 + (sg_ < 8 ? z * 64 + sg_ * 8 : 128 + z * 64 + (sg_ - 8) * 8)); } \
        { const int tau_ = tid >> 3, sg_ = tid & 7; const int t_ = z ? (seqT - 1 - (qbase + (tb_) + tau_)) : (qbase + (tb_) + tau_); const bf16_t* rp_ = P + (size_t)(tok0 + t_) * N0 + 4096 + hd * 64 + sg_ * 8; \
          rkvraw[0] = *(const u32x4*)rp_; rkvraw[1] = *(const u32x4*)(rp_ + 1024); rkvraw[2] = *(const u32x4*)(rp_ + 2048); } } while (0)
    { const int tid = tid0; WKV_LOAD_RAW(0); }
    __syncthreads();
#pragma unroll 1
    for (int tb = 0; tb < T; tb += 64) {
        int tid = tid0; asm volatile("" : "+v"(tid));
        const int lane = tid & 63, fr = lane & 15, fq = lane >> 4, c = lane;
        const int pcol = ((c >> 5) * 32) + (((c >> 2) & 3) * 8) + (((c >> 4) & 1) * 4) + (c & 3);
#pragma unroll
        for (int h = 0; h < 2; ++h) { const int idx = tid + h * NTHR; const int tau = idx >> 4, sg = idx & 15;
            u32x4 o = tlraw[h];
            if (sg < 8) { o.x = pk2(fast_tanh(bflo(o.x)), fast_tanh(bfhi(o.x))); o.y = pk2(fast_tanh(bflo(o.y)), fast_tanh(bfhi(o.y)));
                          o.z = pk2(fast_tanh(bflo(o.z)), fast_tanh(bfhi(o.z))); o.w = pk2(fast_tanh(bflo(o.w)), fast_tanh(bfhi(o.w))); }
            *(u32x4*)((sg < 8 ? TLW : TLA) + tau * 72 + (sg & 7) * 8) = o; }
#pragma unroll
        for (int h = 0; h < 3; ++h) *(u32x4*)(RKV + h * 4096 + (tid >> 3) * 64 + (tid & 7) * 8) = rkvraw[h];
        lds_barrier();
        if (tb + 64 < T) WKV_LOAD_RAW(tb + 64);
        { const bf16_t* TL = (w >> 2) ? TLA : TLW; float* WAo = WA + (w >> 2) * 64 * 68;
#pragma unroll
          for (int mt = 0; mt < 4; ++mt) { f32x4 acc = (f32x4){0.f, 0.f, 0.f, 0.f};
#pragma unroll
            for (int ks = 0; ks < 2; ++ks) { const bf16x8 a = *(const bf16x8*)(TL + (mt * 16 + fr) * 72 + ks * 32 + fq * 8);
                acc = __builtin_amdgcn_mfma_f32_16x16x32_bf16(a, bw[ks], acc, 0, 0, 0); }
#pragma unroll
            for (int jj = 0; jj < 4; ++jj) WAo[(mt * 16 + fq * 4 + jj) * 68 + (w & 3) * 16 + fr] = acc[jj]; } }
        lds_barrier();
        float kkv[8], kmv[8], bv[8], lwv[8], cum[8], rr[8], bonv[8];
        { float run = 0.f;
#pragma unroll
          for (int i = 0; i < 8; ++i) { const int tau = w * 8 + i; const int t = z ? (seqT - 1 - (qbase + tb + tau)) : (qbase + tb + tau); const int tokg = tok0 + t;
            const float wr_ = w0c + WA[tau * 68 + c], ap = a0c + WA[64 * 68 + tau * 68 + c];
            const float nx = -wr_; const float sp = fmaxf(nx, 0.f) + flog(1.f + fexp(-fabsf(nx)));
            const float lw = -fexp(-sp - 0.5f);
            const float iclr = __builtin_amdgcn_rcpf(1.f + fexp(-ap));
            const float kxi = bf2f(RKV[4096 + tau * 64 + c]); rr[i] = bf2f(RKV[tau * 64 + c]);
            const float kkraw = kxi * kkc;
            const float ssq = wave_sum_fast(kkraw * kkraw);
            const float kk = kkraw * __builtin_amdgcn_rsqf(fmaxf(ssq, 1e-24f));
            const float kmod = kxi * (1.f + (iclr - 1.f) * kac);
            bonv[i] = wave_sum_lane63(rr[i] * kmod * rkc);
            run += lw;
            kkv[i] = kk; kmv[i] = kmod; bv[i] = kk * iclr; lwv[i] = lw; cum[i] = run; }
          HT[w * 64 + c] = run;
          if (lane == 63) {
#pragma unroll
            for (int i = 0; i < 8; ++i) BONL[w * 8 + i] = bonv[i]; } }
        lds_barrier();
        if (tid < 64) { const int t = z ? (seqT - 1 - (qbase + tb + tid)) : (qbase + tb + tid); BON[((size_t)z * NTOK + tok0 + t) * 16 + hd] = BONL[tid]; }
        { const float off = (w & 1) ? HT[(w - 1) * 64 + c] : 0.f; const int cn = w >> 1;
          unsigned kbq[8];
#pragma unroll
          for (int i = 0; i < 8; ++i) { const int tau = w * 8 + i; const int j = (w & 1) * 8 + i;
            const float cm = cum[i] + off;
            const float Pj = fexp(cm), ipj = fexp(-cm), pm1 = fexp(cm - lwv[i]);
            const unsigned kb2 = pk2(-bv[i] * ipj, kmv[i] * ipj);
            KTr[tau * 72 + pcol] = (bf16_t)(kb2 >> 16); BTr[tau * 72 + pcol] = f2bf_hw(bv[i] * ipj);
            const unsigned kr2 = pk2(kkv[i] * pm1, rr[i] * Pj);
            KKH[tau * 72 + pcol] = (bf16_t)(kr2 & 0xFFFFu); RH[tau * 72 + pcol] = (bf16_t)(kr2 >> 16);
            kbq[i] = kb2;
            if (j == 15) PC[cn * 64 + c] = Pj; }
#pragma unroll
          for (int g = 0; g < 2; ++g) { u32x4 o;
              o.x = (kbq[g * 4 + 0] & 0xFFFFu) | (kbq[g * 4 + 1] << 16); o.y = (kbq[g * 4 + 2] & 0xFFFFu) | (kbq[g * 4 + 3] << 16);
              o.z = (kbq[g * 4 + 0] >> 16) | (kbq[g * 4 + 1] & 0xFFFF0000u); o.w = (kbq[g * 4 + 2] >> 16) | (kbq[g * 4 + 3] & 0xFFFF0000u);
              *(u32x4*)(KBm + (cn * 64 + c) * 40 + ((w & 1) * 2 + g) * 8) = o; } }
        lds_barrier();
#pragma unroll
        for (int q2 = 0; q2 < 2; ++q2) { const int id = w * 2 + q2; const int cn = id >> 2, which = id & 3;
          const bf16_t* Am = ((which & 1) ? KTr : BTr) + cn * 16 * 72; const bf16_t* Bm = ((which & 2) ? RH : KKH) + cn * 16 * 72;
          const f32x4 acc = mma_nt(Am, 72, Bm, 72, 64, (f32x4){0.f, 0.f, 0.f, 0.f}, fr, fq);
          f32x4 o;
#pragma unroll
          for (int jj = 0; jj < 4; ++jj) { const int i = fq * 4 + jj, j = fr; const bool keep = (which & 2) ? (i <= j) : (i < j); o[jj] = keep ? acc[jj] : 0.f; }
          *(f32x4*)(MM + (cn * 4 + which) * 256 + fr * 16 + fq * 4) = o; }
        lds_barrier();
        if (w < 4) { const int cn = w, col = lane >> 2, rg = lane & 3;
            const float* MbT = MM + (cn * 4 + 0) * 256 + rg * 4; const float* MkT = MM + (cn * 4 + 1) * 256 + rg * 4;
            float Tc[4], A1[4];
#pragma unroll
            for (int e = 0; e < 4; ++e) { Tc[e] = (rg * 4 + e == col) ? 1.f : 0.f; A1[e] = 0.f; }
#define INV_STEP(l, CTRL) do { const f32x4 mb = *(const f32x4*)(MbT + (l) * 16), mk = *(const f32x4*)(MkT + (l) * 16); \
                const float tl_ = __int_as_float(__builtin_amdgcn_update_dpp(0, __float_as_int(Tc[(l) & 3]), CTRL, 0xF, 0xF, true)); \
                Tc[0] -= mb[0] * tl_; Tc[1] -= mb[1] * tl_; Tc[2] -= mb[2] * tl_; Tc[3] -= mb[3] * tl_; \
                A1[0] += mk[0] * tl_; A1[1] += mk[1] * tl_; A1[2] += mk[2] * tl_; A1[3] += mk[3] * tl_; } while (0)
            INV_STEP(15, 0xFF); INV_STEP(14, 0xFF); INV_STEP(13, 0xFF); INV_STEP(12, 0xFF);
            INV_STEP(11, 0xAA); INV_STEP(10, 0xAA); INV_STEP(9, 0xAA); INV_STEP(8, 0xAA);
            INV_STEP(7, 0x55); INV_STEP(6, 0x55); INV_STEP(5, 0x55); INV_STEP(4, 0x55);
            INV_STEP(3, 0x00); INV_STEP(2, 0x00); INV_STEP(1, 0x00);
#undef INV_STEP
            u32x4 o; o.x = pk2(Tc[0], Tc[1]); o.y = pk2(Tc[2], Tc[3]); o.z = pk2(A1[0], A1[1]); o.w = pk2(A1[2], A1[3]);
            *(u32x4*)(TA + (cn * 16 + col) * 40 + rg * 8) = o; }
        else { const int cn = w - 4, j = lane & 15, ig = lane >> 4;
            const f32x4 nb = *(const f32x4*)(MM + (cn * 4 + 2) * 256 + j * 16 + ig * 4), nk = *(const f32x4*)(MM + (cn * 4 + 3) * 256 + j * 16 + ig * 4);
            u32x4 o; o.x = pk2(-nb[0], -nb[1]); o.y = pk2(-nb[2], -nb[3]); o.z = pk2(nk[0], nk[1]); o.w = pk2(nk[2], nk[3]);
            *(u32x4*)(NA + (cn * 16 + j) * 40 + ig * 8) = o; }
        lds_barrier();
        if (w < 4 || sample) {
            const int vb = w & 3;
            const int t0s = z ? (seqT - 1 - (qbase + tb)) : (qbase + tb);
            const long tstep = z ? -1024 : 1024;
            bf16_t* obase = (w < 4) ? OD + ((size_t)z * NTOK + tok0 + t0s) * 1024 + hd * 64 + vb * 16 + fr : RHO + ((size_t)z * 4096 + (tok0 - NPTOK) + t0s) * 1024 + hd * 64 + vb * 16 + fr;
#pragma unroll 1
            for (int cn = 0; cn < 4; ++cn) {
                bf16x8 sb[2];
#pragma unroll
                for (int ks = 0; ks < 2; ++ks) sb[ks] = pack8h(Sacc[2 * ks][0], Sacc[2 * ks][1], Sacc[2 * ks][2], Sacc[2 * ks][3], Sacc[2 * ks + 1][0], Sacc[2 * ks + 1][1], Sacc[2 * ks + 1][2], Sacc[2 * ks + 1][3]);
                f32x4 U0 = (f32x4){0.f, 0.f, 0.f, 0.f}, O = (f32x4){0.f, 0.f, 0.f, 0.f};
#pragma unroll
                for (int ks = 0; ks < 2; ++ks) { const bf16x8 a = *(const bf16x8*)(KKH + (cn * 16 + fr) * 72 + ks * 32 + fq * 8);
                    U0 = __builtin_amdgcn_mfma_f32_16x16x32_bf16(a, sb[ks], U0, 0, 0, 0);
                    const bf16x8 ar = *(const bf16x8*)(RH + (cn * 16 + fr) * 72 + ks * 32 + fq * 8);
                    O = __builtin_amdgcn_mfma_f32_16x16x32_bf16(ar, sb[ks], O, 0, 0, 0); }
                float vf[4];
#pragma unroll
                for (int e = 0; e < 4; ++e) vf[e] = (w < 4) ? bf2f(VS[(cn * 16 + fq * 4 + e) * 64 + vb * 16 + fr]) : 0.f;
                const bf16x8 bU0 = pack8h(U0[0], U0[1], U0[2], U0[3], vf[0], vf[1], vf[2], vf[3]);
                const bf16x8 ta = *(const bf16x8*)(TA + (cn * 16 + fr) * 40 + fq * 8);
                const f32x4 U = __builtin_amdgcn_mfma_f32_16x16x32_bf16(ta, bU0, (f32x4){0.f, 0.f, 0.f, 0.f}, 0, 0, 0);
                const bf16x8 bUV = pack8h(U[0], U[1], U[2], U[3], vf[0], vf[1], vf[2], vf[3]);
                const bf16x8 na = *(const bf16x8*)(NA + (cn * 16 + fr) * 40 + fq * 8);
                O = __builtin_amdgcn_mfma_f32_16x16x32_bf16(na, bUV, O, 0, 0, 0);
#pragma unroll
                for (int jj = 0; jj < 4; ++jj) obase[(long)(cn * 16 + fq * 4 + jj) * tstep] = f2bf_hw(O[jj]);
#pragma unroll
                for (int kt = 0; kt < 4; ++kt) { const bf16x8 kb = *(const bf16x8*)(KBm + (cn * 64 + kt * 16 + fr) * 40 + fq * 8);
                    Sacc[kt] = __builtin_amdgcn_mfma_f32_16x16x32_bf16(kb, bUV, Sacc[kt], 0, 0, 0);
                    const f32x4 pc = *(const f32x4*)(PC + cn * 64 + kt * 16 + fq * 4);
                    Sacc[kt] = Sacc[kt] * pc; }
            }
        }
        lds_barrier();
    }
#undef WKV_LOAD_RAW
    if (!sample) { if (w < 4) { float* so = p.out + (size_t)2 * NPTOK * D + ((size_t)((b * 2 + z) * 16 + hd)) * 4096 + (size_t)(w * 16 + fr0) * 64;
#pragma unroll
        for (int kt = 0; kt < 4; ++kt)
#pragma unroll
            for (int jj = 0; jj < 4; ++jj) so[kt * 16 + fq0 * 4 + jj] = Sacc[kt][jj]; } }
    else { float* so = GH + ((size_t)u * 2 + (w >> 2)) * 4096 + (size_t)((w & 3) * 16 + fr0) * 64;
#pragma unroll
        for (int kt = 0; kt < 4; ++kt)
#pragma unroll
            for (int jj = 0; jj < 4; ++jj) so[kt * 16 + fq0 * 4 + jj] = Sacc[kt][jj]; }
    __syncthreads();
}

__device__ void wkv_fix_unit(const Params& p, int u, float* ldsf) {
    const int tid = threadIdx.x, lane = tid & 63, w = __builtin_amdgcn_readfirstlane(tid >> 6), fr = lane & 15, fq = lane >> 4;
    unsigned char* ws = p.ws;
    bf16_t* OD = (bf16_t*)(ws + WS_X1);
    const bf16_t* RHO = (const bf16_t*)(ws + WS_H);
    const float* GH = (const float*)(ws + WS_BT0);
    const int z = u >> 7, b = (u >> 6) & 1, hd = (u >> 2) & 15, vq = u & 3;
    float* SS = ldsf;
    float* GL = ldsf + 1024;
    bf16_t* SB = (bf16_t*)(ldsf + 1024 + 4096);
    const int v = tid >> 5, kp = (tid & 31) * 2;
    { const float* s0 = p.in[2] + ((size_t)((b * 2 + z) * 16 + hd)) * 4096 + (size_t)(vq * 16 + v) * 64 + kp; SS[v * 64 + kp] = s0[0]; SS[v * 64 + kp + 1] = s0[1]; }
    __syncthreads();
#pragma unroll 1
    for (int sg = 0; sg < 8; ++sg) {
        const int su = ((z * 2 + b) * 16 + hd) * 8 + sg;
        SB[v * 72 + kp] = f2bf_hw(SS[v * 64 + kp]); SB[v * 72 + kp + 1] = f2bf_hw(SS[v * 64 + kp + 1]);
        if (sg < 7) { const f32x4* gsrc = (const f32x4*)(GH + ((size_t)su * 2 + 1) * 4096);
#pragma unroll
            for (int q = 0; q < 2; ++q) ((f32x4*)GL)[tid + q * NTHR] = gsrc[tid + q * NTHR]; }
        __syncthreads();
        const int tlo = z ? (2048 - (sg + 1) * 256) : sg * 256;
#pragma unroll
        for (int q = 0; q < 2; ++q) { const int mt = 2 * w + q;
            f32x4 acc = (f32x4){0.f, 0.f, 0.f, 0.f};
#pragma unroll
            for (int ks = 0; ks < 2; ++ks) { const bf16x8 a = *(const bf16x8*)(RHO + ((size_t)z * 4096 + b * 2048 + tlo + mt * 16 + fr) * 1024 + hd * 64 + ks * 32 + fq * 8);
                const bf16x8 bb = *(const bf16x8*)(SB + fr * 72 + ks * 32 + fq * 8);
                acc = __builtin_amdgcn_mfma_f32_16x16x32_bf16(a, bb, acc, 0, 0, 0); }
#pragma unroll
            for (int jj = 0; jj < 4; ++jj) { bf16_t* op = OD + ((size_t)z * NTOK + NPTOK + b * 2048 + tlo + mt * 16 + fq * 4 + jj) * 1024 + hd * 64 + vq * 16 + fr;
                *op = f2bf_hw(bf2f(*op) + acc[jj]); } }
        if (sg < 7) {
            const float* hsrc = GH + ((size_t)su * 2 + 0) * 4096 + (size_t)(vq * 16 + v) * 64 + kp;
            float a0 = hsrc[0], a1 = hsrc[1];
#pragma unroll 8
            for (int k2 = 0; k2 < 64; ++k2) { const float sv = SS[v * 64 + k2]; a0 += sv * GL[k2 * 64 + kp]; a1 += sv * GL[k2 * 64 + kp + 1]; }
            __syncthreads();
            SS[v * 64 + kp] = a0; SS[v * 64 + kp + 1] = a1;
        }
        __syncthreads();
    }
}
__device__ void phase_wkv_fix(const Params& p, float* lds) {
    for (int it = blockIdx.x; it < 256; it += gridDim.x) wkv_fix_unit(p, it, lds);
}

__device__ void conv_tile(const Params& p, int tile) {
    const int tid = threadIdx.x;
    unsigned char* ws = p.ws;
    const bf16_t* P = (const bf16_t*)(ws + WS_P);
    bf16_t* OC = (bf16_t*)(ws + WS_OC);
    const int cgp = tid & 127, c0 = cgp * 8, sub = tid >> 7;
    float cw0[8], cw1[8], cw2[8];
#pragma unroll
    for (int j = 0; j < 8; ++j) { cw0[j] = p.in[12][c0 + j]; cw1[j] = p.in[12][1024 + c0 + j]; cw2[j] = p.in[12][2048 + c0 + j]; }
    for (int jj = 0; jj < 4; ++jj) {
        const int t = tile * 16 + sub + 4 * jj;
        const int rl = t < NPTOK ? 256 : 64; const int pos = t & (rl - 1);
        const bf16_t* row = P + (size_t)t * N0;
        const u32x4 z4 = (u32x4){0u, 0u, 0u, 0u};
        const u32x4 u1 = *(const u32x4*)(row + c0), g1 = *(const u32x4*)(row + 2048 + c0);
        const u32x4 u0 = pos > 0 ? *(const u32x4*)(row - N0 + c0) : z4, g0 = pos > 0 ? *(const u32x4*)(row - N0 + 2048 + c0) : z4;
        const u32x4 u2 = pos < rl - 1 ? *(const u32x4*)(row + N0 + c0) : z4, g2 = pos < rl - 1 ? *(const u32x4*)(row + N0 + 2048 + c0) : z4;
        const u32x4 gb = *(const u32x4*)(row + 1024 + c0), zc = *(const u32x4*)(row + 3072 + c0);
        u32x4 o;
#pragma unroll
        for (int q = 0; q < 4; ++q) {
            const float y0 = cw0[2 * q] * (bflo(g0[q]) * bflo(u0[q])) + cw1[2 * q] * (bflo(g1[q]) * bflo(u1[q])) + cw2[2 * q] * (bflo(g2[q]) * bflo(u2[q]));
            const float y1 = cw0[2 * q + 1] * (bfhi(g0[q]) * bfhi(u0[q])) + cw1[2 * q + 1] * (bfhi(g1[q]) * bfhi(u1[q])) + cw2[2 * q + 1] * (bfhi(g2[q]) * bfhi(u2[q]));
            o[q] = pack2(silu(bflo(zc[q])) * bflo(gb[q]) * y0, silu(bfhi(zc[q])) * bfhi(gb[q]) * y1);
        }
        *(u32x4*)(OC + (size_t)t * 2048 + c0) = o;
    }
}

__device__ void phase_mix0(const Params& p, float* lds, int rep) {
    (void)rep;
    constexpr int NSCAN = 1024, NCONV = 512;
    for (int it = blockIdx.x; it < NSCAN + NCONV; it += gridDim.x) {
        if (it < NSCAN) wkv_unit(p, it, lds); else conv_tile(p, it - NSCAN);
    }
}

__device__ __forceinline__ float quad_sum(float v) {
    v += __int_as_float(__builtin_amdgcn_update_dpp(0, __float_as_int(v), 0xB1, 0xF, 0xF, true));
    v += __int_as_float(__builtin_amdgcn_update_dpp(0, __float_as_int(v), 0x4E, 0xF, 0xF, true));
    return v;
}
__device__ void phase_wkv_post(const Params& p) {
    const int tid = threadIdx.x, wave = tid >> 6, lane = tid & 63;
    unsigned char* ws = p.ws;
    const bf16_t* P = (const bf16_t*)(ws + WS_P);
    const bf16_t* OD = (const bf16_t*)(ws + WS_X1);
    const float* BON = (const float*)(ws + WS_BON);
    bf16_t* OC = (bf16_t*)(ws + WS_OC);
    const int hh = lane >> 2, ch0 = hh * 64 + (lane & 3) * 16;
    for (int tok = blockIdx.x * 8 + wave; tok < NTOK; tok += gridDim.x * 8) {
        const bf16_t* row = P + (size_t)tok * N0;
        u32x4 a0[2], a1[2], vv[2], zz[2];
#pragma unroll
        for (int h = 0; h < 2; ++h) { a0[h] = *(const u32x4*)(OD + (size_t)tok * 1024 + ch0 + h * 8); a1[h] = *(const u32x4*)(OD + ((size_t)NTOK + tok) * 1024 + ch0 + h * 8);
            vv[h] = *(const u32x4*)(row + 6144 + ch0 + h * 8); zz[h] = *(const u32x4*)(row + 7168 + ch0 + h * 8); }
        const float bon = BON[(size_t)tok * 16 + hh] + BON[((size_t)NTOK + tok) * 16 + hh];
        float o[16]; float s1 = 0.f;
#pragma unroll
        for (int h = 0; h < 2; ++h)
#pragma unroll
            for (int q = 0; q < 4; ++q) { o[h * 8 + 2 * q] = bflo(a0[h][q]) + bflo(a1[h][q]); o[h * 8 + 2 * q + 1] = bfhi(a0[h][q]) + bfhi(a1[h][q]); s1 += o[h * 8 + 2 * q] + o[h * 8 + 2 * q + 1]; }
        const float mu = quad_sum(s1) * (1.f / 64.f);
        float s2 = 0.f;
#pragma unroll
        for (int i = 0; i < 16; ++i) { o[i] -= mu; s2 += o[i] * o[i]; }
        const float rs = rsqrtf(quad_sum(s2) * (1.f / 64.f) + 64e-5f);
        float res[16];
#pragma unroll
        for (int g4 = 0; g4 < 4; ++g4) { const f32x4 lw4 = *(const f32x4*)(p.in[22] + ch0 + g4 * 4), lb4 = *(const f32x4*)(p.in[23] + ch0 + g4 * 4);
#pragma unroll
            for (int e = 0; e < 4; ++e) { const int i = g4 * 4 + e; const unsigned vw = vv[i >> 3][(i & 7) >> 1], zw_ = zz[i >> 3][(i & 7) >> 1];
                const float v1 = (i & 1) ? bfhi(vw) : bflo(vw), z1 = (i & 1) ? bfhi(zw_) : bflo(zw_);
                res[i] = (o[i] * rs * lw4[e] + lb4[e] + bon * v1) * silu(z1); } }
#pragma unroll
        for (int h = 0; h < 2; ++h) { u32x4 w4; w4.x = pk2(res[h * 8 + 0], res[h * 8 + 1]); w4.y = pk2(res[h * 8 + 2], res[h * 8 + 3]); w4.z = pk2(res[h * 8 + 4], res[h * 8 + 5]); w4.w = pk2(res[h * 8 + 6], res[h * 8 + 7]);
            *(u32x4*)(OC + (size_t)tok * 2048 + 1024 + ch0 + h * 8) = w4; }
    }
}

constexpr size_t WS_QE = WS_H;
constexpr size_t WS_KDT = WS_BT0;
constexpr size_t WS_VT = WS_OC + (size_t)NTOK * 1024 * 2;
constexpr size_t WS_EBL = WS_BON + (size_t)2 * NTOK * 16 * 4;
constexpr size_t WS_ATT = WS_P + 52 * MB;

__device__ void gla_a_item(const Params& p, int item, float* ldsf) {
    const int tid = threadIdx.x, lane = tid & 63, w = __builtin_amdgcn_readfirstlane(tid >> 6), fr = lane & 15, fq = lane >> 4;
    unsigned char* ws = p.ws;
    const bf16_t* P1 = (const bf16_t*)(ws + WS_P);
    float* OD = (float*)(ws + WS_P2);
    bf16_t* QEg = (bf16_t*)(ws + WS_QE); bf16_t* KDTg = (bf16_t*)(ws + WS_KDT); bf16_t* VTg = (bf16_t*)(ws + WS_VT); float* EBLg = (float*)(ws + WS_EBL);
    const int hd = item & 3, c = (item >> 2) & 127, z = item >> 9, tok0 = c * 64;
    bf16_t* QE = (bf16_t*)ldsf;
    bf16_t* KE = QE + 64 * 136;
    bf16_t* VT = KE + 64 * 136;
    bf16_t* ATT = VT + 256 * 72;
    float* G = (float*)(ATT + 64 * 72);
    float* L1G = G + 64 * 132;
    float* GK2 = L1G + 1024;
    for (int i = tid; i < 1024; i += NTHR) { const int t = i >> 4, r = i & 15; L1G[i] = bf2f(P1[(size_t)(tok0 + t) * N1 + 3072 + z * 16 + r]); }
    for (int i = tid; i < 2048; i += NTHR) { const int r = i >> 7, d = i & 127; GK2[i] = p.in[27][(size_t)(z * 16 + r) * 512 + hd * 128 + d]; }
#pragma unroll
    for (int ps = 0; ps < 4; ++ps) { const int t = lane, e8 = (ps * 8 + w) * 8;
        const u32x4 v8 = *(const u32x4*)(P1 + (size_t)(tok0 + t) * N1 + 1024 + hd * 256 + e8);
        VT[(e8 + 0) * 72 + t] = (bf16_t)(v8.x & 0xFFFF); VT[(e8 + 1) * 72 + t] = (bf16_t)(v8.x >> 16); VT[(e8 + 2) * 72 + t] = (bf16_t)(v8.y & 0xFFFF); VT[(e8 + 3) * 72 + t] = (bf16_t)(v8.y >> 16);
        VT[(e8 + 4) * 72 + t] = (bf16_t)(v8.z & 0xFFFF); VT[(e8 + 5) * 72 + t] = (bf16_t)(v8.z >> 16); VT[(e8 + 6) * 72 + t] = (bf16_t)(v8.w & 0xFFFF); VT[(e8 + 7) * 72 + t] = (bf16_t)(v8.w >> 16); }
    const int d = tid & 127, tq = tid >> 7;
    const float gbias = p.in[28][z * 512 + hd * 128 + d];
    bf16_t qraw[16], kraw[16];
#pragma unroll
    for (int i = 0; i < 16; ++i) { const size_t row = (size_t)(tok0 + tq * 16 + i) * N1; qraw[i] = P1[row + hd * 128 + d]; kraw[i] = P1[row + 512 + hd * 128 + d]; }
    __syncthreads();
    { float run = 0.f;
#pragma unroll 4
      for (int i = 0; i < 16; ++i) { const int t = z ? (tq * 16 + 15 - i) : (tq * 16 + i);
        float x = gbias;
#pragma unroll
        for (int r = 0; r < 16; ++r) x += L1G[t * 16 + r] * GK2[r * 128 + d];
        const float ls = fminf(x, 0.f) - flog(1.f + fexp(-fabsf(x)));
        run += ls * (1.f / 16.f);
        G[t * 132 + d] = run; } }
    __syncthreads();
    { const int lastr = z ? 0 : 15;
      const float t0 = G[(0 + lastr) * 132 + d], t1 = G[(16 + lastr) * 132 + d], t2 = G[(32 + lastr) * 132 + d], t3 = G[(48 + lastr) * 132 + d];
      const float blast = t0 + t1 + t2 + t3;
      float off;
      if (z == 0) off = tq == 0 ? 0.f : (tq == 1 ? t0 : (tq == 2 ? t0 + t1 : t0 + t1 + t2));
      else off = tq == 3 ? 0.f : (tq == 2 ? t3 : (tq == 1 ? t3 + t2 : t3 + t2 + t1));
      if (tq == 0) EBLg[(size_t)(z * 128 + c) * 512 + hd * 128 + d] = fexp(blast);
      unsigned kdp[8];
#pragma unroll
      for (int i = 0; i < 16; ++i) { const int t = tq * 16 + i;
        const float bc = G[t * 132 + d] + off;
        const float q = bf2f(qraw[i]) * 0.08838834764831845f, k = bf2f(kraw[i]);
        const bf16_t qe = f2bf(q * fexp(bc));
        QE[t * 136 + d] = qe; KE[t * 136 + d] = f2bf(k * fexp(-bc));
        const unsigned kd = (unsigned)f2bf(k * fexp(blast - bc));
        if (i & 1) kdp[i >> 1] |= kd << 16; else kdp[i >> 1] = kd; }
      bf16_t* kdst = KDTg + ((size_t)(((z * 128 + c) * 4 + hd) * 128 + d)) * 64 + tq * 16;
      *(u32x4*)kdst = (u32x4){kdp[0], kdp[1], kdp[2], kdp[3]}; *(u32x4*)(kdst + 8) = (u32x4){kdp[4], kdp[5], kdp[6], kdp[7]}; }
    __syncthreads();
#pragma unroll
    for (int q2 = 0; q2 < 2; ++q2) { const int idx = q2 * NTHR + tid; const int t = idx >> 4, d8 = (idx & 15) * 8;
        *(u32x4*)(QEg + ((size_t)z * NTOK + tok0 + t) * 512 + hd * 128 + d8) = *(const u32x4*)(QE + t * 136 + d8); }
    if (z == 0) {
#pragma unroll
        for (int q4 = 0; q4 < 4; ++q4) { const int idx = q4 * NTHR + tid; const int e = idx >> 3, t8 = (idx & 7) * 8;
            *(u32x4*)(VTg + ((size_t)((c * 4 + hd) * 256 + e)) * 64 + t8) = *(const u32x4*)(VT + e * 72 + t8); } }
#pragma unroll
    for (int q2 = 0; q2 < 2; ++q2) { const int tA = 2 * w + q2, ia = tA >> 2, ja = tA & 3;
        f32x4 a4 = (f32x4){0.f, 0.f, 0.f, 0.f};
        if (z ? (ja >= ia) : (ja <= ia)) a4 = mma_nt(QE + ia * 16 * 136, 136, KE + ja * 16 * 136, 136, 128, a4, fr, fq);
#pragma unroll
        for (int jj = 0; jj < 4; ++jj) { const int i = ia * 16 + fq * 4 + jj, j = ja * 16 + fr; const bool keep = z ? (j >= i) : (j <= i); ATT[i * 72 + j] = f2bf(keep ? a4[jj] : 0.f); } }
    __syncthreads();
    { bf16_t* ATTg = (bf16_t*)(ws + WS_ATT) + ((size_t)((z * 128 + c) * 4 + hd)) * 4096;
      const int i = tid >> 3, j8 = (tid & 7) * 8;
      *(u32x4*)(ATTg + i * 64 + j8) = *(const u32x4*)(ATT + i * 72 + j8); }
    __syncthreads();
}

__device__ void phase_gla_a(const Params& p, float* lds) {
    for (int it = blockIdx.x; it < 1024; it += gridDim.x) gla_a_item(p, it, lds);
}

struct GlaFrags { bf16x8 kdt[2]; u32x4 vts; u32x4 qes[2]; bf16x8 att[2]; f32x4 ebl; };

template <int NE>
__device__ __forceinline__ void gla_b_unit_t(const Params& p, int z, int b, int hd, int e0, int nch, int ch0, bool sample, float* ldsf) {
    const int tid = threadIdx.x, lane = tid & 63, w = __builtin_amdgcn_readfirstlane(tid >> 6), fr = lane & 15, fq = lane >> 4;
    unsigned char* ws = p.ws;
    float* OD = (float*)(ws + WS_P2);
    const bf16_t* QEg = (const bf16_t*)(ws + WS_QE); const bf16_t* KDTg = (const bf16_t*)(ws + WS_KDT); const bf16_t* VTg = (const bf16_t*)(ws + WS_VT); const float* EBLg = (const float*)(ws + WS_EBL);
    const bf16_t* ATTg = (const bf16_t*)(ws + WS_ATT);
    constexpr int NQ = NE / 2;
    bf16_t* ST = (bf16_t*)ldsf;
    bf16_t* VTL = ST + 2 * 64 * 136;
    bf16_t* QEL = VTL + 2 * 64 * 72;
    f32x4 Sacc[NE];
    if (sample) { const float* s0 = p.in[3] + ((size_t)((b * 2 + z) * 4 + hd)) * 32768 + e0 + fr;
#pragma unroll
        for (int et = 0; et < NE; ++et)
#pragma unroll
            for (int jj = 0; jj < 4; ++jj) Sacc[et][jj] = s0[(size_t)(w * 16 + fq * 4 + jj) * 256 + et * 16]; }
    else {
#pragma unroll
        for (int et = 0; et < NE; ++et) Sacc[et] = (f32x4){0.f, 0.f, 0.f, 0.f}; }
    const int it = w >> 1, e2 = (w & 1) * NQ;
    const int ve = tid >> 3, vt8 = (tid & 7) * 8;
#define GLB_LOAD(F, c_) do { const int cc_ = (c_); \
        _Pragma("unroll") for (int ks = 0; ks < 2; ++ks) { (F).kdt[ks] = *(const bf16x8*)(KDTg + ((size_t)(((z * 128 + cc_) * 4 + hd) * 128 + w * 16 + fr)) * 64 + ks * 32 + fq * 8); \
            (F).att[ks] = *(const bf16x8*)(ATTg + ((size_t)((z * 128 + cc_) * 4 + hd)) * 4096 + (it * 16 + fr) * 64 + ks * 32 + fq * 8); } \
        if (ve < NE * 16) (F).vts = *(const u32x4*)(VTg + ((size_t)((cc_ * 4 + hd) * 256 + e0 + ve)) * 64 + vt8); \
        _Pragma("unroll") for (int h_ = 0; h_ < 2; ++h_) (F).qes[h_] = *(const u32x4*)(QEg + ((size_t)z * NTOK + cc_ * 64 + ve) * 512 + hd * 128 + h_ * 64 + vt8); \
        (F).ebl = *(const f32x4*)(EBLg + (size_t)(z * 128 + cc_) * 512 + hd * 128 + w * 16 + fq * 4); } while (0)
#define GLB_STEP(CUR, NX2, ci_) do { const int ci = (ci_); if (ci < nch) { \
        const int c = ch0 + (z ? nch - 1 - ci : ci); \
        bf16_t* STc = ST + (ci & 1) * 64 * 136; bf16_t* VTc = VTL + (ci & 1) * 64 * 72; \
        _Pragma("unroll") for (int et = 0; et < NE; ++et) { u32x2 v2; v2.x = pk2(Sacc[et][0], Sacc[et][1]); v2.y = pk2(Sacc[et][2], Sacc[et][3]); \
            *(u32x2*)(STc + (et * 16 + fr) * 136 + w * 16 + fq * 4) = v2; } \
        if (ve < NE * 16) *(u32x4*)(VTc + ve * 72 + vt8) = (CUR).vts; \
        bf16_t* QEc = QEL + (ci & 1) * 64 * 136; \
        *(u32x4*)(QEc + ve * 136 + vt8) = (CUR).qes[0]; *(u32x4*)(QEc + ve * 136 + 64 + vt8) = (CUR).qes[1]; \
        if (ci + 2 < nch) GLB_LOAD(NX2, ch0 + (z ? nch - 3 - ci : ci + 2)); \
        lds_barrier(); \
        _Pragma("unroll") for (int et = 0; et < NE; ++et) { Sacc[et] = Sacc[et] * (CUR).ebl; \
            _Pragma("unroll") for (int ks = 0; ks < 2; ++ks) { const bf16x8 vf = *(const bf16x8*)(VTc + (et * 16 + fr) * 72 + ks * 32 + fq * 8); \
                Sacc[et] = __builtin_amdgcn_mfma_f32_16x16x32_bf16((CUR).kdt[ks], vf, Sacc[et], 0, 0, 0); } } \
        _Pragma("unroll") for (int q2 = 0; q2 < NQ; ++q2) { f32x4 o = (f32x4){0.f, 0.f, 0.f, 0.f}; \
            _Pragma("unroll") for (int ks = 0; ks < 2; ++ks) { const bf16x8 vf = *(const bf16x8*)(VTc + ((e2 + q2) * 16 + fr) * 72 + ks * 32 + fq * 8); \
                o = __builtin_amdgcn_mfma_f32_16x16x32_bf16((CUR).att[ks], vf, o, 0, 0, 0); } \
            _Pragma("unroll") for (int ks = 0; ks < 4; ++ks) { const bf16x8 bS = *(const bf16x8*)(STc + ((e2 + q2) * 16 + fr) * 136 + ks * 32 + fq * 8); \
                const bf16x8 aq = *(const bf16x8*)(QEc + (it * 16 + fr) * 136 + ks * 32 + fq * 8); \
                o = __builtin_amdgcn_mfma_f32_16x16x32_bf16(aq, bS, o, 0, 0, 0); } \
            _Pragma("unroll") for (int jj = 0; jj < 4; ++jj) OD[((size_t)z * NTOK + c * 64 + it * 16 + fq * 4 + jj) * 1024 + hd * 256 + e0 + (e2 + q2) * 16 + fr] = o[jj]; } } } while (0)
    GlaFrags fa, fb, fc; fa.vts = fb.vts = fc.vts = (u32x4){0u, 0u, 0u, 0u};
    GLB_LOAD(fa, ch0 + (z ? nch - 1 : 0));
    GLB_LOAD(fb, ch0 + (z ? nch - 2 : 1));
    __syncthreads();
#pragma unroll 1
    for (int ci3 = 0; ci3 < nch; ci3 += 3) { GLB_STEP(fa, fc, ci3); GLB_STEP(fb, fa, ci3 + 1); GLB_STEP(fc, fb, ci3 + 2); }
#undef GLB_STEP
#undef GLB_LOAD
    if (!sample) { float* so = p.out + (size_t)2 * NPTOK * D + 2097152 + ((size_t)((b * 2 + z) * 4 + hd)) * 32768 + e0 + fr;
#pragma unroll
        for (int et = 0; et < NE; ++et)
#pragma unroll
            for (int jj = 0; jj < 4; ++jj) so[(size_t)(w * 16 + fq * 4 + jj) * 256 + et * 16] = Sacc[et][jj]; }
    __syncthreads();
}

__device__ void gla_b_unit(const Params& p, int u, float* ldsf) {
    if (u < 128) gla_b_unit_t<2>(p, u >> 6, (u >> 5) & 1, (u >> 3) & 3, (u & 7) * 32, 32, 64 + ((u >> 5) & 1) * 32, true, ldsf);
    else { const int q = u - 128; gla_b_unit_t<4>(p, q >> 8, (q >> 4) & 15, (q >> 2) & 3, (q & 3) * 64, 4, ((q >> 4) & 15) * 4, false, ldsf); }
}

__device__ void phase_gla_b(const Params& p, float* lds, int rep) {
    unsigned* ctr = (unsigned*)(p.ws + WS_CTL) + 16 + rep * 32;
    int* slot = (int*)(lds + LDS_MAIN / 4);
    for (;;) {
        if (threadIdx.x == 0) *slot = (int)atomicAdd(ctr, 1u);
        __syncthreads();
        const int it = *slot;
        __syncthreads();
        if (it >= 640) break;
        gla_b_unit(p, it, lds);
    }
}

__device__ void phase_gla_post(const Params& p) {
    const int tid = threadIdx.x, wave = tid >> 6, lane = tid & 63;
    unsigned char* ws = p.ws;
    const bf16_t* P1 = (const bf16_t*)(ws + WS_P);
    const float* OD = (const float*)(ws + WS_P2);
    bf16_t* OG = (bf16_t*)(ws + WS_OC);
    for (int tok = blockIdx.x * 8 + wave; tok < NTOK; tok += gridDim.x * 8) {
        for (int hd = 0; hd < 4; ++hd) { const int idx = hd * 256 + lane * 4;
            const f32x4 a = *(const f32x4*)(OD + (size_t)tok * 1024 + idx), b2 = *(const f32x4*)(OD + ((size_t)NTOK + tok) * 1024 + idx);
            const f32x4 o = a + b2;
            const float ss = wave_sum(o[0] * o[0] + o[1] * o[1] + o[2] * o[2] + o[3] * o[3]);
            const float rs = rsqrtf(ss * (1.f / 256.f) + 1e-6f);
            const f32x4 gn = *(const f32x4*)(p.in[29] + lane * 4);
            const u32x2 zz = *(const u32x2*)(P1 + (size_t)tok * N1 + 2048 + idx);
            const float z0 = bflo(zz.x), z1 = bfhi(zz.x), z2 = bflo(zz.y), z3 = bfhi(zz.y);
            u32x2 w; w.x = pack2(o[0] * rs * gn[0] * silu(z0), o[1] * rs * gn[1] * silu(z1)); w.y = pack2(o[2] * rs * gn[2] * silu(z2), o[3] * rs * gn[3] * silu(z3));
            *(u32x2*)(OG + (size_t)tok * 1024 + idx) = w; }
    }
}

__device__ void phase_final(const Params& p) {
    const int tid = threadIdx.x, wave = tid >> 6, lane = tid & 63;
    unsigned char* ws = p.ws;
    const float* MOD = (const float*)(ws + WS_MOD);
    const float* X1 = (const float*)(ws + WS_X1);
    const bf16_t* Y = (const bf16_t*)(ws + WS_P2);
    for (int tok = blockIdx.x * 8 + wave; tok < NTOK; tok += gridDim.x * 8) {
        const int cond = tok < NPTOK ? 0 : 1 + ((tok - NPTOK) >> 11);
        f32x4 xv[4]; float ss = 0.f;
#pragma unroll
        for (int i = 0; i < 4; ++i) { const int idx = i * 256 + lane * 4;
            const f32x4 x1 = *(const f32x4*)(X1 + (size_t)tok * D + idx);
            const u32x2 pa = *(const u32x2*)(Y + (size_t)tok * D + idx), pb = *(const u32x2*)(Y + (size_t)NTOK * D + (size_t)tok * D + idx);
            const f32x4 ya = (f32x4){bflo(pa.x), bfhi(pa.x), bflo(pa.y), bfhi(pa.y)}, yb = (f32x4){bflo(pb.x), bfhi(pb.x), bflo(pb.y), bfhi(pb.y)};
            const f32x4 gt = *(const f32x4*)(MOD + (1 * 3 + cond) * 3072 + 2048 + idx);
            xv[i] = x1 + gt * (ya + yb);
            ss += xv[i][0] * xv[i][0] + xv[i][1] * xv[i][1] + xv[i][2] * xv[i][2] + xv[i][3] * xv[i][3]; }
        ss = wave_sum(ss);
        const float rstd = rsqrtf(ss * (1.f / 1024.f) + 1e-6f);
#pragma unroll
        for (int i = 0; i < 4; ++i) { const int idx = i * 256 + lane * 4;
            const f32x4 g = *(const f32x4*)(p.in[9] + idx);
            f32x4 o;
#pragma unroll
            for (int j = 0; j < 4; ++j) o[j] = xv[i][j] * rstd * g[j];
            *(f32x4*)(p.out + (size_t)tok * D + idx) = o; }
    }
}


#define XB_TMO      128
#define XB_XCNT(j)  (256  + 64 * (j))
#define XB_XSUB(j)  (1280 + 64 * (j))
#define XB_XGEN(j)  (2304 + 64 * (j))
#define XB_TOP      3328
#define XB_TOPGEN   3392
#define XCD_BAR_WORDS 3456
#define XB_SPIN_CAP (1u << 18)

__device__ __forceinline__ unsigned xb_ld(unsigned* p)              { return __hip_atomic_load(p, __ATOMIC_RELAXED, __HIP_MEMORY_SCOPE_AGENT); }
__device__ __forceinline__ unsigned xb_add(unsigned* p, unsigned v) { return __hip_atomic_fetch_add(p, v, __ATOMIC_RELAXED, __HIP_MEMORY_SCOPE_AGENT); }
__device__ __forceinline__ unsigned xb_xcc_id() { return (unsigned)__builtin_amdgcn_s_getreg((3 << 11) | 20) & 0xFu; }
#define XB_SPIN(cond, bar) do { unsigned _sp = 0; while (cond) { __builtin_amdgcn_s_sleep(1); \
    if ((++_sp & 255u) == 0u) { if (xb_ld(&(bar)[XB_TMO])) break; if (_sp > XB_SPIN_CAP) { atomicAdd(&(bar)[XB_TMO], 1u); break; } } } } while (0)

struct XcdBarrier {
    unsigned* bar; unsigned x;
    volatile LAS unsigned* st;
};

__device__ __forceinline__ XcdBarrier xcd_barrier_post(unsigned* bar, volatile LAS unsigned* st) {
    XcdBarrier b; b.bar = bar; b.x = xb_xcc_id(); b.st = st;
    if (threadIdx.x == 0) (void)xb_add(&bar[XB_XCNT(b.x)], 1u);
    return b;
}
__device__ __forceinline__ void xcd_barrier_complete(unsigned* bar, unsigned x, unsigned& nloc, unsigned& nx) {
    const unsigned G = gridDim.x * gridDim.y * gridDim.z;
    unsigned sum, cnt, mine, sp = 0u;
    for (;;) {
        sum = 0u; cnt = 0u; mine = 0u;
#pragma unroll
        for (unsigned j = 0; j < 16; ++j) { const unsigned c = xb_ld(&bar[XB_XCNT(j)]); sum += c; cnt += (c > 0u) ? 1u : 0u; mine = (j == x) ? c : mine; }
        if (sum == G) break;
        __builtin_amdgcn_s_sleep(1);
        if ((++sp & 255u) == 0u) { if (xb_ld(&bar[XB_TMO])) break; if (sp > XB_SPIN_CAP) { atomicAdd(&bar[XB_TMO], 1u); break; } }
    }
    nloc = mine > 0u ? mine : 1u; nx = cnt > 0u ? cnt : 1u;
}

__device__ __forceinline__ void xcd_barrier(const XcdBarrier& b) {
    asm volatile("s_waitcnt vmcnt(0)" ::: "memory");
    __syncthreads();
    if (threadIdx.x == 0) {
        unsigned* bar = b.bar;
        __builtin_amdgcn_s_waitcnt(0);
        unsigned nloc = b.st[0], nx = b.st[1];
        if (nloc == 0u) { xcd_barrier_complete(bar, b.x, nloc, nx); b.st[0] = nloc; b.st[1] = nx; }
        const unsigned old = xb_add(&bar[XB_XSUB(b.x)], 1u);
        const unsigned gen = old / nloc;
        if (old + 1u == (gen + 1u) * nloc) {
            __builtin_amdgcn_fence(__ATOMIC_RELEASE, "agent");
            asm volatile("s_waitcnt vmcnt(0)" ::: "memory");
            const unsigned og = xb_add(&bar[XB_TOP], 1u);
            const unsigned tg = og / nx;
            if (og + 1u == (tg + 1u) * nx) xb_add(&bar[XB_TOPGEN], 1u);
            else XB_SPIN(xb_ld(&bar[XB_TOPGEN]) == tg, bar);
            __builtin_amdgcn_fence(__ATOMIC_ACQUIRE, "agent");
            xb_add(&bar[XB_XGEN(b.x)], 1u);
            asm volatile("s_waitcnt vmcnt(0)" ::: "memory");
        } else {
            XB_SPIN(xb_ld(&bar[XB_XGEN(b.x)]) == gen, bar);
            __builtin_amdgcn_fence(__ATOMIC_ACQUIRE, "agent");
            asm volatile("s_waitcnt vmcnt(0)" ::: "memory");
        }
    }
    __syncthreads();
}


constexpr int NPHASE = 14;
__global__ void __launch_bounds__(NTHR, 2) fwd_megakernel(Params p) {
    extern __shared__ __attribute__((aligned(16))) unsigned char smem[];
    float* ldsf = (float*)smem;
    LAS unsigned char* ldsl = (LAS unsigned char*)smem;
    unsigned char* ws = p.ws;
    volatile LAS unsigned* xst = (volatile LAS unsigned*)(ldsl + LDS_MAIN + 16);
    if (threadIdx.x == 0) { xst[0] = 0u; xst[1] = 0u; }
    __syncthreads();
    const XcdBarrier xbar = xcd_barrier_post((unsigned*)(ws + WS_BAR), xst);
    if (p.ph_lo < 0) cg::this_grid().sync();
#ifndef DUP_PHASE
#define DUP_PHASE -1
#endif
#define PHASE(n) if (p.ph_lo <= (n) && (n) < p.ph_hi && ((n) == p.ph_lo || (xcd_barrier(xbar), true))) for (int rep = 0; rep < ((n) == DUP_PHASE ? 2 : 1); ++rep, ((n) == DUP_PHASE ? (xcd_barrier(xbar), 0) : 0))
    PHASE(0) phase_prologue(p, ldsf);
    PHASE(1) phase_h(p, 0, ldsf);
    PHASE(2) { pg8::Gemm g{(const bf16_t*)(ws + WS_H), (const bf16_t*)(ws + WS_BT0), NTOK, 8192, 1024, 1024, 1}; pg8::Order S; S.init(NTOK, 8192, 1, gridDim.x, blockIdx.x);
               pg8::EpiBf16 E{(bf16_t*)(ws + WS_P), N0, 0}; pg8::gemm_phase(ldsl, g, S, E); }
    PHASE(3) phase_mix0(p, ldsf, rep);
    PHASE(4) { phase_wkv_fix(p, ldsf); phase_late_weights(p, ldsf); }
    PHASE(5) phase_wkv_post(p);
    PHASE(6) { pg8::Gemm g{(const bf16_t*)(ws + WS_OC), (const bf16_t*)(ws + WS_WT0O), NTOK, 1024, 1024, 2048, 2}; pg8::Order S; S.init(NTOK, 1024, 2, gridDim.x, blockIdx.x);
               pg8::EpiBf16 E{(bf16_t*)(ws + WS_P), 1024, (size_t)NTOK * 1024}; pg8::gemm_phase(ldsl, g, S, E); }
    PHASE(7) phase_h(p, 1, ldsf);
    PHASE(8) { pg8::Gemm g{(const bf16_t*)(ws + WS_H), (const bf16_t*)(ws + WS_BT1), NTOK, N1, 1024, 1024, 1}; pg8::Order S; S.init(NTOK, N1, 1, gridDim.x, blockIdx.x);
               pg8::EpiBf16 E{(bf16_t*)(ws + WS_P), N1, 0}; pg8::gemm_phase(ldsl, g, S, E); }
    PHASE(9) phase_gla_a(p, ldsf);
    PHASE(10) phase_gla_b(p, ldsf, rep);
    PHASE(11) phase_gla_post(p);
    PHASE(12) { pg8::Gemm g{(const bf16_t*)(ws + WS_OC), (const bf16_t*)(ws + WS_WT1O), NTOK, 1024, 512, 1024, 2}; pg8::Order S; S.init(NTOK, 1024, 2, gridDim.x, blockIdx.x);
                pg8::EpiBf16 E{(bf16_t*)(ws + WS_P2), 1024, (size_t)NTOK * 1024}; pg8::gemm_phase(ldsl, g, S, E); }
    PHASE(13) phase_final(p);
}

extern "C" void kernel_launch(void* const* d_in, const int* in_sizes, int n_in, void* d_out, int out_size, void* d_ws, size_t ws_size, hipStream_t stream) {
    static int grid = 0;
    if (grid == 0) {
        if (n_in != 30 || ws_size < WS_END) { fprintf(stderr, "kernel_launch: unexpected n_in %d / ws_size %zu (need %zu)\n", n_in, ws_size, (size_t)WS_END); grid = -1; return; }
        int dev = 0, cus = 0, per_cu = 0;
        hipGetDevice(&dev);
        hipDeviceGetAttribute(&cus, hipDeviceAttributeMultiprocessorCount, dev);
        hipFuncSetAttribute((const void*)fwd_megakernel, hipFuncAttributeMaxDynamicSharedMemorySize, LDS_BYTES);
        hipOccupancyMaxActiveBlocksPerMultiprocessor(&per_cu, (const void*)fwd_megakernel, NTHR, LDS_BYTES);
        if (per_cu < 1) { fprintf(stderr, "kernel_launch: occupancy query returned %d\n", per_cu); per_cu = 1; }
        grid = cus * per_cu;
        (void)hipGetLastError();
    }
    if (grid < 0) return;
    static_assert(XCD_BAR_WORDS * 4 <= 14336, "barrier words overlap the queue counters");
    hipMemsetAsync((char*)d_ws + WS_BAR, 0, 14336 + 256, stream);
    Params p{};
    for (int i = 0; i < 30; ++i) p.in[i] = (const float*)d_in[i];
    p.out = (float*)d_out; p.ws = (unsigned char*)d_ws;
#if MULTI_LAUNCH
    for (int ph = 0; ph < NPHASE; ++ph) { p.ph_lo = ph; p.ph_hi = ph + 1; hipLaunchKernelGGL(fwd_megakernel, dim3(grid), dim3(NTHR), LDS_BYTES, stream, p); }
#else
    p.ph_lo = 0; p.ph_hi = NPHASE;
    void* args[] = {&p};
    hipError_t e = hipLaunchCooperativeKernel((const void*)fwd_megakernel, dim3(grid), dim3(NTHR), args, LDS_BYTES, stream);
    if (e != hipSuccess) fprintf(stderr, "cooperative launch failed: %s (grid %d)\n", hipGetErrorString(e), grid);
#endif
}
```

```cpp
#include <hip/hip_runtime.h>
#include <hip/hip_cooperative_groups.h>
#include <cstdio>
namespace cg = cooperative_groups;

#define LAS __attribute__((address_space(3)))
typedef unsigned short bf16_t;
typedef short bf16x8 __attribute__((ext_vector_type(8)));
typedef float f32x4 __attribute__((ext_vector_type(4)));
typedef unsigned u32x4 __attribute__((ext_vector_type(4)));
typedef unsigned u32x2 __attribute__((ext_vector_type(2)));

#ifndef MULTI_LAUNCH
#define MULTI_LAUNCH 0
#endif

constexpr int D = 1024, NTOK = 8192, NPTOK = 4096;
constexpr int N0 = 8448;
constexpr int N1 = 3328;
constexpr int NTHR = 512;
constexpr int LDS_MAIN = 139264;
constexpr int LDS_BYTES = LDS_MAIN + 256;

constexpr size_t MB = 1024 * 1024;
constexpr size_t WS_CTL = 0x1A0000 + 14336;
constexpr size_t WS_MOD = 4096;
constexpr size_t WS_BON = WS_MOD + 2 * 3 * 3072 * 4;
constexpr size_t WS_BAR = 0x1A0000;
constexpr size_t WS_BT0 = 2 * MB;
constexpr size_t WS_WT0O = WS_BT0 + (size_t)N0 * 1024 * 2;
constexpr size_t WS_BT1 = WS_WT0O + (size_t)1024 * 2048 * 2;
constexpr size_t WS_WT1O = WS_BT1 + (size_t)N1 * 1024 * 2;
constexpr size_t WS_H = WS_WT1O + (size_t)1024 * 1024 * 2;
constexpr size_t WS_OC = WS_H + (size_t)NTOK * 1024 * 2;
constexpr size_t WS_X1 = WS_OC + (size_t)NTOK * 2048 * 2;
constexpr size_t WS_P = WS_X1 + (size_t)NTOK * 1024 * 4;
constexpr size_t WS_P2 = WS_P + 64 * MB;
constexpr size_t WS_END = WS_P + (size_t)NTOK * N0 * 2;

struct Params {
    const float* in[30];
    float* out;
    unsigned char* ws;
    int ph_lo, ph_hi;
};

__device__ __forceinline__ float bf2f(bf16_t h) { return __uint_as_float(((unsigned)h) << 16); }
__device__ __forceinline__ bf16_t f2bf(float f) { unsigned u = __float_as_uint(f); u += 0x7FFFu + ((u >> 16) & 1u); return (bf16_t)(u >> 16); }
__device__ __forceinline__ unsigned pack2(float lo, float hi) { return (unsigned)f2bf(lo) | ((unsigned)f2bf(hi) << 16); }
__device__ __forceinline__ float bflo(unsigned w) { return __uint_as_float(w << 16); }
__device__ __forceinline__ float bfhi(unsigned w) { return __uint_as_float(w & 0xFFFF0000u); }
__device__ __forceinline__ float fexp(float x) { return __builtin_amdgcn_exp2f(x * 1.44269504f); }
__device__ __forceinline__ float flog(float x) { return __builtin_amdgcn_logf(x) * 0.69314718f; }
__device__ __forceinline__ float silu(float x) { return x * __builtin_amdgcn_rcpf(1.f + fexp(-x)); }
__device__ __forceinline__ float wave_sum(float v) {
#pragma unroll
    for (int m = 32; m >= 1; m >>= 1) v += __shfl_xor(v, m, 64);
    return v;
}

typedef float f32x2_t __attribute__((ext_vector_type(2)));
typedef __bf16 bf16x2_t __attribute__((ext_vector_type(2)));
__device__ __forceinline__ unsigned pk2(float lo, float hi) { const f32x2_t v = {lo, hi}; return __builtin_bit_cast(unsigned, __builtin_convertvector(v, bf16x2_t)); }
__device__ __forceinline__ bf16_t f2bf_hw(float f) { return __builtin_bit_cast(bf16_t, (__bf16)f); }

__device__ __forceinline__ void lds_barrier() { asm volatile("s_waitcnt lgkmcnt(0)" ::: "memory"); __builtin_amdgcn_s_barrier(); asm volatile("" ::: "memory"); }

namespace pg8 {
constexpr int BM = 256, BK = 64, HALF = 128, HTB = HALF * BK * 2, NXCD = 8, WGM = 8;
__device__ __forceinline__ int lds_byte(int r, int c) { const int st = (r >> 4) * 2 + (c >> 5), rr = r & 15, cc = c & 31, ob = rr * 64 + cc * 2; return st * 1024 + (ob ^ (((ob >> 9) & 1) << 5)); }
__device__ __forceinline__ void stage_rc(int b, int& R, int& C) { const int st = b / 1024, sb = b % 1024, swz = sb ^ (((sb >> 9) & 1) << 5); R = (st >> 1) * 16 + swz / 64; C = (st & 1) * 32 + (swz % 64) / 2; }
__device__ __forceinline__ int perm32(int rho) { const int n = rho >> 4, i = rho & 15; return 8 * (i >> 2) + 4 * n + (i & 3); }

struct Unit { int pm, pn, ks; };
struct Gemm { const bf16_t* A; const bf16_t* Bt; int M, N, K, ld, KS; };

struct Order {
    int nM, nN, nNr, nwg, G, c;
    __device__ void init(int M, int N, int KS, int G_, int c_) { nM = M / BM; nNr = N / BM; nN = nNr * KS; nwg = nM * nN; G = G_; c = c_; }
    __device__ bool next(int i, Unit& u) const {
        const long L = (long)i * G + c; if (L >= nwg) return false;
        int wgid = (int)L; { const int q = nwg / NXCD, r = nwg % NXCD, xcd = wgid % NXCD, off = wgid / NXCD; wgid = (xcd < r ? xcd * (q + 1) : r * (q + 1) + (xcd - r) * q) + off; }
        const int nig = WGM * nN, gid = wgid / nig, fm = gid * WGM, gsz = (nM - fm) < WGM ? (nM - fm) : WGM;
        u.pm = fm + ((wgid % nig) % gsz); const int pn = (wgid % nig) / gsz; u.pn = pn % nNr; u.ks = pn / nNr; return true;
    }
};

__device__ __forceinline__ unsigned cvt_pk_bf16(float lo, float hi) { unsigned r; asm volatile("v_cvt_pk_bf16_f32 %0, %1, %2" : "=v"(r) : "v"(lo), "v"(hi)); return r; }

struct EpiF32 {
    static constexpr bool PERM = false;
    float* C; int ldc; size_t ks_stride;
    __device__ __forceinline__ void operator()(const f32x4 (&acc)[2][2][4][2], const Unit& u, int wr, int wc, int fr, int fq) const {
        const int row0 = u.pm * BM + wr * 64 + fr, col0 = u.pn * BM + wc * 32 + 4 * fq;
        float* Cb = C + (size_t)u.ks * ks_stride;
#pragma unroll
        for (int ai = 0; ai < 2; ++ai)
#pragma unroll
            for (int m = 0; m < 4; ++m) { float* rowp = Cb + (size_t)(row0 + ai * HALF + m * 16) * ldc + col0;
#pragma unroll
                for (int bj = 0; bj < 2; ++bj)
#pragma unroll
                    for (int n = 0; n < 2; ++n) *(f32x4*)(rowp + bj * HALF + n * 16) = acc[ai][bj][m][n]; }
    }
};
struct EpiBf16 {
    static constexpr bool PERM = true;
    bf16_t* O; int ldc; size_t ks_stride;
    __device__ __forceinline__ void operator()(const f32x4 (&acc)[2][2][4][2], const Unit& u, int wr, int wc, int fr, int fq) const {
        const int row0 = u.pm * BM + wr * 64 + fr; const int col0 = u.pn * BM + wc * 32 + 8 * fq;
        bf16_t* Ob = O + (size_t)u.ks * ks_stride;
#pragma unroll
        for (int ai = 0; ai < 2; ++ai)
#pragma unroll
            for (int m = 0; m < 4; ++m) { bf16_t* rowp = Ob + (size_t)(row0 + ai * HALF + m * 16) * ldc + col0;
#pragma unroll
                for (int bj = 0; bj < 2; ++bj) { const f32x4 v0 = acc[ai][bj][m][0], v1 = acc[ai][bj][m][1];
                    u32x4 w; w.x = cvt_pk_bf16(v0[0], v0[1]); w.y = cvt_pk_bf16(v0[2], v0[3]); w.z = cvt_pk_bf16(v1[0], v1[1]); w.w = cvt_pk_bf16(v1[2], v1[3]);
                    *(u32x4*)(rowp + bj * HALF) = w; } }
    }
};

template <class Epi>
__device__ __forceinline__ void gemm_phase(LAS unsigned char* lds, const Gemm g, const Order& S, const Epi& E) {
    const int tid = threadIdx.x, wid = __builtin_amdgcn_readfirstlane(tid >> 6), lane = tid & 63, wr = wid >> 2, wc = wid & 3, fr = lane & 15, fq = lane >> 4;
    const int K = g.K, nt = K / BK, ld = g.ld;
    unsigned voffA[2], voffB[2];
#pragma unroll
    for (int i = 0; i < 2; ++i) { int R, C; stage_rc(tid * 16 + i * 8192, R, C); const int Rb = Epi::PERM ? ((R & ~31) + perm32(R & 31)) : R;
        voffA[i] = (unsigned)(R * ld + C) * 2u; voffB[i] = (unsigned)(Rb * ld + C) * 2u; }
    const size_t kstep = (size_t)(BK * 2);
    const size_t hstep = (size_t)HALF * ld * 2;
    const size_t tstep = 2 * hstep;
    const size_t ksb = (size_t)K * 2;
    const unsigned ldsw = (unsigned)wid * 1024u;
    const int aoff = lds_byte(wr * 64 + fr, fq * 8), boff = lds_byte(wc * 32 + fr, fq * 8);
#define PG8_SA(b, h) (((b) * 2 + (h)) * HTB)
#define PG8_SB(b, h) ((4 + (b) * 2 + (h)) * HTB)
#define PG8_STAGE(bufoff, gbase, voff) do { _Pragma("unroll") for (int _i = 0; _i < 2; ++_i) \
        __builtin_amdgcn_global_load_lds((const unsigned*)((const char*)(gbase) + (voff)[_i]), (LAS unsigned*)(lds + (bufoff) + ldsw + _i * 8192), 16, 0, 0); } while (0)
#define PG8_LDA(dst, b, h) do { _Pragma("unroll") for (int m = 0; m < 4; ++m) _Pragma("unroll") for (int k = 0; k < 2; ++k) dst[m][k] = *(const LAS bf16x8*)(lds + PG8_SA(b, h) + aoff + m * 2048 + k * 1024); } while (0)
#define PG8_LDB(dst, b, h) do { _Pragma("unroll") for (int n = 0; n < 2; ++n) _Pragma("unroll") for (int k = 0; k < 2; ++k) dst[n][k] = *(const LAS bf16x8*)(lds + PG8_SB(b, h) + boff + n * 2048 + k * 1024); } while (0)
#define PG8_MMA(ai, bj, At, Bt) do { __builtin_amdgcn_s_setprio(1); _Pragma("unroll") for (int m = 0; m < 4; ++m) _Pragma("unroll") for (int n = 0; n < 2; ++n) _Pragma("unroll") for (int k = 0; k < 2; ++k) \
        acc[ai][bj][m][n] = __builtin_amdgcn_mfma_f32_16x16x32_bf16(Bt[n][k], At[m][k], acc[ai][bj][m][n], 0, 0, 0); __builtin_amdgcn_s_setprio(0); } while (0)
#define PG8_WAIT_V(n) asm volatile("s_waitcnt vmcnt(" #n ")" ::: "memory")
#define PG8_WAIT_L(n) asm volatile("s_waitcnt lgkmcnt(" #n ")" ::: "memory")
#define PG8_BAR __builtin_amdgcn_s_barrier()
#define PG8_SCHED __builtin_amdgcn_sched_barrier(0)
    Unit cur, nxt; int ui = 0;
    if (!S.next(0, cur)) return;
    f32x4 acc[2][2][4][2];
#pragma unroll
    for (int a = 0; a < 2; ++a)
#pragma unroll
        for (int b = 0; b < 2; ++b)
#pragma unroll
            for (int m = 0; m < 4; ++m)
#pragma unroll
                for (int n = 0; n < 2; ++n) acc[a][b][m][n] = (f32x4){0.f, 0.f, 0.f, 0.f};
    bf16x8 At[4][2], B0[2][2], B1[2][2];
    const char* cA = (const char*)g.A + (size_t)cur.pm * tstep + (size_t)cur.ks * ksb; const char* cB = (const char*)g.Bt + (size_t)cur.pn * tstep + (size_t)cur.ks * ksb;
    PG8_STAGE(PG8_SB(0, 0), cB, voffB); PG8_STAGE(PG8_SA(0, 0), cA, voffA); PG8_STAGE(PG8_SB(0, 1), cB + hstep, voffB); PG8_STAGE(PG8_SA(0, 1), cA + hstep, voffA);
    if (wr == 1) PG8_BAR;
    PG8_WAIT_V(4); PG8_BAR;
    PG8_STAGE(PG8_SB(1, 0), cB + kstep, voffB); PG8_STAGE(PG8_SA(1, 0), cA + kstep, voffA); PG8_STAGE(PG8_SB(1, 1), cB + hstep + kstep, voffB);
    PG8_WAIT_V(6); PG8_BAR;
    for (;;) {
        const bool has_next = S.next(ui + 1, nxt);
        const char* nA = has_next ? (const char*)g.A + (size_t)nxt.pm * tstep + (size_t)nxt.ks * ksb : cA; const char* nB = has_next ? (const char*)g.Bt + (size_t)nxt.pn * tstep + (size_t)nxt.ks * ksb : cB;
        for (int t = 0; t < nt; t += 2) {
            const bool last = (t == nt - 2);
            const char* a1 = cA + (size_t)(t + 1) * kstep;
            const char* a2 = last ? nA : cA + (size_t)(t + 2) * kstep; const char* b2 = last ? nB : cB + (size_t)(t + 2) * kstep;
            const char* a3 = a2 + kstep; const char* b3 = b2 + kstep;
            PG8_LDB(B0, 0, 0); PG8_SCHED; PG8_LDA(At, 0, 0); PG8_STAGE(PG8_SA(1, 1), a1 + hstep, voffA);
            PG8_WAIT_L(8); PG8_BAR; PG8_WAIT_L(0); PG8_MMA(0, 0, At, B0); PG8_BAR; PG8_SCHED;
            PG8_LDB(B1, 0, 1); PG8_STAGE(PG8_SB(0, 0), b2, voffB);
            PG8_BAR; PG8_WAIT_L(0); PG8_MMA(0, 1, At, B1); PG8_BAR;
            PG8_LDA(At, 0, 1); PG8_STAGE(PG8_SA(0, 0), a2, voffA);
            PG8_BAR; PG8_WAIT_L(0); PG8_MMA(1, 0, At, B0); PG8_BAR; PG8_SCHED;
            PG8_STAGE(PG8_SB(0, 1), b2 + hstep, voffB);
            PG8_WAIT_V(6); PG8_BAR; PG8_MMA(1, 1, At, B1); PG8_BAR;
            PG8_LDB(B0, 1, 0); PG8_SCHED; PG8_LDA(At, 1, 0); PG8_STAGE(PG8_SA(0, 1), a2 + hstep, voffA);
            PG8_WAIT_L(8); PG8_BAR; PG8_WAIT_L(0); PG8_MMA(0, 0, At, B0); PG8_BAR; PG8_SCHED;
            PG8_LDB(B1, 1, 1); PG8_STAGE(PG8_SB(1, 0), b3, voffB);
            PG8_BAR; PG8_WAIT_L(0); PG8_MMA(0, 1, At, B1); PG8_BAR;
            PG8_LDA(At, 1, 1); PG8_STAGE(PG8_SA(1, 0), a3, voffA);
            PG8_BAR; PG8_WAIT_L(0); PG8_MMA(1, 0, At, B0); PG8_BAR; PG8_SCHED;
            PG8_STAGE(PG8_SB(1, 1), b3 + hstep, voffB);
            PG8_WAIT_V(6); PG8_BAR; PG8_MMA(1, 1, At, B1); PG8_BAR;
        }
        E(acc, cur, wr, wc, fr, fq);
        if (!has_next) break;
#pragma unroll
        for (int a = 0; a < 2; ++a)
#pragma unroll
            for (int b = 0; b < 2; ++b)
#pragma unroll
                for (int m = 0; m < 4; ++m)
#pragma unroll
                    for (int n = 0; n < 2; ++n) acc[a][b][m][n] = (f32x4){0.f, 0.f, 0.f, 0.f};
        cur = nxt; cA = nA; cB = nB; ++ui;
    }
    PG8_WAIT_V(0);
    if (wr == 0) PG8_BAR;
    PG8_BAR;
#undef PG8_SA
#undef PG8_SB
#undef PG8_STAGE
#undef PG8_LDA
#undef PG8_LDB
#undef PG8_MMA
#undef PG8_WAIT_V
#undef PG8_WAIT_L
#undef PG8_BAR
#undef PG8_SCHED
}
}

struct TJob { const float* src; bf16_t* dst; int ldsrc, N, lddst, drow0, k0, n0; };
__device__ __forceinline__ TJob tjob_of(const Params& p, int t) {
    unsigned char* ws = p.ws;
    bf16_t* BT0 = (bf16_t*)(ws + WS_BT0); bf16_t* WT0O = (bf16_t*)(ws + WS_WT0O); bf16_t* BT1 = (bf16_t*)(ws + WS_BT1); bf16_t* WT1O = (bf16_t*)(ws + WS_WT1O);
    TJob j; int nnt;
    if (t < 1024) { j.src = p.in[10]; j.ldsrc = 8192; j.N = 8192; j.dst = BT0; j.lddst = 1024; j.drow0 = 0; nnt = 64; }
    else if (t < 1024 + 32) { t -= 1024; const int z = t >> 4; t &= 15; j.src = p.in[14] + (size_t)z * 1024 * 64; j.ldsrc = 64; j.N = 64; j.dst = BT0; j.lddst = 1024; j.drow0 = 8192 + z * 64; nnt = 1; }
    else if (t < 1024 + 64) { t -= 1024 + 32; const int z = t >> 4; t &= 15; j.src = p.in[17] + (size_t)z * 1024 * 64; j.ldsrc = 64; j.N = 64; j.dst = BT0; j.lddst = 1024; j.drow0 = 8320 + z * 64; nnt = 1; }
    else if (t < 1088 + 256) { t -= 1088; j.src = p.in[11]; j.ldsrc = 1024; j.N = 1024; j.dst = WT0O; j.lddst = 2048; j.drow0 = 0; nnt = 8; }
    else if (t < 1344 + 384) { t -= 1344; j.src = p.in[24]; j.ldsrc = 3072; j.N = 3072; j.dst = BT1; j.lddst = 1024; j.drow0 = 0; nnt = 24; }
    else if (t < 1728 + 32) { t -= 1728; const int z = t >> 4; t &= 15; j.src = p.in[26] + (size_t)z * 1024 * 16; j.ldsrc = 16; j.N = 16; j.dst = BT1; j.lddst = 1024; j.drow0 = 3072 + z * 16; nnt = 1; }
    else { t -= 1760; j.src = p.in[25]; j.ldsrc = 1024; j.N = 1024; j.dst = WT1O; j.lddst = 1024; j.drow0 = 0; nnt = 8; }
    j.k0 = (t / nnt) * 64; j.n0 = (t % nnt) * 128; return j;
}
__device__ __forceinline__ void tjob_load(const TJob& j, f32x4 (&r)[4]) {
    const int tid = threadIdx.x, c4 = (tid & 31) * 4;
#pragma unroll
    for (int i = 0; i < 4; ++i) { const int kk = (tid >> 5) + 16 * i;
        r[i] = (j.n0 + c4 < j.N) ? *(const f32x4*)(j.src + (size_t)(j.k0 + kk) * j.ldsrc + j.n0 + c4) : (f32x4){0.f, 0.f, 0.f, 0.f}; }
}

__device__ void transpose_jobs(const Params& p, float* lds, int t_lo, int t_hi, int rot) {
    const int tid = threadIdx.x;
    float* tile = lds;
    int it = t_lo + (int)((blockIdx.x + (unsigned)rot) % gridDim.x);
    f32x4 cur[4], nxt[4];
    TJob jc = tjob_of(p, it < t_hi ? it : t_lo);
    if (it < t_hi) tjob_load(jc, cur);
    for (; it < t_hi; it += gridDim.x) {
        const int c4 = (tid & 31) * 4;
#pragma unroll
        for (int i = 0; i < 4; ++i) { const int kk = (tid >> 5) + 16 * i; tile[kk * 129 + c4] = cur[i][0]; tile[kk * 129 + c4 + 1] = cur[i][1]; tile[kk * 129 + c4 + 2] = cur[i][2]; tile[kk * 129 + c4 + 3] = cur[i][3]; }
        const int itn = it + gridDim.x;
        const TJob jn = tjob_of(p, itn < t_hi ? itn : t_lo);
        if (itn < t_hi) tjob_load(jn, nxt);
        __syncthreads();
#pragma unroll
        for (int q = 0; q < 2; ++q) { const int idx = tid + q * NTHR; const int nn = idx >> 3, k8 = (idx & 7) * 8;
            if (jc.n0 + nn < jc.N) { u32x4 o; o.x = pk2(tile[(k8 + 0) * 129 + nn], tile[(k8 + 1) * 129 + nn]); o.y = pk2(tile[(k8 + 2) * 129 + nn], tile[(k8 + 3) * 129 + nn]);
                o.z = pk2(tile[(k8 + 4) * 129 + nn], tile[(k8 + 5) * 129 + nn]); o.w = pk2(tile[(k8 + 6) * 129 + nn], tile[(k8 + 7) * 129 + nn]);
                *(u32x4*)(jc.dst + (size_t)(jc.drow0 + jc.n0 + nn) * jc.lddst + jc.k0 + k8) = o; } }
        __syncthreads();
        jc = jn;
#pragma unroll
        for (int i = 0; i < 4; ++i) cur[i] = nxt[i];
    }
}

__device__ void phase_prologue(const Params& p, float* lds) {
    const int tid = threadIdx.x;
    unsigned char* ws = p.ws;
    bf16_t* BT1 = (bf16_t*)(ws + WS_BT1);
    float* MOD = (float*)(ws + WS_MOD);
    constexpr int NGEMV = 192;
    for (int it = blockIdx.x; it < NGEMV; it += gridDim.x) {
        const int l = it / 96, j0 = (it % 96) * 32;
        float* sc = lds;
        float* red = lds + 3072;
        for (int i = tid; i < 3072; i += NTHR) { const int cnd = i >> 10, k = i & 1023; const float v = cnd == 0 ? p.in[5][k] : p.in[4][(cnd - 1) * 1024 + k]; sc[i] = silu(v); }
        __syncthreads();
        const int col = tid & 31, ksp = tid >> 5;
        float a0 = 0.f, a1 = 0.f, a2 = 0.f;
        const float* w = p.in[7] + (size_t)l * 1024 * 3072 + j0 + col;
#pragma unroll 16
        for (int k = ksp * 64; k < ksp * 64 + 64; ++k) { const float wv = w[(size_t)k * 3072]; a0 += sc[k] * wv; a1 += sc[1024 + k] * wv; a2 += sc[2048 + k] * wv; }
        red[(ksp * 3 + 0) * 32 + col] = a0; red[(ksp * 3 + 1) * 32 + col] = a1; red[(ksp * 3 + 2) * 32 + col] = a2;
        __syncthreads();
        if (tid < 96) { const int cnd = tid >> 5, cc = tid & 31; float s = 0.f; for (int q = 0; q < 16; ++q) s += red[(q * 3 + cnd) * 32 + cc];
            MOD[(l * 3 + cnd) * 3072 + j0 + cc] = s + p.in[8][l * 3072 + j0 + cc]; }
        __syncthreads();
    }
    transpose_jobs(p, lds, 0, 1088, 64);
}
__device__ void phase_late_weights(const Params& p, float* lds) {
    const int tid = threadIdx.x;
    bf16_t* BT1 = (bf16_t*)(p.ws + WS_BT1);
    transpose_jobs(p, lds, 1088, 1888, 0);
    { u32x4* z = (u32x4*)(BT1 + (size_t)3104 * 1024); const int n = 224 * 1024 * 2 / 16;
      for (int i = blockIdx.x * NTHR + tid; i < n; i += gridDim.x * NTHR) z[i] = (u32x4){0u, 0u, 0u, 0u}; }
}

__device__ void phase_h(const Params& p, int layer, float* ldsf) {
    const int tid = threadIdx.x, wave = __builtin_amdgcn_readfirstlane(tid >> 6), lane = tid & 63, fr = lane & 15, fq = lane >> 4;
    unsigned char* ws = p.ws;
    const float* MOD = (const float*)(ws + WS_MOD);
    bf16_t* H = (bf16_t*)(ws + WS_H);
    float* X1 = (float*)(ws + WS_X1);
    const bf16_t* Y = (const bf16_t*)(ws + WS_P);
    bf16_t* HL = (bf16_t*)ldsf;
    for (int tb = blockIdx.x * 32; tb < NTOK; tb += gridDim.x * 32) {
#pragma unroll 1
        for (int q = 0; q < 4; ++q) { const int tl = wave * 4 + q, tok = tb + tl;
            const float* xr = tok < NPTOK ? p.in[0] + (size_t)tok * D : p.in[1] + (size_t)(tok - NPTOK) * D;
            const int cond = tok < NPTOK ? 0 : 1 + ((tok - NPTOK) >> 11);
            f32x4 xv[4]; float ss = 0.f;
#pragma unroll
            for (int i = 0; i < 4; ++i) { const int idx = i * 256 + lane * 4; xv[i] = *(const f32x4*)(xr + idx);
                if (layer == 1) { const u32x2 pa = *(const u32x2*)(Y + (size_t)tok * D + idx), pb = *(const u32x2*)(Y + (size_t)NTOK * D + (size_t)tok * D + idx);
                    const f32x4 ya = (f32x4){bflo(pa.x), bfhi(pa.x), bflo(pa.y), bfhi(pa.y)}, yb = (f32x4){bflo(pb.x), bfhi(pb.x), bflo(pb.y), bfhi(pb.y)};
                    const f32x4 gt = *(const f32x4*)(MOD + (0 * 3 + cond) * 3072 + 2048 + idx);
                    xv[i] = xv[i] + gt * (ya + yb); *(f32x4*)(X1 + (size_t)tok * D + idx) = xv[i]; }
                ss += xv[i][0] * xv[i][0] + xv[i][1] * xv[i][1] + xv[i][2] * xv[i][2] + xv[i][3] * xv[i][3]; }
            ss = wave_sum(ss);
            const float rstd = rsqrtf(ss * (1.f / 1024.f) + 1e-6f);
#pragma unroll
            for (int i = 0; i < 4; ++i) { const int idx = i * 256 + lane * 4;
                const f32x4 g = *(const f32x4*)(p.in[6] + layer * D + idx);
                const f32x4 sh = *(const f32x4*)(MOD + (layer * 3 + cond) * 3072 + idx), sc = *(const f32x4*)(MOD + (layer * 3 + cond) * 3072 + 1024 + idx);
                f32x4 h;
#pragma unroll
                for (int j = 0; j < 4; ++j) h[j] = xv[i][j] * rstd * g[j] * (1.f + sc[j]) + sh[j];
                u32x2 w2; w2.x = pk2(h[0], h[1]); w2.y = pk2(h[2], h[3]);
                *(u32x2*)(H + (size_t)tok * D + idx) = w2;
                if (layer == 0) *(u32x2*)(HL + tl * 1032 + idx) = w2; } }
        if (layer == 0) {
            __syncthreads();
            const bf16_t* BL = (const bf16_t*)(ws + WS_BT0) + (size_t)8192 * 1024;
            bf16_t* P = (bf16_t*)(ws + WS_P);
            f32x4 acc[2][2];
#pragma unroll
            for (int mt = 0; mt < 2; ++mt)
#pragma unroll
                for (int n2 = 0; n2 < 2; ++n2) acc[mt][n2] = (f32x4){0.f, 0.f, 0.f, 0.f};
#pragma unroll 16
            for (int ks = 0; ks < 32; ++ks) {
                bf16x8 af[2], bfr[2];
#pragma unroll
                for (int mt = 0; mt < 2; ++mt) af[mt] = *(const bf16x8*)(HL + (mt * 16 + fr) * 1032 + ks * 32 + fq * 8);
#pragma unroll
                for (int n2 = 0; n2 < 2; ++n2) bfr[n2] = *(const bf16x8*)(BL + (size_t)((wave * 2 + n2) * 16 + fr) * 1024 + ks * 32 + fq * 8);
#pragma unroll
                for (int mt = 0; mt < 2; ++mt)
#pragma unroll
                    for (int n2 = 0; n2 < 2; ++n2) acc[mt][n2] = __builtin_amdgcn_mfma_f32_16x16x32_bf16(af[mt], bfr[n2], acc[mt][n2], 0, 0, 0);
            }
#pragma unroll
            for (int mt = 0; mt < 2; ++mt)
#pragma unroll
                for (int n2 = 0; n2 < 2; ++n2)
#pragma unroll
                    for (int jj = 0; jj < 4; ++jj) P[(size_t)(tb + mt * 16 + fq * 4 + jj) * N0 + 8192 + (wave * 2 + n2) * 16 + fr] = f2bf_hw(acc[mt][n2][jj]);
            __syncthreads();
        }
    }
}

__device__ __forceinline__ f32x4 mma_nt(const bf16_t* A, int lda, const bf16_t* B, int ldb, int K, f32x4 acc, int fr, int fq) {
    for (int k0 = 0; k0 < K; k0 += 32) {
        const bf16x8 a = *(const bf16x8*)(A + fr * lda + k0 + fq * 8);
        const bf16x8 b = *(const bf16x8*)(B + fr * ldb + k0 + fq * 8);
        acc = __builtin_amdgcn_mfma_f32_16x16x32_bf16(a, b, acc, 0, 0, 0);
    }
    return acc;
}
__device__ __forceinline__ bf16x8 pack8(float a0, float a1, float a2, float a3, float a4, float a5, float a6, float a7) {
    u32x4 w; w.x = pack2(a0, a1); w.y = pack2(a2, a3); w.z = pack2(a4, a5); w.w = pack2(a6, a7);
    return __builtin_bit_cast(bf16x8, w);
}
__device__ __forceinline__ float dpp_add(float v, float o) { return v + o; }
__device__ __forceinline__ float wave_sum_fast(float v) {
    v += __int_as_float(__builtin_amdgcn_update_dpp(0, __float_as_int(v), 0xB1, 0xF, 0xF, true));
    v += __int_as_float(__builtin_amdgcn_update_dpp(0, __float_as_int(v), 0x4E, 0xF, 0xF, true));
    v += __int_as_float(__builtin_amdgcn_update_dpp(0, __float_as_int(v), 0x141, 0xF, 0xF, true));
    v += __int_as_float(__builtin_amdgcn_update_dpp(0, __float_as_int(v), 0x140, 0xF, 0xF, true));
    v += __shfl_xor(v, 16, 64); v += __shfl_xor(v, 32, 64);
    return v;
}
__device__ __forceinline__ float wave_sum_dpp(float v) {
    v += __int_as_float(__builtin_amdgcn_update_dpp(0, __float_as_int(v), 0xB1, 0xF, 0xF, true));
    v += __int_as_float(__builtin_amdgcn_update_dpp(0, __float_as_int(v), 0x4E, 0xF, 0xF, true));
    v += __int_as_float(__builtin_amdgcn_update_dpp(0, __float_as_int(v), 0x141, 0xF, 0xF, true));
    v += __int_as_float(__builtin_amdgcn_update_dpp(0, __float_as_int(v), 0x140, 0xF, 0xF, true));
    v += __int_as_float(__builtin_amdgcn_update_dpp(0, __float_as_int(v), 0x142, 0xA, 0xF, false));
    v += __int_as_float(__builtin_amdgcn_update_dpp(0, __float_as_int(v), 0x143, 0xC, 0xF, false));
    return __int_as_float(__builtin_amdgcn_readlane(__float_as_int(v), 63));
}
__device__ __forceinline__ float wave_sum_lane63(float v) {
    v += __int_as_float(__builtin_amdgcn_update_dpp(0, __float_as_int(v), 0xB1, 0xF, 0xF, true));
    v += __int_as_float(__builtin_amdgcn_update_dpp(0, __float_as_int(v), 0x4E, 0xF, 0xF, true));
    v += __int_as_float(__builtin_amdgcn_update_dpp(0, __float_as_int(v), 0x141, 0xF, 0xF, true));
    v += __int_as_float(__builtin_amdgcn_update_dpp(0, __float_as_int(v), 0x140, 0xF, 0xF, true));
    v += __int_as_float(__builtin_amdgcn_update_dpp(0, __float_as_int(v), 0x142, 0xA, 0xF, false));
    v += __int_as_float(__builtin_amdgcn_update_dpp(0, __float_as_int(v), 0x143, 0xC, 0xF, false));
    return v;
}
__device__ __forceinline__ float fast_tanh(float x) { const float e = fexp(2.f * x); return 1.f - 2.f * __builtin_amdgcn_rcpf(1.f + e); }
__device__ __forceinline__ bf16x8 pack8h(float a0, float a1, float a2, float a3, float a4, float a5, float a6, float a7) {
    u32x4 w; w.x = pk2(a0, a1); w.y = pk2(a2, a3); w.z = pk2(a4, a5); w.w = pk2(a6, a7);
    return __builtin_bit_cast(bf16x8, w);
}

__device__ void wkv_unit(const Params& p, int u, float* ldsf) {
    const int tid0 = threadIdx.x, lane0 = tid0 & 63, w = __builtin_amdgcn_readfirstlane(tid0 >> 6), fr0 = lane0 & 15, fq0 = lane0 >> 4;
    unsigned char* ws = p.ws;
    unsigned char* lds = (unsigned char*)ldsf;
    const bf16_t* P = (const bf16_t*)(ws + WS_P);
    bf16_t* OD = (bf16_t*)(ws + WS_X1);
    float* BON = (float*)(ws + WS_BON);
    int z, b, hd, sgm, seqT, tok0; bool sample; const int T = 256;
    if (u < 512) { sample = true; z = u >> 8; b = (u >> 7) & 1; hd = (u >> 3) & 15; sgm = u & 7; seqT = 2048; tok0 = NPTOK + b * 2048; }
    else { const int q = u - 512; sample = false; z = q >> 8; b = (q >> 4) & 15; hd = q & 15; sgm = 0; seqT = 256; tok0 = b * 256; }
    const int qbase = sgm * 256;
    bf16_t* RHO = (bf16_t*)(ws + WS_H);
    float* GH = (float*)(ws + WS_BT0);
    bf16_t* TLW = (bf16_t*)(lds + 0);
    bf16_t* TLA = (bf16_t*)(lds + 9216);
    float* HT = (float*)(lds + 18432);
    float* BONL = (float*)(lds + 57344);
    bf16_t* KTr = (bf16_t*)(lds + 20480);
    bf16_t* BTr = (bf16_t*)(lds + 29696);
    bf16_t* KKH = (bf16_t*)(lds + 38912);
    bf16_t* RH = (bf16_t*)(lds + 48128);
    const bf16_t* VS = (const bf16_t*)(lds + 113664 + 2 * 8192);
    bf16_t* TA = (bf16_t*)(lds + 65536);
    bf16_t* NA = (bf16_t*)(lds + 70656);
    float* PC = (float*)(lds + 75776);
    bf16_t* KBm = (bf16_t*)(lds + 76800);
    float* MM = (float*)(lds + 97280);
    float* WA = (float*)(lds + 76800);
    bf16x8 bw[2];
    { const float* W2 = (w >> 2) ? p.in[18] : p.in[15];
#pragma unroll
      for (int ks = 0; ks < 2; ++ks) { float t8[8];
#pragma unroll
        for (int e = 0; e < 8; ++e) t8[e] = W2[(size_t)(z * 64 + ks * 32 + fq0 * 8 + e) * 1024 + hd * 64 + (w & 3) * 16 + fr0];
        bw[ks] = pack8h(t8[0], t8[1], t8[2], t8[3], t8[4], t8[5], t8[6], t8[7]); } }
    f32x4 Sacc[4];
#pragma unroll
    for (int kt = 0; kt < 4; ++kt) Sacc[kt] = (f32x4){0.f, 0.f, 0.f, 0.f};
    if (w >= 4) {
#pragma unroll
        for (int kt = 0; kt < 4; ++kt)
#pragma unroll
            for (int jj = 0; jj < 4; ++jj) Sacc[kt][jj] = (kt * 16 + fq0 * 4 + jj == (w - 4) * 16 + fr0) ? 1.f : 0.f; }
    const int ch = hd * 64 + lane0;
    const float w0c = p.in[13][z * 1024 + ch], a0c = p.in[16][z * 1024 + ch], kkc = p.in[19][ch], kac = p.in[20][ch], rkc = p.in[21][ch];
    bf16_t* RKV = (bf16_t*)(lds + 113664);
    u32x4 tlraw[2], rkvraw[3];
#define WKV_LOAD_RAW(tb_) do { \
        _Pragma("unroll") for (int h_ = 0; h_ < 2; ++h_) { const int idx_ = tid + h_ * NTHR; const int tau_ = idx_ >> 4, sg_ = idx_ & 15; const int t_ = z ? (seqT - 1 - (qbase + (tb_) + tau_)) : (qbase + (tb_) + tau_); \
            tlraw[h_] = *(const u32x4*)(P + (size_t)(tok0 + t_) * N0 + 8192 + (sg_ < 8 ? z * 64 + sg_ * 8 : 128 + z * 64 + (sg_ - 8) * 8)); } \
        { const int tau_ = tid >> 3, sg_ = tid & 7; const int t_ = z ? (seqT - 1 - (qbase + (tb_) + tau_)) : (qbase + (tb_) + tau_); const bf16_t* rp_ = P + (size_t)(tok0 + t_) * N0 + 4096 + hd * 64 + sg_ * 8; \
          rkvraw[0] = *(const u32x4*)rp_; rkvraw[1] = *(const u32x4*)(rp_ + 1024); rkvraw[2] = *(const u32x4*)(rp_ + 2048); } } while (0)
    { const int tid = tid0; WKV_LOAD_RAW(0); }
    __syncthreads();
#pragma unroll 1
    for (int tb = 0; tb < T; tb += 64) {
        int tid = tid0; asm volatile("" : "+v"(tid));
        const int lane = tid & 63, fr = lane & 15, fq = lane >> 4, c = lane;
        const int pcol = ((c >> 5) * 32) + (((c >> 2) & 3) * 8) + (((c >> 4) & 1) * 4) + (c & 3);
#pragma unroll
        for (int h = 0; h < 2; ++h) { const int idx = tid + h * NTHR; const int tau = idx >> 4, sg = idx & 15;
            u32x4 o = tlraw[h];
            if (sg < 8) { o.x = pk2(fast_tanh(bflo(o.x)), fast_tanh(bfhi(o.x))); o.y = pk2(fast_tanh(bflo(o.y)), fast_tanh(bfhi(o.y)));
                          o.z = pk2(fast_tanh(bflo(o.z)), fast_tanh(bfhi(o.z))); o.w = pk2(fast_tanh(bflo(o.w)), fast_tanh(bfhi(o.w))); }
            *(u32x4*)((sg < 8 ? TLW : TLA) + tau * 72 + (sg & 7) * 8) = o; }
#pragma unroll
        for (int h = 0; h < 3; ++h) *(u32x4*)(RKV + h * 4096 + (tid >> 3) * 64 + (tid & 7) * 8) = rkvraw[h];
        lds_barrier();
        if (tb + 64 < T) WKV_LOAD_RAW(tb + 64);
        { const bf16_t* TL = (w >> 2) ? TLA : TLW; float* WAo = WA + (w >> 2) * 64 * 68;
#pragma unroll
          for (int mt = 0; mt < 4; ++mt) { f32x4 acc = (f32x4){0.f, 0.f, 0.f, 0.f};
#pragma unroll
            for (int ks = 0; ks < 2; ++ks) { const bf16x8 a = *(const bf16x8*)(TL + (mt * 16 + fr) * 72 + ks * 32 + fq * 8);
                acc = __builtin_amdgcn_mfma_f32_16x16x32_bf16(a, bw[ks], acc, 0, 0, 0); }
#pragma unroll
            for (int jj = 0; jj < 4; ++jj) WAo[(mt * 16 + fq * 4 + jj) * 68 + (w & 3) * 16 + fr] = acc[jj]; } }
        lds_barrier();
        float kkv[8], kmv[8], bv[8], lwv[8], cum[8], rr[8], bonv[8];
        { float run = 0.f;
#pragma unroll
          for (int i = 0; i < 8; ++i) { const int tau = w * 8 + i; const int t = z ? (seqT - 1 - (qbase + tb + tau)) : (qbase + tb + tau); const int tokg = tok0 + t;
            const float wr_ = w0c + WA[tau * 68 + c], ap = a0c + WA[64 * 68 + tau * 68 + c];
            const float nx = -wr_; const float sp = fmaxf(nx, 0.f) + flog(1.f + fexp(-fabsf(nx)));
            const float lw = -fexp(-sp - 0.5f);
            const float iclr = __builtin_amdgcn_rcpf(1.f + fexp(-ap));
            const float kxi = bf2f(RKV[4096 + tau * 64 + c]); rr[i] = bf2f(RKV[tau * 64 + c]);
            const float kkraw = kxi * kkc;
            const float ssq = wave_sum_fast(kkraw * kkraw);
            const float kk = kkraw * __builtin_amdgcn_rsqf(fmaxf(ssq, 1e-24f));
            const float kmod = kxi * (1.f + (iclr - 1.f) * kac);
            bonv[i] = wave_sum_lane63(rr[i] * kmod * rkc);
            run += lw;
            kkv[i] = kk; kmv[i] = kmod; bv[i] = kk * iclr; lwv[i] = lw; cum[i] = run; }
          HT[w * 64 + c] = run;
          if (lane == 63) {
#pragma unroll
            for (int i = 0; i < 8; ++i) BONL[w * 8 + i] = bonv[i]; } }
        lds_barrier();
        if (tid < 64) { const int t = z ? (seqT - 1 - (qbase + tb + tid)) : (qbase + tb + tid); BON[((size_t)z * NTOK + tok0 + t) * 16 + hd] = BONL[tid]; }
        { const float off = (w & 1) ? HT[(w - 1) * 64 + c] : 0.f; const int cn = w >> 1;
          unsigned kbq[8];
#pragma unroll
          for (int i = 0; i < 8; ++i) { const int tau = w * 8 + i; const int j = (w & 1) * 8 + i;
            const float cm = cum[i] + off;
            const float Pj = fexp(cm), ipj = fexp(-cm), pm1 = fexp(cm - lwv[i]);
            const unsigned kb2 = pk2(-bv[i] * ipj, kmv[i] * ipj);
            KTr[tau * 72 + pcol] = (bf16_t)(kb2 >> 16); BTr[tau * 72 + pcol] = f2bf_hw(bv[i] * ipj);
            const unsigned kr2 = pk2(kkv[i] * pm1, rr[i] * Pj);
            KKH[tau * 72 + pcol] = (bf16_t)(kr2 & 0xFFFFu); RH[tau * 72 + pcol] = (bf16_t)(kr2 >> 16);
            kbq[i] = kb2;
            if (j == 15) PC[cn * 64 + c] = Pj; }
#pragma unroll
          for (int g = 0; g < 2; ++g) { u32x4 o;
              o.x = (kbq[g * 4 + 0] & 0xFFFFu) | (kbq[g * 4 + 1] << 16); o.y = (kbq[g * 4 + 2] & 0xFFFFu) | (kbq[g * 4 + 3] << 16);
              o.z = (kbq[g * 4 + 0] >> 16) | (kbq[g * 4 + 1] & 0xFFFF0000u); o.w = (kbq[g * 4 + 2] >> 16) | (kbq[g * 4 + 3] & 0xFFFF0000u);
              *(u32x4*)(KBm + (cn * 64 + c) * 40 + ((w & 1) * 2 + g) * 8) = o; } }
        lds_barrier();
#pragma unroll
        for (int q2 = 0; q2 < 2; ++q2) { const int id = w * 2 + q2; const int cn = id >> 2, which = id & 3;
          const bf16_t* Am = ((which & 1) ? KTr : BTr) + cn * 16 * 72; const bf16_t* Bm = ((which & 2) ? RH : KKH) + cn * 16 * 72;
          const f32x4 acc = mma_nt(Am, 72, Bm, 72, 64, (f32x4){0.f, 0.f, 0.f, 0.f}, fr, fq);
          f32x4 o;
#pragma unroll
          for (int jj = 0; jj < 4; ++jj) { const int i = fq * 4 + jj, j = fr; const bool keep = (which & 2) ? (i <= j) : (i < j); o[jj] = keep ? acc[jj] : 0.f; }
          *(f32x4*)(MM + (cn * 4 + which) * 256 + fr * 16 + fq * 4) = o; }
        lds_barrier();
        if (w < 4) { const int cn = w, col = lane >> 2, rg = lane & 3;
            const float* MbT = MM + (cn * 4 + 0) * 256 + rg * 4; const float* MkT = MM + (cn * 4 + 1) * 256 + rg * 4;
            float Tc[4], A1[4];
#pragma unroll
            for (int e = 0; e < 4; ++e) { Tc[e] = (rg * 4 + e == col) ? 1.f : 0.f; A1[e] = 0.f; }
#define INV_STEP(l, CTRL) do { const f32x4 mb = *(const f32x4*)(MbT + (l) * 16), mk = *(const f32x4*)(MkT + (l) * 16); \
                const float tl_ = __int_as_float(__builtin_amdgcn_update_dpp(0, __float_as_int(Tc[(l) & 3]), CTRL, 0xF, 0xF, true)); \
                Tc[0] -= mb[0] * tl_; Tc[1] -= mb[1] * tl_; Tc[2] -= mb[2] * tl_; Tc[3] -= mb[3] * tl_; \
                A1[0] += mk[0] * tl_; A1[1] += mk[1] * tl_; A1[2] += mk[2] * tl_; A1[3] += mk[3] * tl_; } while (0)
            INV_STEP(15, 0xFF); INV_STEP(14, 0xFF); INV_STEP(13, 0xFF); INV_STEP(12, 0xFF);
            INV_STEP(11, 0xAA); INV_STEP(10, 0xAA); INV_STEP(9, 0xAA); INV_STEP(8, 0xAA);
            INV_STEP(7, 0x55); INV_STEP(6, 0x55); INV_STEP(5, 0x55); INV_STEP(4, 0x55);
            INV_STEP(3, 0x00); INV_STEP(2, 0x00); INV_STEP(1, 0x00);
#undef INV_STEP
            u32x4 o; o.x = pk2(Tc[0], Tc[1]); o.y = pk2(Tc[2], Tc[3]); o.z = pk2(A1[0], A1[1]); o.w = pk2(A1[2], A1[3]);
            *(u32x4*)(TA + (cn * 16 + col) * 40 + rg * 8) = o; }
        else { const int cn = w - 4, j = lane & 15, ig = lane >> 4;
            const f32x4 nb = *(const f32x4*)(MM + (cn * 4 + 2) * 256 + j * 16 + ig * 4), nk = *(const f32x4*)(MM + (cn * 4 + 3) * 256 + j * 16 + ig * 4);
            u32x4 o; o.x = pk2(-nb[0], -nb[1]); o.y = pk2(-nb[2], -nb[3]); o.z = pk2(nk[0], nk[1]); o.w = pk2(nk[2], nk[3]);
            *(u32x4*)(NA + (cn * 16 + j) * 40 + ig * 8) = o; }
        lds_barrier();
        if (w < 4 || sample) {
            const int vb = w & 3;
            const int t0s = z ? (seqT - 1 - (qbase + tb)) : (qbase + tb);
            const long tstep = z ? -1024 : 1024;
            bf16_t* obase = (w < 4) ? OD + ((size_t)z * NTOK + tok0 + t0s) * 1024 + hd * 64 + vb * 16 + fq * 4 : RHO + ((size_t)z * 4096 + (tok0 - NPTOK) + t0s) * 1024 + hd * 64 + vb * 16 + fq * 4;
#pragma unroll 1
            for (int cn = 0; cn < 4; ++cn) {
                bf16x8 sb[2];
#pragma unroll
                for (int ks = 0; ks < 2; ++ks) sb[ks] = pack8h(Sacc[2 * ks][0], Sacc[2 * ks][1], Sacc[2 * ks][2], Sacc[2 * ks][3], Sacc[2 * ks + 1][0], Sacc[2 * ks + 1][1], Sacc[2 * ks + 1][2], Sacc[2 * ks + 1][3]);
                f32x4 U0 = (f32x4){0.f, 0.f, 0.f, 0.f}, O = (f32x4){0.f, 0.f, 0.f, 0.f};
#pragma unroll
                for (int ks = 0; ks < 2; ++ks) { const bf16x8 a = *(const bf16x8*)(KKH + (cn * 16 + fr) * 72 + ks * 32 + fq * 8);
                    U0 = __builtin_amdgcn_mfma_f32_16x16x32_bf16(a, sb[ks], U0, 0, 0, 0);
                    const bf16x8 ar = *(const bf16x8*)(RH + (cn * 16 + fr) * 72 + ks * 32 + fq * 8);
                    O = __builtin_amdgcn_mfma_f32_16x16x32_bf16(sb[ks], ar, O, 0, 0, 0); }
                float vf[4];
#pragma unroll
                for (int e = 0; e < 4; ++e) vf[e] = (w < 4) ? bf2f(VS[(cn * 16 + fq * 4 + e) * 64 + vb * 16 + fr]) : 0.f;
                const bf16x8 bU0 = pack8h(U0[0], U0[1], U0[2], U0[3], vf[0], vf[1], vf[2], vf[3]);
                const bf16x8 ta = *(const bf16x8*)(TA + (cn * 16 + fr) * 40 + fq * 8);
                const f32x4 U = __builtin_amdgcn_mfma_f32_16x16x32_bf16(ta, bU0, (f32x4){0.f, 0.f, 0.f, 0.f}, 0, 0, 0);
                const bf16x8 bUV = pack8h(U[0], U[1], U[2], U[3], vf[0], vf[1], vf[2], vf[3]);
                const bf16x8 na = *(const bf16x8*)(NA + (cn * 16 + fr) * 40 + fq * 8);
                O = __builtin_amdgcn_mfma_f32_16x16x32_bf16(bUV, na, O, 0, 0, 0);
#pragma unroll
                for (int jj = 0; jj < 1; ++jj) { u32x2 o2; o2.x = pk2(O[0], O[1]); o2.y = pk2(O[2], O[3]); *(u32x2*)(obase + (long)(cn * 16 + fr) * tstep) = o2; }
#pragma unroll
                for (int kt = 0; kt < 4; ++kt) { const bf16x8 kb = *(const bf16x8*)(KBm + (cn * 64 + kt * 16 + fr) * 40 + fq * 8);
                    Sacc[kt] = __builtin_amdgcn_mfma_f32_16x16x32_bf16(kb, bUV, Sacc[kt], 0, 0, 0);
                    const f32x4 pc = *(const f32x4*)(PC + cn * 64 + kt * 16 + fq * 4);
                    Sacc[kt] = Sacc[kt] * pc; }
            }
        }
        lds_barrier();
    }
#undef WKV_LOAD_RAW
    if (!sample) { if (w < 4) { float* so = p.out + (size_t)2 * NPTOK * D + ((size_t)((b * 2 + z) * 16 + hd)) * 4096 + (size_t)(w * 16 + fr0) * 64;
#pragma unroll
        for (int kt = 0; kt < 4; ++kt)
#pragma unroll
            for (int jj = 0; jj < 4; ++jj) so[kt * 16 + fq0 * 4 + jj] = Sacc[kt][jj]; } }
    else { float* so = GH + ((size_t)u * 2 + (w >> 2)) * 4096 + (size_t)((w & 3) * 16 + fr0) * 64;
#pragma unroll
        for (int kt = 0; kt < 4; ++kt)
#pragma unroll
            for (int jj = 0; jj < 4; ++jj) so[kt * 16 + fq0 * 4 + jj] = Sacc[kt][jj]; }
    __syncthreads();
}

__device__ void wkv_fix_unit(const Params& p, int u, float* ldsf) {
    const int tid = threadIdx.x, lane = tid & 63, w = __builtin_amdgcn_readfirstlane(tid >> 6), fr = lane & 15, fq = lane >> 4;
    unsigned char* ws = p.ws;
    bf16_t* OD = (bf16_t*)(ws + WS_X1);
    const bf16_t* RHO = (const bf16_t*)(ws + WS_H);
    const float* GH = (const float*)(ws + WS_BT0);
    const int z = u >> 7, b = (u >> 6) & 1, hd = (u >> 2) & 15, vq = u & 3;
    float* SS = ldsf;
    float* GL = ldsf + 1024;
    bf16_t* SB = (bf16_t*)(ldsf + 1024 + 4096);
    const int v = tid >> 5, kp = (tid & 31) * 2;
    { const float* s0 = p.in[2] + ((size_t)((b * 2 + z) * 16 + hd)) * 4096 + (size_t)(vq * 16 + v) * 64 + kp; SS[v * 64 + kp] = s0[0]; SS[v * 64 + kp + 1] = s0[1]; }
    __syncthreads();
#pragma unroll 1
    for (int sg = 0; sg < 8; ++sg) {
        const int su = ((z * 2 + b) * 16 + hd) * 8 + sg;
        SB[v * 72 + kp] = f2bf_hw(SS[v * 64 + kp]); SB[v * 72 + kp + 1] = f2bf_hw(SS[v * 64 + kp + 1]);
        if (sg < 7) { const f32x4* gsrc = (const f32x4*)(GH + ((size_t)su * 2 + 1) * 4096);
#pragma unroll
            for (int q = 0; q < 2; ++q) ((f32x4*)GL)[tid + q * NTHR] = gsrc[tid + q * NTHR]; }
        __syncthreads();
        const int tlo = z ? (2048 - (sg + 1) * 256) : sg * 256;
#pragma unroll
        for (int q = 0; q < 2; ++q) { const int mt = 2 * w + q;
            f32x4 acc = (f32x4){0.f, 0.f, 0.f, 0.f};
#pragma unroll
            for (int ks = 0; ks < 2; ++ks) { const bf16x8 a = *(const bf16x8*)(RHO + ((size_t)z * 4096 + b * 2048 + tlo + mt * 16 + fr) * 1024 + hd * 64 + ks * 32 + fq * 8);
                const bf16x8 bb = *(const bf16x8*)(SB + fr * 72 + ks * 32 + fq * 8);
                acc = __builtin_amdgcn_mfma_f32_16x16x32_bf16(a, bb, acc, 0, 0, 0); }
#pragma unroll
            for (int jj = 0; jj < 4; ++jj) { bf16_t* op = OD + ((size_t)z * NTOK + NPTOK + b * 2048 + tlo + mt * 16 + fq * 4 + jj) * 1024 + hd * 64 + vq * 16 + fr;
                *op = f2bf_hw(bf2f(*op) + acc[jj]); } }
        if (sg < 7) {
            const float* hsrc = GH + ((size_t)su * 2 + 0) * 4096 + (size_t)(vq * 16 + v) * 64 + kp;
            float a0 = hsrc[0], a1 = hsrc[1];
#pragma unroll 8
            for (int k2 = 0; k2 < 64; ++k2) { const float sv = SS[v * 64 + k2]; a0 += sv * GL[k2 * 64 + kp]; a1 += sv * GL[k2 * 64 + kp + 1]; }
            __syncthreads();
            SS[v * 64 + kp] = a0; SS[v * 64 + kp + 1] = a1;
        }
        __syncthreads();
    }
}
__device__ void phase_wkv_fix(const Params& p, float* lds) {
    for (int it = blockIdx.x; it < 256; it += gridDim.x) wkv_fix_unit(p, it, lds);
}

__device__ void conv_tile(const Params& p, int tile) {
    const int tid = threadIdx.x;
    unsigned char* ws = p.ws;
    const bf16_t* P = (const bf16_t*)(ws + WS_P);
    bf16_t* OC = (bf16_t*)(ws + WS_OC);
    const int cgp = tid & 127, c0 = cgp * 8, sub = tid >> 7;
    float cw0[8], cw1[8], cw2[8];
#pragma unroll
    for (int j = 0; j < 8; ++j) { cw0[j] = p.in[12][c0 + j]; cw1[j] = p.in[12][1024 + c0 + j]; cw2[j] = p.in[12][2048 + c0 + j]; }
    for (int jj = 0; jj < 4; ++jj) {
        const int t = tile * 16 + sub + 4 * jj;
        const int rl = t < NPTOK ? 256 : 64; const int pos = t & (rl - 1);
        const bf16_t* row = P + (size_t)t * N0;
        const u32x4 z4 = (u32x4){0u, 0u, 0u, 0u};
        const u32x4 u1 = *(const u32x4*)(row + c0), g1 = *(const u32x4*)(row + 2048 + c0);
        const u32x4 u0 = pos > 0 ? *(const u32x4*)(row - N0 + c0) : z4, g0 = pos > 0 ? *(const u32x4*)(row - N0 + 2048 + c0) : z4;
        const u32x4 u2 = pos < rl - 1 ? *(const u32x4*)(row + N0 + c0) : z4, g2 = pos < rl - 1 ? *(const u32x4*)(row + N0 + 2048 + c0) : z4;
        const u32x4 gb = *(const u32x4*)(row + 1024 + c0), zc = *(const u32x4*)(row + 3072 + c0);
        u32x4 o;
#pragma unroll
        for (int q = 0; q < 4; ++q) {
            const float y0 = cw0[2 * q] * (bflo(g0[q]) * bflo(u0[q])) + cw1[2 * q] * (bflo(g1[q]) * bflo(u1[q])) + cw2[2 * q] * (bflo(g2[q]) * bflo(u2[q]));
            const float y1 = cw0[2 * q + 1] * (bfhi(g0[q]) * bfhi(u0[q])) + cw1[2 * q + 1] * (bfhi(g1[q]) * bfhi(u1[q])) + cw2[2 * q + 1] * (bfhi(g2[q]) * bfhi(u2[q]));
            o[q] = pack2(silu(bflo(zc[q])) * bflo(gb[q]) * y0, silu(bfhi(zc[q])) * bfhi(gb[q]) * y1);
        }
        *(u32x4*)(OC + (size_t)t * 2048 + c0) = o;
    }
}

__device__ void phase_mix0(const Params& p, float* lds, int rep) {
    (void)rep;
    constexpr int NSCAN = 1024, NCONV = 512;
    for (int it = blockIdx.x; it < NSCAN + NCONV; it += gridDim.x) {
        if (it < NSCAN) wkv_unit(p, it, lds); else conv_tile(p, it - NSCAN);
    }
}

__device__ __forceinline__ float quad_sum(float v) {
    v += __int_as_float(__builtin_amdgcn_update_dpp(0, __float_as_int(v), 0xB1, 0xF, 0xF, true));
    v += __int_as_float(__builtin_amdgcn_update_dpp(0, __float_as_int(v), 0x4E, 0xF, 0xF, true));
    return v;
}
__device__ void phase_wkv_post(const Params& p) {
    const int tid = threadIdx.x, wave = tid >> 6, lane = tid & 63;
    unsigned char* ws = p.ws;
    const bf16_t* P = (const bf16_t*)(ws + WS_P);
    const bf16_t* OD = (const bf16_t*)(ws + WS_X1);
    const float* BON = (const float*)(ws + WS_BON);
    bf16_t* OC = (bf16_t*)(ws + WS_OC);
    const int hh = lane >> 2, ch0 = hh * 64 + (lane & 3) * 16;
    for (int tok = blockIdx.x * 8 + wave; tok < NTOK; tok += gridDim.x * 8) {
        const bf16_t* row = P + (size_t)tok * N0;
        u32x4 a0[2], a1[2], vv[2], zz[2];
#pragma unroll
        for (int h = 0; h < 2; ++h) { a0[h] = *(const u32x4*)(OD + (size_t)tok * 1024 + ch0 + h * 8); a1[h] = *(const u32x4*)(OD + ((size_t)NTOK + tok) * 1024 + ch0 + h * 8);
            vv[h] = *(const u32x4*)(row + 6144 + ch0 + h * 8); zz[h] = *(const u32x4*)(row + 7168 + ch0 + h * 8); }
        const float bon = BON[(size_t)tok * 16 + hh] + BON[((size_t)NTOK + tok) * 16 + hh];
        float o[16]; float s1 = 0.f;
#pragma unroll
        for (int h = 0; h < 2; ++h)
#pragma unroll
            for (int q = 0; q < 4; ++q) { o[h * 8 + 2 * q] = bflo(a0[h][q]) + bflo(a1[h][q]); o[h * 8 + 2 * q + 1] = bfhi(a0[h][q]) + bfhi(a1[h][q]); s1 += o[h * 8 + 2 * q] + o[h * 8 + 2 * q + 1]; }
        const float mu = quad_sum(s1) * (1.f / 64.f);
        float s2 = 0.f;
#pragma unroll
        for (int i = 0; i < 16; ++i) { o[i] -= mu; s2 += o[i] * o[i]; }
        const float rs = rsqrtf(quad_sum(s2) * (1.f / 64.f) + 64e-5f);
        float res[16];
#pragma unroll
        for (int g4 = 0; g4 < 4; ++g4) { const f32x4 lw4 = *(const f32x4*)(p.in[22] + ch0 + g4 * 4), lb4 = *(const f32x4*)(p.in[23] + ch0 + g4 * 4);
#pragma unroll
            for (int e = 0; e < 4; ++e) { const int i = g4 * 4 + e; const unsigned vw = vv[i >> 3][(i & 7) >> 1], zw_ = zz[i >> 3][(i & 7) >> 1];
                const float v1 = (i & 1) ? bfhi(vw) : bflo(vw), z1 = (i & 1) ? bfhi(zw_) : bflo(zw_);
                res[i] = (o[i] * rs * lw4[e] + lb4[e] + bon * v1) * silu(z1); } }
#pragma unroll
        for (int h = 0; h < 2; ++h) { u32x4 w4; w4.x = pk2(res[h * 8 + 0], res[h * 8 + 1]); w4.y = pk2(res[h * 8 + 2], res[h * 8 + 3]); w4.z = pk2(res[h * 8 + 4], res[h * 8 + 5]); w4.w = pk2(res[h * 8 + 6], res[h * 8 + 7]);
            *(u32x4*)(OC + (size_t)tok * 2048 + 1024 + ch0 + h * 8) = w4; }
    }
}

constexpr size_t WS_QE = WS_H;
constexpr size_t WS_KDT = WS_BT0;
constexpr size_t WS_VT = WS_OC + (size_t)NTOK * 1024 * 2;
constexpr size_t WS_EBL = WS_BON + (size_t)2 * NTOK * 16 * 4;
constexpr size_t WS_ATT = WS_P + 52 * MB;

__device__ void gla_a_item(const Params& p, int item, float* ldsf) {
    const int tid = threadIdx.x, lane = tid & 63, w = __builtin_amdgcn_readfirstlane(tid >> 6), fr = lane & 15, fq = lane >> 4;
    unsigned char* ws = p.ws;
    const bf16_t* P1 = (const bf16_t*)(ws + WS_P);
    float* OD = (float*)(ws + WS_P2);
    bf16_t* QEg = (bf16_t*)(ws + WS_QE); bf16_t* KDTg = (bf16_t*)(ws + WS_KDT); bf16_t* VTg = (bf16_t*)(ws + WS_VT); float* EBLg = (float*)(ws + WS_EBL);
    const int hd = item & 3, c = (item >> 2) & 127, z = item >> 9, tok0 = c * 64;
    bf16_t* QE = (bf16_t*)ldsf;
    bf16_t* KE = QE + 64 * 136;
    bf16_t* VT = KE + 64 * 136;
    bf16_t* ATT = VT + 256 * 72;
    float* G = (float*)(ATT + 64 * 72);
    float* L1G = G + 64 * 132;
    float* GK2 = L1G + 1024;
    for (int i = tid; i < 1024; i += NTHR) { const int t = i >> 4, r = i & 15; L1G[i] = bf2f(P1[(size_t)(tok0 + t) * N1 + 3072 + z * 16 + r]); }
    for (int i = tid; i < 2048; i += NTHR) { const int r = i >> 7, d = i & 127; GK2[i] = p.in[27][(size_t)(z * 16 + r) * 512 + hd * 128 + d]; }
#pragma unroll
    for (int ps = 0; ps < 4; ++ps) { const int t = lane, e8 = (ps * 8 + w) * 8;
        const u32x4 v8 = *(const u32x4*)(P1 + (size_t)(tok0 + t) * N1 + 1024 + hd * 256 + e8);
        VT[(e8 + 0) * 72 + t] = (bf16_t)(v8.x & 0xFFFF); VT[(e8 + 1) * 72 + t] = (bf16_t)(v8.x >> 16); VT[(e8 + 2) * 72 + t] = (bf16_t)(v8.y & 0xFFFF); VT[(e8 + 3) * 72 + t] = (bf16_t)(v8.y >> 16);
        VT[(e8 + 4) * 72 + t] = (bf16_t)(v8.z & 0xFFFF); VT[(e8 + 5) * 72 + t] = (bf16_t)(v8.z >> 16); VT[(e8 + 6) * 72 + t] = (bf16_t)(v8.w & 0xFFFF); VT[(e8 + 7) * 72 + t] = (bf16_t)(v8.w >> 16); }
    const int d = tid & 127, tq = tid >> 7;
    const float gbias = p.in[28][z * 512 + hd * 128 + d];
    bf16_t qraw[16], kraw[16];
#pragma unroll
    for (int i = 0; i < 16; ++i) { const size_t row = (size_t)(tok0 + tq * 16 + i) * N1; qraw[i] = P1[row + hd * 128 + d]; kraw[i] = P1[row + 512 + hd * 128 + d]; }
    __syncthreads();
    { float run = 0.f;
#pragma unroll 4
      for (int i = 0; i < 16; ++i) { const int t = z ? (tq * 16 + 15 - i) : (tq * 16 + i);
        float x = gbias;
#pragma unroll
        for (int r = 0; r < 16; ++r) x += L1G[t * 16 + r] * GK2[r * 128 + d];
        const float ls = fminf(x, 0.f) - flog(1.f + fexp(-fabsf(x)));
        run += ls * (1.f / 16.f);
        G[t * 132 + d] = run; } }
    __syncthreads();
    { const int lastr = z ? 0 : 15;
      const float t0 = G[(0 + lastr) * 132 + d], t1 = G[(16 + lastr) * 132 + d], t2 = G[(32 + lastr) * 132 + d], t3 = G[(48 + lastr) * 132 + d];
      const float blast = t0 + t1 + t2 + t3;
      float off;
      if (z == 0) off = tq == 0 ? 0.f : (tq == 1 ? t0 : (tq == 2 ? t0 + t1 : t0 + t1 + t2));
      else off = tq == 3 ? 0.f : (tq == 2 ? t3 : (tq == 1 ? t3 + t2 : t3 + t2 + t1));
      if (tq == 0) EBLg[(size_t)(z * 128 + c) * 512 + hd * 128 + d] = fexp(blast);
      unsigned kdp[8];
#pragma unroll
      for (int i = 0; i < 16; ++i) { const int t = tq * 16 + i;
        const float bc = G[t * 132 + d] + off;
        const float q = bf2f(qraw[i]) * 0.08838834764831845f, k = bf2f(kraw[i]);
        const bf16_t qe = f2bf(q * fexp(bc));
        QE[t * 136 + d] = qe; KE[t * 136 + d] = f2bf(k * fexp(-bc));
        const unsigned kd = (unsigned)f2bf(k * fexp(blast - bc));
        if (i & 1) kdp[i >> 1] |= kd << 16; else kdp[i >> 1] = kd; }
      bf16_t* kdst = KDTg + ((size_t)(((z * 128 + c) * 4 + hd) * 128 + d)) * 64 + tq * 16;
      *(u32x4*)kdst = (u32x4){kdp[0], kdp[1], kdp[2], kdp[3]}; *(u32x4*)(kdst + 8) = (u32x4){kdp[4], kdp[5], kdp[6], kdp[7]}; }
    __syncthreads();
#pragma unroll
    for (int q2 = 0; q2 < 2; ++q2) { const int idx = q2 * NTHR + tid; const int t = idx >> 4, d8 = (idx & 15) * 8;
        *(u32x4*)(QEg + ((size_t)z * NTOK + tok0 + t) * 512 + hd * 128 + d8) = *(const u32x4*)(QE + t * 136 + d8); }
    if (z == 0) {
#pragma unroll
        for (int q4 = 0; q4 < 4; ++q4) { const int idx = q4 * NTHR + tid; const int e = idx >> 3, t8 = (idx & 7) * 8;
            *(u32x4*)(VTg + ((size_t)((c * 4 + hd) * 256 + e)) * 64 + t8) = *(const u32x4*)(VT + e * 72 + t8); } }
#pragma unroll
    for (int q2 = 0; q2 < 2; ++q2) { const int tA = 2 * w + q2, ia = tA >> 2, ja = tA & 3;
        f32x4 a4 = (f32x4){0.f, 0.f, 0.f, 0.f};
        if (z ? (ja >= ia) : (ja <= ia)) a4 = mma_nt(QE + ia * 16 * 136, 136, KE + ja * 16 * 136, 136, 128, a4, fr, fq);
#pragma unroll
        for (int jj = 0; jj < 4; ++jj) { const int i = ia * 16 + fq * 4 + jj, j = ja * 16 + fr; const bool keep = z ? (j >= i) : (j <= i); ATT[i * 72 + j] = f2bf(keep ? a4[jj] : 0.f); } }
    __syncthreads();
    { bf16_t* ATTg = (bf16_t*)(ws + WS_ATT) + ((size_t)((z * 128 + c) * 4 + hd)) * 4096;
      const int i = tid >> 3, j8 = (tid & 7) * 8;
      *(u32x4*)(ATTg + i * 64 + j8) = *(const u32x4*)(ATT + i * 72 + j8); }
    __syncthreads();
}

__device__ void phase_gla_a(const Params& p, float* lds) {
    for (int it = blockIdx.x; it < 1024; it += gridDim.x) gla_a_item(p, it, lds);
}

struct GlaFrags { bf16x8 kdt[2]; u32x4 vts; u32x4 qes[2]; bf16x8 att[2]; f32x4 ebl; };

template <int NE>
__device__ __forceinline__ void gla_b_unit_t(const Params& p, int z, int b, int hd, int e0, int nch, int ch0, bool sample, float* ldsf) {
    const int tid = threadIdx.x, lane = tid & 63, w = __builtin_amdgcn_readfirstlane(tid >> 6), fr = lane & 15, fq = lane >> 4;
    unsigned char* ws = p.ws;
    bf16_t* OD = (bf16_t*)(ws + WS_P2);
    const bf16_t* QEg = (const bf16_t*)(ws + WS_QE); const bf16_t* KDTg = (const bf16_t*)(ws + WS_KDT); const bf16_t* VTg = (const bf16_t*)(ws + WS_VT); const float* EBLg = (const float*)(ws + WS_EBL);
    const bf16_t* ATTg = (const bf16_t*)(ws + WS_ATT);
    constexpr int NQ = NE / 2;
    bf16_t* ST = (bf16_t*)ldsf;
    bf16_t* VTL = ST + 2 * 64 * 136;
    bf16_t* QEL = VTL + 2 * 64 * 72;
    f32x4 Sacc[NE];
    if (sample) { const float* s0 = p.in[3] + ((size_t)((b * 2 + z) * 4 + hd)) * 32768 + e0 + fr;
#pragma unroll
        for (int et = 0; et < NE; ++et)
#pragma unroll
            for (int jj = 0; jj < 4; ++jj) Sacc[et][jj] = s0[(size_t)(w * 16 + fq * 4 + jj) * 256 + et * 16]; }
    else {
#pragma unroll
        for (int et = 0; et < NE; ++et) Sacc[et] = (f32x4){0.f, 0.f, 0.f, 0.f}; }
    const int it = w >> 1, e2 = (w & 1) * NQ;
    const int ve = tid >> 3, vt8 = (tid & 7) * 8;
#define GLB_LOAD(F, c_) do { const int cc_ = (c_); \
        _Pragma("unroll") for (int ks = 0; ks < 2; ++ks) { (F).kdt[ks] = *(const bf16x8*)(KDTg + ((size_t)(((z * 128 + cc_) * 4 + hd) * 128 + w * 16 + fr)) * 64 + ks * 32 + fq * 8); \
            (F).att[ks] = *(const bf16x8*)(ATTg + ((size_t)((z * 128 + cc_) * 4 + hd)) * 4096 + (it * 16 + fr) * 64 + ks * 32 + fq * 8); } \
        if (ve < NE * 16) (F).vts = *(const u32x4*)(VTg + ((size_t)((cc_ * 4 + hd) * 256 + e0 + ve)) * 64 + vt8); \
        _Pragma("unroll") for (int h_ = 0; h_ < 2; ++h_) (F).qes[h_] = *(const u32x4*)(QEg + ((size_t)z * NTOK + cc_ * 64 + ve) * 512 + hd * 128 + h_ * 64 + vt8); \
        (F).ebl = *(const f32x4*)(EBLg + (size_t)(z * 128 + cc_) * 512 + hd * 128 + w * 16 + fq * 4); } while (0)
#define GLB_STEP(CUR, NX2, ci_) do { const int ci = (ci_); if (ci < nch) { \
        const int c = ch0 + (z ? nch - 1 - ci : ci); \
        bf16_t* STc = ST + (ci & 1) * 64 * 136; bf16_t* VTc = VTL + (ci & 1) * 64 * 72; \
        _Pragma("unroll") for (int et = 0; et < NE; ++et) { u32x2 v2; v2.x = pk2(Sacc[et][0], Sacc[et][1]); v2.y = pk2(Sacc[et][2], Sacc[et][3]); \
            *(u32x2*)(STc + (et * 16 + fr) * 136 + w * 16 + fq * 4) = v2; } \
        if (ve < NE * 16) *(u32x4*)(VTc + ve * 72 + vt8) = (CUR).vts; \
        bf16_t* QEc = QEL + (ci & 1) * 64 * 136; \
        *(u32x4*)(QEc + ve * 136 + vt8) = (CUR).qes[0]; *(u32x4*)(QEc + ve * 136 + 64 + vt8) = (CUR).qes[1]; \
        if (ci + 2 < nch) GLB_LOAD(NX2, ch0 + (z ? nch - 3 - ci : ci + 2)); \
        lds_barrier(); \
        _Pragma("unroll") for (int et = 0; et < NE; ++et) { Sacc[et] = Sacc[et] * (CUR).ebl; \
            _Pragma("unroll") for (int ks = 0; ks < 2; ++ks) { const bf16x8 vf = *(const bf16x8*)(VTc + (et * 16 + fr) * 72 + ks * 32 + fq * 8); \
                Sacc[et] = __builtin_amdgcn_mfma_f32_16x16x32_bf16((CUR).kdt[ks], vf, Sacc[et], 0, 0, 0); } } \
        _Pragma("unroll") for (int q2 = 0; q2 < NQ; ++q2) { f32x4 o = (f32x4){0.f, 0.f, 0.f, 0.f}; \
            _Pragma("unroll") for (int ks = 0; ks < 2; ++ks) { const bf16x8 vf = *(const bf16x8*)(VTc + ((e2 + q2) * 16 + fr) * 72 + ks * 32 + fq * 8); \
                o = __builtin_amdgcn_mfma_f32_16x16x32_bf16(vf, (CUR).att[ks], o, 0, 0, 0); } \
            _Pragma("unroll") for (int ks = 0; ks < 4; ++ks) { const bf16x8 bS = *(const bf16x8*)(STc + ((e2 + q2) * 16 + fr) * 136 + ks * 32 + fq * 8); \
                const bf16x8 aq = *(const bf16x8*)(QEc + (it * 16 + fr) * 136 + ks * 32 + fq * 8); \
                o = __builtin_amdgcn_mfma_f32_16x16x32_bf16(bS, aq, o, 0, 0, 0); } \
            { u32x2 o2; o2.x = pk2(o[0], o[1]); o2.y = pk2(o[2], o[3]);        \
              *(u32x2*)(OD + ((size_t)z * NTOK + c * 64 + it * 16 + fr) * 1024 + hd * 256 + e0 + (e2 + q2) * 16 + fq * 4) = o2; } } } } while (0)
    GlaFrags fa, fb, fc; fa.vts = fb.vts = fc.vts = (u32x4){0u, 0u, 0u, 0u};
    GLB_LOAD(fa, ch0 + (z ? nch - 1 : 0));
    GLB_LOAD(fb, ch0 + (z ? nch - 2 : 1));
    __syncthreads();
#pragma unroll 1
    for (int ci3 = 0; ci3 < nch; ci3 += 3) { GLB_STEP(fa, fc, ci3); GLB_STEP(fb, fa, ci3 + 1); GLB_STEP(fc, fb, ci3 + 2); }
#undef GLB_STEP
#undef GLB_LOAD
    if (!sample) { float* so = p.out + (size_t)2 * NPTOK * D + 2097152 + ((size_t)((b * 2 + z) * 4 + hd)) * 32768 + e0 + fr;
#pragma unroll
        for (int et = 0; et < NE; ++et)
#pragma unroll
            for (int jj = 0; jj < 4; ++jj) so[(size_t)(w * 16 + fq * 4 + jj) * 256 + et * 16] = Sacc[et][jj]; }
    __syncthreads();
}

__device__ void gla_b_unit(const Params& p, int u, float* ldsf) {
    if (u < 128) gla_b_unit_t<2>(p, u >> 6, (u >> 5) & 1, (u >> 3) & 3, (u & 7) * 32, 32, 64 + ((u >> 5) & 1) * 32, true, ldsf);
    else { const int q = u - 128; gla_b_unit_t<4>(p, q >> 8, (q >> 4) & 15, (q >> 2) & 3, (q & 3) * 64, 4, ((q >> 4) & 15) * 4, false, ldsf); }
}

__device__ void phase_gla_b(const Params& p, float* lds, int rep) {
    unsigned* ctr = (unsigned*)(p.ws + WS_CTL) + 16 + rep * 32;
    int* slot = (int*)(lds + LDS_MAIN / 4);
    for (;;) {
        if (threadIdx.x == 0) *slot = (int)atomicAdd(ctr, 1u);
        __syncthreads();
        const int it = *slot;
        __syncthreads();
        if (it >= 640) break;
        gla_b_unit(p, it, lds);
    }
}

__device__ void phase_gla_post(const Params& p) {
    const int tid = threadIdx.x, wave = tid >> 6, lane = tid & 63;
    unsigned char* ws = p.ws;
    const bf16_t* P1 = (const bf16_t*)(ws + WS_P);
    const bf16_t* OD = (const bf16_t*)(ws + WS_P2);
    bf16_t* OG = (bf16_t*)(ws + WS_OC);
    for (int tok = blockIdx.x * 8 + wave; tok < NTOK; tok += gridDim.x * 8) {
        for (int hd = 0; hd < 4; ++hd) { const int idx = hd * 256 + lane * 4;
            const u32x2 pa = *(const u32x2*)(OD + (size_t)tok * 1024 + idx), pb = *(const u32x2*)(OD + ((size_t)NTOK + tok) * 1024 + idx);
            const f32x4 o = (f32x4){bflo(pa.x) + bflo(pb.x), bfhi(pa.x) + bfhi(pb.x), bflo(pa.y) + bflo(pb.y), bfhi(pa.y) + bfhi(pb.y)};
            const float ss = wave_sum(o[0] * o[0] + o[1] * o[1] + o[2] * o[2] + o[3] * o[3]);
            const float rs = rsqrtf(ss * (1.f / 256.f) + 1e-6f);
            const f32x4 gn = *(const f32x4*)(p.in[29] + lane * 4);
            const u32x2 zz = *(const u32x2*)(P1 + (size_t)tok * N1 + 2048 + idx);
            const float z0 = bflo(zz.x), z1 = bfhi(zz.x), z2 = bflo(zz.y), z3 = bfhi(zz.y);
            u32x2 w; w.x = pack2(o[0] * rs * gn[0] * silu(z0), o[1] * rs * gn[1] * silu(z1)); w.y = pack2(o[2] * rs * gn[2] * silu(z2), o[3] * rs * gn[3] * silu(z3));
            *(u32x2*)(OG + (size_t)tok * 1024 + idx) = w; }
    }
}

__device__ void phase_final(const Params& p) {
    const int tid = threadIdx.x, wave = tid >> 6, lane = tid & 63;
    unsigned char* ws = p.ws;
    const float* MOD = (const float*)(ws + WS_MOD);
    const float* X1 = (const float*)(ws + WS_X1);
    const bf16_t* Y = (const bf16_t*)(ws + WS_P2);
    for (int tok = blockIdx.x * 8 + wave; tok < NTOK; tok += gridDim.x * 8) {
        const int cond = tok < NPTOK ? 0 : 1 + ((tok - NPTOK) >> 11);
        f32x4 xv[4]; float ss = 0.f;
#pragma unroll
        for (int i = 0; i < 4; ++i) { const int idx = i * 256 + lane * 4;
            const f32x4 x1 = *(const f32x4*)(X1 + (size_t)tok * D + idx);
            const u32x2 pa = *(const u32x2*)(Y + (size_t)tok * D + idx), pb = *(const u32x2*)(Y + (size_t)NTOK * D + (size_t)tok * D + idx);
            const f32x4 ya = (f32x4){bflo(pa.x), bfhi(pa.x), bflo(pa.y), bfhi(pa.y)}, yb = (f32x4){bflo(pb.x), bfhi(pb.x), bflo(pb.y), bfhi(pb.y)};
            const f32x4 gt = *(const f32x4*)(MOD + (1 * 3 + cond) * 3072 + 2048 + idx);
            xv[i] = x1 + gt * (ya + yb);
            ss += xv[i][0] * xv[i][0] + xv[i][1] * xv[i][1] + xv[i][2] * xv[i][2] + xv[i][3] * xv[i][3]; }
        ss = wave_sum(ss);
        const float rstd = rsqrtf(ss * (1.f / 1024.f) + 1e-6f);
#pragma unroll
        for (int i = 0; i < 4; ++i) { const int idx = i * 256 + lane * 4;
            const f32x4 g = *(const f32x4*)(p.in[9] + idx);
            f32x4 o;
#pragma unroll
            for (int j = 0; j < 4; ++j) o[j] = xv[i][j] * rstd * g[j];
            *(f32x4*)(p.out + (size_t)tok * D + idx) = o; }
    }
}


#define XB_TMO      128
#define XB_XCNT(j)  (256  + 64 * (j))
#define XB_XSUB(j)  (1280 + 64 * (j))
#define XB_XGEN(j)  (2304 + 64 * (j))
#define XB_TOP      3328
#define XB_TOPGEN   3392
#define XCD_BAR_WORDS 3456
#define XB_SPIN_CAP (1u << 18)

__device__ __forceinline__ unsigned xb_ld(unsigned* p)              { return __hip_atomic_load(p, __ATOMIC_RELAXED, __HIP_MEMORY_SCOPE_AGENT); }
__device__ __forceinline__ unsigned xb_add(unsigned* p, unsigned v) { return __hip_atomic_fetch_add(p, v, __ATOMIC_RELAXED, __HIP_MEMORY_SCOPE_AGENT); }
__device__ __forceinline__ unsigned xb_xcc_id() { return (unsigned)__builtin_amdgcn_s_getreg((3 << 11) | 20) & 0xFu; }
#define XB_SPIN(cond, bar) do { unsigned _sp = 0; while (cond) { __builtin_amdgcn_s_sleep(1); \
    if ((++_sp & 255u) == 0u) { if (xb_ld(&(bar)[XB_TMO])) break; if (_sp > XB_SPIN_CAP) { atomicAdd(&(bar)[XB_TMO], 1u); break; } } } } while (0)

struct XcdBarrier {
    unsigned* bar; unsigned x;
    volatile LAS unsigned* st;
};

__device__ __forceinline__ XcdBarrier xcd_barrier_post(unsigned* bar, volatile LAS unsigned* st) {
    XcdBarrier b; b.bar = bar; b.x = xb_xcc_id(); b.st = st;
    if (threadIdx.x == 0) (void)xb_add(&bar[XB_XCNT(b.x)], 1u);
    return b;
}
__device__ __forceinline__ void xcd_barrier_complete(unsigned* bar, unsigned x, unsigned& nloc, unsigned& nx) {
    const unsigned G = gridDim.x * gridDim.y * gridDim.z;
    unsigned sum, cnt, mine, sp = 0u;
    for (;;) {
        sum = 0u; cnt = 0u; mine = 0u;
#pragma unroll
        for (unsigned j = 0; j < 16; ++j) { const unsigned c = xb_ld(&bar[XB_XCNT(j)]); sum += c; cnt += (c > 0u) ? 1u : 0u; mine = (j == x) ? c : mine; }
        if (sum == G) break;
        __builtin_amdgcn_s_sleep(1);
        if ((++sp & 255u) == 0u) { if (xb_ld(&bar[XB_TMO])) break; if (sp > XB_SPIN_CAP) { atomicAdd(&bar[XB_TMO], 1u); break; } }
    }
    nloc = mine > 0u ? mine : 1u; nx = cnt > 0u ? cnt : 1u;
}

__device__ __forceinline__ void xcd_barrier(const XcdBarrier& b) {
    asm volatile("s_waitcnt vmcnt(0)" ::: "memory");
    __syncthreads();
    if (threadIdx.x == 0) {
        unsigned* bar = b.bar;
        __builtin_amdgcn_s_waitcnt(0);
        unsigned nloc = b.st[0], nx = b.st[1];
        if (nloc == 0u) { xcd_barrier_complete(bar, b.x, nloc, nx); b.st[0] = nloc; b.st[1] = nx; }
        const unsigned old = xb_add(&bar[XB_XSUB(b.x)], 1u);
        const unsigned gen = old / nloc;
        if (old + 1u == (gen + 1u) * nloc) {
            __builtin_amdgcn_fence(__ATOMIC_RELEASE, "agent");
            asm volatile("s_waitcnt vmcnt(0)" ::: "memory");
            const unsigned og = xb_add(&bar[XB_TOP], 1u);
            const unsigned tg = og / nx;
            if (og + 1u == (tg + 1u) * nx) xb_add(&bar[XB_TOPGEN], 1u);
            else XB_SPIN(xb_ld(&bar[XB_TOPGEN]) == tg, bar);
            __builtin_amdgcn_fence(__ATOMIC_ACQUIRE, "agent");
            xb_add(&bar[XB_XGEN(b.x)], 1u);
            asm volatile("s_waitcnt vmcnt(0)" ::: "memory");
        } else {
            XB_SPIN(xb_ld(&bar[XB_XGEN(b.x)]) == gen, bar);
            __builtin_amdgcn_fence(__ATOMIC_ACQUIRE, "agent");
            asm volatile("s_waitcnt vmcnt(0)" ::: "memory");
        }
    }
    __syncthreads();
}


constexpr int NPHASE = 14;
__global__ void __launch_bounds__(NTHR, 2) fwd_megakernel(Params p) {
    extern __shared__ __attribute__((aligned(16))) unsigned char smem[];
    float* ldsf = (float*)smem;
    LAS unsigned char* ldsl = (LAS unsigned char*)smem;
    unsigned char* ws = p.ws;
    volatile LAS unsigned* xst = (volatile LAS unsigned*)(ldsl + LDS_MAIN + 16);
    if (threadIdx.x == 0) { xst[0] = 0u; xst[1] = 0u; }
    __syncthreads();
    const XcdBarrier xbar = xcd_barrier_post((unsigned*)(ws + WS_BAR), xst);
    if (p.ph_lo < 0) cg::this_grid().sync();
#ifndef DUP_PHASE
#define DUP_PHASE -1
#endif
#define PHASE(n) if (p.ph_lo <= (n) && (n) < p.ph_hi && ((n) == p.ph_lo || (xcd_barrier(xbar), true))) for (int rep = 0; rep < ((n) == DUP_PHASE ? 2 : 1); ++rep, ((n) == DUP_PHASE ? (xcd_barrier(xbar), 0) : 0))
    PHASE(0) phase_prologue(p, ldsf);
    PHASE(1) phase_h(p, 0, ldsf);
    PHASE(2) { pg8::Gemm g{(const bf16_t*)(ws + WS_H), (const bf16_t*)(ws + WS_BT0), NTOK, 8192, 1024, 1024, 1}; pg8::Order S; S.init(NTOK, 8192, 1, gridDim.x, blockIdx.x);
               pg8::EpiBf16 E{(bf16_t*)(ws + WS_P), N0, 0}; pg8::gemm_phase(ldsl, g, S, E); }
    PHASE(3) phase_mix0(p, ldsf, rep);
    PHASE(4) { phase_wkv_fix(p, ldsf); phase_late_weights(p, ldsf); }
    PHASE(5) phase_wkv_post(p);
    PHASE(6) { pg8::Gemm g{(const bf16_t*)(ws + WS_OC), (const bf16_t*)(ws + WS_WT0O), NTOK, 1024, 1024, 2048, 2}; pg8::Order S; S.init(NTOK, 1024, 2, gridDim.x, blockIdx.x);
               pg8::EpiBf16 E{(bf16_t*)(ws + WS_P), 1024, (size_t)NTOK * 1024}; pg8::gemm_phase(ldsl, g, S, E); }
    PHASE(7) phase_h(p, 1, ldsf);
    PHASE(8) { pg8::Gemm g{(const bf16_t*)(ws + WS_H), (const bf16_t*)(ws + WS_BT1), NTOK, N1, 1024, 1024, 1}; pg8::Order S; S.init(NTOK, N1, 1, gridDim.x, blockIdx.x);
               pg8::EpiBf16 E{(bf16_t*)(ws + WS_P), N1, 0}; pg8::gemm_phase(ldsl, g, S, E); }
    PHASE(9) phase_gla_a(p, ldsf);
    PHASE(10) phase_gla_b(p, ldsf, rep);
    PHASE(11) phase_gla_post(p);
    PHASE(12) { pg8::Gemm g{(const bf16_t*)(ws + WS_OC), (const bf16_t*)(ws + WS_WT1O), NTOK, 1024, 512, 1024, 2}; pg8::Order S; S.init(NTOK, 1024, 2, gridDim.x, blockIdx.x);
                pg8::EpiBf16 E{(bf16_t*)(ws + WS_P2), 1024, (size_t)NTOK * 1024}; pg8::gemm_phase(ldsl, g, S, E); }
    PHASE(13) phase_final(p);
}

extern "C" void kernel_launch(void* const* d_in, const int* in_sizes, int n_in, void* d_out, int out_size, void* d_ws, size_t ws_size, hipStream_t stream) {
    static int grid = 0;
    if (grid == 0) {
        if (n_in != 30 || ws_size < WS_END) { fprintf(stderr, "kernel_launch: unexpected n_in %d / ws_size %zu (need %zu)\n", n_in, ws_size, (size_t)WS_END); grid = -1; return; }
        int dev = 0, cus = 0, per_cu = 0;
        hipGetDevice(&dev);
        hipDeviceGetAttribute(&cus, hipDeviceAttributeMultiprocessorCount, dev);
        hipFuncSetAttribute((const void*)fwd_megakernel, hipFuncAttributeMaxDynamicSharedMemorySize, LDS_BYTES);
        hipOccupancyMaxActiveBlocksPerMultiprocessor(&per_cu, (const void*)fwd_megakernel, NTHR, LDS_BYTES);
        if (per_cu < 1) { fprintf(stderr, "kernel_launch: occupancy query returned %d\n", per_cu); per_cu = 1; }
        grid = cus * per_cu;
        (void)hipGetLastError();
    }
    if (grid < 0) return;
    static_assert(XCD_BAR_WORDS * 4 <= 14336, "barrier words overlap the queue counters");
    hipMemsetAsync((char*)d_ws + WS_BAR, 0, 14336 + 256, stream);
    Params p{};
    for (int i = 0; i < 30; ++i) p.in[i] = (const float*)d_in[i];
    p.out = (float*)d_out; p.ws = (unsigned char*)d_ws;
#if MULTI_LAUNCH
    for (int ph = 0; ph < NPHASE; ++ph) { p.ph_lo = ph; p.ph_hi = ph + 1; hipLaunchKernelGGL(fwd_megakernel, dim3(grid), dim3(NTHR), LDS_BYTES, stream, p); }
#else
    p.ph_lo = 0; p.ph_hi = NPHASE;
    void* args[] = {&p};
    hipError_t e = hipLaunchCooperativeKernel((const void*)fwd_megakernel, dim3(grid), dim3(NTHR), args, LDS_BYTES, stream);
    if (e != hipSuccess) fprintf(stderr, "cooperative launch failed: %s (grid %d)\n", hipGetErrorString(e), grid);
#endif
}
```

```cpp
#include <hip/hip_runtime.h>
#include <hip/hip_cooperative_groups.h>
#include <cstdio>
namespace cg = cooperative_groups;

#define LAS __attribute__((address_space(3)))
typedef unsigned short bf16_t;
typedef short bf16x8 __attribute__((ext_vector_type(8)));
typedef float f32x4 __attribute__((ext_vector_type(4)));
typedef unsigned u32x4 __attribute__((ext_vector_type(4)));
typedef unsigned u32x2 __attribute__((ext_vector_type(2)));

#ifndef MULTI_LAUNCH
#define MULTI_LAUNCH 0
#endif

constexpr int D = 1024, NTOK = 8192, NPTOK = 4096;
constexpr int N0 = 8448;
constexpr int N1 = 3328;
constexpr int NTHR = 512;
constexpr int LDS_MAIN = 139264;
constexpr int LDS_BYTES = LDS_MAIN + 256;

constexpr size_t MB = 1024 * 1024;
constexpr size_t WS_CTL = 0x1A0000 + 14336;
constexpr size_t WS_MOD = 4096;
constexpr size_t WS_BON = WS_MOD + 2 * 3 * 3072 * 4;
constexpr size_t WS_BAR = 0x1A0000;
constexpr size_t WS_BT0 = 2 * MB;
constexpr size_t WS_WT0O = WS_BT0 + (size_t)N0 * 1024 * 2;
constexpr size_t WS_BT1 = WS_WT0O + (size_t)1024 * 2048 * 2;
constexpr size_t WS_WT1O = WS_BT1 + (size_t)N1 * 1024 * 2;
constexpr size_t WS_H = WS_WT1O + (size_t)1024 * 1024 * 2;
constexpr size_t WS_OC = WS_H + (size_t)NTOK * 1024 * 2;
constexpr size_t WS_X1 = WS_OC + (size_t)NTOK * 2048 * 2;
constexpr size_t WS_P = WS_X1 + (size_t)NTOK * 1024 * 4;
constexpr size_t WS_P2 = WS_P + 64 * MB;
constexpr size_t WS_END = WS_P + (size_t)NTOK * N0 * 2;

struct Params {
    const float* in[30];
    float* out;
    unsigned char* ws;
    int ph_lo, ph_hi;
};

__device__ __forceinline__ float bf2f(bf16_t h) { return __uint_as_float(((unsigned)h) << 16); }
__device__ __forceinline__ bf16_t f2bf(float f) { unsigned u = __float_as_uint(f); u += 0x7FFFu + ((u >> 16) & 1u); return (bf16_t)(u >> 16); }
__device__ __forceinline__ unsigned pack2(float lo, float hi) { return (unsigned)f2bf(lo) | ((unsigned)f2bf(hi) << 16); }
__device__ __forceinline__ float bflo(unsigned w) { return __uint_as_float(w << 16); }
__device__ __forceinline__ float bfhi(unsigned w) { return __uint_as_float(w & 0xFFFF0000u); }
__device__ __forceinline__ float fexp(float x) { return __builtin_amdgcn_exp2f(x * 1.44269504f); }
__device__ __forceinline__ float flog(float x) { return __builtin_amdgcn_logf(x) * 0.69314718f; }
__device__ __forceinline__ float silu(float x) { return x * __builtin_amdgcn_rcpf(1.f + fexp(-x)); }
__device__ __forceinline__ float wave_sum(float v) {
#pragma unroll
    for (int m = 32; m >= 1; m >>= 1) v += __shfl_xor(v, m, 64);
    return v;
}

typedef float f32x2_t __attribute__((ext_vector_type(2)));
typedef __bf16 bf16x2_t __attribute__((ext_vector_type(2)));
__device__ __forceinline__ unsigned pk2(float lo, float hi) { const f32x2_t v = {lo, hi}; return __builtin_bit_cast(unsigned, __builtin_convertvector(v, bf16x2_t)); }
__device__ __forceinline__ bf16_t f2bf_hw(float f) { return __builtin_bit_cast(bf16_t, (__bf16)f); }

__device__ __forceinline__ void lds_barrier() { asm volatile("s_waitcnt lgkmcnt(0)" ::: "memory"); __builtin_amdgcn_s_barrier(); asm volatile("" ::: "memory"); }

namespace pg8 {
constexpr int BM = 256, BK = 64, HALF = 128, HTB = HALF * BK * 2, NXCD = 8, WGM = 8;
__device__ __forceinline__ int lds_byte(int r, int c) { const int st = (r >> 4) * 2 + (c >> 5), rr = r & 15, cc = c & 31, ob = rr * 64 + cc * 2; return st * 1024 + (ob ^ (((ob >> 9) & 1) << 5)); }
__device__ __forceinline__ void stage_rc(int b, int& R, int& C) { const int st = b / 1024, sb = b % 1024, swz = sb ^ (((sb >> 9) & 1) << 5); R = (st >> 1) * 16 + swz / 64; C = (st & 1) * 32 + (swz % 64) / 2; }
__device__ __forceinline__ int perm32(int rho) { const int n = rho >> 4, i = rho & 15; return 8 * (i >> 2) + 4 * n + (i & 3); }

struct Unit { int pm, pn, ks; };
struct Gemm { const bf16_t* A; const bf16_t* Bt; int M, N, K, ld, KS; };

struct Order {
    int nM, nN, nNr, nwg, G, c;
    __device__ void init(int M, int N, int KS, int G_, int c_) { nM = M / BM; nNr = N / BM; nN = nNr * KS; nwg = nM * nN; G = G_; c = c_; }
    __device__ bool next(int i, Unit& u) const {
        const long L = (long)i * G + c; if (L >= nwg) return false;
        int wgid = (int)L; { const int q = nwg / NXCD, r = nwg % NXCD, xcd = wgid % NXCD, off = wgid / NXCD; wgid = (xcd < r ? xcd * (q + 1) : r * (q + 1) + (xcd - r) * q) + off; }
        const int nig = WGM * nN, gid = wgid / nig, fm = gid * WGM, gsz = (nM - fm) < WGM ? (nM - fm) : WGM;
        u.pm = fm + ((wgid % nig) % gsz); const int pn = (wgid % nig) / gsz; u.pn = pn % nNr; u.ks = pn / nNr; return true;
    }
};

__device__ __forceinline__ unsigned cvt_pk_bf16(float lo, float hi) { unsigned r; asm volatile("v_cvt_pk_bf16_f32 %0, %1, %2" : "=v"(r) : "v"(lo), "v"(hi)); return r; }

struct EpiF32 {
    static constexpr bool PERM = false;
    float* C; int ldc; size_t ks_stride;
    __device__ __forceinline__ void operator()(const f32x4 (&acc)[2][2][4][2], const Unit& u, int wr, int wc, int fr, int fq) const {
        const int row0 = u.pm * BM + wr * 64 + fr, col0 = u.pn * BM + wc * 32 + 4 * fq;
        float* Cb = C + (size_t)u.ks * ks_stride;
#pragma unroll
        for (int ai = 0; ai < 2; ++ai)
#pragma unroll
            for (int m = 0; m < 4; ++m) { float* rowp = Cb + (size_t)(row0 + ai * HALF + m * 16) * ldc + col0;
#pragma unroll
                for (int bj = 0; bj < 2; ++bj)
#pragma unroll
                    for (int n = 0; n < 2; ++n) *(f32x4*)(rowp + bj * HALF + n * 16) = acc[ai][bj][m][n]; }
    }
};
struct EpiBf16 {
    static constexpr bool PERM = true;
    bf16_t* O; int ldc; size_t ks_stride;
    __device__ __forceinline__ void operator()(const f32x4 (&acc)[2][2][4][2], const Unit& u, int wr, int wc, int fr, int fq) const {
        const int row0 = u.pm * BM + wr * 64 + fr; const int col0 = u.pn * BM + wc * 32 + 8 * fq;
        bf16_t* Ob = O + (size_t)u.ks * ks_stride;
#pragma unroll
        for (int ai = 0; ai < 2; ++ai)
#pragma unroll
            for (int m = 0; m < 4; ++m) { bf16_t* rowp = Ob + (size_t)(row0 + ai * HALF + m * 16) * ldc + col0;
#pragma unroll
                for (int bj = 0; bj < 2; ++bj) { const f32x4 v0 = acc[ai][bj][m][0], v1 = acc[ai][bj][m][1];
                    u32x4 w; w.x = cvt_pk_bf16(v0[0], v0[1]); w.y = cvt_pk_bf16(v0[2], v0[3]); w.z = cvt_pk_bf16(v1[0], v1[1]); w.w = cvt_pk_bf16(v1[2], v1[3]);
                    *(u32x4*)(rowp + bj * HALF) = w; } }
    }
};

template <class Epi>
__device__ __forceinline__ void gemm_phase(LAS unsigned char* lds, const Gemm g, const Order& S, const Epi& E) {
    const int tid = threadIdx.x, wid = __builtin_amdgcn_readfirstlane(tid >> 6), lane = tid & 63, wr = wid >> 2, wc = wid & 3, fr = lane & 15, fq = lane >> 4;
    const int K = g.K, nt = K / BK, ld = g.ld;
    unsigned voffA[2], voffB[2];
#pragma unroll
    for (int i = 0; i < 2; ++i) { int R, C; stage_rc(tid * 16 + i * 8192, R, C); const int Rb = Epi::PERM ? ((R & ~31) + perm32(R & 31)) : R;
        voffA[i] = (unsigned)(R * ld + C) * 2u; voffB[i] = (unsigned)(Rb * ld + C) * 2u; }
    const size_t kstep = (size_t)(BK * 2);
    const size_t hstep = (size_t)HALF * ld * 2;
    const size_t tstep = 2 * hstep;
    const size_t ksb = (size_t)K * 2;
    const unsigned ldsw = (unsigned)wid * 1024u;
    const int aoff = lds_byte(wr * 64 + fr, fq * 8), boff = lds_byte(wc * 32 + fr, fq * 8);
#define PG8_SA(b, h) (((b) * 2 + (h)) * HTB)
#define PG8_SB(b, h) ((4 + (b) * 2 + (h)) * HTB)
#define PG8_STAGE(bufoff, gbase, voff) do { _Pragma("unroll") for (int _i = 0; _i < 2; ++_i) \
        __builtin_amdgcn_global_load_lds((const unsigned*)((const char*)(gbase) + (voff)[_i]), (LAS unsigned*)(lds + (bufoff) + ldsw + _i * 8192), 16, 0, 0); } while (0)
#define PG8_LDA(dst, b, h) do { _Pragma("unroll") for (int m = 0; m < 4; ++m) _Pragma("unroll") for (int k = 0; k < 2; ++k) dst[m][k] = *(const LAS bf16x8*)(lds + PG8_SA(b, h) + aoff + m * 2048 + k * 1024); } while (0)
#define PG8_LDB(dst, b, h) do { _Pragma("unroll") for (int n = 0; n < 2; ++n) _Pragma("unroll") for (int k = 0; k < 2; ++k) dst[n][k] = *(const LAS bf16x8*)(lds + PG8_SB(b, h) + boff + n * 2048 + k * 1024); } while (0)
#define PG8_MMA(ai, bj, At, Bt) do { __builtin_amdgcn_s_setprio(1); _Pragma("unroll") for (int m = 0; m < 4; ++m) _Pragma("unroll") for (int n = 0; n < 2; ++n) _Pragma("unroll") for (int k = 0; k < 2; ++k) \
        acc[ai][bj][m][n] = __builtin_amdgcn_mfma_f32_16x16x32_bf16(Bt[n][k], At[m][k], acc[ai][bj][m][n], 0, 0, 0); __builtin_amdgcn_s_setprio(0); } while (0)
#define PG8_WAIT_V(n) asm volatile("s_waitcnt vmcnt(" #n ")" ::: "memory")
#define PG8_WAIT_L(n) asm volatile("s_waitcnt lgkmcnt(" #n ")" ::: "memory")
#define PG8_BAR __builtin_amdgcn_s_barrier()
#define PG8_SCHED __builtin_amdgcn_sched_barrier(0)
    Unit cur, nxt; int ui = 0;
    if (!S.next(0, cur)) return;
    f32x4 acc[2][2][4][2];
#pragma unroll
    for (int a = 0; a < 2; ++a)
#pragma unroll
        for (int b = 0; b < 2; ++b)
#pragma unroll
            for (int m = 0; m < 4; ++m)
#pragma unroll
                for (int n = 0; n < 2; ++n) acc[a][b][m][n] = (f32x4){0.f, 0.f, 0.f, 0.f};
    bf16x8 At[4][2], B0[2][2], B1[2][2];
    const char* cA = (const char*)g.A + (size_t)cur.pm * tstep + (size_t)cur.ks * ksb; const char* cB = (const char*)g.Bt + (size_t)cur.pn * tstep + (size_t)cur.ks * ksb;
    PG8_STAGE(PG8_SB(0, 0), cB, voffB); PG8_STAGE(PG8_SA(0, 0), cA, voffA); PG8_STAGE(PG8_SB(0, 1), cB + hstep, voffB); PG8_STAGE(PG8_SA(0, 1), cA + hstep, voffA);
    if (wr == 1) PG8_BAR;
    PG8_WAIT_V(4); PG8_BAR;
    PG8_STAGE(PG8_SB(1, 0), cB + kstep, voffB); PG8_STAGE(PG8_SA(1, 0), cA + kstep, voffA); PG8_STAGE(PG8_SB(1, 1), cB + hstep + kstep, voffB);
    PG8_WAIT_V(6); PG8_BAR;
    for (;;) {
        const bool has_next = S.next(ui + 1, nxt);
        const char* nA = has_next ? (const char*)g.A + (size_t)nxt.pm * tstep + (size_t)nxt.ks * ksb : cA; const char* nB = has_next ? (const char*)g.Bt + (size_t)nxt.pn * tstep + (size_t)nxt.ks * ksb : cB;
        for (int t = 0; t < nt; t += 2) {
            const bool last = (t == nt - 2);
            const char* a1 = cA + (size_t)(t + 1) * kstep;
            const char* a2 = last ? nA : cA + (size_t)(t + 2) * kstep; const char* b2 = last ? nB : cB + (size_t)(t + 2) * kstep;
            const char* a3 = a2 + kstep; const char* b3 = b2 + kstep;
            PG8_LDB(B0, 0, 0); PG8_SCHED; PG8_LDA(At, 0, 0); PG8_STAGE(PG8_SA(1, 1), a1 + hstep, voffA);
            PG8_WAIT_L(8); PG8_BAR; PG8_WAIT_L(0); PG8_MMA(0, 0, At, B0); PG8_BAR; PG8_SCHED;
            PG8_LDB(B1, 0, 1); PG8_STAGE(PG8_SB(0, 0), b2, voffB);
            PG8_BAR; PG8_WAIT_L(0); PG8_MMA(0, 1, At, B1); PG8_BAR;
            PG8_LDA(At, 0, 1); PG8_STAGE(PG8_SA(0, 0), a2, voffA);
            PG8_BAR; PG8_WAIT_L(0); PG8_MMA(1, 0, At, B0); PG8_BAR; PG8_SCHED;
            PG8_STAGE(PG8_SB(0, 1), b2 + hstep, voffB);
            PG8_WAIT_V(6); PG8_BAR; PG8_MMA(1, 1, At, B1); PG8_BAR;
            PG8_LDB(B0, 1, 0); PG8_SCHED; PG8_LDA(At, 1, 0); PG8_STAGE(PG8_SA(0, 1), a2 + hstep, voffA);
            PG8_WAIT_L(8); PG8_BAR; PG8_WAIT_L(0); PG8_MMA(0, 0, At, B0); PG8_BAR; PG8_SCHED;
            PG8_LDB(B1, 1, 1); PG8_STAGE(PG8_SB(1, 0), b3, voffB);
            PG8_BAR; PG8_WAIT_L(0); PG8_MMA(0, 1, At, B1); PG8_BAR;
            PG8_LDA(At, 1, 1); PG8_STAGE(PG8_SA(1, 0), a3, voffA);
            PG8_BAR; PG8_WAIT_L(0); PG8_MMA(1, 0, At, B0); PG8_BAR; PG8_SCHED;
            PG8_STAGE(PG8_SB(1, 1), b3 + hstep, voffB);
            PG8_WAIT_V(6); PG8_BAR; PG8_MMA(1, 1, At, B1); PG8_BAR;
        }
        E(acc, cur, wr, wc, fr, fq);
        if (!has_next) break;
#pragma unroll
        for (int a = 0; a < 2; ++a)
#pragma unroll
            for (int b = 0; b < 2; ++b)
#pragma unroll
                for (int m = 0; m < 4; ++m)
#pragma unroll
                    for (int n = 0; n < 2; ++n) acc[a][b][m][n] = (f32x4){0.f, 0.f, 0.f, 0.f};
        cur = nxt; cA = nA; cB = nB; ++ui;
    }
    PG8_WAIT_V(0);
    if (wr == 0) PG8_BAR;
    PG8_BAR;
#undef PG8_SA
#undef PG8_SB
#undef PG8_STAGE
#undef PG8_LDA
#undef PG8_LDB
#undef PG8_MMA
#undef PG8_WAIT_V
#undef PG8_WAIT_L
#undef PG8_BAR
#undef PG8_SCHED
}
}

struct TJob { const float* src; bf16_t* dst; int ldsrc, N, lddst, drow0, k0, n0; };
__device__ __forceinline__ TJob tjob_of(const Params& p, int t) {
    unsigned char* ws = p.ws;
    bf16_t* BT0 = (bf16_t*)(ws + WS_BT0); bf16_t* WT0O = (bf16_t*)(ws + WS_WT0O); bf16_t* BT1 = (bf16_t*)(ws + WS_BT1); bf16_t* WT1O = (bf16_t*)(ws + WS_WT1O);
    TJob j; int nnt;
    if (t < 1024) { j.src = p.in[10]; j.ldsrc = 8192; j.N = 8192; j.dst = BT0; j.lddst = 1024; j.drow0 = 0; nnt = 64; }
    else if (t < 1024 + 32) { t -= 1024; const int z = t >> 4; t &= 15; j.src = p.in[14] + (size_t)z * 1024 * 64; j.ldsrc = 64; j.N = 64; j.dst = BT0; j.lddst = 1024; j.drow0 = 8192 + z * 64; nnt = 1; }
    else if (t < 1024 + 64) { t -= 1024 + 32; const int z = t >> 4; t &= 15; j.src = p.in[17] + (size_t)z * 1024 * 64; j.ldsrc = 64; j.N = 64; j.dst = BT0; j.lddst = 1024; j.drow0 = 8320 + z * 64; nnt = 1; }
    else if (t < 1088 + 256) { t -= 1088; j.src = p.in[11]; j.ldsrc = 1024; j.N = 1024; j.dst = WT0O; j.lddst = 2048; j.drow0 = 0; nnt = 8; }
    else if (t < 1344 + 384) { t -= 1344; j.src = p.in[24]; j.ldsrc = 3072; j.N = 3072; j.dst = BT1; j.lddst = 1024; j.drow0 = 0; nnt = 24; }
    else if (t < 1728 + 32) { t -= 1728; const int z = t >> 4; t &= 15; j.src = p.in[26] + (size_t)z * 1024 * 16; j.ldsrc = 16; j.N = 16; j.dst = BT1; j.lddst = 1024; j.drow0 = 3072 + z * 16; nnt = 1; }
    else { t -= 1760; j.src = p.in[25]; j.ldsrc = 1024; j.N = 1024; j.dst = WT1O; j.lddst = 1024; j.drow0 = 0; nnt = 8; }
    j.k0 = (t / nnt) * 64; j.n0 = (t % nnt) * 128; return j;
}
__device__ __forceinline__ void tjob_load(const TJob& j, f32x4 (&r)[4]) {
    const int tid = threadIdx.x, c4 = (tid & 31) * 4;
#pragma unroll
    for (int i = 0; i < 4; ++i) { const int kk = (tid >> 5) + 16 * i;
        r[i] = (j.n0 + c4 < j.N) ? *(const f32x4*)(j.src + (size_t)(j.k0 + kk) * j.ldsrc + j.n0 + c4) : (f32x4){0.f, 0.f, 0.f, 0.f}; }
}

__device__ void transpose_jobs(const Params& p, float* lds, int t_lo, int t_hi, int rot) {
    const int tid = threadIdx.x;
    float* tile = lds;
    int it = t_lo + (int)((blockIdx.x + (unsigned)rot) % gridDim.x);
    f32x4 cur[4], nxt[4];
    TJob jc = tjob_of(p, it < t_hi ? it : t_lo);
    if (it < t_hi) tjob_load(jc, cur);
    for (; it < t_hi; it += gridDim.x) {
        const int c4 = (tid & 31) * 4;
#pragma unroll
        for (int i = 0; i < 4; ++i) { const int kk = (tid >> 5) + 16 * i; tile[kk * 129 + c4] = cur[i][0]; tile[kk * 129 + c4 + 1] = cur[i][1]; tile[kk * 129 + c4 + 2] = cur[i][2]; tile[kk * 129 + c4 + 3] = cur[i][3]; }
        const int itn = it + gridDim.x;
        const TJob jn = tjob_of(p, itn < t_hi ? itn : t_lo);
        if (itn < t_hi) tjob_load(jn, nxt);
        __syncthreads();
#pragma unroll
        for (int q = 0; q < 2; ++q) { const int idx = tid + q * NTHR; const int nn = idx >> 3, k8 = (idx & 7) * 8;
            if (jc.n0 + nn < jc.N) { u32x4 o; o.x = pk2(tile[(k8 + 0) * 129 + nn], tile[(k8 + 1) * 129 + nn]); o.y = pk2(tile[(k8 + 2) * 129 + nn], tile[(k8 + 3) * 129 + nn]);
                o.z = pk2(tile[(k8 + 4) * 129 + nn], tile[(k8 + 5) * 129 + nn]); o.w = pk2(tile[(k8 + 6) * 129 + nn], tile[(k8 + 7) * 129 + nn]);
                *(u32x4*)(jc.dst + (size_t)(jc.drow0 + jc.n0 + nn) * jc.lddst + jc.k0 + k8) = o; } }
        __syncthreads();
        jc = jn;
#pragma unroll
        for (int i = 0; i < 4; ++i) cur[i] = nxt[i];
    }
}

__device__ void phase_prologue(const Params& p, float* lds) {
    const int tid = threadIdx.x;
    unsigned char* ws = p.ws;
    bf16_t* BT1 = (bf16_t*)(ws + WS_BT1);
    float* MOD = (float*)(ws + WS_MOD);
    constexpr int NGEMV = 192;
    for (int it = blockIdx.x; it < NGEMV; it += gridDim.x) {
        const int l = it / 96, j0 = (it % 96) * 32;
        float* sc = lds;
        float* red = lds + 3072;
        for (int i = tid; i < 3072; i += NTHR) { const int cnd = i >> 10, k = i & 1023; const float v = cnd == 0 ? p.in[5][k] : p.in[4][(cnd - 1) * 1024 + k]; sc[i] = silu(v); }
        __syncthreads();
        const int col = tid & 31, ksp = tid >> 5;
        float a0 = 0.f, a1 = 0.f, a2 = 0.f;
        const float* w = p.in[7] + (size_t)l * 1024 * 3072 + j0 + col;
#pragma unroll 16
        for (int k = ksp * 64; k < ksp * 64 + 64; ++k) { const float wv = w[(size_t)k * 3072]; a0 += sc[k] * wv; a1 += sc[1024 + k] * wv; a2 += sc[2048 + k] * wv; }
        red[(ksp * 3 + 0) * 32 + col] = a0; red[(ksp * 3 + 1) * 32 + col] = a1; red[(ksp * 3 + 2) * 32 + col] = a2;
        __syncthreads();
        if (tid < 96) { const int cnd = tid >> 5, cc = tid & 31; float s = 0.f; for (int q = 0; q < 16; ++q) s += red[(q * 3 + cnd) * 32 + cc];
            MOD[(l * 3 + cnd) * 3072 + j0 + cc] = s + p.in[8][l * 3072 + j0 + cc]; }
        __syncthreads();
    }
    transpose_jobs(p, lds, 0, 1088, 64);
}
__device__ void phase_late_weights(const Params& p, float* lds) {
    const int tid = threadIdx.x;
    bf16_t* BT1 = (bf16_t*)(p.ws + WS_BT1);
    transpose_jobs(p, lds, 1088, 1888, 0);
    { u32x4* z = (u32x4*)(BT1 + (size_t)3104 * 1024); const int n = 224 * 1024 * 2 / 16;
      for (int i = blockIdx.x * NTHR + tid; i < n; i += gridDim.x * NTHR) z[i] = (u32x4){0u, 0u, 0u, 0u}; }
}

__device__ void phase_h(const Params& p, int layer, float* ldsf) {
    const int tid = threadIdx.x, wave = __builtin_amdgcn_readfirstlane(tid >> 6), lane = tid & 63, fr = lane & 15, fq = lane >> 4;
    unsigned char* ws = p.ws;
    const float* MOD = (const float*)(ws + WS_MOD);
    bf16_t* H = (bf16_t*)(ws + WS_H);
    float* X1 = (float*)(ws + WS_X1);
    const bf16_t* Y = (const bf16_t*)(ws + WS_P);
    bf16_t* HL = (bf16_t*)ldsf;
    for (int tb = blockIdx.x * 32; tb < NTOK; tb += gridDim.x * 32) {
#pragma unroll 1
        for (int q = 0; q < 4; ++q) { const int tl = wave * 4 + q, tok = tb + tl;
            const float* xr = tok < NPTOK ? p.in[0] + (size_t)tok * D : p.in[1] + (size_t)(tok - NPTOK) * D;
            const int cond = tok < NPTOK ? 0 : 1 + ((tok - NPTOK) >> 11);
            f32x4 xv[4]; float ss = 0.f;
#pragma unroll
            for (int i = 0; i < 4; ++i) { const int idx = i * 256 + lane * 4; xv[i] = *(const f32x4*)(xr + idx);
                if (layer == 1) { const u32x2 pa = *(const u32x2*)(Y + (size_t)tok * D + idx), pb = *(const u32x2*)(Y + (size_t)NTOK * D + (size_t)tok * D + idx);
                    const f32x4 ya = (f32x4){bflo(pa.x), bfhi(pa.x), bflo(pa.y), bfhi(pa.y)}, yb = (f32x4){bflo(pb.x), bfhi(pb.x), bflo(pb.y), bfhi(pb.y)};
                    const f32x4 gt = *(const f32x4*)(MOD + (0 * 3 + cond) * 3072 + 2048 + idx);
                    xv[i] = xv[i] + gt * (ya + yb); *(f32x4*)(X1 + (size_t)tok * D + idx) = xv[i]; }
                ss += xv[i][0] * xv[i][0] + xv[i][1] * xv[i][1] + xv[i][2] * xv[i][2] + xv[i][3] * xv[i][3]; }
            ss = wave_sum(ss);
            const float rstd = rsqrtf(ss * (1.f / 1024.f) + 1e-6f);
#pragma unroll
            for (int i = 0; i < 4; ++i) { const int idx = i * 256 + lane * 4;
                const f32x4 g = *(const f32x4*)(p.in[6] + layer * D + idx);
                const f32x4 sh = *(const f32x4*)(MOD + (layer * 3 + cond) * 3072 + idx), sc = *(const f32x4*)(MOD + (layer * 3 + cond) * 3072 + 1024 + idx);
                f32x4 h;
#pragma unroll
                for (int j = 0; j < 4; ++j) h[j] = xv[i][j] * rstd * g[j] * (1.f + sc[j]) + sh[j];
                u32x2 w2; w2.x = pk2(h[0], h[1]); w2.y = pk2(h[2], h[3]);
                *(u32x2*)(H + (size_t)tok * D + idx) = w2;
                if (layer == 0) *(u32x2*)(HL + tl * 1032 + idx) = w2; } }
        if (layer == 0) {
            __syncthreads();
            const bf16_t* BL = (const bf16_t*)(ws + WS_BT0) + (size_t)8192 * 1024;
            bf16_t* P = (bf16_t*)(ws + WS_P);
            f32x4 acc[2][2];
#pragma unroll
            for (int mt = 0; mt < 2; ++mt)
#pragma unroll
                for (int n2 = 0; n2 < 2; ++n2) acc[mt][n2] = (f32x4){0.f, 0.f, 0.f, 0.f};
#pragma unroll 16
            for (int ks = 0; ks < 32; ++ks) {
                bf16x8 af[2], bfr[2];
#pragma unroll
                for (int mt = 0; mt < 2; ++mt) af[mt] = *(const bf16x8*)(HL + (mt * 16 + fr) * 1032 + ks * 32 + fq * 8);
#pragma unroll
                for (int n2 = 0; n2 < 2; ++n2) bfr[n2] = *(const bf16x8*)(BL + (size_t)((wave * 2 + n2) * 16 + fr) * 1024 + ks * 32 + fq * 8);
#pragma unroll
                for (int mt = 0; mt < 2; ++mt)
#pragma unroll
                    for (int n2 = 0; n2 < 2; ++n2) acc[mt][n2] = __builtin_amdgcn_mfma_f32_16x16x32_bf16(bfr[n2], af[mt], acc[mt][n2], 0, 0, 0);
            }
#pragma unroll
            for (int mt = 0; mt < 2; ++mt)
#pragma unroll
                for (int n2 = 0; n2 < 2; ++n2)
                    { u32x2 o2; o2.x = pk2(acc[mt][n2][0], acc[mt][n2][1]); o2.y = pk2(acc[mt][n2][2], acc[mt][n2][3]);
                      *(u32x2*)(P + (size_t)(tb + mt * 16 + fr) * N0 + 8192 + (wave * 2 + n2) * 16 + fq * 4) = o2; }
            __syncthreads();
        }
    }
}

__device__ __forceinline__ f32x4 mma_nt(const bf16_t* A, int lda, const bf16_t* B, int ldb, int K, f32x4 acc, int fr, int fq) {
    for (int k0 = 0; k0 < K; k0 += 32) {
        const bf16x8 a = *(const bf16x8*)(A + fr * lda + k0 + fq * 8);
        const bf16x8 b = *(const bf16x8*)(B + fr * ldb + k0 + fq * 8);
        acc = __builtin_amdgcn_mfma_f32_16x16x32_bf16(a, b, acc, 0, 0, 0);
    }
    return acc;
}
__device__ __forceinline__ bf16x8 pack8(float a0, float a1, float a2, float a3, float a4, float a5, float a6, float a7) {
    u32x4 w; w.x = pack2(a0, a1); w.y = pack2(a2, a3); w.z = pack2(a4, a5); w.w = pack2(a6, a7);
    return __builtin_bit_cast(bf16x8, w);
}
__device__ __forceinline__ float dpp_add(float v, float o) { return v + o; }
__device__ __forceinline__ float wave_sum_fast(float v) {
    v += __int_as_float(__builtin_amdgcn_update_dpp(0, __float_as_int(v), 0xB1, 0xF, 0xF, true));
    v += __int_as_float(__builtin_amdgcn_update_dpp(0, __float_as_int(v), 0x4E, 0xF, 0xF, true));
    v += __int_as_float(__builtin_amdgcn_update_dpp(0, __float_as_int(v), 0x141, 0xF, 0xF, true));
    v += __int_as_float(__builtin_amdgcn_update_dpp(0, __float_as_int(v), 0x140, 0xF, 0xF, true));
    v += __shfl_xor(v, 16, 64); v += __shfl_xor(v, 32, 64);
    return v;
}
__device__ __forceinline__ float wave_sum_dpp(float v) {
    v += __int_as_float(__builtin_amdgcn_update_dpp(0, __float_as_int(v), 0xB1, 0xF, 0xF, true));
    v += __int_as_float(__builtin_amdgcn_update_dpp(0, __float_as_int(v), 0x4E, 0xF, 0xF, true));
    v += __int_as_float(__builtin_amdgcn_update_dpp(0, __float_as_int(v), 0x141, 0xF, 0xF, true));
    v += __int_as_float(__builtin_amdgcn_update_dpp(0, __float_as_int(v), 0x140, 0xF, 0xF, true));
    v += __int_as_float(__builtin_amdgcn_update_dpp(0, __float_as_int(v), 0x142, 0xA, 0xF, false));
    v += __int_as_float(__builtin_amdgcn_update_dpp(0, __float_as_int(v), 0x143, 0xC, 0xF, false));
    return __int_as_float(__builtin_amdgcn_readlane(__float_as_int(v), 63));
}
__device__ __forceinline__ float wave_sum_lane63(float v) {
    v += __int_as_float(__builtin_amdgcn_update_dpp(0, __float_as_int(v), 0xB1, 0xF, 0xF, true));
    v += __int_as_float(__builtin_amdgcn_update_dpp(0, __float_as_int(v), 0x4E, 0xF, 0xF, true));
    v += __int_as_float(__builtin_amdgcn_update_dpp(0, __float_as_int(v), 0x141, 0xF, 0xF, true));
    v += __int_as_float(__builtin_amdgcn_update_dpp(0, __float_as_int(v), 0x140, 0xF, 0xF, true));
    v += __int_as_float(__builtin_amdgcn_update_dpp(0, __float_as_int(v), 0x142, 0xA, 0xF, false));
    v += __int_as_float(__builtin_amdgcn_update_dpp(0, __float_as_int(v), 0x143, 0xC, 0xF, false));
    return v;
}
__device__ __forceinline__ float fast_tanh(float x) { const float e = fexp(2.f * x); return 1.f - 2.f * __builtin_amdgcn_rcpf(1.f + e); }
__device__ __forceinline__ bf16x8 pack8h(float a0, float a1, float a2, float a3, float a4, float a5, float a6, float a7) {
    u32x4 w; w.x = pk2(a0, a1); w.y = pk2(a2, a3); w.z = pk2(a4, a5); w.w = pk2(a6, a7);
    return __builtin_bit_cast(bf16x8, w);
}

__device__ void wkv_unit(const Params& p, int u, float* ldsf) {
    const int tid0 = threadIdx.x, lane0 = tid0 & 63, w = __builtin_amdgcn_readfirstlane(tid0 >> 6), fr0 = lane0 & 15, fq0 = lane0 >> 4;
    unsigned char* ws = p.ws;
    unsigned char* lds = (unsigned char*)ldsf;
    const bf16_t* P = (const bf16_t*)(ws + WS_P);
    bf16_t* OD = (bf16_t*)(ws + WS_X1);
    float* BON = (float*)(ws + WS_BON);
    int z, b, hd, sgm, seqT, tok0; bool sample; const int T = 256;
    if (u < 512) { sample = true; z = u >> 8; b = (u >> 7) & 1; hd = (u >> 3) & 15; sgm = u & 7; seqT = 2048; tok0 = NPTOK + b * 2048; }
    else { const int q = u - 512; sample = false; z = q >> 8; b = (q >> 4) & 15; hd = q & 15; sgm = 0; seqT = 256; tok0 = b * 256; }
    const int qbase = sgm * 256;
    bf16_t* RHO = (bf16_t*)(ws + WS_H);
    float* GH = (float*)(ws + WS_BT0);
    bf16_t* TLW = (bf16_t*)(lds + 0);
    bf16_t* TLA = (bf16_t*)(lds + 9216);
    float* HT = (float*)(lds + 18432);
    float* BONL = (float*)(lds + 57344);
    bf16_t* KTr = (bf16_t*)(lds + 20480);
    bf16_t* BTr = (bf16_t*)(lds + 29696);
    bf16_t* KKH = (bf16_t*)(lds + 38912);
    bf16_t* RH = (bf16_t*)(lds + 48128);
    const bf16_t* VS = (const bf16_t*)(lds + 113664 + 2 * 8192);
    bf16_t* TA = (bf16_t*)(lds + 65536);
    bf16_t* NA = (bf16_t*)(lds + 70656);
    float* PC = (float*)(lds + 75776);
    bf16_t* KBm = (bf16_t*)(lds + 76800);
    float* MM = (float*)(lds + 97280);
    float* WA = (float*)(lds + 76800);
    bf16x8 bw[2];
    { const float* W2 = (w >> 2) ? p.in[18] : p.in[15];
#pragma unroll
      for (int ks = 0; ks < 2; ++ks) { float t8[8];
#pragma unroll
        for (int e = 0; e < 8; ++e) t8[e] = W2[(size_t)(z * 64 + ks * 32 + fq0 * 8 + e) * 1024 + hd * 64 + (w & 3) * 16 + fr0];
        bw[ks] = pack8h(t8[0], t8[1], t8[2], t8[3], t8[4], t8[5], t8[6], t8[7]); } }
    f32x4 Sacc[4];
#pragma unroll
    for (int kt = 0; kt < 4; ++kt) Sacc[kt] = (f32x4){0.f, 0.f, 0.f, 0.f};
    if (w >= 4) {
#pragma unroll
        for (int kt = 0; kt < 4; ++kt)
#pragma unroll
            for (int jj = 0; jj < 4; ++jj) Sacc[kt][jj] = (kt * 16 + fq0 * 4 + jj == (w - 4) * 16 + fr0) ? 1.f : 0.f; }
    const int ch = hd * 64 + lane0;
    const float w0c = p.in[13][z * 1024 + ch], a0c = p.in[16][z * 1024 + ch], kkc = p.in[19][ch], kac = p.in[20][ch], rkc = p.in[21][ch];
    bf16_t* RKV = (bf16_t*)(lds + 113664);
    u32x4 tlraw[2], rkvraw[3];
#define WKV_LOAD_RAW(tb_) do { \
        _Pragma("unroll") for (int h_ = 0; h_ < 2; ++h_) { const int idx_ = tid + h_ * NTHR; const int tau_ = idx_ >> 4, sg_ = idx_ & 15; const int t_ = z ? (seqT - 1 - (qbase + (tb_) + tau_)) : (qbase + (tb_) + tau_); \
            tlraw[h_] = *(const u32x4*)(P + (size_t)(tok0 + t_) * N0 + 8192 + (sg_ < 8 ? z * 64 + sg_ * 8 : 128 + z * 64 + (sg_ - 8) * 8)); } \
        { const int tau_ = tid >> 3, sg_ = tid & 7; const int t_ = z ? (seqT - 1 - (qbase + (tb_) + tau_)) : (qbase + (tb_) + tau_); const bf16_t* rp_ = P + (size_t)(tok0 + t_) * N0 + 4096 + hd * 64 + sg_ * 8; \
          rkvraw[0] = *(const u32x4*)rp_; rkvraw[1] = *(const u32x4*)(rp_ + 1024); rkvraw[2] = *(const u32x4*)(rp_ + 2048); } } while (0)
    { const int tid = tid0; WKV_LOAD_RAW(0); }
    __syncthreads();
#pragma unroll 1
    for (int tb = 0; tb < T; tb += 64) {
        int tid = tid0; asm volatile("" : "+v"(tid));
        const int lane = tid & 63, fr = lane & 15, fq = lane >> 4, c = lane;
        const int pcol = ((c >> 5) * 32) + (((c >> 2) & 3) * 8) + (((c >> 4) & 1) * 4) + (c & 3);
#pragma unroll
        for (int h = 0; h < 2; ++h) { const int idx = tid + h * NTHR; const int tau = idx >> 4, sg = idx & 15;
            u32x4 o = tlraw[h];
            if (sg < 8) { o.x = pk2(fast_tanh(bflo(o.x)), fast_tanh(bfhi(o.x))); o.y = pk2(fast_tanh(bflo(o.y)), fast_tanh(bfhi(o.y)));
                          o.z = pk2(fast_tanh(bflo(o.z)), fast_tanh(bfhi(o.z))); o.w = pk2(fast_tanh(bflo(o.w)), fast_tanh(bfhi(o.w))); }
            *(u32x4*)((sg < 8 ? TLW : TLA) + tau * 72 + (sg & 7) * 8) = o; }
#pragma unroll
        for (int h = 0; h < 3; ++h) *(u32x4*)(RKV + h * 4096 + (tid >> 3) * 64 + (tid & 7) * 8) = rkvraw[h];
        lds_barrier();
        if (tb + 64 < T) WKV_LOAD_RAW(tb + 64);
        { const bf16_t* TL = (w >> 2) ? TLA : TLW; float* WAo = WA + (w >> 2) * 64 * 68;
#pragma unroll
          for (int mt = 0; mt < 4; ++mt) { f32x4 acc = (f32x4){0.f, 0.f, 0.f, 0.f};
#pragma unroll
            for (int ks = 0; ks < 2; ++ks) { const bf16x8 a = *(const bf16x8*)(TL + (mt * 16 + fr) * 72 + ks * 32 + fq * 8);
                acc = __builtin_amdgcn_mfma_f32_16x16x32_bf16(a, bw[ks], acc, 0, 0, 0); }
#pragma unroll
            for (int jj = 0; jj < 4; ++jj) WAo[(mt * 16 + fq * 4 + jj) * 68 + (w & 3) * 16 + fr] = acc[jj]; } }
        lds_barrier();
        float kkv[8], kmv[8], bv[8], lwv[8], cum[8], rr[8], bonv[8];
        { float run = 0.f;
#pragma unroll
          for (int i = 0; i < 8; ++i) { const int tau = w * 8 + i; const int t = z ? (seqT - 1 - (qbase + tb + tau)) : (qbase + tb + tau); const int tokg = tok0 + t;
            const float wr_ = w0c + WA[tau * 68 + c], ap = a0c + WA[64 * 68 + tau * 68 + c];
            const float nx = -wr_; const float sp = fmaxf(nx, 0.f) + flog(1.f + fexp(-fabsf(nx)));
            const float lw = -fexp(-sp - 0.5f);
            const float iclr = __builtin_amdgcn_rcpf(1.f + fexp(-ap));
            const float kxi = bf2f(RKV[4096 + tau * 64 + c]); rr[i] = bf2f(RKV[tau * 64 + c]);
            const float kkraw = kxi * kkc;
            const float ssq = wave_sum_fast(kkraw * kkraw);
            const float kk = kkraw * __builtin_amdgcn_rsqf(fmaxf(ssq, 1e-24f));
            const float kmod = kxi * (1.f + (iclr - 1.f) * kac);
            bonv[i] = wave_sum_lane63(rr[i] * kmod * rkc);
            run += lw;
            kkv[i] = kk; kmv[i] = kmod; bv[i] = kk * iclr; lwv[i] = lw; cum[i] = run; }
          HT[w * 64 + c] = run;
          if (lane == 63) {
#pragma unroll
            for (int i = 0; i < 8; ++i) BONL[w * 8 + i] = bonv[i]; } }
        lds_barrier();
        if (tid < 64) { const int t = z ? (seqT - 1 - (qbase + tb + tid)) : (qbase + tb + tid); BON[((size_t)z * NTOK + tok0 + t) * 16 + hd] = BONL[tid]; }
        { const float off = (w & 1) ? HT[(w - 1) * 64 + c] : 0.f; const int cn = w >> 1;
          unsigned kbq[8];
#pragma unroll
          for (int i = 0; i < 8; ++i) { const int tau = w * 8 + i; const int j = (w & 1) * 8 + i;
            const float cm = cum[i] + off;
            const float Pj = fexp(cm), ipj = fexp(-cm), pm1 = fexp(cm - lwv[i]);
            const unsigned kb2 = pk2(-bv[i] * ipj, kmv[i] * ipj);
            KTr[tau * 72 + pcol] = (bf16_t)(kb2 >> 16); BTr[tau * 72 + pcol] = f2bf_hw(bv[i] * ipj);
            const unsigned kr2 = pk2(kkv[i] * pm1, rr[i] * Pj);
            KKH[tau * 72 + pcol] = (bf16_t)(kr2 & 0xFFFFu); RH[tau * 72 + pcol] = (bf16_t)(kr2 >> 16);
            kbq[i] = kb2;
            if (j == 15) PC[cn * 64 + c] = Pj; }
#pragma unroll
          for (int g = 0; g < 2; ++g) { u32x4 o;
              o.x = (kbq[g * 4 + 0] & 0xFFFFu) | (kbq[g * 4 + 1] << 16); o.y = (kbq[g * 4 + 2] & 0xFFFFu) | (kbq[g * 4 + 3] << 16);
              o.z = (kbq[g * 4 + 0] >> 16) | (kbq[g * 4 + 1] & 0xFFFF0000u); o.w = (kbq[g * 4 + 2] >> 16) | (kbq[g * 4 + 3] & 0xFFFF0000u);
              *(u32x4*)(KBm + (cn * 64 + c) * 40 + ((w & 1) * 2 + g) * 8) = o; } }
        lds_barrier();
#pragma unroll
        for (int q2 = 0; q2 < 2; ++q2) { const int id = w * 2 + q2; const int cn = id >> 2, which = id & 3;
          const bf16_t* Am = ((which & 1) ? KTr : BTr) + cn * 16 * 72; const bf16_t* Bm = ((which & 2) ? RH : KKH) + cn * 16 * 72;
          const f32x4 acc = mma_nt(Am, 72, Bm, 72, 64, (f32x4){0.f, 0.f, 0.f, 0.f}, fr, fq);
          f32x4 o;
#pragma unroll
          for (int jj = 0; jj < 4; ++jj) { const int i = fq * 4 + jj, j = fr; const bool keep = (which & 2) ? (i <= j) : (i < j); o[jj] = keep ? acc[jj] : 0.f; }
          *(f32x4*)(MM + (cn * 4 + which) * 256 + fr * 16 + fq * 4) = o; }
        lds_barrier();
        if (w < 4) { const int cn = w, col = lane >> 2, rg = lane & 3;
            const float* MbT = MM + (cn * 4 + 0) * 256 + rg * 4; const float* MkT = MM + (cn * 4 + 1) * 256 + rg * 4;
            float Tc[4], A1[4];
#pragma unroll
            for (int e = 0; e < 4; ++e) { Tc[e] = (rg * 4 + e == col) ? 1.f : 0.f; A1[e] = 0.f; }
#define INV_STEP(l, CTRL) do { const f32x4 mb = *(const f32x4*)(MbT + (l) * 16), mk = *(const f32x4*)(MkT + (l) * 16); \
                const float tl_ = __int_as_float(__builtin_amdgcn_update_dpp(0, __float_as_int(Tc[(l) & 3]), CTRL, 0xF, 0xF, true)); \
                Tc[0] -= mb[0] * tl_; Tc[1] -= mb[1] * tl_; Tc[2] -= mb[2] * tl_; Tc[3] -= mb[3] * tl_; \
                A1[0] += mk[0] * tl_; A1[1] += mk[1] * tl_; A1[2] += mk[2] * tl_; A1[3] += mk[3] * tl_; } while (0)
            INV_STEP(15, 0xFF); INV_STEP(14, 0xFF); INV_STEP(13, 0xFF); INV_STEP(12, 0xFF);
            INV_STEP(11, 0xAA); INV_STEP(10, 0xAA); INV_STEP(9, 0xAA); INV_STEP(8, 0xAA);
            INV_STEP(7, 0x55); INV_STEP(6, 0x55); INV_STEP(5, 0x55); INV_STEP(4, 0x55);
            INV_STEP(3, 0x00); INV_STEP(2, 0x00); INV_STEP(1, 0x00);
#undef INV_STEP
            u32x4 o; o.x = pk2(Tc[0], Tc[1]); o.y = pk2(Tc[2], Tc[3]); o.z = pk2(A1[0], A1[1]); o.w = pk2(A1[2], A1[3]);
            *(u32x4*)(TA + (cn * 16 + col) * 40 + rg * 8) = o; }
        else { const int cn = w - 4, j = lane & 15, ig = lane >> 4;
            const f32x4 nb = *(const f32x4*)(MM + (cn * 4 + 2) * 256 + j * 16 + ig * 4), nk = *(const f32x4*)(MM + (cn * 4 + 3) * 256 + j * 16 + ig * 4);
            u32x4 o; o.x = pk2(-nb[0], -nb[1]); o.y = pk2(-nb[2], -nb[3]); o.z = pk2(nk[0], nk[1]); o.w = pk2(nk[2], nk[3]);
            *(u32x4*)(NA + (cn * 16 + j) * 40 + ig * 8) = o; }
        lds_barrier();
        if (w < 4 || sample) {
            const int vb = w & 3;
            const int t0s = z ? (seqT - 1 - (qbase + tb)) : (qbase + tb);
            const long tstep = z ? -1024 : 1024;
            bf16_t* obase = (w < 4) ? OD + ((size_t)z * NTOK + tok0 + t0s) * 1024 + hd * 64 + vb * 16 + fq * 4 : RHO + ((size_t)z * 4096 + (tok0 - NPTOK) + t0s) * 1024 + hd * 64 + vb * 16 + fq * 4;
#pragma unroll 1
            for (int cn = 0; cn < 4; ++cn) {
                bf16x8 sb[2];
#pragma unroll
                for (int ks = 0; ks < 2; ++ks) sb[ks] = pack8h(Sacc[2 * ks][0], Sacc[2 * ks][1], Sacc[2 * ks][2], Sacc[2 * ks][3], Sacc[2 * ks + 1][0], Sacc[2 * ks + 1][1], Sacc[2 * ks + 1][2], Sacc[2 * ks + 1][3]);
                f32x4 U0 = (f32x4){0.f, 0.f, 0.f, 0.f}, O = (f32x4){0.f, 0.f, 0.f, 0.f};
#pragma unroll
                for (int ks = 0; ks < 2; ++ks) { const bf16x8 a = *(const bf16x8*)(KKH + (cn * 16 + fr) * 72 + ks * 32 + fq * 8);
                    U0 = __builtin_amdgcn_mfma_f32_16x16x32_bf16(a, sb[ks], U0, 0, 0, 0);
                    const bf16x8 ar = *(const bf16x8*)(RH + (cn * 16 + fr) * 72 + ks * 32 + fq * 8);
                    O = __builtin_amdgcn_mfma_f32_16x16x32_bf16(sb[ks], ar, O, 0, 0, 0); }
                float vf[4];
#pragma unroll
                for (int e = 0; e < 4; ++e) vf[e] = (w < 4) ? bf2f(VS[(cn * 16 + fq * 4 + e) * 64 + vb * 16 + fr]) : 0.f;
                const bf16x8 bU0 = pack8h(U0[0], U0[1], U0[2], U0[3], vf[0], vf[1], vf[2], vf[3]);
                const bf16x8 ta = *(const bf16x8*)(TA + (cn * 16 + fr) * 40 + fq * 8);
                const f32x4 U = __builtin_amdgcn_mfma_f32_16x16x32_bf16(ta, bU0, (f32x4){0.f, 0.f, 0.f, 0.f}, 0, 0, 0);
                const bf16x8 bUV = pack8h(U[0], U[1], U[2], U[3], vf[0], vf[1], vf[2], vf[3]);
                const bf16x8 na = *(const bf16x8*)(NA + (cn * 16 + fr) * 40 + fq * 8);
                O = __builtin_amdgcn_mfma_f32_16x16x32_bf16(bUV, na, O, 0, 0, 0);
#pragma unroll
                for (int jj = 0; jj < 1; ++jj) { u32x2 o2; o2.x = pk2(O[0], O[1]); o2.y = pk2(O[2], O[3]); *(u32x2*)(obase + (long)(cn * 16 + fr) * tstep) = o2; }
#pragma unroll
                for (int kt = 0; kt < 4; ++kt) { const bf16x8 kb = *(const bf16x8*)(KBm + (cn * 64 + kt * 16 + fr) * 40 + fq * 8);
                    Sacc[kt] = __builtin_amdgcn_mfma_f32_16x16x32_bf16(kb, bUV, Sacc[kt], 0, 0, 0);
                    const f32x4 pc = *(const f32x4*)(PC + cn * 64 + kt * 16 + fq * 4);
                    Sacc[kt] = Sacc[kt] * pc; }
            }
        }
        lds_barrier();
    }
#undef WKV_LOAD_RAW
    if (!sample) { if (w < 4) { float* so = p.out + (size_t)2 * NPTOK * D + ((size_t)((b * 2 + z) * 16 + hd)) * 4096 + (size_t)(w * 16 + fr0) * 64;
#pragma unroll
        for (int kt = 0; kt < 4; ++kt)
#pragma unroll
            for (int jj = 0; jj < 4; ++jj) so[kt * 16 + fq0 * 4 + jj] = Sacc[kt][jj]; } }
    else { float* so = GH + ((size_t)u * 2 + (w >> 2)) * 4096 + (size_t)((w & 3) * 16 + fr0) * 64;
#pragma unroll
        for (int kt = 0; kt < 4; ++kt)
#pragma unroll
            for (int jj = 0; jj < 4; ++jj) so[kt * 16 + fq0 * 4 + jj] = Sacc[kt][jj]; }
    __syncthreads();
}

__device__ void wkv_fix_unit(const Params& p, int u, float* ldsf) {
    const int tid = threadIdx.x, lane = tid & 63, w = __builtin_amdgcn_readfirstlane(tid >> 6), fr = lane & 15, fq = lane >> 4;
    unsigned char* ws = p.ws;
    bf16_t* OD = (bf16_t*)(ws + WS_X1);
    const bf16_t* RHO = (const bf16_t*)(ws + WS_H);
    const float* GH = (const float*)(ws + WS_BT0);
    const int z = u >> 7, b = (u >> 6) & 1, hd = (u >> 2) & 15, vq = u & 3;
    float* SS = ldsf;
    float* GL = ldsf + 1024;
    bf16_t* SB = (bf16_t*)(ldsf + 1024 + 4096);
    const int v = tid >> 5, kp = (tid & 31) * 2;
    { const float* s0 = p.in[2] + ((size_t)((b * 2 + z) * 16 + hd)) * 4096 + (size_t)(vq * 16 + v) * 64 + kp; SS[v * 64 + kp] = s0[0]; SS[v * 64 + kp + 1] = s0[1]; }
    __syncthreads();
#pragma unroll 1
    for (int sg = 0; sg < 8; ++sg) {
        const int su = ((z * 2 + b) * 16 + hd) * 8 + sg;
        SB[v * 72 + kp] = f2bf_hw(SS[v * 64 + kp]); SB[v * 72 + kp + 1] = f2bf_hw(SS[v * 64 + kp + 1]);
        if (sg < 7) { const f32x4* gsrc = (const f32x4*)(GH + ((size_t)su * 2 + 1) * 4096);
#pragma unroll
            for (int q = 0; q < 2; ++q) ((f32x4*)GL)[tid + q * NTHR] = gsrc[tid + q * NTHR]; }
        __syncthreads();
        const int tlo = z ? (2048 - (sg + 1) * 256) : sg * 256;
#pragma unroll
        for (int q = 0; q < 2; ++q) { const int mt = 2 * w + q;
            f32x4 acc = (f32x4){0.f, 0.f, 0.f, 0.f};
#pragma unroll
            for (int ks = 0; ks < 2; ++ks) { const bf16x8 a = *(const bf16x8*)(RHO + ((size_t)z * 4096 + b * 2048 + tlo + mt * 16 + fr) * 1024 + hd * 64 + ks * 32 + fq * 8);
                const bf16x8 bb = *(const bf16x8*)(SB + fr * 72 + ks * 32 + fq * 8);
                acc = __builtin_amdgcn_mfma_f32_16x16x32_bf16(bb, a, acc, 0, 0, 0); }
            { u32x2* op = (u32x2*)(OD + ((size_t)z * NTOK + NPTOK + b * 2048 + tlo + mt * 16 + fr) * 1024 + hd * 64 + vq * 16 + fq * 4);
              const u32x2 old = *op; u32x2 nw; nw.x = pk2(bflo(old.x) + acc[0], bfhi(old.x) + acc[1]); nw.y = pk2(bflo(old.y) + acc[2], bfhi(old.y) + acc[3]); *op = nw; } }
        if (sg < 7) {
            const float* hsrc = GH + ((size_t)su * 2 + 0) * 4096 + (size_t)(vq * 16 + v) * 64 + kp;
            float a0 = hsrc[0], a1 = hsrc[1];
#pragma unroll 8
            for (int k2 = 0; k2 < 64; ++k2) { const float sv = SS[v * 64 + k2]; a0 += sv * GL[k2 * 64 + kp]; a1 += sv * GL[k2 * 64 + kp + 1]; }
            __syncthreads();
            SS[v * 64 + kp] = a0; SS[v * 64 + kp + 1] = a1;
        }
        __syncthreads();
    }
}
__device__ void phase_wkv_fix(const Params& p, float* lds) {
    for (int it = blockIdx.x; it < 256; it += gridDim.x) wkv_fix_unit(p, it, lds);
}

__device__ void conv_tile(const Params& p, int tile) {
    const int tid = threadIdx.x;
    unsigned char* ws = p.ws;
    const bf16_t* P = (const bf16_t*)(ws + WS_P);
    bf16_t* OC = (bf16_t*)(ws + WS_OC);
    const int cgp = tid & 127, c0 = cgp * 8, sub = tid >> 7;
    float cw0[8], cw1[8], cw2[8];
#pragma unroll
    for (int j = 0; j < 8; ++j) { cw0[j] = p.in[12][c0 + j]; cw1[j] = p.in[12][1024 + c0 + j]; cw2[j] = p.in[12][2048 + c0 + j]; }
    for (int jj = 0; jj < 4; ++jj) {
        const int t = tile * 16 + sub + 4 * jj;
        const int rl = t < NPTOK ? 256 : 64; const int pos = t & (rl - 1);
        const bf16_t* row = P + (size_t)t * N0;
        const u32x4 z4 = (u32x4){0u, 0u, 0u, 0u};
        const u32x4 u1 = *(const u32x4*)(row + c0), g1 = *(const u32x4*)(row + 2048 + c0);
        const u32x4 u0 = pos > 0 ? *(const u32x4*)(row - N0 + c0) : z4, g0 = pos > 0 ? *(const u32x4*)(row - N0 + 2048 + c0) : z4;
        const u32x4 u2 = pos < rl - 1 ? *(const u32x4*)(row + N0 + c0) : z4, g2 = pos < rl - 1 ? *(const u32x4*)(row + N0 + 2048 + c0) : z4;
        const u32x4 gb = *(const u32x4*)(row + 1024 + c0), zc = *(const u32x4*)(row + 3072 + c0);
        u32x4 o;
#pragma unroll
        for (int q = 0; q < 4; ++q) {
            const float y0 = cw0[2 * q] * (bflo(g0[q]) * bflo(u0[q])) + cw1[2 * q] * (bflo(g1[q]) * bflo(u1[q])) + cw2[2 * q] * (bflo(g2[q]) * bflo(u2[q]));
            const float y1 = cw0[2 * q + 1] * (bfhi(g0[q]) * bfhi(u0[q])) + cw1[2 * q + 1] * (bfhi(g1[q]) * bfhi(u1[q])) + cw2[2 * q + 1] * (bfhi(g2[q]) * bfhi(u2[q]));
            o[q] = pack2(silu(bflo(zc[q])) * bflo(gb[q]) * y0, silu(bfhi(zc[q])) * bfhi(gb[q]) * y1);
        }
        *(u32x4*)(OC + (size_t)t * 2048 + c0) = o;
    }
}

__device__ void phase_mix0(const Params& p, float* lds, int rep) {
    (void)rep;
    constexpr int NSCAN = 1024, NCONV = 512;
    for (int it = blockIdx.x; it < NSCAN + NCONV; it += gridDim.x) {
        if (it < NSCAN) wkv_unit(p, it, lds); else conv_tile(p, it - NSCAN);
    }
}

__device__ __forceinline__ float quad_sum(float v) {
    v += __int_as_float(__builtin_amdgcn_update_dpp(0, __float_as_int(v), 0xB1, 0xF, 0xF, true));
    v += __int_as_float(__builtin_amdgcn_update_dpp(0, __float_as_int(v), 0x4E, 0xF, 0xF, true));
    return v;
}
__device__ void phase_wkv_post(const Params& p) {
    const int tid = threadIdx.x, wave = tid >> 6, lane = tid & 63;
    unsigned char* ws = p.ws;
    const bf16_t* P = (const bf16_t*)(ws + WS_P);
    const bf16_t* OD = (const bf16_t*)(ws + WS_X1);
    const float* BON = (const float*)(ws + WS_BON);
    bf16_t* OC = (bf16_t*)(ws + WS_OC);
    const int hh = lane >> 2, ch0 = hh * 64 + (lane & 3) * 16;
    for (int tok = blockIdx.x * 8 + wave; tok < NTOK; tok += gridDim.x * 8) {
        const bf16_t* row = P + (size_t)tok * N0;
        u32x4 a0[2], a1[2], vv[2], zz[2];
#pragma unroll
        for (int h = 0; h < 2; ++h) { a0[h] = *(const u32x4*)(OD + (size_t)tok * 1024 + ch0 + h * 8); a1[h] = *(const u32x4*)(OD + ((size_t)NTOK + tok) * 1024 + ch0 + h * 8);
            vv[h] = *(const u32x4*)(row + 6144 + ch0 + h * 8); zz[h] = *(const u32x4*)(row + 7168 + ch0 + h * 8); }
        const float bon = BON[(size_t)tok * 16 + hh] + BON[((size_t)NTOK + tok) * 16 + hh];
        float o[16]; float s1 = 0.f;
#pragma unroll
        for (int h = 0; h < 2; ++h)
#pragma unroll
            for (int q = 0; q < 4; ++q) { o[h * 8 + 2 * q] = bflo(a0[h][q]) + bflo(a1[h][q]); o[h * 8 + 2 * q + 1] = bfhi(a0[h][q]) + bfhi(a1[h][q]); s1 += o[h * 8 + 2 * q] + o[h * 8 + 2 * q + 1]; }
        const float mu = quad_sum(s1) * (1.f / 64.f);
        float s2 = 0.f;
#pragma unroll
        for (int i = 0; i < 16; ++i) { o[i] -= mu; s2 += o[i] * o[i]; }
        const float rs = rsqrtf(quad_sum(s2) * (1.f / 64.f) + 64e-5f);
        float res[16];
#pragma unroll
        for (int g4 = 0; g4 < 4; ++g4) { const f32x4 lw4 = *(const f32x4*)(p.in[22] + ch0 + g4 * 4), lb4 = *(const f32x4*)(p.in[23] + ch0 + g4 * 4);
#pragma unroll
            for (int e = 0; e < 4; ++e) { const int i = g4 * 4 + e; const unsigned vw = vv[i >> 3][(i & 7) >> 1], zw_ = zz[i >> 3][(i & 7) >> 1];
                const float v1 = (i & 1) ? bfhi(vw) : bflo(vw), z1 = (i & 1) ? bfhi(zw_) : bflo(zw_);
                res[i] = (o[i] * rs * lw4[e] + lb4[e] + bon * v1) * silu(z1); } }
#pragma unroll
        for (int h = 0; h < 2; ++h) { u32x4 w4; w4.x = pk2(res[h * 8 + 0], res[h * 8 + 1]); w4.y = pk2(res[h * 8 + 2], res[h * 8 + 3]); w4.z = pk2(res[h * 8 + 4], res[h * 8 + 5]); w4.w = pk2(res[h * 8 + 6], res[h * 8 + 7]);
            *(u32x4*)(OC + (size_t)tok * 2048 + 1024 + ch0 + h * 8) = w4; }
    }
}

constexpr size_t WS_QE = WS_H;
constexpr size_t WS_KDT = WS_BT0;
constexpr size_t WS_VT = WS_OC + (size_t)NTOK * 1024 * 2;
constexpr size_t WS_EBL = WS_BON + (size_t)2 * NTOK * 16 * 4;
constexpr size_t WS_ATT = WS_P + 52 * MB;

__device__ void gla_a_item(const Params& p, int item, float* ldsf) {
    const int tid = threadIdx.x, lane = tid & 63, w = __builtin_amdgcn_readfirstlane(tid >> 6), fr = lane & 15, fq = lane >> 4;
    unsigned char* ws = p.ws;
    const bf16_t* P1 = (const bf16_t*)(ws + WS_P);
    float* OD = (float*)(ws + WS_P2);
    bf16_t* QEg = (bf16_t*)(ws + WS_QE); bf16_t* KDTg = (bf16_t*)(ws + WS_KDT); bf16_t* VTg = (bf16_t*)(ws + WS_VT); float* EBLg = (float*)(ws + WS_EBL);
    const int hd = item & 3, c = (item >> 2) & 127, z = item >> 9, tok0 = c * 64;
    bf16_t* QE = (bf16_t*)ldsf;
    bf16_t* KE = QE + 64 * 136;
    bf16_t* VT = KE + 64 * 136;
    bf16_t* ATT = VT + 256 * 72;
    float* G = (float*)(ATT + 64 * 72);
    float* L1G = G + 64 * 132;
    float* GK2 = L1G + 1024;
    for (int i = tid; i < 1024; i += NTHR) { const int t = i >> 4, r = i & 15; L1G[i] = bf2f(P1[(size_t)(tok0 + t) * N1 + 3072 + z * 16 + r]); }
    for (int i = tid; i < 2048; i += NTHR) { const int r = i >> 7, d = i & 127; GK2[i] = p.in[27][(size_t)(z * 16 + r) * 512 + hd * 128 + d]; }
#pragma unroll
    for (int ps = 0; ps < 4; ++ps) { const int t = lane, e8 = (ps * 8 + w) * 8;
        const u32x4 v8 = *(const u32x4*)(P1 + (size_t)(tok0 + t) * N1 + 1024 + hd * 256 + e8);
        VT[(e8 + 0) * 72 + t] = (bf16_t)(v8.x & 0xFFFF); VT[(e8 + 1) * 72 + t] = (bf16_t)(v8.x >> 16); VT[(e8 + 2) * 72 + t] = (bf16_t)(v8.y & 0xFFFF); VT[(e8 + 3) * 72 + t] = (bf16_t)(v8.y >> 16);
        VT[(e8 + 4) * 72 + t] = (bf16_t)(v8.z & 0xFFFF); VT[(e8 + 5) * 72 + t] = (bf16_t)(v8.z >> 16); VT[(e8 + 6) * 72 + t] = (bf16_t)(v8.w & 0xFFFF); VT[(e8 + 7) * 72 + t] = (bf16_t)(v8.w >> 16); }
    const int d = tid & 127, tq = tid >> 7;
    const float gbias = p.in[28][z * 512 + hd * 128 + d];
    bf16_t qraw[16], kraw[16];
#pragma unroll
    for (int i = 0; i < 16; ++i) { const size_t row = (size_t)(tok0 + tq * 16 + i) * N1; qraw[i] = P1[row + hd * 128 + d]; kraw[i] = P1[row + 512 + hd * 128 + d]; }
    __syncthreads();
    { float run = 0.f;
#pragma unroll 4
      for (int i = 0; i < 16; ++i) { const int t = z ? (tq * 16 + 15 - i) : (tq * 16 + i);
        float x = gbias;
#pragma unroll
        for (int r = 0; r < 16; ++r) x += L1G[t * 16 + r] * GK2[r * 128 + d];
        const float ls = fminf(x, 0.f) - flog(1.f + fexp(-fabsf(x)));
        run += ls * (1.f / 16.f);
        G[t * 132 + d] = run; } }
    __syncthreads();
    { const int lastr = z ? 0 : 15;
      const float t0 = G[(0 + lastr) * 132 + d], t1 = G[(16 + lastr) * 132 + d], t2 = G[(32 + lastr) * 132 + d], t3 = G[(48 + lastr) * 132 + d];
      const float blast = t0 + t1 + t2 + t3;
      float off;
      if (z == 0) off = tq == 0 ? 0.f : (tq == 1 ? t0 : (tq == 2 ? t0 + t1 : t0 + t1 + t2));
      else off = tq == 3 ? 0.f : (tq == 2 ? t3 : (tq == 1 ? t3 + t2 : t3 + t2 + t1));
      if (tq == 0) EBLg[(size_t)(z * 128 + c) * 512 + hd * 128 + d] = fexp(blast);
      unsigned kdp[8];
#pragma unroll
      for (int i = 0; i < 16; ++i) { const int t = tq * 16 + i;
        const float bc = G[t * 132 + d] + off;
        const float q = bf2f(qraw[i]) * 0.08838834764831845f, k = bf2f(kraw[i]);
        const bf16_t qe = f2bf(q * fexp(bc));
        QE[t * 136 + d] = qe; KE[t * 136 + d] = f2bf(k * fexp(-bc));
        const unsigned kd = (unsigned)f2bf(k * fexp(blast - bc));
        if (i & 1) kdp[i >> 1] |= kd << 16; else kdp[i >> 1] = kd; }
      bf16_t* kdst = KDTg + ((size_t)(((z * 128 + c) * 4 + hd) * 128 + d)) * 64 + tq * 16;
      *(u32x4*)kdst = (u32x4){kdp[0], kdp[1], kdp[2], kdp[3]}; *(u32x4*)(kdst + 8) = (u32x4){kdp[4], kdp[5], kdp[6], kdp[7]}; }
    __syncthreads();
#pragma unroll
    for (int q2 = 0; q2 < 2; ++q2) { const int idx = q2 * NTHR + tid; const int t = idx >> 4, d8 = (idx & 15) * 8;
        *(u32x4*)(QEg + ((size_t)z * NTOK + tok0 + t) * 512 + hd * 128 + d8) = *(const u32x4*)(QE + t * 136 + d8); }
    if (z == 0) {
#pragma unroll
        for (int q4 = 0; q4 < 4; ++q4) { const int idx = q4 * NTHR + tid; const int e = idx >> 3, t8 = (idx & 7) * 8;
            *(u32x4*)(VTg + ((size_t)((c * 4 + hd) * 256 + e)) * 64 + t8) = *(const u32x4*)(VT + e * 72 + t8); } }
#pragma unroll
    for (int q2 = 0; q2 < 2; ++q2) { const int tA = 2 * w + q2, ia = tA >> 2, ja = tA & 3;
        f32x4 a4 = (f32x4){0.f, 0.f, 0.f, 0.f};
        if (z ? (ja >= ia) : (ja <= ia)) a4 = mma_nt(QE + ia * 16 * 136, 136, KE + ja * 16 * 136, 136, 128, a4, fr, fq);
#pragma unroll
        for (int jj = 0; jj < 4; ++jj) { const int i = ia * 16 + fq * 4 + jj, j = ja * 16 + fr; const bool keep = z ? (j >= i) : (j <= i); ATT[i * 72 + j] = f2bf(keep ? a4[jj] : 0.f); } }
    __syncthreads();
    { bf16_t* ATTg = (bf16_t*)(ws + WS_ATT) + ((size_t)((z * 128 + c) * 4 + hd)) * 4096;
      const int i = tid >> 3, j8 = (tid & 7) * 8;
      *(u32x4*)(ATTg + i * 64 + j8) = *(const u32x4*)(ATT + i * 72 + j8); }
    __syncthreads();
}

__device__ void phase_gla_a(const Params& p, float* lds) {
    for (int it = blockIdx.x; it < 1024; it += gridDim.x) gla_a_item(p, it, lds);
}

struct GlaFrags { bf16x8 kdt[2]; u32x4 vts; u32x4 qes[2]; bf16x8 att[2]; f32x4 ebl; };

template <int NE>
__device__ __forceinline__ void gla_b_unit_t(const Params& p, int z, int b, int hd, int e0, int nch, int ch0, bool sample, float* ldsf) {
    const int tid = threadIdx.x, lane = tid & 63, w = __builtin_amdgcn_readfirstlane(tid >> 6), fr = lane & 15, fq = lane >> 4;
    unsigned char* ws = p.ws;
    bf16_t* OD = (bf16_t*)(ws + WS_P2);
    const bf16_t* QEg = (const bf16_t*)(ws + WS_QE); const bf16_t* KDTg = (const bf16_t*)(ws + WS_KDT); const bf16_t* VTg = (const bf16_t*)(ws + WS_VT); const float* EBLg = (const float*)(ws + WS_EBL);
    const bf16_t* ATTg = (const bf16_t*)(ws + WS_ATT);
    constexpr int NQ = NE / 2;
    bf16_t* ST = (bf16_t*)ldsf;
    bf16_t* VTL = ST + 2 * 64 * 136;
    bf16_t* QEL = VTL + 2 * 64 * 72;
    f32x4 Sacc[NE];
    if (sample) { const float* s0 = p.in[3] + ((size_t)((b * 2 + z) * 4 + hd)) * 32768 + e0 + fr;
#pragma unroll
        for (int et = 0; et < NE; ++et)
#pragma unroll
            for (int jj = 0; jj < 4; ++jj) Sacc[et][jj] = s0[(size_t)(w * 16 + fq * 4 + jj) * 256 + et * 16]; }
    else {
#pragma unroll
        for (int et = 0; et < NE; ++et) Sacc[et] = (f32x4){0.f, 0.f, 0.f, 0.f}; }
    const int it = w >> 1, e2 = (w & 1) * NQ;
    const int ve = tid >> 3, vt8 = (tid & 7) * 8;
#define GLB_LOAD(F, c_) do { const int cc_ = (c_); \
        _Pragma("unroll") for (int ks = 0; ks < 2; ++ks) { (F).kdt[ks] = *(const bf16x8*)(KDTg + ((size_t)(((z * 128 + cc_) * 4 + hd) * 128 + w * 16 + fr)) * 64 + ks * 32 + fq * 8); \
            (F).att[ks] = *(const bf16x8*)(ATTg + ((size_t)((z * 128 + cc_) * 4 + hd)) * 4096 + (it * 16 + fr) * 64 + ks * 32 + fq * 8); } \
        if (ve < NE * 16) (F).vts = *(const u32x4*)(VTg + ((size_t)((cc_ * 4 + hd) * 256 + e0 + ve)) * 64 + vt8); \
        _Pragma("unroll") for (int h_ = 0; h_ < 2; ++h_) (F).qes[h_] = *(const u32x4*)(QEg + ((size_t)z * NTOK + cc_ * 64 + ve) * 512 + hd * 128 + h_ * 64 + vt8); \
        (F).ebl = *(const f32x4*)(EBLg + (size_t)(z * 128 + cc_) * 512 + hd * 128 + w * 16 + fq * 4); } while (0)
#define GLB_STEP(CUR, NX2, ci_) do { const int ci = (ci_); if (ci < nch) { \
        const int c = ch0 + (z ? nch - 1 - ci : ci); \
        bf16_t* STc = ST + (ci & 1) * 64 * 136; bf16_t* VTc = VTL + (ci & 1) * 64 * 72; \
        _Pragma("unroll") for (int et = 0; et < NE; ++et) { u32x2 v2; v2.x = pk2(Sacc[et][0], Sacc[et][1]); v2.y = pk2(Sacc[et][2], Sacc[et][3]); \
            *(u32x2*)(STc + (et * 16 + fr) * 136 + w * 16 + fq * 4) = v2; } \
        if (ve < NE * 16) *(u32x4*)(VTc + ve * 72 + vt8) = (CUR).vts; \
        bf16_t* QEc = QEL + (ci & 1) * 64 * 136; \
        *(u32x4*)(QEc + ve * 136 + vt8) = (CUR).qes[0]; *(u32x4*)(QEc + ve * 136 + 64 + vt8) = (CUR).qes[1]; \
        if (ci + 2 < nch) GLB_LOAD(NX2, ch0 + (z ? nch - 3 - ci : ci + 2)); \
        lds_barrier(); \
        _Pragma("unroll") for (int et = 0; et < NE; ++et) { Sacc[et] = Sacc[et] * (CUR).ebl; \
            _Pragma("unroll") for (int ks = 0; ks < 2; ++ks) { const bf16x8 vf = *(const bf16x8*)(VTc + (et * 16 + fr) * 72 + ks * 32 + fq * 8); \
                Sacc[et] = __builtin_amdgcn_mfma_f32_16x16x32_bf16((CUR).kdt[ks], vf, Sacc[et], 0, 0, 0); } } \
        _Pragma("unroll") for (int q2 = 0; q2 < NQ; ++q2) { f32x4 o = (f32x4){0.f, 0.f, 0.f, 0.f}; \
            _Pragma("unroll") for (int ks = 0; ks < 2; ++ks) { const bf16x8 vf = *(const bf16x8*)(VTc + ((e2 + q2) * 16 + fr) * 72 + ks * 32 + fq * 8); \
                o = __builtin_amdgcn_mfma_f32_16x16x32_bf16(vf, (CUR).att[ks], o, 0, 0, 0); } \
            _Pragma("unroll") for (int ks = 0; ks < 4; ++ks) { const bf16x8 bS = *(const bf16x8*)(STc + ((e2 + q2) * 16 + fr) * 136 + ks * 32 + fq * 8); \
                const bf16x8 aq = *(const bf16x8*)(QEc + (it * 16 + fr) * 136 + ks * 32 + fq * 8); \
                o = __builtin_amdgcn_mfma_f32_16x16x32_bf16(bS, aq, o, 0, 0, 0); } \
            { u32x2 o2; o2.x = pk2(o[0], o[1]); o2.y = pk2(o[2], o[3]);        \
              *(u32x2*)(OD + ((size_t)z * NTOK + c * 64 + it * 16 + fr) * 1024 + hd * 256 + e0 + (e2 + q2) * 16 + fq * 4) = o2; } } } } while (0)
    GlaFrags fa, fb, fc; fa.vts = fb.vts = fc.vts = (u32x4){0u, 0u, 0u, 0u};
    GLB_LOAD(fa, ch0 + (z ? nch - 1 : 0));
    GLB_LOAD(fb, ch0 + (z ? nch - 2 : 1));
    __syncthreads();
#pragma unroll 1
    for (int ci3 = 0; ci3 < nch; ci3 += 3) { GLB_STEP(fa, fc, ci3); GLB_STEP(fb, fa, ci3 + 1); GLB_STEP(fc, fb, ci3 + 2); }
#undef GLB_STEP
#undef GLB_LOAD
    if (!sample) { float* so = p.out + (size_t)2 * NPTOK * D + 2097152 + ((size_t)((b * 2 + z) * 4 + hd)) * 32768 + e0 + fr;
#pragma unroll
        for (int et = 0; et < NE; ++et)
#pragma unroll
            for (int jj = 0; jj < 4; ++jj) so[(size_t)(w * 16 + fq * 4 + jj) * 256 + et * 16] = Sacc[et][jj]; }
    __syncthreads();
}

__device__ void gla_b_unit(const Params& p, int u, float* ldsf) {
    if (u < 128) gla_b_unit_t<2>(p, u >> 6, (u >> 5) & 1, (u >> 3) & 3, (u & 7) * 32, 32, 64 + ((u >> 5) & 1) * 32, true, ldsf);
    else { const int q = u - 128; gla_b_unit_t<4>(p, q >> 8, (q >> 4) & 15, (q >> 2) & 3, (q & 3) * 64, 4, ((q >> 4) & 15) * 4, false, ldsf); }
}

__device__ void phase_gla_b(const Params& p, float* lds, int rep) {
    unsigned* ctr = (unsigned*)(p.ws + WS_CTL) + 16 + rep * 32;
    int* slot = (int*)(lds + LDS_MAIN / 4);
    for (;;) {
        if (threadIdx.x == 0) *slot = (int)atomicAdd(ctr, 1u);
        __syncthreads();
        const int it = *slot;
        __syncthreads();
        if (it >= 640) break;
        gla_b_unit(p, it, lds);
    }
}

__device__ void phase_gla_post(const Params& p) {
    const int tid = threadIdx.x, wave = tid >> 6, lane = tid & 63;
    unsigned char* ws = p.ws;
    const bf16_t* P1 = (const bf16_t*)(ws + WS_P);
    const bf16_t* OD = (const bf16_t*)(ws + WS_P2);
    bf16_t* OG = (bf16_t*)(ws + WS_OC);
    for (int tok = blockIdx.x * 8 + wave; tok < NTOK; tok += gridDim.x * 8) {
        for (int hd = 0; hd < 4; ++hd) { const int idx = hd * 256 + lane * 4;
            const u32x2 pa = *(const u32x2*)(OD + (size_t)tok * 1024 + idx), pb = *(const u32x2*)(OD + ((size_t)NTOK + tok) * 1024 + idx);
            const f32x4 o = (f32x4){bflo(pa.x) + bflo(pb.x), bfhi(pa.x) + bfhi(pb.x), bflo(pa.y) + bflo(pb.y), bfhi(pa.y) + bfhi(pb.y)};
            const float ss = wave_sum(o[0] * o[0] + o[1] * o[1] + o[2] * o[2] + o[3] * o[3]);
            const float rs = rsqrtf(ss * (1.f / 256.f) + 1e-6f);
            const f32x4 gn = *(const f32x4*)(p.in[29] + lane * 4);
            const u32x2 zz = *(const u32x2*)(P1 + (size_t)tok * N1 + 2048 + idx);
            const float z0 = bflo(zz.x), z1 = bfhi(zz.x), z2 = bflo(zz.y), z3 = bfhi(zz.y);
            u32x2 w; w.x = pack2(o[0] * rs * gn[0] * silu(z0), o[1] * rs * gn[1] * silu(z1)); w.y = pack2(o[2] * rs * gn[2] * silu(z2), o[3] * rs * gn[3] * silu(z3));
            *(u32x2*)(OG + (size_t)tok * 1024 + idx) = w; }
    }
}

__device__ void phase_final(const Params& p) {
    const int tid = threadIdx.x, wave = tid >> 6, lane = tid & 63;
    unsigned char* ws = p.ws;
    const float* MOD = (const float*)(ws + WS_MOD);
    const float* X1 = (const float*)(ws + WS_X1);
    const bf16_t* Y = (const bf16_t*)(ws + WS_P2);
    for (int tok = blockIdx.x * 8 + wave; tok < NTOK; tok += gridDim.x * 8) {
        const int cond = tok < NPTOK ? 0 : 1 + ((tok - NPTOK) >> 11);
        f32x4 xv[4]; float ss = 0.f;
#pragma unroll
        for (int i = 0; i < 4; ++i) { const int idx = i * 256 + lane * 4;
            const f32x4 x1 = *(const f32x4*)(X1 + (size_t)tok * D + idx);
            const u32x2 pa = *(const u32x2*)(Y + (size_t)tok * D + idx), pb = *(const u32x2*)(Y + (size_t)NTOK * D + (size_t)tok * D + idx);
            const f32x4 ya = (f32x4){bflo(pa.x), bfhi(pa.x), bflo(pa.y), bfhi(pa.y)}, yb = (f32x4){bflo(pb.x), bfhi(pb.x), bflo(pb.y), bfhi(pb.y)};
            const f32x4 gt = *(const f32x4*)(MOD + (1 * 3 + cond) * 3072 + 2048 + idx);
            xv[i] = x1 + gt * (ya + yb);
            ss += xv[i][0] * xv[i][0] + xv[i][1] * xv[i][1] + xv[i][2] * xv[i][2] + xv[i][3] * xv[i][3]; }
        ss = wave_sum(ss);
        const float rstd = rsqrtf(ss * (1.f / 1024.f) + 1e-6f);
#pragma unroll
        for (int i = 0; i < 4; ++i) { const int idx = i * 256 + lane * 4;
            const f32x4 g = *(const f32x4*)(p.in[9] + idx);
            f32x4 o;
#pragma unroll
            for (int j = 0; j < 4; ++j) o[j] = xv[i][j] * rstd * g[j];
            *(f32x4*)(p.out + (size_t)tok * D + idx) = o; }
    }
}


#define XB_TMO      128
#define XB_XCNT(j)  (256  + 64 * (j))
#define XB_XSUB(j)  (1280 + 64 * (j))
#define XB_XGEN(j)  (2304 + 64 * (j))
#define XB_TOP      3328
#define XB_TOPGEN   3392
#define XCD_BAR_WORDS 3456
#define XB_SPIN_CAP (1u << 18)

__device__ __forceinline__ unsigned xb_ld(unsigned* p)              { return __hip_atomic_load(p, __ATOMIC_RELAXED, __HIP_MEMORY_SCOPE_AGENT); }
__device__ __forceinline__ unsigned xb_add(unsigned* p, unsigned v) { return __hip_atomic_fetch_add(p, v, __ATOMIC_RELAXED, __HIP_MEMORY_SCOPE_AGENT); }
__device__ __forceinline__ unsigned xb_xcc_id() { return (unsigned)__builtin_amdgcn_s_getreg((3 << 11) | 20) & 0xFu; }
#define XB_SPIN(cond, bar) do { unsigned _sp = 0; while (cond) { __builtin_amdgcn_s_sleep(1); \
    if ((++_sp & 255u) == 0u) { if (xb_ld(&(bar)[XB_TMO])) break; if (_sp > XB_SPIN_CAP) { atomicAdd(&(bar)[XB_TMO], 1u); break; } } } } while (0)

struct XcdBarrier {
    unsigned* bar; unsigned x;
    volatile LAS unsigned* st;
};

__device__ __forceinline__ XcdBarrier xcd_barrier_post(unsigned* bar, volatile LAS unsigned* st) {
    XcdBarrier b; b.bar = bar; b.x = xb_xcc_id(); b.st = st;
    if (threadIdx.x == 0) (void)xb_add(&bar[XB_XCNT(b.x)], 1u);
    return b;
}
__device__ __forceinline__ void xcd_barrier_complete(unsigned* bar, unsigned x, unsigned& nloc, unsigned& nx) {
    const unsigned G = gridDim.x * gridDim.y * gridDim.z;
    unsigned sum, cnt, mine, sp = 0u;
    for (;;) {
        sum = 0u; cnt = 0u; mine = 0u;
#pragma unroll
        for (unsigned j = 0; j < 16; ++j) { const unsigned c = xb_ld(&bar[XB_XCNT(j)]); sum += c; cnt += (c > 0u) ? 1u : 0u; mine = (j == x) ? c : mine; }
        if (sum == G) break;
        __builtin_amdgcn_s_sleep(1);
        if ((++sp & 255u) == 0u) { if (xb_ld(&bar[XB_TMO])) break; if (sp > XB_SPIN_CAP) { atomicAdd(&bar[XB_TMO], 1u); break; } }
    }
    nloc = mine > 0u ? mine : 1u; nx = cnt > 0u ? cnt : 1u;
}

__device__ __forceinline__ void xcd_barrier(const XcdBarrier& b) {
    asm volatile("s_waitcnt vmcnt(0)" ::: "memory");
    __syncthreads();
    if (threadIdx.x == 0) {
        unsigned* bar = b.bar;
        __builtin_amdgcn_s_waitcnt(0);
        unsigned nloc = b.st[0], nx = b.st[1];
        if (nloc == 0u) { xcd_barrier_complete(bar, b.x, nloc, nx); b.st[0] = nloc; b.st[1] = nx; }
        const unsigned old = xb_add(&bar[XB_XSUB(b.x)], 1u);
        const unsigned gen = old / nloc;
        if (old + 1u == (gen + 1u) * nloc) {
            __builtin_amdgcn_fence(__ATOMIC_RELEASE, "agent");
            asm volatile("s_waitcnt vmcnt(0)" ::: "memory");
            const unsigned og = xb_add(&bar[XB_TOP], 1u);
            const unsigned tg = og / nx;
            if (og + 1u == (tg + 1u) * nx) xb_add(&bar[XB_TOPGEN], 1u);
            else XB_SPIN(xb_ld(&bar[XB_TOPGEN]) == tg, bar);
            __builtin_amdgcn_fence(__ATOMIC_ACQUIRE, "agent");
            xb_add(&bar[XB_XGEN(b.x)], 1u);
            asm volatile("s_waitcnt vmcnt(0)" ::: "memory");
        } else {
            XB_SPIN(xb_ld(&bar[XB_XGEN(b.x)]) == gen, bar);
            __builtin_amdgcn_fence(__ATOMIC_ACQUIRE, "agent");
            asm volatile("s_waitcnt vmcnt(0)" ::: "memory");
        }
    }
    __syncthreads();
}


constexpr int NPHASE = 14;
__global__ void __launch_bounds__(NTHR, 2) fwd_megakernel(Params p) {
    extern __shared__ __attribute__((aligned(16))) unsigned char smem[];
    float* ldsf = (float*)smem;
    LAS unsigned char* ldsl = (LAS unsigned char*)smem;
    unsigned char* ws = p.ws;
    volatile LAS unsigned* xst = (volatile LAS unsigned*)(ldsl + LDS_MAIN + 16);
    if (threadIdx.x == 0) { xst[0] = 0u; xst[1] = 0u; }
    __syncthreads();
    const XcdBarrier xbar = xcd_barrier_post((unsigned*)(ws + WS_BAR), xst);
    if (p.ph_lo < 0) cg::this_grid().sync();
#ifndef DUP_PHASE
#define DUP_PHASE -1
#endif
#define PHASE(n) if (p.ph_lo <= (n) && (n) < p.ph_hi && ((n) == p.ph_lo || (xcd_barrier(xbar), true))) for (int rep = 0; rep < ((n) == DUP_PHASE ? 2 : 1); ++rep, ((n) == DUP_PHASE ? (xcd_barrier(xbar), 0) : 0))
    PHASE(0) phase_prologue(p, ldsf);
    PHASE(1) phase_h(p, 0, ldsf);
    PHASE(2) { pg8::Gemm g{(const bf16_t*)(ws + WS_H), (const bf16_t*)(ws + WS_BT0), NTOK, 8192, 1024, 1024, 1}; pg8::Order S; S.init(NTOK, 8192, 1, gridDim.x, blockIdx.x);
               pg8::EpiBf16 E{(bf16_t*)(ws + WS_P), N0, 0}; pg8::gemm_phase(ldsl, g, S, E); }
    PHASE(3) phase_mix0(p, ldsf, rep);
    PHASE(4) { phase_wkv_fix(p, ldsf); phase_late_weights(p, ldsf); }
    PHASE(5) phase_wkv_post(p);
    PHASE(6) { pg8::Gemm g{(const bf16_t*)(ws + WS_OC), (const bf16_t*)(ws + WS_WT0O), NTOK, 1024, 1024, 2048, 2}; pg8::Order S; S.init(NTOK, 1024, 2, gridDim.x, blockIdx.x);
               pg8::EpiBf16 E{(bf16_t*)(ws + WS_P), 1024, (size_t)NTOK * 1024}; pg8::gemm_phase(ldsl, g, S, E); }
    PHASE(7) phase_h(p, 1, ldsf);
    PHASE(8) { pg8::Gemm g{(const bf16_t*)(ws + WS_H), (const bf16_t*)(ws + WS_BT1), NTOK, N1, 1024, 1024, 1}; pg8::Order S; S.init(NTOK, N1, 1, gridDim.x, blockIdx.x);
               pg8::EpiBf16 E{(bf16_t*)(ws + WS_P), N1, 0}; pg8::gemm_phase(ldsl, g, S, E); }
    PHASE(9) phase_gla_a(p, ldsf);
    PHASE(10) phase_gla_b(p, ldsf, rep);
    PHASE(11) phase_gla_post(p);
    PHASE(12) { pg8::Gemm g{(const bf16_t*)(ws + WS_OC), (const bf16_t*)(ws + WS_WT1O), NTOK, 1024, 512, 1024, 2}; pg8::Order S; S.init(NTOK, 1024, 2, gridDim.x, blockIdx.x);
                pg8::EpiBf16 E{(bf16_t*)(ws + WS_P2), 1024, (size_t)NTOK * 1024}; pg8::gemm_phase(ldsl, g, S, E); }
    PHASE(13) phase_final(p);
}

extern "C" void kernel_launch(void* const* d_in, const int* in_sizes, int n_in, void* d_out, int out_size, void* d_ws, size_t ws_size, hipStream_t stream) {
    static int grid = 0;
    if (grid == 0) {
        if (n_in != 30 || ws_size < WS_END) { fprintf(stderr, "kernel_launch: unexpected n_in %d / ws_size %zu (need %zu)\n", n_in, ws_size, (size_t)WS_END); grid = -1; return; }
        int dev = 0, cus = 0, per_cu = 0;
        hipGetDevice(&dev);
        hipDeviceGetAttribute(&cus, hipDeviceAttributeMultiprocessorCount, dev);
        hipFuncSetAttribute((const void*)fwd_megakernel, hipFuncAttributeMaxDynamicSharedMemorySize, LDS_BYTES);
        hipOccupancyMaxActiveBlocksPerMultiprocessor(&per_cu, (const void*)fwd_megakernel, NTHR, LDS_BYTES);
        if (per_cu < 1) { fprintf(stderr, "kernel_launch: occupancy query returned %d\n", per_cu); per_cu = 1; }
        grid = cus * per_cu;
        (void)hipGetLastError();
    }
    if (grid < 0) return;
    static_assert(XCD_BAR_WORDS * 4 <= 14336, "barrier words overlap the queue counters");
    hipMemsetAsync((char*)d_ws + WS_BAR, 0, 14336 + 256, stream);
    Params p{};
    for (int i = 0; i < 30; ++i) p.in[i] = (const float*)d_in[i];
    p.out = (float*)d_out; p.ws = (unsigned char*)d_ws;
#if MULTI_LAUNCH
    for (int ph = 0; ph < NPHASE; ++ph) { p.ph_lo = ph; p.ph_hi = ph + 1; hipLaunchKernelGGL(fwd_megakernel, dim3(grid), dim3(NTHR), LDS_BYTES, stream, p); }
#else
    p.ph_lo = 0; p.ph_hi = NPHASE;
    void* args[] = {&p};
    hipError_t e = hipLaunchCooperativeKernel((const void*)fwd_megakernel, dim3(grid), dim3(NTHR), args, LDS_BYTES, stream);
    if (e != hipSuccess) fprintf(stderr, "cooperative launch failed: %s (grid %d)\n", hipGetErrorString(e), grid);
#endif
}
```

```cpp
#include <hip/hip_runtime.h>
#include <hip/hip_cooperative_groups.h>
#include <cstdio>
namespace cg = cooperative_groups;

#define LAS __attribute__((address_space(3)))
typedef unsigned short bf16_t;
typedef short bf16x8 __attribute__((ext_vector_type(8)));
typedef float f32x4 __attribute__((ext_vector_type(4)));
typedef unsigned u32x4 __attribute__((ext_vector_type(4)));
typedef unsigned u32x2 __attribute__((ext_vector_type(2)));

#ifndef MULTI_LAUNCH
#define MULTI_LAUNCH 0
#endif

constexpr int D = 1024, NTOK = 8192, NPTOK = 4096;
constexpr int N0 = 8448;
constexpr int N1 = 3328;
constexpr int NTHR = 512;
constexpr int LDS_MAIN = 139264;
constexpr int LDS_BYTES = LDS_MAIN + 256;

constexpr size_t MB = 1024 * 1024;
constexpr size_t WS_CTL = 0x1A0000 + 14336;
constexpr size_t WS_MOD = 4096;
constexpr size_t WS_BON = WS_MOD + 2 * 3 * 3072 * 4;
constexpr size_t WS_BAR = 0x1A0000;
constexpr size_t WS_BT0 = 2 * MB;
constexpr size_t WS_WT0O = WS_BT0 + (size_t)N0 * 1024 * 2;
constexpr size_t WS_BT1 = WS_WT0O + (size_t)1024 * 2048 * 2;
constexpr size_t WS_WT1O = WS_BT1 + (size_t)N1 * 1024 * 2;
constexpr size_t WS_H = WS_WT1O + (size_t)1024 * 1024 * 2;
constexpr size_t WS_OC = WS_H + (size_t)NTOK * 1024 * 2;
constexpr size_t WS_X1 = WS_OC + (size_t)NTOK * 2048 * 2;
constexpr size_t WS_P = WS_X1 + (size_t)NTOK * 1024 * 4;
constexpr size_t WS_P2 = WS_P + 64 * MB;
constexpr size_t WS_END = WS_P + (size_t)NTOK * N0 * 2;

struct Params {
    const float* in[30];
    float* out;
    unsigned char* ws;
    int ph_lo, ph_hi;
};

__device__ __forceinline__ float bf2f(bf16_t h) { return __uint_as_float(((unsigned)h) << 16); }
__device__ __forceinline__ bf16_t f2bf(float f) { unsigned u = __float_as_uint(f); u += 0x7FFFu + ((u >> 16) & 1u); return (bf16_t)(u >> 16); }
__device__ __forceinline__ unsigned pack2(float lo, float hi) { return (unsigned)f2bf(lo) | ((unsigned)f2bf(hi) << 16); }
__device__ __forceinline__ float bflo(unsigned w) { return __uint_as_float(w << 16); }
__device__ __forceinline__ float bfhi(unsigned w) { return __uint_as_float(w & 0xFFFF0000u); }
__device__ __forceinline__ float fexp(float x) { return __builtin_amdgcn_exp2f(x * 1.44269504f); }
__device__ __forceinline__ float flog(float x) { return __builtin_amdgcn_logf(x) * 0.69314718f; }
__device__ __forceinline__ float silu(float x) { return x * __builtin_amdgcn_rcpf(1.f + fexp(-x)); }
__device__ __forceinline__ float wave_sum(float v) {
#pragma unroll
    for (int m = 32; m >= 1; m >>= 1) v += __shfl_xor(v, m, 64);
    return v;
}

typedef float f32x2_t __attribute__((ext_vector_type(2)));
typedef __bf16 bf16x2_t __attribute__((ext_vector_type(2)));
__device__ __forceinline__ unsigned pk2(float lo, float hi) { const f32x2_t v = {lo, hi}; return __builtin_bit_cast(unsigned, __builtin_convertvector(v, bf16x2_t)); }
__device__ __forceinline__ bf16_t f2bf_hw(float f) { return __builtin_bit_cast(bf16_t, (__bf16)f); }

__device__ __forceinline__ void lds_barrier() { asm volatile("s_waitcnt lgkmcnt(0)" ::: "memory"); __builtin_amdgcn_s_barrier(); asm volatile("" ::: "memory"); }

namespace pg8 {
constexpr int BM = 256, BK = 64, HALF = 128, HTB = HALF * BK * 2, NXCD = 8, WGM = 8;
__device__ __forceinline__ int lds_byte(int r, int c) { const int st = (r >> 4) * 2 + (c >> 5), rr = r & 15, cc = c & 31, ob = rr * 64 + cc * 2; return st * 1024 + (ob ^ (((ob >> 9) & 1) << 5)); }
__device__ __forceinline__ void stage_rc(int b, int& R, int& C) { const int st = b / 1024, sb = b % 1024, swz = sb ^ (((sb >> 9) & 1) << 5); R = (st >> 1) * 16 + swz / 64; C = (st & 1) * 32 + (swz % 64) / 2; }
__device__ __forceinline__ int perm32(int rho) { const int n = rho >> 4, i = rho & 15; return 8 * (i >> 2) + 4 * n + (i & 3); }

struct Unit { int pm, pn, ks; };
struct Gemm { const bf16_t* A; const bf16_t* Bt; int M, N, K, ld, KS; };

struct Order {
    int nM, nN, nNr, nwg, G, c;
    __device__ void init(int M, int N, int KS, int G_, int c_) { nM = M / BM; nNr = N / BM; nN = nNr * KS; nwg = nM * nN; G = G_; c = c_; }
    __device__ bool next(int i, Unit& u) const {
        const long L = (long)i * G + c; if (L >= nwg) return false;
        int wgid = (int)L; { const int q = nwg / NXCD, r = nwg % NXCD, xcd = wgid % NXCD, off = wgid / NXCD; wgid = (xcd < r ? xcd * (q + 1) : r * (q + 1) + (xcd - r) * q) + off; }
        const int nig = WGM * nN, gid = wgid / nig, fm = gid * WGM, gsz = (nM - fm) < WGM ? (nM - fm) : WGM;
        u.pm = fm + ((wgid % nig) % gsz); const int pn = (wgid % nig) / gsz; u.pn = pn % nNr; u.ks = pn / nNr; return true;
    }
};

__device__ __forceinline__ unsigned cvt_pk_bf16(float lo, float hi) { unsigned r; asm volatile("v_cvt_pk_bf16_f32 %0, %1, %2" : "=v"(r) : "v"(lo), "v"(hi)); return r; }

struct EpiF32 {
    static constexpr bool PERM = false;
    float* C; int ldc; size_t ks_stride;
    __device__ __forceinline__ void operator()(const f32x4 (&acc)[2][2][4][2], const Unit& u, int wr, int wc, int fr, int fq) const {
        const int row0 = u.pm * BM + wr * 64 + fr, col0 = u.pn * BM + wc * 32 + 4 * fq;
        float* Cb = C + (size_t)u.ks * ks_stride;
#pragma unroll
        for (int ai = 0; ai < 2; ++ai)
#pragma unroll
            for (int m = 0; m < 4; ++m) { float* rowp = Cb + (size_t)(row0 + ai * HALF + m * 16) * ldc + col0;
#pragma unroll
                for (int bj = 0; bj < 2; ++bj)
#pragma unroll
                    for (int n = 0; n < 2; ++n) *(f32x4*)(rowp + bj * HALF + n * 16) = acc[ai][bj][m][n]; }
    }
};
struct EpiBf16 {
    static constexpr bool PERM = true;
    bf16_t* O; int ldc; size_t ks_stride;
    __device__ __forceinline__ void operator()(const f32x4 (&acc)[2][2][4][2], const Unit& u, int wr, int wc, int fr, int fq) const {
        const int row0 = u.pm * BM + wr * 64 + fr; const int col0 = u.pn * BM + wc * 32 + 8 * fq;
        bf16_t* Ob = O + (size_t)u.ks * ks_stride;
#pragma unroll
        for (int ai = 0; ai < 2; ++ai)
#pragma unroll
            for (int m = 0; m < 4; ++m) { bf16_t* rowp = Ob + (size_t)(row0 + ai * HALF + m * 16) * ldc + col0;
#pragma unroll
                for (int bj = 0; bj < 2; ++bj) { const f32x4 v0 = acc[ai][bj][m][0], v1 = acc[ai][bj][m][1];
                    u32x4 w; w.x = cvt_pk_bf16(v0[0], v0[1]); w.y = cvt_pk_bf16(v0[2], v0[3]); w.z = cvt_pk_bf16(v1[0], v1[1]); w.w = cvt_pk_bf16(v1[2], v1[3]);
                    *(u32x4*)(rowp + bj * HALF) = w; } }
    }
};

template <class Epi>
__device__ __forceinline__ void gemm_phase(LAS unsigned char* lds, const Gemm g, const Order& S, const Epi& E) {
    const int tid = threadIdx.x, wid = __builtin_amdgcn_readfirstlane(tid >> 6), lane = tid & 63, wr = wid >> 2, wc = wid & 3, fr = lane & 15, fq = lane >> 4;
    const int K = g.K, nt = K / BK, ld = g.ld;
    unsigned voffA[2], voffB[2];
#pragma unroll
    for (int i = 0; i < 2; ++i) { int R, C; stage_rc(tid * 16 + i * 8192, R, C); const int Rb = Epi::PERM ? ((R & ~31) + perm32(R & 31)) : R;
        voffA[i] = (unsigned)(R * ld + C) * 2u; voffB[i] = (unsigned)(Rb * ld + C) * 2u; }
    const size_t kstep = (size_t)(BK * 2);
    const size_t hstep = (size_t)HALF * ld * 2;
    const size_t tstep = 2 * hstep;
    const size_t ksb = (size_t)K * 2;
    const unsigned ldsw = (unsigned)wid * 1024u;
    const int aoff = lds_byte(wr * 64 + fr, fq * 8), boff = lds_byte(wc * 32 + fr, fq * 8);
#define PG8_SA(b, h) (((b) * 2 + (h)) * HTB)
#define PG8_SB(b, h) ((4 + (b) * 2 + (h)) * HTB)
#define PG8_STAGE(bufoff, gbase, voff) do { _Pragma("unroll") for (int _i = 0; _i < 2; ++_i) \
        __builtin_amdgcn_global_load_lds((const unsigned*)((const char*)(gbase) + (voff)[_i]), (LAS unsigned*)(lds + (bufoff) + ldsw + _i * 8192), 16, 0, 0); } while (0)
#define PG8_LDA(dst, b, h) do { _Pragma("unroll") for (int m = 0; m < 4; ++m) _Pragma("unroll") for (int k = 0; k < 2; ++k) dst[m][k] = *(const LAS bf16x8*)(lds + PG8_SA(b, h) + aoff + m * 2048 + k * 1024); } while (0)
#define PG8_LDB(dst, b, h) do { _Pragma("unroll") for (int n = 0; n < 2; ++n) _Pragma("unroll") for (int k = 0; k < 2; ++k) dst[n][k] = *(const LAS bf16x8*)(lds + PG8_SB(b, h) + boff + n * 2048 + k * 1024); } while (0)
#define PG8_MMA(ai, bj, At, Bt) do { __builtin_amdgcn_s_setprio(1); _Pragma("unroll") for (int m = 0; m < 4; ++m) _Pragma("unroll") for (int n = 0; n < 2; ++n) _Pragma("unroll") for (int k = 0; k < 2; ++k) \
        acc[ai][bj][m][n] = __builtin_amdgcn_mfma_f32_16x16x32_bf16(Bt[n][k], At[m][k], acc[ai][bj][m][n], 0, 0, 0); __builtin_amdgcn_s_setprio(0); } while (0)
#define PG8_WAIT_V(n) asm volatile("s_waitcnt vmcnt(" #n ")" ::: "memory")
#define PG8_WAIT_L(n) asm volatile("s_waitcnt lgkmcnt(" #n ")" ::: "memory")
#define PG8_BAR __builtin_amdgcn_s_barrier()
#define PG8_SCHED __builtin_amdgcn_sched_barrier(0)
    Unit cur, nxt; int ui = 0;
    if (!S.next(0, cur)) return;
    f32x4 acc[2][2][4][2];
#pragma unroll
    for (int a = 0; a < 2; ++a)
#pragma unroll
        for (int b = 0; b < 2; ++b)
#pragma unroll
            for (int m = 0; m < 4; ++m)
#pragma unroll
                for (int n = 0; n < 2; ++n) acc[a][b][m][n] = (f32x4){0.f, 0.f, 0.f, 0.f};
    bf16x8 At[4][2], B0[2][2], B1[2][2];
    const char* cA = (const char*)g.A + (size_t)cur.pm * tstep + (size_t)cur.ks * ksb; const char* cB = (const char*)g.Bt + (size_t)cur.pn * tstep + (size_t)cur.ks * ksb;
    PG8_STAGE(PG8_SB(0, 0), cB, voffB); PG8_STAGE(PG8_SA(0, 0), cA, voffA); PG8_STAGE(PG8_SB(0, 1), cB + hstep, voffB); PG8_STAGE(PG8_SA(0, 1), cA + hstep, voffA);
    if (wr == 1) PG8_BAR;
    PG8_WAIT_V(4); PG8_BAR;
    PG8_STAGE(PG8_SB(1, 0), cB + kstep, voffB); PG8_STAGE(PG8_SA(1, 0), cA + kstep, voffA); PG8_STAGE(PG8_SB(1, 1), cB + hstep + kstep, voffB);
    PG8_WAIT_V(6); PG8_BAR;
    for (;;) {
        const bool has_next = S.next(ui + 1, nxt);
        const char* nA = has_next ? (const char*)g.A + (size_t)nxt.pm * tstep + (size_t)nxt.ks * ksb : cA; const char* nB = has_next ? (const char*)g.Bt + (size_t)nxt.pn * tstep + (size_t)nxt.ks * ksb : cB;
        for (int t = 0; t < nt; t += 2) {
            const bool last = (t == nt - 2);
            const char* a1 = cA + (size_t)(t + 1) * kstep;
            const char* a2 = last ? nA : cA + (size_t)(t + 2) * kstep; const char* b2 = last ? nB : cB + (size_t)(t + 2) * kstep;
            const char* a3 = a2 + kstep; const char* b3 = b2 + kstep;
            PG8_LDB(B0, 0, 0); PG8_SCHED; PG8_LDA(At, 0, 0); PG8_STAGE(PG8_SA(1, 1), a1 + hstep, voffA);
            PG8_WAIT_L(8); PG8_BAR; PG8_WAIT_L(0); PG8_MMA(0, 0, At, B0); PG8_BAR; PG8_SCHED;
            PG8_LDB(B1, 0, 1); PG8_STAGE(PG8_SB(0, 0), b2, voffB);
            PG8_BAR; PG8_WAIT_L(0); PG8_MMA(0, 1, At, B1); PG8_BAR;
            PG8_LDA(At, 0, 1); PG8_STAGE(PG8_SA(0, 0), a2, voffA);
            PG8_BAR; PG8_WAIT_L(0); PG8_MMA(1, 0, At, B0); PG8_BAR; PG8_SCHED;
            PG8_STAGE(PG8_SB(0, 1), b2 + hstep, voffB);
            PG8_WAIT_V(6); PG8_BAR; PG8_MMA(1, 1, At, B1); PG8_BAR;
            PG8_LDB(B0, 1, 0); PG8_SCHED; PG8_LDA(At, 1, 0); PG8_STAGE(PG8_SA(0, 1), a2 + hstep, voffA);
            PG8_WAIT_L(8); PG8_BAR; PG8_WAIT_L(0); PG8_MMA(0, 0, At, B0); PG8_BAR; PG8_SCHED;
            PG8_LDB(B1, 1, 1); PG8_STAGE(PG8_SB(1, 0), b3, voffB);
            PG8_BAR; PG8_WAIT_L(0); PG8_MMA(0, 1, At, B1); PG8_BAR;
            PG8_LDA(At, 1, 1); PG8_STAGE(PG8_SA(1, 0), a3, voffA);
            PG8_BAR; PG8_WAIT_L(0); PG8_MMA(1, 0, At, B0); PG8_BAR; PG8_SCHED;
            PG8_STAGE(PG8_SB(1, 1), b3 + hstep, voffB);
            PG8_WAIT_V(6); PG8_BAR; PG8_MMA(1, 1, At, B1); PG8_BAR;
        }
        E(acc, cur, wr, wc, fr, fq);
        if (!has_next) break;
#pragma unroll
        for (int a = 0; a < 2; ++a)
#pragma unroll
            for (int b = 0; b < 2; ++b)
#pragma unroll
                for (int m = 0; m < 4; ++m)
#pragma unroll
                    for (int n = 0; n < 2; ++n) acc[a][b][m][n] = (f32x4){0.f, 0.f, 0.f, 0.f};
        cur = nxt; cA = nA; cB = nB; ++ui;
    }
    PG8_WAIT_V(0);
    if (wr == 0) PG8_BAR;
    PG8_BAR;
#undef PG8_SA
#undef PG8_SB
#undef PG8_STAGE
#undef PG8_LDA
#undef PG8_LDB
#undef PG8_MMA
#undef PG8_WAIT_V
#undef PG8_WAIT_L
#undef PG8_BAR
#undef PG8_SCHED
}
}

struct TJob { const float* src; bf16_t* dst; int ldsrc, N, lddst, drow0, k0, n0; };
__device__ __forceinline__ TJob tjob_of(const Params& p, int t) {
    unsigned char* ws = p.ws;
    bf16_t* BT0 = (bf16_t*)(ws + WS_BT0); bf16_t* WT0O = (bf16_t*)(ws + WS_WT0O); bf16_t* BT1 = (bf16_t*)(ws + WS_BT1); bf16_t* WT1O = (bf16_t*)(ws + WS_WT1O);
    TJob j; int nnt;
    if (t < 1024) { j.src = p.in[10]; j.ldsrc = 8192; j.N = 8192; j.dst = BT0; j.lddst = 1024; j.drow0 = 0; nnt = 64; }
    else if (t < 1024 + 32) { t -= 1024; const int z = t >> 4; t &= 15; j.src = p.in[14] + (size_t)z * 1024 * 64; j.ldsrc = 64; j.N = 64; j.dst = BT0; j.lddst = 1024; j.drow0 = 8192 + z * 64; nnt = 1; }
    else if (t < 1024 + 64) { t -= 1024 + 32; const int z = t >> 4; t &= 15; j.src = p.in[17] + (size_t)z * 1024 * 64; j.ldsrc = 64; j.N = 64; j.dst = BT0; j.lddst = 1024; j.drow0 = 8320 + z * 64; nnt = 1; }
    else if (t < 1088 + 256) { t -= 1088; j.src = p.in[11]; j.ldsrc = 1024; j.N = 1024; j.dst = WT0O; j.lddst = 2048; j.drow0 = 0; nnt = 8; }
    else if (t < 1344 + 384) { t -= 1344; j.src = p.in[24]; j.ldsrc = 3072; j.N = 3072; j.dst = BT1; j.lddst = 1024; j.drow0 = 0; nnt = 24; }
    else if (t < 1728 + 32) { t -= 1728; const int z = t >> 4; t &= 15; j.src = p.in[26] + (size_t)z * 1024 * 16; j.ldsrc = 16; j.N = 16; j.dst = BT1; j.lddst = 1024; j.drow0 = 3072 + z * 16; nnt = 1; }
    else { t -= 1760; j.src = p.in[25]; j.ldsrc = 1024; j.N = 1024; j.dst = WT1O; j.lddst = 1024; j.drow0 = 0; nnt = 8; }
    j.k0 = (t / nnt) * 64; j.n0 = (t % nnt) * 128; return j;
}
__device__ __forceinline__ void tjob_load(const TJob& j, f32x4 (&r)[4]) {
    const int tid = threadIdx.x, c4 = (tid & 31) * 4;
#pragma unroll
    for (int i = 0; i < 4; ++i) { const int kk = (tid >> 5) + 16 * i;
        r[i] = (j.n0 + c4 < j.N) ? *(const f32x4*)(j.src + (size_t)(j.k0 + kk) * j.ldsrc + j.n0 + c4) : (f32x4){0.f, 0.f, 0.f, 0.f}; }
}

__device__ void transpose_jobs(const Params& p, float* lds, int t_lo, int t_hi, int rot) {
    const int tid = threadIdx.x;
    float* tile = lds;
    int it = t_lo + (int)((blockIdx.x + (unsigned)rot) % gridDim.x);
    f32x4 cur[4], nxt[4];
    TJob jc = tjob_of(p, it < t_hi ? it : t_lo);
    if (it < t_hi) tjob_load(jc, cur);
    for (; it < t_hi; it += gridDim.x) {
        const int c4 = (tid & 31) * 4;
#pragma unroll
        for (int i = 0; i < 4; ++i) { const int kk = (tid >> 5) + 16 * i; tile[kk * 129 + c4] = cur[i][0]; tile[kk * 129 + c4 + 1] = cur[i][1]; tile[kk * 129 + c4 + 2] = cur[i][2]; tile[kk * 129 + c4 + 3] = cur[i][3]; }
        const int itn = it + gridDim.x;
        const TJob jn = tjob_of(p, itn < t_hi ? itn : t_lo);
        if (itn < t_hi) tjob_load(jn, nxt);
        __syncthreads();
#pragma unroll
        for (int q = 0; q < 2; ++q) { const int idx = tid + q * NTHR; const int nn = idx >> 3, k8 = (idx & 7) * 8;
            if (jc.n0 + nn < jc.N) { u32x4 o; o.x = pk2(tile[(k8 + 0) * 129 + nn], tile[(k8 + 1) * 129 + nn]); o.y = pk2(tile[(k8 + 2) * 129 + nn], tile[(k8 + 3) * 129 + nn]);
                o.z = pk2(tile[(k8 + 4) * 129 + nn], tile[(k8 + 5) * 129 + nn]); o.w = pk2(tile[(k8 + 6) * 129 + nn], tile[(k8 + 7) * 129 + nn]);
                *(u32x4*)(jc.dst + (size_t)(jc.drow0 + jc.n0 + nn) * jc.lddst + jc.k0 + k8) = o; } }
        __syncthreads();
        jc = jn;
#pragma unroll
        for (int i = 0; i < 4; ++i) cur[i] = nxt[i];
    }
}

__device__ void phase_prologue(const Params& p, float* lds) {
    const int tid = threadIdx.x;
    unsigned char* ws = p.ws;
    bf16_t* BT1 = (bf16_t*)(ws + WS_BT1);
    float* MOD = (float*)(ws + WS_MOD);
    constexpr int NGEMV = 192;
    for (int it = blockIdx.x; it < NGEMV; it += gridDim.x) {
        const int l = it / 96, j0 = (it % 96) * 32;
        float* sc = lds;
        float* red = lds + 3072;
        for (int i = tid; i < 3072; i += NTHR) { const int cnd = i >> 10, k = i & 1023; const float v = cnd == 0 ? p.in[5][k] : p.in[4][(cnd - 1) * 1024 + k]; sc[i] = silu(v); }
        __syncthreads();
        const int col = tid & 31, ksp = tid >> 5;
        float a0 = 0.f, a1 = 0.f, a2 = 0.f;
        const float* w = p.in[7] + (size_t)l * 1024 * 3072 + j0 + col;
#pragma unroll 16
        for (int k = ksp * 64; k < ksp * 64 + 64; ++k) { const float wv = w[(size_t)k * 3072]; a0 += sc[k] * wv; a1 += sc[1024 + k] * wv; a2 += sc[2048 + k] * wv; }
        red[(ksp * 3 + 0) * 32 + col] = a0; red[(ksp * 3 + 1) * 32 + col] = a1; red[(ksp * 3 + 2) * 32 + col] = a2;
        __syncthreads();
        if (tid < 96) { const int cnd = tid >> 5, cc = tid & 31; float s = 0.f; for (int q = 0; q < 16; ++q) s += red[(q * 3 + cnd) * 32 + cc];
            MOD[(l * 3 + cnd) * 3072 + j0 + cc] = s + p.in[8][l * 3072 + j0 + cc]; }
        __syncthreads();
    }
    transpose_jobs(p, lds, 0, 1088, 64);
}
__device__ void phase_late_weights(const Params& p, float* lds) {
    const int tid = threadIdx.x;
    bf16_t* BT1 = (bf16_t*)(p.ws + WS_BT1);
    transpose_jobs(p, lds, 1088, 1888, 0);
    { u32x4* z = (u32x4*)(BT1 + (size_t)3104 * 1024); const int n = 224 * 1024 * 2 / 16;
      for (int i = blockIdx.x * NTHR + tid; i < n; i += gridDim.x * NTHR) z[i] = (u32x4){0u, 0u, 0u, 0u}; }
}

__device__ void phase_h(const Params& p, int layer, float* ldsf) {
    const int tid = threadIdx.x, wave = __builtin_amdgcn_readfirstlane(tid >> 6), lane = tid & 63, fr = lane & 15, fq = lane >> 4;
    unsigned char* ws = p.ws;
    const float* MOD = (const float*)(ws + WS_MOD);
    bf16_t* H = (bf16_t*)(ws + WS_H);
    float* X1 = (float*)(ws + WS_X1);
    const bf16_t* Y = (const bf16_t*)(ws + WS_P);
    bf16_t* HL = (bf16_t*)ldsf;
    for (int tb = blockIdx.x * 32; tb < NTOK; tb += gridDim.x * 32) {
#pragma unroll 1
        for (int q = 0; q < 4; ++q) { const int tl = wave * 4 + q, tok = tb + tl;
            const float* xr = tok < NPTOK ? p.in[0] + (size_t)tok * D : p.in[1] + (size_t)(tok - NPTOK) * D;
            const int cond = tok < NPTOK ? 0 : 1 + ((tok - NPTOK) >> 11);
            f32x4 xv[4]; float ss = 0.f;
#pragma unroll
            for (int i = 0; i < 4; ++i) { const int idx = i * 256 + lane * 4; xv[i] = *(const f32x4*)(xr + idx);
                if (layer == 1) { const u32x2 pa = *(const u32x2*)(Y + (size_t)tok * D + idx), pb = *(const u32x2*)(Y + (size_t)NTOK * D + (size_t)tok * D + idx);
                    const f32x4 ya = (f32x4){bflo(pa.x), bfhi(pa.x), bflo(pa.y), bfhi(pa.y)}, yb = (f32x4){bflo(pb.x), bfhi(pb.x), bflo(pb.y), bfhi(pb.y)};
                    const f32x4 gt = *(const f32x4*)(MOD + (0 * 3 + cond) * 3072 + 2048 + idx);
                    xv[i] = xv[i] + gt * (ya + yb); *(f32x4*)(X1 + (size_t)tok * D + idx) = xv[i]; }
                ss += xv[i][0] * xv[i][0] + xv[i][1] * xv[i][1] + xv[i][2] * xv[i][2] + xv[i][3] * xv[i][3]; }
            ss = wave_sum(ss);
            const float rstd = rsqrtf(ss * (1.f / 1024.f) + 1e-6f);
#pragma unroll
            for (int i = 0; i < 4; ++i) { const int idx = i * 256 + lane * 4;
                const f32x4 g = *(const f32x4*)(p.in[6] + layer * D + idx);
                const f32x4 sh = *(const f32x4*)(MOD + (layer * 3 + cond) * 3072 + idx), sc = *(const f32x4*)(MOD + (layer * 3 + cond) * 3072 + 1024 + idx);
                f32x4 h;
#pragma unroll
                for (int j = 0; j < 4; ++j) h[j] = xv[i][j] * rstd * g[j] * (1.f + sc[j]) + sh[j];
                u32x2 w2; w2.x = pk2(h[0], h[1]); w2.y = pk2(h[2], h[3]);
                *(u32x2*)(H + (size_t)tok * D + idx) = w2;
                if (layer == 0) *(u32x2*)(HL + tl * 1032 + idx) = w2; } }
        if (layer == 0) {
            __syncthreads();
            const bf16_t* BL = (const bf16_t*)(ws + WS_BT0) + (size_t)8192 * 1024;
            bf16_t* P = (bf16_t*)(ws + WS_P);
            f32x4 acc[2][2];
#pragma unroll
            for (int mt = 0; mt < 2; ++mt)
#pragma unroll
                for (int n2 = 0; n2 < 2; ++n2) acc[mt][n2] = (f32x4){0.f, 0.f, 0.f, 0.f};
#pragma unroll 16
            for (int ks = 0; ks < 32; ++ks) {
                bf16x8 af[2], bfr[2];
#pragma unroll
                for (int mt = 0; mt < 2; ++mt) af[mt] = *(const bf16x8*)(HL + (mt * 16 + fr) * 1032 + ks * 32 + fq * 8);
#pragma unroll
                for (int n2 = 0; n2 < 2; ++n2) bfr[n2] = *(const bf16x8*)(BL + (size_t)((wave * 2 + n2) * 16 + fr) * 1024 + ks * 32 + fq * 8);
#pragma unroll
                for (int mt = 0; mt < 2; ++mt)
#pragma unroll
                    for (int n2 = 0; n2 < 2; ++n2) acc[mt][n2] = __builtin_amdgcn_mfma_f32_16x16x32_bf16(bfr[n2], af[mt], acc[mt][n2], 0, 0, 0);
            }
#pragma unroll
            for (int mt = 0; mt < 2; ++mt)
#pragma unroll
                for (int n2 = 0; n2 < 2; ++n2)
                    { u32x2 o2; o2.x = pk2(acc[mt][n2][0], acc[mt][n2][1]); o2.y = pk2(acc[mt][n2][2], acc[mt][n2][3]);
                      *(u32x2*)(P + (size_t)(tb + mt * 16 + fr) * N0 + 8192 + (wave * 2 + n2) * 16 + fq * 4) = o2; }
            __syncthreads();
        }
    }
}

__device__ __forceinline__ f32x4 mma_nt(const bf16_t* A, int lda, const bf16_t* B, int ldb, int K, f32x4 acc, int fr, int fq) {
    for (int k0 = 0; k0 < K; k0 += 32) {
        const bf16x8 a = *(const bf16x8*)(A + fr * lda + k0 + fq * 8);
        const bf16x8 b = *(const bf16x8*)(B + fr * ldb + k0 + fq * 8);
        acc = __builtin_amdgcn_mfma_f32_16x16x32_bf16(a, b, acc, 0, 0, 0);
    }
    return acc;
}
__device__ __forceinline__ bf16x8 pack8(float a0, float a1, float a2, float a3, float a4, float a5, float a6, float a7) {
    u32x4 w; w.x = pack2(a0, a1); w.y = pack2(a2, a3); w.z = pack2(a4, a5); w.w = pack2(a6, a7);
    return __builtin_bit_cast(bf16x8, w);
}
__device__ __forceinline__ float dpp_add(float v, float o) { return v + o; }
__device__ __forceinline__ float wave_sum_fast(float v) {
    v += __int_as_float(__builtin_amdgcn_update_dpp(0, __float_as_int(v), 0xB1, 0xF, 0xF, true));
    v += __int_as_float(__builtin_amdgcn_update_dpp(0, __float_as_int(v), 0x4E, 0xF, 0xF, true));
    v += __int_as_float(__builtin_amdgcn_update_dpp(0, __float_as_int(v), 0x141, 0xF, 0xF, true));
    v += __int_as_float(__builtin_amdgcn_update_dpp(0, __float_as_int(v), 0x140, 0xF, 0xF, true));
    v += __shfl_xor(v, 16, 64); v += __shfl_xor(v, 32, 64);
    return v;
}
__device__ __forceinline__ float wave_sum_dpp(float v) {
    v += __int_as_float(__builtin_amdgcn_update_dpp(0, __float_as_int(v), 0xB1, 0xF, 0xF, true));
    v += __int_as_float(__builtin_amdgcn_update_dpp(0, __float_as_int(v), 0x4E, 0xF, 0xF, true));
    v += __int_as_float(__builtin_amdgcn_update_dpp(0, __float_as_int(v), 0x141, 0xF, 0xF, true));
    v += __int_as_float(__builtin_amdgcn_update_dpp(0, __float_as_int(v), 0x140, 0xF, 0xF, true));
    v += __int_as_float(__builtin_amdgcn_update_dpp(0, __float_as_int(v), 0x142, 0xA, 0xF, false));
    v += __int_as_float(__builtin_amdgcn_update_dpp(0, __float_as_int(v), 0x143, 0xC, 0xF, false));
    return __int_as_float(__builtin_amdgcn_readlane(__float_as_int(v), 63));
}
__device__ __forceinline__ float wave_sum_lane63(float v) {
    v += __int_as_float(__builtin_amdgcn_update_dpp(0, __float_as_int(v), 0xB1, 0xF, 0xF, true));
    v += __int_as_float(__builtin_amdgcn_update_dpp(0, __float_as_int(v), 0x4E, 0xF, 0xF, true));
    v += __int_as_float(__builtin_amdgcn_update_dpp(0, __float_as_int(v), 0x141, 0xF, 0xF, true));
    v += __int_as_float(__builtin_amdgcn_update_dpp(0, __float_as_int(v), 0x140, 0xF, 0xF, true));
    v += __int_as_float(__builtin_amdgcn_update_dpp(0, __float_as_int(v), 0x142, 0xA, 0xF, false));
    v += __int_as_float(__builtin_amdgcn_update_dpp(0, __float_as_int(v), 0x143, 0xC, 0xF, false));
    return v;
}
__device__ __forceinline__ float fast_tanh(float x) { const float e = fexp(2.f * x); return 1.f - 2.f * __builtin_amdgcn_rcpf(1.f + e); }
__device__ __forceinline__ bf16x8 pack8h(float a0, float a1, float a2, float a3, float a4, float a5, float a6, float a7) {
    u32x4 w; w.x = pk2(a0, a1); w.y = pk2(a2, a3); w.z = pk2(a4, a5); w.w = pk2(a6, a7);
    return __builtin_bit_cast(bf16x8, w);
}

__device__ __forceinline__ void conv_pair(const Params& p, int t0, int c0) {
    unsigned char* ws = p.ws;
    const bf16_t* P = (const bf16_t*)(ws + WS_P);
    bf16_t* OC = (bf16_t*)(ws + WS_OC);
    const int rl = t0 < NPTOK ? 256 : 64; const int pos0 = t0 & (rl - 1);
    const bool hasp = pos0 > 0, hasn = pos0 + 2 < rl;
    const bf16_t* row0 = P + (size_t)t0 * N0 + c0;
    const u32x4 z4 = (u32x4){0u, 0u, 0u, 0u};
    u32x4 uu[4], gg[4], gb[2], zc[2];
    uu[0] = hasp ? *(const u32x4*)(row0 - N0) : z4; gg[0] = hasp ? *(const u32x4*)(row0 - N0 + 2048) : z4;
#pragma unroll
    for (int j = 0; j < 2; ++j) { uu[j + 1] = *(const u32x4*)(row0 + (size_t)j * N0); gg[j + 1] = *(const u32x4*)(row0 + (size_t)j * N0 + 2048);
        gb[j] = *(const u32x4*)(row0 + (size_t)j * N0 + 1024); zc[j] = *(const u32x4*)(row0 + (size_t)j * N0 + 3072); }
    uu[3] = hasn ? *(const u32x4*)(row0 + (size_t)2 * N0) : z4; gg[3] = hasn ? *(const u32x4*)(row0 + (size_t)2 * N0 + 2048) : z4;
    float cw[3][8];
#pragma unroll
    for (int k = 0; k < 3; ++k) { const f32x4 a = *(const f32x4*)(p.in[12] + k * 1024 + c0), b = *(const f32x4*)(p.in[12] + k * 1024 + c0 + 4);
        cw[k][0] = a[0]; cw[k][1] = a[1]; cw[k][2] = a[2]; cw[k][3] = a[3]; cw[k][4] = b[0]; cw[k][5] = b[1]; cw[k][6] = b[2]; cw[k][7] = b[3]; }
#pragma unroll
    for (int j = 0; j < 2; ++j) { u32x4 o;
#pragma unroll
        for (int q = 0; q < 4; ++q) {
            const float y0 = cw[0][2 * q] * (bflo(gg[j][q]) * bflo(uu[j][q])) + cw[1][2 * q] * (bflo(gg[j + 1][q]) * bflo(uu[j + 1][q])) + cw[2][2 * q] * (bflo(gg[j + 2][q]) * bflo(uu[j + 2][q]));
            const float y1 = cw[0][2 * q + 1] * (bfhi(gg[j][q]) * bfhi(uu[j][q])) + cw[1][2 * q + 1] * (bfhi(gg[j + 1][q]) * bfhi(uu[j + 1][q])) + cw[2][2 * q + 1] * (bfhi(gg[j + 2][q]) * bfhi(uu[j + 2][q]));
            o[q] = pk2(silu(bflo(zc[j][q])) * bflo(gb[j][q]) * y0, silu(bfhi(zc[j][q])) * bfhi(gb[j][q]) * y1);
        }
        *(u32x4*)(OC + (size_t)(t0 + j) * 2048 + c0) = o; }
}

__device__ void wkv_unit(const Params& p, int u, float* ldsf) {
    const int tid0 = threadIdx.x, lane0 = tid0 & 63, w = __builtin_amdgcn_readfirstlane(tid0 >> 6), fr0 = lane0 & 15, fq0 = lane0 >> 4;
    unsigned char* ws = p.ws;
    unsigned char* lds = (unsigned char*)ldsf;
    const bf16_t* P = (const bf16_t*)(ws + WS_P);
    bf16_t* OD = (bf16_t*)(ws + WS_X1);
    float* BON = (float*)(ws + WS_BON);
    int z, b, hd, sgm, seqT, tok0; bool sample; const int T = 256;
    if (u < 512) { sample = true; z = u >> 8; b = (u >> 7) & 1; hd = (u >> 3) & 15; sgm = u & 7; seqT = 2048; tok0 = NPTOK + b * 2048; }
    else { const int q = u - 512; sample = false; z = q >> 8; b = (q >> 4) & 15; hd = q & 15; sgm = 0; seqT = 256; tok0 = b * 256; }
    const int qbase = sgm * 256;
    bf16_t* RHO = (bf16_t*)(ws + WS_H);
    float* GH = (float*)(ws + WS_BT0);
    bf16_t* TLW = (bf16_t*)(lds + 0);
    bf16_t* TLA = (bf16_t*)(lds + 9216);
    float* HT = (float*)(lds + 18432);
    float* BONL = (float*)(lds + 57344);
    bf16_t* KTr = (bf16_t*)(lds + 20480);
    bf16_t* BTr = (bf16_t*)(lds + 29696);
    bf16_t* KKH = (bf16_t*)(lds + 38912);
    bf16_t* RH = (bf16_t*)(lds + 48128);
    const bf16_t* VS = (const bf16_t*)(lds + 113664 + 2 * 8192);
    bf16_t* TA = (bf16_t*)(lds + 65536);
    bf16_t* NA = (bf16_t*)(lds + 70656);
    float* PC = (float*)(lds + 75776);
    bf16_t* KBm = (bf16_t*)(lds + 76800);
    float* MM = (float*)(lds + 97280);
    float* WA = (float*)(lds + 76800);
    bf16x8 bw[2];
    { const float* W2 = (w >> 2) ? p.in[18] : p.in[15];
#pragma unroll
      for (int ks = 0; ks < 2; ++ks) { float t8[8];
#pragma unroll
        for (int e = 0; e < 8; ++e) t8[e] = W2[(size_t)(z * 64 + ks * 32 + fq0 * 8 + e) * 1024 + hd * 64 + (w & 3) * 16 + fr0];
        bw[ks] = pack8h(t8[0], t8[1], t8[2], t8[3], t8[4], t8[5], t8[6], t8[7]); } }
    f32x4 Sacc[4];
#pragma unroll
    for (int kt = 0; kt < 4; ++kt) Sacc[kt] = (f32x4){0.f, 0.f, 0.f, 0.f};
    if (w >= 4) {
#pragma unroll
        for (int kt = 0; kt < 4; ++kt)
#pragma unroll
            for (int jj = 0; jj < 4; ++jj) Sacc[kt][jj] = (kt * 16 + fq0 * 4 + jj == (w - 4) * 16 + fr0) ? 1.f : 0.f; }
    const int ch = hd * 64 + lane0;
    const float w0c = p.in[13][z * 1024 + ch], a0c = p.in[16][z * 1024 + ch], kkc = p.in[19][ch], kac = p.in[20][ch], rkc = p.in[21][ch];
    bf16_t* RKV = (bf16_t*)(lds + 113664);
    u32x4 tlraw[2], rkvraw[3];
#define WKV_LOAD_RAW(tb_) do { \
        _Pragma("unroll") for (int h_ = 0; h_ < 2; ++h_) { const int idx_ = tid + h_ * NTHR; const int tau_ = idx_ >> 4, sg_ = idx_ & 15; const int t_ = z ? (seqT - 1 - (qbase + (tb_) + tau_)) : (qbase + (tb_) + tau_); \
            tlraw[h_] = *(const u32x4*)(P + (size_t)(tok0 + t_) * N0 + 8192 + (sg_ < 8 ? z * 64 + sg_ * 8 : 128 + z * 64 + (sg_ - 8) * 8)); } \
        { const int tau_ = tid >> 3, sg_ = tid & 7; const int t_ = z ? (seqT - 1 - (qbase + (tb_) + tau_)) : (qbase + (tb_) + tau_); const bf16_t* rp_ = P + (size_t)(tok0 + t_) * N0 + 4096 + hd * 64 + sg_ * 8; \
          rkvraw[0] = *(const u32x4*)rp_; rkvraw[1] = *(const u32x4*)(rp_ + 1024); rkvraw[2] = *(const u32x4*)(rp_ + 2048); } } while (0)
    { const int tid = tid0; WKV_LOAD_RAW(0); }
    __syncthreads();
#pragma unroll 1
    for (int tb = 0; tb < T; tb += 64) {
        int tid = tid0; asm volatile("" : "+v"(tid));
        const int lane = tid & 63, fr = lane & 15, fq = lane >> 4, c = lane;
        const int pcol = ((c >> 5) * 32) + (((c >> 2) & 3) * 8) + (((c >> 4) & 1) * 4) + (c & 3);
#pragma unroll
        for (int h = 0; h < 2; ++h) { const int idx = tid + h * NTHR; const int tau = idx >> 4, sg = idx & 15;
            u32x4 o = tlraw[h];
            if (sg < 8) { o.x = pk2(fast_tanh(bflo(o.x)), fast_tanh(bfhi(o.x))); o.y = pk2(fast_tanh(bflo(o.y)), fast_tanh(bfhi(o.y)));
                          o.z = pk2(fast_tanh(bflo(o.z)), fast_tanh(bfhi(o.z))); o.w = pk2(fast_tanh(bflo(o.w)), fast_tanh(bfhi(o.w))); }
            *(u32x4*)((sg < 8 ? TLW : TLA) + tau * 72 + (sg & 7) * 8) = o; }
#pragma unroll
        for (int h = 0; h < 3; ++h) *(u32x4*)(RKV + h * 4096 + (tid >> 3) * 64 + (tid & 7) * 8) = rkvraw[h];
        lds_barrier();
        if (tb + 64 < T) WKV_LOAD_RAW(tb + 64);
        { const bf16_t* TL = (w >> 2) ? TLA : TLW; float* WAo = WA + (w >> 2) * 64 * 68;
#pragma unroll
          for (int mt = 0; mt < 4; ++mt) { f32x4 acc = (f32x4){0.f, 0.f, 0.f, 0.f};
#pragma unroll
            for (int ks = 0; ks < 2; ++ks) { const bf16x8 a = *(const bf16x8*)(TL + (mt * 16 + fr) * 72 + ks * 32 + fq * 8);
                acc = __builtin_amdgcn_mfma_f32_16x16x32_bf16(a, bw[ks], acc, 0, 0, 0); }
#pragma unroll
            for (int jj = 0; jj < 4; ++jj) WAo[(mt * 16 + fq * 4 + jj) * 68 + (w & 3) * 16 + fr] = acc[jj]; } }
        lds_barrier();
        float kkv[8], kmv[8], bv[8], lwv[8], cum[8], rr[8], bonv[8];
        { float run = 0.f;
#pragma unroll
          for (int i = 0; i < 8; ++i) { const int tau = w * 8 + i; const int t = z ? (seqT - 1 - (qbase + tb + tau)) : (qbase + tb + tau); const int tokg = tok0 + t;
            const float wr_ = w0c + WA[tau * 68 + c], ap = a0c + WA[64 * 68 + tau * 68 + c];
            const float nx = -wr_; const float sp = fmaxf(nx, 0.f) + flog(1.f + fexp(-fabsf(nx)));
            const float lw = -fexp(-sp - 0.5f);
            const float iclr = __builtin_amdgcn_rcpf(1.f + fexp(-ap));
            const float kxi = bf2f(RKV[4096 + tau * 64 + c]); rr[i] = bf2f(RKV[tau * 64 + c]);
            const float kkraw = kxi * kkc;
            const float ssq = wave_sum_fast(kkraw * kkraw);
            const float kk = kkraw * __builtin_amdgcn_rsqf(fmaxf(ssq, 1e-24f));
            const float kmod = kxi * (1.f + (iclr - 1.f) * kac);
            bonv[i] = wave_sum_lane63(rr[i] * kmod * rkc);
            run += lw;
            kkv[i] = kk; kmv[i] = kmod; bv[i] = kk * iclr; lwv[i] = lw; cum[i] = run; }
          HT[w * 64 + c] = run;
          if (lane == 63) {
#pragma unroll
            for (int i = 0; i < 8; ++i) BONL[w * 8 + i] = bonv[i]; } }
        lds_barrier();
        if (tid < 64) { const int t = z ? (seqT - 1 - (qbase + tb + tid)) : (qbase + tb + tid); BON[((size_t)z * NTOK + tok0 + t) * 16 + hd] = BONL[tid]; }
        { const float off = (w & 1) ? HT[(w - 1) * 64 + c] : 0.f; const int cn = w >> 1;
          unsigned kbq[8];
#pragma unroll
          for (int i = 0; i < 8; ++i) { const int tau = w * 8 + i; const int j = (w & 1) * 8 + i;
            const float cm = cum[i] + off;
            const float Pj = fexp(cm), ipj = fexp(-cm), pm1 = fexp(cm - lwv[i]);
            const unsigned kb2 = pk2(-bv[i] * ipj, kmv[i] * ipj);
            KTr[tau * 72 + pcol] = (bf16_t)(kb2 >> 16); BTr[tau * 72 + pcol] = f2bf_hw(bv[i] * ipj);
            const unsigned kr2 = pk2(kkv[i] * pm1, rr[i] * Pj);
            KKH[tau * 72 + pcol] = (bf16_t)(kr2 & 0xFFFFu); RH[tau * 72 + pcol] = (bf16_t)(kr2 >> 16);
            kbq[i] = kb2;
            if (j == 15) PC[cn * 64 + c] = Pj; }
#pragma unroll
          for (int g = 0; g < 2; ++g) { u32x4 o;
              o.x = (kbq[g * 4 + 0] & 0xFFFFu) | (kbq[g * 4 + 1] << 16); o.y = (kbq[g * 4 + 2] & 0xFFFFu) | (kbq[g * 4 + 3] << 16);
              o.z = (kbq[g * 4 + 0] >> 16) | (kbq[g * 4 + 1] & 0xFFFF0000u); o.w = (kbq[g * 4 + 2] >> 16) | (kbq[g * 4 + 3] & 0xFFFF0000u);
              *(u32x4*)(KBm + (cn * 64 + c) * 40 + ((w & 1) * 2 + g) * 8) = o; } }
        lds_barrier();
#pragma unroll
        for (int q2 = 0; q2 < 2; ++q2) { const int id = w * 2 + q2; const int cn = id >> 2, which = id & 3;
          const bf16_t* Am = ((which & 1) ? KTr : BTr) + cn * 16 * 72; const bf16_t* Bm = ((which & 2) ? RH : KKH) + cn * 16 * 72;
          const f32x4 acc = mma_nt(Am, 72, Bm, 72, 64, (f32x4){0.f, 0.f, 0.f, 0.f}, fr, fq);
          f32x4 o;
#pragma unroll
          for (int jj = 0; jj < 4; ++jj) { const int i = fq * 4 + jj, j = fr; const bool keep = (which & 2) ? (i <= j) : (i < j); o[jj] = keep ? acc[jj] : 0.f; }
          *(f32x4*)(MM + (cn * 4 + which) * 256 + fr * 16 + fq * 4) = o; }
        lds_barrier();
        if (w < 4) { const int cn = w, col = lane >> 2, rg = lane & 3;
            const float* MbT = MM + (cn * 4 + 0) * 256 + rg * 4; const float* MkT = MM + (cn * 4 + 1) * 256 + rg * 4;
            float Tc[4], A1[4];
#pragma unroll
            for (int e = 0; e < 4; ++e) { Tc[e] = (rg * 4 + e == col) ? 1.f : 0.f; A1[e] = 0.f; }
#define INV_STEP(l, CTRL) do { const f32x4 mb = *(const f32x4*)(MbT + (l) * 16), mk = *(const f32x4*)(MkT + (l) * 16); \
                const float tl_ = __int_as_float(__builtin_amdgcn_update_dpp(0, __float_as_int(Tc[(l) & 3]), CTRL, 0xF, 0xF, true)); \
                Tc[0] -= mb[0] * tl_; Tc[1] -= mb[1] * tl_; Tc[2] -= mb[2] * tl_; Tc[3] -= mb[3] * tl_; \
                A1[0] += mk[0] * tl_; A1[1] += mk[1] * tl_; A1[2] += mk[2] * tl_; A1[3] += mk[3] * tl_; } while (0)
            INV_STEP(15, 0xFF); INV_STEP(14, 0xFF); INV_STEP(13, 0xFF); INV_STEP(12, 0xFF);
            INV_STEP(11, 0xAA); INV_STEP(10, 0xAA); INV_STEP(9, 0xAA); INV_STEP(8, 0xAA);
            INV_STEP(7, 0x55); INV_STEP(6, 0x55); INV_STEP(5, 0x55); INV_STEP(4, 0x55);
            INV_STEP(3, 0x00); INV_STEP(2, 0x00); INV_STEP(1, 0x00);
#undef INV_STEP
            u32x4 o; o.x = pk2(Tc[0], Tc[1]); o.y = pk2(Tc[2], Tc[3]); o.z = pk2(A1[0], A1[1]); o.w = pk2(A1[2], A1[3]);
            *(u32x4*)(TA + (cn * 16 + col) * 40 + rg * 8) = o; }
        else { const int cn = w - 4, j = lane & 15, ig = lane >> 4;
            const f32x4 nb = *(const f32x4*)(MM + (cn * 4 + 2) * 256 + j * 16 + ig * 4), nk = *(const f32x4*)(MM + (cn * 4 + 3) * 256 + j * 16 + ig * 4);
            u32x4 o; o.x = pk2(-nb[0], -nb[1]); o.y = pk2(-nb[2], -nb[3]); o.z = pk2(nk[0], nk[1]); o.w = pk2(nk[2], nk[3]);
            *(u32x4*)(NA + (cn * 16 + j) * 40 + ig * 8) = o; }
        lds_barrier();
        if (w < 4 || sample) {
            const int vb = w & 3;
            const int t0s = z ? (seqT - 1 - (qbase + tb)) : (qbase + tb);
            const long tstep = z ? -1024 : 1024;
            bf16_t* obase = (w < 4) ? OD + ((size_t)z * NTOK + tok0 + t0s) * 1024 + hd * 64 + vb * 16 + fq * 4 : RHO + ((size_t)z * 4096 + (tok0 - NPTOK) + t0s) * 1024 + hd * 64 + vb * 16 + fq * 4;
#pragma unroll 1
            for (int cn = 0; cn < 4; ++cn) {
                bf16x8 sb[2];
#pragma unroll
                for (int ks = 0; ks < 2; ++ks) sb[ks] = pack8h(Sacc[2 * ks][0], Sacc[2 * ks][1], Sacc[2 * ks][2], Sacc[2 * ks][3], Sacc[2 * ks + 1][0], Sacc[2 * ks + 1][1], Sacc[2 * ks + 1][2], Sacc[2 * ks + 1][3]);
                f32x4 U0 = (f32x4){0.f, 0.f, 0.f, 0.f}, O = (f32x4){0.f, 0.f, 0.f, 0.f};
#pragma unroll
                for (int ks = 0; ks < 2; ++ks) { const bf16x8 a = *(const bf16x8*)(KKH + (cn * 16 + fr) * 72 + ks * 32 + fq * 8);
                    U0 = __builtin_amdgcn_mfma_f32_16x16x32_bf16(a, sb[ks], U0, 0, 0, 0);
                    const bf16x8 ar = *(const bf16x8*)(RH + (cn * 16 + fr) * 72 + ks * 32 + fq * 8);
                    O = __builtin_amdgcn_mfma_f32_16x16x32_bf16(sb[ks], ar, O, 0, 0, 0); }
                float vf[4];
#pragma unroll
                for (int e = 0; e < 4; ++e) vf[e] = (w < 4) ? bf2f(VS[(cn * 16 + fq * 4 + e) * 64 + vb * 16 + fr]) : 0.f;
                const bf16x8 bU0 = pack8h(U0[0], U0[1], U0[2], U0[3], vf[0], vf[1], vf[2], vf[3]);
                const bf16x8 ta = *(const bf16x8*)(TA + (cn * 16 + fr) * 40 + fq * 8);
                const f32x4 U = __builtin_amdgcn_mfma_f32_16x16x32_bf16(ta, bU0, (f32x4){0.f, 0.f, 0.f, 0.f}, 0, 0, 0);
                const bf16x8 bUV = pack8h(U[0], U[1], U[2], U[3], vf[0], vf[1], vf[2], vf[3]);
                const bf16x8 na = *(const bf16x8*)(NA + (cn * 16 + fr) * 40 + fq * 8);
                O = __builtin_amdgcn_mfma_f32_16x16x32_bf16(bUV, na, O, 0, 0, 0);
#pragma unroll
                for (int jj = 0; jj < 1; ++jj) { u32x2 o2; o2.x = pk2(O[0], O[1]); o2.y = pk2(O[2], O[3]); *(u32x2*)(obase + (long)(cn * 16 + fr) * tstep) = o2; }
#pragma unroll
                for (int kt = 0; kt < 4; ++kt) { const bf16x8 kb = *(const bf16x8*)(KBm + (cn * 64 + kt * 16 + fr) * 40 + fq * 8);
                    Sacc[kt] = __builtin_amdgcn_mfma_f32_16x16x32_bf16(kb, bUV, Sacc[kt], 0, 0, 0);
                    const f32x4 pc = *(const f32x4*)(PC + cn * 64 + kt * 16 + fq * 4);
                    Sacc[kt] = Sacc[kt] * pc; }
            }
        } else {
            const int slot = (u - 512) * 4 + (tb >> 6);
            conv_pair(p, slot * 4 + ((tid - 256) >> 7) * 2, ((tid - 256) & 127) * 8);
        }
        lds_barrier();
    }
#undef WKV_LOAD_RAW
    if (!sample) { if (w < 4) { float* so = p.out + (size_t)2 * NPTOK * D + ((size_t)((b * 2 + z) * 16 + hd)) * 4096 + (size_t)(w * 16 + fr0) * 64;
#pragma unroll
        for (int kt = 0; kt < 4; ++kt)
#pragma unroll
            for (int jj = 0; jj < 4; ++jj) so[kt * 16 + fq0 * 4 + jj] = Sacc[kt][jj]; } }
    else { float* so = GH + ((size_t)u * 2 + (w >> 2)) * 4096 + (size_t)((w & 3) * 16 + fr0) * 64;
#pragma unroll
        for (int kt = 0; kt < 4; ++kt)
#pragma unroll
            for (int jj = 0; jj < 4; ++jj) so[kt * 16 + fq0 * 4 + jj] = Sacc[kt][jj]; }
    __syncthreads();
}

__device__ void wkv_fix_unit(const Params& p, int u, float* ldsf) {
    const int tid = threadIdx.x, lane = tid & 63, w = __builtin_amdgcn_readfirstlane(tid >> 6), fr = lane & 15, fq = lane >> 4;
    unsigned char* ws = p.ws;
    bf16_t* OD = (bf16_t*)(ws + WS_X1);
    const bf16_t* RHO = (const bf16_t*)(ws + WS_H);
    const float* GH = (const float*)(ws + WS_BT0);
    const int z = u >> 7, b = (u >> 6) & 1, hd = (u >> 2) & 15, vq = u & 3;
    float* SS = ldsf;
    float* GL = ldsf + 1024;
    bf16_t* SB = (bf16_t*)(ldsf + 1024 + 4096);
    const int v = tid >> 5, kp = (tid & 31) * 2;
    { const float* s0 = p.in[2] + ((size_t)((b * 2 + z) * 16 + hd)) * 4096 + (size_t)(vq * 16 + v) * 64 + kp; SS[v * 64 + kp] = s0[0]; SS[v * 64 + kp + 1] = s0[1]; }
    __syncthreads();
#pragma unroll 1
    for (int sg = 0; sg < 8; ++sg) {
        const int su = ((z * 2 + b) * 16 + hd) * 8 + sg;
        SB[v * 72 + kp] = f2bf_hw(SS[v * 64 + kp]); SB[v * 72 + kp + 1] = f2bf_hw(SS[v * 64 + kp + 1]);
        if (sg < 7) { const f32x4* gsrc = (const f32x4*)(GH + ((size_t)su * 2 + 1) * 4096);
#pragma unroll
            for (int q = 0; q < 2; ++q) ((f32x4*)GL)[tid + q * NTHR] = gsrc[tid + q * NTHR]; }
        __syncthreads();
        const int tlo = z ? (2048 - (sg + 1) * 256) : sg * 256;
#pragma unroll
        for (int q = 0; q < 2; ++q) { const int mt = 2 * w + q;
            f32x4 acc = (f32x4){0.f, 0.f, 0.f, 0.f};
#pragma unroll
            for (int ks = 0; ks < 2; ++ks) { const bf16x8 a = *(const bf16x8*)(RHO + ((size_t)z * 4096 + b * 2048 + tlo + mt * 16 + fr) * 1024 + hd * 64 + ks * 32 + fq * 8);
                const bf16x8 bb = *(const bf16x8*)(SB + fr * 72 + ks * 32 + fq * 8);
                acc = __builtin_amdgcn_mfma_f32_16x16x32_bf16(bb, a, acc, 0, 0, 0); }
            { u32x2* op = (u32x2*)(OD + ((size_t)z * NTOK + NPTOK + b * 2048 + tlo + mt * 16 + fr) * 1024 + hd * 64 + vq * 16 + fq * 4);
              const u32x2 old = *op; u32x2 nw; nw.x = pk2(bflo(old.x) + acc[0], bfhi(old.x) + acc[1]); nw.y = pk2(bflo(old.y) + acc[2], bfhi(old.y) + acc[3]); *op = nw; } }
        if (sg < 7) {
            const float* hsrc = GH + ((size_t)su * 2 + 0) * 4096 + (size_t)(vq * 16 + v) * 64 + kp;
            float a0 = hsrc[0], a1 = hsrc[1];
#pragma unroll 8
            for (int k2 = 0; k2 < 64; ++k2) { const float sv = SS[v * 64 + k2]; a0 += sv * GL[k2 * 64 + kp]; a1 += sv * GL[k2 * 64 + kp + 1]; }
            __syncthreads();
            SS[v * 64 + kp] = a0; SS[v * 64 + kp + 1] = a1;
        }
        __syncthreads();
    }
}
__device__ void phase_wkv_fix(const Params& p, float* lds) {
    for (int it = blockIdx.x; it < 256; it += gridDim.x) wkv_fix_unit(p, it, lds);
}

__device__ void conv_tile(const Params& p, int tile) {
    const int tid = threadIdx.x;
    unsigned char* ws = p.ws;
    const bf16_t* P = (const bf16_t*)(ws + WS_P);
    bf16_t* OC = (bf16_t*)(ws + WS_OC);
    const int cgp = tid & 127, c0 = cgp * 8, sub = tid >> 7;
    float cw0[8], cw1[8], cw2[8];
#pragma unroll
    for (int j = 0; j < 8; ++j) { cw0[j] = p.in[12][c0 + j]; cw1[j] = p.in[12][1024 + c0 + j]; cw2[j] = p.in[12][2048 + c0 + j]; }
    for (int jj = 0; jj < 4; ++jj) {
        const int t = tile * 16 + sub + 4 * jj;
        const int rl = t < NPTOK ? 256 : 64; const int pos = t & (rl - 1);
        const bf16_t* row = P + (size_t)t * N0;
        const u32x4 z4 = (u32x4){0u, 0u, 0u, 0u};
        const u32x4 u1 = *(const u32x4*)(row + c0), g1 = *(const u32x4*)(row + 2048 + c0);
        const u32x4 u0 = pos > 0 ? *(const u32x4*)(row - N0 + c0) : z4, g0 = pos > 0 ? *(const u32x4*)(row - N0 + 2048 + c0) : z4;
        const u32x4 u2 = pos < rl - 1 ? *(const u32x4*)(row + N0 + c0) : z4, g2 = pos < rl - 1 ? *(const u32x4*)(row + N0 + 2048 + c0) : z4;
        const u32x4 gb = *(const u32x4*)(row + 1024 + c0), zc = *(const u32x4*)(row + 3072 + c0);
        u32x4 o;
#pragma unroll
        for (int q = 0; q < 4; ++q) {
            const float y0 = cw0[2 * q] * (bflo(g0[q]) * bflo(u0[q])) + cw1[2 * q] * (bflo(g1[q]) * bflo(u1[q])) + cw2[2 * q] * (bflo(g2[q]) * bflo(u2[q]));
            const float y1 = cw0[2 * q + 1] * (bfhi(g0[q]) * bfhi(u0[q])) + cw1[2 * q + 1] * (bfhi(g1[q]) * bfhi(u1[q])) + cw2[2 * q + 1] * (bfhi(g2[q]) * bfhi(u2[q]));
            o[q] = pack2(silu(bflo(zc[q])) * bflo(gb[q]) * y0, silu(bfhi(zc[q])) * bfhi(gb[q]) * y1);
        }
        *(u32x4*)(OC + (size_t)t * 2048 + c0) = o;
    }
}

__device__ void phase_mix0(const Params& p, float* lds, int rep) {
    (void)rep;
    constexpr int NSCAN = 1024;
    for (int it = blockIdx.x; it < NSCAN; it += gridDim.x) wkv_unit(p, it, lds);
}

__device__ __forceinline__ float quad_sum(float v) {
    v += __int_as_float(__builtin_amdgcn_update_dpp(0, __float_as_int(v), 0xB1, 0xF, 0xF, true));
    v += __int_as_float(__builtin_amdgcn_update_dpp(0, __float_as_int(v), 0x4E, 0xF, 0xF, true));
    return v;
}
__device__ void phase_wkv_post(const Params& p) {
    const int tid = threadIdx.x, wave = tid >> 6, lane = tid & 63;
    unsigned char* ws = p.ws;
    const bf16_t* P = (const bf16_t*)(ws + WS_P);
    const bf16_t* OD = (const bf16_t*)(ws + WS_X1);
    const float* BON = (const float*)(ws + WS_BON);
    bf16_t* OC = (bf16_t*)(ws + WS_OC);
    const int hh = lane >> 2, ch0 = hh * 64 + (lane & 3) * 16;
    for (int tok = blockIdx.x * 8 + wave; tok < NTOK; tok += gridDim.x * 8) {
        const bf16_t* row = P + (size_t)tok * N0;
        u32x4 a0[2], a1[2], vv[2], zz[2];
#pragma unroll
        for (int h = 0; h < 2; ++h) { a0[h] = *(const u32x4*)(OD + (size_t)tok * 1024 + ch0 + h * 8); a1[h] = *(const u32x4*)(OD + ((size_t)NTOK + tok) * 1024 + ch0 + h * 8);
            vv[h] = *(const u32x4*)(row + 6144 + ch0 + h * 8); zz[h] = *(const u32x4*)(row + 7168 + ch0 + h * 8); }
        const float bon = BON[(size_t)tok * 16 + hh] + BON[((size_t)NTOK + tok) * 16 + hh];
        float o[16]; float s1 = 0.f;
#pragma unroll
        for (int h = 0; h < 2; ++h)
#pragma unroll
            for (int q = 0; q < 4; ++q) { o[h * 8 + 2 * q] = bflo(a0[h][q]) + bflo(a1[h][q]); o[h * 8 + 2 * q + 1] = bfhi(a0[h][q]) + bfhi(a1[h][q]); s1 += o[h * 8 + 2 * q] + o[h * 8 + 2 * q + 1]; }
        const float mu = quad_sum(s1) * (1.f / 64.f);
        float s2 = 0.f;
#pragma unroll
        for (int i = 0; i < 16; ++i) { o[i] -= mu; s2 += o[i] * o[i]; }
        const float rs = rsqrtf(quad_sum(s2) * (1.f / 64.f) + 64e-5f);
        float res[16];
#pragma unroll
        for (int g4 = 0; g4 < 4; ++g4) { const f32x4 lw4 = *(const f32x4*)(p.in[22] + ch0 + g4 * 4), lb4 = *(const f32x4*)(p.in[23] + ch0 + g4 * 4);
#pragma unroll
            for (int e = 0; e < 4; ++e) { const int i = g4 * 4 + e; const unsigned vw = vv[i >> 3][(i & 7) >> 1], zw_ = zz[i >> 3][(i & 7) >> 1];
                const float v1 = (i & 1) ? bfhi(vw) : bflo(vw), z1 = (i & 1) ? bfhi(zw_) : bflo(zw_);
                res[i] = (o[i] * rs * lw4[e] + lb4[e] + bon * v1) * silu(z1); } }
#pragma unroll
        for (int h = 0; h < 2; ++h) { u32x4 w4; w4.x = pk2(res[h * 8 + 0], res[h * 8 + 1]); w4.y = pk2(res[h * 8 + 2], res[h * 8 + 3]); w4.z = pk2(res[h * 8 + 4], res[h * 8 + 5]); w4.w = pk2(res[h * 8 + 6], res[h * 8 + 7]);
            *(u32x4*)(OC + (size_t)tok * 2048 + 1024 + ch0 + h * 8) = w4; }
    }
}

constexpr size_t WS_QE = WS_H;
constexpr size_t WS_KDT = WS_BT0;
constexpr size_t WS_VT = WS_OC + (size_t)NTOK * 1024 * 2;
constexpr size_t WS_EBL = WS_BON + (size_t)2 * NTOK * 16 * 4;
constexpr size_t WS_ATT = WS_P + 52 * MB;

__device__ void gla_a_item(const Params& p, int item, float* ldsf) {
    const int tid = threadIdx.x, lane = tid & 63, w = __builtin_amdgcn_readfirstlane(tid >> 6), fr = lane & 15, fq = lane >> 4;
    unsigned char* ws = p.ws;
    const bf16_t* P1 = (const bf16_t*)(ws + WS_P);
    float* OD = (float*)(ws + WS_P2);
    bf16_t* QEg = (bf16_t*)(ws + WS_QE); bf16_t* KDTg = (bf16_t*)(ws + WS_KDT); bf16_t* VTg = (bf16_t*)(ws + WS_VT); float* EBLg = (float*)(ws + WS_EBL);
    const int hd = item & 3, c = (item >> 2) & 127, z = item >> 9, tok0 = c * 64;
    bf16_t* QE = (bf16_t*)ldsf;
    bf16_t* KE = QE + 64 * 136;
    bf16_t* VT = KE + 64 * 136;
    bf16_t* ATT = VT + 256 * 72;
    float* G = (float*)(ATT + 64 * 72);
    float* L1G = G + 64 * 132;
    float* GK2 = L1G + 1024;
    for (int i = tid; i < 1024; i += NTHR) { const int t = i >> 4, r = i & 15; L1G[i] = bf2f(P1[(size_t)(tok0 + t) * N1 + 3072 + z * 16 + r]); }
    for (int i = tid; i < 2048; i += NTHR) { const int r = i >> 7, d = i & 127; GK2[i] = p.in[27][(size_t)(z * 16 + r) * 512 + hd * 128 + d]; }
#pragma unroll
    for (int ps = 0; ps < 4; ++ps) { const int t = lane, e8 = (ps * 8 + w) * 8;
        const u32x4 v8 = *(const u32x4*)(P1 + (size_t)(tok0 + t) * N1 + 1024 + hd * 256 + e8);
        VT[(e8 + 0) * 72 + t] = (bf16_t)(v8.x & 0xFFFF); VT[(e8 + 1) * 72 + t] = (bf16_t)(v8.x >> 16); VT[(e8 + 2) * 72 + t] = (bf16_t)(v8.y & 0xFFFF); VT[(e8 + 3) * 72 + t] = (bf16_t)(v8.y >> 16);
        VT[(e8 + 4) * 72 + t] = (bf16_t)(v8.z & 0xFFFF); VT[(e8 + 5) * 72 + t] = (bf16_t)(v8.z >> 16); VT[(e8 + 6) * 72 + t] = (bf16_t)(v8.w & 0xFFFF); VT[(e8 + 7) * 72 + t] = (bf16_t)(v8.w >> 16); }
    const int d = tid & 127, tq = tid >> 7;
    const float gbias = p.in[28][z * 512 + hd * 128 + d];
    bf16_t qraw[16], kraw[16];
#pragma unroll
    for (int i = 0; i < 16; ++i) { const size_t row = (size_t)(tok0 + tq * 16 + i) * N1; qraw[i] = P1[row + hd * 128 + d]; kraw[i] = P1[row + 512 + hd * 128 + d]; }
    __syncthreads();
    { float run = 0.f;
#pragma unroll 4
      for (int i = 0; i < 16; ++i) { const int t = z ? (tq * 16 + 15 - i) : (tq * 16 + i);
        float x = gbias;
#pragma unroll
        for (int r = 0; r < 16; ++r) x += L1G[t * 16 + r] * GK2[r * 128 + d];
        const float ls = fminf(x, 0.f) - flog(1.f + fexp(-fabsf(x)));
        run += ls * (1.f / 16.f);
        G[t * 132 + d] = run; } }
    __syncthreads();
    { const int lastr = z ? 0 : 15;
      const float t0 = G[(0 + lastr) * 132 + d], t1 = G[(16 + lastr) * 132 + d], t2 = G[(32 + lastr) * 132 + d], t3 = G[(48 + lastr) * 132 + d];
      const float blast = t0 + t1 + t2 + t3;
      float off;
      if (z == 0) off = tq == 0 ? 0.f : (tq == 1 ? t0 : (tq == 2 ? t0 + t1 : t0 + t1 + t2));
      else off = tq == 3 ? 0.f : (tq == 2 ? t3 : (tq == 1 ? t3 + t2 : t3 + t2 + t1));
      if (tq == 0) EBLg[(size_t)(z * 128 + c) * 512 + hd * 128 + d] = fexp(blast);
      unsigned kdp[8];
#pragma unroll
      for (int i = 0; i < 16; ++i) { const int t = tq * 16 + i;
        const float bc = G[t * 132 + d] + off;
        const float q = bf2f(qraw[i]) * 0.08838834764831845f, k = bf2f(kraw[i]);
        const bf16_t qe = f2bf(q * fexp(bc));
        QE[t * 136 + d] = qe; KE[t * 136 + d] = f2bf(k * fexp(-bc));
        const unsigned kd = (unsigned)f2bf(k * fexp(blast - bc));
        if (i & 1) kdp[i >> 1] |= kd << 16; else kdp[i >> 1] = kd; }
      bf16_t* kdst = KDTg + ((size_t)(((z * 128 + c) * 4 + hd) * 128 + d)) * 64 + tq * 16;
      *(u32x4*)kdst = (u32x4){kdp[0], kdp[1], kdp[2], kdp[3]}; *(u32x4*)(kdst + 8) = (u32x4){kdp[4], kdp[5], kdp[6], kdp[7]}; }
    __syncthreads();
#pragma unroll
    for (int q2 = 0; q2 < 2; ++q2) { const int idx = q2 * NTHR + tid; const int t = idx >> 4, d8 = (idx & 15) * 8;
        *(u32x4*)(QEg + ((size_t)z * NTOK + tok0 + t) * 512 + hd * 128 + d8) = *(const u32x4*)(QE + t * 136 + d8); }
    if (z == 0) {
#pragma unroll
        for (int q4 = 0; q4 < 4; ++q4) { const int idx = q4 * NTHR + tid; const int e = idx >> 3, t8 = (idx & 7) * 8;
            *(u32x4*)(VTg + ((size_t)((c * 4 + hd) * 256 + e)) * 64 + t8) = *(const u32x4*)(VT + e * 72 + t8); } }
#pragma unroll
    for (int q2 = 0; q2 < 2; ++q2) { const int tA = 2 * w + q2, ia = tA >> 2, ja = tA & 3;
        f32x4 a4 = (f32x4){0.f, 0.f, 0.f, 0.f};
        if (z ? (ja >= ia) : (ja <= ia)) a4 = mma_nt(QE + ia * 16 * 136, 136, KE + ja * 16 * 136, 136, 128, a4, fr, fq);
#pragma unroll
        for (int jj = 0; jj < 4; ++jj) { const int i = ia * 16 + fq * 4 + jj, j = ja * 16 + fr; const bool keep = z ? (j >= i) : (j <= i); ATT[i * 72 + j] = f2bf(keep ? a4[jj] : 0.f); } }
    __syncthreads();
    { bf16_t* ATTg = (bf16_t*)(ws + WS_ATT) + ((size_t)((z * 128 + c) * 4 + hd)) * 4096;
      const int i = tid >> 3, j8 = (tid & 7) * 8;
      *(u32x4*)(ATTg + i * 64 + j8) = *(const u32x4*)(ATT + i * 72 + j8); }
    __syncthreads();
}

__device__ void phase_gla_a(const Params& p, float* lds) {
    for (int it = blockIdx.x; it < 1024; it += gridDim.x) gla_a_item(p, it, lds);
}

struct GlaFrags { bf16x8 kdt[2]; u32x4 vts; u32x4 qes[2]; bf16x8 att[2]; f32x4 ebl; };

template <int NE>
__device__ __forceinline__ void gla_b_unit_t(const Params& p, int z, int b, int hd, int e0, int nch, int ch0, bool sample, float* ldsf) {
    const int tid = threadIdx.x, lane = tid & 63, w = __builtin_amdgcn_readfirstlane(tid >> 6), fr = lane & 15, fq = lane >> 4;
    unsigned char* ws = p.ws;
    bf16_t* OD = (bf16_t*)(ws + WS_P2);
    const bf16_t* QEg = (const bf16_t*)(ws + WS_QE); const bf16_t* KDTg = (const bf16_t*)(ws + WS_KDT); const bf16_t* VTg = (const bf16_t*)(ws + WS_VT); const float* EBLg = (const float*)(ws + WS_EBL);
    const bf16_t* ATTg = (const bf16_t*)(ws + WS_ATT);
    constexpr int NQ = NE / 2;
    bf16_t* ST = (bf16_t*)ldsf;
    bf16_t* VTL = ST + 2 * 64 * 136;
    bf16_t* QEL = VTL + 2 * 64 * 72;
    f32x4 Sacc[NE];
    if (sample) { const float* s0 = p.in[3] + ((size_t)((b * 2 + z) * 4 + hd)) * 32768 + e0 + fr;
#pragma unroll
        for (int et = 0; et < NE; ++et)
#pragma unroll
            for (int jj = 0; jj < 4; ++jj) Sacc[et][jj] = s0[(size_t)(w * 16 + fq * 4 + jj) * 256 + et * 16]; }
    else {
#pragma unroll
        for (int et = 0; et < NE; ++et) Sacc[et] = (f32x4){0.f, 0.f, 0.f, 0.f}; }
    const int it = w >> 1, e2 = (w & 1) * NQ;
    const int ve = tid >> 3, vt8 = (tid & 7) * 8;
#define GLB_LOAD(F, c_) do { const int cc_ = (c_); \
        _Pragma("unroll") for (int ks = 0; ks < 2; ++ks) { (F).kdt[ks] = *(const bf16x8*)(KDTg + ((size_t)(((z * 128 + cc_) * 4 + hd) * 128 + w * 16 + fr)) * 64 + ks * 32 + fq * 8); \
            (F).att[ks] = *(const bf16x8*)(ATTg + ((size_t)((z * 128 + cc_) * 4 + hd)) * 4096 + (it * 16 + fr) * 64 + ks * 32 + fq * 8); } \
        if (ve < NE * 16) (F).vts = *(const u32x4*)(VTg + ((size_t)((cc_ * 4 + hd) * 256 + e0 + ve)) * 64 + vt8); \
        _Pragma("unroll") for (int h_ = 0; h_ < 2; ++h_) (F).qes[h_] = *(const u32x4*)(QEg + ((size_t)z * NTOK + cc_ * 64 + ve) * 512 + hd * 128 + h_ * 64 + vt8); \
        (F).ebl = *(const f32x4*)(EBLg + (size_t)(z * 128 + cc_) * 512 + hd * 128 + w * 16 + fq * 4); } while (0)
#define GLB_STEP(CUR, NX2, ci_) do { const int ci = (ci_); if (ci < nch) { \
        const int c = ch0 + (z ? nch - 1 - ci : ci); \
        bf16_t* STc = ST + (ci & 1) * 64 * 136; bf16_t* VTc = VTL + (ci & 1) * 64 * 72; \
        _Pragma("unroll") for (int et = 0; et < NE; ++et) { u32x2 v2; v2.x = pk2(Sacc[et][0], Sacc[et][1]); v2.y = pk2(Sacc[et][2], Sacc[et][3]); \
            *(u32x2*)(STc + (et * 16 + fr) * 136 + w * 16 + fq * 4) = v2; } \
        if (ve < NE * 16) *(u32x4*)(VTc + ve * 72 + vt8) = (CUR).vts; \
        bf16_t* QEc = QEL + (ci & 1) * 64 * 136; \
        *(u32x4*)(QEc + ve * 136 + vt8) = (CUR).qes[0]; *(u32x4*)(QEc + ve * 136 + 64 + vt8) = (CUR).qes[1]; \
        if (ci + 2 < nch) GLB_LOAD(NX2, ch0 + (z ? nch - 3 - ci : ci + 2)); \
        lds_barrier(); \
        _Pragma("unroll") for (int et = 0; et < NE; ++et) { Sacc[et] = Sacc[et] * (CUR).ebl; \
            _Pragma("unroll") for (int ks = 0; ks < 2; ++ks) { const bf16x8 vf = *(const bf16x8*)(VTc + (et * 16 + fr) * 72 + ks * 32 + fq * 8); \
                Sacc[et] = __builtin_amdgcn_mfma_f32_16x16x32_bf16((CUR).kdt[ks], vf, Sacc[et], 0, 0, 0); } } \
        _Pragma("unroll") for (int q2 = 0; q2 < NQ; ++q2) { f32x4 o = (f32x4){0.f, 0.f, 0.f, 0.f}; \
            _Pragma("unroll") for (int ks = 0; ks < 2; ++ks) { const bf16x8 vf = *(const bf16x8*)(VTc + ((e2 + q2) * 16 + fr) * 72 + ks * 32 + fq * 8); \
                o = __builtin_amdgcn_mfma_f32_16x16x32_bf16(vf, (CUR).att[ks], o, 0, 0, 0); } \
            _Pragma("unroll") for (int ks = 0; ks < 4; ++ks) { const bf16x8 bS = *(const bf16x8*)(STc + ((e2 + q2) * 16 + fr) * 136 + ks * 32 + fq * 8); \
                const bf16x8 aq = *(const bf16x8*)(QEc + (it * 16 + fr) * 136 + ks * 32 + fq * 8); \
                o = __builtin_amdgcn_mfma_f32_16x16x32_bf16(bS, aq, o, 0, 0, 0); } \
            { u32x2 o2; o2.x = pk2(o[0], o[1]); o2.y = pk2(o[2], o[3]);        \
              *(u32x2*)(OD + ((size_t)z * NTOK + c * 64 + it * 16 + fr) * 1024 + hd * 256 + e0 + (e2 + q2) * 16 + fq * 4) = o2; } } } } while (0)
    GlaFrags fa, fb, fc; fa.vts = fb.vts = fc.vts = (u32x4){0u, 0u, 0u, 0u};
    GLB_LOAD(fa, ch0 + (z ? nch - 1 : 0));
    GLB_LOAD(fb, ch0 + (z ? nch - 2 : 1));
    __syncthreads();
#pragma unroll 1
    for (int ci3 = 0; ci3 < nch; ci3 += 3) { GLB_STEP(fa, fc, ci3); GLB_STEP(fb, fa, ci3 + 1); GLB_STEP(fc, fb, ci3 + 2); }
#undef GLB_STEP
#undef GLB_LOAD
    if (!sample) { float* so = p.out + (size_t)2 * NPTOK * D + 2097152 + ((size_t)((b * 2 + z) * 4 + hd)) * 32768 + e0 + fr;
#pragma unroll
        for (int et = 0; et < NE; ++et)
#pragma unroll
            for (int jj = 0; jj < 4; ++jj) so[(size_t)(w * 16 + fq * 4 + jj) * 256 + et * 16] = Sacc[et][jj]; }
    __syncthreads();
}

__device__ void gla_b_unit(const Params& p, int u, float* ldsf) {
    if (u < 128) gla_b_unit_t<2>(p, u >> 6, (u >> 5) & 1, (u >> 3) & 3, (u & 7) * 32, 32, 64 + ((u >> 5) & 1) * 32, true, ldsf);
    else { const int q = u - 128; gla_b_unit_t<4>(p, q >> 8, (q >> 4) & 15, (q >> 2) & 3, (q & 3) * 64, 4, ((q >> 4) & 15) * 4, false, ldsf); }
}

__device__ void phase_gla_b(const Params& p, float* lds, int rep) {
    unsigned* ctr = (unsigned*)(p.ws + WS_CTL) + 16 + rep * 32;
    int* slot = (int*)(lds + LDS_MAIN / 4);
    for (;;) {
        if (threadIdx.x == 0) *slot = (int)atomicAdd(ctr, 1u);
        __syncthreads();
        const int it = *slot;
        __syncthreads();
        if (it >= 640) break;
        gla_b_unit(p, it, lds);
    }
}

__device__ void phase_gla_post(const Params& p) {
    const int tid = threadIdx.x, wave = tid >> 6, lane = tid & 63;
    unsigned char* ws = p.ws;
    const bf16_t* P1 = (const bf16_t*)(ws + WS_P);
    const bf16_t* OD = (const bf16_t*)(ws + WS_P2);
    bf16_t* OG = (bf16_t*)(ws + WS_OC);
    for (int tok = blockIdx.x * 8 + wave; tok < NTOK; tok += gridDim.x * 8) {
        for (int hd = 0; hd < 4; ++hd) { const int idx = hd * 256 + lane * 4;
            const u32x2 pa = *(const u32x2*)(OD + (size_t)tok * 1024 + idx), pb = *(const u32x2*)(OD + ((size_t)NTOK + tok) * 1024 + idx);
            const f32x4 o = (f32x4){bflo(pa.x) + bflo(pb.x), bfhi(pa.x) + bfhi(pb.x), bflo(pa.y) + bflo(pb.y), bfhi(pa.y) + bfhi(pb.y)};
            const float ss = wave_sum(o[0] * o[0] + o[1] * o[1] + o[2] * o[2] + o[3] * o[3]);
            const float rs = rsqrtf(ss * (1.f / 256.f) + 1e-6f);
            const f32x4 gn = *(const f32x4*)(p.in[29] + lane * 4);
            const u32x2 zz = *(const u32x2*)(P1 + (size_t)tok * N1 + 2048 + idx);
            const float z0 = bflo(zz.x), z1 = bfhi(zz.x), z2 = bflo(zz.y), z3 = bfhi(zz.y);
            u32x2 w; w.x = pack2(o[0] * rs * gn[0] * silu(z0), o[1] * rs * gn[1] * silu(z1)); w.y = pack2(o[2] * rs * gn[2] * silu(z2), o[3] * rs * gn[3] * silu(z3));
            *(u32x2*)(OG + (size_t)tok * 1024 + idx) = w; }
    }
}

__device__ void phase_final(const Params& p) {
    const int tid = threadIdx.x, wave = tid >> 6, lane = tid & 63;
    unsigned char* ws = p.ws;
    const float* MOD = (const float*)(ws + WS_MOD);
    const float* X1 = (const float*)(ws + WS_X1);
    const bf16_t* Y = (const bf16_t*)(ws + WS_P2);
    for (int tok = blockIdx.x * 8 + wave; tok < NTOK; tok += gridDim.x * 8) {
        const int cond = tok < NPTOK ? 0 : 1 + ((tok - NPTOK) >> 11);
        f32x4 xv[4]; float ss = 0.f;
#pragma unroll
        for (int i = 0; i < 4; ++i) { const int idx = i * 256 + lane * 4;
            const f32x4 x1 = *(const f32x4*)(X1 + (size_t)tok * D + idx);
            const u32x2 pa = *(const u32x2*)(Y + (size_t)tok * D + idx), pb = *(const u32x2*)(Y + (size_t)NTOK * D + (size_t)tok * D + idx);
            const f32x4 ya = (f32x4){bflo(pa.x), bfhi(pa.x), bflo(pa.y), bfhi(pa.y)}, yb = (f32x4){bflo(pb.x), bfhi(pb.x), bflo(pb.y), bfhi(pb.y)};
            const f32x4 gt = *(const f32x4*)(MOD + (1 * 3 + cond) * 3072 + 2048 + idx);
            xv[i] = x1 + gt * (ya + yb);
            ss += xv[i][0] * xv[i][0] + xv[i][1] * xv[i][1] + xv[i][2] * xv[i][2] + xv[i][3] * xv[i][3]; }
        ss = wave_sum(ss);
        const float rstd = rsqrtf(ss * (1.f / 1024.f) + 1e-6f);
#pragma unroll
        for (int i = 0; i < 4; ++i) { const int idx = i * 256 + lane * 4;
            const f32x4 g = *(const f32x4*)(p.in[9] + idx);
            f32x4 o;
#pragma unroll
            for (int j = 0; j < 4; ++j) o[j] = xv[i][j] * rstd * g[j];
            *(f32x4*)(p.out + (size_t)tok * D + idx) = o; }
    }
}


#define XB_TMO      128
#define XB_XCNT(j)  (256  + 64 * (j))
#define XB_XSUB(j)  (1280 + 64 * (j))
#define XB_XGEN(j)  (2304 + 64 * (j))
#define XB_TOP      3328
#define XB_TOPGEN   3392
#define XCD_BAR_WORDS 3456
#define XB_SPIN_CAP (1u << 18)

__device__ __forceinline__ unsigned xb_ld(unsigned* p)              { return __hip_atomic_load(p, __ATOMIC_RELAXED, __HIP_MEMORY_SCOPE_AGENT); }
__device__ __forceinline__ unsigned xb_add(unsigned* p, unsigned v) { return __hip_atomic_fetch_add(p, v, __ATOMIC_RELAXED, __HIP_MEMORY_SCOPE_AGENT); }
__device__ __forceinline__ unsigned xb_xcc_id() { return (unsigned)__builtin_amdgcn_s_getreg((3 << 11) | 20) & 0xFu; }
#define XB_SPIN(cond, bar) do { unsigned _sp = 0; while (cond) { __builtin_amdgcn_s_sleep(1); \
    if ((++_sp & 255u) == 0u) { if (xb_ld(&(bar)[XB_TMO])) break; if (_sp > XB_SPIN_CAP) { atomicAdd(&(bar)[XB_TMO], 1u); break; } } } } while (0)

struct XcdBarrier {
    unsigned* bar; unsigned x;
    volatile LAS unsigned* st;
};

__device__ __forceinline__ XcdBarrier xcd_barrier_post(unsigned* bar, volatile LAS unsigned* st) {
    XcdBarrier b; b.bar = bar; b.x = xb_xcc_id(); b.st = st;
    if (threadIdx.x == 0) (void)xb_add(&bar[XB_XCNT(b.x)], 1u);
    return b;
}
__device__ __forceinline__ void xcd_barrier_complete(unsigned* bar, unsigned x, unsigned& nloc, unsigned& nx) {
    const unsigned G = gridDim.x * gridDim.y * gridDim.z;
    unsigned sum, cnt, mine, sp = 0u;
    for (;;) {
        sum = 0u; cnt = 0u; mine = 0u;
#pragma unroll
        for (unsigned j = 0; j < 16; ++j) { const unsigned c = xb_ld(&bar[XB_XCNT(j)]); sum += c; cnt += (c > 0u) ? 1u : 0u; mine = (j == x) ? c : mine; }
        if (sum == G) break;
        __builtin_amdgcn_s_sleep(1);
        if ((++sp & 255u) == 0u) { if (xb_ld(&bar[XB_TMO])) break; if (sp > XB_SPIN_CAP) { atomicAdd(&bar[XB_TMO], 1u); break; } }
    }
    nloc = mine > 0u ? mine : 1u; nx = cnt > 0u ? cnt : 1u;
}

__device__ __forceinline__ void xcd_barrier(const XcdBarrier& b) {
    asm volatile("s_waitcnt vmcnt(0)" ::: "memory");
    __syncthreads();
    if (threadIdx.x == 0) {
        unsigned* bar = b.bar;
        __builtin_amdgcn_s_waitcnt(0);
        unsigned nloc = b.st[0], nx = b.st[1];
        if (nloc == 0u) { xcd_barrier_complete(bar, b.x, nloc, nx); b.st[0] = nloc; b.st[1] = nx; }
        const unsigned old = xb_add(&bar[XB_XSUB(b.x)], 1u);
        const unsigned gen = old / nloc;
        if (old + 1u == (gen + 1u) * nloc) {
            __builtin_amdgcn_fence(__ATOMIC_RELEASE, "agent");
            asm volatile("s_waitcnt vmcnt(0)" ::: "memory");
            const unsigned og = xb_add(&bar[XB_TOP], 1u);
            const unsigned tg = og / nx;
            if (og + 1u == (tg + 1u) * nx) xb_add(&bar[XB_TOPGEN], 1u);
            else XB_SPIN(xb_ld(&bar[XB_TOPGEN]) == tg, bar);
            __builtin_amdgcn_fence(__ATOMIC_ACQUIRE, "agent");
            xb_add(&bar[XB_XGEN(b.x)], 1u);
            asm volatile("s_waitcnt vmcnt(0)" ::: "memory");
        } else {
            XB_SPIN(xb_ld(&bar[XB_XGEN(b.x)]) == gen, bar);
            __builtin_amdgcn_fence(__ATOMIC_ACQUIRE, "agent");
            asm volatile("s_waitcnt vmcnt(0)" ::: "memory");
        }
    }
    __syncthreads();
}


constexpr int NPHASE = 14;
__global__ void __launch_bounds__(NTHR, 2) fwd_megakernel(Params p) {
    extern __shared__ __attribute__((aligned(16))) unsigned char smem[];
    float* ldsf = (float*)smem;
    LAS unsigned char* ldsl = (LAS unsigned char*)smem;
    unsigned char* ws = p.ws;
    volatile LAS unsigned* xst = (volatile LAS unsigned*)(ldsl + LDS_MAIN + 16);
    if (threadIdx.x == 0) { xst[0] = 0u; xst[1] = 0u; }
    __syncthreads();
    const XcdBarrier xbar = xcd_barrier_post((unsigned*)(ws + WS_BAR), xst);
    if (p.ph_lo < 0) cg::this_grid().sync();
#ifndef DUP_PHASE
#define DUP_PHASE -1
#endif
#define PHASE(n) if (p.ph_lo <= (n) && (n) < p.ph_hi && ((n) == p.ph_lo || (xcd_barrier(xbar), true))) for (int rep = 0; rep < ((n) == DUP_PHASE ? 2 : 1); ++rep, ((n) == DUP_PHASE ? (xcd_barrier(xbar), 0) : 0))
    PHASE(0) phase_prologue(p, ldsf);
    PHASE(1) phase_h(p, 0, ldsf);
    PHASE(2) { pg8::Gemm g{(const bf16_t*)(ws + WS_H), (const bf16_t*)(ws + WS_BT0), NTOK, 8192, 1024, 1024, 1}; pg8::Order S; S.init(NTOK, 8192, 1, gridDim.x, blockIdx.x);
               pg8::EpiBf16 E{(bf16_t*)(ws + WS_P), N0, 0}; pg8::gemm_phase(ldsl, g, S, E); }
    PHASE(3) phase_mix0(p, ldsf, rep);
    PHASE(4) { phase_wkv_fix(p, ldsf); phase_late_weights(p, ldsf); }
    PHASE(5) phase_wkv_post(p);
    PHASE(6) { pg8::Gemm g{(const bf16_t*)(ws + WS_OC), (const bf16_t*)(ws + WS_WT0O), NTOK, 1024, 1024, 2048, 2}; pg8::Order S; S.init(NTOK, 1024, 2, gridDim.x, blockIdx.x);
               pg8::EpiBf16 E{(bf16_t*)(ws + WS_P), 1024, (size_t)NTOK * 1024}; pg8::gemm_phase(ldsl, g, S, E); }
    PHASE(7) phase_h(p, 1, ldsf);
    PHASE(8) { pg8::Gemm g{(const bf16_t*)(ws + WS_H), (const bf16_t*)(ws + WS_BT1), NTOK, N1, 1024, 1024, 1}; pg8::Order S; S.init(NTOK, N1, 1, gridDim.x, blockIdx.x);
               pg8::EpiBf16 E{(bf16_t*)(ws + WS_P), N1, 0}; pg8::gemm_phase(ldsl, g, S, E); }
    PHASE(9) phase_gla_a(p, ldsf);
    PHASE(10) phase_gla_b(p, ldsf, rep);
    PHASE(11) phase_gla_post(p);
    PHASE(12) { pg8::Gemm g{(const bf16_t*)(ws + WS_OC), (const bf16_t*)(ws + WS_WT1O), NTOK, 1024, 512, 1024, 2}; pg8::Order S; S.init(NTOK, 1024, 2, gridDim.x, blockIdx.x);
                pg8::EpiBf16 E{(bf16_t*)(ws + WS_P2), 1024, (size_t)NTOK * 1024}; pg8::gemm_phase(ldsl, g, S, E); }
    PHASE(13) phase_final(p);
}

extern "C" void kernel_launch(void* const* d_in, const int* in_sizes, int n_in, void* d_out, int out_size, void* d_ws, size_t ws_size, hipStream_t stream) {
    static int grid = 0;
    if (grid == 0) {
        if (n_in != 30 || ws_size < WS_END) { fprintf(stderr, "kernel_launch: unexpected n_in %d / ws_size %zu (need %zu)\n", n_in, ws_size, (size_t)WS_END); grid = -1; return; }
        int dev = 0, cus = 0, per_cu = 0;
        hipGetDevice(&dev);
        hipDeviceGetAttribute(&cus, hipDeviceAttributeMultiprocessorCount, dev);
        hipFuncSetAttribute((const void*)fwd_megakernel, hipFuncAttributeMaxDynamicSharedMemorySize, LDS_BYTES);
        hipOccupancyMaxActiveBlocksPerMultiprocessor(&per_cu, (const void*)fwd_megakernel, NTHR, LDS_BYTES);
        if (per_cu < 1) { fprintf(stderr, "kernel_launch: occupancy query returned %d\n", per_cu); per_cu = 1; }
        grid = cus * per_cu;
        (void)hipGetLastError();
    }
    if (grid < 0) return;
    static_assert(XCD_BAR_WORDS * 4 <= 14336, "barrier words overlap the queue counters");
    hipMemsetAsync((char*)d_ws + WS_BAR, 0, 14336 + 256, stream);
    Params p{};
    for (int i = 0; i < 30; ++i) p.in[i] = (const float*)d_in[i];
    p.out = (float*)d_out; p.ws = (unsigned char*)d_ws;
#if MULTI_LAUNCH
    for (int ph = 0; ph < NPHASE; ++ph) { p.ph_lo = ph; p.ph_hi = ph + 1; hipLaunchKernelGGL(fwd_megakernel, dim3(grid), dim3(NTHR), LDS_BYTES, stream, p); }
#else
    p.ph_lo = 0; p.ph_hi = NPHASE;
    void* args[] = {&p};
    hipError_t e = hipLaunchCooperativeKernel((const void*)fwd_megakernel, dim3(grid), dim3(NTHR), args, LDS_BYTES, stream);
    if (e != hipSuccess) fprintf(stderr, "cooperative launch failed: %s (grid %d)\n", hipGetErrorString(e), grid);
#endif
}
```

```cpp
#include <hip/hip_runtime.h>
#include <hip/hip_cooperative_groups.h>
#include <cstdio>
namespace cg = cooperative_groups;

#define LAS __attribute__((address_space(3)))
typedef unsigned short bf16_t;
typedef short bf16x8 __attribute__((ext_vector_type(8)));
typedef float f32x4 __attribute__((ext_vector_type(4)));
typedef unsigned u32x4 __attribute__((ext_vector_type(4)));
typedef unsigned u32x2 __attribute__((ext_vector_type(2)));

#ifndef MULTI_LAUNCH
#define MULTI_LAUNCH 0
#endif

constexpr int D = 1024, NTOK = 8192, NPTOK = 4096;
constexpr int N0 = 8448;
constexpr int N1 = 3328;
constexpr int NTHR = 512;
constexpr int LDS_MAIN = 139264;
constexpr int LDS_BYTES = LDS_MAIN + 256;

constexpr size_t MB = 1024 * 1024;
constexpr size_t WS_CTL = 0x1A0000 + 14336;
constexpr size_t WS_MOD = 4096;
constexpr size_t WS_BON = WS_MOD + 2 * 3 * 3072 * 4;
constexpr size_t WS_BAR = 0x1A0000;
constexpr size_t WS_BT0 = 2 * MB;
constexpr size_t WS_WT0O = WS_BT0 + (size_t)N0 * 1024 * 2;
constexpr size_t WS_BT1 = WS_WT0O + (size_t)1024 * 2048 * 2;
constexpr size_t WS_WT1O = WS_BT1 + (size_t)N1 * 1024 * 2;
constexpr size_t WS_H = WS_WT1O + (size_t)1024 * 1024 * 2;
constexpr size_t WS_OC = WS_H + (size_t)NTOK * 1024 * 2;
constexpr size_t WS_X1 = WS_OC + (size_t)NTOK * 2048 * 2;
constexpr size_t WS_P = WS_X1 + (size_t)NTOK * 1024 * 4;
constexpr size_t WS_P2 = WS_P + 64 * MB;
constexpr size_t WS_END = WS_P + (size_t)NTOK * N0 * 2;

struct Params {
    const float* in[30];
    float* out;
    unsigned char* ws;
    int ph_lo, ph_hi;
};

__device__ __forceinline__ float bf2f(bf16_t h) { return __uint_as_float(((unsigned)h) << 16); }
__device__ __forceinline__ bf16_t f2bf(float f) { unsigned u = __float_as_uint(f); u += 0x7FFFu + ((u >> 16) & 1u); return (bf16_t)(u >> 16); }
__device__ __forceinline__ unsigned pack2(float lo, float hi) { return (unsigned)f2bf(lo) | ((unsigned)f2bf(hi) << 16); }
__device__ __forceinline__ float bflo(unsigned w) { return __uint_as_float(w << 16); }
__device__ __forceinline__ float bfhi(unsigned w) { return __uint_as_float(w & 0xFFFF0000u); }
__device__ __forceinline__ float fexp(float x) { return __builtin_amdgcn_exp2f(x * 1.44269504f); }
__device__ __forceinline__ float flog(float x) { return __builtin_amdgcn_logf(x) * 0.69314718f; }
__device__ __forceinline__ float silu(float x) { return x * __builtin_amdgcn_rcpf(1.f + fexp(-x)); }
__device__ __forceinline__ float wave_sum(float v) {
#pragma unroll
    for (int m = 32; m >= 1; m >>= 1) v += __shfl_xor(v, m, 64);
    return v;
}

typedef float f32x2_t __attribute__((ext_vector_type(2)));
typedef __bf16 bf16x2_t __attribute__((ext_vector_type(2)));
__device__ __forceinline__ unsigned pk2(float lo, float hi) { const f32x2_t v = {lo, hi}; return __builtin_bit_cast(unsigned, __builtin_convertvector(v, bf16x2_t)); }
__device__ __forceinline__ bf16_t f2bf_hw(float f) { return __builtin_bit_cast(bf16_t, (__bf16)f); }

__device__ __forceinline__ void lds_barrier() { asm volatile("s_waitcnt lgkmcnt(0)" ::: "memory"); __builtin_amdgcn_s_barrier(); asm volatile("" ::: "memory"); }

namespace pg8 {
constexpr int BM = 256, BK = 64, HALF = 128, HTB = HALF * BK * 2, NXCD = 8, WGM = 8;
__device__ __forceinline__ int lds_byte(int r, int c) { const int st = (r >> 4) * 2 + (c >> 5), rr = r & 15, cc = c & 31, ob = rr * 64 + cc * 2; return st * 1024 + (ob ^ (((ob >> 9) & 1) << 5)); }
__device__ __forceinline__ void stage_rc(int b, int& R, int& C) { const int st = b / 1024, sb = b % 1024, swz = sb ^ (((sb >> 9) & 1) << 5); R = (st >> 1) * 16 + swz / 64; C = (st & 1) * 32 + (swz % 64) / 2; }
__device__ __forceinline__ int perm32(int rho) { const int n = rho >> 4, i = rho & 15; return 8 * (i >> 2) + 4 * n + (i & 3); }

struct Unit { int pm, pn, ks; };
struct Gemm { const bf16_t* A; const bf16_t* Bt; int M, N, K, ld, KS; };

struct Order {
    int nM, nN, nNr, nwg, G, c;
    __device__ void init(int M, int N, int KS, int G_, int c_) { nM = M / BM; nNr = N / BM; nN = nNr * KS; nwg = nM * nN; G = G_; c = c_; }
    __device__ bool next(int i, Unit& u) const {
        const long L = (long)i * G + c; if (L >= nwg) return false;
        int wgid = (int)L; { const int q = nwg / NXCD, r = nwg % NXCD, xcd = wgid % NXCD, off = wgid / NXCD; wgid = (xcd < r ? xcd * (q + 1) : r * (q + 1) + (xcd - r) * q) + off; }
        const int nig = WGM * nN, gid = wgid / nig, fm = gid * WGM, gsz = (nM - fm) < WGM ? (nM - fm) : WGM;
        u.pm = fm + ((wgid % nig) % gsz); const int pn = (wgid % nig) / gsz; u.pn = pn % nNr; u.ks = pn / nNr; return true;
    }
};

__device__ __forceinline__ unsigned cvt_pk_bf16(float lo, float hi) { unsigned r; asm volatile("v_cvt_pk_bf16_f32 %0, %1, %2" : "=v"(r) : "v"(lo), "v"(hi)); return r; }

struct EpiF32 {
    static constexpr bool PERM = false;
    float* C; int ldc; size_t ks_stride;
    __device__ __forceinline__ void operator()(const f32x4 (&acc)[2][2][4][2], const Unit& u, int wr, int wc, int fr, int fq) const {
        const int row0 = u.pm * BM + wr * 64 + fr, col0 = u.pn * BM + wc * 32 + 4 * fq;
        float* Cb = C + (size_t)u.ks * ks_stride;
#pragma unroll
        for (int ai = 0; ai < 2; ++ai)
#pragma unroll
            for (int m = 0; m < 4; ++m) { float* rowp = Cb + (size_t)(row0 + ai * HALF + m * 16) * ldc + col0;
#pragma unroll
                for (int bj = 0; bj < 2; ++bj)
#pragma unroll
                    for (int n = 0; n < 2; ++n) *(f32x4*)(rowp + bj * HALF + n * 16) = acc[ai][bj][m][n]; }
    }
};
struct EpiBf16 {
    static constexpr bool PERM = true;
    bf16_t* O; int ldc; size_t ks_stride;
    __device__ __forceinline__ void operator()(const f32x4 (&acc)[2][2][4][2], const Unit& u, int wr, int wc, int fr, int fq) const {
        const int row0 = u.pm * BM + wr * 64 + fr; const int col0 = u.pn * BM + wc * 32 + 8 * fq;
        bf16_t* Ob = O + (size_t)u.ks * ks_stride;
#pragma unroll
        for (int ai = 0; ai < 2; ++ai)
#pragma unroll
            for (int m = 0; m < 4; ++m) { bf16_t* rowp = Ob + (size_t)(row0 + ai * HALF + m * 16) * ldc + col0;
#pragma unroll
                for (int bj = 0; bj < 2; ++bj) { const f32x4 v0 = acc[ai][bj][m][0], v1 = acc[ai][bj][m][1];
                    u32x4 w; w.x = cvt_pk_bf16(v0[0], v0[1]); w.y = cvt_pk_bf16(v0[2], v0[3]); w.z = cvt_pk_bf16(v1[0], v1[1]); w.w = cvt_pk_bf16(v1[2], v1[3]);
                    *(u32x4*)(rowp + bj * HALF) = w; } }
    }
};

template <class Epi>
__device__ __forceinline__ void gemm_phase(LAS unsigned char* lds, const Gemm g, const Order& S, const Epi& E) {
    const int tid = threadIdx.x, wid = __builtin_amdgcn_readfirstlane(tid >> 6), lane = tid & 63, wr = wid >> 2, wc = wid & 3, fr = lane & 15, fq = lane >> 4;
    const int K = g.K, nt = K / BK, ld = g.ld;
    unsigned voffA[2], voffB[2];
#pragma unroll
    for (int i = 0; i < 2; ++i) { int R, C; stage_rc(tid * 16 + i * 8192, R, C); const int Rb = Epi::PERM ? ((R & ~31) + perm32(R & 31)) : R;
        voffA[i] = (unsigned)(R * ld + C) * 2u; voffB[i] = (unsigned)(Rb * ld + C) * 2u; }
    const size_t kstep = (size_t)(BK * 2);
    const size_t hstep = (size_t)HALF * ld * 2;
    const size_t tstep = 2 * hstep;
    const size_t ksb = (size_t)K * 2;
    const unsigned ldsw = (unsigned)wid * 1024u;
    const int aoff = lds_byte(wr * 64 + fr, fq * 8), boff = lds_byte(wc * 32 + fr, fq * 8);
#define PG8_SA(b, h) (((b) * 2 + (h)) * HTB)
#define PG8_SB(b, h) ((4 + (b) * 2 + (h)) * HTB)
#define PG8_STAGE(bufoff, gbase, voff) do { _Pragma("unroll") for (int _i = 0; _i < 2; ++_i) \
        __builtin_amdgcn_global_load_lds((const unsigned*)((const char*)(gbase) + (voff)[_i]), (LAS unsigned*)(lds + (bufoff) + ldsw + _i * 8192), 16, 0, 0); } while (0)
#define PG8_LDA(dst, b, h) do { _Pragma("unroll") for (int m = 0; m < 4; ++m) _Pragma("unroll") for (int k = 0; k < 2; ++k) dst[m][k] = *(const LAS bf16x8*)(lds + PG8_SA(b, h) + aoff + m * 2048 + k * 1024); } while (0)
#define PG8_LDB(dst, b, h) do { _Pragma("unroll") for (int n = 0; n < 2; ++n) _Pragma("unroll") for (int k = 0; k < 2; ++k) dst[n][k] = *(const LAS bf16x8*)(lds + PG8_SB(b, h) + boff + n * 2048 + k * 1024); } while (0)
#define PG8_MMA(ai, bj, At, Bt) do { __builtin_amdgcn_s_setprio(1); _Pragma("unroll") for (int m = 0; m < 4; ++m) _Pragma("unroll") for (int n = 0; n < 2; ++n) _Pragma("unroll") for (int k = 0; k < 2; ++k) \
        acc[ai][bj][m][n] = __builtin_amdgcn_mfma_f32_16x16x32_bf16(Bt[n][k], At[m][k], acc[ai][bj][m][n], 0, 0, 0); __builtin_amdgcn_s_setprio(0); } while (0)
#define PG8_WAIT_V(n) asm volatile("s_waitcnt vmcnt(" #n ")" ::: "memory")
#define PG8_WAIT_L(n) asm volatile("s_waitcnt lgkmcnt(" #n ")" ::: "memory")
#define PG8_BAR __builtin_amdgcn_s_barrier()
#define PG8_SCHED __builtin_amdgcn_sched_barrier(0)
    Unit cur, nxt; int ui = 0;
    if (!S.next(0, cur)) return;
    f32x4 acc[2][2][4][2];
#pragma unroll
    for (int a = 0; a < 2; ++a)
#pragma unroll
        for (int b = 0; b < 2; ++b)
#pragma unroll
            for (int m = 0; m < 4; ++m)
#pragma unroll
                for (int n = 0; n < 2; ++n) acc[a][b][m][n] = (f32x4){0.f, 0.f, 0.f, 0.f};
    bf16x8 At[4][2], B0[2][2], B1[2][2];
    const char* cA = (const char*)g.A + (size_t)cur.pm * tstep + (size_t)cur.ks * ksb; const char* cB = (const char*)g.Bt + (size_t)cur.pn * tstep + (size_t)cur.ks * ksb;
    PG8_STAGE(PG8_SB(0, 0), cB, voffB); PG8_STAGE(PG8_SA(0, 0), cA, voffA); PG8_STAGE(PG8_SB(0, 1), cB + hstep, voffB); PG8_STAGE(PG8_SA(0, 1), cA + hstep, voffA);
    if (wr == 1) PG8_BAR;
    PG8_WAIT_V(4); PG8_BAR;
    PG8_STAGE(PG8_SB(1, 0), cB + kstep, voffB); PG8_STAGE(PG8_SA(1, 0), cA + kstep, voffA); PG8_STAGE(PG8_SB(1, 1), cB + hstep + kstep, voffB);
    PG8_WAIT_V(6); PG8_BAR;
    for (;;) {
        const bool has_next = S.next(ui + 1, nxt);
        const char* nA = has_next ? (const char*)g.A + (size_t)nxt.pm * tstep + (size_t)nxt.ks * ksb : cA; const char* nB = has_next ? (const char*)g.Bt + (size_t)nxt.pn * tstep + (size_t)nxt.ks * ksb : cB;
        for (int t = 0; t < nt; t += 2) {
            const bool last = (t == nt - 2);
            const char* a1 = cA + (size_t)(t + 1) * kstep;
            const char* a2 = last ? nA : cA + (size_t)(t + 2) * kstep; const char* b2 = last ? nB : cB + (size_t)(t + 2) * kstep;
            const char* a3 = a2 + kstep; const char* b3 = b2 + kstep;
            PG8_LDB(B0, 0, 0); PG8_SCHED; PG8_LDA(At, 0, 0); PG8_STAGE(PG8_SA(1, 1), a1 + hstep, voffA);
            PG8_WAIT_L(8); PG8_BAR; PG8_WAIT_L(0); PG8_MMA(0, 0, At, B0); PG8_BAR; PG8_SCHED;
            PG8_LDB(B1, 0, 1); PG8_STAGE(PG8_SB(0, 0), b2, voffB);
            PG8_BAR; PG8_WAIT_L(0); PG8_MMA(0, 1, At, B1); PG8_BAR;
            PG8_LDA(At, 0, 1); PG8_STAGE(PG8_SA(0, 0), a2, voffA);
            PG8_BAR; PG8_WAIT_L(0); PG8_MMA(1, 0, At, B0); PG8_BAR; PG8_SCHED;
            PG8_STAGE(PG8_SB(0, 1), b2 + hstep, voffB);
            PG8_WAIT_V(6); PG8_BAR; PG8_MMA(1, 1, At, B1); PG8_BAR;
            PG8_LDB(B0, 1, 0); PG8_SCHED; PG8_LDA(At, 1, 0); PG8_STAGE(PG8_SA(0, 1), a2 + hstep, voffA);
            PG8_WAIT_L(8); PG8_BAR; PG8_WAIT_L(0); PG8_MMA(0, 0, At, B0); PG8_BAR; PG8_SCHED;
            PG8_LDB(B1, 1, 1); PG8_STAGE(PG8_SB(1, 0), b3, voffB);
            PG8_BAR; PG8_WAIT_L(0); PG8_MMA(0, 1, At, B1); PG8_BAR;
            PG8_LDA(At, 1, 1); PG8_STAGE(PG8_SA(1, 0), a3, voffA);
            PG8_BAR; PG8_WAIT_L(0); PG8_MMA(1, 0, At, B0); PG8_BAR; PG8_SCHED;
            PG8_STAGE(PG8_SB(1, 1), b3 + hstep, voffB);
            PG8_WAIT_V(6); PG8_BAR; PG8_MMA(1, 1, At, B1); PG8_BAR;
        }
        E(acc, cur, wr, wc, fr, fq);
        if (!has_next) break;
#pragma unroll
        for (int a = 0; a < 2; ++a)
#pragma unroll
            for (int b = 0; b < 2; ++b)
#pragma unroll
                for (int m = 0; m < 4; ++m)
#pragma unroll
                    for (int n = 0; n < 2; ++n) acc[a][b][m][n] = (f32x4){0.f, 0.f, 0.f, 0.f};
        cur = nxt; cA = nA; cB = nB; ++ui;
    }
    PG8_WAIT_V(0);
    if (wr == 0) PG8_BAR;
    PG8_BAR;
#undef PG8_SA
#undef PG8_SB
#undef PG8_STAGE
#undef PG8_LDA
#undef PG8_LDB
#undef PG8_MMA
#undef PG8_WAIT_V
#undef PG8_WAIT_L
#undef PG8_BAR
#undef PG8_SCHED
}
}

struct TJob { const float* src; bf16_t* dst; int ldsrc, N, lddst, drow0, k0, n0; };
__device__ __forceinline__ TJob tjob_of(const Params& p, int t) {
    unsigned char* ws = p.ws;
    bf16_t* BT0 = (bf16_t*)(ws + WS_BT0); bf16_t* WT0O = (bf16_t*)(ws + WS_WT0O); bf16_t* BT1 = (bf16_t*)(ws + WS_BT1); bf16_t* WT1O = (bf16_t*)(ws + WS_WT1O);
    TJob j; int nnt;
    if (t < 1024) { j.src = p.in[10]; j.ldsrc = 8192; j.N = 8192; j.dst = BT0; j.lddst = 1024; j.drow0 = 0; nnt = 64; }
    else if (t < 1024 + 32) { t -= 1024; const int z = t >> 4; t &= 15; j.src = p.in[14] + (size_t)z * 1024 * 64; j.ldsrc = 64; j.N = 64; j.dst = BT0; j.lddst = 1024; j.drow0 = 8192 + z * 64; nnt = 1; }
    else if (t < 1024 + 64) { t -= 1024 + 32; const int z = t >> 4; t &= 15; j.src = p.in[17] + (size_t)z * 1024 * 64; j.ldsrc = 64; j.N = 64; j.dst = BT0; j.lddst = 1024; j.drow0 = 8320 + z * 64; nnt = 1; }
    else if (t < 1088 + 256) { t -= 1088; j.src = p.in[11]; j.ldsrc = 1024; j.N = 1024; j.dst = WT0O; j.lddst = 2048; j.drow0 = 0; nnt = 8; }
    else if (t < 1344 + 384) { t -= 1344; j.src = p.in[24]; j.ldsrc = 3072; j.N = 3072; j.dst = BT1; j.lddst = 1024; j.drow0 = 0; nnt = 24; }
    else if (t < 1728 + 32) { t -= 1728; const int z = t >> 4; t &= 15; j.src = p.in[26] + (size_t)z * 1024 * 16; j.ldsrc = 16; j.N = 16; j.dst = BT1; j.lddst = 1024; j.drow0 = 3072 + z * 16; nnt = 1; }
    else { t -= 1760; j.src = p.in[25]; j.ldsrc = 1024; j.N = 1024; j.dst = WT1O; j.lddst = 1024; j.drow0 = 0; nnt = 8; }
    j.k0 = (t / nnt) * 64; j.n0 = (t % nnt) * 128; return j;
}
__device__ __forceinline__ void tjob_load(const TJob& j, f32x4 (&r)[4]) {
    const int tid = threadIdx.x, c4 = (tid & 31) * 4;
#pragma unroll
    for (int i = 0; i < 4; ++i) { const int kk = (tid >> 5) + 16 * i;
        r[i] = (j.n0 + c4 < j.N) ? *(const f32x4*)(j.src + (size_t)(j.k0 + kk) * j.ldsrc + j.n0 + c4) : (f32x4){0.f, 0.f, 0.f, 0.f}; }
}

__device__ void transpose_jobs(const Params& p, float* lds, int t_lo, int t_hi, int rot) {
    const int tid = threadIdx.x;
    float* tile = lds;
    int it = t_lo + (int)((blockIdx.x + (unsigned)rot) % gridDim.x);
    f32x4 cur[4], nxt[4];
    TJob jc = tjob_of(p, it < t_hi ? it : t_lo);
    if (it < t_hi) tjob_load(jc, cur);
    for (; it < t_hi; it += gridDim.x) {
        const int c4 = (tid & 31) * 4;
#pragma unroll
        for (int i = 0; i < 4; ++i) { const int kk = (tid >> 5) + 16 * i; tile[kk * 129 + c4] = cur[i][0]; tile[kk * 129 + c4 + 1] = cur[i][1]; tile[kk * 129 + c4 + 2] = cur[i][2]; tile[kk * 129 + c4 + 3] = cur[i][3]; }
        const int itn = it + gridDim.x;
        const TJob jn = tjob_of(p, itn < t_hi ? itn : t_lo);
        if (itn < t_hi) tjob_load(jn, nxt);
        __syncthreads();
#pragma unroll
        for (int q = 0; q < 2; ++q) { const int idx = tid + q * NTHR; const int nn = idx >> 3, k8 = (idx & 7) * 8;
            if (jc.n0 + nn < jc.N) { u32x4 o; o.x = pk2(tile[(k8 + 0) * 129 + nn], tile[(k8 + 1) * 129 + nn]); o.y = pk2(tile[(k8 + 2) * 129 + nn], tile[(k8 + 3) * 129 + nn]);
                o.z = pk2(tile[(k8 + 4) * 129 + nn], tile[(k8 + 5) * 129 + nn]); o.w = pk2(tile[(k8 + 6) * 129 + nn], tile[(k8 + 7) * 129 + nn]);
                *(u32x4*)(jc.dst + (size_t)(jc.drow0 + jc.n0 + nn) * jc.lddst + jc.k0 + k8) = o; } }
        __syncthreads();
        jc = jn;
#pragma unroll
        for (int i = 0; i < 4; ++i) cur[i] = nxt[i];
    }
}

__device__ void phase_prologue(const Params& p, float* lds) {
    const int tid = threadIdx.x;
    unsigned char* ws = p.ws;
    bf16_t* BT1 = (bf16_t*)(ws + WS_BT1);
    float* MOD = (float*)(ws + WS_MOD);
    constexpr int NGEMV = 192;
    for (int it = blockIdx.x; it < NGEMV; it += gridDim.x) {
        const int l = it / 96, j0 = (it % 96) * 32;
        float* sc = lds;
        float* red = lds + 3072;
        for (int i = tid; i < 3072; i += NTHR) { const int cnd = i >> 10, k = i & 1023; const float v = cnd == 0 ? p.in[5][k] : p.in[4][(cnd - 1) * 1024 + k]; sc[i] = silu(v); }
        __syncthreads();
        const int col = tid & 31, ksp = tid >> 5;
        float a0 = 0.f, a1 = 0.f, a2 = 0.f;
        const float* w = p.in[7] + (size_t)l * 1024 * 3072 + j0 + col;
#pragma unroll 16
        for (int k = ksp * 64; k < ksp * 64 + 64; ++k) { const float wv = w[(size_t)k * 3072]; a0 += sc[k] * wv; a1 += sc[1024 + k] * wv; a2 += sc[2048 + k] * wv; }
        red[(ksp * 3 + 0) * 32 + col] = a0; red[(ksp * 3 + 1) * 32 + col] = a1; red[(ksp * 3 + 2) * 32 + col] = a2;
        __syncthreads();
        if (tid < 96) { const int cnd = tid >> 5, cc = tid & 31; float s = 0.f; for (int q = 0; q < 16; ++q) s += red[(q * 3 + cnd) * 32 + cc];
            MOD[(l * 3 + cnd) * 3072 + j0 + cc] = s + p.in[8][l * 3072 + j0 + cc]; }
        __syncthreads();
    }
    transpose_jobs(p, lds, 0, 1088, 64);
}
__device__ void phase_late_weights(const Params& p, float* lds) {
    const int tid = threadIdx.x;
    bf16_t* BT1 = (bf16_t*)(p.ws + WS_BT1);
    transpose_jobs(p, lds, 1088, 1888, 0);
    { u32x4* z = (u32x4*)(BT1 + (size_t)3104 * 1024); const int n = 224 * 1024 * 2 / 16;
      for (int i = blockIdx.x * NTHR + tid; i < n; i += gridDim.x * NTHR) z[i] = (u32x4){0u, 0u, 0u, 0u}; }
}

__device__ void phase_h(const Params& p, int layer, float* ldsf) {
    const int tid = threadIdx.x, wave = __builtin_amdgcn_readfirstlane(tid >> 6), lane = tid & 63, fr = lane & 15, fq = lane >> 4;
    unsigned char* ws = p.ws;
    const float* MOD = (const float*)(ws + WS_MOD);
    bf16_t* H = (bf16_t*)(ws + WS_H);
    bf16_t* X1 = (bf16_t*)(ws + WS_X1);
    const bf16_t* Y = (const bf16_t*)(ws + WS_P);
    bf16_t* HL = (bf16_t*)ldsf;
    for (int tb = blockIdx.x * 32; tb < NTOK; tb += gridDim.x * 32) {
#pragma unroll 1
        for (int q = 0; q < 4; ++q) { const int tl = wave * 4 + q, tok = tb + tl;
            const float* xr = tok < NPTOK ? p.in[0] + (size_t)tok * D : p.in[1] + (size_t)(tok - NPTOK) * D;
            const int cond = tok < NPTOK ? 0 : 1 + ((tok - NPTOK) >> 11);
            f32x4 xv[4]; float ss = 0.f;
#pragma unroll
            for (int i = 0; i < 4; ++i) { const int idx = i * 256 + lane * 4; xv[i] = *(const f32x4*)(xr + idx);
                if (layer == 1) { const u32x2 pa = *(const u32x2*)(Y + (size_t)tok * D + idx), pb = *(const u32x2*)(Y + (size_t)NTOK * D + (size_t)tok * D + idx);
                    const f32x4 ya = (f32x4){bflo(pa.x), bfhi(pa.x), bflo(pa.y), bfhi(pa.y)}, yb = (f32x4){bflo(pb.x), bfhi(pb.x), bflo(pb.y), bfhi(pb.y)};
                    const f32x4 gt = *(const f32x4*)(MOD + (0 * 3 + cond) * 3072 + 2048 + idx);
                    xv[i] = xv[i] + gt * (ya + yb); { u32x2 xw; xw.x = pk2(xv[i][0], xv[i][1]); xw.y = pk2(xv[i][2], xv[i][3]); *(u32x2*)(X1 + (size_t)tok * D + idx) = xw; } }
                ss += xv[i][0] * xv[i][0] + xv[i][1] * xv[i][1] + xv[i][2] * xv[i][2] + xv[i][3] * xv[i][3]; }
            ss = wave_sum(ss);
            const float rstd = rsqrtf(ss * (1.f / 1024.f) + 1e-6f);
#pragma unroll
            for (int i = 0; i < 4; ++i) { const int idx = i * 256 + lane * 4;
                const f32x4 g = *(const f32x4*)(p.in[6] + layer * D + idx);
                const f32x4 sh = *(const f32x4*)(MOD + (layer * 3 + cond) * 3072 + idx), sc = *(const f32x4*)(MOD + (layer * 3 + cond) * 3072 + 1024 + idx);
                f32x4 h;
#pragma unroll
                for (int j = 0; j < 4; ++j) h[j] = xv[i][j] * rstd * g[j] * (1.f + sc[j]) + sh[j];
                u32x2 w2; w2.x = pk2(h[0], h[1]); w2.y = pk2(h[2], h[3]);
                *(u32x2*)(H + (size_t)tok * D + idx) = w2;
                if (layer == 0) *(u32x2*)(HL + tl * 1032 + idx) = w2; } }
        if (layer == 0) {
            __syncthreads();
            const bf16_t* BL = (const bf16_t*)(ws + WS_BT0) + (size_t)8192 * 1024;
            bf16_t* P = (bf16_t*)(ws + WS_P);
            f32x4 acc[2][2];
#pragma unroll
            for (int mt = 0; mt < 2; ++mt)
#pragma unroll
                for (int n2 = 0; n2 < 2; ++n2) acc[mt][n2] = (f32x4){0.f, 0.f, 0.f, 0.f};
#pragma unroll 16
            for (int ks = 0; ks < 32; ++ks) {
                bf16x8 af[2], bfr[2];
#pragma unroll
                for (int mt = 0; mt < 2; ++mt) af[mt] = *(const bf16x8*)(HL + (mt * 16 + fr) * 1032 + ks * 32 + fq * 8);
#pragma unroll
                for (int n2 = 0; n2 < 2; ++n2) bfr[n2] = *(const bf16x8*)(BL + (size_t)((wave * 2 + n2) * 16 + fr) * 1024 + ks * 32 + fq * 8);
#pragma unroll
                for (int mt = 0; mt < 2; ++mt)
#pragma unroll
                    for (int n2 = 0; n2 < 2; ++n2) acc[mt][n2] = __builtin_amdgcn_mfma_f32_16x16x32_bf16(bfr[n2], af[mt], acc[mt][n2], 0, 0, 0);
            }
#pragma unroll
            for (int mt = 0; mt < 2; ++mt)
#pragma unroll
                for (int n2 = 0; n2 < 2; ++n2)
                    { u32x2 o2; o2.x = pk2(acc[mt][n2][0], acc[mt][n2][1]); o2.y = pk2(acc[mt][n2][2], acc[mt][n2][3]);
                      *(u32x2*)(P + (size_t)(tb + mt * 16 + fr) * N0 + 8192 + (wave * 2 + n2) * 16 + fq * 4) = o2; }
            __syncthreads();
        }
    }
}

__device__ __forceinline__ f32x4 mma_nt(const bf16_t* A, int lda, const bf16_t* B, int ldb, int K, f32x4 acc, int fr, int fq) {
    for (int k0 = 0; k0 < K; k0 += 32) {
        const bf16x8 a = *(const bf16x8*)(A + fr * lda + k0 + fq * 8);
        const bf16x8 b = *(const bf16x8*)(B + fr * ldb + k0 + fq * 8);
        acc = __builtin_amdgcn_mfma_f32_16x16x32_bf16(a, b, acc, 0, 0, 0);
    }
    return acc;
}
__device__ __forceinline__ bf16x8 pack8(float a0, float a1, float a2, float a3, float a4, float a5, float a6, float a7) {
    u32x4 w; w.x = pack2(a0, a1); w.y = pack2(a2, a3); w.z = pack2(a4, a5); w.w = pack2(a6, a7);
    return __builtin_bit_cast(bf16x8, w);
}
__device__ __forceinline__ float dpp_add(float v, float o) { return v + o; }
__device__ __forceinline__ float wave_sum_fast(float v) {
    v += __int_as_float(__builtin_amdgcn_update_dpp(0, __float_as_int(v), 0xB1, 0xF, 0xF, true));
    v += __int_as_float(__builtin_amdgcn_update_dpp(0, __float_as_int(v), 0x4E, 0xF, 0xF, true));
    v += __int_as_float(__builtin_amdgcn_update_dpp(0, __float_as_int(v), 0x141, 0xF, 0xF, true));
    v += __int_as_float(__builtin_amdgcn_update_dpp(0, __float_as_int(v), 0x140, 0xF, 0xF, true));
    v += __shfl_xor(v, 16, 64); v += __shfl_xor(v, 32, 64);
    return v;
}
__device__ __forceinline__ float wave_sum_dpp(float v) {
    v += __int_as_float(__builtin_amdgcn_update_dpp(0, __float_as_int(v), 0xB1, 0xF, 0xF, true));
    v += __int_as_float(__builtin_amdgcn_update_dpp(0, __float_as_int(v), 0x4E, 0xF, 0xF, true));
    v += __int_as_float(__builtin_amdgcn_update_dpp(0, __float_as_int(v), 0x141, 0xF, 0xF, true));
    v += __int_as_float(__builtin_amdgcn_update_dpp(0, __float_as_int(v), 0x140, 0xF, 0xF, true));
    v += __int_as_float(__builtin_amdgcn_update_dpp(0, __float_as_int(v), 0x142, 0xA, 0xF, false));
    v += __int_as_float(__builtin_amdgcn_update_dpp(0, __float_as_int(v), 0x143, 0xC, 0xF, false));
    return __int_as_float(__builtin_amdgcn_readlane(__float_as_int(v), 63));
}
__device__ __forceinline__ float wave_sum_lane63(float v) {
    v += __int_as_float(__builtin_amdgcn_update_dpp(0, __float_as_int(v), 0xB1, 0xF, 0xF, true));
    v += __int_as_float(__builtin_amdgcn_update_dpp(0, __float_as_int(v), 0x4E, 0xF, 0xF, true));
    v += __int_as_float(__builtin_amdgcn_update_dpp(0, __float_as_int(v), 0x141, 0xF, 0xF, true));
    v += __int_as_float(__builtin_amdgcn_update_dpp(0, __float_as_int(v), 0x140, 0xF, 0xF, true));
    v += __int_as_float(__builtin_amdgcn_update_dpp(0, __float_as_int(v), 0x142, 0xA, 0xF, false));
    v += __int_as_float(__builtin_amdgcn_update_dpp(0, __float_as_int(v), 0x143, 0xC, 0xF, false));
    return v;
}
__device__ __forceinline__ float fast_tanh(float x) { const float e = fexp(2.f * x); return 1.f - 2.f * __builtin_amdgcn_rcpf(1.f + e); }
__device__ __forceinline__ bf16x8 pack8h(float a0, float a1, float a2, float a3, float a4, float a5, float a6, float a7) {
    u32x4 w; w.x = pk2(a0, a1); w.y = pk2(a2, a3); w.z = pk2(a4, a5); w.w = pk2(a6, a7);
    return __builtin_bit_cast(bf16x8, w);
}

__device__ __forceinline__ void conv_pair(const Params& p, int t0, int c0) {
    unsigned char* ws = p.ws;
    const bf16_t* P = (const bf16_t*)(ws + WS_P);
    bf16_t* OC = (bf16_t*)(ws + WS_OC);
    const int rl = t0 < NPTOK ? 256 : 64; const int pos0 = t0 & (rl - 1);
    const bool hasp = pos0 > 0, hasn = pos0 + 2 < rl;
    const bf16_t* row0 = P + (size_t)t0 * N0 + c0;
    const u32x4 z4 = (u32x4){0u, 0u, 0u, 0u};
    u32x4 uu[4], gg[4], gb[2], zc[2];
    uu[0] = hasp ? *(const u32x4*)(row0 - N0) : z4; gg[0] = hasp ? *(const u32x4*)(row0 - N0 + 2048) : z4;
#pragma unroll
    for (int j = 0; j < 2; ++j) { uu[j + 1] = *(const u32x4*)(row0 + (size_t)j * N0); gg[j + 1] = *(const u32x4*)(row0 + (size_t)j * N0 + 2048);
        gb[j] = *(const u32x4*)(row0 + (size_t)j * N0 + 1024); zc[j] = *(const u32x4*)(row0 + (size_t)j * N0 + 3072); }
    uu[3] = hasn ? *(const u32x4*)(row0 + (size_t)2 * N0) : z4; gg[3] = hasn ? *(const u32x4*)(row0 + (size_t)2 * N0 + 2048) : z4;
    float cw[3][8];
#pragma unroll
    for (int k = 0; k < 3; ++k) { const f32x4 a = *(const f32x4*)(p.in[12] + k * 1024 + c0), b = *(const f32x4*)(p.in[12] + k * 1024 + c0 + 4);
        cw[k][0] = a[0]; cw[k][1] = a[1]; cw[k][2] = a[2]; cw[k][3] = a[3]; cw[k][4] = b[0]; cw[k][5] = b[1]; cw[k][6] = b[2]; cw[k][7] = b[3]; }
#pragma unroll
    for (int j = 0; j < 2; ++j) { u32x4 o;
#pragma unroll
        for (int q = 0; q < 4; ++q) {
            const float y0 = cw[0][2 * q] * (bflo(gg[j][q]) * bflo(uu[j][q])) + cw[1][2 * q] * (bflo(gg[j + 1][q]) * bflo(uu[j + 1][q])) + cw[2][2 * q] * (bflo(gg[j + 2][q]) * bflo(uu[j + 2][q]));
            const float y1 = cw[0][2 * q + 1] * (bfhi(gg[j][q]) * bfhi(uu[j][q])) + cw[1][2 * q + 1] * (bfhi(gg[j + 1][q]) * bfhi(uu[j + 1][q])) + cw[2][2 * q + 1] * (bfhi(gg[j + 2][q]) * bfhi(uu[j + 2][q]));
            o[q] = pk2(silu(bflo(zc[j][q])) * bflo(gb[j][q]) * y0, silu(bfhi(zc[j][q])) * bfhi(gb[j][q]) * y1);
        }
        *(u32x4*)(OC + (size_t)(t0 + j) * 2048 + c0) = o; }
}

__device__ void wkv_unit(const Params& p, int u, float* ldsf) {
    const int tid0 = threadIdx.x, lane0 = tid0 & 63, w = __builtin_amdgcn_readfirstlane(tid0 >> 6), fr0 = lane0 & 15, fq0 = lane0 >> 4;
    unsigned char* ws = p.ws;
    unsigned char* lds = (unsigned char*)ldsf;
    const bf16_t* P = (const bf16_t*)(ws + WS_P);
    bf16_t* OD = (bf16_t*)(ws + WS_X1);
    float* BON = (float*)(ws + WS_BON);
    int z, b, hd, sgm, seqT, tok0; bool sample; const int T = 256;
    if (u < 512) { sample = true; z = u >> 8; b = (u >> 7) & 1; hd = (u >> 3) & 15; sgm = u & 7; seqT = 2048; tok0 = NPTOK + b * 2048; }
    else { const int q = u - 512; sample = false; z = q >> 8; b = (q >> 4) & 15; hd = q & 15; sgm = 0; seqT = 256; tok0 = b * 256; }
    const int qbase = sgm * 256;
    bf16_t* RHO = (bf16_t*)(ws + WS_H);
    float* GH = (float*)(ws + WS_BT0);
    bf16_t* TLW = (bf16_t*)(lds + 0);
    bf16_t* TLA = (bf16_t*)(lds + 9216);
    float* HT = (float*)(lds + 18432);
    float* BONL = (float*)(lds + 57344);
    bf16_t* KTr = (bf16_t*)(lds + 20480);
    bf16_t* BTr = (bf16_t*)(lds + 29696);
    bf16_t* KKH = (bf16_t*)(lds + 38912);
    bf16_t* RH = (bf16_t*)(lds + 48128);
    const bf16_t* VS = (const bf16_t*)(lds + 113664 + 2 * 8192);
    bf16_t* TA = (bf16_t*)(lds + 65536);
    bf16_t* NA = (bf16_t*)(lds + 70656);
    float* PC = (float*)(lds + 75776);
    bf16_t* KBm = (bf16_t*)(lds + 76800);
    float* MM = (float*)(lds + 97280);
    float* WA = (float*)(lds + 76800);
    bf16x8 bw[2];
    { const float* W2 = (w >> 2) ? p.in[18] : p.in[15];
#pragma unroll
      for (int ks = 0; ks < 2; ++ks) { float t8[8];
#pragma unroll
        for (int e = 0; e < 8; ++e) t8[e] = W2[(size_t)(z * 64 + ks * 32 + fq0 * 8 + e) * 1024 + hd * 64 + (w & 3) * 16 + fr0];
        bw[ks] = pack8h(t8[0], t8[1], t8[2], t8[3], t8[4], t8[5], t8[6], t8[7]); } }
    f32x4 Sacc[4];
#pragma unroll
    for (int kt = 0; kt < 4; ++kt) Sacc[kt] = (f32x4){0.f, 0.f, 0.f, 0.f};
    if (w >= 4) {
#pragma unroll
        for (int kt = 0; kt < 4; ++kt)
#pragma unroll
            for (int jj = 0; jj < 4; ++jj) Sacc[kt][jj] = (kt * 16 + fq0 * 4 + jj == (w - 4) * 16 + fr0) ? 1.f : 0.f; }
    const int ch = hd * 64 + lane0;
    const float w0c = p.in[13][z * 1024 + ch], a0c = p.in[16][z * 1024 + ch], kkc = p.in[19][ch], kac = p.in[20][ch], rkc = p.in[21][ch];
    bf16_t* RKV = (bf16_t*)(lds + 113664);
    u32x4 tlraw[2], rkvraw[3];
#define WKV_LOAD_RAW(tb_) do { \
        _Pragma("unroll") for (int h_ = 0; h_ < 2; ++h_) { const int idx_ = tid + h_ * NTHR; const int tau_ = idx_ >> 4, sg_ = idx_ & 15; const int t_ = z ? (seqT - 1 - (qbase + (tb_) + tau_)) : (qbase + (tb_) + tau_); \
            tlraw[h_] = *(const u32x4*)(P + (size_t)(tok0 + t_) * N0 + 8192 + (sg_ < 8 ? z * 64 + sg_ * 8 : 128 + z * 64 + (sg_ - 8) * 8)); } \
        { const int tau_ = tid >> 3, sg_ = tid & 7; const int t_ = z ? (seqT - 1 - (qbase + (tb_) + tau_)) : (qbase + (tb_) + tau_); const bf16_t* rp_ = P + (size_t)(tok0 + t_) * N0 + 4096 + hd * 64 + sg_ * 8; \
          rkvraw[0] = *(const u32x4*)rp_; rkvraw[1] = *(const u32x4*)(rp_ + 1024); rkvraw[2] = *(const u32x4*)(rp_ + 2048); } } while (0)
    { const int tid = tid0; WKV_LOAD_RAW(0); }
    __syncthreads();
#pragma unroll 1
    for (int tb = 0; tb < T; tb += 64) {
        int tid = tid0; asm volatile("" : "+v"(tid));
        const int lane = tid & 63, fr = lane & 15, fq = lane >> 4, c = lane;
        const int pcol = ((c >> 5) * 32) + (((c >> 2) & 3) * 8) + (((c >> 4) & 1) * 4) + (c & 3);
#pragma unroll
        for (int h = 0; h < 2; ++h) { const int idx = tid + h * NTHR; const int tau = idx >> 4, sg = idx & 15;
            u32x4 o = tlraw[h];
            if (sg < 8) { o.x = pk2(fast_tanh(bflo(o.x)), fast_tanh(bfhi(o.x))); o.y = pk2(fast_tanh(bflo(o.y)), fast_tanh(bfhi(o.y)));
                          o.z = pk2(fast_tanh(bflo(o.z)), fast_tanh(bfhi(o.z))); o.w = pk2(fast_tanh(bflo(o.w)), fast_tanh(bfhi(o.w))); }
            *(u32x4*)((sg < 8 ? TLW : TLA) + tau * 72 + (sg & 7) * 8) = o; }
#pragma unroll
        for (int h = 0; h < 3; ++h) *(u32x4*)(RKV + h * 4096 + (tid >> 3) * 64 + (tid & 7) * 8) = rkvraw[h];
        lds_barrier();
        if (tb + 64 < T) WKV_LOAD_RAW(tb + 64);
        { const bf16_t* TL = (w >> 2) ? TLA : TLW; float* WAo = WA + (w >> 2) * 64 * 68;
#pragma unroll
          for (int mt = 0; mt < 4; ++mt) { f32x4 acc = (f32x4){0.f, 0.f, 0.f, 0.f};
#pragma unroll
            for (int ks = 0; ks < 2; ++ks) { const bf16x8 a = *(const bf16x8*)(TL + (mt * 16 + fr) * 72 + ks * 32 + fq * 8);
                acc = __builtin_amdgcn_mfma_f32_16x16x32_bf16(a, bw[ks], acc, 0, 0, 0); }
#pragma unroll
            for (int jj = 0; jj < 4; ++jj) WAo[(mt * 16 + fq * 4 + jj) * 68 + (w & 3) * 16 + fr] = acc[jj]; } }
        lds_barrier();
        float kkv[8], kmv[8], bv[8], lwv[8], cum[8], rr[8], bonv[8];
        { float run = 0.f;
#pragma unroll
          for (int i = 0; i < 8; ++i) { const int tau = w * 8 + i; const int t = z ? (seqT - 1 - (qbase + tb + tau)) : (qbase + tb + tau); const int tokg = tok0 + t;
            const float wr_ = w0c + WA[tau * 68 + c], ap = a0c + WA[64 * 68 + tau * 68 + c];
            const float nx = -wr_; const float sp = fmaxf(nx, 0.f) + flog(1.f + fexp(-fabsf(nx)));
            const float lw = -fexp(-sp - 0.5f);
            const float iclr = __builtin_amdgcn_rcpf(1.f + fexp(-ap));
            const float kxi = bf2f(RKV[4096 + tau * 64 + c]); rr[i] = bf2f(RKV[tau * 64 + c]);
            const float kkraw = kxi * kkc;
            const float ssq = wave_sum_fast(kkraw * kkraw);
            const float kk = kkraw * __builtin_amdgcn_rsqf(fmaxf(ssq, 1e-24f));
            const float kmod = kxi * (1.f + (iclr - 1.f) * kac);
            bonv[i] = wave_sum_lane63(rr[i] * kmod * rkc);
            run += lw;
            kkv[i] = kk; kmv[i] = kmod; bv[i] = kk * iclr; lwv[i] = lw; cum[i] = run; }
          HT[w * 64 + c] = run;
          if (lane == 63) {
#pragma unroll
            for (int i = 0; i < 8; ++i) BONL[w * 8 + i] = bonv[i]; } }
        lds_barrier();
        if (tid < 64) { const int t = z ? (seqT - 1 - (qbase + tb + tid)) : (qbase + tb + tid); BON[((size_t)z * NTOK + tok0 + t) * 16 + hd] = BONL[tid]; }
        { const float off = (w & 1) ? HT[(w - 1) * 64 + c] : 0.f; const int cn = w >> 1;
          unsigned kbq[8];
#pragma unroll
          for (int i = 0; i < 8; ++i) { const int tau = w * 8 + i; const int j = (w & 1) * 8 + i;
            const float cm = cum[i] + off;
            const float Pj = fexp(cm), ipj = fexp(-cm), pm1 = fexp(cm - lwv[i]);
            const unsigned kb2 = pk2(-bv[i] * ipj, kmv[i] * ipj);
            KTr[tau * 72 + pcol] = (bf16_t)(kb2 >> 16); BTr[tau * 72 + pcol] = f2bf_hw(bv[i] * ipj);
            const unsigned kr2 = pk2(kkv[i] * pm1, rr[i] * Pj);
            KKH[tau * 72 + pcol] = (bf16_t)(kr2 & 0xFFFFu); RH[tau * 72 + pcol] = (bf16_t)(kr2 >> 16);
            kbq[i] = kb2;
            if (j == 15) PC[cn * 64 + c] = Pj; }
#pragma unroll
          for (int g = 0; g < 2; ++g) { u32x4 o;
              o.x = (kbq[g * 4 + 0] & 0xFFFFu) | (kbq[g * 4 + 1] << 16); o.y = (kbq[g * 4 + 2] & 0xFFFFu) | (kbq[g * 4 + 3] << 16);
              o.z = (kbq[g * 4 + 0] >> 16) | (kbq[g * 4 + 1] & 0xFFFF0000u); o.w = (kbq[g * 4 + 2] >> 16) | (kbq[g * 4 + 3] & 0xFFFF0000u);
              *(u32x4*)(KBm + (cn * 64 + c) * 40 + ((w & 1) * 2 + g) * 8) = o; } }
        lds_barrier();
#pragma unroll
        for (int q2 = 0; q2 < 2; ++q2) { const int id = w * 2 + q2; const int cn = id >> 2, which = id & 3;
          const bf16_t* Am = ((which & 1) ? KTr : BTr) + cn * 16 * 72; const bf16_t* Bm = ((which & 2) ? RH : KKH) + cn * 16 * 72;
          const f32x4 acc = mma_nt(Am, 72, Bm, 72, 64, (f32x4){0.f, 0.f, 0.f, 0.f}, fr, fq);
          f32x4 o;
#pragma unroll
          for (int jj = 0; jj < 4; ++jj) { const int i = fq * 4 + jj, j = fr; const bool keep = (which & 2) ? (i <= j) : (i < j); o[jj] = keep ? acc[jj] : 0.f; }
          *(f32x4*)(MM + (cn * 4 + which) * 256 + fr * 16 + fq * 4) = o; }
        lds_barrier();
        if (w < 4) { const int cn = w, col = lane >> 2, rg = lane & 3;
            const float* MbT = MM + (cn * 4 + 0) * 256 + rg * 4; const float* MkT = MM + (cn * 4 + 1) * 256 + rg * 4;
            float Tc[4], A1[4];
#pragma unroll
            for (int e = 0; e < 4; ++e) { Tc[e] = (rg * 4 + e == col) ? 1.f : 0.f; A1[e] = 0.f; }
#define INV_STEP(l, CTRL) do { const f32x4 mb = *(const f32x4*)(MbT + (l) * 16), mk = *(const f32x4*)(MkT + (l) * 16); \
                const float tl_ = __int_as_float(__builtin_amdgcn_update_dpp(0, __float_as_int(Tc[(l) & 3]), CTRL, 0xF, 0xF, true)); \
                Tc[0] -= mb[0] * tl_; Tc[1] -= mb[1] * tl_; Tc[2] -= mb[2] * tl_; Tc[3] -= mb[3] * tl_; \
                A1[0] += mk[0] * tl_; A1[1] += mk[1] * tl_; A1[2] += mk[2] * tl_; A1[3] += mk[3] * tl_; } while (0)
            INV_STEP(15, 0xFF); INV_STEP(14, 0xFF); INV_STEP(13, 0xFF); INV_STEP(12, 0xFF);
            INV_STEP(11, 0xAA); INV_STEP(10, 0xAA); INV_STEP(9, 0xAA); INV_STEP(8, 0xAA);
            INV_STEP(7, 0x55); INV_STEP(6, 0x55); INV_STEP(5, 0x55); INV_STEP(4, 0x55);
            INV_STEP(3, 0x00); INV_STEP(2, 0x00); INV_STEP(1, 0x00);
#undef INV_STEP
            u32x4 o; o.x = pk2(Tc[0], Tc[1]); o.y = pk2(Tc[2], Tc[3]); o.z = pk2(A1[0], A1[1]); o.w = pk2(A1[2], A1[3]);
            *(u32x4*)(TA + (cn * 16 + col) * 40 + rg * 8) = o; }
        else { const int cn = w - 4, j = lane & 15, ig = lane >> 4;
            const f32x4 nb = *(const f32x4*)(MM + (cn * 4 + 2) * 256 + j * 16 + ig * 4), nk = *(const f32x4*)(MM + (cn * 4 + 3) * 256 + j * 16 + ig * 4);
            u32x4 o; o.x = pk2(-nb[0], -nb[1]); o.y = pk2(-nb[2], -nb[3]); o.z = pk2(nk[0], nk[1]); o.w = pk2(nk[2], nk[3]);
            *(u32x4*)(NA + (cn * 16 + j) * 40 + ig * 8) = o; }
        lds_barrier();
        if (w < 4 || sample) {
            const int vb = w & 3;
            const int t0s = z ? (seqT - 1 - (qbase + tb)) : (qbase + tb);
            const long tstep = z ? -1024 : 1024;
            bf16_t* obase = (w < 4) ? OD + ((size_t)z * NTOK + tok0 + t0s) * 1024 + hd * 64 + vb * 16 + fq * 4 : RHO + ((size_t)z * 4096 + (tok0 - NPTOK) + t0s) * 1024 + hd * 64 + vb * 16 + fq * 4;
#pragma unroll 1
            for (int cn = 0; cn < 4; ++cn) {
                bf16x8 sb[2];
#pragma unroll
                for (int ks = 0; ks < 2; ++ks) sb[ks] = pack8h(Sacc[2 * ks][0], Sacc[2 * ks][1], Sacc[2 * ks][2], Sacc[2 * ks][3], Sacc[2 * ks + 1][0], Sacc[2 * ks + 1][1], Sacc[2 * ks + 1][2], Sacc[2 * ks + 1][3]);
                f32x4 U0 = (f32x4){0.f, 0.f, 0.f, 0.f}, O = (f32x4){0.f, 0.f, 0.f, 0.f};
#pragma unroll
                for (int ks = 0; ks < 2; ++ks) { const bf16x8 a = *(const bf16x8*)(KKH + (cn * 16 + fr) * 72 + ks * 32 + fq * 8);
                    U0 = __builtin_amdgcn_mfma_f32_16x16x32_bf16(a, sb[ks], U0, 0, 0, 0);
                    const bf16x8 ar = *(const bf16x8*)(RH + (cn * 16 + fr) * 72 + ks * 32 + fq * 8);
                    O = __builtin_amdgcn_mfma_f32_16x16x32_bf16(sb[ks], ar, O, 0, 0, 0); }
                float vf[4];
#pragma unroll
                for (int e = 0; e < 4; ++e) vf[e] = (w < 4) ? bf2f(VS[(cn * 16 + fq * 4 + e) * 64 + vb * 16 + fr]) : 0.f;
                const bf16x8 bU0 = pack8h(U0[0], U0[1], U0[2], U0[3], vf[0], vf[1], vf[2], vf[3]);
                const bf16x8 ta = *(const bf16x8*)(TA + (cn * 16 + fr) * 40 + fq * 8);
                const f32x4 U = __builtin_amdgcn_mfma_f32_16x16x32_bf16(ta, bU0, (f32x4){0.f, 0.f, 0.f, 0.f}, 0, 0, 0);
                const bf16x8 bUV = pack8h(U[0], U[1], U[2], U[3], vf[0], vf[1], vf[2], vf[3]);
                const bf16x8 na = *(const bf16x8*)(NA + (cn * 16 + fr) * 40 + fq * 8);
                O = __builtin_amdgcn_mfma_f32_16x16x32_bf16(bUV, na, O, 0, 0, 0);
#pragma unroll
                for (int jj = 0; jj < 1; ++jj) { u32x2 o2; o2.x = pk2(O[0], O[1]); o2.y = pk2(O[2], O[3]); *(u32x2*)(obase + (long)(cn * 16 + fr) * tstep) = o2; }
#pragma unroll
                for (int kt = 0; kt < 4; ++kt) { const bf16x8 kb = *(const bf16x8*)(KBm + (cn * 64 + kt * 16 + fr) * 40 + fq * 8);
                    Sacc[kt] = __builtin_amdgcn_mfma_f32_16x16x32_bf16(kb, bUV, Sacc[kt], 0, 0, 0);
                    const f32x4 pc = *(const f32x4*)(PC + cn * 64 + kt * 16 + fq * 4);
                    Sacc[kt] = Sacc[kt] * pc; }
            }
        } else {
            const int slot = (u - 512) * 4 + (tb >> 6);
            conv_pair(p, slot * 4 + ((tid - 256) >> 7) * 2, ((tid - 256) & 127) * 8);
        }
        lds_barrier();
    }
#undef WKV_LOAD_RAW
    if (!sample) { if (w < 4) { float* so = p.out + (size_t)2 * NPTOK * D + ((size_t)((b * 2 + z) * 16 + hd)) * 4096 + (size_t)(w * 16 + fr0) * 64;
#pragma unroll
        for (int kt = 0; kt < 4; ++kt)
#pragma unroll
            for (int jj = 0; jj < 4; ++jj) so[kt * 16 + fq0 * 4 + jj] = Sacc[kt][jj]; } }
    else { float* so = GH + ((size_t)u * 2 + (w >> 2)) * 4096 + (size_t)((w & 3) * 16 + fr0) * 64;
#pragma unroll
        for (int kt = 0; kt < 4; ++kt)
#pragma unroll
            for (int jj = 0; jj < 4; ++jj) so[kt * 16 + fq0 * 4 + jj] = Sacc[kt][jj]; }
    __syncthreads();
}

__device__ void wkv_fix_unit(const Params& p, int u, float* ldsf) {
    const int tid = threadIdx.x, lane = tid & 63, w = __builtin_amdgcn_readfirstlane(tid >> 6), fr = lane & 15, fq = lane >> 4;
    unsigned char* ws = p.ws;
    bf16_t* OD = (bf16_t*)(ws + WS_X1);
    const bf16_t* RHO = (const bf16_t*)(ws + WS_H);
    const float* GH = (const float*)(ws + WS_BT0);
    const int z = u >> 7, b = (u >> 6) & 1, hd = (u >> 2) & 15, vq = u & 3;
    float* SS = ldsf;
    float* GL = ldsf + 1024;
    bf16_t* SB = (bf16_t*)(ldsf + 1024 + 4096);
    const int v = tid >> 5, kp = (tid & 31) * 2;
    { const float* s0 = p.in[2] + ((size_t)((b * 2 + z) * 16 + hd)) * 4096 + (size_t)(vq * 16 + v) * 64 + kp; SS[v * 64 + kp] = s0[0]; SS[v * 64 + kp + 1] = s0[1]; }
    __syncthreads();
#pragma unroll 1
    for (int sg = 0; sg < 8; ++sg) {
        const int su = ((z * 2 + b) * 16 + hd) * 8 + sg;
        SB[v * 72 + kp] = f2bf_hw(SS[v * 64 + kp]); SB[v * 72 + kp + 1] = f2bf_hw(SS[v * 64 + kp + 1]);
        if (sg < 7) { const f32x4* gsrc = (const f32x4*)(GH + ((size_t)su * 2 + 1) * 4096);
#pragma unroll
            for (int q = 0; q < 2; ++q) ((f32x4*)GL)[tid + q * NTHR] = gsrc[tid + q * NTHR]; }
        __syncthreads();
        const int tlo = z ? (2048 - (sg + 1) * 256) : sg * 256;
#pragma unroll
        for (int q = 0; q < 2; ++q) { const int mt = 2 * w + q;
            f32x4 acc = (f32x4){0.f, 0.f, 0.f, 0.f};
#pragma unroll
            for (int ks = 0; ks < 2; ++ks) { const bf16x8 a = *(const bf16x8*)(RHO + ((size_t)z * 4096 + b * 2048 + tlo + mt * 16 + fr) * 1024 + hd * 64 + ks * 32 + fq * 8);
                const bf16x8 bb = *(const bf16x8*)(SB + fr * 72 + ks * 32 + fq * 8);
                acc = __builtin_amdgcn_mfma_f32_16x16x32_bf16(bb, a, acc, 0, 0, 0); }
            { u32x2* op = (u32x2*)(OD + ((size_t)z * NTOK + NPTOK + b * 2048 + tlo + mt * 16 + fr) * 1024 + hd * 64 + vq * 16 + fq * 4);
              const u32x2 old = *op; u32x2 nw; nw.x = pk2(bflo(old.x) + acc[0], bfhi(old.x) + acc[1]); nw.y = pk2(bflo(old.y) + acc[2], bfhi(old.y) + acc[3]); *op = nw; } }
        if (sg < 7) {
            const float* hsrc = GH + ((size_t)su * 2 + 0) * 4096 + (size_t)(vq * 16 + v) * 64 + kp;
            float a0 = hsrc[0], a1 = hsrc[1];
#pragma unroll 8
            for (int k2 = 0; k2 < 64; ++k2) { const float sv = SS[v * 64 + k2]; a0 += sv * GL[k2 * 64 + kp]; a1 += sv * GL[k2 * 64 + kp + 1]; }
            __syncthreads();
            SS[v * 64 + kp] = a0; SS[v * 64 + kp + 1] = a1;
        }
        __syncthreads();
    }
}
__device__ void phase_wkv_fix(const Params& p, float* lds) {
    for (int it = blockIdx.x; it < 256; it += gridDim.x) wkv_fix_unit(p, it, lds);
}

__device__ void conv_tile(const Params& p, int tile) {
    const int tid = threadIdx.x;
    unsigned char* ws = p.ws;
    const bf16_t* P = (const bf16_t*)(ws + WS_P);
    bf16_t* OC = (bf16_t*)(ws + WS_OC);
    const int cgp = tid & 127, c0 = cgp * 8, sub = tid >> 7;
    float cw0[8], cw1[8], cw2[8];
#pragma unroll
    for (int j = 0; j < 8; ++j) { cw0[j] = p.in[12][c0 + j]; cw1[j] = p.in[12][1024 + c0 + j]; cw2[j] = p.in[12][2048 + c0 + j]; }
    for (int jj = 0; jj < 4; ++jj) {
        const int t = tile * 16 + sub + 4 * jj;
        const int rl = t < NPTOK ? 256 : 64; const int pos = t & (rl - 1);
        const bf16_t* row = P + (size_t)t * N0;
        const u32x4 z4 = (u32x4){0u, 0u, 0u, 0u};
        const u32x4 u1 = *(const u32x4*)(row + c0), g1 = *(const u32x4*)(row + 2048 + c0);
        const u32x4 u0 = pos > 0 ? *(const u32x4*)(row - N0 + c0) : z4, g0 = pos > 0 ? *(const u32x4*)(row - N0 + 2048 + c0) : z4;
        const u32x4 u2 = pos < rl - 1 ? *(const u32x4*)(row + N0 + c0) : z4, g2 = pos < rl - 1 ? *(const u32x4*)(row + N0 + 2048 + c0) : z4;
        const u32x4 gb = *(const u32x4*)(row + 1024 + c0), zc = *(const u32x4*)(row + 3072 + c0);
        u32x4 o;
#pragma unroll
        for (int q = 0; q < 4; ++q) {
            const float y0 = cw0[2 * q] * (bflo(g0[q]) * bflo(u0[q])) + cw1[2 * q] * (bflo(g1[q]) * bflo(u1[q])) + cw2[2 * q] * (bflo(g2[q]) * bflo(u2[q]));
            const float y1 = cw0[2 * q + 1] * (bfhi(g0[q]) * bfhi(u0[q])) + cw1[2 * q + 1] * (bfhi(g1[q]) * bfhi(u1[q])) + cw2[2 * q + 1] * (bfhi(g2[q]) * bfhi(u2[q]));
            o[q] = pack2(silu(bflo(zc[q])) * bflo(gb[q]) * y0, silu(bfhi(zc[q])) * bfhi(gb[q]) * y1);
        }
        *(u32x4*)(OC + (size_t)t * 2048 + c0) = o;
    }
}

__device__ void phase_mix0(const Params& p, float* lds, int rep) {
    (void)rep;
    constexpr int NSCAN = 1024;
    for (int it = blockIdx.x; it < NSCAN; it += gridDim.x) wkv_unit(p, it, lds);
}

__device__ __forceinline__ float quad_sum(float v) {
    v += __int_as_float(__builtin_amdgcn_update_dpp(0, __float_as_int(v), 0xB1, 0xF, 0xF, true));
    v += __int_as_float(__builtin_amdgcn_update_dpp(0, __float_as_int(v), 0x4E, 0xF, 0xF, true));
    return v;
}
__device__ void phase_wkv_post(const Params& p) {
    const int tid = threadIdx.x, wave = tid >> 6, lane = tid & 63;
    unsigned char* ws = p.ws;
    const bf16_t* P = (const bf16_t*)(ws + WS_P);
    const bf16_t* OD = (const bf16_t*)(ws + WS_X1);
    const float* BON = (const float*)(ws + WS_BON);
    bf16_t* OC = (bf16_t*)(ws + WS_OC);
    const int hh = lane >> 2, ch0 = hh * 64 + (lane & 3) * 16;
    for (int tok = blockIdx.x * 8 + wave; tok < NTOK; tok += gridDim.x * 8) {
        const bf16_t* row = P + (size_t)tok * N0;
        u32x4 a0[2], a1[2], vv[2], zz[2];
#pragma unroll
        for (int h = 0; h < 2; ++h) { a0[h] = *(const u32x4*)(OD + (size_t)tok * 1024 + ch0 + h * 8); a1[h] = *(const u32x4*)(OD + ((size_t)NTOK + tok) * 1024 + ch0 + h * 8);
            vv[h] = *(const u32x4*)(row + 6144 + ch0 + h * 8); zz[h] = *(const u32x4*)(row + 7168 + ch0 + h * 8); }
        const float bon = BON[(size_t)tok * 16 + hh] + BON[((size_t)NTOK + tok) * 16 + hh];
        float o[16]; float s1 = 0.f;
#pragma unroll
        for (int h = 0; h < 2; ++h)
#pragma unroll
            for (int q = 0; q < 4; ++q) { o[h * 8 + 2 * q] = bflo(a0[h][q]) + bflo(a1[h][q]); o[h * 8 + 2 * q + 1] = bfhi(a0[h][q]) + bfhi(a1[h][q]); s1 += o[h * 8 + 2 * q] + o[h * 8 + 2 * q + 1]; }
        const float mu = quad_sum(s1) * (1.f / 64.f);
        float s2 = 0.f;
#pragma unroll
        for (int i = 0; i < 16; ++i) { o[i] -= mu; s2 += o[i] * o[i]; }
        const float rs = rsqrtf(quad_sum(s2) * (1.f / 64.f) + 64e-5f);
        float res[16];
#pragma unroll
        for (int g4 = 0; g4 < 4; ++g4) { const f32x4 lw4 = *(const f32x4*)(p.in[22] + ch0 + g4 * 4), lb4 = *(const f32x4*)(p.in[23] + ch0 + g4 * 4);
#pragma unroll
            for (int e = 0; e < 4; ++e) { const int i = g4 * 4 + e; const unsigned vw = vv[i >> 3][(i & 7) >> 1], zw_ = zz[i >> 3][(i & 7) >> 1];
                const float v1 = (i & 1) ? bfhi(vw) : bflo(vw), z1 = (i & 1) ? bfhi(zw_) : bflo(zw_);
                res[i] = (o[i] * rs * lw4[e] + lb4[e] + bon * v1) * silu(z1); } }
#pragma unroll
        for (int h = 0; h < 2; ++h) { u32x4 w4; w4.x = pk2(res[h * 8 + 0], res[h * 8 + 1]); w4.y = pk2(res[h * 8 + 2], res[h * 8 + 3]); w4.z = pk2(res[h * 8 + 4], res[h * 8 + 5]); w4.w = pk2(res[h * 8 + 6], res[h * 8 + 7]);
            *(u32x4*)(OC + (size_t)tok * 2048 + 1024 + ch0 + h * 8) = w4; }
    }
}

constexpr size_t WS_QE = WS_H;
constexpr size_t WS_KDT = WS_BT0;
constexpr size_t WS_VT = WS_OC + (size_t)NTOK * 1024 * 2;
constexpr size_t WS_EBL = WS_BON + (size_t)2 * NTOK * 16 * 4;
constexpr size_t WS_ATT = WS_P + 52 * MB;

__device__ void gla_a_item(const Params& p, int item, float* ldsf) {
    const int tid = threadIdx.x, lane = tid & 63, w = __builtin_amdgcn_readfirstlane(tid >> 6), fr = lane & 15, fq = lane >> 4;
    unsigned char* ws = p.ws;
    const bf16_t* P1 = (const bf16_t*)(ws + WS_P);
    float* OD = (float*)(ws + WS_P2);
    bf16_t* QEg = (bf16_t*)(ws + WS_QE); bf16_t* KDTg = (bf16_t*)(ws + WS_KDT); bf16_t* VTg = (bf16_t*)(ws + WS_VT); float* EBLg = (float*)(ws + WS_EBL);
    const int hd = item & 3, c = (item >> 2) & 127, z = item >> 9, tok0 = c * 64;
    bf16_t* QE = (bf16_t*)ldsf;
    bf16_t* KE = QE + 64 * 136;
    bf16_t* VT = KE + 64 * 136;
    bf16_t* ATT = VT + 256 * 72;
    float* G = (float*)(ATT + 64 * 72);
    float* L1G = G + 64 * 132;
    float* GK2 = L1G + 1024;
    for (int i = tid; i < 1024; i += NTHR) { const int t = i >> 4, r = i & 15; L1G[i] = bf2f(P1[(size_t)(tok0 + t) * N1 + 3072 + z * 16 + r]); }
    for (int i = tid; i < 2048; i += NTHR) { const int r = i >> 7, d = i & 127; GK2[i] = p.in[27][(size_t)(z * 16 + r) * 512 + hd * 128 + d]; }
#pragma unroll
    for (int ps = 0; ps < 4; ++ps) { const int t = lane, e8 = (ps * 8 + w) * 8;
        const u32x4 v8 = *(const u32x4*)(P1 + (size_t)(tok0 + t) * N1 + 1024 + hd * 256 + e8);
        VT[(e8 + 0) * 72 + t] = (bf16_t)(v8.x & 0xFFFF); VT[(e8 + 1) * 72 + t] = (bf16_t)(v8.x >> 16); VT[(e8 + 2) * 72 + t] = (bf16_t)(v8.y & 0xFFFF); VT[(e8 + 3) * 72 + t] = (bf16_t)(v8.y >> 16);
        VT[(e8 + 4) * 72 + t] = (bf16_t)(v8.z & 0xFFFF); VT[(e8 + 5) * 72 + t] = (bf16_t)(v8.z >> 16); VT[(e8 + 6) * 72 + t] = (bf16_t)(v8.w & 0xFFFF); VT[(e8 + 7) * 72 + t] = (bf16_t)(v8.w >> 16); }
    const int d = tid & 127, tq = tid >> 7;
    const float gbias = p.in[28][z * 512 + hd * 128 + d];
    bf16_t qraw[16], kraw[16];
#pragma unroll
    for (int i = 0; i < 16; ++i) { const size_t row = (size_t)(tok0 + tq * 16 + i) * N1; qraw[i] = P1[row + hd * 128 + d]; kraw[i] = P1[row + 512 + hd * 128 + d]; }
    __syncthreads();
    { float run = 0.f;
#pragma unroll 4
      for (int i = 0; i < 16; ++i) { const int t = z ? (tq * 16 + 15 - i) : (tq * 16 + i);
        float x = gbias;
#pragma unroll
        for (int r = 0; r < 16; ++r) x += L1G[t * 16 + r] * GK2[r * 128 + d];
        const float ls = fminf(x, 0.f) - flog(1.f + fexp(-fabsf(x)));
        run += ls * (1.f / 16.f);
        G[t * 132 + d] = run; } }
    __syncthreads();
    { const int lastr = z ? 0 : 15;
      const float t0 = G[(0 + lastr) * 132 + d], t1 = G[(16 + lastr) * 132 + d], t2 = G[(32 + lastr) * 132 + d], t3 = G[(48 + lastr) * 132 + d];
      const float blast = t0 + t1 + t2 + t3;
      float off;
      if (z == 0) off = tq == 0 ? 0.f : (tq == 1 ? t0 : (tq == 2 ? t0 + t1 : t0 + t1 + t2));
      else off = tq == 3 ? 0.f : (tq == 2 ? t3 : (tq == 1 ? t3 + t2 : t3 + t2 + t1));
      if (tq == 0) EBLg[(size_t)(z * 128 + c) * 512 + hd * 128 + d] = fexp(blast);
      unsigned kdp[8];
#pragma unroll
      for (int i = 0; i < 16; ++i) { const int t = tq * 16 + i;
        const float bc = G[t * 132 + d] + off;
        const float q = bf2f(qraw[i]) * 0.08838834764831845f, k = bf2f(kraw[i]);
        const bf16_t qe = f2bf(q * fexp(bc));
        QE[t * 136 + d] = qe; KE[t * 136 + d] = f2bf(k * fexp(-bc));
        const unsigned kd = (unsigned)f2bf(k * fexp(blast - bc));
        if (i & 1) kdp[i >> 1] |= kd << 16; else kdp[i >> 1] = kd; }
      bf16_t* kdst = KDTg + ((size_t)(((z * 128 + c) * 4 + hd) * 128 + d)) * 64 + tq * 16;
      *(u32x4*)kdst = (u32x4){kdp[0], kdp[1], kdp[2], kdp[3]}; *(u32x4*)(kdst + 8) = (u32x4){kdp[4], kdp[5], kdp[6], kdp[7]}; }
    __syncthreads();
#pragma unroll
    for (int q2 = 0; q2 < 2; ++q2) { const int idx = q2 * NTHR + tid; const int t = idx >> 4, d8 = (idx & 15) * 8;
        *(u32x4*)(QEg + ((size_t)z * NTOK + tok0 + t) * 512 + hd * 128 + d8) = *(const u32x4*)(QE + t * 136 + d8); }
    if (z == 0) {
#pragma unroll
        for (int q4 = 0; q4 < 4; ++q4) { const int idx = q4 * NTHR + tid; const int e = idx >> 3, t8 = (idx & 7) * 8;
            *(u32x4*)(VTg + ((size_t)((c * 4 + hd) * 256 + e)) * 64 + t8) = *(const u32x4*)(VT + e * 72 + t8); } }
#pragma unroll
    for (int q2 = 0; q2 < 2; ++q2) { const int tA = 2 * w + q2, ia = tA >> 2, ja = tA & 3;
        f32x4 a4 = (f32x4){0.f, 0.f, 0.f, 0.f};
        if (z ? (ja >= ia) : (ja <= ia)) a4 = mma_nt(QE + ia * 16 * 136, 136, KE + ja * 16 * 136, 136, 128, a4, fr, fq);
#pragma unroll
        for (int jj = 0; jj < 4; ++jj) { const int i = ia * 16 + fq * 4 + jj, j = ja * 16 + fr; const bool keep = z ? (j >= i) : (j <= i); ATT[i * 72 + j] = f2bf(keep ? a4[jj] : 0.f); } }
    __syncthreads();
    { bf16_t* ATTg = (bf16_t*)(ws + WS_ATT) + ((size_t)((z * 128 + c) * 4 + hd)) * 4096;
      const int i = tid >> 3, j8 = (tid & 7) * 8;
      *(u32x4*)(ATTg + i * 64 + j8) = *(const u32x4*)(ATT + i * 72 + j8); }
    __syncthreads();
}

__device__ void phase_gla_a(const Params& p, float* lds) {
    for (int it = blockIdx.x; it < 1024; it += gridDim.x) gla_a_item(p, it, lds);
}

struct GlaFrags { bf16x8 kdt[2]; u32x4 vts; u32x4 qes[2]; bf16x8 att[2]; f32x4 ebl; };

template <int NE>
__device__ __forceinline__ void gla_b_unit_t(const Params& p, int z, int b, int hd, int e0, int nch, int ch0, bool sample, float* ldsf) {
    const int tid = threadIdx.x, lane = tid & 63, w = __builtin_amdgcn_readfirstlane(tid >> 6), fr = lane & 15, fq = lane >> 4;
    unsigned char* ws = p.ws;
    bf16_t* OD = (bf16_t*)(ws + WS_P2);
    const bf16_t* QEg = (const bf16_t*)(ws + WS_QE); const bf16_t* KDTg = (const bf16_t*)(ws + WS_KDT); const bf16_t* VTg = (const bf16_t*)(ws + WS_VT); const float* EBLg = (const float*)(ws + WS_EBL);
    const bf16_t* ATTg = (const bf16_t*)(ws + WS_ATT);
    constexpr int NQ = NE / 2;
    bf16_t* ST = (bf16_t*)ldsf;
    bf16_t* VTL = ST + 2 * 64 * 136;
    bf16_t* QEL = VTL + 2 * 64 * 72;
    f32x4 Sacc[NE];
    if (sample) { const float* s0 = p.in[3] + ((size_t)((b * 2 + z) * 4 + hd)) * 32768 + e0 + fr;
#pragma unroll
        for (int et = 0; et < NE; ++et)
#pragma unroll
            for (int jj = 0; jj < 4; ++jj) Sacc[et][jj] = s0[(size_t)(w * 16 + fq * 4 + jj) * 256 + et * 16]; }
    else {
#pragma unroll
        for (int et = 0; et < NE; ++et) Sacc[et] = (f32x4){0.f, 0.f, 0.f, 0.f}; }
    const int it = w >> 1, e2 = (w & 1) * NQ;
    const int ve = tid >> 3, vt8 = (tid & 7) * 8;
#define GLB_LOAD(F, c_) do { const int cc_ = (c_); \
        _Pragma("unroll") for (int ks = 0; ks < 2; ++ks) { (F).kdt[ks] = *(const bf16x8*)(KDTg + ((size_t)(((z * 128 + cc_) * 4 + hd) * 128 + w * 16 + fr)) * 64 + ks * 32 + fq * 8); \
            (F).att[ks] = *(const bf16x8*)(ATTg + ((size_t)((z * 128 + cc_) * 4 + hd)) * 4096 + (it * 16 + fr) * 64 + ks * 32 + fq * 8); } \
        if (ve < NE * 16) (F).vts = *(const u32x4*)(VTg + ((size_t)((cc_ * 4 + hd) * 256 + e0 + ve)) * 64 + vt8); \
        _Pragma("unroll") for (int h_ = 0; h_ < 2; ++h_) (F).qes[h_] = *(const u32x4*)(QEg + ((size_t)z * NTOK + cc_ * 64 + ve) * 512 + hd * 128 + h_ * 64 + vt8); \
        (F).ebl = *(const f32x4*)(EBLg + (size_t)(z * 128 + cc_) * 512 + hd * 128 + w * 16 + fq * 4); } while (0)
#define GLB_STEP(CUR, NX2, ci_) do { const int ci = (ci_); if (ci < nch) { \
        const int c = ch0 + (z ? nch - 1 - ci : ci); \
        bf16_t* STc = ST + (ci & 1) * 64 * 136; bf16_t* VTc = VTL + (ci & 1) * 64 * 72; \
        _Pragma("unroll") for (int et = 0; et < NE; ++et) { u32x2 v2; v2.x = pk2(Sacc[et][0], Sacc[et][1]); v2.y = pk2(Sacc[et][2], Sacc[et][3]); \
            *(u32x2*)(STc + (et * 16 + fr) * 136 + w * 16 + fq * 4) = v2; } \
        if (ve < NE * 16) *(u32x4*)(VTc + ve * 72 + vt8) = (CUR).vts; \
        bf16_t* QEc = QEL + (ci & 1) * 64 * 136; \
        *(u32x4*)(QEc + ve * 136 + vt8) = (CUR).qes[0]; *(u32x4*)(QEc + ve * 136 + 64 + vt8) = (CUR).qes[1]; \
        if (ci + 2 < nch) GLB_LOAD(NX2, ch0 + (z ? nch - 3 - ci : ci + 2)); \
        lds_barrier(); \
        _Pragma("unroll") for (int et = 0; et < NE; ++et) { Sacc[et] = Sacc[et] * (CUR).ebl; \
            _Pragma("unroll") for (int ks = 0; ks < 2; ++ks) { const bf16x8 vf = *(const bf16x8*)(VTc + (et * 16 + fr) * 72 + ks * 32 + fq * 8); \
                Sacc[et] = __builtin_amdgcn_mfma_f32_16x16x32_bf16((CUR).kdt[ks], vf, Sacc[et], 0, 0, 0); } } \
        _Pragma("unroll") for (int q2 = 0; q2 < NQ; ++q2) { f32x4 o = (f32x4){0.f, 0.f, 0.f, 0.f}; \
            _Pragma("unroll") for (int ks = 0; ks < 2; ++ks) { const bf16x8 vf = *(const bf16x8*)(VTc + ((e2 + q2) * 16 + fr) * 72 + ks * 32 + fq * 8); \
                o = __builtin_amdgcn_mfma_f32_16x16x32_bf16(vf, (CUR).att[ks], o, 0, 0, 0); } \
            _Pragma("unroll") for (int ks = 0; ks < 4; ++ks) { const bf16x8 bS = *(const bf16x8*)(STc + ((e2 + q2) * 16 + fr) * 136 + ks * 32 + fq * 8); \
                const bf16x8 aq = *(const bf16x8*)(QEc + (it * 16 + fr) * 136 + ks * 32 + fq * 8); \
                o = __builtin_amdgcn_mfma_f32_16x16x32_bf16(bS, aq, o, 0, 0, 0); } \
            { u32x2 o2; o2.x = pk2(o[0], o[1]); o2.y = pk2(o[2], o[3]);        \
              *(u32x2*)(OD + ((size_t)z * NTOK + c * 64 + it * 16 + fr) * 1024 + hd * 256 + e0 + (e2 + q2) * 16 + fq * 4) = o2; } } } } while (0)
    GlaFrags fa, fb, fc; fa.vts = fb.vts = fc.vts = (u32x4){0u, 0u, 0u, 0u};
    GLB_LOAD(fa, ch0 + (z ? nch - 1 : 0));
    GLB_LOAD(fb, ch0 + (z ? nch - 2 : 1));
    __syncthreads();
#pragma unroll 1
    for (int ci3 = 0; ci3 < nch; ci3 += 3) { GLB_STEP(fa, fc, ci3); GLB_STEP(fb, fa, ci3 + 1); GLB_STEP(fc, fb, ci3 + 2); }
#undef GLB_STEP
#undef GLB_LOAD
    if (!sample) { float* so = p.out + (size_t)2 * NPTOK * D + 2097152 + ((size_t)((b * 2 + z) * 4 + hd)) * 32768 + e0 + fr;
#pragma unroll
        for (int et = 0; et < NE; ++et)
#pragma unroll
            for (int jj = 0; jj < 4; ++jj) so[(size_t)(w * 16 + fq * 4 + jj) * 256 + et * 16] = Sacc[et][jj]; }
    __syncthreads();
}

__device__ void gla_b_unit(const Params& p, int u, float* ldsf) {
    if (u < 128) gla_b_unit_t<2>(p, u >> 6, (u >> 5) & 1, (u >> 3) & 3, (u & 7) * 32, 32, 64 + ((u >> 5) & 1) * 32, true, ldsf);
    else { const int q = u - 128; gla_b_unit_t<4>(p, q >> 8, (q >> 4) & 15, (q >> 2) & 3, (q & 3) * 64, 4, ((q >> 4) & 15) * 4, false, ldsf); }
}

__device__ void phase_gla_b(const Params& p, float* lds, int rep) {
    unsigned* ctr = (unsigned*)(p.ws + WS_CTL) + 16 + rep * 32;
    int* slot = (int*)(lds + LDS_MAIN / 4);
    for (;;) {
        if (threadIdx.x == 0) *slot = (int)atomicAdd(ctr, 1u);
        __syncthreads();
        const int it = *slot;
        __syncthreads();
        if (it >= 640) break;
        gla_b_unit(p, it, lds);
    }
}

__device__ void phase_gla_post(const Params& p) {
    const int tid = threadIdx.x, wave = tid >> 6, lane = tid & 63;
    unsigned char* ws = p.ws;
    const bf16_t* P1 = (const bf16_t*)(ws + WS_P);
    const bf16_t* OD = (const bf16_t*)(ws + WS_P2);
    bf16_t* OG = (bf16_t*)(ws + WS_OC);
    for (int tok = blockIdx.x * 8 + wave; tok < NTOK; tok += gridDim.x * 8) {
        for (int hd = 0; hd < 4; ++hd) { const int idx = hd * 256 + lane * 4;
            const u32x2 pa = *(const u32x2*)(OD + (size_t)tok * 1024 + idx), pb = *(const u32x2*)(OD + ((size_t)NTOK + tok) * 1024 + idx);
            const f32x4 o = (f32x4){bflo(pa.x) + bflo(pb.x), bfhi(pa.x) + bfhi(pb.x), bflo(pa.y) + bflo(pb.y), bfhi(pa.y) + bfhi(pb.y)};
            const float ss = wave_sum(o[0] * o[0] + o[1] * o[1] + o[2] * o[2] + o[3] * o[3]);
            const float rs = rsqrtf(ss * (1.f / 256.f) + 1e-6f);
            const f32x4 gn = *(const f32x4*)(p.in[29] + lane * 4);
            const u32x2 zz = *(const u32x2*)(P1 + (size_t)tok * N1 + 2048 + idx);
            const float z0 = bflo(zz.x), z1 = bfhi(zz.x), z2 = bflo(zz.y), z3 = bfhi(zz.y);
            u32x2 w; w.x = pack2(o[0] * rs * gn[0] * silu(z0), o[1] * rs * gn[1] * silu(z1)); w.y = pack2(o[2] * rs * gn[2] * silu(z2), o[3] * rs * gn[3] * silu(z3));
            *(u32x2*)(OG + (size_t)tok * 1024 + idx) = w; }
    }
}

__device__ void phase_final(const Params& p) {
    const int tid = threadIdx.x, wave = tid >> 6, lane = tid & 63;
    unsigned char* ws = p.ws;
    const float* MOD = (const float*)(ws + WS_MOD);
    const bf16_t* X1 = (const bf16_t*)(ws + WS_X1);
    const bf16_t* Y = (const bf16_t*)(ws + WS_P2);
    for (int tok = blockIdx.x * 8 + wave; tok < NTOK; tok += gridDim.x * 8) {
        const int cond = tok < NPTOK ? 0 : 1 + ((tok - NPTOK) >> 11);
        f32x4 xv[4]; float ss = 0.f;
#pragma unroll
        for (int i = 0; i < 4; ++i) { const int idx = i * 256 + lane * 4;
            const u32x2 xp = *(const u32x2*)(X1 + (size_t)tok * D + idx);
            const f32x4 x1 = (f32x4){bflo(xp.x), bfhi(xp.x), bflo(xp.y), bfhi(xp.y)};
            const u32x2 pa = *(const u32x2*)(Y + (size_t)tok * D + idx), pb = *(const u32x2*)(Y + (size_t)NTOK * D + (size_t)tok * D + idx);
            const f32x4 ya = (f32x4){bflo(pa.x), bfhi(pa.x), bflo(pa.y), bfhi(pa.y)}, yb = (f32x4){bflo(pb.x), bfhi(pb.x), bflo(pb.y), bfhi(pb.y)};
            const f32x4 gt = *(const f32x4*)(MOD + (1 * 3 + cond) * 3072 + 2048 + idx);
            xv[i] = x1 + gt * (ya + yb);
            ss += xv[i][0] * xv[i][0] + xv[i][1] * xv[i][1] + xv[i][2] * xv[i][2] + xv[i][3] * xv[i][3]; }
        ss = wave_sum(ss);
        const float rstd = rsqrtf(ss * (1.f / 1024.f) + 1e-6f);
#pragma unroll
        for (int i = 0; i < 4; ++i) { const int idx = i * 256 + lane * 4;
            const f32x4 g = *(const f32x4*)(p.in[9] + idx);
            f32x4 o;
#pragma unroll
            for (int j = 0; j < 4; ++j) o[j] = xv[i][j] * rstd * g[j];
            *(f32x4*)(p.out + (size_t)tok * D + idx) = o; }
    }
}


#define XB_TMO      128
#define XB_XCNT(j)  (256  + 64 * (j))
#define XB_XSUB(j)  (1280 + 64 * (j))
#define XB_XGEN(j)  (2304 + 64 * (j))
#define XB_TOP      3328
#define XB_TOPGEN   3392
#define XCD_BAR_WORDS 3456
#define XB_SPIN_CAP (1u << 18)

__device__ __forceinline__ unsigned xb_ld(unsigned* p)              { return __hip_atomic_load(p, __ATOMIC_RELAXED, __HIP_MEMORY_SCOPE_AGENT); }
__device__ __forceinline__ unsigned xb_add(unsigned* p, unsigned v) { return __hip_atomic_fetch_add(p, v, __ATOMIC_RELAXED, __HIP_MEMORY_SCOPE_AGENT); }
__device__ __forceinline__ unsigned xb_xcc_id() { return (unsigned)__builtin_amdgcn_s_getreg((3 << 11) | 20) & 0xFu; }
#define XB_SPIN(cond, bar) do { unsigned _sp = 0; while (cond) { __builtin_amdgcn_s_sleep(1); \
    if ((++_sp & 255u) == 0u) { if (xb_ld(&(bar)[XB_TMO])) break; if (_sp > XB_SPIN_CAP) { atomicAdd(&(bar)[XB_TMO], 1u); break; } } } } while (0)

struct XcdBarrier {
    unsigned* bar; unsigned x;
    volatile LAS unsigned* st;
};

__device__ __forceinline__ XcdBarrier xcd_barrier_post(unsigned* bar, volatile LAS unsigned* st) {
    XcdBarrier b; b.bar = bar; b.x = xb_xcc_id(); b.st = st;
    if (threadIdx.x == 0) (void)xb_add(&bar[XB_XCNT(b.x)], 1u);
    return b;
}
__device__ __forceinline__ void xcd_barrier_complete(unsigned* bar, unsigned x, unsigned& nloc, unsigned& nx) {
    const unsigned G = gridDim.x * gridDim.y * gridDim.z;
    unsigned sum, cnt, mine, sp = 0u;
    for (;;) {
        sum = 0u; cnt = 0u; mine = 0u;
#pragma unroll
        for (unsigned j = 0; j < 16; ++j) { const unsigned c = xb_ld(&bar[XB_XCNT(j)]); sum += c; cnt += (c > 0u) ? 1u : 0u; mine = (j == x) ? c : mine; }
        if (sum == G) break;
        __builtin_amdgcn_s_sleep(1);
        if ((++sp & 255u) == 0u) { if (xb_ld(&bar[XB_TMO])) break; if (sp > XB_SPIN_CAP) { atomicAdd(&bar[XB_TMO], 1u); break; } }
    }
    nloc = mine > 0u ? mine : 1u; nx = cnt > 0u ? cnt : 1u;
}

__device__ __forceinline__ void xcd_barrier(const XcdBarrier& b) {
    asm volatile("s_waitcnt vmcnt(0)" ::: "memory");
    __syncthreads();
    if (threadIdx.x == 0) {
        unsigned* bar = b.bar;
        __builtin_amdgcn_s_waitcnt(0);
        unsigned nloc = b.st[0], nx = b.st[1];
        if (nloc == 0u) { xcd_barrier_complete(bar, b.x, nloc, nx); b.st[0] = nloc; b.st[1] = nx; }
        const unsigned old = xb_add(&bar[XB_XSUB(b.x)], 1u);
        const unsigned gen = old / nloc;
        if (old + 1u == (gen + 1u) * nloc) {
            __builtin_amdgcn_fence(__ATOMIC_RELEASE, "agent");
            asm volatile("s_waitcnt vmcnt(0)" ::: "memory");
            const unsigned og = xb_add(&bar[XB_TOP], 1u);
            const unsigned tg = og / nx;
            if (og + 1u == (tg + 1u) * nx) xb_add(&bar[XB_TOPGEN], 1u);
            else XB_SPIN(xb_ld(&bar[XB_TOPGEN]) == tg, bar);
            __builtin_amdgcn_fence(__ATOMIC_ACQUIRE, "agent");
            xb_add(&bar[XB_XGEN(b.x)], 1u);
            asm volatile("s_waitcnt vmcnt(0)" ::: "memory");
        } else {
            XB_SPIN(xb_ld(&bar[XB_XGEN(b.x)]) == gen, bar);
            __builtin_amdgcn_fence(__ATOMIC_ACQUIRE, "agent");
            asm volatile("s_waitcnt vmcnt(0)" ::: "memory");
        }
    }
    __syncthreads();
}


constexpr int NPHASE = 14;
__global__ void __launch_bounds__(NTHR, 2) fwd_megakernel(Params p) {
    extern __shared__ __attribute__((aligned(16))) unsigned char smem[];
    float* ldsf = (float*)smem;
    LAS unsigned char* ldsl = (LAS unsigned char*)smem;
    unsigned char* ws = p.ws;
    volatile LAS unsigned* xst = (volatile LAS unsigned*)(ldsl + LDS_MAIN + 16);
    if (threadIdx.x == 0) { xst[0] = 0u; xst[1] = 0u; }
    __syncthreads();
    const XcdBarrier xbar = xcd_barrier_post((unsigned*)(ws + WS_BAR), xst);
    if (p.ph_lo < 0) cg::this_grid().sync();
#ifndef DUP_PHASE
#define DUP_PHASE -1
#endif
#define PHASE(n) if (p.ph_lo <= (n) && (n) < p.ph_hi && ((n) == p.ph_lo || (xcd_barrier(xbar), true))) for (int rep = 0; rep < ((n) == DUP_PHASE ? 2 : 1); ++rep, ((n) == DUP_PHASE ? (xcd_barrier(xbar), 0) : 0))
    PHASE(0) phase_prologue(p, ldsf);
    PHASE(1) phase_h(p, 0, ldsf);
    PHASE(2) { pg8::Gemm g{(const bf16_t*)(ws + WS_H), (const bf16_t*)(ws + WS_BT0), NTOK, 8192, 1024, 1024, 1}; pg8::Order S; S.init(NTOK, 8192, 1, gridDim.x, blockIdx.x);
               pg8::EpiBf16 E{(bf16_t*)(ws + WS_P), N0, 0}; pg8::gemm_phase(ldsl, g, S, E); }
    PHASE(3) phase_mix0(p, ldsf, rep);
    PHASE(4) { phase_wkv_fix(p, ldsf); phase_late_weights(p, ldsf); }
    PHASE(5) phase_wkv_post(p);
    PHASE(6) { pg8::Gemm g{(const bf16_t*)(ws + WS_OC), (const bf16_t*)(ws + WS_WT0O), NTOK, 1024, 1024, 2048, 2}; pg8::Order S; S.init(NTOK, 1024, 2, gridDim.x, blockIdx.x);
               pg8::EpiBf16 E{(bf16_t*)(ws + WS_P), 1024, (size_t)NTOK * 1024}; pg8::gemm_phase(ldsl, g, S, E); }
    PHASE(7) phase_h(p, 1, ldsf);
    PHASE(8) { pg8::Gemm g{(const bf16_t*)(ws + WS_H), (const bf16_t*)(ws + WS_BT1), NTOK, N1, 1024, 1024, 1}; pg8::Order S; S.init(NTOK, N1, 1, gridDim.x, blockIdx.x);
               pg8::EpiBf16 E{(bf16_t*)(ws + WS_P), N1, 0}; pg8::gemm_phase(ldsl, g, S, E); }
    PHASE(9) phase_gla_a(p, ldsf);
    PHASE(10) phase_gla_b(p, ldsf, rep);
    PHASE(11) phase_gla_post(p);
    PHASE(12) { pg8::Gemm g{(const bf16_t*)(ws + WS_OC), (const bf16_t*)(ws + WS_WT1O), NTOK, 1024, 512, 1024, 2}; pg8::Order S; S.init(NTOK, 1024, 2, gridDim.x, blockIdx.x);
                pg8::EpiBf16 E{(bf16_t*)(ws + WS_P2), 1024, (size_t)NTOK * 1024}; pg8::gemm_phase(ldsl, g, S, E); }
    PHASE(13) phase_final(p);
}

extern "C" void kernel_launch(void* const* d_in, const int* in_sizes, int n_in, void* d_out, int out_size, void* d_ws, size_t ws_size, hipStream_t stream) {
    static int grid = 0;
    if (grid == 0) {
        if (n_in != 30 || ws_size < WS_END) { fprintf(stderr, "kernel_launch: unexpected n_in %d / ws_size %zu (need %zu)\n", n_in, ws_size, (size_t)WS_END); grid = -1; return; }
        int dev = 0, cus = 0, per_cu = 0;
        hipGetDevice(&dev);
        hipDeviceGetAttribute(&cus, hipDeviceAttributeMultiprocessorCount, dev);
        hipFuncSetAttribute((const void*)fwd_megakernel, hipFuncAttributeMaxDynamicSharedMemorySize, LDS_BYTES);
        hipOccupancyMaxActiveBlocksPerMultiprocessor(&per_cu, (const void*)fwd_megakernel, NTHR, LDS_BYTES);
        if (per_cu < 1) { fprintf(stderr, "kernel_launch: occupancy query returned %d\n", per_cu); per_cu = 1; }
        grid = cus * per_cu;
        (void)hipGetLastError();
    }
    if (grid < 0) return;
    static_assert(XCD_BAR_WORDS * 4 <= 14336, "barrier words overlap the queue counters");
    hipMemsetAsync((char*)d_ws + WS_BAR, 0, 14336 + 256, stream);
    Params p{};
    for (int i = 0; i < 30; ++i) p.in[i] = (const float*)d_in[i];
    p.out = (float*)d_out; p.ws = (unsigned char*)d_ws;
#if MULTI_LAUNCH
    for (int ph = 0; ph < NPHASE; ++ph) { p.ph_lo = ph; p.ph_hi = ph + 1; hipLaunchKernelGGL(fwd_megakernel, dim3(grid), dim3(NTHR), LDS_BYTES, stream, p); }
#else
    p.ph_lo = 0; p.ph_hi = NPHASE;
    void* args[] = {&p};
    hipError_t e = hipLaunchCooperativeKernel((const void*)fwd_megakernel, dim3(grid), dim3(NTHR), args, LDS_BYTES, stream);
    if (e != hipSuccess) fprintf(stderr, "cooperative launch failed: %s (grid %d)\n", hipGetErrorString(e), grid);
#endif
}
```
